# Optimizing an MI355X kernel written in HIP

```python
import jax
import jax.numpy as jnp
from jax import lax
import numpy as np

D_MODEL = 1024
BATCH = 4
SEQ = 8192
DEPTH = 2

GRID_W = 64
CTX_LEN = 256
HEAD_DIM = 64
ROPE_BASE = 10000.0
EPS = 1e-6

A_HEADS = 8
A_KV_HEADS = 2
A_GROUP = A_HEADS // A_KV_HEADS
A_WINDOW = 128
A_BLOCK = A_WINDOW
B_HEADS = 8
B_DK = 64
B_DV = 64
B_CHUNK = 64
C_HEADS = 8
C_NOPE = 64
C_ROPE = 32
C_V = 64
C_Q_LORA = 256
C_KV_LORA = 128
C_QBLOCK = 128
N_BRANCH = 3
BRANCH_W = 512
N_GROUPS = 4
EXPERTS_PER_GROUP = 8
N_EXPERTS = N_GROUPS * EXPERTS_PER_GROUP
TOP_K_IN_GROUP = 2
D_EXPERT = 256

A_Q_W = A_HEADS * HEAD_DIM
A_KV_W = A_KV_HEADS * HEAD_DIM
B_W = B_HEADS * B_DK
GATE_W = N_BRANCH * D_MODEL
IN_SPLITS = (A_Q_W, A_KV_W, A_KV_W, B_W, B_W, B_W, B_W, B_W, C_Q_LORA, C_KV_LORA, C_ROPE, GATE_W)
IN_W = A_Q_W + 2 * A_KV_W + 5 * B_W + C_Q_LORA + C_KV_LORA + C_ROPE + GATE_W

kernel_name = 'hybrid_dit_trunk_swa_hgrn2_mla_hmoe'

F32 = jnp.float32


def rmsnorm(x, g):
    xf = x.astype(F32)
    y = xf * lax.rsqrt(jnp.mean(xf * xf, axis=-1, keepdims=True) + EPS)
    return (y * g.astype(F32)).astype(x.dtype)


def modulate(x, g, shift, scale):
    return rmsnorm(x, g) * (1 + scale) + shift


def axial_rope(rows, rot_dim):
    row = jnp.repeat(jnp.arange(rows, dtype=F32), GRID_W)
    col = jnp.tile(jnp.arange(GRID_W, dtype=F32), rows)
    n_freq = rot_dim // 4
    inv = ROPE_BASE ** (-jnp.arange(n_freq, dtype=F32) / n_freq)
    ang = jnp.concatenate([row[:, None] * inv, col[:, None] * inv], axis=-1)
    return jnp.cos(ang), jnp.sin(ang)


def apply_rope(x, cos, sin):
    half = x.shape[-1] // 2
    x1, x2 = x[..., :half], x[..., half:]
    c = cos[None, :, None, :].astype(x.dtype)
    s = sin[None, :, None, :].astype(x.dtype)
    return jnp.concatenate([x1 * c - x2 * s, x1 * s + x2 * c], axis=-1)


def multi_softmax(parts, sink=None):
    m = parts[0].max(-1, keepdims=True)
    for p in parts[1:]:
        m = jnp.maximum(m, p.max(-1, keepdims=True))
    if sink is not None:
        m = jnp.maximum(m, sink)
    es = [jnp.exp(p - m) for p in parts]
    denom = es[0].sum(-1, keepdims=True)
    for e in es[1:]:
        denom = denom + e.sum(-1, keepdims=True)
    if sink is not None:
        denom = denom + jnp.exp(sink - m)
    return [e / denom for e in es]


def split_in(p):
    idx = np.cumsum(IN_SPLITS)[:-1].tolist()
    return jnp.split(p, idx, axis=-1)


def window_gqa(q, k, v, qc, kc, vc, sink, cos, sin, need_ctx):
    b, s = q.shape[:2]
    nb = s // A_BLOCK
    scale = HEAD_DIM ** -0.5
    q = apply_rope(q, cos, sin)
    k = apply_rope(k, cos, sin)
    qb = q.reshape(b, nb, A_BLOCK, A_KV_HEADS, A_GROUP, HEAD_DIM)

    def band(t):
        tp = jnp.pad(t, ((0, 0), (A_BLOCK, A_BLOCK), (0, 0), (0, 0)))
        tp = tp.reshape(b, nb + 2, A_BLOCK, A_KV_HEADS, HEAD_DIM)
        return jnp.concatenate([tp[:, :-2], tp[:, 1:-1], tp[:, 2:]], axis=2)

    kb, vb = band(k), band(v)
    blk = jnp.arange(nb)[:, None, None] * A_BLOCK
    qpos = blk + jnp.arange(A_BLOCK)[None, :, None]
    kpos = blk - A_BLOCK + jnp.arange(3 * A_BLOCK)[None, None, :]
    valid = (kpos >= 0) & (kpos < s) & (jnp.abs(qpos - kpos) <= A_WINDOW)
    s_lat = jnp.einsum('bnqhgd,bnkhd->bnhgqk', qb, kb, preferred_element_type=F32) * scale
    s_lat = jnp.where(valid[None, :, None, None], s_lat, -jnp.inf)
    s_ctx = jnp.einsum('bnqhgd,blhd->bnhgql', qb, kc, preferred_element_type=F32) * scale
    snk = sink.astype(F32).reshape(1, 1, A_KV_HEADS, A_GROUP, 1, 1)
    p_lat, p_ctx = multi_softmax([s_lat, s_ctx], snk)
    o = (jnp.einsum('bnhgqk,bnkhd->bnqhgd', p_lat.astype(v.dtype), vb)
         + jnp.einsum('bnhgql,blhd->bnqhgd', p_ctx.astype(v.dtype), vc))
    o = o.reshape(b, s, A_Q_W)
    oc = None
    if need_ctx:
        lc = qc.shape[1]
        qcg = qc.reshape(b, lc, A_KV_HEADS, A_GROUP, HEAD_DIM)
        sc = jnp.einsum('blhgd,bmhd->bhglm', qcg, kc, preferred_element_type=F32) * scale
        (pc,) = multi_softmax([sc], sink.astype(F32).reshape(1, A_KV_HEADS, A_GROUP, 1, 1))
        oc = jnp.einsum('bhglm,bmhd->blhgd', pc.astype(vc.dtype), vc).reshape(b, lc, A_Q_W)
    return o, oc


def gla_chunks(q, k, v, logf, s0):
    b, t = q.shape[:2]
    nc = t // B_CHUNK

    def chunks(a):
        return a.astype(F32).reshape(b, nc, B_CHUNK, B_HEADS, a.shape[-1]).transpose(1, 0, 3, 2, 4)

    tri = jnp.tril(jnp.ones((B_CHUNK, B_CHUNK), dtype=bool))

    def step(S, inp):
        qc, kc, vc, gc = inp
        bc = jnp.cumsum(gc, axis=2)
        inter = jnp.einsum('bhtd,bhde->bhte', qc * jnp.exp(bc), S)
        diff = jnp.where(tri[:, :, None], bc[:, :, :, None, :] - bc[:, :, None, :, :], -jnp.inf)
        att = jnp.einsum('bhtsd,bhsd->bhts', qc[:, :, :, None, :] * jnp.exp(diff), kc)
        o = inter + jnp.einsum('bhts,bhse->bhte', att, vc)
        blast = bc[:, :, -1:, :]
        S = jnp.exp(blast[:, :, 0, :, None]) * S + jnp.einsum('bhsd,bhse->bhde', kc * jnp.exp(blast - bc), vc)
        return S, o

    S, o = lax.scan(step, s0, (chunks(q), chunks(k), chunks(v), chunks(logf)))
    o = o.transpose(1, 0, 3, 2, 4).reshape(b, t, B_HEADS, B_DV)
    return o, S


def hgrn2(q, i, zf, zb, g, qc, ic, zfc, zbc, gc, lb, g_onorm, need_ctx):
    def heads(a):
        return a.reshape(a.shape[0], a.shape[1], B_HEADS, B_DK)

    def forget(z, lbd):
        z = z.astype(F32)
        logf = jnp.logaddexp(jnp.log(lbd), jnp.log1p(-lbd) + jax.nn.log_sigmoid(z))
        key = (1 - lbd) * jax.nn.sigmoid(-z)
        return heads(key), heads(logf)

    def flip(a):
        return a[:, ::-1]

    b = q.shape[0]
    s0 = jnp.zeros((b, B_HEADS, B_DK, B_DV), F32)
    qh, vh, qch, vch = heads(q), heads(i), heads(qc), heads(ic)
    kfc, lfc = forget(zfc, lb[0])
    kf, lf = forget(zf, lb[0])
    oc_f, S_f = gla_chunks(qch, kfc, vch, lfc, s0)
    o_f, _ = gla_chunks(qh, kf, vh, lf, S_f)
    kbc, lbc = forget(zbc, lb[1])
    kbw, lbw = forget(zb, lb[1])
    oc_b, S_b = gla_chunks(flip(qch), flip(kbc), flip(vch), flip(lbc), s0)
    o_b, _ = gla_chunks(flip(qh), flip(kbw), flip(vh), flip(lbw), S_b)
    gn = g_onorm.reshape(B_HEADS, B_DV)
    o = rmsnorm(o_f + flip(o_b), gn).reshape(q.shape[0], q.shape[1], B_W).astype(g.dtype) * jax.nn.silu(g)
    oc = None
    if need_ctx:
        oc = rmsnorm(oc_f + flip(oc_b), gn).reshape(qc.shape[0], qc.shape[1], B_W).astype(gc.dtype) * jax.nn.silu(gc)
    return o, oc


def mla(cq, ckv, kr, cqc, ckvc, krc, g_q, g_kv, w_uq, w_ukv, cos, sin, need_ctx):
    def expand(cq_, ckv_, kr_, rope):
        b_, n_ = cq_.shape[:2]
        qh = (rmsnorm(cq_, g_q) @ w_uq).reshape(b_, n_, C_HEADS, C_NOPE + C_ROPE)
        kvh = (rmsnorm(ckv_, g_kv) @ w_ukv).reshape(b_, n_, C_HEADS, C_NOPE + C_V)
        q_nope, q_rope = qh[..., :C_NOPE], qh[..., C_NOPE:]
        k_nope, vv = kvh[..., :C_NOPE], kvh[..., C_NOPE:]
        k_rope = kr_[:, :, None, :]
        if rope:
            q_rope = apply_rope(q_rope, cos, sin)
            k_rope = apply_rope(k_rope, cos, sin)
        qf = jnp.concatenate([q_nope, q_rope], axis=-1)
        kf = jnp.concatenate([k_nope, jnp.broadcast_to(k_rope, (b_, n_, C_HEADS, C_ROPE))], axis=-1)
        return qf, kf, vv

    q, k, v = expand(cq, ckv, kr, True)
    qc, kc, vc = expand(cqc, ckvc, krc, False)
    scale = (C_NOPE + C_ROPE) ** -0.5
    b, s = q.shape[:2]
    nb = s // C_QBLOCK
    qb = q.reshape(b, nb, C_QBLOCK, C_HEADS, C_NOPE + C_ROPE).transpose(1, 0, 2, 3, 4)

    def block(qi):
        s_lat = jnp.einsum('bqhd,bkhd->bhqk', qi, k, preferred_element_type=F32) * scale
        s_ctx = jnp.einsum('bqhd,blhd->bhql', qi, kc, preferred_element_type=F32) * scale
        p_lat, p_ctx = multi_softmax([s_lat, s_ctx])
        return (jnp.einsum('bhqk,bkhd->bqhd', p_lat.astype(v.dtype), v)
                + jnp.einsum('bhql,blhd->bqhd', p_ctx.astype(vc.dtype), vc))

    o = lax.map(block, qb).transpose(1, 0, 2, 3, 4).reshape(b, s, C_HEADS * C_V)
    oc = None
    if need_ctx:
        sc = jnp.einsum('blhd,bmhd->bhlm', qc, kc, preferred_element_type=F32) * scale
        (pc,) = multi_softmax([sc])
        oc = jnp.einsum('bhlm,bmhd->blhd', pc.astype(vc.dtype), vc).reshape(qc.shape[0], qc.shape[1], C_HEADS * C_V)
    return o, oc


def merge_branches(branches, gate_logits, w_br, w_out):
    gl = gate_logits.reshape(gate_logits.shape[0], gate_logits.shape[1], N_BRANCH, D_MODEL)
    y = jax.nn.sigmoid(gl[:, :, 0]) * (branches[0] @ w_br[0])
    for n in range(1, N_BRANCH):
        y = y + jax.nn.sigmoid(gl[:, :, n]) * (branches[n] @ w_br[n])
    return y @ w_out


def hier_moe(h, w_rg, w_re, w1, w3, w2):
    shp = h.shape
    hf = h.reshape(-1, D_MODEL)
    n = hf.shape[0]
    g_logits = jnp.dot(hf, w_rg, preferred_element_type=F32)
    g_prob = jax.nn.softmax(g_logits, axis=-1)
    g_sel = jnp.argmax(g_logits, axis=-1)
    g_w = jnp.take_along_axis(g_prob, g_sel[:, None], axis=-1)
    e_logits = jnp.dot(hf, w_re, preferred_element_type=F32).reshape(n, N_GROUPS, EXPERTS_PER_GROUP)
    e_logits = jnp.take_along_axis(e_logits, g_sel[:, None, None], axis=1)[:, 0]
    e_prob = jax.nn.softmax(e_logits, axis=-1)
    top_v, top_i = lax.top_k(e_prob, TOP_K_IN_GROUP)
    wts = g_w * top_v / top_v.sum(-1, keepdims=True)
    ids = g_sel[:, None] * EXPERTS_PER_GROUP + top_i
    combine = (jax.nn.one_hot(ids, N_EXPERTS, dtype=F32) * wts[..., None]).sum(1)

    def expert(y, inp):
        w1e, w3e, w2e, ce = inp
        a = jax.nn.silu(hf @ w1e) * (hf @ w3e)
        return y + ce[:, None].astype(hf.dtype) * (a @ w2e), None

    y, _ = lax.scan(expert, jnp.zeros_like(hf), (w1, w3, w2, combine.T))
    return y.reshape(shp)


def trunk_layer(x, xc, mod, mod_c, lb, cos_a, sin_a, cos_c, sin_c, g_n1, g_n2, w_in, sink, g_onorm,
                g_q, g_kv, w_uq, w_ukv, w_br, w_out, w_rg, w_re, w1, w3, w2, need_ctx):
    sh1, sc1, gt1, sh2, sc2, gt2 = jnp.split(mod[:, None, :], 6, axis=-1)
    sh1c, sc1c, gt1c, sh2c, sc2c, gt2c = jnp.split(mod_c, 6, axis=-1)
    h = modulate(x, g_n1, sh1, sc1)
    hc = modulate(xc, g_n1, sh1c, sc1c)
    aq, ak, av, bq, bi, bzf, bzb, bg, cq, ckv, ckr, gl = split_in(h @ w_in)
    aqc, akc, avc, bqc, bic, bzfc, bzbc, bgc, cqc, ckvc, ckrc, glc = split_in(hc @ w_in)

    def hd(t, nh):
        return t.reshape(t.shape[0], t.shape[1], nh, HEAD_DIM)

    o_a, oc_a = window_gqa(hd(aq, A_HEADS), hd(ak, A_KV_HEADS), hd(av, A_KV_HEADS),
                           hd(aqc, A_HEADS), hd(akc, A_KV_HEADS), hd(avc, A_KV_HEADS),
                           sink, cos_a, sin_a, need_ctx)
    o_b, oc_b = hgrn2(bq, bi, bzf, bzb, bg, bqc, bic, bzfc, bzbc, bgc, lb, g_onorm, need_ctx)
    o_c, oc_c = mla(cq, ckv, ckr, cqc, ckvc, ckrc, g_q, g_kv, w_uq, w_ukv, cos_c, sin_c, need_ctx)
    x = x + gt1 * merge_branches((o_a, o_b, o_c), gl, w_br, w_out)
    x = x + gt2 * hier_moe(modulate(x, g_n2, sh2, sc2), w_rg, w_re, w1, w3, w2)
    if need_ctx:
        xc = xc + gt1c * merge_branches((oc_a, oc_b, oc_c), glc, w_br, w_out)
        xc = xc + gt2c * hier_moe(modulate(xc, g_n2, sh2c, sc2c), w_rg, w_re, w1, w3, w2)
    return x, xc


def setup_inputs(seed: int = 0) -> dict:
    key = jax.random.key(seed)
    ks = jax.random.split(key, 24)

    def nrm(k, shape, s):
        return jax.random.normal(k, shape, F32) * s

    return {
        'x': nrm(ks[0], (BATCH, SEQ, D_MODEL), 1.0),
        'c': nrm(ks[1], (BATCH, D_MODEL), 1.0),
        'ctx': nrm(ks[2], (BATCH, CTX_LEN, D_MODEL), 1.0),
        'c_ctx': nrm(ks[3], (D_MODEL,), 1.0),
        'w_mod': nrm(ks[4], (DEPTH, D_MODEL, 6 * D_MODEL), 0.5 * D_MODEL ** -0.5),
        'b_mod': nrm(ks[5], (DEPTH, 6 * D_MODEL), 0.02),
        'g_norm1': 1.0 + nrm(ks[6], (DEPTH, D_MODEL), 0.02),
        'g_norm2': 1.0 + nrm(ks[7], (DEPTH, D_MODEL), 0.02),
        'w_in': nrm(ks[8], (DEPTH, D_MODEL, IN_W), D_MODEL ** -0.5),
        'a_sink': nrm(ks[9], (DEPTH, A_HEADS), 0.5),
        'b_lb_logits': nrm(ks[10], (DEPTH, 2, B_W), 0.5),
        'b_onorm': 1.0 + nrm(ks[11], (DEPTH, B_W), 0.02),
        'c_qnorm': 1.0 + nrm(ks[12], (DEPTH, C_Q_LORA), 0.02),
        'c_kvnorm': 1.0 + nrm(ks[13], (DEPTH, C_KV_LORA), 0.02),
        'w_uq': nrm(ks[14], (DEPTH, C_Q_LORA, C_HEADS * (C_NOPE + C_ROPE)), C_Q_LORA ** -0.5),
        'w_ukv': nrm(ks[15], (DEPTH, C_KV_LORA, C_HEADS * (C_NOPE + C_V)), C_KV_LORA ** -0.5),
        'w_br': nrm(ks[16], (DEPTH, N_BRANCH, BRANCH_W, D_MODEL), BRANCH_W ** -0.5),
        'w_out': nrm(ks[17], (DEPTH, D_MODEL, D_MODEL), D_MODEL ** -0.5),
        'w_rg': nrm(ks[18], (DEPTH, D_MODEL, N_GROUPS), D_MODEL ** -0.5),
        'w_re': nrm(ks[19], (DEPTH, D_MODEL, N_EXPERTS), D_MODEL ** -0.5),
        'w1': nrm(ks[20], (DEPTH, N_EXPERTS, D_MODEL, D_EXPERT), D_MODEL ** -0.5),
        'w3': nrm(ks[21], (DEPTH, N_EXPERTS, D_MODEL, D_EXPERT), D_MODEL ** -0.5),
        'w2': nrm(ks[22], (DEPTH, N_EXPERTS, D_EXPERT, D_MODEL), D_EXPERT ** -0.5),
        'g_final': 1.0 + nrm(ks[23], (D_MODEL,), 0.02),
    }


def reference(x, c, ctx, c_ctx, w_mod, b_mod, g_norm1, g_norm2, w_in, a_sink, b_lb_logits, b_onorm,
              c_qnorm, c_kvnorm, w_uq, w_ukv, w_br, w_out, w_rg, w_re, w1, w3, w2, g_final):
    rows = x.shape[1] // GRID_W
    cos_a, sin_a = axial_rope(rows, HEAD_DIM)
    cos_c, sin_c = axial_rope(rows, C_ROPE)
    lb_all = jnp.cumsum(jax.nn.softmax(b_lb_logits.astype(F32), axis=0), axis=0)
    lb_all = lb_all - lb_all[0:1]
    xc = ctx
    for l in range(DEPTH):
        mod = jax.nn.silu(c) @ w_mod[l] + b_mod[l]
        mod_c = jax.nn.silu(c_ctx) @ w_mod[l] + b_mod[l]
        x, xc = trunk_layer(x, xc, mod, mod_c, lb_all[l], cos_a, sin_a, cos_c, sin_c,
                            g_norm1[l], g_norm2[l], w_in[l], a_sink[l], b_onorm[l],
                            c_qnorm[l], c_kvnorm[l], w_uq[l], w_ukv[l], w_br[l], w_out[l],
                            w_rg[l], w_re[l], w1[l], w3[l], w2[l], l < DEPTH - 1)
    return rmsnorm(x, g_final)
```

```cpp
#include <hip/hip_runtime.h>
#include <stdint.h>
#include <math.h>

namespace {
typedef unsigned short bf16_t;
typedef _Float16 f16_t;
typedef short bf16x8 __attribute__((ext_vector_type(8)));
typedef short s16x4 __attribute__((ext_vector_type(4)));
typedef float f32x4 __attribute__((ext_vector_type(4)));
typedef float f32x16 __attribute__((ext_vector_type(16)));
typedef unsigned u32x4 __attribute__((ext_vector_type(4)));
#define LAS __attribute__((address_space(3)))

constexpr int D = 1024, NB = 4, SEQ = 8192, CTXL = 256, RPB = SEQ + CTXL, G = NB * RPB;
constexpr int INW = 6816, MIXW = 3744, GATEW = 3072;
constexpr float EPS = 1e-6f;
constexpr float LOG2E = 1.4426950408889634f;
constexpr int PMAX = 75776;
constexpr int NTILE = PMAX / 256;

__device__ __forceinline__ float bf2f(bf16_t v) { return __uint_as_float(((unsigned)v) << 16); }
__device__ __forceinline__ bf16_t f2bf(float f) { unsigned u = __float_as_uint(f); u += 0x7fffu + ((u >> 16) & 1u); return (bf16_t)(u >> 16); }
__device__ __forceinline__ unsigned pk2(float lo, float hi) { return (unsigned)f2bf(lo) | ((unsigned)f2bf(hi) << 16); }
__device__ __forceinline__ float silu_f(float v) { return v / (1.f + expf(-v)); }
__device__ __forceinline__ float sigmoid_f(float v) { return 1.f / (1.f + expf(-v)); }

__global__ __launch_bounds__(256) void k_mod(const float* c, const float* cctx, const float* wmod, const float* bmod, float* MOD) {
    __shared__ float sc[1024];
    const int rr = blockIdx.y, l = blockIdx.z;
    const float* cv = rr < 4 ? c + rr * 1024 : cctx;
    for (int k = threadIdx.x; k < 1024; k += 256) sc[k] = silu_f(cv[k]);
    __syncthreads();
    const int j = blockIdx.x * 256 + threadIdx.x;
    const float* w = wmod + (size_t)l * 1024 * 6144 + j;
    float acc = 0.f;
    for (int k = 0; k < 1024; ++k) acc += sc[k] * w[(size_t)k * 6144];
    MOD[(size_t)(l * 5 + rr) * 6144 + j] = acc + bmod[l * 6144 + j];
}

__global__ __launch_bounds__(256) void k_tables(const float* lblog, float* ropa_c, float* ropa_s, float* ropc_c, float* ropc_s, float* LB) {
    const int i = blockIdx.x * 256 + threadIdx.x;
    if (i < 8192 * 32) { const int t = i >> 5, j = i & 31, row = t >> 6, col = t & 63, f = j & 15;
        const float inv = powf(10000.f, -(float)f / 16.f); const float ang = (j < 16 ? (float)row : (float)col) * inv;
        ropa_c[i] = (float)cos((double)ang); ropa_s[i] = (float)sin((double)ang); }
    if (i < 8192 * 16) { const int t = i >> 4, j = i & 15, row = t >> 6, col = t & 63, f = j & 7;
        const float inv = powf(10000.f, -(float)f / 8.f); const float ang = (j < 8 ? (float)row : (float)col) * inv;
        ropc_c[i] = (float)cos((double)ang); ropc_s[i] = (float)sin((double)ang); }
    if (i < 2048) { const int l = i >> 10, rest = i & 1023;
        if (l == 0) LB[i] = 0.f; else { const float a0 = lblog[rest], a1 = lblog[1024 + rest]; LB[i] = 1.f / (1.f + expf(a0 - a1)); } }
}

__global__ void k_wt(const float* W, int ldw, int c0, int ncols, bf16_t* Bt, int K, int P, long wstride_z, long bstride_z) {
    __shared__ float tile[32][33];
    W += (size_t)blockIdx.z * wstride_z; Bt += (size_t)blockIdx.z * bstride_z;
    const int p0 = blockIdx.x * 32, k0 = blockIdx.y * 32, tx = threadIdx.x, ty = threadIdx.y;
    for (int i = ty; i < 32; i += 8) { const int k = k0 + i, p = p0 + tx; float v = 0.f; if (p < ncols && k < K) v = W[(size_t)k * ldw + c0 + p]; tile[i][tx] = v; }
    __syncthreads();
    for (int i = ty; i < 32; i += 8) { const int p = p0 + i, k = k0 + tx; if (p < P && k < K) Bt[(size_t)p * K + k] = f2bf(tile[tx][i]); }
}
__global__ __launch_bounds__(256) void k_wc(const float* wuq, const float* wukv, const float* gq, const float* gkv, bf16_t* WC) {
    const int i = blockIdx.x * 256 + threadIdx.x; if (i >= 1792 * 384) return;
    const int p = i / 384, k = i % 384; float v = 0.f;
    if (p < 768) { if (k < 256) v = wuq[k * 768 + p] * gq[k]; } else { if (k >= 256) v = wukv[(k - 256) * 1024 + (p - 768)] * gkv[k - 256]; }
    WC[i] = f2bf(v);
}

struct GArgs { const bf16_t* A; long lda; const bf16_t* Bt; long ldb; float* C; long ldc; int M, N, K; const int* perm; const int* tile_e; long strideB; bf16_t* Y; const float* posw; int mode; int gather; };
__global__ __launch_bounds__(256) void k_gemm(GArgs a) {
    const int lane = threadIdx.x & 63, w = threadIdx.x >> 6;
    const int m0 = blockIdx.y * 64 + w * 16, n0 = blockIdx.x * 64;
    const bf16_t* Bt = a.Bt;
    if (a.tile_e) { const int e = a.tile_e[(blockIdx.y * 64) >> 8]; if (e < 0) return; Bt += (size_t)e * a.strideB; }
    const int fr = lane & 15, fq = lane >> 4;
    int arow = m0 + fr; if (arow >= a.M) arow = a.M - 1;
    long asrc = arow;
    if (a.gather) { const int pe = a.perm[arow]; asrc = pe >= 0 ? (pe >> 1) : 0; }
    const bf16_t* ap = a.A + asrc * a.lda + fq * 8;
    f32x4 acc[4];
    const bf16_t* bp[4];
#pragma unroll
    for (int n = 0; n < 4; ++n) { acc[n] = (f32x4){0.f, 0.f, 0.f, 0.f}; int br = n0 + n * 16 + fr; if (br >= a.N) br = a.N - 1; bp[n] = Bt + (long)br * a.ldb + fq * 8; }
    for (int k = 0; k < a.K; k += 32) {
        const bf16x8 af = *(const bf16x8*)(ap + k);
#pragma unroll
        for (int n = 0; n < 4; ++n) { const bf16x8 bfv = *(const bf16x8*)(bp[n] + k); acc[n] = __builtin_amdgcn_mfma_f32_16x16x32_bf16(af, bfv, acc[n], 0, 0, 0); }
    }
#pragma unroll
    for (int n = 0; n < 4; ++n)
#pragma unroll
        for (int i = 0; i < 4; ++i) { const int row = m0 + fq * 4 + i, col = n0 + n * 16 + fr;
            if (row < a.M && col < a.N) {
                if (a.mode == 0) a.C[(long)row * a.ldc + col] = acc[n][i];
                else { const int pe = a.perm[row]; if (pe >= 0) a.Y[(long)pe * 1024 + col] = f2bf(acc[n][i] * a.posw[row]); }
            } }
}

struct RowInfo { int b, r; bool lat; };
__device__ __forceinline__ RowInfo rowinfo(int g) { RowInfo ri; ri.b = g / RPB; ri.r = g - ri.b * RPB; ri.lat = ri.r < SEQ; return ri; }
__device__ __forceinline__ size_t xoff(const RowInfo& ri) { return ri.lat ? ((size_t)ri.b * SEQ + ri.r) * D : ((size_t)ri.b * CTXL + (ri.r - SEQ)) * D; }

__device__ __forceinline__ float block_sum(float v, float* red) {
#pragma unroll
    for (int o = 32; o >= 1; o >>= 1) v += __shfl_xor(v, o);
    __syncthreads();
    if ((threadIdx.x & 63) == 0) red[threadIdx.x >> 6] = v;
    __syncthreads();
    return red[0] + red[1] + red[2] + red[3];
}

struct NormArgs { const float* xl_src; const float* xc_src; float* xl_dst; float* xc_dst; const bf16_t* ym; const float* modc; int gtc_off;
                  const float* gn; const float* mod; int sh_off, sc_off; bf16_t* H; int skip_ctx;
                  const float* wrg; const float* wre; int* route_e; float* route_w; int* counts; };
__global__ __launch_bounds__(256) void k_norm_mod(NormArgs a) {
    __shared__ float red[4]; __shared__ float sh[1024]; __shared__ float slog[36];
    const int g = blockIdx.x; const RowInfo ri = rowinfo(g);
    if (a.skip_ctx && !ri.lat) return;
    const int mrow = ri.lat ? ri.b : 4;
    const float* xs = (ri.lat ? a.xl_src : a.xc_src) + xoff(ri);
    float* xd = (ri.lat ? a.xl_dst : a.xc_dst) + xoff(ri);
    const int c = threadIdx.x * 4;
    f32x4 v = *(const f32x4*)(xs + c);
    if (a.ym) {
        const bf16_t* y0 = a.ym + (size_t)g * 2048 + c; const float* gt = a.modc + (size_t)mrow * 6144 + a.gtc_off + c;
#pragma unroll
        for (int j = 0; j < 4; ++j) v[j] += gt[j] * (bf2f(y0[j]) + bf2f(y0[1024 + j]));
    }
    if (a.ym || xd != xs) *(f32x4*)(xd + c) = v;
    const float ss = block_sum(v[0] * v[0] + v[1] * v[1] + v[2] * v[2] + v[3] * v[3], red);
    const float rinv = rsqrtf(ss * (1.f / D) + EPS);
    const float* mo = a.mod + (size_t)mrow * 6144;
    float hv[4];
#pragma unroll
    for (int j = 0; j < 4; ++j) hv[j] = v[j] * rinv * a.gn[c + j] * (1.f + mo[a.sc_off + c + j]) + mo[a.sh_off + c + j];
    bf16_t* hp = a.H + (size_t)g * D + c;
    *(uint2*)hp = make_uint2(pk2(hv[0], hv[1]), pk2(hv[2], hv[3]));
    if (a.wrg) {
#pragma unroll
        for (int j = 0; j < 4; ++j) sh[c + j] = hv[j];
        __syncthreads();
        if (threadIdx.x < 36) { const int j = threadIdx.x; float acc = 0.f;
            if (j < 4) { for (int k = 0; k < 1024; ++k) acc += sh[k] * a.wrg[k * 4 + j]; }
            else { for (int k = 0; k < 1024; ++k) acc += sh[k] * a.wre[k * 32 + (j - 4)]; }
            slog[j] = acc; }
        __syncthreads();
        if (threadIdx.x == 0) {
            int gs = 0; float gm = slog[0];
            for (int j = 1; j < 4; ++j) if (slog[j] > gm) { gm = slog[j]; gs = j; }
            float gsum = 0.f; for (int j = 0; j < 4; ++j) gsum += expf(slog[j] - gm);
            const float gw = 1.f / gsum;
            const float* el = slog + 4 + gs * 8;
            int i0 = 0; float m0 = el[0]; for (int j = 1; j < 8; ++j) if (el[j] > m0) { m0 = el[j]; i0 = j; }
            int i1 = -1; float m1 = -3.4e38f; for (int j = 0; j < 8; ++j) if (j != i0 && el[j] > m1) { m1 = el[j]; i1 = j; }
            const float p1 = expf(m1 - m0);
            const float w0 = gw / (1.f + p1), w1 = gw * p1 / (1.f + p1);
            const int e0 = gs * 8 + i0, e1 = gs * 8 + i1;
            a.route_e[g * 2] = e0; a.route_e[g * 2 + 1] = e1; a.route_w[g * 2] = w0; a.route_w[g * 2 + 1] = w1;
            atomicAdd(a.counts + e0, 1); atomicAdd(a.counts + e1, 1);
        }
    }
}

__global__ __launch_bounds__(256) void k_final(float* xl, const bf16_t* ym, const float* modc, const float* gf) {
    __shared__ float red[4];
    const int lrow = blockIdx.x;
    const int b = lrow / SEQ, t = lrow - b * SEQ; const int g = b * RPB + t;
    float* xp = xl + (size_t)lrow * D; const int c = threadIdx.x * 4;
    f32x4 v = *(const f32x4*)(xp + c);
    const bf16_t* y0 = ym + (size_t)g * 2048 + c; const float* gt = modc + (size_t)b * 6144 + 5120 + c;
#pragma unroll
    for (int j = 0; j < 4; ++j) v[j] += gt[j] * (bf2f(y0[j]) + bf2f(y0[1024 + j]));
    const float ss = block_sum(v[0] * v[0] + v[1] * v[1] + v[2] * v[2] + v[3] * v[3], red);
    const float rinv = rsqrtf(ss * (1.f / D) + EPS);
    f32x4 o;
#pragma unroll
    for (int j = 0; j < 4; ++j) o[j] = v[j] * rinv * gf[c + j];
    *(f32x4*)(xp + c) = o;
}

__device__ __forceinline__ float logf_gate(float z, float lb) {
    const float ls = fminf(z, 0.f) - log1pf(expf(-fabsf(z)));
    if (lb <= 0.f) return ls;
    const float a = logf(lb), bb = log1pf(-lb) + ls; const float mx = fmaxf(a, bb);
    return mx + log1pf(expf(-fabsf(a - bb)));
}
struct PostG1 { const float* T;   bf16_t *AQ, *AK, *AV, *BQ, *BV, *BG; f16_t *BLF, *BLB; bf16_t *CQKV, *CKR; float* RS;
                const float *ropa_c, *ropa_s, *ropc_c, *ropc_s; const float* LBl; int g0; int pad; };
__global__ __launch_bounds__(256) void k_post_g1(PostG1 a) {
    __shared__ float red[4];
    const int g = a.g0 + blockIdx.x; const RowInfo ri = rowinfo(g); const int t = ri.r; const size_t s = blockIdx.x;
    const float* T = a.T + s * MIXW;
    float ssq = 0.f, sskv = 0.f;
    for (int j = threadIdx.x; j < MIXW; j += 256) {
        float v = T[j];
        if (j < 640) { const int d = j & 63, base = j - d, i = d & 31;
            if (ri.lat) { const float x1 = T[base + i], x2 = T[base + i + 32], cc = a.ropa_c[t * 32 + i], ss = a.ropa_s[t * 32 + i]; v = d < 32 ? x1 * cc - x2 * ss : x1 * ss + x2 * cc; }
            if (j < 512) a.AQ[s * 512 + j] = f2bf(v); else a.AK[s * 128 + j - 512] = f2bf(v); }
        else if (j < 768) a.AV[s * 128 + j - 640] = f2bf(v);
        else if (j < 1280) a.BQ[s * 512 + j - 768] = f2bf(v);
        else if (j < 1792) a.BV[s * 512 + j - 1280] = f2bf(v);
        else if (j < 2304) a.BLF[s * 512 + j - 1792] = (f16_t)logf_gate(v, a.LBl[j - 1792]);
        else if (j < 2816) a.BLB[s * 512 + j - 2304] = (f16_t)logf_gate(v, a.LBl[512 + j - 2304]);
        else if (j < 3328) a.BG[s * 512 + j - 2816] = f2bf(v);
        else if (j < 3712) { a.CQKV[s * 384 + j - 3328] = f2bf(v); if (j < 3584) ssq += v * v; else sskv += v * v; }
        else { const int d = j - 3712, i = d & 15;
            if (ri.lat) { const float x1 = T[3712 + i], x2 = T[3712 + i + 16], cc = a.ropc_c[t * 16 + i], ss = a.ropc_s[t * 16 + i]; v = d < 16 ? x1 * cc - x2 * ss : x1 * ss + x2 * cc; }
            a.CKR[s * 32 + d] = f2bf(v); }
    }
    const float s1 = block_sum(ssq, red); const float s2 = block_sum(sskv, red);
    if (threadIdx.x == 0) { a.RS[g * 2] = s1; a.RS[g * 2 + 1] = s2; }
}
struct PostC { const float* T; const float* RS; bf16_t* CQ; bf16_t* CKV; const float *ropc_c, *ropc_s; int g0; };
__global__ __launch_bounds__(256) void k_post_c(PostC a) {
    const int g = a.g0 + blockIdx.x; const RowInfo ri = rowinfo(g); const int t = ri.r; const size_t s = blockIdx.x;
    const float* T = a.T + s * 1792;
    const float rq = rsqrtf(a.RS[g * 2] * (1.f / 256.f) + EPS), rkv = rsqrtf(a.RS[g * 2 + 1] * (1.f / 128.f) + EPS);
    for (int j = threadIdx.x; j < 1792; j += 256) {
        if (j < 768) { const int h = j / 96, d = j - h * 96; float v = T[j];
            if (d >= 64 && ri.lat) { const int dd = d - 64, i = dd & 15; const float x1 = T[h * 96 + 64 + i], x2 = T[h * 96 + 64 + i + 16], cc = a.ropc_c[t * 16 + i], ss = a.ropc_s[t * 16 + i]; v = dd < 16 ? x1 * cc - x2 * ss : x1 * ss + x2 * cc; }
            a.CQ[s * 768 + j] = f2bf(v * rq); }
        else a.CKV[s * 1024 + j - 768] = f2bf(T[j] * rkv);
    }
}

__device__ __forceinline__ int crow(int r, int hi) { return (r & 3) + 8 * (r >> 2) + 4 * hi; }
__device__ __forceinline__ unsigned cvtpk(float lo, float hi) { unsigned r; asm("v_cvt_pk_bf16_f32 %0, %1, %2" : "=v"(r) : "v"(lo), "v"(hi)); return r; }
typedef short v4i16_t __attribute__((ext_vector_type(4)));
__device__ __forceinline__ s16x4 vtr(const LAS char* p) { return __builtin_bit_cast(s16x4, __builtin_amdgcn_ds_read_tr16_b64_v4i16((LAS v4i16_t*)p)); }
#define MFMA32(a, b, c) __builtin_amdgcn_mfma_f32_32x32x16_bf16(a, b, c, 0, 0, 0)

struct AttnArgs { const bf16_t* Q; int qld, qhs; const bf16_t* K1; int k1ld, k1hs, kvgroup; const bf16_t* K2; int k2ld; const bf16_t* V; int vld, vhs;
                  bf16_t* O; int old, ohs; float scale_l2; const float* sink; int window; int inbase; int obase; int pad; };
template <int DQK>
__global__ __launch_bounds__(512, 2) void k_attn(AttnArgs p) {
    constexpr int NS = DQK / 16, NCH = DQK / 8;
    __shared__ __attribute__((aligned(16))) char lds[12288 + 8192 + 2048];
    const int tid = threadIdx.x, lane = tid & 63, r32 = lane & 31, hi = lane >> 5, wid = tid >> 6;
    const int qb = blockIdx.x, h = blockIdx.y;
    const bool ctxq = (qb == 32);
    const int q0 = p.inbase + (ctxq ? SEQ : qb * 256); const int oq0 = p.obase + (ctxq ? SEQ : qb * 256);
    int lat_k0 = 0, lat_k1 = 0;
    if (!ctxq) { if (p.window) { lat_k0 = qb * 256 - 128; if (lat_k0 < 0) lat_k0 = 0; lat_k1 = qb * 256 + 384; if (lat_k1 > SEQ) lat_k1 = SEQ; } else { lat_k0 = 0; lat_k1 = SEQ; } }
    const int ntiles = 4 + (lat_k1 - lat_k0) / 64;
    const int qrow = q0 + wid * 32 + r32;
    const int qpos = qb * 256 + wid * 32 + r32;
    LAS char* ldsK = (LAS char*)lds; LAS char* ldsV = (LAS char*)lds + 12288; LAS float* wsf = (LAS float*)((LAS char*)lds + 20480) + wid * 64;
    bf16x8 qr[NS];
#pragma unroll
    for (int s = 0; s < NS; ++s) qr[s] = *(const bf16x8*)(p.Q + (size_t)qrow * p.qld + h * p.qhs + 16 * s + 8 * hi);
    const int k1off = (h / p.kvgroup) * p.k1hs, voff = (h / p.kvgroup) * p.vhs;
    f32x16 o0, o1;
#pragma unroll
    for (int r = 0; r < 16; ++r) { o0[r] = 0.f; o1[r] = 0.f; }
    float m = -1e30f, l = 0.f;
    const LAS char* vbase = ldsV + ((lane >> 4) & 1) * 32 + (lane & 3) * 8 + (4 * hi + ((lane & 15) >> 2)) * 64;
    for (int it = 0; it < ntiles; ++it) {
        const bool lat = it >= 4;
        const int kpos0 = lat ? lat_k0 + 64 * (it - 4) : 0;
        const int krow0 = p.inbase + (lat ? kpos0 : SEQ + 64 * it);
        __syncthreads();
        for (int pc = tid; pc < NCH * 64; pc += 512) { const int c = pc >> 6, row = pc & 63;
            const bf16_t* src = (c < 8) ? p.K1 + (size_t)(krow0 + row) * p.k1ld + k1off + c * 8 : p.K2 + (size_t)(krow0 + row) * p.k2ld + (c - 8) * 8;
            *(LAS u32x4*)(ldsK + c * 1024 + row * 16) = *(const u32x4*)src; }
        { const int dh = tid >> 8, row = (tid & 255) >> 2, pp = tid & 3;
          *(LAS u32x4*)(ldsV + dh * 4096 + row * 64 + pp * 16) = *(const u32x4*)(p.V + (size_t)(krow0 + row) * p.vld + voff + dh * 32 + pp * 8); }
        __syncthreads();
        f32x16 c0, c1;
#pragma unroll
        for (int r = 0; r < 16; ++r) { c0[r] = 0.f; c1[r] = 0.f; }
#pragma unroll
        for (int s = 0; s < NS; ++s) {
            const bf16x8 k0 = *(const LAS bf16x8*)(ldsK + (2 * s + hi) * 1024 + r32 * 16);
            const bf16x8 k1 = *(const LAS bf16x8*)(ldsK + (2 * s + hi) * 1024 + 512 + r32 * 16);
            c0 = MFMA32(k0, qr[s], c0); c1 = MFMA32(k1, qr[s], c1);
        }
        float mx = -1e30f;
#pragma unroll
        for (int r = 0; r < 16; ++r) {
            float s0 = c0[r] * p.scale_l2, s1 = c1[r] * p.scale_l2;
            if (lat && p.window) { const int kp = kpos0 + crow(r, hi); int d0 = qpos - kp; if (d0 < 0) d0 = -d0; int d1 = qpos - (kp + 32); if (d1 < 0) d1 = -d1;
                if (d0 > p.window) s0 = -1e30f; if (d1 > p.window) s1 = -1e30f; }
            c0[r] = s0; c1[r] = s1; mx = fmaxf(mx, fmaxf(s0, s1));
        }
        mx = fmaxf(mx, __shfl_xor(mx, 32));
        const float mn = fmaxf(m, mx); const float alpha = __builtin_amdgcn_exp2f(m - mn); m = mn;
        float rs = 0.f;
#pragma unroll
        for (int r = 0; r < 16; ++r) { c0[r] = __builtin_amdgcn_exp2f(c0[r] - m); c1[r] = __builtin_amdgcn_exp2f(c1[r] - m); rs += c0[r] + c1[r]; }
        l = l * alpha + rs;
        if (__any(alpha != 1.f)) {
            if (hi == 0) wsf[r32] = alpha;
#pragma unroll
            for (int r = 0; r < 16; ++r) { const float f = wsf[crow(r, hi)]; o0[r] *= f; o1[r] *= f; }
        }
        u32x4 pw[4];
        pw[0] = (u32x4){cvtpk(c0[0], c0[1]), cvtpk(c0[2], c0[3]), cvtpk(c0[4], c0[5]), cvtpk(c0[6], c0[7])};
        pw[1] = (u32x4){cvtpk(c0[8], c0[9]), cvtpk(c0[10], c0[11]), cvtpk(c0[12], c0[13]), cvtpk(c0[14], c0[15])};
        pw[2] = (u32x4){cvtpk(c1[0], c1[1]), cvtpk(c1[2], c1[3]), cvtpk(c1[4], c1[5]), cvtpk(c1[6], c1[7])};
        pw[3] = (u32x4){cvtpk(c1[8], c1[9]), cvtpk(c1[10], c1[11]), cvtpk(c1[12], c1[13]), cvtpk(c1[14], c1[15])};
#pragma unroll
        for (int s = 0; s < 4; ++s) {
            const s16x4 a0 = vtr(vbase + s * 1024), a1 = vtr(vbase + s * 1024 + 512);
            const s16x4 b0 = vtr(vbase + 4096 + s * 1024), b1 = vtr(vbase + 4096 + s * 1024 + 512);
            const bf16x8 v0 = (bf16x8){a0[0], a0[1], a0[2], a0[3], a1[0], a1[1], a1[2], a1[3]};
            const bf16x8 v1 = (bf16x8){b0[0], b0[1], b0[2], b0[3], b1[0], b1[1], b1[2], b1[3]};
            const bf16x8 pa = __builtin_bit_cast(bf16x8, pw[s]);
            o0 = MFMA32(pa, v0, o0); o1 = MFMA32(pa, v1, o1);
        }
    }
    float lt = l + __shfl_xor(l, 32);
    float fin = 1.f;
    if (p.sink) { const float sk = p.sink[h] * LOG2E; const float m2 = fmaxf(m, sk); fin = __builtin_amdgcn_exp2f(m - m2); lt = lt * fin + __builtin_amdgcn_exp2f(sk - m2); }
    const float sc = fin / lt;
    if (hi == 0) wsf[r32] = sc;
    bf16_t* Ob = p.O + (size_t)(oq0 + wid * 32) * p.old + h * p.ohs + r32;
#pragma unroll
    for (int r = 0; r < 16; ++r) { const int qr_ = crow(r, hi); const float f = wsf[qr_];
        Ob[(size_t)qr_ * p.old] = f2bf(o0[r] * f); Ob[(size_t)qr_ * p.old + 32] = f2bf(o1[r] * f); }
}

__global__ __launch_bounds__(256) void k_scan(const bf16_t* BQ, const bf16_t* BV, const f16_t* BLF, const f16_t* BLB, float* OF, float* OBk, int gbase) {
    __shared__ float cq[64][64], cf[64][64], cv[64][64]; __shared__ float red[2][4][64];
    const int h = blockIdx.x >> 1, dir = blockIdx.x & 1, tid = threadIdx.x, e = tid & 63, dg = tid >> 6;
    const f16_t* BL = dir ? BLB : BLF; float* OUT = dir ? OBk : OF;
    float S[16];
#pragma unroll
    for (int i = 0; i < 16; ++i) S[i] = 0.f;
    for (int chunk = 0; chunk < RPB / 64; ++chunk) {
        __syncthreads();
        for (int i = tid; i < 4096; i += 256) { const int s = i >> 6, d = i & 63; const int step = chunk * 64 + s;
            int r; if (dir == 0) r = step < CTXL ? SEQ + step : step - CTXL; else r = step < CTXL ? SEQ + (CTXL - 1 - step) : SEQ - 1 - (step - CTXL);
            const size_t off = (size_t)r * 512 + h * 64 + d;
            cq[s][d] = bf2f(BQ[off]); cv[s][d] = bf2f(BV[off]); const float lf = (float)BL[off]; cf[s][d] = expf(lf); }
        __syncthreads();
        for (int s = 0; s < 64; ++s) {
            const float ve = cv[s][e]; float part = 0.f;
#pragma unroll
            for (int i = 0; i < 16; ++i) { const int d = dg * 16 + i; const float f = cf[s][d]; S[i] = f * S[i] + (1.f - f) * ve; part += S[i] * cq[s][d]; }
            red[s & 1][dg][e] = part;
            __syncthreads();
            if (tid < 64) { const int step = chunk * 64 + s;
                int r; if (dir == 0) r = step < CTXL ? SEQ + step : step - CTXL; else r = step < CTXL ? SEQ + (CTXL - 1 - step) : SEQ - 1 - (step - CTXL);
                OUT[(size_t)r * 512 + h * 64 + e] = red[s & 1][0][e] + red[s & 1][1][e] + red[s & 1][2][e] + red[s & 1][3][e]; }
        }
    }
}
__global__ __launch_bounds__(256) void k_scan_combine(const float* OF, const float* OBk, const bf16_t* BG, const float* gn, bf16_t* OB, int g0) {
    const int w = threadIdx.x >> 6, e = threadIdx.x & 63; const int idx = blockIdx.x * 4 + w; const int g = g0 + (idx >> 3), h = idx & 7;
    const size_t off = (size_t)g * 512 + h * 64 + e, offs = (size_t)(idx >> 3) * 512 + h * 64 + e;
    const float o = OF[offs] + OBk[offs]; float ss = o * o;
#pragma unroll
    for (int k = 32; k >= 1; k >>= 1) ss += __shfl_xor(ss, k);
    const float rinv = rsqrtf(ss * (1.f / 64.f) + EPS); const float gv = bf2f(BG[offs]);
    OB[off] = f2bf(o * rinv * gn[h * 64 + e] * silu_f(gv));
}

__global__ __launch_bounds__(256) void k_post_gate(const float* T, bf16_t* GATE, int g0, int n) {
    const size_t i = (size_t)blockIdx.x * 256 + threadIdx.x; if (i >= (size_t)n) return;
    (void)g0; GATE[i] = f2bf(sigmoid_f(T[i]));
}
__global__ __launch_bounds__(256) void k_post_merge(const float* T0, const float* T1, const float* T2, const bf16_t* GATE, bf16_t* Y, int g0) {
    (void)g0; const size_t g = blockIdx.x; const int c = threadIdx.x * 4;
#pragma unroll
    for (int j = 0; j < 4; ++j) { const size_t o = g * 1024 + c + j; const bf16_t* gp = GATE + g * GATEW + c + j;
        Y[o] = f2bf(bf2f(gp[0]) * T0[o] + bf2f(gp[1024]) * T1[o] + bf2f(gp[2048]) * T2[o]); }
}
__global__ __launch_bounds__(256) void k_post_res(const float* T, const float* xl_src, const float* xc_src, float* xl_dst, float* xc_dst, const float* mod, int g0) {
    const int g = g0 + blockIdx.x; const RowInfo ri = rowinfo(g); const int mrow = ri.lat ? ri.b : 4; const int c = threadIdx.x * 4;
    const float* xs = (ri.lat ? xl_src : xc_src) + xoff(ri); float* xd = (ri.lat ? xl_dst : xc_dst) + xoff(ri);
    const float* gt = mod + (size_t)mrow * 6144 + 2048 + c; const float* tp = T + (size_t)blockIdx.x * 1024 + c;
    f32x4 v = *(const f32x4*)(xs + c);
#pragma unroll
    for (int j = 0; j < 4; ++j) v[j] += gt[j] * tp[j];
    *(f32x4*)(xd + c) = v;
}

__global__ void k_moe_offsets(const int* counts, int* offs, int* cursor, int* tile_e) {
    if (threadIdx.x == 0) { int o = 0; for (int e = 0; e < 32; ++e) { offs[e] = o; cursor[e] = 0; const int n = (counts[e] + 255) & ~255; for (int t = o >> 8; t < (o + n) >> 8; ++t) tile_e[t] = e; o += n; }
        offs[32] = o; for (int t = o >> 8; t < NTILE; ++t) tile_e[t] = -1; }
}
__global__ __launch_bounds__(256) void k_moe_scatter(const int* route_e, const float* route_w, const int* offs, int* cursor, int* perm, float* posw, int skip_ctx) {
    const int i = blockIdx.x * 256 + threadIdx.x; if (i >= 2 * G) return;
    const int g = i >> 1; const RowInfo ri = rowinfo(g); if (skip_ctx && !ri.lat) return;
    const int e = route_e[i]; const int pos = offs[e] + atomicAdd(cursor + e, 1);
    perm[pos] = i; posw[pos] = route_w[i];
}
__global__ __launch_bounds__(256) void k_post_up(const float* T, const int* tile_e, bf16_t* AUP) {
    const int pos = blockIdx.x; if (tile_e[pos >> 8] < 0) return;
    const int j = threadIdx.x; const float u1 = T[(size_t)pos * 512 + j], u3 = T[(size_t)pos * 512 + 256 + j];
    AUP[(size_t)pos * 256 + j] = f2bf(silu_f(u1) * u3);
}
}

extern "C" void kernel_launch(void* const* d_in, const int* in_sizes, int n_in, void* d_out, int out_size, void* d_ws, size_t ws_size, hipStream_t stream) {
    const float* x = (const float*)d_in[0]; const float* c = (const float*)d_in[1]; const float* ctx = (const float*)d_in[2]; const float* c_ctx = (const float*)d_in[3];
    const float* w_mod = (const float*)d_in[4]; const float* b_mod = (const float*)d_in[5]; const float* g_norm1 = (const float*)d_in[6]; const float* g_norm2 = (const float*)d_in[7];
    const float* w_in = (const float*)d_in[8]; const float* a_sink = (const float*)d_in[9]; const float* b_lb = (const float*)d_in[10]; const float* b_onorm = (const float*)d_in[11];
    const float* c_qnorm = (const float*)d_in[12]; const float* c_kvnorm = (const float*)d_in[13]; const float* w_uq = (const float*)d_in[14]; const float* w_ukv = (const float*)d_in[15];
    const float* w_br = (const float*)d_in[16]; const float* w_out = (const float*)d_in[17]; const float* w_rg = (const float*)d_in[18]; const float* w_re = (const float*)d_in[19];
    const float* w1 = (const float*)d_in[20]; const float* w3 = (const float*)d_in[21]; const float* w2 = (const float*)d_in[22]; const float* g_final = (const float*)d_in[23];
    float* out = (float*)d_out; char* ws = (char*)d_ws;
    const size_t MiB = 1u << 20;
    int* counts = (int*)(ws + 0);
    int* offs = (int*)(ws + 256);
    int* cursor = (int*)(ws + 512);
    int* tile_e = (int*)(ws + 1024);
    float* MOD = (float*)(ws + 1 * MiB);
    float* LB = (float*)(ws + 1 * MiB + 512 * 1024);
    float* ropa_c = (float*)(ws + 2 * MiB); float* ropa_s = (float*)(ws + 3 * MiB);
    float* ropc_c = (float*)(ws + 4 * MiB); float* ropc_s = (float*)(ws + 4 * MiB + 512 * 1024);
    float* XC = (float*)(ws + 5 * MiB);
    float* RS = (float*)(ws + 9 * MiB);
    int* route_e = (int*)(ws + 10 * MiB); float* route_w = (float*)(ws + 11 * MiB);
    int* perm = (int*)(ws + 12 * MiB); float* posw = (float*)(ws + 13 * MiB);
    bf16_t* WIN = (bf16_t*)(ws + 16 * MiB);
    bf16_t* WC = (bf16_t*)(ws + 30 * MiB);
    bf16_t* WBR = (bf16_t*)(ws + 32 * MiB);
    bf16_t* WOUT = (bf16_t*)(ws + 35 * MiB);
    bf16_t* WUP = (bf16_t*)(ws + 37 * MiB);
    bf16_t* WDN = (bf16_t*)(ws + 69 * MiB);
    bf16_t* H = (bf16_t*)(ws + 85 * MiB);
    bf16_t* OA = (bf16_t*)(ws + 151 * MiB);
    bf16_t* OB = (bf16_t*)(ws + 184 * MiB);
    bf16_t* OC = (bf16_t*)(ws + 217 * MiB);
    char* SL = ws + 250 * MiB;
    bf16_t* AQs = (bf16_t*)(SL);
    bf16_t* AKs = (bf16_t*)(SL + 9 * MiB);
    bf16_t* AVs = (bf16_t*)(SL + 12 * MiB);
    bf16_t* BQs = (bf16_t*)(SL + 15 * MiB);
    bf16_t* BVs = (bf16_t*)(SL + 24 * MiB);
    bf16_t* BGs = (bf16_t*)(SL + 33 * MiB);
    f16_t* BLFs = (f16_t*)(SL + 42 * MiB);
    f16_t* BLBs = (f16_t*)(SL + 51 * MiB);
    bf16_t* CQKVs = (bf16_t*)(SL + 60 * MiB);
    bf16_t* CKRs = (bf16_t*)(SL + 67 * MiB);
    bf16_t* CQs = (bf16_t*)(SL + 68 * MiB);
    float* TMP = (float*)(ws + 340 * MiB);
    float* OFt = (float*)(ws + 461 * MiB);
    float* OBt = (float*)(ws + 478 * MiB);
    bf16_t* CKVs = (bf16_t*)(ws + 495 * MiB);
    bf16_t* GATEs = (bf16_t*)(SL);
    bf16_t* Ys = (bf16_t*)(SL + 60 * MiB);
    bf16_t* YM2 = (bf16_t*)(ws + 151 * MiB);
    bf16_t* AUP = (bf16_t*)(ws + 284 * MiB);
    (void)in_sizes; (void)n_in; (void)out_size; (void)ws_size;

    hipMemsetAsync(ws, 0, 4096, stream);
    k_mod<<<dim3(24, 5, 2), 256, 0, stream>>>(c, c_ctx, w_mod, b_mod, MOD);
    k_tables<<<1024, 256, 0, stream>>>(b_lb, ropa_c, ropa_s, ropc_c, ropc_s, LB);

    auto gemm = [&](const bf16_t* A, long lda, const bf16_t* Bt, long ldb, float* C, long ldc, int M, int N, int K) {
        GArgs a{}; a.A = A; a.lda = lda; a.Bt = Bt; a.ldb = ldb; a.C = C; a.ldc = ldc; a.M = M; a.N = N; a.K = K; a.mode = 0; a.gather = 0;
        k_gemm<<<dim3((N + 63) / 64, (M + 63) / 64), 256, 0, stream>>>(a);
    };

    for (int l = 0; l < 2; ++l) {
        const float* MODl = MOD + (size_t)l * 5 * 6144;
        const bool last = (l == 1);
        k_wt<<<dim3(INW / 32, 32, 1), dim3(32, 8), 0, stream>>>(w_in + (size_t)l * 1024 * INW, INW, 0, INW, WIN, 1024, INW, 0, 0);
        k_wc<<<(1792 * 384 + 255) / 256, 256, 0, stream>>>(w_uq + (size_t)l * 256 * 768, w_ukv + (size_t)l * 128 * 1024, c_qnorm + l * 256, c_kvnorm + l * 128, WC);
        k_wt<<<dim3(32, 16, 3), dim3(32, 8), 0, stream>>>(w_br + (size_t)l * 3 * 512 * 1024, 1024, 0, 1024, WBR, 512, 1024, 512 * 1024, 1024 * 512);
        k_wt<<<dim3(32, 32, 1), dim3(32, 8), 0, stream>>>(w_out + (size_t)l * 1024 * 1024, 1024, 0, 1024, WOUT, 1024, 1024, 0, 0);
        k_wt<<<dim3(8, 32, 32), dim3(32, 8), 0, stream>>>(w1 + (size_t)l * 32 * 1024 * 256, 256, 0, 256, WUP, 1024, 256, 1024 * 256, 512 * 1024);
        k_wt<<<dim3(8, 32, 32), dim3(32, 8), 0, stream>>>(w3 + (size_t)l * 32 * 1024 * 256, 256, 0, 256, WUP + 256 * 1024, 1024, 256, 1024 * 256, 512 * 1024);
        k_wt<<<dim3(32, 8, 32), dim3(32, 8), 0, stream>>>(w2 + (size_t)l * 32 * 256 * 1024, 1024, 0, 1024, WDN, 256, 1024, 256 * 1024, 1024 * 256);
        { NormArgs a{}; a.xl_src = l == 0 ? x : out; a.xc_src = l == 0 ? ctx : XC; a.xl_dst = out; a.xc_dst = XC;
          a.ym = l == 0 ? nullptr : YM2; a.modc = MOD + (size_t)(l - 1 < 0 ? 0 : l - 1) * 5 * 6144; a.gtc_off = 5120;
          a.gn = g_norm1 + l * 1024; a.mod = MODl; a.sh_off = 0; a.sc_off = 1024; a.H = H; a.skip_ctx = 0; a.wrg = nullptr;
          if (l == 0) { a.xl_dst = (float*)x; a.xc_dst = (float*)ctx; }
          k_norm_mod<<<G, 256, 0, stream>>>(a); }
        for (int b = 0; b < NB; ++b) {
            const int g0 = b * RPB;
            bf16_t* AQ = AQs; bf16_t* AK = AKs; bf16_t* AV = AVs; bf16_t* BQ = BQs; bf16_t* BV = BVs; bf16_t* BG = BGs; f16_t* BLF = BLFs; f16_t* BLB = BLBs;
            bf16_t* CQKV = CQKVs; bf16_t* CKR = CKRs; bf16_t* CQ = CQs; bf16_t* CKV = CKVs; float* OFv = OFt; float* OBv = OBt;
            gemm(H + (size_t)g0 * 1024, 1024, WIN, 1024, TMP, MIXW, RPB, MIXW, 1024);
            { PostG1 a{}; a.T = TMP; a.AQ = AQ; a.AK = AK; a.AV = AV; a.BQ = BQ; a.BV = BV; a.BG = BG; a.BLF = BLF; a.BLB = BLB; a.CQKV = CQKV; a.CKR = CKR; a.RS = RS;
              a.ropa_c = ropa_c; a.ropa_s = ropa_s; a.ropc_c = ropc_c; a.ropc_s = ropc_s; a.LBl = LB + l * 1024; a.g0 = g0;
              k_post_g1<<<RPB, 256, 0, stream>>>(a); }
            gemm(CQKVs, 384, WC, 384, TMP, 1792, RPB, 1792, 384);
            { PostC a{}; a.T = TMP; a.RS = RS; a.CQ = CQ; a.CKV = CKV; a.ropc_c = ropc_c; a.ropc_s = ropc_s; a.g0 = g0; k_post_c<<<RPB, 256, 0, stream>>>(a); }
            const int nqb = last ? 32 : 33;
            { AttnArgs a{}; a.Q = AQ; a.qld = 512; a.qhs = 64; a.K1 = AK; a.k1ld = 128; a.k1hs = 64; a.kvgroup = 4; a.K2 = nullptr; a.k2ld = 0; a.V = AV; a.vld = 128; a.vhs = 64;
              a.O = OA; a.old = 512; a.ohs = 64; a.scale_l2 = 0.125f * LOG2E; a.sink = a_sink + l * 8; a.window = 128; a.inbase = 0; a.obase = g0;
              k_attn<64><<<dim3(nqb, 8), 512, 0, stream>>>(a); }
            k_scan<<<16, 256, 0, stream>>>(BQ, BV, BLF, BLB, OFv, OBv, g0);
            k_scan_combine<<<(last ? SEQ : RPB) * 2, 256, 0, stream>>>(OFv, OBv, BG, b_onorm + l * 512, OB, g0);
            { AttnArgs a{}; a.Q = CQ; a.qld = 768; a.qhs = 96; a.K1 = CKV; a.k1ld = 1024; a.k1hs = 128; a.kvgroup = 1; a.K2 = CKR; a.k2ld = 32; a.V = CKV + 64; a.vld = 1024; a.vhs = 128;
              a.O = OC; a.old = 512; a.ohs = 64; a.scale_l2 = 0.10206207261596577f * LOG2E; a.sink = nullptr; a.window = 0; a.inbase = 0; a.obase = g0;
              k_attn<96><<<dim3(nqb, 8), 512, 0, stream>>>(a); }
        }
        for (int b = 0; b < NB; ++b) {
            const int g0 = b * RPB; const int M = last ? SEQ : RPB;
            bf16_t* GATE = GATEs; bf16_t* Y = Ys;
            gemm(H + (size_t)g0 * 1024, 1024, WIN + (size_t)MIXW * 1024, 1024, TMP, GATEW, M, GATEW, 1024);
            k_post_gate<<<(int)(((size_t)M * GATEW + 255) / 256), 256, 0, stream>>>(TMP, GATE, g0, M * GATEW);
            float* T0 = TMP; float* T1 = TMP + (size_t)RPB * 1024; float* T2 = TMP + (size_t)2 * RPB * 1024;
            gemm(OA + (size_t)g0 * 512, 512, WBR, 512, T0, 1024, M, 1024, 512);
            gemm(OB + (size_t)g0 * 512, 512, WBR + 1024 * 512, 512, T1, 1024, M, 1024, 512);
            gemm(OC + (size_t)g0 * 512, 512, WBR + 2 * 1024 * 512, 512, T2, 1024, M, 1024, 512);
            k_post_merge<<<M, 256, 0, stream>>>(T0, T1, T2, GATE, Y, g0);
            gemm(Ys, 1024, WOUT, 1024, TMP, 1024, M, 1024, 1024);
            k_post_res<<<M, 256, 0, stream>>>(TMP, l == 0 ? x : out, l == 0 ? ctx : XC, out, XC, MODl, g0);
        }
        hipMemsetAsync(counts, 0, 128, stream);
        hipMemsetAsync(perm, 0xFF, PMAX * 4, stream);
        { NormArgs a{}; a.xl_src = out; a.xc_src = XC; a.xl_dst = out; a.xc_dst = XC; a.ym = nullptr; a.modc = MODl; a.gtc_off = 5120;
          a.gn = g_norm2 + l * 1024; a.mod = MODl; a.sh_off = 3072; a.sc_off = 4096; a.H = H; a.skip_ctx = last ? 1 : 0;
          a.wrg = w_rg + (size_t)l * 1024 * 4; a.wre = w_re + (size_t)l * 1024 * 32; a.route_e = route_e; a.route_w = route_w; a.counts = counts;
          k_norm_mod<<<G, 256, 0, stream>>>(a); }
        k_moe_offsets<<<1, 64, 0, stream>>>(counts, offs, cursor, tile_e);
        k_moe_scatter<<<(2 * G + 255) / 256, 256, 0, stream>>>(route_e, route_w, offs, cursor, perm, posw, last ? 1 : 0);
        { GArgs a{}; a.A = H; a.lda = 1024; a.Bt = WUP; a.ldb = 1024; a.C = TMP; a.ldc = 512; a.M = PMAX; a.N = 512; a.K = 1024; a.perm = perm; a.tile_e = tile_e; a.strideB = 512 * 1024; a.mode = 0; a.gather = 1;
          k_gemm<<<dim3(8, PMAX / 64), 256, 0, stream>>>(a); }
        k_post_up<<<PMAX, 256, 0, stream>>>(TMP, tile_e, AUP);
        { GArgs a{}; a.A = AUP; a.lda = 256; a.Bt = WDN; a.ldb = 256; a.C = nullptr; a.ldc = 0; a.M = PMAX; a.N = 1024; a.K = 256; a.perm = perm; a.tile_e = tile_e; a.strideB = 1024 * 256; a.Y = YM2; a.posw = posw; a.mode = 1; a.gather = 0;
          k_gemm<<<dim3(16, PMAX / 64), 256, 0, stream>>>(a); }
    }
    k_final<<<NB * SEQ, 256, 0, stream>>>(out, YM2, MOD + (size_t)5 * 6144, g_final);
}
```

```cpp
#include <hip/hip_runtime.h>
#include <stdint.h>
#include <math.h>

namespace {
typedef unsigned short bf16_t;
typedef _Float16 f16_t;
typedef short bf16x8 __attribute__((ext_vector_type(8)));
typedef short s16x4 __attribute__((ext_vector_type(4)));
typedef float f32x4 __attribute__((ext_vector_type(4)));
typedef float f32x16 __attribute__((ext_vector_type(16)));
typedef unsigned u32x4 __attribute__((ext_vector_type(4)));
#define LAS __attribute__((address_space(3)))

constexpr int D = 1024, NB = 4, SEQ = 8192, CTXL = 256, RPB = SEQ + CTXL, G = NB * RPB;
constexpr int INW = 6816, MIXW = 3744, GATEW = 3072;
constexpr float EPS = 1e-6f;
constexpr float LOG2E = 1.4426950408889634f;
constexpr int PMAX = 75776;
constexpr int NTILE = PMAX / 256;

__device__ __forceinline__ float bf2f(bf16_t v) { return __uint_as_float(((unsigned)v) << 16); }
__device__ __forceinline__ bf16_t f2bf(float f) { unsigned u = __float_as_uint(f); u += 0x7fffu + ((u >> 16) & 1u); return (bf16_t)(u >> 16); }
typedef float f32x2v __attribute__((ext_vector_type(2)));
typedef __bf16 bf16x2v __attribute__((ext_vector_type(2)));
__device__ __forceinline__ unsigned pkbf(float lo, float hi) { const f32x2v v = {lo, hi}; const bf16x2v b = __builtin_convertvector(v, bf16x2v); return __builtin_bit_cast(unsigned, b); }
__device__ __forceinline__ unsigned pk2(float lo, float hi) { return (unsigned)f2bf(lo) | ((unsigned)f2bf(hi) << 16); }
__device__ __forceinline__ float silu_f(float v) { return v / (1.f + expf(-v)); }
__device__ __forceinline__ float sigmoid_f(float v) { return 1.f / (1.f + expf(-v)); }
__device__ __forceinline__ int opaque_tid() { int t = threadIdx.x; asm volatile("" : "+v"(t)); return t; }
struct RowInfo { int b, r; bool lat; };
__device__ __forceinline__ RowInfo rowinfo(int g) { RowInfo ri; ri.b = g / RPB; ri.r = g - ri.b * RPB; ri.lat = ri.r < SEQ; return ri; }
__device__ __forceinline__ size_t xoff(const RowInfo& ri) { return ri.lat ? ((size_t)ri.b * SEQ + ri.r) * D : ((size_t)ri.b * CTXL + (ri.r - SEQ)) * D; }
__device__ __forceinline__ int crow(int r, int hi) { return (r & 3) + 8 * (r >> 2) + 4 * hi; }
__device__ __forceinline__ unsigned cvtpk(float lo, float hi) { return pkbf(lo, hi); }
typedef short v4i16_t __attribute__((ext_vector_type(4)));
__device__ __forceinline__ s16x4 vtr(const LAS char* p) { return __builtin_bit_cast(s16x4, __builtin_amdgcn_ds_read_tr16_b64_v4i16((LAS v4i16_t*)p)); }
#define MFMA32(a, b, c) __builtin_amdgcn_mfma_f32_32x32x16_bf16(a, b, c, 0, 0, 0)

struct AttnArgs { const bf16_t* Q; int qld, qhs; const bf16_t* K1; int k1ld, k1hs, kvgroup; const bf16_t* K2; int k2ld; const bf16_t* V; int vld, vhs;
                  bf16_t* O; int old, ohs; float scale_l2; const float* sink; int window; int pad; };
template <int DQK>
__device__ __forceinline__ void attn_unit(LAS char* lds, const AttnArgs& p, int b, int qb, int h) {
    constexpr int NS = DQK / 16, NCH = DQK / 8;
    const int tid = opaque_tid(), lane = tid & 63, r32 = lane & 31, hi = lane >> 5, wid = tid >> 6;
    const int rb = b * RPB;
    const bool ctxq = (qb == 32);
    const int q0 = rb + (ctxq ? SEQ : qb * 256); const int oq0 = rb + (ctxq ? SEQ : qb * 256);
    int lat_k0 = 0, lat_k1 = 0;
    if (!ctxq) { if (p.window) { lat_k0 = qb * 256 - 128; if (lat_k0 < 0) lat_k0 = 0; lat_k1 = qb * 256 + 384; if (lat_k1 > SEQ) lat_k1 = SEQ; } else { lat_k0 = 0; lat_k1 = SEQ; } }
    const int ntiles = 4 + (lat_k1 - lat_k0) / 64;
    const int qrow = q0 + wid * 32 + r32;
    const int qpos = qb * 256 + wid * 32 + r32;
    LAS char* ldsK = (LAS char*)lds; LAS char* ldsV = (LAS char*)lds + 12288; LAS float* wsf = (LAS float*)((LAS char*)lds + 20480) + wid * 64;
    bf16x8 qr[NS];
#pragma unroll
    for (int s = 0; s < NS; ++s) qr[s] = *(const bf16x8*)(p.Q + (size_t)qrow * p.qld + h * p.qhs + 16 * s + 8 * hi);
    const int k1off = (h / p.kvgroup) * p.k1hs, voff = (h / p.kvgroup) * p.vhs;
    f32x16 o0, o1;
#pragma unroll
    for (int r = 0; r < 16; ++r) { o0[r] = 0.f; o1[r] = 0.f; }
    float m = -1e30f, l = 0.f;
    const LAS char* vbase = ldsV + ((lane >> 4) & 1) * 32 + (lane & 3) * 8 + (4 * hi + ((lane & 15) >> 2)) * 64;
    for (int it = 0; it < ntiles; ++it) {
        const bool lat = it >= 4;
        const int kpos0 = lat ? lat_k0 + 64 * (it - 4) : 0;
        const int krow0 = rb + (lat ? kpos0 : SEQ + 64 * it);
        __syncthreads();
        for (int pc = tid; pc < NCH * 64; pc += 512) { const int c = pc >> 6, row = pc & 63;
            const bf16_t* src = (c < 8) ? p.K1 + (size_t)(krow0 + row) * p.k1ld + k1off + c * 8 : p.K2 + (size_t)(krow0 + row) * p.k2ld + (c - 8) * 8;
            *(LAS u32x4*)(ldsK + c * 1024 + row * 16) = *(const u32x4*)src; }
        { const int dh = tid >> 8, row = (tid & 255) >> 2, pp = tid & 3;
          *(LAS u32x4*)(ldsV + dh * 4096 + row * 64 + pp * 16) = *(const u32x4*)(p.V + (size_t)(krow0 + row) * p.vld + voff + dh * 32 + pp * 8); }
        __syncthreads();
        f32x16 c0, c1;
#pragma unroll
        for (int r = 0; r < 16; ++r) { c0[r] = 0.f; c1[r] = 0.f; }
#pragma unroll
        for (int s = 0; s < NS; ++s) {
            const bf16x8 k0 = *(const LAS bf16x8*)(ldsK + (2 * s + hi) * 1024 + r32 * 16);
            const bf16x8 k1 = *(const LAS bf16x8*)(ldsK + (2 * s + hi) * 1024 + 512 + r32 * 16);
            c0 = MFMA32(k0, qr[s], c0); c1 = MFMA32(k1, qr[s], c1);
        }
        float mx = -1e30f;
#pragma unroll
        for (int r = 0; r < 16; ++r) {
            float s0 = c0[r] * p.scale_l2, s1 = c1[r] * p.scale_l2;
            if (lat && p.window) { const int kp = kpos0 + crow(r, hi); int d0 = qpos - kp; if (d0 < 0) d0 = -d0; int d1 = qpos - (kp + 32); if (d1 < 0) d1 = -d1;
                if (d0 > p.window) s0 = -1e30f; if (d1 > p.window) s1 = -1e30f; }
            c0[r] = s0; c1[r] = s1; mx = fmaxf(mx, fmaxf(s0, s1));
        }
        mx = fmaxf(mx, __shfl_xor(mx, 32));
        const float mn = fmaxf(m, mx); const float alpha = __builtin_amdgcn_exp2f(m - mn); m = mn;
        float rs = 0.f;
#pragma unroll
        for (int r = 0; r < 16; ++r) { c0[r] = __builtin_amdgcn_exp2f(c0[r] - m); c1[r] = __builtin_amdgcn_exp2f(c1[r] - m); rs += c0[r] + c1[r]; }
        l = l * alpha + rs;
        if (__any(alpha != 1.f)) {
            if (hi == 0) wsf[r32] = alpha;
#pragma unroll
            for (int r = 0; r < 16; ++r) { const float f = wsf[crow(r, hi)]; o0[r] *= f; o1[r] *= f; }
        }
        u32x4 pw[4];
        pw[0] = (u32x4){cvtpk(c0[0], c0[1]), cvtpk(c0[2], c0[3]), cvtpk(c0[4], c0[5]), cvtpk(c0[6], c0[7])};
        pw[1] = (u32x4){cvtpk(c0[8], c0[9]), cvtpk(c0[10], c0[11]), cvtpk(c0[12], c0[13]), cvtpk(c0[14], c0[15])};
        pw[2] = (u32x4){cvtpk(c1[0], c1[1]), cvtpk(c1[2], c1[3]), cvtpk(c1[4], c1[5]), cvtpk(c1[6], c1[7])};
        pw[3] = (u32x4){cvtpk(c1[8], c1[9]), cvtpk(c1[10], c1[11]), cvtpk(c1[12], c1[13]), cvtpk(c1[14], c1[15])};
#pragma unroll
        for (int s = 0; s < 4; ++s) {
            const s16x4 a0 = vtr(vbase + s * 1024), a1 = vtr(vbase + s * 1024 + 512);
            const s16x4 b0 = vtr(vbase + 4096 + s * 1024), b1 = vtr(vbase + 4096 + s * 1024 + 512);
            const bf16x8 v0 = (bf16x8){a0[0], a0[1], a0[2], a0[3], a1[0], a1[1], a1[2], a1[3]};
            const bf16x8 v1 = (bf16x8){b0[0], b0[1], b0[2], b0[3], b1[0], b1[1], b1[2], b1[3]};
            const bf16x8 pa = __builtin_bit_cast(bf16x8, pw[s]);
            o0 = MFMA32(pa, v0, o0); o1 = MFMA32(pa, v1, o1);
        }
    }
    float lt = l + __shfl_xor(l, 32);
    float fin = 1.f;
    if (p.sink) { const float sk = p.sink[h] * LOG2E; const float m2 = fmaxf(m, sk); fin = __builtin_amdgcn_exp2f(m - m2); lt = lt * fin + __builtin_amdgcn_exp2f(sk - m2); }
    const float sc = fin / lt;
    if (hi == 0) wsf[r32] = sc;
    bf16_t* Ob = p.O + (size_t)(oq0 + wid * 32) * p.old + h * p.ohs + r32;
#pragma unroll
    for (int r = 0; r < 16; ++r) { const int qr_ = crow(r, hi); const float f = wsf[qr_];
        Ob[(size_t)qr_ * p.old] = f2bf(o0[r] * f); Ob[(size_t)qr_ * p.old + 32] = f2bf(o1[r] * f); }
}
namespace gp {
constexpr int BM = 256, BK = 64, HALF = 128, HTB = HALF * BK * 2, STAGE_BYTES = 8 * HTB, NXCD = 8, WGM = 8;
__host__ __device__ __forceinline__ int lds_byte(int r, int c) { const int st = (r >> 4) * 2 + (c >> 5), rr = r & 15, cc = c & 31, ob = rr * 64 + cc * 2; return st * 1024 + (ob ^ (((ob >> 9) & 1) << 5)); }
__host__ __device__ __forceinline__ void stage_rc(int b, int& R, int& C) { const int st = b / 1024, sb = b % 1024, swz = sb ^ (((sb >> 9) & 1) << 5); R = (st >> 1) * 16 + swz / 64; C = (st & 1) * 32 + (swz % 64) / 2; }
__host__ __device__ __forceinline__ int perm32(int rho) { const int n = rho >> 4, i = rho & 15; return 8 * (i >> 2) + 4 * n + (i & 3); }

struct GUnit { const char* A; const char* B; int nt, pm, pn, tag; const unsigned* goff; };

__device__ __forceinline__ bool tile_order(int i, int G_, int c, int nM, int nN, int& pm, int& pn) {
    const int nwg = nM * nN; const long L = (long)i * G_ + c; if (L >= nwg) return false;
    int wgid = (int)L; { const int q = nwg / NXCD, r = nwg % NXCD, xcd = wgid % NXCD, off = wgid / NXCD; wgid = (xcd < r ? xcd * (q + 1) : r * (q + 1) + (xcd - r) * q) + off; }
    const int nig = WGM * nN, gid = wgid / nig, fm = gid * WGM, gsz = (nM - fm) < WGM ? (nM - fm) : WGM;
    pm = fm + ((wgid % nig) % gsz); pn = (wgid % nig) / gsz; return true;
}
__device__ __forceinline__ unsigned cvt_pk_bf16(float lo, float hi) { return pkbf(lo, hi); }

template <class Epi, class Sched>
__device__ __forceinline__ void gemm_phase(LAS unsigned char* lds, const Sched& S, const Epi& E) {
    constexpr bool GATHER = Sched::GATHER;
    const int tid = opaque_tid(), wid = __builtin_amdgcn_readfirstlane(tid >> 6), lane = tid & 63, wr = wid >> 2, wc = wid & 3, fr = lane & 15, fq = lane >> 4;
    const int lda2 = S.lda2, ldb2 = S.ldb2;
    unsigned voffA[2], voffB[2], rowA[2];
#pragma unroll
    for (int i = 0; i < 2; ++i) { int R, C; stage_rc(tid * 16 + i * 8192, R, C); const int Rb = Epi::PERM ? ((R & ~31) + perm32(R & 31)) : R;
        voffA[i] = GATHER ? (unsigned)C * 2u : (unsigned)R * (unsigned)lda2 + (unsigned)C * 2u; rowA[i] = (unsigned)R; voffB[i] = (unsigned)Rb * (unsigned)ldb2 + (unsigned)C * 2u; }
    const size_t hA = GATHER ? 0 : (size_t)HALF * lda2, hB = (size_t)HALF * ldb2;
    const unsigned ldsw = (unsigned)wid * 1024u;
    const int aoff = lds_byte(wr * 64 + fr, fq * 8), boff = lds_byte(wc * 32 + fr, fq * 8);
    constexpr size_t kstep = (size_t)(BK * 2);
#define GP_SA(b, h) (((b) * 2 + (h)) * HTB)
#define GP_SB(b, h) ((4 + (b) * 2 + (h)) * HTB)
#define GP_STAGE(bufoff, gbase, v0, v1) do { \
        __builtin_amdgcn_global_load_lds((const unsigned*)((const char*)(gbase) + (v0)), (LAS unsigned*)(lds + (bufoff) + ldsw), 16, 0, 0); \
        __builtin_amdgcn_global_load_lds((const unsigned*)((const char*)(gbase) + (v1)), (LAS unsigned*)(lds + (bufoff) + ldsw + 8192), 16, 0, 0); } while (0)
#define GP_LDA(dst, b, h) do { _Pragma("unroll") for (int m = 0; m < 4; ++m) _Pragma("unroll") for (int k = 0; k < 2; ++k) dst[m][k] = *(const LAS bf16x8*)(lds + GP_SA(b, h) + aoff + m * 2048 + k * 1024); } while (0)
#define GP_LDB(dst, b, h) do { _Pragma("unroll") for (int n = 0; n < 2; ++n) _Pragma("unroll") for (int k = 0; k < 2; ++k) dst[n][k] = *(const LAS bf16x8*)(lds + GP_SB(b, h) + boff + n * 2048 + k * 1024); } while (0)
#define GP_MMA(ai, bj, At, Bt) do { __builtin_amdgcn_s_setprio(1); _Pragma("unroll") for (int m = 0; m < 4; ++m) _Pragma("unroll") for (int n = 0; n < 2; ++n) _Pragma("unroll") for (int k = 0; k < 2; ++k) \
        acc[ai][bj][m][n] = __builtin_amdgcn_mfma_f32_16x16x32_bf16(Bt[n][k], At[m][k], acc[ai][bj][m][n], 0, 0, 0); __builtin_amdgcn_s_setprio(0); } while (0)
#define GP_WAIT_V(n) asm volatile("s_waitcnt vmcnt(" #n ")" ::: "memory")
#define GP_WAIT_L(n) asm volatile("s_waitcnt lgkmcnt(" #n ")" ::: "memory")
#define GP_BAR __builtin_amdgcn_s_barrier()
#define GP_SCHED __builtin_amdgcn_sched_barrier(0)
#define GP_GOFF(U, o0, o1, p0, p1) do { if (GATHER) { o0 = (U).goff[rowA[0]] + voffA[0]; o1 = (U).goff[rowA[1]] + voffA[1]; p0 = (U).goff[128 + rowA[0]] + voffA[0]; p1 = (U).goff[128 + rowA[1]] + voffA[1]; } \
        else { o0 = voffA[0]; o1 = voffA[1]; p0 = voffA[0]; p1 = voffA[1]; } } while (0)
    GUnit cur, nxt; int ui = 0;
    if (!S.next(0, cur)) return;
    f32x4 acc[2][2][4][2];
#pragma unroll
    for (int a = 0; a < 2; ++a)
#pragma unroll
        for (int b = 0; b < 2; ++b)
#pragma unroll
            for (int m = 0; m < 4; ++m)
#pragma unroll
                for (int n = 0; n < 2; ++n) acc[a][b][m][n] = (f32x4){0.f, 0.f, 0.f, 0.f};
    bf16x8 At[4][2], B0[2][2], B1[2][2];
    unsigned g00, g01, g10, g11;
    GP_GOFF(cur, g00, g01, g10, g11);
    const char* cA = cur.A; const char* cB = cur.B;
    GP_STAGE(GP_SB(0, 0), cB, voffB[0], voffB[1]); GP_STAGE(GP_SA(0, 0), cA, g00, g01); GP_STAGE(GP_SB(0, 1), cB + hB, voffB[0], voffB[1]); GP_STAGE(GP_SA(0, 1), cA + hA, g10, g11);
    if (wr == 1) GP_BAR;
    GP_WAIT_V(4); GP_BAR;
    GP_STAGE(GP_SB(1, 0), cB + kstep, voffB[0], voffB[1]); GP_STAGE(GP_SA(1, 0), cA + kstep, g00, g01); GP_STAGE(GP_SB(1, 1), cB + hB + kstep, voffB[0], voffB[1]);
    GP_WAIT_V(6); GP_BAR;
    for (;;) {
        const bool has_next = S.next(ui + 1, nxt);
        const char* nA = has_next ? nxt.A : cA; const char* nB = has_next ? nxt.B : cB;
        const int nt = cur.nt;
        for (int t = 0; t < nt; t += 2) {
            const bool last = (t == nt - 2);
            const char* a1 = cA + (size_t)(t + 1) * kstep;
            const char* a2 = last ? nA : cA + (size_t)(t + 2) * kstep; const char* b2 = last ? nB : cB + (size_t)(t + 2) * kstep;
            const char* a3 = a2 + kstep; const char* b3 = b2 + kstep;
            unsigned w00 = g00, w01 = g01, w10 = g10, w11 = g11;
            if (GATHER && last && has_next) { GP_GOFF(nxt, w00, w01, w10, w11); }
            GP_LDB(B0, 0, 0); GP_SCHED; GP_LDA(At, 0, 0); GP_STAGE(GP_SA(1, 1), a1 + hA, g10, g11);
            GP_WAIT_L(8); GP_BAR; GP_WAIT_L(0); GP_MMA(0, 0, At, B0); GP_BAR; GP_SCHED;
            GP_LDB(B1, 0, 1); GP_STAGE(GP_SB(0, 0), b2, voffB[0], voffB[1]);
            GP_BAR; GP_WAIT_L(0); GP_MMA(0, 1, At, B1); GP_BAR;
            GP_LDA(At, 0, 1); GP_STAGE(GP_SA(0, 0), a2, w00, w01);
            GP_BAR; GP_WAIT_L(0); GP_MMA(1, 0, At, B0); GP_BAR; GP_SCHED;
            GP_STAGE(GP_SB(0, 1), b2 + hB, voffB[0], voffB[1]);
            GP_WAIT_V(6); GP_BAR; GP_MMA(1, 1, At, B1); GP_BAR;
            GP_LDB(B0, 1, 0); GP_SCHED; GP_LDA(At, 1, 0); GP_STAGE(GP_SA(0, 1), a2 + hA, w10, w11);
            GP_WAIT_L(8); GP_BAR; GP_WAIT_L(0); GP_MMA(0, 0, At, B0); GP_BAR; GP_SCHED;
            GP_LDB(B1, 1, 1); GP_STAGE(GP_SB(1, 0), b3, voffB[0], voffB[1]);
            GP_BAR; GP_WAIT_L(0); GP_MMA(0, 1, At, B1); GP_BAR;
            GP_LDA(At, 1, 1); GP_STAGE(GP_SA(1, 0), a3, w00, w01);
            GP_BAR; GP_WAIT_L(0); GP_MMA(1, 0, At, B0); GP_BAR; GP_SCHED;
            GP_STAGE(GP_SB(1, 1), b3 + hB, voffB[0], voffB[1]);
            GP_WAIT_V(6); GP_BAR; GP_MMA(1, 1, At, B1); GP_BAR;
            if (GATHER && last) { g00 = w00; g01 = w01; g10 = w10; g11 = w11; }
        }
        { int fr_e = fr, fq_e = fq; asm volatile("" : "+v"(fr_e), "+v"(fq_e));
          E(acc, cur, wr, wc, fr_e, fq_e); }
        if (!has_next) break;
#pragma unroll
        for (int a = 0; a < 2; ++a)
#pragma unroll
            for (int b = 0; b < 2; ++b)
#pragma unroll
                for (int m = 0; m < 4; ++m)
#pragma unroll
                    for (int n = 0; n < 2; ++n) acc[a][b][m][n] = (f32x4){0.f, 0.f, 0.f, 0.f};
        cur = nxt; cA = nA; cB = nB; ++ui;
    }
    GP_WAIT_V(0);
    if (wr == 0) GP_BAR;
    GP_BAR;
#undef GP_SA
#undef GP_SB
#undef GP_STAGE
#undef GP_LDA
#undef GP_LDB
#undef GP_MMA
#undef GP_WAIT_V
#undef GP_WAIT_L
#undef GP_BAR
#undef GP_SCHED
#undef GP_GOFF
}
}

struct SchedStd {
    static constexpr bool GATHER = false;
    const bf16_t* A; const bf16_t* Bt; int K, nM, nN, G_, c, skipctx, lda2, ldb2;
    __device__ __forceinline__ bool next(int i, gp::GUnit& u) const {
        int pmv, pn; if (!gp::tile_order(i, G_, c, nM, nN, pmv, pn)) return false;
        const int pm = skipctx ? pmv + pmv / 32 : pmv;
        u.A = (const char*)(A + (size_t)pm * 256 * K); u.B = (const char*)(Bt + (size_t)pn * 256 * K); u.nt = K / 64; u.pm = pm; u.pn = pn; u.tag = 0; u.goff = nullptr; return true;
    }
};

__device__ __forceinline__ float fexp(float x) { return __builtin_amdgcn_exp2f(x * LOG2E); }
__device__ __forceinline__ float flog(float x) { return __builtin_amdgcn_logf(x) * 0.6931471805599453f; }
__device__ __forceinline__ float fsigmoid(float x) { return __builtin_amdgcn_rcpf(1.f + fexp(-x)); }
__device__ __forceinline__ float logf_gate_fast(float z, float lb) {
    if (lb <= 0.f) return fminf(z, 0.f) - flog(1.f + fexp(-fabsf(z)));
    return flog(lb + (1.f - lb) * fsigmoid(z));
}
__device__ __forceinline__ unsigned pkh2(float lo, float hi) { const f16_t a = (f16_t)lo, b = (f16_t)hi; return (unsigned)__builtin_bit_cast(unsigned short, a) | ((unsigned)__builtin_bit_cast(unsigned short, b) << 16); }

template <class T> __device__ __forceinline__ T* opq(T* p) { asm volatile("" : "+s"(p)); return p; }
struct EpiG1 {
    static constexpr bool PERM = true;
    bf16_t *AQ, *AK, *AV, *BQ, *BV, *BG; f16_t *BLF, *BLB; bf16_t *CQKV, *CKR; float* RS; const float *ropa_c, *ropa_s, *ropc_c, *ropc_s; const float* LBl; int rowoff;
    __device__ __forceinline__ void operator()(const f32x4 (&acc)[2][2][4][2], const gp::GUnit& u, int wr, int wc, int fr, int fq) const {
        const int pn = u.pn; const int pr = u.pm % 33; const bool lat = pr < 32;
        const int grow0 = u.pm * 256 + wr * 64 + fr; const int t0 = pr * 256 + wr * 64 + fr;
        if (pn < 3) {
            const int hh = pn * 4 + wc; bf16_t* dst; int ld, coff; bf16_t* const aq_ = opq(AQ); bf16_t* const ak_ = opq(AK); bf16_t* const av_ = opq(AV);
            if (hh < 8) { dst = aq_; ld = 512; coff = hh * 64; } else if (hh < 10) { dst = ak_; ld = 128; coff = (hh - 8) * 64; } else { dst = av_; ld = 128; coff = (hh - 10) * 64; }
            const bool rope = lat && hh < 10;
#pragma unroll
            for (int ai = 0; ai < 2; ++ai)
#pragma unroll
                for (int m = 0; m < 4; ++m) { const int grow = grow0 + ai * 128 + m * 16, t = t0 + ai * 128 + m * 16; const size_t row = (size_t)(grow - rowoff);
                    f32x4 x1a = acc[ai][0][m][0], x1b = acc[ai][0][m][1], x2a = acc[ai][1][m][0], x2b = acc[ai][1][m][1];
                    if (rope) { const f32x4 ca = *(const f32x4*)(ropa_c + t * 32 + 8 * fq), cb = *(const f32x4*)(ropa_c + t * 32 + 8 * fq + 4), sa = *(const f32x4*)(ropa_s + t * 32 + 8 * fq), sb = *(const f32x4*)(ropa_s + t * 32 + 8 * fq + 4);
                        const f32x4 o1a = x1a * ca - x2a * sa, o2a = x1a * sa + x2a * ca, o1b = x1b * cb - x2b * sb, o2b = x1b * sb + x2b * cb; x1a = o1a; x2a = o2a; x1b = o1b; x2b = o2b; }
                    bf16_t* p = dst + row * ld + coff + 8 * fq;
                    u32x4 w1, w2; w1.x = gp::cvt_pk_bf16(x1a[0], x1a[1]); w1.y = gp::cvt_pk_bf16(x1a[2], x1a[3]); w1.z = gp::cvt_pk_bf16(x1b[0], x1b[1]); w1.w = gp::cvt_pk_bf16(x1b[2], x1b[3]);
                    w2.x = gp::cvt_pk_bf16(x2a[0], x2a[1]); w2.y = gp::cvt_pk_bf16(x2a[2], x2a[3]); w2.z = gp::cvt_pk_bf16(x2b[0], x2b[1]); w2.w = gp::cvt_pk_bf16(x2b[2], x2b[3]);
                    *(u32x4*)p = w1; *(u32x4*)(p + 32) = w2; asm volatile("" ::: "memory"); }
        } else if (pn < 13) {
            const int q = pn - 3, which = q >> 1; const int cb0 = (q & 1) * 256 + wc * 32 + 8 * fq;
            if (which == 2 || which == 3) {
                f16_t* const blf_ = opq(BLF); f16_t* const blb_ = opq(BLB); f16_t* dst = which == 2 ? blf_ : blb_; const float* lbp = LBl + (which == 2 ? 0 : 512);
#pragma unroll
                for (int bj = 0; bj < 2; ++bj) { const int c0 = cb0 + bj * 128; const f32x4 la = *(const f32x4*)(lbp + c0), lb4 = *(const f32x4*)(lbp + c0 + 4);
#pragma unroll
                    for (int ai = 0; ai < 2; ++ai)
#pragma unroll
                        for (int m = 0; m < 4; ++m) { const size_t row = (size_t)(grow0 + ai * 128 + m * 16 - rowoff); const f32x4 v0 = acc[ai][bj][m][0], v1 = acc[ai][bj][m][1];
                            u32x4 w; w.x = pkh2(logf_gate_fast(v0[0], la[0]), logf_gate_fast(v0[1], la[1])); w.y = pkh2(logf_gate_fast(v0[2], la[2]), logf_gate_fast(v0[3], la[3]));
                            w.z = pkh2(logf_gate_fast(v1[0], lb4[0]), logf_gate_fast(v1[1], lb4[1])); w.w = pkh2(logf_gate_fast(v1[2], lb4[2]), logf_gate_fast(v1[3], lb4[3]));
                            *(u32x4*)(dst + row * 512 + c0) = w; } }
            } else {
                bf16_t* const bq_ = opq(BQ); bf16_t* const bv_ = opq(BV); bf16_t* const bg_ = opq(BG); bf16_t* dst = which == 0 ? bq_ : (which == 1 ? bv_ : bg_);
#pragma unroll
                for (int ai = 0; ai < 2; ++ai)
#pragma unroll
                    for (int m = 0; m < 4; ++m) { const size_t row = (size_t)(grow0 + ai * 128 + m * 16 - rowoff);
#pragma unroll
                        for (int bj = 0; bj < 2; ++bj) { const f32x4 v0 = acc[ai][bj][m][0], v1 = acc[ai][bj][m][1];
                            u32x4 w; w.x = gp::cvt_pk_bf16(v0[0], v0[1]); w.y = gp::cvt_pk_bf16(v0[2], v0[3]); w.z = gp::cvt_pk_bf16(v1[0], v1[1]); w.w = gp::cvt_pk_bf16(v1[2], v1[3]);
                            *(u32x4*)(dst + row * 512 + cb0 + bj * 128) = w; } }
            }
        } else if (pn == 13) {
#pragma unroll
            for (int ai = 0; ai < 2; ++ai)
#pragma unroll
                for (int m = 0; m < 4; ++m) { const int grow = grow0 + ai * 128 + m * 16; const size_t row = (size_t)(grow - rowoff); float ss = 0.f;
#pragma unroll
                    for (int bj = 0; bj < 2; ++bj) { const f32x4 v0 = acc[ai][bj][m][0], v1 = acc[ai][bj][m][1];
                        ss += v0[0] * v0[0] + v0[1] * v0[1] + v0[2] * v0[2] + v0[3] * v0[3] + v1[0] * v1[0] + v1[1] * v1[1] + v1[2] * v1[2] + v1[3] * v1[3];
                        u32x4 w; w.x = gp::cvt_pk_bf16(v0[0], v0[1]); w.y = gp::cvt_pk_bf16(v0[2], v0[3]); w.z = gp::cvt_pk_bf16(v1[0], v1[1]); w.w = gp::cvt_pk_bf16(v1[2], v1[3]);
                        *(u32x4*)(CQKV + row * 384 + bj * 128 + wc * 32 + 8 * fq) = w; }
                    ss += __shfl_xor(ss, 16); ss += __shfl_xor(ss, 32);
                    if (fq == 0) RS[(size_t)grow * 8 + wc] = ss; }
        } else {
#pragma unroll
            for (int ai = 0; ai < 2; ++ai)
#pragma unroll
                for (int m = 0; m < 4; ++m) { const int grow = grow0 + ai * 128 + m * 16, t = t0 + ai * 128 + m * 16; const size_t row = (size_t)(grow - rowoff);
                    const f32x4 v0 = acc[ai][0][m][0], v1 = acc[ai][0][m][1];
                    float ss = v0[0] * v0[0] + v0[1] * v0[1] + v0[2] * v0[2] + v0[3] * v0[3] + v1[0] * v1[0] + v1[1] * v1[1] + v1[2] * v1[2] + v1[3] * v1[3];
                    u32x4 w; w.x = gp::cvt_pk_bf16(v0[0], v0[1]); w.y = gp::cvt_pk_bf16(v0[2], v0[3]); w.z = gp::cvt_pk_bf16(v1[0], v1[1]); w.w = gp::cvt_pk_bf16(v1[2], v1[3]);
                    *(u32x4*)(CQKV + row * 384 + 256 + wc * 32 + 8 * fq) = w;
                    ss += __shfl_xor(ss, 16); ss += __shfl_xor(ss, 32);
                    if (fq == 0) RS[(size_t)grow * 8 + 4 + wc] = ss;
                    if (wc == 0) { f32x4 x1 = acc[ai][1][m][0], x2 = acc[ai][1][m][1];
                        if (lat) { const f32x4 cc = *(const f32x4*)(ropc_c + t * 16 + 4 * fq), sn = *(const f32x4*)(ropc_s + t * 16 + 4 * fq); const f32x4 o1 = x1 * cc - x2 * sn, o2 = x1 * sn + x2 * cc; x1 = o1; x2 = o2; }
                        *(uint2*)(CKR + row * 32 + 4 * fq) = make_uint2(gp::cvt_pk_bf16(x1[0], x1[1]), gp::cvt_pk_bf16(x1[2], x1[3]));
                        *(uint2*)(CKR + row * 32 + 16 + 4 * fq) = make_uint2(gp::cvt_pk_bf16(x2[0], x2[1]), gp::cvt_pk_bf16(x2[2], x2[3])); } }
        }
    }
};

struct EpiC {
    static constexpr bool PERM = true;
    bf16_t *CQ, *CKV; const float* RS; const float *ropc_c, *ropc_s; int pmoff;
    __device__ __forceinline__ void operator()(const f32x4 (&acc)[2][2][4][2], const gp::GUnit& u, int wr, int wc, int fr, int fq) const {
        const int pn = u.pn; const int pr = (u.pm + pmoff) % 33; const bool lat = pr < 32;
        const int grow0 = u.pm * 256 + wr * 64 + fr; const int t0 = pr * 256 + wr * 64 + fr;
#pragma unroll
        for (int ai = 0; ai < 2; ++ai)
#pragma unroll
            for (int m = 0; m < 4; ++m) { const size_t row = (size_t)(grow0 + ai * 128 + m * 16); const int t = t0 + ai * 128 + m * 16;
                if (pn < 3) { const f32x4 p4 = *(const f32x4*)(RS + row * 8); const float rq = rsqrtf(((p4[0] + p4[1]) + (p4[2] + p4[3])) * (1.f / 256.f) + EPS);
#pragma unroll
                    for (int bj = 0; bj < 2; ++bj) { const int gi = pn * 8 + bj * 4 + wc, head = gi / 3, part = gi - head * 3;
                        f32x4 v0 = acc[ai][bj][m][0] * rq, v1 = acc[ai][bj][m][1] * rq;
                        bf16_t* p = CQ + row * 768 + head * 96;
                        if (part < 2) { u32x4 w; w.x = gp::cvt_pk_bf16(v0[0], v0[1]); w.y = gp::cvt_pk_bf16(v0[2], v0[3]); w.z = gp::cvt_pk_bf16(v1[0], v1[1]); w.w = gp::cvt_pk_bf16(v1[2], v1[3]);
                            *(u32x4*)(p + part * 32 + 8 * fq) = w; }
                        else { if (lat) { const f32x4 cc = *(const f32x4*)(ropc_c + t * 16 + 4 * fq), sn = *(const f32x4*)(ropc_s + t * 16 + 4 * fq); const f32x4 o1 = v0 * cc - v1 * sn, o2 = v0 * sn + v1 * cc; v0 = o1; v1 = o2; }
                            *(uint2*)(p + 64 + 4 * fq) = make_uint2(gp::cvt_pk_bf16(v0[0], v0[1]), gp::cvt_pk_bf16(v0[2], v0[3]));
                            *(uint2*)(p + 80 + 4 * fq) = make_uint2(gp::cvt_pk_bf16(v1[0], v1[1]), gp::cvt_pk_bf16(v1[2], v1[3])); } }
                } else { const f32x4 p4 = *(const f32x4*)(RS + row * 8 + 4); const float rkv = rsqrtf(((p4[0] + p4[1]) + (p4[2] + p4[3])) * (1.f / 128.f) + EPS);
#pragma unroll
                    for (int bj = 0; bj < 2; ++bj) { const f32x4 v0 = acc[ai][bj][m][0] * rkv, v1 = acc[ai][bj][m][1] * rkv;
                        u32x4 w; w.x = gp::cvt_pk_bf16(v0[0], v0[1]); w.y = gp::cvt_pk_bf16(v0[2], v0[3]); w.z = gp::cvt_pk_bf16(v1[0], v1[1]); w.w = gp::cvt_pk_bf16(v1[2], v1[3]);
                        *(u32x4*)(CKV + row * 1024 + (pn - 3) * 256 + bj * 128 + wc * 32 + 8 * fq) = w; } }
                asm volatile("" ::: "memory"); }
    }
};
struct EpiGate {
    static constexpr bool PERM = true;
    bf16_t* GATE; long nstride; int ld;
    __device__ __forceinline__ void operator()(const f32x4 (&acc)[2][2][4][2], const gp::GUnit& u, int wr, int wc, int fr, int fq) const {
        const int n3 = u.pn >> 2; bf16_t* base = GATE + (size_t)n3 * nstride + (u.pn & 3) * 256 + wc * 32 + 8 * fq; const int row0 = u.pm * 256 + wr * 64 + fr;
#pragma unroll
        for (int ai = 0; ai < 2; ++ai)
#pragma unroll
            for (int m = 0; m < 4; ++m) { bf16_t* rp = base + (size_t)(row0 + ai * 128 + m * 16) * ld;
#pragma unroll
                for (int bj = 0; bj < 2; ++bj) { const f32x4 v0 = acc[ai][bj][m][0], v1 = acc[ai][bj][m][1];
                    u32x4 w; w.x = gp::cvt_pk_bf16(fsigmoid(v0[0]), fsigmoid(v0[1])); w.y = gp::cvt_pk_bf16(fsigmoid(v0[2]), fsigmoid(v0[3])); w.z = gp::cvt_pk_bf16(fsigmoid(v1[0]), fsigmoid(v1[1])); w.w = gp::cvt_pk_bf16(fsigmoid(v1[2]), fsigmoid(v1[3]));
                    *(u32x4*)(rp + bj * 128) = w; } }
    }
};
struct SchedMerge {
    static constexpr bool GATHER = false;
    const bf16_t *A0, *A1, *A2; const bf16_t* Bt; int nM, G_, c, skipctx, lda2, ldb2;
    __device__ __forceinline__ bool next(int i, gp::GUnit& u) const {
        const int j = i / 3, n = i - 3 * j; int pmv, pn; if (!gp::tile_order(j, G_, c, nM, 4, pmv, pn)) return false;
        const int pm = skipctx ? pmv + pmv / 32 : pmv;
        const bf16_t* a0 = opq(A0); const bf16_t* a1 = opq(A1); const bf16_t* a2 = opq(A2);
        const bf16_t* a = n == 0 ? a0 : (n == 1 ? a1 : a2);
        u.A = (const char*)(a + (size_t)pm * 256 * 512); u.B = (const char*)(Bt + (size_t)n * 1024 * 512 + (size_t)pn * 256 * 512); u.nt = 8; u.pm = pm; u.pn = pn; u.tag = n; u.goff = nullptr; return true;
    }
};
__device__ __forceinline__ float bflo(unsigned w) { return __uint_as_float(w << 16); }
__device__ __forceinline__ float bfhi(unsigned w) { return __uint_as_float(w & 0xffff0000u); }
struct EpiMerge {
    static constexpr bool PERM = true;
    const bf16_t* GATE; long nstride; int ld; bf16_t* Y;
    __device__ __forceinline__ void operator()(const f32x4 (&acc)[2][2][4][2], const gp::GUnit& u, int wr, int wc, int fr, int fq) const {
        const int n3 = u.tag; const int col = u.pn * 256 + wc * 32 + 8 * fq; const bf16_t* gb = GATE + (size_t)n3 * nstride + col; const int row0 = u.pm * 256 + wr * 64 + fr;
#pragma unroll
        for (int ai = 0; ai < 2; ++ai)
#pragma unroll
            for (int m = 0; m < 4; ++m) { const size_t row = (size_t)(row0 + ai * 128 + m * 16);
#pragma unroll
                for (int bj = 0; bj < 2; ++bj) { const u32x4 g = *(const u32x4*)(gb + row * ld + bj * 128); u32x4* yp = (u32x4*)(Y + row * 1024 + col + bj * 128);
                    const f32x4 v0 = acc[ai][bj][m][0], v1 = acc[ai][bj][m][1];
                    float r[8] = {v0[0] * bflo(g.x), v0[1] * bfhi(g.x), v0[2] * bflo(g.y), v0[3] * bfhi(g.y), v1[0] * bflo(g.z), v1[1] * bfhi(g.z), v1[2] * bflo(g.w), v1[3] * bfhi(g.w)};
                    if (n3 != 0) { const u32x4 o = __builtin_nontemporal_load(yp);     r[0] += bflo(o.x); r[1] += bfhi(o.x); r[2] += bflo(o.y); r[3] += bfhi(o.y); r[4] += bflo(o.z); r[5] += bfhi(o.z); r[6] += bflo(o.w); r[7] += bfhi(o.w); }
                    u32x4 w; w.x = gp::cvt_pk_bf16(r[0], r[1]); w.y = gp::cvt_pk_bf16(r[2], r[3]); w.z = gp::cvt_pk_bf16(r[4], r[5]); w.w = gp::cvt_pk_bf16(r[6], r[7]);
                    *yp = w; }
                asm volatile("" ::: "memory"); }
    }
};
struct EpiOut {
    static constexpr bool PERM = false;
    const float *xl_src, *xc_src; float *xl_dst, *xc_dst; const float* mod; int pmoff;
    __device__ __forceinline__ void operator()(const f32x4 (&acc)[2][2][4][2], const gp::GUnit& u, int wr, int wc, int fr, int fq) const {
        const int gpm = u.pm + pmoff, b = gpm / 33, pr = gpm - b * 33; const bool lat = pr < 32;
        const float* xs = opq(lat ? xl_src : xc_src); float* xd = opq(lat ? xl_dst : xc_dst);
        const size_t rbase = lat ? ((size_t)b * SEQ + pr * 256) : ((size_t)b * CTXL);
        const float* gt = mod + (size_t)(lat ? b : 4) * 6144 + 2048; const int col0 = u.pn * 256 + wc * 32 + 4 * fq;
#pragma unroll
        for (int ai = 0; ai < 2; ++ai)
#pragma unroll
            for (int m = 0; m < 4; ++m) { const size_t off = (rbase + ai * 128 + wr * 64 + m * 16 + fr) * D + col0;
#pragma unroll
                for (int bj = 0; bj < 2; ++bj)
#pragma unroll
                    for (int n = 0; n < 2; ++n) { const int cc = bj * 128 + n * 16; const f32x4 g4 = *(const f32x4*)(gt + col0 + cc); const f32x4 xv = *(const f32x4*)(xs + off + cc);
                        *(f32x4*)(xd + off + cc) = xv + g4 * acc[ai][bj][m][n]; }
                asm volatile("" ::: "memory"); }
    }
};
template <bool GATHER_> struct SchedMoE {
    static constexpr bool GATHER = GATHER_;
    const bf16_t* A; const bf16_t* Bt; const int* tile_e; const unsigned* goff; int K, nM, nN, G_, c, lda2, ldb2; long strideB;
    __device__ __forceinline__ bool next(int i, gp::GUnit& u) const {
        int pm, pn; if (!gp::tile_order(i, G_, c, nM, nN, pm, pn)) return false;
        const int e = tile_e[pm];
        u.A = GATHER ? (const char*)A : (const char*)(A + (size_t)pm * 256 * K); u.B = (const char*)(Bt + (size_t)e * strideB + (size_t)pn * 256 * K); u.nt = K / 64; u.pm = pm; u.pn = pn; u.tag = e;
        u.goff = GATHER ? goff + (size_t)pm * 256 : nullptr; return true;
    }
};
struct EpiUp {
    static constexpr bool PERM = true;
    bf16_t* AUP;
    __device__ __forceinline__ void operator()(const f32x4 (&acc)[2][2][4][2], const gp::GUnit& u, int wr, int wc, int fr, int fq) const {
        const int row0 = u.pm * 256 + wr * 64 + fr; bf16_t* base = AUP + u.pn * 128 + wc * 32 + 8 * fq;
#pragma unroll
        for (int ai = 0; ai < 2; ++ai)
#pragma unroll
            for (int m = 0; m < 4; ++m) { const f32x4 a0 = acc[ai][0][m][0], a1 = acc[ai][0][m][1], b0 = acc[ai][1][m][0], b1 = acc[ai][1][m][1];
                float r[8];
#pragma unroll
                for (int e = 0; e < 4; ++e) { r[e] = a0[e] * fsigmoid(a0[e]) * b0[e]; r[4 + e] = a1[e] * fsigmoid(a1[e]) * b1[e]; }
                u32x4 w; w.x = gp::cvt_pk_bf16(r[0], r[1]); w.y = gp::cvt_pk_bf16(r[2], r[3]); w.z = gp::cvt_pk_bf16(r[4], r[5]); w.w = gp::cvt_pk_bf16(r[6], r[7]);
                *(u32x4*)(base + (size_t)(row0 + ai * 128 + m * 16) * 256) = w; }
    }
};
struct EpiDown {
    static constexpr bool PERM = true;
    bf16_t* YM2; const int* perm; const float* posw;
    __device__ __forceinline__ void operator()(const f32x4 (&acc)[2][2][4][2], const gp::GUnit& u, int wr, int wc, int fr, int fq) const {
        const int row0 = u.pm * 256 + wr * 64 + fr; const int col = u.pn * 256 + wc * 32 + 8 * fq;
#pragma unroll
        for (int ai = 0; ai < 2; ++ai)
#pragma unroll
            for (int m = 0; m < 4; ++m) { const int pos = row0 + ai * 128 + m * 16; const int pe = perm[pos]; const float w8 = posw[pos];
                if (pe >= 0) {
#pragma unroll
                    for (int bj = 0; bj < 2; ++bj) { const f32x4 v0 = acc[ai][bj][m][0] * w8, v1 = acc[ai][bj][m][1] * w8;
                        u32x4 w; w.x = gp::cvt_pk_bf16(v0[0], v0[1]); w.y = gp::cvt_pk_bf16(v0[2], v0[3]); w.z = gp::cvt_pk_bf16(v1[0], v1[1]); w.w = gp::cvt_pk_bf16(v1[2], v1[3]);
                        *(u32x4*)(YM2 + (size_t)pe * 1024 + col + bj * 128) = w; } } }
    }
};
enum { MAP_WIN = 1, MAP_WC = 2, MAP_WUP = 3 };
__device__ __forceinline__ int colmap(int kind, int p) {
    if (kind == MAP_WIN) {
        if (p >= 3840) return MIXW + (p - 3840);
        const int pn = p >> 8, q = p & 255, bj = q >> 7, wc = (q >> 5) & 3, j = q & 31;
        if (pn < 3) return (pn * 4 + wc) * 64 + bj * 32 + j;
        if (pn < 14) return p;
        if (bj == 0) return p;
        if (wc != 0) return -1;
        return 3712 + 16 * ((j >> 2) & 1) + 4 * (j >> 3) + (j & 3);
    }
    return p;
}
constexpr int NCHK = RPB / 64;
struct ScanArgs { const bf16_t* BQ; const bf16_t* BV; const bf16_t* BG; const f16_t* BLF; const f16_t* BLB; bf16_t* ST; float* DS; bf16_t* OB; const float* gn; int in_off; int out_off; int skipctx_out; int pad; };
#define MFMA16(a, b, c) __builtin_amdgcn_mfma_f32_16x16x32_bf16(a, b, c, 0, 0, 0)
constexpr int SC_RAW = 0, SC_VT = 32768, SC_A = SC_VT + 9216;
__device__ __forceinline__ void scan_stage(LAS char* lds, const ScanArgs& a, size_t row0, int h, int tid) {
    LAS float* RAW = (LAS float*)(lds + SC_RAW); LAS bf16_t* VT = (LAS bf16_t*)(lds + SC_VT);
    const int row = tid >> 3, c8 = (tid & 7) * 8; const size_t off = (row0 + row) * 512 + h * 64 + c8;
    typedef _Float16 h8 __attribute__((ext_vector_type(8)));
    const h8 lf = *(const h8*)(a.BLF + off), lb = *(const h8*)(a.BLB + off); const bf16x8 v = *(const bf16x8*)(a.BV + off);
#pragma unroll
    for (int j = 0; j < 8; ++j) { RAW[row * 64 + c8 + j] = (float)lf[j]; RAW[4096 + row * 64 + c8 + j] = (float)lb[j]; VT[(c8 + j) * 72 + row] = (bf16_t)v[j]; }
}
__device__ __forceinline__ void scan_cumsum(LAS char* lds, LAS float* XCH, int tid, float (&lf)[16], float (&bc)[16], float& total) {
    LAS float* RAW = (LAS float*)(lds + SC_RAW);
    const int col = tid & 127, dir = col >> 6, d = col & 63, seg = tid >> 7;
#pragma unroll
    for (int j = 0; j < 16; ++j) lf[j] = RAW[dir * 4096 + (16 * seg + j) * 64 + d];
    if (dir == 0) { float c = 0.f;
#pragma unroll
        for (int j = 0; j < 16; ++j) { c += lf[j]; bc[j] = c; } }
    else { float c = 0.f;
#pragma unroll
        for (int j = 15; j >= 0; --j) { c += lf[j]; bc[j] = c; } }
    XCH[seg * 128 + col] = dir == 0 ? bc[15] : bc[0];
    __syncthreads();
    const float t0 = XCH[col], t1 = XCH[128 + col], t2 = XCH[256 + col], t3 = XCH[384 + col];
    total = (t0 + t1) + (t2 + t3);
    float off;
    if (dir == 0) off = seg == 0 ? 0.f : (seg == 1 ? t0 : (seg == 2 ? t0 + t1 : t0 + t1 + t2));
    else off = seg == 3 ? 0.f : (seg == 2 ? t3 : (seg == 1 ? t3 + t2 : t3 + t2 + t1));
#pragma unroll
    for (int j = 0; j < 16; ++j) bc[j] += off;
}
__device__ __forceinline__ void scan_s1_unit(LAS char* lds, const ScanArgs& a, int b, int h, int k) {
    const int tid = opaque_tid(), lane = tid & 63, wid = tid >> 6;
    LAS bf16_t* VT = (LAS bf16_t*)(lds + SC_VT); LAS bf16_t* KKT = (LAS bf16_t*)(lds + SC_A); LAS float* XCH = (LAS float*)(lds + SC_A + 18432);
    const size_t row0 = (size_t)b * RPB + 64 * k - a.in_off;
    scan_stage(lds, a, row0, h, tid);
    __syncthreads();
    float lf[16], bc[16], total; scan_cumsum(lds, XCH, tid, lf, bc, total);
    const int col = tid & 127, dir = col >> 6, d = col & 63, seg = tid >> 7;
    const size_t sidx = ((size_t)((b * 8 + h) * 2 + dir)) * NCHK + k;
    { unsigned w[8];
#pragma unroll
      for (int j = 0; j < 16; j += 2) { const float k0 = (1.f - fexp(lf[j])) * fexp(total - bc[j]), k1 = (1.f - fexp(lf[j + 1])) * fexp(total - bc[j + 1]); w[j >> 1] = pkbf(k0, k1); }
      LAS u32x4* kp = (LAS u32x4*)(KKT + (dir * 64 + d) * 72 + 16 * seg); kp[0] = (u32x4){w[0], w[1], w[2], w[3]}; kp[1] = (u32x4){w[4], w[5], w[6], w[7]};
      if (seg == 0) a.DS[sidx * 64 + d] = fexp(total); }
    __syncthreads();
    { const int wdir = wid >> 2, et = wid & 3, fr = lane & 15, fq = lane >> 4;
      f32x4 acc[4];
#pragma unroll
      for (int dt = 0; dt < 4; ++dt) acc[dt] = (f32x4){0.f, 0.f, 0.f, 0.f};
#pragma unroll
      for (int ks = 0; ks < 2; ++ks) { const bf16x8 af = *(const LAS bf16x8*)(VT + (16 * et + fr) * 72 + 32 * ks + 8 * fq);
#pragma unroll
          for (int dt = 0; dt < 4; ++dt) { const bf16x8 bfv = *(const LAS bf16x8*)(KKT + (wdir * 64 + 16 * dt + fr) * 72 + 32 * ks + 8 * fq); acc[dt] = MFMA16(af, bfv, acc[dt]); } }
      bf16_t* sp = a.ST + (((size_t)((b * 8 + h) * 2 + wdir)) * NCHK + k) * 4096;
#pragma unroll
      for (int dt = 0; dt < 4; ++dt)
#pragma unroll
          for (int r = 0; r < 4; ++r) sp[(16 * et + 4 * fq + r) * 64 + 16 * dt + fr] = f2bf(acc[dt][r]); }
    __syncthreads();
}
__device__ __forceinline__ void scan_s2_task(const ScanArgs& a, int task) {
    const int chain = task >> 2, quarter = task & 3, dir = chain & 1, tid = opaque_tid();
    const int e = 16 * quarter + (tid >> 5), d = 2 * (tid & 31);
    float s0 = 0.f, s1 = 0.f;
    for (int g = 0; g < NCHK; g += 12) {
        unsigned L[12]; float2 Dv[12]; unsigned* pp[12];
#pragma unroll
        for (int j = 0; j < 12; ++j) { const int step = g + j; const int k = dir == 0 ? (step < 4 ? 128 + step : step - 4) : (step < 4 ? 131 - step : 131 - step);
            const size_t idx = (size_t)chain * NCHK + k; pp[j] = (unsigned*)(a.ST + idx * 4096 + e * 64 + d); L[j] = *pp[j]; Dv[j] = *(const float2*)(a.DS + idx * 64 + d); }
#pragma unroll
        for (int j = 0; j < 12; ++j) { *pp[j] = pkbf(s0, s1); s0 = Dv[j].x * s0 + bflo(L[j]); s1 = Dv[j].y * s1 + bfhi(L[j]); }
    }
}
__device__ __forceinline__ void scan_s3_unit(LAS char* lds, const ScanArgs& a, int b, int h, int k) {
    const int tid = opaque_tid(), lane = tid & 63, wid = tid >> 6;
    LAS float* BC = (LAS float*)(lds + SC_RAW); LAS bf16_t* VT = (LAS bf16_t*)(lds + SC_VT);
    LAS bf16_t* STL = (LAS bf16_t*)(lds + SC_A);
    LAS float* XCH = (LAS float*)(lds + SC_A + 18432);
    LAS float* OSUM = (LAS float*)(lds + SC_A + 18432 + 2048);
    LAS bf16_t* PW = (LAS bf16_t*)(lds + SC_A + 18432 + 2048 + 16384) + wid * 3456;
    const size_t row0 = (size_t)b * RPB + 64 * k - a.in_off;
    scan_stage(lds, a, row0, h, tid);
    { const int sd = tid >> 8, e = (tid & 255) >> 2, c16 = (tid & 3) * 16;
      const bf16_t* sp = a.ST + (((size_t)((b * 8 + h) * 2 + sd)) * NCHK + k) * 4096 + e * 64 + c16;
      const u32x4 s0 = *(const u32x4*)sp, s1 = *(const u32x4*)(sp + 8);
      LAS u32x4* dp = (LAS u32x4*)(STL + (sd * 64 + e) * 72 + c16); dp[0] = s0; dp[1] = s1; }
    __syncthreads();
    { float lf[16], bc[16], total; scan_cumsum(lds, XCH, tid, lf, bc, total);
      const int col = tid & 127, dir = col >> 6, d = col & 63, seg = tid >> 7;
      __syncthreads();
#pragma unroll
      for (int j = 0; j < 16; ++j) BC[dir * 4096 + (16 * seg + j) * 64 + d] = bc[j]; }
    __syncthreads();
    const int dir = wid >> 2, si = wid & 3;
    LAS bf16_t* QP = PW; LAS bf16_t* KP = PW + 1152; LAS bf16_t* ATT = PW + 2304;
    const int erow = lane >> 2, dg = (lane & 3) * 16;
    const int fr = lane & 15, fq = lane >> 4;
    LAS const float* bcd = BC + dir * 4096;
    float refv[16];
    { const int rr = dir == 0 ? 16 * si - 1 : 16 * (si + 1);
#pragma unroll
      for (int j = 0; j < 16; ++j) refv[j] = (rr >= 0 && rr < 64) ? bcd[rr * 64 + dg + j] : 0.f; }
    float qv[16], bq[16];
    { const bf16_t* qp = a.BQ + (row0 + 16 * si + erow) * 512 + h * 64 + dg; const bf16x8 q0 = *(const bf16x8*)qp, q1 = *(const bf16x8*)(qp + 8);
#pragma unroll
      for (int j = 0; j < 8; ++j) { qv[j] = bf2f((bf16_t)q0[j]); qv[8 + j] = bf2f((bf16_t)q1[j]); }
#pragma unroll
      for (int j = 0; j < 16; ++j) bq[j] = bcd[(16 * si + erow) * 64 + dg + j]; }
    { unsigned w[8];
#pragma unroll
      for (int j = 0; j < 16; j += 2) w[j >> 1] = pkbf(qv[j] * fexp(bq[j] - refv[j]), qv[j + 1] * fexp(bq[j + 1] - refv[j + 1]));
      LAS u32x4* p = (LAS u32x4*)(QP + erow * 72 + dg); p[0] = (u32x4){w[0], w[1], w[2], w[3]}; p[1] = (u32x4){w[4], w[5], w[6], w[7]};
      LAS u32x4* z = (LAS u32x4*)(ATT + erow * 72 + dg); z[0] = (u32x4){0u, 0u, 0u, 0u}; z[1] = (u32x4){0u, 0u, 0u, 0u}; }
    const int j_lo = dir == 0 ? 0 : si, j_hi = dir == 0 ? si : 3;
    for (int jb = j_lo; jb <= j_hi; ++jb) {
        { const int sg = 16 * jb + erow; const int sn = dir == 0 ? sg - 1 : sg + 1; unsigned w[8];
#pragma unroll
          for (int j = 0; j < 16; j += 2) { float kk[2];
#pragma unroll
              for (int t = 0; t < 2; ++t) { const float bs = bcd[sg * 64 + dg + j + t]; const float bn = (sn >= 0 && sn < 64) ? bcd[sn * 64 + dg + j + t] : 0.f;
                  kk[t] = (1.f - fexp(bs - bn)) * fexp(fminf(refv[j + t] - bs, 60.f)); }
              w[j >> 1] = pkbf(kk[0], kk[1]); }
          LAS u32x4* p = (LAS u32x4*)(KP + erow * 72 + dg); p[0] = (u32x4){w[0], w[1], w[2], w[3]}; p[1] = (u32x4){w[4], w[5], w[6], w[7]}; }
        __builtin_amdgcn_wave_barrier(); asm volatile("s_waitcnt lgkmcnt(0)" ::: "memory");
        f32x4 c = (f32x4){0.f, 0.f, 0.f, 0.f};
#pragma unroll
        for (int ks = 0; ks < 2; ++ks) { const bf16x8 af = *(const LAS bf16x8*)(QP + fr * 72 + 32 * ks + 8 * fq), bfv = *(const LAS bf16x8*)(KP + fr * 72 + 32 * ks + 8 * fq); c = MFMA16(af, bfv, c); }
#pragma unroll
        for (int r = 0; r < 4; ++r) { const int tq = 4 * fq + r; float v = c[r];
            if (jb == si) { if (dir == 0 ? (fr > tq) : (fr < tq)) v = 0.f; }
            ATT[tq * 72 + 16 * jb + fr] = f2bf(v); }
        __builtin_amdgcn_wave_barrier(); asm volatile("s_waitcnt lgkmcnt(0)" ::: "memory");
    }
    { unsigned w[8];
#pragma unroll
      for (int j = 0; j < 16; j += 2) w[j >> 1] = pkbf(qv[j] * fexp(bq[j]), qv[j + 1] * fexp(bq[j + 1]));
      LAS u32x4* p = (LAS u32x4*)(QP + erow * 72 + dg); p[0] = (u32x4){w[0], w[1], w[2], w[3]}; p[1] = (u32x4){w[4], w[5], w[6], w[7]}; }
    __builtin_amdgcn_wave_barrier(); asm volatile("s_waitcnt lgkmcnt(0)" ::: "memory");
    f32x4 o[4];
#pragma unroll
    for (int n = 0; n < 4; ++n) o[n] = (f32x4){0.f, 0.f, 0.f, 0.f};
#pragma unroll
    for (int ks = 0; ks < 2; ++ks) { const bf16x8 aq = *(const LAS bf16x8*)(QP + fr * 72 + 32 * ks + 8 * fq), aa = *(const LAS bf16x8*)(ATT + fr * 72 + 32 * ks + 8 * fq);
#pragma unroll
        for (int n = 0; n < 4; ++n) { const bf16x8 bs = *(const LAS bf16x8*)(STL + (dir * 64 + 16 * n + fr) * 72 + 32 * ks + 8 * fq), bv = *(const LAS bf16x8*)(VT + (16 * n + fr) * 72 + 32 * ks + 8 * fq);
            o[n] = MFMA16(aq, bs, o[n]); o[n] = MFMA16(aa, bv, o[n]); } }
    if (dir == 0) {
#pragma unroll
        for (int n = 0; n < 4; ++n)
#pragma unroll
            for (int r = 0; r < 4; ++r) OSUM[(16 * si + 4 * fq + r) * 64 + 16 * n + fr] = o[n][r]; }
    __syncthreads();
    if (dir == 1) {
        const bool wr_out = !(a.skipctx_out && k >= 128);
        float ss[4] = {0.f, 0.f, 0.f, 0.f};
#pragma unroll
        for (int n = 0; n < 4; ++n)
#pragma unroll
            for (int r = 0; r < 4; ++r) { o[n][r] += OSUM[(16 * si + 4 * fq + r) * 64 + 16 * n + fr]; ss[r] += o[n][r] * o[n][r]; }
#pragma unroll
        for (int r = 0; r < 4; ++r) { ss[r] += __shfl_xor(ss[r], 1); ss[r] += __shfl_xor(ss[r], 2); ss[r] += __shfl_xor(ss[r], 4); ss[r] += __shfl_xor(ss[r], 8); ss[r] = rsqrtf(ss[r] * (1.f / 64.f) + EPS); }
        if (wr_out) {
            const size_t orow0 = (size_t)b * RPB + 64 * k - a.out_off;
#pragma unroll
            for (int n = 0; n < 4; ++n)
#pragma unroll
                for (int r = 0; r < 4; ++r) { const int tq = 16 * si + 4 * fq + r, e = 16 * n + fr; const float gv = bf2f(a.BG[(row0 + tq) * 512 + h * 64 + e]);
                    a.OB[(orow0 + tq) * 512 + h * 64 + e] = f2bf(o[n][r] * ss[r] * a.gn[h * 64 + e] * gv * fsigmoid(gv)); }
        }
    }
    __syncthreads();
}
constexpr int SCAN_LDS = SC_A + 18432 + 2048 + 16384 + 8 * 6912;

#define XB_TMO      128
#define XB_XCNT(j)  (256  + 64 * (j))
#define XB_XSUB(j)  (1280 + 64 * (j))
#define XB_XGEN(j)  (2304 + 64 * (j))
#define XB_TOP      3328
#define XB_TOPGEN   3392
#define XCD_BAR_WORDS 3456
#define XB_SPIN_CAP (1u << 18)

__device__ __forceinline__ unsigned xb_ld(unsigned* p)              { return __hip_atomic_load(p, __ATOMIC_RELAXED, __HIP_MEMORY_SCOPE_AGENT); }
__device__ __forceinline__ unsigned xb_add(unsigned* p, unsigned v) { return __hip_atomic_fetch_add(p, v, __ATOMIC_RELAXED, __HIP_MEMORY_SCOPE_AGENT); }
__device__ __forceinline__ unsigned xb_xcc_id() { return (unsigned)__builtin_amdgcn_s_getreg((3 << 11) | 20) & 0xFu; }
#define XB_SPIN(cond, bar) do { unsigned _sp = 0; while (cond) { __builtin_amdgcn_s_sleep(1); \
    if ((++_sp & 255u) == 0u) { if (xb_ld(&(bar)[XB_TMO])) break; if (_sp > XB_SPIN_CAP) { atomicAdd(&(bar)[XB_TMO], 1u); break; } } } } while (0)

struct XcdBarrier {
    unsigned* bar; unsigned x;
    volatile LAS unsigned* st;
};

__device__ __forceinline__ XcdBarrier xcd_barrier_post(unsigned* bar, volatile LAS unsigned* st) {
    XcdBarrier b; b.bar = bar; b.x = xb_xcc_id(); b.st = st;
    if (threadIdx.x == 0) (void)xb_add(&bar[XB_XCNT(b.x)], 1u);
    return b;
}
__device__ __forceinline__ void xcd_barrier_complete(unsigned* bar, unsigned x, unsigned& nloc, unsigned& nx) {
    const unsigned G = gridDim.x * gridDim.y * gridDim.z;
    unsigned sum, cnt, mine, sp = 0u;
    for (;;) {
        sum = 0u; cnt = 0u; mine = 0u;
#pragma unroll
        for (unsigned j = 0; j < 16; ++j) { const unsigned c = xb_ld(&bar[XB_XCNT(j)]); sum += c; cnt += (c > 0u) ? 1u : 0u; mine = (j == x) ? c : mine; }
        if (sum == G) break;
        __builtin_amdgcn_s_sleep(1);
        if ((++sp & 255u) == 0u) { if (xb_ld(&bar[XB_TMO])) break; if (sp > XB_SPIN_CAP) { atomicAdd(&bar[XB_TMO], 1u); break; } }
    }
    nloc = mine > 0u ? mine : 1u; nx = cnt > 0u ? cnt : 1u;
}

__device__ __forceinline__ void xcd_barrier(const XcdBarrier& b) {
    asm volatile("s_waitcnt vmcnt(0)" ::: "memory");
    __syncthreads();
    if (threadIdx.x == 0) {
        unsigned* bar = b.bar;
        __builtin_amdgcn_s_waitcnt(0);
        unsigned nloc = b.st[0], nx = b.st[1];
        if (nloc == 0u) { xcd_barrier_complete(bar, b.x, nloc, nx); b.st[0] = nloc; b.st[1] = nx; }
        const unsigned old = xb_add(&bar[XB_XSUB(b.x)], 1u);
        const unsigned gen = old / nloc;
        if (old + 1u == (gen + 1u) * nloc) {
            __builtin_amdgcn_fence(__ATOMIC_RELEASE, "agent");
            asm volatile("s_waitcnt vmcnt(0)" ::: "memory");
            const unsigned og = xb_add(&bar[XB_TOP], 1u);
            const unsigned tg = og / nx;
            if (og + 1u == (tg + 1u) * nx) xb_add(&bar[XB_TOPGEN], 1u);
            else XB_SPIN(xb_ld(&bar[XB_TOPGEN]) == tg, bar);
            __builtin_amdgcn_fence(__ATOMIC_ACQUIRE, "agent");
            xb_add(&bar[XB_XGEN(b.x)], 1u);
            asm volatile("s_waitcnt vmcnt(0)" ::: "memory");
        } else {
            XB_SPIN(xb_ld(&bar[XB_XGEN(b.x)]) == gen, bar);
            __builtin_amdgcn_fence(__ATOMIC_ACQUIRE, "agent");
            asm volatile("s_waitcnt vmcnt(0)" ::: "memory");
        }
    }
    __syncthreads();
}


constexpr size_t MiB = 1u << 20;
constexpr size_t CTL_ZERO_BYTES = 64 * 1024;
constexpr int CW_COUNTS = 8192, CW_CURSOR = 8192 + 128;
constexpr size_t O_MOD = 1 * MiB, O_LB = 1 * MiB + 512 * 1024, O_ROPA_C = 2 * MiB, O_ROPA_S = 3 * MiB, O_ROPC_C = 4 * MiB, O_ROPC_S = 4 * MiB + 512 * 1024, O_XC = 5 * MiB;
constexpr size_t O_ROUTE_E = 9 * MiB, O_ROUTE_W = 9 * MiB + 512 * 1024, O_PERM = 10 * MiB, O_POSW = 10 * MiB + 512 * 1024, O_GOFF = 11 * MiB, O_TILEE = 11 * MiB + 512 * 1024;
constexpr size_t O_RS = 12 * MiB, O_DS = 13 * MiB + 512 * 1024;
constexpr size_t O_WINP = 16 * MiB, O_WC = 30 * MiB, O_WBR = 32 * MiB, O_WOUT = 35 * MiB;
constexpr size_t O_H = 38 * MiB;
constexpr size_t O_AQ = 104 * MiB, O_AK = 137 * MiB, O_AV = 145 * MiB + 512 * 1024;
constexpr size_t O_BQ = 154 * MiB, O_BV = 187 * MiB, O_BG = 220 * MiB, O_BLF = 253 * MiB, O_BLB = 286 * MiB;
constexpr size_t O_CQKV = 319 * MiB, O_CKR = 344 * MiB, O_CQ = 347 * MiB, O_CKV = 397 * MiB, O_OC = 463 * MiB, WS_END = 496 * MiB;
constexpr size_t O_GATE = 187 * MiB;
constexpr size_t O_YM2 = 154 * MiB, O_AUP = 104 * MiB, O_WUP = 397 * MiB, O_WDN = 429 * MiB;
constexpr int LDS_BYTES = 163840, LDS_BAR_OFF = LDS_BYTES - 64, LDS_PTR_OFF = LDS_BYTES - 512;

struct KP { const float* in[24]; float* out; char* ws; int ph_lo, ph_hi; };
struct Frame {
    LAS char* lds; char* ws; float* out;
};
#define WSP(T, off) ((T*)(F.ws + (off)))
__device__ __forceinline__ const float* in_ptr(const Frame& F, int k) { const volatile LAS unsigned* q = (const volatile LAS unsigned*)(F.lds + LDS_PTR_OFF + 8 * k);
    unsigned lo = q[0], hi = q[1]; lo = __builtin_amdgcn_readfirstlane(lo); hi = __builtin_amdgcn_readfirstlane(hi); return (const float*)(((unsigned long long)hi << 32) | lo); }
#define INP(k) in_ptr(F, k)
__device__ __forceinline__ float wave_sum(float v) {
#pragma unroll
    for (int o = 32; o >= 1; o >>= 1) v += __shfl_xor(v, o);
    return v;
}

__device__ __forceinline__ void p0_mod(const Frame& F) {
    const int tid = opaque_tid(), lane = tid & 63, wave = __builtin_amdgcn_readfirstlane(tid >> 6); (void)lane; (void)wave;
    LAS float* sc = (LAS float*)F.lds;
    LAS float* red = (LAS float*)(F.lds + 20480);
    for (int i = tid; i < 5 * 1024; i += 512) { const int r = i >> 10, k = i & 1023; const float v = r < 4 ? INP(1)[r * 1024 + k] : INP(3)[k]; sc[i] = v / (1.f + expf(-v)); }
    __syncthreads();
    float* MOD = WSP(float, O_MOD);
    for (int u = blockIdx.x; u < 2 * 96; u += gridDim.x) { const int l = u / 96, j = (u % 96) * 64 + lane;
        const float* w = INP(4) + (size_t)l * 1024 * 6144 + j; float a0 = 0.f, a1 = 0.f, a2 = 0.f, a3 = 0.f, a4 = 0.f;
#pragma unroll 8
        for (int kk = 0; kk < 128; ++kk) { const int k = wave * 128 + kk; const float wv = w[(size_t)k * 6144]; a0 += sc[k] * wv; a1 += sc[1024 + k] * wv; a2 += sc[2048 + k] * wv; a3 += sc[3072 + k] * wv; a4 += sc[4096 + k] * wv; }
        red[(wave * 5 + 0) * 64 + lane] = a0; red[(wave * 5 + 1) * 64 + lane] = a1; red[(wave * 5 + 2) * 64 + lane] = a2; red[(wave * 5 + 3) * 64 + lane] = a3; red[(wave * 5 + 4) * 64 + lane] = a4;
        __syncthreads();
        if (tid < 320) { const int r = tid >> 6, ln = tid & 63; float s = 0.f;
#pragma unroll
            for (int w8 = 0; w8 < 8; ++w8) s += red[(w8 * 5 + r) * 64 + ln];
            const int jj = (u % 96) * 64 + ln; MOD[(size_t)(l * 5 + r) * 6144 + jj] = s + INP(5)[l * 6144 + jj]; }
        __syncthreads();
    }
}
__device__ __forceinline__ void p0_tables(const Frame& F) {
    const int tid = opaque_tid(), lane = tid & 63, wave = __builtin_amdgcn_readfirstlane(tid >> 6); (void)lane; (void)wave;
    float* ropa_c = WSP(float, O_ROPA_C); float* ropa_s = WSP(float, O_ROPA_S); float* ropc_c = WSP(float, O_ROPC_C); float* ropc_s = WSP(float, O_ROPC_S); float* LB = WSP(float, O_LB);
    for (int i = blockIdx.x * 512 + tid; i < 8192 * 32; i += gridDim.x * 512) {
        { const int t = i >> 5, j = i & 31, row = t >> 6, col = t & 63, f = j & 15; const float inv = powf(10000.f, -(float)f / 16.f); const float ang = (j < 16 ? (float)row : (float)col) * inv;
          ropa_c[i] = (float)cos((double)ang); ropa_s[i] = (float)sin((double)ang); }
        if (i < 8192 * 16) { const int t = i >> 4, j = i & 15, row = t >> 6, col = t & 63, f = j & 7; const float inv = powf(10000.f, -(float)f / 8.f); const float ang = (j < 8 ? (float)row : (float)col) * inv;
          ropc_c[i] = (float)cos((double)ang); ropc_s[i] = (float)sin((double)ang); }
        if (i < 2048) { const int l = i >> 10, rest = i & 1023; if (l == 0) LB[i] = 0.f; else { const float a0 = INP(10)[rest], a1 = INP(10)[1024 + rest]; LB[i] = 1.f / (1.f + expf(a0 - a1)); } }
    }
}
template <class CM> __device__ __forceinline__ void wt_tile(const float* W, int ldw, const CM& cm, bf16_t* Bt, int K, int p0, int k0, LAS float* scr, int lane) {
    const int tx = lane & 31, half = lane >> 5; const int c = cm(p0 + tx);
#pragma unroll 8
    for (int i = 0; i < 32; ++i) { const int kk = 2 * i + half; scr[kk * 33 + tx] = c >= 0 ? W[(size_t)(k0 + kk) * ldw + c] : 0.f; }
    asm volatile("s_waitcnt lgkmcnt(0)" ::: "memory"); __builtin_amdgcn_wave_barrier();
#pragma unroll 8
    for (int pi = 0; pi < 32; ++pi) Bt[(size_t)(p0 + pi) * K + k0 + lane] = f2bf(scr[lane * 33 + pi]);
    asm volatile("s_waitcnt lgkmcnt(0)" ::: "memory"); __builtin_amdgcn_wave_barrier();
}
struct CmWin { __device__ __forceinline__ int operator()(int p) const { return colmap(MAP_WIN, p); } };
struct CmId { __device__ __forceinline__ int operator()(int p) const { return p; } };
__device__ __forceinline__ void conv_weights_nonmoe(const Frame& F, int l) {
    const int tid = opaque_tid(), lane = tid & 63, wave = __builtin_amdgcn_readfirstlane(tid >> 6); (void)lane; (void)wave;
    LAS float* scr = (LAS float*)F.lds + wave * (64 * 33);
    const int gw = blockIdx.x * 8 + wave, NGW = gridDim.x * 8;
    constexpr int I_WIN = 216 * 16, I_BR = 3 * 32 * 8, I_OUT = 32 * 16;
    for (int it = gw; it < I_WIN + I_BR + I_OUT; it += NGW) {
        int r = it;
        if (r < I_WIN) { wt_tile(INP(8) + (size_t)l * 1024 * INW, INW, CmWin(), WSP(bf16_t, O_WINP), 1024, (r / 16) * 32, (r % 16) * 64, scr, lane); continue; } r -= I_WIN;
        if (r < I_BR) { const int n = r / 256, q = r % 256; wt_tile(INP(16) + ((size_t)l * 3 + n) * 512 * 1024, 1024, CmId(), WSP(bf16_t, O_WBR) + (size_t)n * 1024 * 512, 512, (q / 8) * 32, (q % 8) * 64, scr, lane); continue; } r -= I_BR;
        wt_tile(INP(17) + (size_t)l * 1024 * 1024, 1024, CmId(), WSP(bf16_t, O_WOUT), 1024, (r / 16) * 32, (r % 16) * 64, scr, lane);
    }
    const float* wuq = INP(14) + (size_t)l * 256 * 768; const float* wukv = INP(15) + (size_t)l * 128 * 1024; const float* gq = INP(12) + l * 256; const float* gkv = INP(13) + l * 128; bf16_t* WC = WSP(bf16_t, O_WC);
    for (int i = blockIdx.x * 512 + tid; i < 1792 * 384; i += gridDim.x * 512) {
        const int pp = i / 384, k = i % 384; float v = 0.f;
        if (pp < 768) { const int pn = pp >> 8, q = pp & 255, bj = q >> 7, wc = (q >> 5) & 3, j = q & 31; const int gi = pn * 8 + bj * 4 + wc, head = gi / 3, part = gi - head * 3;
            const int p = part < 2 ? head * 96 + part * 32 + j : head * 96 + 64 + 16 * ((j >> 2) & 1) + 4 * (j >> 3) + (j & 3);
            if (k < 256) v = wuq[k * 768 + p] * gq[k]; }
        else { if (k >= 256) v = wukv[(k - 256) * 1024 + (pp - 768)] * gkv[k - 256]; }
        WC[i] = f2bf(v); }
}
struct CmUp { __device__ __forceinline__ int operator()(int p) const { return ((p >> 8) << 7) + (p & 127); } };
__device__ __forceinline__ void conv_weights_moe(const Frame& F, int l) {
    const int tid = opaque_tid(), lane = tid & 63, wave = __builtin_amdgcn_readfirstlane(tid >> 6); (void)lane; (void)wave;
    LAS float* scr = (LAS float*)F.lds + wave * (64 * 33);
    const int gw = blockIdx.x * 8 + wave, NGW = gridDim.x * 8;
    constexpr int I_UP = 32 * 16 * 16, I_DN = 32 * 32 * 4;
    for (int it = gw; it < I_UP + I_DN; it += NGW) {
        int r = it;
        if (r < I_UP) { const int e = r / 256, q = r % 256, p0 = (q / 16) * 32, k0 = (q % 16) * 64; const bool isw3 = (p0 >> 7) & 1;
            const float* W = (isw3 ? INP(21) : INP(20)) + ((size_t)l * 32 + e) * 1024 * 256;
            wt_tile(W, 256, CmUp(), WSP(bf16_t, O_WUP) + (size_t)e * 512 * 1024, 1024, p0, k0, scr, lane); continue; } r -= I_UP;
        { const int e = r / 128, q = r % 128; wt_tile(INP(22) + ((size_t)l * 32 + e) * 256 * 1024, 1024, CmId(), WSP(bf16_t, O_WDN) + (size_t)e * 1024 * 256, 256, (q / 4) * 32, (q % 4) * 64, scr, lane); }
    }
}

__device__ __forceinline__ void rp_load(const float* xs, float* xd, bool wx, const bf16_t* ym, const float* gt, int lane, f32x4 (&v)[4], float& rinv) {
    float ss = 0.f;
#pragma unroll
    for (int j = 0; j < 4; ++j) { const int c = 4 * lane + 256 * j; v[j] = *(const f32x4*)(xs + c);
        if (ym) { const uint2 y0 = *(const uint2*)(ym + c), y1 = *(const uint2*)(ym + 1024 + c); const f32x4 g4 = *(const f32x4*)(gt + c);
            v[j][0] += g4[0] * (bflo(y0.x) + bflo(y1.x)); v[j][1] += g4[1] * (bfhi(y0.x) + bfhi(y1.x)); v[j][2] += g4[2] * (bflo(y0.y) + bflo(y1.y)); v[j][3] += g4[3] * (bfhi(y0.y) + bfhi(y1.y)); }
        if (wx) *(f32x4*)(xd + c) = v[j];
        ss += v[j][0] * v[j][0] + v[j][1] * v[j][1] + v[j][2] * v[j][2] + v[j][3] * v[j][3]; }
    rinv = rsqrtf(wave_sum(ss) * (1.f / D) + EPS);
}
__device__ __forceinline__ void rp_mod(const f32x4 (&v)[4], float rinv, const float* gn, const float* mo, int sh_off, int sc_off, bf16_t* hp, int lane, f32x4 (&hv)[4]) {
#pragma unroll
    for (int j = 0; j < 4; ++j) { const int c = 4 * lane + 256 * j; const f32x4 g4 = *(const f32x4*)(gn + c), s4 = *(const f32x4*)(mo + sc_off + c), h4 = *(const f32x4*)(mo + sh_off + c);
        hv[j] = v[j] * rinv * g4 * (s4 + 1.f) + h4;
        *(uint2*)(hp + c) = make_uint2(pkbf(hv[j][0], hv[j][1]), pkbf(hv[j][2], hv[j][3])); }
}
__device__ __forceinline__ void phase_rowpass1(const Frame& F, int l, bool combine) {
    const int tid = opaque_tid(), lane = tid & 63, wave = __builtin_amdgcn_readfirstlane(tid >> 6); (void)lane; (void)wave;
    const int gw = blockIdx.x * 8 + wave, NGW = gridDim.x * 8;
    const float* xl = (l == 0) ? INP(0) : F.out; const float* xc = (l == 0) ? INP(2) : WSP(float, O_XC);
    const float* MODl = WSP(float, O_MOD) + (size_t)l * 5 * 6144; const float* MODp = WSP(float, O_MOD);
    for (int g = gw; g < G; g += NGW) { const RowInfo ri = rowinfo(g); const int mrow = ri.lat ? ri.b : 4; const size_t xo = xoff(ri);
        const float* xs = (ri.lat ? xl : xc) + xo; float* xd = (ri.lat ? F.out : WSP(float, O_XC)) + xo;
        f32x4 v[4], hv[4]; float rinv;
        rp_load(xs, xd, combine, combine ? WSP(bf16_t, O_YM2) + (size_t)g * 2048 : nullptr, MODp + (size_t)mrow * 6144 + 5120, lane, v, rinv);
        rp_mod(v, rinv, INP(6) + l * 1024, MODl + (size_t)mrow * 6144, 0, 1024, WSP(bf16_t, O_H) + (size_t)g * D, lane, hv); }
}
__device__ __forceinline__ void phase_rowpass2(const Frame& F, int l, bool last) {
    const int tid = opaque_tid(), lane = tid & 63, wave = __builtin_amdgcn_readfirstlane(tid >> 6); (void)lane; (void)wave;
    LAS float* WT = (LAS float*)F.lds;
    { const float* wrg = INP(18) + (size_t)l * 1024 * 4; const float* wre = INP(19) + (size_t)l * 1024 * 32;
      for (int i = tid; i < 1024 * 4; i += 512) WT[(i & 3) * 1024 + (i >> 2)] = wrg[i];
      for (int i = tid; i < 1024 * 32; i += 512) WT[(4 + (i & 31)) * 1024 + (i >> 5)] = wre[i]; }
    { int* perm = WSP(int, O_PERM); unsigned* goff = WSP(unsigned, O_GOFF);
      for (int i = blockIdx.x * 512 + tid; i < PMAX; i += gridDim.x * 512) { perm[i] = -1; goff[i] = 0u; } }
    __syncthreads();
    const int gw = blockIdx.x * 8 + wave, NGW = gridDim.x * 8;
    const float* MODl = WSP(float, O_MOD) + (size_t)l * 5 * 6144;
    int* route_e = WSP(int, O_ROUTE_E); float* route_w = WSP(float, O_ROUTE_W); unsigned* counts = WSP(unsigned, 0) + CW_COUNTS + l * 32;
    for (int g = gw; g < G; g += NGW) { const RowInfo ri = rowinfo(g); if (last && !ri.lat) continue;
        const int mrow = ri.lat ? ri.b : 4; const size_t xo = xoff(ri);
        const float* xs = (ri.lat ? F.out : WSP(float, O_XC)) + xo;
        f32x4 v[4], hv[4]; float rinv;
        rp_load(xs, nullptr, false, nullptr, nullptr, lane, v, rinv);
        rp_mod(v, rinv, INP(7) + l * 1024, MODl + (size_t)mrow * 6144, 3072, 4096, WSP(bf16_t, O_H) + (size_t)g * D, lane, hv);
        float lg[36];
#pragma unroll
        for (int c = 0; c < 36; ++c) { float p = 0.f;
#pragma unroll
            for (int j = 0; j < 4; ++j) { const f32x4 w4 = *(const LAS f32x4*)(WT + c * 1024 + 4 * lane + 256 * j); p += hv[j][0] * w4[0] + hv[j][1] * w4[1] + hv[j][2] * w4[2] + hv[j][3] * w4[3]; }
            lg[c] = wave_sum(p); }
        int gs = 0; float gm = lg[0];
#pragma unroll
        for (int j = 1; j < 4; ++j) if (lg[j] > gm) { gm = lg[j]; gs = j; }
        float gsum = 0.f;
#pragma unroll
        for (int j = 0; j < 4; ++j) gsum += expf(lg[j] - gm);
        const float gwt = 1.f / gsum;
        int i0s = 0, i1s = 1; float m0s = 0.f, m1s = 0.f;
#pragma unroll
        for (int gi = 0; gi < 4; ++gi) { int i0 = 0; float m0 = lg[4 + gi * 8];
#pragma unroll
            for (int j = 1; j < 8; ++j) if (lg[4 + gi * 8 + j] > m0) { m0 = lg[4 + gi * 8 + j]; i0 = j; }
            int i1 = -1; float m1 = -3.4e38f;
#pragma unroll
            for (int j = 0; j < 8; ++j) if (j != i0 && lg[4 + gi * 8 + j] > m1) { m1 = lg[4 + gi * 8 + j]; i1 = j; }
            if (gi == gs) { i0s = i0; i1s = i1; m0s = m0; m1s = m1; } }
        const float p1 = expf(m1s - m0s); const float w0 = gwt / (1.f + p1), w1 = gwt * p1 / (1.f + p1);
        if (lane == 0) { const int e0 = gs * 8 + i0s, e1 = gs * 8 + i1s; route_e[g * 2] = e0; route_e[g * 2 + 1] = e1; route_w[g * 2] = w0; route_w[g * 2 + 1] = w1;
            atomicAdd(counts + e0, 1u); atomicAdd(counts + e1, 1u); }
    }
}
__device__ __forceinline__ void phase_final(const Frame& F) {
    const int tid = opaque_tid(), lane = tid & 63, wave = __builtin_amdgcn_readfirstlane(tid >> 6); (void)lane; (void)wave;
    const int gw = blockIdx.x * 8 + wave, NGW = gridDim.x * 8; const float* MOD1 = WSP(float, O_MOD) + (size_t)5 * 6144;
    for (int lr = gw; lr < NB * SEQ; lr += NGW) { const int b = lr / SEQ, t = lr - b * SEQ; const int g = b * RPB + t; float* xp = F.out + (size_t)lr * D;
        f32x4 v[4]; float rinv; rp_load(xp, nullptr, false, WSP(bf16_t, O_YM2) + (size_t)g * 2048, MOD1 + (size_t)b * 6144 + 5120, lane, v, rinv);
#pragma unroll
        for (int j = 0; j < 4; ++j) { const int c = 4 * lane + 256 * j; const f32x4 g4 = *(const f32x4*)(INP(23) + c); *(f32x4*)(xp + c) = v[j] * rinv * g4; } }
}
__device__ __forceinline__ void phase_moe_scatter(const Frame& F, int l, bool last) {
    const int tid = opaque_tid(), lane = tid & 63, wave = __builtin_amdgcn_readfirstlane(tid >> 6); (void)lane; (void)wave;
    LAS int* soff = (LAS int*)F.lds; const unsigned* counts = WSP(unsigned, 0) + CW_COUNTS + l * 32; unsigned* cursor = WSP(unsigned, 0) + CW_CURSOR + l * 32;
    if (tid == 0) { int o = 0; int* tile_e = WSP(int, O_TILEE);
#pragma clang loop unroll(disable) vectorize(disable)
        for (int e = 0; e < 32; ++e) { soff[e] = o; const int n = ((int)__hip_atomic_load(counts + e, __ATOMIC_RELAXED, __HIP_MEMORY_SCOPE_AGENT) + 255) & ~255;
            if (blockIdx.x == 0) {
#pragma clang loop unroll(disable) vectorize(disable)
                for (int t = o >> 8; t < (o + n) >> 8; ++t) tile_e[t] = e; }
            o += n; }
        soff[32] = o; if (blockIdx.x == 0) tile_e[NTILE] = o >> 8; }
    __syncthreads();
    const int* route_e = WSP(int, O_ROUTE_E); const float* route_w = WSP(float, O_ROUTE_W); int* perm = WSP(int, O_PERM); float* posw = WSP(float, O_POSW); unsigned* goff = WSP(unsigned, O_GOFF);
    for (int i = blockIdx.x * 512 + tid; i < 2 * G; i += gridDim.x * 512) { const int g = i >> 1; const RowInfo ri = rowinfo(g); if (last && !ri.lat) continue;
        const int e = route_e[i]; const int pos = soff[e] + (int)atomicAdd(cursor + e, 1u);
        perm[pos] = i; posw[pos] = route_w[i]; goff[pos] = (unsigned)g * 2048u; }
}

__global__ void __launch_bounds__(512, 2) hybrid_trunk_fwd(KP p) {
    extern __shared__ __attribute__((aligned(16))) unsigned char dynlds[];
    Frame F; F.lds = (LAS char*)dynlds; F.ws = p.ws; F.out = p.out;
    if (threadIdx.x == 0) { LAS unsigned long long* pp = (LAS unsigned long long*)(F.lds + LDS_PTR_OFF);
        pp[0] = (unsigned long long)p.in[0];
        pp[1] = (unsigned long long)p.in[1];
        pp[2] = (unsigned long long)p.in[2];
        pp[3] = (unsigned long long)p.in[3];
        pp[4] = (unsigned long long)p.in[4];
        pp[5] = (unsigned long long)p.in[5];
        pp[6] = (unsigned long long)p.in[6];
        pp[7] = (unsigned long long)p.in[7];
        pp[8] = (unsigned long long)p.in[8];
        pp[9] = (unsigned long long)p.in[9];
        pp[10] = (unsigned long long)p.in[10];
        pp[11] = (unsigned long long)p.in[11];
        pp[12] = (unsigned long long)p.in[12];
        pp[13] = (unsigned long long)p.in[13];
        pp[14] = (unsigned long long)p.in[14];
        pp[15] = (unsigned long long)p.in[15];
        pp[16] = (unsigned long long)p.in[16];
        pp[17] = (unsigned long long)p.in[17];
        pp[18] = (unsigned long long)p.in[18];
        pp[19] = (unsigned long long)p.in[19];
        pp[20] = (unsigned long long)p.in[20];
        pp[21] = (unsigned long long)p.in[21];
        pp[22] = (unsigned long long)p.in[22];
        pp[23] = (unsigned long long)p.in[23];
    }
    LAS unsigned char* glds = (LAS unsigned char*)dynlds;
    volatile LAS unsigned* barst = (volatile LAS unsigned*)(F.lds + LDS_BAR_OFF);
    if (threadIdx.x < 16) ((LAS unsigned*)(F.lds + LDS_BAR_OFF))[threadIdx.x] = 0u;
    __syncthreads();
    const bool multi = (p.ph_hi - p.ph_lo) > 1;
    XcdBarrier bar; bar.bar = (unsigned*)F.ws; bar.x = 0; bar.st = nullptr;
    if (multi) bar = xcd_barrier_post((unsigned*)F.ws, barst);
    int ph = 0;
#define PH_BEGIN if (ph >= p.ph_lo && ph < p.ph_hi) {
#define PH_END   if (ph + 1 < p.ph_hi) xcd_barrier(bar); else __syncthreads(); } ++ph;
    const int Gd = gridDim.x, cb = blockIdx.x;

    PH_BEGIN p0_mod(F); p0_tables(F); __syncthreads(); conv_weights_nonmoe(F, 0); PH_END

    for (int l = 0; l < 2; ++l) {
        const bool last = (l == 1);
        const float* MODl = WSP(float, O_MOD) + (size_t)l * 5 * 6144;
        PH_BEGIN phase_rowpass1(F, l, l > 0); PH_END
        PH_BEGIN
        { SchedStd S{}; S.A = WSP(bf16_t, O_H); S.Bt = WSP(bf16_t, O_WINP); S.K = 1024; S.nM = 132; S.nN = 15; S.G_ = Gd; S.c = cb; S.skipctx = 0; S.lda2 = 2048; S.ldb2 = 2048;
          EpiG1 E{}; E.AQ = WSP(bf16_t, O_AQ); E.AK = WSP(bf16_t, O_AK); E.AV = WSP(bf16_t, O_AV); E.BQ = WSP(bf16_t, O_BQ); E.BV = WSP(bf16_t, O_BV); E.BG = WSP(bf16_t, O_BG); E.BLF = WSP(f16_t, O_BLF); E.BLB = WSP(f16_t, O_BLB);
          E.CQKV = WSP(bf16_t, O_CQKV); E.CKR = WSP(bf16_t, O_CKR); E.RS = WSP(float, O_RS); E.ropa_c = WSP(float, O_ROPA_C); E.ropa_s = WSP(float, O_ROPA_S); E.ropc_c = WSP(float, O_ROPC_C); E.ropc_s = WSP(float, O_ROPC_S);
          E.LBl = WSP(float, O_LB) + l * 1024; E.rowoff = 0;
          gp::gemm_phase<EpiG1, SchedStd>(glds, S, E); }
        PH_END
        PH_BEGIN
        { SchedStd S{}; S.A = WSP(bf16_t, O_CQKV); S.Bt = WSP(bf16_t, O_WC); S.K = 384; S.nM = 132; S.nN = 7; S.G_ = Gd; S.c = cb; S.skipctx = 0; S.lda2 = 768; S.ldb2 = 768;
          EpiC E{}; E.CQ = WSP(bf16_t, O_CQ); E.CKV = WSP(bf16_t, O_CKV); E.RS = WSP(float, O_RS); E.ropc_c = WSP(float, O_ROPC_C); E.ropc_s = WSP(float, O_ROPC_S); E.pmoff = 0;
          gp::gemm_phase<EpiC, SchedStd>(glds, S, E); }
        __syncthreads();
        { AttnArgs a{}; a.Q = WSP(bf16_t, O_AQ); a.qld = 512; a.qhs = 64; a.K1 = WSP(bf16_t, O_AK); a.k1ld = 128; a.k1hs = 64; a.kvgroup = 4; a.K2 = nullptr; a.k2ld = 0; a.V = WSP(bf16_t, O_AV); a.vld = 128; a.vhs = 64;
          a.O = WSP(bf16_t, O_AQ); a.old = 512; a.ohs = 64; a.scale_l2 = 0.125f * LOG2E; a.sink = INP(9) + l * 8; a.window = 128;
          const int nqb = last ? 32 : 33;
          for (int u = cb; u < NB * 8 * nqb; u += Gd) { const int b = u / (8 * nqb), rem = u - b * 8 * nqb, h = rem / nqb, qb = rem - h * nqb; attn_unit<64>(F.lds, a, b, qb, h); } }
        __syncthreads();
        { ScanArgs a{}; a.BQ = WSP(bf16_t, O_BQ); a.BV = WSP(bf16_t, O_BV); a.BG = WSP(bf16_t, O_BG); a.BLF = WSP(f16_t, O_BLF); a.BLB = WSP(f16_t, O_BLB); a.ST = WSP(bf16_t, O_H); a.DS = WSP(float, O_DS); a.OB = WSP(bf16_t, O_BQ); a.gn = INP(11) + l * 512;
          for (int u = cb; u < NB * 8 * NCHK; u += Gd) { const int b = u / (8 * NCHK), rem = u - b * 8 * NCHK, h = rem / NCHK, k = rem - h * NCHK; scan_s1_unit(F.lds, a, b, h, k); } }
        PH_END
        PH_BEGIN
        { ScanArgs a{}; a.ST = WSP(bf16_t, O_H); a.DS = WSP(float, O_DS);
          for (int t = cb; t < NB * 8 * 2 * 4; t += Gd) scan_s2_task(a, t); }
        { AttnArgs a{}; a.Q = WSP(bf16_t, O_CQ); a.qld = 768; a.qhs = 96; a.K1 = WSP(bf16_t, O_CKV); a.k1ld = 1024; a.k1hs = 128; a.kvgroup = 1; a.K2 = WSP(bf16_t, O_CKR); a.k2ld = 32; a.V = WSP(bf16_t, O_CKV) + 64; a.vld = 1024; a.vhs = 128;
          a.O = WSP(bf16_t, O_OC); a.old = 512; a.ohs = 64; a.scale_l2 = 0.10206207261596577f * LOG2E; a.sink = nullptr; a.window = 0;
          const int nqb = last ? 32 : 33;
          for (int u = cb; u < NB * 8 * nqb; u += Gd) { const int b = u / (8 * nqb), rem = u - b * 8 * nqb, h = rem / nqb, qb = rem - h * nqb; attn_unit<96>(F.lds, a, b, qb, h); } }
        PH_END
        PH_BEGIN
        { ScanArgs a{}; a.BQ = WSP(bf16_t, O_BQ); a.BV = WSP(bf16_t, O_BV); a.BG = WSP(bf16_t, O_BG); a.BLF = WSP(f16_t, O_BLF); a.BLB = WSP(f16_t, O_BLB); a.ST = WSP(bf16_t, O_H); a.DS = WSP(float, O_DS); a.OB = WSP(bf16_t, O_BQ); a.gn = INP(11) + l * 512; a.skipctx_out = last ? 1 : 0;
          for (int u = cb; u < NB * 8 * NCHK; u += Gd) { const int b = u / (8 * NCHK), rem = u - b * 8 * NCHK, h = rem / NCHK, k = rem - h * NCHK; scan_s3_unit(F.lds, a, b, h, k); } }
        PH_END
        PH_BEGIN phase_rowpass1(F, l, false); PH_END
        PH_BEGIN
        { SchedStd S{}; S.A = WSP(bf16_t, O_H); S.Bt = WSP(bf16_t, O_WINP) + (size_t)3840 * 1024; S.K = 1024; S.nM = last ? 128 : 132; S.nN = 12; S.G_ = Gd; S.c = cb; S.skipctx = last ? 1 : 0; S.lda2 = 2048; S.ldb2 = 2048;
          EpiGate E{}; E.GATE = WSP(bf16_t, O_GATE); E.nstride = (long)G * 1024; E.ld = 1024;
          gp::gemm_phase<EpiGate, SchedStd>(glds, S, E); }
        PH_END
        PH_BEGIN
        { SchedMerge S{}; S.A0 = WSP(bf16_t, O_AQ); S.A1 = WSP(bf16_t, O_BQ); S.A2 = WSP(bf16_t, O_OC); S.Bt = WSP(bf16_t, O_WBR); S.nM = last ? 128 : 132; S.G_ = Gd; S.c = cb; S.skipctx = last ? 1 : 0; S.lda2 = 1024; S.ldb2 = 1024;
          EpiMerge E{}; E.GATE = WSP(bf16_t, O_GATE); E.nstride = (long)G * 1024; E.ld = 1024; E.Y = WSP(bf16_t, O_H);
          gp::gemm_phase<EpiMerge, SchedMerge>(glds, S, E); }
        PH_END
        PH_BEGIN
        { SchedStd S{}; S.A = WSP(bf16_t, O_H); S.Bt = WSP(bf16_t, O_WOUT); S.K = 1024; S.nM = last ? 128 : 132; S.nN = 4; S.G_ = Gd; S.c = cb; S.skipctx = last ? 1 : 0; S.lda2 = 2048; S.ldb2 = 2048;
          EpiOut E{}; E.xl_src = l == 0 ? INP(0) : F.out; E.xc_src = l == 0 ? INP(2) : WSP(float, O_XC); E.xl_dst = F.out; E.xc_dst = WSP(float, O_XC); E.mod = MODl; E.pmoff = 0;
          gp::gemm_phase<EpiOut, SchedStd>(glds, S, E); }
        PH_END
        PH_BEGIN phase_rowpass2(F, l, last); __syncthreads(); conv_weights_moe(F, l); if (!last) conv_weights_nonmoe(F, l + 1); PH_END
        PH_BEGIN phase_moe_scatter(F, l, last); PH_END
        PH_BEGIN
        { SchedMoE<true> S{}; S.A = WSP(bf16_t, O_H); S.Bt = WSP(bf16_t, O_WUP); S.tile_e = WSP(int, O_TILEE); S.goff = WSP(unsigned, O_GOFF); S.K = 1024; S.nM = WSP(int, O_TILEE)[NTILE]; S.nN = 2; S.G_ = Gd; S.c = cb; S.lda2 = 2048; S.ldb2 = 2048; S.strideB = 512 * 1024;
          EpiUp E{}; E.AUP = WSP(bf16_t, O_AUP);
          gp::gemm_phase<EpiUp, SchedMoE<true>>(glds, S, E); }
        PH_END
        PH_BEGIN
        { SchedMoE<false> S{}; S.A = WSP(bf16_t, O_AUP); S.Bt = WSP(bf16_t, O_WDN); S.tile_e = WSP(int, O_TILEE); S.goff = nullptr; S.K = 256; S.nM = WSP(int, O_TILEE)[NTILE]; S.nN = 4; S.G_ = Gd; S.c = cb; S.lda2 = 512; S.ldb2 = 512; S.strideB = 1024 * 256;
          EpiDown E{}; E.YM2 = WSP(bf16_t, O_YM2); E.perm = WSP(int, O_PERM); E.posw = WSP(float, O_POSW);
          gp::gemm_phase<EpiDown, SchedMoE<false>>(glds, S, E); }
        PH_END
    }
    PH_BEGIN phase_final(F); PH_END
#undef PH_BEGIN
#undef PH_END
}
constexpr int N_PHASES = 1 + 2 * 13 + 1;
}

#ifndef MK_N_LAUNCHES
#define MK_N_LAUNCHES 1
#endif
extern "C" void kernel_launch(void* const* d_in, const int* in_sizes, int n_in, void* d_out, int out_size, void* d_ws, size_t ws_size, hipStream_t stream) {
    static int grid = 0;
    if (grid == 0) {
        if (ws_size < WS_END) { grid = -1; return; }
        int dev = 0, cus = 0;
        if (hipGetDevice(&dev) != hipSuccess || hipDeviceGetAttribute(&cus, hipDeviceAttributeMultiprocessorCount, dev) != hipSuccess) { grid = -1; return; }
        if (hipFuncSetAttribute((const void*)hybrid_trunk_fwd, hipFuncAttributeMaxDynamicSharedMemorySize, LDS_BYTES) != hipSuccess) { grid = -1; return; }
        int per_cu = 0; (void)hipOccupancyMaxActiveBlocksPerMultiprocessor(&per_cu, (const void*)hybrid_trunk_fwd, 512, LDS_BYTES); (void)hipGetLastError();
        grid = cus;
    }
    if (grid < 0) return;
    (void)hipMemsetAsync(d_ws, 0, CTL_ZERO_BYTES, stream);
    KP p{}; for (int i = 0; i < 24; ++i) p.in[i] = (const float*)d_in[i]; p.out = (float*)d_out; p.ws = (char*)d_ws;
    (void)in_sizes; (void)n_in; (void)out_size;
    if (MK_N_LAUNCHES == 1) { p.ph_lo = 0; p.ph_hi = N_PHASES; hipLaunchKernelGGL(hybrid_trunk_fwd, dim3(grid), dim3(512), LDS_BYTES, stream, p); }
    else { for (int k = 0; k < N_PHASES; ++k) { p.ph_lo = k; p.ph_hi = k + 1; hipLaunchKernelGGL(hybrid_trunk_fwd, dim3(grid), dim3(512), LDS_BYTES, stream, p); } }
}
```

```cpp
#include <hip/hip_runtime.h>
#include <stdint.h>
#include <math.h>

namespace {
typedef unsigned short bf16_t;
typedef _Float16 f16_t;
typedef short bf16x8 __attribute__((ext_vector_type(8)));
typedef short s16x4 __attribute__((ext_vector_type(4)));
typedef float f32x4 __attribute__((ext_vector_type(4)));
typedef float f32x16 __attribute__((ext_vector_type(16)));
typedef unsigned u32x4 __attribute__((ext_vector_type(4)));
#define LAS __attribute__((address_space(3)))

constexpr int D = 1024, NB = 4, SEQ = 8192, CTXL = 256, RPB = SEQ + CTXL, G = NB * RPB;
constexpr int INW = 6816, MIXW = 3744, GATEW = 3072;
constexpr float EPS = 1e-6f;
constexpr float LOG2E = 1.4426950408889634f;
constexpr int PMAX = 75776;
constexpr int NTILE = PMAX / 256;

__device__ __forceinline__ float bf2f(bf16_t v) { return __uint_as_float(((unsigned)v) << 16); }
__device__ __forceinline__ bf16_t f2bf(float f) { unsigned u = __float_as_uint(f); u += 0x7fffu + ((u >> 16) & 1u); return (bf16_t)(u >> 16); }
typedef float f32x2v __attribute__((ext_vector_type(2)));
typedef __bf16 bf16x2v __attribute__((ext_vector_type(2)));
__device__ __forceinline__ unsigned pkbf(float lo, float hi) { const f32x2v v = {lo, hi}; const bf16x2v b = __builtin_convertvector(v, bf16x2v); return __builtin_bit_cast(unsigned, b); }
__device__ __forceinline__ unsigned pk2(float lo, float hi) { return (unsigned)f2bf(lo) | ((unsigned)f2bf(hi) << 16); }
__device__ __forceinline__ float silu_f(float v) { return v / (1.f + expf(-v)); }
__device__ __forceinline__ float sigmoid_f(float v) { return 1.f / (1.f + expf(-v)); }
__device__ __forceinline__ int opaque_tid() { int t = threadIdx.x; asm volatile("" : "+v"(t)); return t; }
struct RowInfo { int b, r; bool lat; };
__device__ __forceinline__ RowInfo rowinfo(int g) { RowInfo ri; ri.b = g / RPB; ri.r = g - ri.b * RPB; ri.lat = ri.r < SEQ; return ri; }
__device__ __forceinline__ size_t xoff(const RowInfo& ri) { return ri.lat ? ((size_t)ri.b * SEQ + ri.r) * D : ((size_t)ri.b * CTXL + (ri.r - SEQ)) * D; }
__device__ __forceinline__ int crow(int r, int hi) { return (r & 3) + 8 * (r >> 2) + 4 * hi; }
__device__ __forceinline__ unsigned cvtpk(float lo, float hi) { return pkbf(lo, hi); }
typedef short v4i16_t __attribute__((ext_vector_type(4)));
__device__ __forceinline__ s16x4 vtr(const LAS char* p) { return __builtin_bit_cast(s16x4, __builtin_amdgcn_ds_read_tr16_b64_v4i16((LAS v4i16_t*)p)); }
#define MFMA32(a, b, c) __builtin_amdgcn_mfma_f32_32x32x16_bf16(a, b, c, 0, 0, 0)

struct AttnArgs { const bf16_t* Q; int qld, qhs; const bf16_t* K1; int k1ld, k1hs, kvgroup; const bf16_t* K2; int k2ld; const bf16_t* V; int vld, vhs;
                  bf16_t* O; int old, ohs; float scale_l2; const float* sink; int window; int pad; };
template <int DQK>
__device__ __forceinline__ void attn_unit(LAS char* lds, const AttnArgs& p, int b, int qb, int h, bool nostore = false) {
    constexpr int NS = DQK / 16, NCH = DQK / 8; constexpr float THR = 8.f;
    constexpr int KB = 0, VB = 24576, WSF = 40960;
    const int tid = opaque_tid(), lane = tid & 63, r32 = lane & 31, hi = lane >> 5, wid = tid >> 6;
    const int rb = b * RPB;
    const bool ctxq = (qb == 32);
    const int q0 = rb + (ctxq ? SEQ : qb * 256);
    int lat_k0 = 0, lat_k1 = 0;
    if (!ctxq) { if (p.window) { lat_k0 = qb * 256 - 128; if (lat_k0 < 0) lat_k0 = 0; lat_k1 = qb * 256 + 384; if (lat_k1 > SEQ) lat_k1 = SEQ; } else { lat_k0 = 0; lat_k1 = SEQ; } }
    const int ntiles = 4 + (lat_k1 - lat_k0) / 64;
    const int qrow = q0 + wid * 32 + r32;
    const int qpos = qb * 256 + wid * 32 + r32;
    LAS float* wsf = (LAS float*)(lds + WSF) + wid * 64;
    bf16x8 qr[NS];
#pragma unroll
    for (int s = 0; s < NS; ++s) qr[s] = *(const bf16x8*)(p.Q + (size_t)qrow * p.qld + h * p.qhs + 16 * s + 8 * hi);
    const int k1off = (h / p.kvgroup) * p.k1hs, voff = (h / p.kvgroup) * p.vhs;
    const int kc0 = tid >> 6, krow = tid & 63; const bool k2nd = (NCH > 8) && (tid < (NCH - 8) * 64); const int kc1 = 8 + (tid >> 6);
    const int vdh = tid >> 8, vrow = (tid & 255) >> 2, vpp = tid & 3;
    u32x4 sk0, sk1, sv;
    sk1 = (u32x4){0u, 0u, 0u, 0u};
#define AT_LOAD(it_) do { const bool lat_ = (it_) >= 4; const int kr0_ = rb + (lat_ ? lat_k0 + 64 * ((it_) - 4) : SEQ + 64 * (it_)); \
        sk0 = *(const u32x4*)(p.K1 + (size_t)(kr0_ + krow) * p.k1ld + k1off + kc0 * 8); \
        if (k2nd) sk1 = *(const u32x4*)(p.K2 + (size_t)(kr0_ + krow) * p.k2ld + (kc1 - 8) * 8); \
        sv = *(const u32x4*)(p.V + (size_t)(kr0_ + vrow) * p.vld + voff + vdh * 32 + vpp * 8); } while (0)
#define AT_STORE(buf_) do { *(LAS u32x4*)(lds + KB + (buf_) * 12288 + kc0 * 1024 + krow * 16) = sk0; \
        if (k2nd) *(LAS u32x4*)(lds + KB + (buf_) * 12288 + kc1 * 1024 + krow * 16) = sk1; \
        *(LAS u32x4*)(lds + VB + (buf_) * 8192 + vdh * 4096 + vrow * 64 + vpp * 16) = sv; } while (0)
    f32x16 o0, o1, negm;
#pragma unroll
    for (int r = 0; r < 16; ++r) { o0[r] = 0.f; o1[r] = 0.f; negm[r] = 0.f; }
    float m = 0.f, l = 0.f;
    const int vlane = ((lane >> 4) & 1) * 32 + (lane & 3) * 8 + (4 * hi + ((lane & 15) >> 2)) * 64;
    __syncthreads();
    AT_LOAD(0); AT_STORE(0);
    __syncthreads();
    for (int it = 0; it < ntiles; ++it) {
        const int cur = it & 1; const bool more = it + 1 < ntiles;
        if (more) AT_LOAD(it + 1);
        const LAS char* ldsK = lds + KB + cur * 12288; const LAS char* vbase = lds + VB + cur * 8192 + vlane;
        f32x16 c0 = negm, c1 = negm;
#pragma unroll
        for (int s = 0; s < NS; ++s) {
            const bf16x8 k0 = *(const LAS bf16x8*)(ldsK + (2 * s + hi) * 1024 + r32 * 16);
            const bf16x8 k1 = *(const LAS bf16x8*)(ldsK + (2 * s + hi) * 1024 + 512 + r32 * 16);
            c0 = MFMA32(k0, qr[s], c0); c1 = MFMA32(k1, qr[s], c1);
        }
        if (p.window && it >= 4) { const int kpos0 = lat_k0 + 64 * (it - 4);
#pragma unroll
            for (int r = 0; r < 16; ++r) { const int kp = kpos0 + crow(r, hi); int d0 = qpos - kp; if (d0 < 0) d0 = -d0; int d1 = qpos - (kp + 32); if (d1 < 0) d1 = -d1;
                if (d0 > p.window) c0[r] = -1e30f; if (d1 > p.window) c1[r] = -1e30f; } }
        float mx = fmaxf(fmaxf(c0[0], c0[1]), c1[0]);
#pragma unroll
        for (int r = 2; r < 16; r += 2) mx = fmaxf(fmaxf(mx, c0[r]), c0[r + 1]);
#pragma unroll
        for (int r = 1; r < 15; r += 2) mx = fmaxf(fmaxf(mx, c1[r]), c1[r + 1]);
        mx = fmaxf(mx, c1[15]);
        mx = fmaxf(mx, __shfl_xor(mx, 32));
        if (it == 0 || __any(mx > THR)) {
            const float dl = it == 0 ? mx : fmaxf(mx, 0.f);
            m += dl; const float alpha = __builtin_amdgcn_exp2f(-dl); l *= alpha;
#pragma unroll
            for (int r = 0; r < 16; ++r) { c0[r] -= dl; c1[r] -= dl; negm[r] = -m; }
            if (hi == 0) wsf[r32] = alpha;
#pragma unroll
            for (int r = 0; r < 16; ++r) { const float f = wsf[crow(r, hi)]; o0[r] *= f; o1[r] *= f; }
        }
        float rs = 0.f;
#pragma unroll
        for (int r = 0; r < 16; ++r) { c0[r] = __builtin_amdgcn_exp2f(c0[r]); c1[r] = __builtin_amdgcn_exp2f(c1[r]); rs += c0[r] + c1[r]; }
        l += rs;
        u32x4 pw[4];
        pw[0] = (u32x4){cvtpk(c0[0], c0[1]), cvtpk(c0[2], c0[3]), cvtpk(c0[4], c0[5]), cvtpk(c0[6], c0[7])};
        pw[1] = (u32x4){cvtpk(c0[8], c0[9]), cvtpk(c0[10], c0[11]), cvtpk(c0[12], c0[13]), cvtpk(c0[14], c0[15])};
        pw[2] = (u32x4){cvtpk(c1[0], c1[1]), cvtpk(c1[2], c1[3]), cvtpk(c1[4], c1[5]), cvtpk(c1[6], c1[7])};
        pw[3] = (u32x4){cvtpk(c1[8], c1[9]), cvtpk(c1[10], c1[11]), cvtpk(c1[12], c1[13]), cvtpk(c1[14], c1[15])};
#pragma unroll
        for (int s = 0; s < 4; ++s) {
            const s16x4 a0 = vtr(vbase + s * 1024), a1 = vtr(vbase + s * 1024 + 512);
            const s16x4 b0 = vtr(vbase + 4096 + s * 1024), b1 = vtr(vbase + 4096 + s * 1024 + 512);
            const bf16x8 v0 = (bf16x8){a0[0], a0[1], a0[2], a0[3], a1[0], a1[1], a1[2], a1[3]};
            const bf16x8 v1 = (bf16x8){b0[0], b0[1], b0[2], b0[3], b1[0], b1[1], b1[2], b1[3]};
            const bf16x8 pa = __builtin_bit_cast(bf16x8, pw[s]);
            o0 = MFMA32(pa, v0, o0); o1 = MFMA32(pa, v1, o1);
        }
        if (more) AT_STORE(cur ^ 1);
        __syncthreads();
    }
#undef AT_LOAD
#undef AT_STORE
    float lt = l + __shfl_xor(l, 32);
    float fin = 1.f;
    if (p.sink) { const float sk = p.sink[h] * LOG2E; const float m2 = fmaxf(m, sk); fin = __builtin_amdgcn_exp2f(m - m2); lt = lt * fin + __builtin_amdgcn_exp2f(sk - m2); }
    const float sc = fin / lt;
    if (hi == 0) wsf[r32] = sc;
    bf16_t* Ob = p.O + (size_t)(q0 + wid * 32) * p.old + h * p.ohs + r32;
#pragma unroll
    for (int r = 0; r < 16; ++r) { const int qr_ = crow(r, hi); const float f = wsf[qr_];
        if (!nostore) { Ob[(size_t)qr_ * p.old] = f2bf(o0[r] * f); Ob[(size_t)qr_ * p.old + 32] = f2bf(o1[r] * f); } }
}

namespace gp {
constexpr int BM = 256, BK = 64, HALF = 128, HTB = HALF * BK * 2, STAGE_BYTES = 8 * HTB, NXCD = 8, WGM = 8;
__host__ __device__ __forceinline__ int lds_byte(int r, int c) { const int st = (r >> 4) * 2 + (c >> 5), rr = r & 15, cc = c & 31, ob = rr * 64 + cc * 2; return st * 1024 + (ob ^ (((ob >> 9) & 1) << 5)); }
__host__ __device__ __forceinline__ void stage_rc(int b, int& R, int& C) { const int st = b / 1024, sb = b % 1024, swz = sb ^ (((sb >> 9) & 1) << 5); R = (st >> 1) * 16 + swz / 64; C = (st & 1) * 32 + (swz % 64) / 2; }
__host__ __device__ __forceinline__ int perm32(int rho) { const int n = rho >> 4, i = rho & 15; return 8 * (i >> 2) + 4 * n + (i & 3); }

struct GUnit { const char* A; const char* B; int nt, pm, pn, tag; const unsigned* goff; };

__device__ __forceinline__ bool tile_order(int i, int G_, int c, int nM, int nN, int& pm, int& pn) {
    const int nwg = nM * nN; const long L = (long)i * G_ + c; if (L >= nwg) return false;
    int wgid = (int)L; { const int q = nwg / NXCD, r = nwg % NXCD, xcd = wgid % NXCD, off = wgid / NXCD; wgid = (xcd < r ? xcd * (q + 1) : r * (q + 1) + (xcd - r) * q) + off; }
    const int nig = WGM * nN, gid = wgid / nig, fm = gid * WGM, gsz = (nM - fm) < WGM ? (nM - fm) : WGM;
    pm = fm + ((wgid % nig) % gsz); pn = (wgid % nig) / gsz; return true;
}
__device__ __forceinline__ unsigned cvt_pk_bf16(float lo, float hi) { return pkbf(lo, hi); }

template <class Epi, class Sched>
__device__ __forceinline__ void gemm_phase(LAS unsigned char* lds, const Sched& S, const Epi& E) {
    constexpr bool GATHER = Sched::GATHER;
    const int tid = opaque_tid(), wid = __builtin_amdgcn_readfirstlane(tid >> 6), lane = tid & 63, wr = wid >> 2, wc = wid & 3, fr = lane & 15, fq = lane >> 4;
    const int lda2 = S.lda2, ldb2 = S.ldb2;
    unsigned voffA[2], voffB[2], rowA[2];
#pragma unroll
    for (int i = 0; i < 2; ++i) { int R, C; stage_rc(tid * 16 + i * 8192, R, C); const int Rb = Epi::PERM ? ((R & ~31) + perm32(R & 31)) : R;
        voffA[i] = GATHER ? (unsigned)C * 2u : (unsigned)R * (unsigned)lda2 + (unsigned)C * 2u; rowA[i] = (unsigned)R; voffB[i] = (unsigned)Rb * (unsigned)ldb2 + (unsigned)C * 2u; }
    const size_t hA = GATHER ? 0 : (size_t)HALF * lda2, hB = (size_t)HALF * ldb2;
    const unsigned ldsw = (unsigned)wid * 1024u;
    const int aoff = lds_byte(wr * 64 + fr, fq * 8), boff = lds_byte(wc * 32 + fr, fq * 8);
    constexpr size_t kstep = (size_t)(BK * 2);
#define GP_SA(b, h) (((b) * 2 + (h)) * HTB)
#define GP_SB(b, h) ((4 + (b) * 2 + (h)) * HTB)
#define GP_STAGE(bufoff, gbase, v0, v1) do { \
        __builtin_amdgcn_global_load_lds((const unsigned*)((const char*)(gbase) + (v0)), (LAS unsigned*)(lds + (bufoff) + ldsw), 16, 0, 0); \
        __builtin_amdgcn_global_load_lds((const unsigned*)((const char*)(gbase) + (v1)), (LAS unsigned*)(lds + (bufoff) + ldsw + 8192), 16, 0, 0); } while (0)
#define GP_LDA(dst, b, h) do { _Pragma("unroll") for (int m = 0; m < 4; ++m) _Pragma("unroll") for (int k = 0; k < 2; ++k) dst[m][k] = *(const LAS bf16x8*)(lds + GP_SA(b, h) + aoff + m * 2048 + k * 1024); } while (0)
#define GP_LDB(dst, b, h) do { _Pragma("unroll") for (int n = 0; n < 2; ++n) _Pragma("unroll") for (int k = 0; k < 2; ++k) dst[n][k] = *(const LAS bf16x8*)(lds + GP_SB(b, h) + boff + n * 2048 + k * 1024); } while (0)
#define GP_MMA(ai, bj, At, Bt) do { __builtin_amdgcn_s_setprio(1); _Pragma("unroll") for (int m = 0; m < 4; ++m) _Pragma("unroll") for (int n = 0; n < 2; ++n) _Pragma("unroll") for (int k = 0; k < 2; ++k) \
        acc[ai][bj][m][n] = __builtin_amdgcn_mfma_f32_16x16x32_bf16(Bt[n][k], At[m][k], acc[ai][bj][m][n], 0, 0, 0); __builtin_amdgcn_s_setprio(0); } while (0)
#define GP_WAIT_V(n) asm volatile("s_waitcnt vmcnt(" #n ")" ::: "memory")
#define GP_WAIT_L(n) asm volatile("s_waitcnt lgkmcnt(" #n ")" ::: "memory")
#define GP_BAR __builtin_amdgcn_s_barrier()
#define GP_SCHED __builtin_amdgcn_sched_barrier(0)
#define GP_GOFF(U, o0, o1, p0, p1) do { if (GATHER) { o0 = (U).goff[rowA[0]] + voffA[0]; o1 = (U).goff[rowA[1]] + voffA[1]; p0 = (U).goff[128 + rowA[0]] + voffA[0]; p1 = (U).goff[128 + rowA[1]] + voffA[1]; } \
        else { o0 = voffA[0]; o1 = voffA[1]; p0 = voffA[0]; p1 = voffA[1]; } } while (0)
    GUnit cur, nxt; int ui = 0;
    if (!S.next(0, cur)) return;
    f32x4 acc[2][2][4][2];
#pragma unroll
    for (int a = 0; a < 2; ++a)
#pragma unroll
        for (int b = 0; b < 2; ++b)
#pragma unroll
            for (int m = 0; m < 4; ++m)
#pragma unroll
                for (int n = 0; n < 2; ++n) acc[a][b][m][n] = (f32x4){0.f, 0.f, 0.f, 0.f};
    bf16x8 At[4][2], B0[2][2], B1[2][2];
    unsigned g00, g01, g10, g11;
    GP_GOFF(cur, g00, g01, g10, g11);
    const char* cA = cur.A; const char* cB = cur.B;
    GP_STAGE(GP_SB(0, 0), cB, voffB[0], voffB[1]); GP_STAGE(GP_SA(0, 0), cA, g00, g01); GP_STAGE(GP_SB(0, 1), cB + hB, voffB[0], voffB[1]); GP_STAGE(GP_SA(0, 1), cA + hA, g10, g11);
    if (wr == 1) GP_BAR;
    GP_WAIT_V(4); GP_BAR;
    GP_STAGE(GP_SB(1, 0), cB + kstep, voffB[0], voffB[1]); GP_STAGE(GP_SA(1, 0), cA + kstep, g00, g01); GP_STAGE(GP_SB(1, 1), cB + hB + kstep, voffB[0], voffB[1]);
    GP_WAIT_V(6); GP_BAR;
    for (;;) {
        const bool has_next = S.next(ui + 1, nxt);
        const char* nA = has_next ? nxt.A : cA; const char* nB = has_next ? nxt.B : cB;
        const int nt = cur.nt;
        for (int t = 0; t < nt; t += 2) {
            const bool last = (t == nt - 2);
            const char* a1 = cA + (size_t)(t + 1) * kstep;
            const char* a2 = last ? nA : cA + (size_t)(t + 2) * kstep; const char* b2 = last ? nB : cB + (size_t)(t + 2) * kstep;
            const char* a3 = a2 + kstep; const char* b3 = b2 + kstep;
            unsigned w00 = g00, w01 = g01, w10 = g10, w11 = g11;
            if (GATHER && last && has_next) { GP_GOFF(nxt, w00, w01, w10, w11); }
            GP_LDB(B0, 0, 0); GP_SCHED; GP_LDA(At, 0, 0); GP_STAGE(GP_SA(1, 1), a1 + hA, g10, g11);
            GP_WAIT_L(8); GP_BAR; GP_WAIT_L(0); GP_MMA(0, 0, At, B0); GP_BAR; GP_SCHED;
            GP_LDB(B1, 0, 1); GP_STAGE(GP_SB(0, 0), b2, voffB[0], voffB[1]);
            GP_BAR; GP_WAIT_L(0); GP_MMA(0, 1, At, B1); GP_BAR;
            GP_LDA(At, 0, 1); GP_STAGE(GP_SA(0, 0), a2, w00, w01);
            GP_BAR; GP_WAIT_L(0); GP_MMA(1, 0, At, B0); GP_BAR; GP_SCHED;
            GP_STAGE(GP_SB(0, 1), b2 + hB, voffB[0], voffB[1]);
            GP_WAIT_V(6); GP_BAR; GP_MMA(1, 1, At, B1); GP_BAR;
            GP_LDB(B0, 1, 0); GP_SCHED; GP_LDA(At, 1, 0); GP_STAGE(GP_SA(0, 1), a2 + hA, w10, w11);
            GP_WAIT_L(8); GP_BAR; GP_WAIT_L(0); GP_MMA(0, 0, At, B0); GP_BAR; GP_SCHED;
            GP_LDB(B1, 1, 1); GP_STAGE(GP_SB(1, 0), b3, voffB[0], voffB[1]);
            GP_BAR; GP_WAIT_L(0); GP_MMA(0, 1, At, B1); GP_BAR;
            GP_LDA(At, 1, 1); GP_STAGE(GP_SA(1, 0), a3, w00, w01);
            GP_BAR; GP_WAIT_L(0); GP_MMA(1, 0, At, B0); GP_BAR; GP_SCHED;
            GP_STAGE(GP_SB(1, 1), b3 + hB, voffB[0], voffB[1]);
            GP_WAIT_V(6); GP_BAR; GP_MMA(1, 1, At, B1); GP_BAR;
            if (GATHER && last) { g00 = w00; g01 = w01; g10 = w10; g11 = w11; }
        }
        { int fr_e = fr, fq_e = fq; asm volatile("" : "+v"(fr_e), "+v"(fq_e));
          E(acc, cur, wr, wc, fr_e, fq_e); }
        if (!has_next) break;
#pragma unroll
        for (int a = 0; a < 2; ++a)
#pragma unroll
            for (int b = 0; b < 2; ++b)
#pragma unroll
                for (int m = 0; m < 4; ++m)
#pragma unroll
                    for (int n = 0; n < 2; ++n) acc[a][b][m][n] = (f32x4){0.f, 0.f, 0.f, 0.f};
        cur = nxt; cA = nA; cB = nB; ++ui;
    }
    GP_WAIT_V(0);
    if (wr == 0) GP_BAR;
    GP_BAR;
#undef GP_SA
#undef GP_SB
#undef GP_STAGE
#undef GP_LDA
#undef GP_LDB
#undef GP_MMA
#undef GP_WAIT_V
#undef GP_WAIT_L
#undef GP_BAR
#undef GP_SCHED
#undef GP_GOFF
}
}

struct SchedStd {
    static constexpr bool GATHER = false;
    const bf16_t* A; const bf16_t* Bt; int K, nM, nN, G_, c, skipctx, lda2, ldb2;
    __device__ __forceinline__ bool next(int i, gp::GUnit& u) const {
        int pmv, pn; if (!gp::tile_order(i, G_, c, nM, nN, pmv, pn)) return false;
        const int pm = skipctx ? pmv + pmv / 32 : pmv;
        u.A = (const char*)(A + (size_t)pm * 256 * K); u.B = (const char*)(Bt + (size_t)pn * 256 * K); u.nt = K / 64; u.pm = pm; u.pn = pn; u.tag = 0; u.goff = nullptr; return true;
    }
};

__device__ __forceinline__ float fexp(float x) { return __builtin_amdgcn_exp2f(x * LOG2E); }
__device__ __forceinline__ float flog(float x) { return __builtin_amdgcn_logf(x) * 0.6931471805599453f; }
__device__ __forceinline__ float fsigmoid(float x) { return __builtin_amdgcn_rcpf(1.f + fexp(-x)); }
__device__ __forceinline__ float logf_gate_fast(float z, float lb) {
    if (lb <= 0.f) return fminf(z, 0.f) - flog(1.f + fexp(-fabsf(z)));
    return flog(lb + (1.f - lb) * fsigmoid(z));
}
__device__ __forceinline__ unsigned pkh2(float lo, float hi) { const f16_t a = (f16_t)lo, b = (f16_t)hi; return (unsigned)__builtin_bit_cast(unsigned short, a) | ((unsigned)__builtin_bit_cast(unsigned short, b) << 16); }

template <class T> __device__ __forceinline__ T* opq(T* p) { asm volatile("" : "+s"(p)); return p; }
struct EpiG1 {
    static constexpr bool PERM = true;
    bf16_t *AQ, *AK, *AV, *BQ, *BV, *BG; f16_t *BLF, *BLB; bf16_t *CQKV, *CKR; float* RS; const float *ropa_c, *ropa_s, *ropc_c, *ropc_s; const float* LBl; int rowoff;
    __device__ __forceinline__ void operator()(const f32x4 (&acc)[2][2][4][2], const gp::GUnit& u, int wr, int wc, int fr, int fq) const {
        const int pn = u.pn; const int pr = u.pm % 33; const bool lat = pr < 32;
        const int grow0 = u.pm * 256 + wr * 64 + fr; const int t0 = pr * 256 + wr * 64 + fr;
        if (pn < 3) {
            const int hh = pn * 4 + wc; bf16_t* dst; int ld, coff; bf16_t* const aq_ = opq(AQ); bf16_t* const ak_ = opq(AK); bf16_t* const av_ = opq(AV);
            if (hh < 8) { dst = aq_; ld = 512; coff = hh * 64; } else if (hh < 10) { dst = ak_; ld = 128; coff = (hh - 8) * 64; } else { dst = av_; ld = 128; coff = (hh - 10) * 64; }
            const bool rope = lat && hh < 10;
#pragma unroll
            for (int ai = 0; ai < 2; ++ai)
#pragma unroll
                for (int m = 0; m < 4; ++m) { const int grow = grow0 + ai * 128 + m * 16, t = t0 + ai * 128 + m * 16; const size_t row = (size_t)(grow - rowoff);
                    f32x4 x1a = acc[ai][0][m][0], x1b = acc[ai][0][m][1], x2a = acc[ai][1][m][0], x2b = acc[ai][1][m][1];
                    if (rope) { const f32x4 ca = *(const f32x4*)(ropa_c + t * 32 + 8 * fq), cb = *(const f32x4*)(ropa_c + t * 32 + 8 * fq + 4), sa = *(const f32x4*)(ropa_s + t * 32 + 8 * fq), sb = *(const f32x4*)(ropa_s + t * 32 + 8 * fq + 4);
                        const f32x4 o1a = x1a * ca - x2a * sa, o2a = x1a * sa + x2a * ca, o1b = x1b * cb - x2b * sb, o2b = x1b * sb + x2b * cb; x1a = o1a; x2a = o2a; x1b = o1b; x2b = o2b; }
                    if (hh < 8) { const float qs = 0.125f * LOG2E; x1a *= qs; x1b *= qs; x2a *= qs; x2b *= qs; }
                    bf16_t* p = dst + row * ld + coff + 8 * fq;
                    u32x4 w1, w2; w1.x = gp::cvt_pk_bf16(x1a[0], x1a[1]); w1.y = gp::cvt_pk_bf16(x1a[2], x1a[3]); w1.z = gp::cvt_pk_bf16(x1b[0], x1b[1]); w1.w = gp::cvt_pk_bf16(x1b[2], x1b[3]);
                    w2.x = gp::cvt_pk_bf16(x2a[0], x2a[1]); w2.y = gp::cvt_pk_bf16(x2a[2], x2a[3]); w2.z = gp::cvt_pk_bf16(x2b[0], x2b[1]); w2.w = gp::cvt_pk_bf16(x2b[2], x2b[3]);
                    *(u32x4*)p = w1; *(u32x4*)(p + 32) = w2; asm volatile("" ::: "memory"); }
        } else if (pn < 13) {
            const int q = pn - 3, which = q >> 1; const int cb0 = (q & 1) * 256 + wc * 32 + 8 * fq;
            if (which == 2 || which == 3) {
                f16_t* const blf_ = opq(BLF); f16_t* const blb_ = opq(BLB); f16_t* dst = which == 2 ? blf_ : blb_; const float* lbp = LBl + (which == 2 ? 0 : 512);
#pragma unroll
                for (int bj = 0; bj < 2; ++bj) { const int c0 = cb0 + bj * 128; const f32x4 la = *(const f32x4*)(lbp + c0), lb4 = *(const f32x4*)(lbp + c0 + 4);
#pragma unroll
                    for (int ai = 0; ai < 2; ++ai)
#pragma unroll
                        for (int m = 0; m < 4; ++m) { const size_t row = (size_t)(grow0 + ai * 128 + m * 16 - rowoff); const f32x4 v0 = acc[ai][bj][m][0], v1 = acc[ai][bj][m][1];
                            u32x4 w; w.x = pkh2(logf_gate_fast(v0[0], la[0]), logf_gate_fast(v0[1], la[1])); w.y = pkh2(logf_gate_fast(v0[2], la[2]), logf_gate_fast(v0[3], la[3]));
                            w.z = pkh2(logf_gate_fast(v1[0], lb4[0]), logf_gate_fast(v1[1], lb4[1])); w.w = pkh2(logf_gate_fast(v1[2], lb4[2]), logf_gate_fast(v1[3], lb4[3]));
                            *(u32x4*)(dst + row * 512 + c0) = w; } }
            } else {
                bf16_t* const bq_ = opq(BQ); bf16_t* const bv_ = opq(BV); bf16_t* const bg_ = opq(BG); bf16_t* dst = which == 0 ? bq_ : (which == 1 ? bv_ : bg_);
#pragma unroll
                for (int ai = 0; ai < 2; ++ai)
#pragma unroll
                    for (int m = 0; m < 4; ++m) { const size_t row = (size_t)(grow0 + ai * 128 + m * 16 - rowoff);
#pragma unroll
                        for (int bj = 0; bj < 2; ++bj) { const f32x4 v0 = acc[ai][bj][m][0], v1 = acc[ai][bj][m][1];
                            u32x4 w; w.x = gp::cvt_pk_bf16(v0[0], v0[1]); w.y = gp::cvt_pk_bf16(v0[2], v0[3]); w.z = gp::cvt_pk_bf16(v1[0], v1[1]); w.w = gp::cvt_pk_bf16(v1[2], v1[3]);
                            *(u32x4*)(dst + row * 512 + cb0 + bj * 128) = w; } }
            }
        } else if (pn == 13) {
#pragma unroll
            for (int ai = 0; ai < 2; ++ai)
#pragma unroll
                for (int m = 0; m < 4; ++m) { const int grow = grow0 + ai * 128 + m * 16; const size_t row = (size_t)(grow - rowoff); float ss = 0.f;
#pragma unroll
                    for (int bj = 0; bj < 2; ++bj) { const f32x4 v0 = acc[ai][bj][m][0], v1 = acc[ai][bj][m][1];
                        ss += v0[0] * v0[0] + v0[1] * v0[1] + v0[2] * v0[2] + v0[3] * v0[3] + v1[0] * v1[0] + v1[1] * v1[1] + v1[2] * v1[2] + v1[3] * v1[3];
                        u32x4 w; w.x = gp::cvt_pk_bf16(v0[0], v0[1]); w.y = gp::cvt_pk_bf16(v0[2], v0[3]); w.z = gp::cvt_pk_bf16(v1[0], v1[1]); w.w = gp::cvt_pk_bf16(v1[2], v1[3]);
                        *(u32x4*)(CQKV + row * 384 + bj * 128 + wc * 32 + 8 * fq) = w; }
                    ss += __shfl_xor(ss, 16); ss += __shfl_xor(ss, 32);
                    if (fq == 0) RS[(size_t)grow * 8 + wc] = ss; }
        } else {
#pragma unroll
            for (int ai = 0; ai < 2; ++ai)
#pragma unroll
                for (int m = 0; m < 4; ++m) { const int grow = grow0 + ai * 128 + m * 16, t = t0 + ai * 128 + m * 16; const size_t row = (size_t)(grow - rowoff);
                    const f32x4 v0 = acc[ai][0][m][0], v1 = acc[ai][0][m][1];
                    float ss = v0[0] * v0[0] + v0[1] * v0[1] + v0[2] * v0[2] + v0[3] * v0[3] + v1[0] * v1[0] + v1[1] * v1[1] + v1[2] * v1[2] + v1[3] * v1[3];
                    u32x4 w; w.x = gp::cvt_pk_bf16(v0[0], v0[1]); w.y = gp::cvt_pk_bf16(v0[2], v0[3]); w.z = gp::cvt_pk_bf16(v1[0], v1[1]); w.w = gp::cvt_pk_bf16(v1[2], v1[3]);
                    *(u32x4*)(CQKV + row * 384 + 256 + wc * 32 + 8 * fq) = w;
                    ss += __shfl_xor(ss, 16); ss += __shfl_xor(ss, 32);
                    if (fq == 0) RS[(size_t)grow * 8 + 4 + wc] = ss;
                    if (wc == 0) { f32x4 x1 = acc[ai][1][m][0], x2 = acc[ai][1][m][1];
                        if (lat) { const f32x4 cc = *(const f32x4*)(ropc_c + t * 16 + 4 * fq), sn = *(const f32x4*)(ropc_s + t * 16 + 4 * fq); const f32x4 o1 = x1 * cc - x2 * sn, o2 = x1 * sn + x2 * cc; x1 = o1; x2 = o2; }
                        *(uint2*)(CKR + row * 32 + 4 * fq) = make_uint2(gp::cvt_pk_bf16(x1[0], x1[1]), gp::cvt_pk_bf16(x1[2], x1[3]));
                        *(uint2*)(CKR + row * 32 + 16 + 4 * fq) = make_uint2(gp::cvt_pk_bf16(x2[0], x2[1]), gp::cvt_pk_bf16(x2[2], x2[3])); } }
        }
    }
};

struct EpiC {
    static constexpr bool PERM = true;
    bf16_t *CQ, *CKV; const float* RS; const float *ropc_c, *ropc_s; int pmoff;
    __device__ __forceinline__ void operator()(const f32x4 (&acc)[2][2][4][2], const gp::GUnit& u, int wr, int wc, int fr, int fq) const {
        const int pn = u.pn; const int pr = (u.pm + pmoff) % 33; const bool lat = pr < 32;
        const int grow0 = u.pm * 256 + wr * 64 + fr; const int t0 = pr * 256 + wr * 64 + fr;
#pragma unroll
        for (int ai = 0; ai < 2; ++ai)
#pragma unroll
            for (int m = 0; m < 4; ++m) { const size_t row = (size_t)(grow0 + ai * 128 + m * 16); const int t = t0 + ai * 128 + m * 16;
                if (pn < 3) { const f32x4 p4 = *(const f32x4*)(RS + row * 8); const float rq = rsqrtf(((p4[0] + p4[1]) + (p4[2] + p4[3])) * (1.f / 256.f) + EPS) * (0.10206207261596577f * LOG2E);
#pragma unroll
                    for (int bj = 0; bj < 2; ++bj) { const int gi = pn * 8 + bj * 4 + wc, head = gi / 3, part = gi - head * 3;
                        f32x4 v0 = acc[ai][bj][m][0] * rq, v1 = acc[ai][bj][m][1] * rq;
                        bf16_t* p = CQ + row * 768 + head * 96;
                        if (part < 2) { u32x4 w; w.x = gp::cvt_pk_bf16(v0[0], v0[1]); w.y = gp::cvt_pk_bf16(v0[2], v0[3]); w.z = gp::cvt_pk_bf16(v1[0], v1[1]); w.w = gp::cvt_pk_bf16(v1[2], v1[3]);
                            *(u32x4*)(p + part * 32 + 8 * fq) = w; }
                        else { if (lat) { const f32x4 cc = *(const f32x4*)(ropc_c + t * 16 + 4 * fq), sn = *(const f32x4*)(ropc_s + t * 16 + 4 * fq); const f32x4 o1 = v0 * cc - v1 * sn, o2 = v0 * sn + v1 * cc; v0 = o1; v1 = o2; }
                            *(uint2*)(p + 64 + 4 * fq) = make_uint2(gp::cvt_pk_bf16(v0[0], v0[1]), gp::cvt_pk_bf16(v0[2], v0[3]));
                            *(uint2*)(p + 80 + 4 * fq) = make_uint2(gp::cvt_pk_bf16(v1[0], v1[1]), gp::cvt_pk_bf16(v1[2], v1[3])); } }
                } else { const f32x4 p4 = *(const f32x4*)(RS + row * 8 + 4); const float rkv = rsqrtf(((p4[0] + p4[1]) + (p4[2] + p4[3])) * (1.f / 128.f) + EPS);
#pragma unroll
                    for (int bj = 0; bj < 2; ++bj) { const f32x4 v0 = acc[ai][bj][m][0] * rkv, v1 = acc[ai][bj][m][1] * rkv;
                        u32x4 w; w.x = gp::cvt_pk_bf16(v0[0], v0[1]); w.y = gp::cvt_pk_bf16(v0[2], v0[3]); w.z = gp::cvt_pk_bf16(v1[0], v1[1]); w.w = gp::cvt_pk_bf16(v1[2], v1[3]);
                        *(u32x4*)(CKV + row * 1024 + (pn - 3) * 256 + bj * 128 + wc * 32 + 8 * fq) = w; } }
                asm volatile("" ::: "memory"); }
    }
};
struct EpiGate {
    static constexpr bool PERM = true;
    bf16_t* GATE; long nstride; int ld;
    __device__ __forceinline__ void operator()(const f32x4 (&acc)[2][2][4][2], const gp::GUnit& u, int wr, int wc, int fr, int fq) const {
        const int n3 = u.pn >> 2; bf16_t* base = GATE + (size_t)n3 * nstride + (u.pn & 3) * 256 + wc * 32 + 8 * fq; const int row0 = u.pm * 256 + wr * 64 + fr;
#pragma unroll
        for (int ai = 0; ai < 2; ++ai)
#pragma unroll
            for (int m = 0; m < 4; ++m) { bf16_t* rp = base + (size_t)(row0 + ai * 128 + m * 16) * ld;
#pragma unroll
                for (int bj = 0; bj < 2; ++bj) { const f32x4 v0 = acc[ai][bj][m][0], v1 = acc[ai][bj][m][1];
                    u32x4 w; w.x = gp::cvt_pk_bf16(fsigmoid(v0[0]), fsigmoid(v0[1])); w.y = gp::cvt_pk_bf16(fsigmoid(v0[2]), fsigmoid(v0[3])); w.z = gp::cvt_pk_bf16(fsigmoid(v1[0]), fsigmoid(v1[1])); w.w = gp::cvt_pk_bf16(fsigmoid(v1[2]), fsigmoid(v1[3]));
                    *(u32x4*)(rp + bj * 128) = w; } }
    }
};
struct SchedMerge {
    static constexpr bool GATHER = false;
    const bf16_t *A0, *A1, *A2; const bf16_t* Bt; int nM, G_, c, skipctx, lda2, ldb2;
    __device__ __forceinline__ bool next(int i, gp::GUnit& u) const {
        const int j = i / 3, n = i - 3 * j; int pmv, pn; if (!gp::tile_order(j, G_, c, nM, 4, pmv, pn)) return false;
        const int pm = skipctx ? pmv + pmv / 32 : pmv;
        const bf16_t* a0 = opq(A0); const bf16_t* a1 = opq(A1); const bf16_t* a2 = opq(A2);
        const bf16_t* a = n == 0 ? a0 : (n == 1 ? a1 : a2);
        u.A = (const char*)(a + (size_t)pm * 256 * 512); u.B = (const char*)(Bt + (size_t)n * 1024 * 512 + (size_t)pn * 256 * 512); u.nt = 8; u.pm = pm; u.pn = pn; u.tag = n; u.goff = nullptr; return true;
    }
};
__device__ __forceinline__ float bflo(unsigned w) { return __uint_as_float(w << 16); }
__device__ __forceinline__ float bfhi(unsigned w) { return __uint_as_float(w & 0xffff0000u); }
struct EpiMerge {
    static constexpr bool PERM = true;
    const bf16_t* GATE; long nstride; int ld; bf16_t* Y;
    __device__ __forceinline__ void operator()(const f32x4 (&acc)[2][2][4][2], const gp::GUnit& u, int wr, int wc, int fr, int fq) const {
        const int n3 = u.tag; const int col = u.pn * 256 + wc * 32 + 8 * fq; const bf16_t* gb = GATE + (size_t)n3 * nstride + col; const int row0 = u.pm * 256 + wr * 64 + fr;
#pragma unroll
        for (int ai = 0; ai < 2; ++ai)
#pragma unroll
            for (int m = 0; m < 4; ++m) { const size_t row = (size_t)(row0 + ai * 128 + m * 16);
#pragma unroll
                for (int bj = 0; bj < 2; ++bj) { const u32x4 g = *(const u32x4*)(gb + row * ld + bj * 128); u32x4* yp = (u32x4*)(Y + row * 1024 + col + bj * 128);
                    const f32x4 v0 = acc[ai][bj][m][0], v1 = acc[ai][bj][m][1];
                    float r[8] = {v0[0] * bflo(g.x), v0[1] * bfhi(g.x), v0[2] * bflo(g.y), v0[3] * bfhi(g.y), v1[0] * bflo(g.z), v1[1] * bfhi(g.z), v1[2] * bflo(g.w), v1[3] * bfhi(g.w)};
                    if (n3 != 0) { const u32x4 o = __builtin_nontemporal_load(yp);     r[0] += bflo(o.x); r[1] += bfhi(o.x); r[2] += bflo(o.y); r[3] += bfhi(o.y); r[4] += bflo(o.z); r[5] += bfhi(o.z); r[6] += bflo(o.w); r[7] += bfhi(o.w); }
                    u32x4 w; w.x = gp::cvt_pk_bf16(r[0], r[1]); w.y = gp::cvt_pk_bf16(r[2], r[3]); w.z = gp::cvt_pk_bf16(r[4], r[5]); w.w = gp::cvt_pk_bf16(r[6], r[7]);
                    *yp = w; }
                asm volatile("" ::: "memory"); }
    }
};
struct EpiOut {
    static constexpr bool PERM = false;
    const float *xl_src, *xc_src; float *xl_dst, *xc_dst; const float* mod; int pmoff;
    __device__ __forceinline__ void operator()(const f32x4 (&acc)[2][2][4][2], const gp::GUnit& u, int wr, int wc, int fr, int fq) const {
        const int gpm = u.pm + pmoff, b = gpm / 33, pr = gpm - b * 33; const bool lat = pr < 32;
        const float* xs = opq(lat ? xl_src : xc_src); float* xd = opq(lat ? xl_dst : xc_dst);
        const size_t rbase = lat ? ((size_t)b * SEQ + pr * 256) : ((size_t)b * CTXL);
        const float* gt = mod + (size_t)(lat ? b : 4) * 6144 + 2048; const int col0 = u.pn * 256 + wc * 32 + 4 * fq;
#pragma unroll
        for (int ai = 0; ai < 2; ++ai)
#pragma unroll
            for (int m = 0; m < 4; ++m) { const size_t off = (rbase + ai * 128 + wr * 64 + m * 16 + fr) * D + col0;
#pragma unroll
                for (int bj = 0; bj < 2; ++bj)
#pragma unroll
                    for (int n = 0; n < 2; ++n) { const int cc = bj * 128 + n * 16; const f32x4 g4 = *(const f32x4*)(gt + col0 + cc); const f32x4 xv = *(const f32x4*)(xs + off + cc);
                        *(f32x4*)(xd + off + cc) = xv + g4 * acc[ai][bj][m][n]; }
                asm volatile("" ::: "memory"); }
    }
};
template <bool GATHER_> struct SchedMoE {
    static constexpr bool GATHER = GATHER_;
    const bf16_t* A; const bf16_t* Bt; const int* tile_e; const unsigned* goff; int K, nM, nN, G_, c, lda2, ldb2; long strideB;
    __device__ __forceinline__ bool next(int i, gp::GUnit& u) const {
        int pm, pn; if (!gp::tile_order(i, G_, c, nM, nN, pm, pn)) return false;
        const int e = tile_e[pm];
        u.A = GATHER ? (const char*)A : (const char*)(A + (size_t)pm * 256 * K); u.B = (const char*)(Bt + (size_t)e * strideB + (size_t)pn * 256 * K); u.nt = K / 64; u.pm = pm; u.pn = pn; u.tag = e;
        u.goff = GATHER ? goff + (size_t)pm * 256 : nullptr; return true;
    }
};
struct EpiUp {
    static constexpr bool PERM = true;
    bf16_t* AUP;
    __device__ __forceinline__ void operator()(const f32x4 (&acc)[2][2][4][2], const gp::GUnit& u, int wr, int wc, int fr, int fq) const {
        const int row0 = u.pm * 256 + wr * 64 + fr; bf16_t* base = AUP + u.pn * 128 + wc * 32 + 8 * fq;
#pragma unroll
        for (int ai = 0; ai < 2; ++ai)
#pragma unroll
            for (int m = 0; m < 4; ++m) { const f32x4 a0 = acc[ai][0][m][0], a1 = acc[ai][0][m][1], b0 = acc[ai][1][m][0], b1 = acc[ai][1][m][1];
                float r[8];
#pragma unroll
                for (int e = 0; e < 4; ++e) { r[e] = a0[e] * fsigmoid(a0[e]) * b0[e]; r[4 + e] = a1[e] * fsigmoid(a1[e]) * b1[e]; }
                u32x4 w; w.x = gp::cvt_pk_bf16(r[0], r[1]); w.y = gp::cvt_pk_bf16(r[2], r[3]); w.z = gp::cvt_pk_bf16(r[4], r[5]); w.w = gp::cvt_pk_bf16(r[6], r[7]);
                *(u32x4*)(base + (size_t)(row0 + ai * 128 + m * 16) * 256) = w; }
    }
};
struct EpiDown {
    static constexpr bool PERM = true;
    bf16_t* YM2; const int* perm; const float* posw;
    __device__ __forceinline__ void operator()(const f32x4 (&acc)[2][2][4][2], const gp::GUnit& u, int wr, int wc, int fr, int fq) const {
        const int row0 = u.pm * 256 + wr * 64 + fr; const int col = u.pn * 256 + wc * 32 + 8 * fq;
#pragma unroll
        for (int ai = 0; ai < 2; ++ai)
#pragma unroll
            for (int m = 0; m < 4; ++m) { const int pos = row0 + ai * 128 + m * 16; const int pe = perm[pos]; const float w8 = posw[pos];
                if (pe >= 0) {
#pragma unroll
                    for (int bj = 0; bj < 2; ++bj) { const f32x4 v0 = acc[ai][bj][m][0] * w8, v1 = acc[ai][bj][m][1] * w8;
                        u32x4 w; w.x = gp::cvt_pk_bf16(v0[0], v0[1]); w.y = gp::cvt_pk_bf16(v0[2], v0[3]); w.z = gp::cvt_pk_bf16(v1[0], v1[1]); w.w = gp::cvt_pk_bf16(v1[2], v1[3]);
                        *(u32x4*)(YM2 + (size_t)pe * 1024 + col + bj * 128) = w; } } }
    }
};
enum { MAP_WIN = 1, MAP_WC = 2, MAP_WUP = 3 };
__device__ __forceinline__ int colmap(int kind, int p) {
    if (kind == MAP_WIN) {
        if (p >= 3840) return MIXW + (p - 3840);
        const int pn = p >> 8, q = p & 255, bj = q >> 7, wc = (q >> 5) & 3, j = q & 31;
        if (pn < 3) return (pn * 4 + wc) * 64 + bj * 32 + j;
        if (pn < 14) return p;
        if (bj == 0) return p;
        if (wc != 0) return -1;
        return 3712 + 16 * ((j >> 2) & 1) + 4 * (j >> 3) + (j & 3);
    }
    return p;
}
constexpr int NCHK = RPB / 64;
struct ScanArgs { const bf16_t* BQ; const bf16_t* BV; const bf16_t* BG; const f16_t* BLF; const f16_t* BLB; bf16_t* ST; float* DS; bf16_t* OB; const float* gn; int in_off; int out_off; int skipctx_out; int pad; };
#define MFMA16(a, b, c) __builtin_amdgcn_mfma_f32_16x16x32_bf16(a, b, c, 0, 0, 0)
constexpr int SC_RAW = 0, SC_VT = 32768, SC_A = SC_VT + 9216;
__device__ __forceinline__ void scan_stage(LAS char* lds, const ScanArgs& a, size_t row0, int h, int tid) {
    LAS float* RAW = (LAS float*)(lds + SC_RAW); LAS bf16_t* VT = (LAS bf16_t*)(lds + SC_VT);
    const int row = tid >> 3, c8 = (tid & 7) * 8; const size_t off = (row0 + row) * 512 + h * 64 + c8;
    typedef _Float16 h8 __attribute__((ext_vector_type(8)));
    const h8 lf = *(const h8*)(a.BLF + off), lb = *(const h8*)(a.BLB + off); const bf16x8 v = *(const bf16x8*)(a.BV + off);
#pragma unroll
    for (int j = 0; j < 8; ++j) { RAW[row * 64 + c8 + j] = (float)lf[j]; RAW[4096 + row * 64 + c8 + j] = (float)lb[j]; VT[(c8 + j) * 72 + row] = (bf16_t)v[j]; }
}
__device__ __forceinline__ void scan_cumsum(LAS char* lds, LAS float* XCH, int tid, float (&lf)[16], float (&bc)[16], float& total) {
    LAS float* RAW = (LAS float*)(lds + SC_RAW);
    const int col = tid & 127, dir = col >> 6, d = col & 63, seg = tid >> 7;
#pragma unroll
    for (int j = 0; j < 16; ++j) lf[j] = RAW[dir * 4096 + (16 * seg + j) * 64 + d];
    if (dir == 0) { float c = 0.f;
#pragma unroll
        for (int j = 0; j < 16; ++j) { c += lf[j]; bc[j] = c; } }
    else { float c = 0.f;
#pragma unroll
        for (int j = 15; j >= 0; --j) { c += lf[j]; bc[j] = c; } }
    XCH[seg * 128 + col] = dir == 0 ? bc[15] : bc[0];
    __syncthreads();
    const float t0 = XCH[col], t1 = XCH[128 + col], t2 = XCH[256 + col], t3 = XCH[384 + col];
    total = (t0 + t1) + (t2 + t3);
    float off;
    if (dir == 0) off = seg == 0 ? 0.f : (seg == 1 ? t0 : (seg == 2 ? t0 + t1 : t0 + t1 + t2));
    else off = seg == 3 ? 0.f : (seg == 2 ? t3 : (seg == 1 ? t3 + t2 : t3 + t2 + t1));
#pragma unroll
    for (int j = 0; j < 16; ++j) bc[j] += off;
}
__device__ __forceinline__ void scan_s1_unit(LAS char* lds, const ScanArgs& a, int b, int h, int k) {
    const int tid = opaque_tid(), lane = tid & 63, wid = tid >> 6;
    LAS bf16_t* VT = (LAS bf16_t*)(lds + SC_VT); LAS bf16_t* KKT = (LAS bf16_t*)(lds + SC_A); LAS float* XCH = (LAS float*)(lds + SC_A + 18432);
    const size_t row0 = (size_t)b * RPB + 64 * k - a.in_off;
    scan_stage(lds, a, row0, h, tid);
    __syncthreads();
    float lf[16], bc[16], total; scan_cumsum(lds, XCH, tid, lf, bc, total);
    const int col = tid & 127, dir = col >> 6, d = col & 63, seg = tid >> 7;
    const size_t sidx = ((size_t)((b * 8 + h) * 2 + dir)) * NCHK + k;
    { unsigned w[8];
#pragma unroll
      for (int j = 0; j < 16; j += 2) { const float k0 = (1.f - fexp(lf[j])) * fexp(total - bc[j]), k1 = (1.f - fexp(lf[j + 1])) * fexp(total - bc[j + 1]); w[j >> 1] = pkbf(k0, k1); }
      LAS u32x4* kp = (LAS u32x4*)(KKT + (dir * 64 + d) * 72 + 16 * seg); kp[0] = (u32x4){w[0], w[1], w[2], w[3]}; kp[1] = (u32x4){w[4], w[5], w[6], w[7]};
      if (seg == 0) a.DS[sidx * 64 + d] = fexp(total); }
    __syncthreads();
    { const int wdir = wid >> 2, et = wid & 3, fr = lane & 15, fq = lane >> 4;
      f32x4 acc[4];
#pragma unroll
      for (int dt = 0; dt < 4; ++dt) acc[dt] = (f32x4){0.f, 0.f, 0.f, 0.f};
#pragma unroll
      for (int ks = 0; ks < 2; ++ks) { const bf16x8 af = *(const LAS bf16x8*)(VT + (16 * et + fr) * 72 + 32 * ks + 8 * fq);
#pragma unroll
          for (int dt = 0; dt < 4; ++dt) { const bf16x8 bfv = *(const LAS bf16x8*)(KKT + (wdir * 64 + 16 * dt + fr) * 72 + 32 * ks + 8 * fq); acc[dt] = MFMA16(af, bfv, acc[dt]); } }
      bf16_t* sp = a.ST + (((size_t)((b * 8 + h) * 2 + wdir)) * NCHK + k) * 4096;
#pragma unroll
      for (int dt = 0; dt < 4; ++dt)
#pragma unroll
          for (int r = 0; r < 4; ++r) sp[(16 * et + 4 * fq + r) * 64 + 16 * dt + fr] = f2bf(acc[dt][r]); }
    __syncthreads();
}
__device__ __forceinline__ void scan_s2_task(const ScanArgs& a, int task) {
    const int chain = task >> 2, quarter = task & 3, dir = chain & 1, tid = opaque_tid();
    const int e = 16 * quarter + (tid >> 5), d = 2 * (tid & 31);
    float s0 = 0.f, s1 = 0.f;
    for (int g = 0; g < NCHK; g += 12) {
        unsigned L[12]; float2 Dv[12]; unsigned* pp[12];
#pragma unroll
        for (int j = 0; j < 12; ++j) { const int step = g + j; const int k = dir == 0 ? (step < 4 ? 128 + step : step - 4) : (step < 4 ? 131 - step : 131 - step);
            const size_t idx = (size_t)chain * NCHK + k; pp[j] = (unsigned*)(a.ST + idx * 4096 + e * 64 + d); L[j] = *pp[j]; Dv[j] = *(const float2*)(a.DS + idx * 64 + d); }
#pragma unroll
        for (int j = 0; j < 12; ++j) { *pp[j] = pkbf(s0, s1); s0 = Dv[j].x * s0 + bflo(L[j]); s1 = Dv[j].y * s1 + bfhi(L[j]); }
    }
}
__device__ __forceinline__ void scan_s3_unit(LAS char* lds, const ScanArgs& a, int b, int h, int k) {
    const int tid = opaque_tid(), lane = tid & 63, wid = tid >> 6;
    LAS float* BC = (LAS float*)(lds + SC_RAW); LAS bf16_t* VT = (LAS bf16_t*)(lds + SC_VT);
    LAS bf16_t* STL = (LAS bf16_t*)(lds + SC_A);
    LAS float* XCH = (LAS float*)(lds + SC_A + 18432);
    LAS float* OSUM = (LAS float*)(lds + SC_A + 18432 + 2048);
    LAS bf16_t* PW = (LAS bf16_t*)(lds + SC_A + 18432 + 2048 + 16384) + wid * 3456;
    const size_t row0 = (size_t)b * RPB + 64 * k - a.in_off;
    scan_stage(lds, a, row0, h, tid);
    { const int sd = tid >> 8, e = (tid & 255) >> 2, c16 = (tid & 3) * 16;
      const bf16_t* sp = a.ST + (((size_t)((b * 8 + h) * 2 + sd)) * NCHK + k) * 4096 + e * 64 + c16;
      const u32x4 s0 = *(const u32x4*)sp, s1 = *(const u32x4*)(sp + 8);
      LAS u32x4* dp = (LAS u32x4*)(STL + (sd * 64 + e) * 72 + c16); dp[0] = s0; dp[1] = s1; }
    __syncthreads();
    { float lf[16], bc[16], total; scan_cumsum(lds, XCH, tid, lf, bc, total);
      const int col = tid & 127, dir = col >> 6, d = col & 63, seg = tid >> 7;
      __syncthreads();
#pragma unroll
      for (int j = 0; j < 16; ++j) BC[dir * 4096 + (16 * seg + j) * 64 + d] = bc[j]; }
    __syncthreads();
    const int dir = wid >> 2, si = wid & 3;
    LAS bf16_t* QP = PW; LAS bf16_t* KP = PW + 1152; LAS bf16_t* ATT = PW + 2304;
    const int erow = lane >> 2, dg = (lane & 3) * 16;
    const int fr = lane & 15, fq = lane >> 4;
    LAS const float* bcd = BC + dir * 4096;
    float refv[16];
    { const int rr = dir == 0 ? 16 * si - 1 : 16 * (si + 1);
#pragma unroll
      for (int j = 0; j < 16; ++j) refv[j] = (rr >= 0 && rr < 64) ? bcd[rr * 64 + dg + j] : 0.f; }
    float qv[16], bq[16];
    { const bf16_t* qp = a.BQ + (row0 + 16 * si + erow) * 512 + h * 64 + dg; const bf16x8 q0 = *(const bf16x8*)qp, q1 = *(const bf16x8*)(qp + 8);
#pragma unroll
      for (int j = 0; j < 8; ++j) { qv[j] = bf2f((bf16_t)q0[j]); qv[8 + j] = bf2f((bf16_t)q1[j]); }
#pragma unroll
      for (int j = 0; j < 16; ++j) bq[j] = bcd[(16 * si + erow) * 64 + dg + j]; }
    { unsigned w[8];
#pragma unroll
      for (int j = 0; j < 16; j += 2) w[j >> 1] = pkbf(qv[j] * fexp(bq[j] - refv[j]), qv[j + 1] * fexp(bq[j + 1] - refv[j + 1]));
      LAS u32x4* p = (LAS u32x4*)(QP + erow * 72 + dg); p[0] = (u32x4){w[0], w[1], w[2], w[3]}; p[1] = (u32x4){w[4], w[5], w[6], w[7]};
      LAS u32x4* z = (LAS u32x4*)(ATT + erow * 72 + dg); z[0] = (u32x4){0u, 0u, 0u, 0u}; z[1] = (u32x4){0u, 0u, 0u, 0u}; }
    const int j_lo = dir == 0 ? 0 : si, j_hi = dir == 0 ? si : 3;
    for (int jb = j_lo; jb <= j_hi; ++jb) {
        { const int sg = 16 * jb + erow; const int sn = dir == 0 ? sg - 1 : sg + 1; unsigned w[8];
#pragma unroll
          for (int j = 0; j < 16; j += 2) { float kk[2];
#pragma unroll
              for (int t = 0; t < 2; ++t) { const float bs = bcd[sg * 64 + dg + j + t]; const float bn = (sn >= 0 && sn < 64) ? bcd[sn * 64 + dg + j + t] : 0.f;
                  kk[t] = (1.f - fexp(bs - bn)) * fexp(fminf(refv[j + t] - bs, 60.f)); }
              w[j >> 1] = pkbf(kk[0], kk[1]); }
          LAS u32x4* p = (LAS u32x4*)(KP + erow * 72 + dg); p[0] = (u32x4){w[0], w[1], w[2], w[3]}; p[1] = (u32x4){w[4], w[5], w[6], w[7]}; }
        __builtin_amdgcn_wave_barrier(); asm volatile("s_waitcnt lgkmcnt(0)" ::: "memory");
        f32x4 c = (f32x4){0.f, 0.f, 0.f, 0.f};
#pragma unroll
        for (int ks = 0; ks < 2; ++ks) { const bf16x8 af = *(const LAS bf16x8*)(QP + fr * 72 + 32 * ks + 8 * fq), bfv = *(const LAS bf16x8*)(KP + fr * 72 + 32 * ks + 8 * fq); c = MFMA16(af, bfv, c); }
#pragma unroll
        for (int r = 0; r < 4; ++r) { const int tq = 4 * fq + r; float v = c[r];
            if (jb == si) { if (dir == 0 ? (fr > tq) : (fr < tq)) v = 0.f; }
            ATT[tq * 72 + 16 * jb + fr] = f2bf(v); }
        __builtin_amdgcn_wave_barrier(); asm volatile("s_waitcnt lgkmcnt(0)" ::: "memory");
    }
    { unsigned w[8];
#pragma unroll
      for (int j = 0; j < 16; j += 2) w[j >> 1] = pkbf(qv[j] * fexp(bq[j]), qv[j + 1] * fexp(bq[j + 1]));
      LAS u32x4* p = (LAS u32x4*)(QP + erow * 72 + dg); p[0] = (u32x4){w[0], w[1], w[2], w[3]}; p[1] = (u32x4){w[4], w[5], w[6], w[7]}; }
    __builtin_amdgcn_wave_barrier(); asm volatile("s_waitcnt lgkmcnt(0)" ::: "memory");
    f32x4 o[4];
#pragma unroll
    for (int n = 0; n < 4; ++n) o[n] = (f32x4){0.f, 0.f, 0.f, 0.f};
#pragma unroll
    for (int ks = 0; ks < 2; ++ks) { const bf16x8 aq = *(const LAS bf16x8*)(QP + fr * 72 + 32 * ks + 8 * fq), aa = *(const LAS bf16x8*)(ATT + fr * 72 + 32 * ks + 8 * fq);
#pragma unroll
        for (int n = 0; n < 4; ++n) { const bf16x8 bs = *(const LAS bf16x8*)(STL + (dir * 64 + 16 * n + fr) * 72 + 32 * ks + 8 * fq), bv = *(const LAS bf16x8*)(VT + (16 * n + fr) * 72 + 32 * ks + 8 * fq);
            o[n] = MFMA16(aq, bs, o[n]); o[n] = MFMA16(aa, bv, o[n]); } }
    if (dir == 0) {
#pragma unroll
        for (int n = 0; n < 4; ++n)
#pragma unroll
            for (int r = 0; r < 4; ++r) OSUM[(16 * si + 4 * fq + r) * 64 + 16 * n + fr] = o[n][r]; }
    __syncthreads();
    if (dir == 1) {
        const bool wr_out = !(a.skipctx_out && k >= 128) && !a.pad;
        float ss[4] = {0.f, 0.f, 0.f, 0.f};
#pragma unroll
        for (int n = 0; n < 4; ++n)
#pragma unroll
            for (int r = 0; r < 4; ++r) { o[n][r] += OSUM[(16 * si + 4 * fq + r) * 64 + 16 * n + fr]; ss[r] += o[n][r] * o[n][r]; }
#pragma unroll
        for (int r = 0; r < 4; ++r) { ss[r] += __shfl_xor(ss[r], 1); ss[r] += __shfl_xor(ss[r], 2); ss[r] += __shfl_xor(ss[r], 4); ss[r] += __shfl_xor(ss[r], 8); ss[r] = rsqrtf(ss[r] * (1.f / 64.f) + EPS); }
        if (wr_out) {
            const size_t orow0 = (size_t)b * RPB + 64 * k - a.out_off;
#pragma unroll
            for (int n = 0; n < 4; ++n)
#pragma unroll
                for (int r = 0; r < 4; ++r) { const int tq = 16 * si + 4 * fq + r, e = 16 * n + fr; const float gv = bf2f(a.BG[(row0 + tq) * 512 + h * 64 + e]);
                    a.OB[(orow0 + tq) * 512 + h * 64 + e] = f2bf(o[n][r] * ss[r] * a.gn[h * 64 + e] * gv * fsigmoid(gv)); }
        }
    }
    __syncthreads();
}
constexpr int SCAN_LDS = SC_A + 18432 + 2048 + 16384 + 8 * 6912;

#define XB_TMO      128
#define XB_XCNT(j)  (256  + 64 * (j))
#define XB_XSUB(j)  (1280 + 64 * (j))
#define XB_XGEN(j)  (2304 + 64 * (j))
#define XB_TOP      3328
#define XB_TOPGEN   3392
#define XCD_BAR_WORDS 3456
#define XB_SPIN_CAP (1u << 18)

__device__ __forceinline__ unsigned xb_ld(unsigned* p)              { return __hip_atomic_load(p, __ATOMIC_RELAXED, __HIP_MEMORY_SCOPE_AGENT); }
__device__ __forceinline__ unsigned xb_add(unsigned* p, unsigned v) { return __hip_atomic_fetch_add(p, v, __ATOMIC_RELAXED, __HIP_MEMORY_SCOPE_AGENT); }
__device__ __forceinline__ unsigned xb_xcc_id() { return (unsigned)__builtin_amdgcn_s_getreg((3 << 11) | 20) & 0xFu; }
#define XB_SPIN(cond, bar) do { unsigned _sp = 0; while (cond) { __builtin_amdgcn_s_sleep(1); \
    if ((++_sp & 255u) == 0u) { if (xb_ld(&(bar)[XB_TMO])) break; if (_sp > XB_SPIN_CAP) { atomicAdd(&(bar)[XB_TMO], 1u); break; } } } } while (0)

struct XcdBarrier {
    unsigned* bar; unsigned x;
    volatile LAS unsigned* st;
};

__device__ __forceinline__ XcdBarrier xcd_barrier_post(unsigned* bar, volatile LAS unsigned* st) {
    XcdBarrier b; b.bar = bar; b.x = xb_xcc_id(); b.st = st;
    if (threadIdx.x == 0) (void)xb_add(&bar[XB_XCNT(b.x)], 1u);
    return b;
}
__device__ __forceinline__ void xcd_barrier_complete(unsigned* bar, unsigned x, unsigned& nloc, unsigned& nx) {
    const unsigned G = gridDim.x * gridDim.y * gridDim.z;
    unsigned sum, cnt, mine, sp = 0u;
    for (;;) {
        sum = 0u; cnt = 0u; mine = 0u;
#pragma unroll
        for (unsigned j = 0; j < 16; ++j) { const unsigned c = xb_ld(&bar[XB_XCNT(j)]); sum += c; cnt += (c > 0u) ? 1u : 0u; mine = (j == x) ? c : mine; }
        if (sum == G) break;
        __builtin_amdgcn_s_sleep(1);
        if ((++sp & 255u) == 0u) { if (xb_ld(&bar[XB_TMO])) break; if (sp > XB_SPIN_CAP) { atomicAdd(&bar[XB_TMO], 1u); break; } }
    }
    nloc = mine > 0u ? mine : 1u; nx = cnt > 0u ? cnt : 1u;
}

__device__ __forceinline__ void xcd_barrier(const XcdBarrier& b) {
    asm volatile("s_waitcnt vmcnt(0)" ::: "memory");
    __syncthreads();
    if (threadIdx.x == 0) {
        unsigned* bar = b.bar;
        __builtin_amdgcn_s_waitcnt(0);
        unsigned nloc = b.st[0], nx = b.st[1];
        if (nloc == 0u) { xcd_barrier_complete(bar, b.x, nloc, nx); b.st[0] = nloc; b.st[1] = nx; }
        const unsigned old = xb_add(&bar[XB_XSUB(b.x)], 1u);
        const unsigned gen = old / nloc;
        if (old + 1u == (gen + 1u) * nloc) {
            __builtin_amdgcn_fence(__ATOMIC_RELEASE, "agent");
            asm volatile("s_waitcnt vmcnt(0)" ::: "memory");
            const unsigned og = xb_add(&bar[XB_TOP], 1u);
            const unsigned tg = og / nx;
            if (og + 1u == (tg + 1u) * nx) xb_add(&bar[XB_TOPGEN], 1u);
            else XB_SPIN(xb_ld(&bar[XB_TOPGEN]) == tg, bar);
            __builtin_amdgcn_fence(__ATOMIC_ACQUIRE, "agent");
            xb_add(&bar[XB_XGEN(b.x)], 1u);
            asm volatile("s_waitcnt vmcnt(0)" ::: "memory");
        } else {
            XB_SPIN(xb_ld(&bar[XB_XGEN(b.x)]) == gen, bar);
            __builtin_amdgcn_fence(__ATOMIC_ACQUIRE, "agent");
            asm volatile("s_waitcnt vmcnt(0)" ::: "memory");
        }
    }
    __syncthreads();
}


constexpr size_t MiB = 1u << 20;
constexpr size_t CTL_ZERO_BYTES = 64 * 1024;
constexpr int CW_COUNTS = 8192, CW_CURSOR = 8192 + 128;
constexpr size_t O_MOD = 1 * MiB, O_LB = 1 * MiB + 512 * 1024, O_ROPA_C = 2 * MiB, O_ROPA_S = 3 * MiB, O_ROPC_C = 4 * MiB, O_ROPC_S = 4 * MiB + 512 * 1024, O_XC = 5 * MiB;
constexpr size_t O_ROUTE_E = 9 * MiB, O_ROUTE_W = 9 * MiB + 512 * 1024, O_PERM = 10 * MiB, O_POSW = 10 * MiB + 512 * 1024, O_GOFF = 11 * MiB, O_TILEE = 11 * MiB + 512 * 1024;
constexpr size_t O_RS = 12 * MiB, O_DS = 13 * MiB + 512 * 1024, O_WGH = 15 * MiB + 768 * 1024;
constexpr size_t O_WINP = 16 * MiB, O_WC = 30 * MiB, O_WBR = 32 * MiB, O_WOUT = 35 * MiB;
constexpr size_t O_H = 38 * MiB;
constexpr size_t O_AQ = 104 * MiB, O_AK = 137 * MiB, O_AV = 145 * MiB + 512 * 1024;
constexpr size_t O_BQ = 154 * MiB, O_BV = 187 * MiB, O_BG = 220 * MiB, O_BLF = 253 * MiB, O_BLB = 286 * MiB;
constexpr size_t O_CQKV = 319 * MiB, O_CKR = 344 * MiB, O_CQ = 347 * MiB, O_CKV = 397 * MiB, O_OC = 463 * MiB, WS_END = 496 * MiB;
constexpr size_t O_GATE = 187 * MiB;
constexpr size_t O_YM2 = 154 * MiB, O_AUP = 104 * MiB, O_WUP = 397 * MiB, O_WDN = 429 * MiB;
constexpr int LDS_BYTES = 163840, LDS_BAR_OFF = LDS_BYTES - 64, LDS_PTR_OFF = LDS_BYTES - 512;

struct KP { const float* in[24]; float* out; char* ws; int ph_lo, ph_hi; };
struct Frame {
    LAS char* lds; char* ws; float* out;
};
#define WSP(T, off) ((T*)(F.ws + (off)))
__device__ __forceinline__ const float* in_ptr(const Frame& F, int k) { const volatile LAS unsigned* q = (const volatile LAS unsigned*)(F.lds + LDS_PTR_OFF + 8 * k);
    unsigned lo = q[0], hi = q[1]; lo = __builtin_amdgcn_readfirstlane(lo); hi = __builtin_amdgcn_readfirstlane(hi); return (const float*)(((unsigned long long)hi << 32) | lo); }
#define INP(k) in_ptr(F, k)
__device__ __forceinline__ float wave_sum(float v) {
#pragma unroll
    for (int o = 32; o >= 1; o >>= 1) v += __shfl_xor(v, o);
    return v;
}

__device__ __forceinline__ void p0_mod(const Frame& F) {
    const int tid = opaque_tid(), lane = tid & 63, wave = __builtin_amdgcn_readfirstlane(tid >> 6); (void)lane; (void)wave;
    LAS float* sc = (LAS float*)F.lds;
    LAS float* red = (LAS float*)(F.lds + 20480);
    for (int i = tid; i < 5 * 1024; i += 512) { const int r = i >> 10, k = i & 1023; const float v = r < 4 ? INP(1)[r * 1024 + k] : INP(3)[k]; sc[i] = v / (1.f + expf(-v)); }
    __syncthreads();
    float* MOD = WSP(float, O_MOD);
    for (int u = blockIdx.x; u < 2 * 96; u += gridDim.x) { const int l = u / 96, j = (u % 96) * 64 + lane;
        const float* w = INP(4) + (size_t)l * 1024 * 6144 + j; float a0 = 0.f, a1 = 0.f, a2 = 0.f, a3 = 0.f, a4 = 0.f;
#pragma unroll 8
        for (int kk = 0; kk < 128; ++kk) { const int k = wave * 128 + kk; const float wv = w[(size_t)k * 6144]; a0 += sc[k] * wv; a1 += sc[1024 + k] * wv; a2 += sc[2048 + k] * wv; a3 += sc[3072 + k] * wv; a4 += sc[4096 + k] * wv; }
        red[(wave * 5 + 0) * 64 + lane] = a0; red[(wave * 5 + 1) * 64 + lane] = a1; red[(wave * 5 + 2) * 64 + lane] = a2; red[(wave * 5 + 3) * 64 + lane] = a3; red[(wave * 5 + 4) * 64 + lane] = a4;
        __syncthreads();
        if (tid < 320) { const int r = tid >> 6, ln = tid & 63; float s = 0.f;
#pragma unroll
            for (int w8 = 0; w8 < 8; ++w8) s += red[(w8 * 5 + r) * 64 + ln];
            const int jj = (u % 96) * 64 + ln; MOD[(size_t)(l * 5 + r) * 6144 + jj] = s + INP(5)[l * 6144 + jj]; }
        __syncthreads();
    }
}
__device__ __forceinline__ void p0_tables(const Frame& F) {
    const int tid = opaque_tid(), lane = tid & 63, wave = __builtin_amdgcn_readfirstlane(tid >> 6); (void)lane; (void)wave;
    float* ropa_c = WSP(float, O_ROPA_C); float* ropa_s = WSP(float, O_ROPA_S); float* ropc_c = WSP(float, O_ROPC_C); float* ropc_s = WSP(float, O_ROPC_S); float* LB = WSP(float, O_LB);
    for (int i = blockIdx.x * 512 + tid; i < 8192 * 32; i += gridDim.x * 512) {
        { const int t = i >> 5, j = i & 31, row = t >> 6, col = t & 63, f = j & 15; const float inv = powf(10000.f, -(float)f / 16.f); const float ang = (j < 16 ? (float)row : (float)col) * inv;
          ropa_c[i] = (float)cos((double)ang); ropa_s[i] = (float)sin((double)ang); }
        if (i < 8192 * 16) { const int t = i >> 4, j = i & 15, row = t >> 6, col = t & 63, f = j & 7; const float inv = powf(10000.f, -(float)f / 8.f); const float ang = (j < 8 ? (float)row : (float)col) * inv;
          ropc_c[i] = (float)cos((double)ang); ropc_s[i] = (float)sin((double)ang); }
        if (i < 2048) { const int l = i >> 10, rest = i & 1023; if (l == 0) LB[i] = 0.f; else { const float a0 = INP(10)[rest], a1 = INP(10)[1024 + rest]; LB[i] = 1.f / (1.f + expf(a0 - a1)); } }
    }
}
template <class CM> __device__ __forceinline__ void wt_tile(const float* W, int ldw, const CM& cm, bf16_t* Bt, int K, int p0, int k0, LAS float* scr, int lane) {
    const int tx = lane & 31, half = lane >> 5; const int c = cm(p0 + tx);
#pragma unroll 8
    for (int i = 0; i < 32; ++i) { const int kk = 2 * i + half; scr[kk * 33 + tx] = c >= 0 ? W[(size_t)(k0 + kk) * ldw + c] : 0.f; }
    asm volatile("s_waitcnt lgkmcnt(0)" ::: "memory"); __builtin_amdgcn_wave_barrier();
#pragma unroll 8
    for (int pi = 0; pi < 32; ++pi) Bt[(size_t)(p0 + pi) * K + k0 + lane] = f2bf(scr[lane * 33 + pi]);
    asm volatile("s_waitcnt lgkmcnt(0)" ::: "memory"); __builtin_amdgcn_wave_barrier();
}
struct CmWin { __device__ __forceinline__ int operator()(int p) const { return colmap(MAP_WIN, p); } };
struct CmId { __device__ __forceinline__ int operator()(int p) const { return p; } };
__device__ __forceinline__ void conv_weights_nonmoe(const Frame& F, int l) {
    const int tid = opaque_tid(), lane = tid & 63, wave = __builtin_amdgcn_readfirstlane(tid >> 6); (void)lane; (void)wave;
    LAS float* scr = (LAS float*)F.lds + wave * (64 * 33);
    const int gw = blockIdx.x * 8 + wave, NGW = gridDim.x * 8;
    constexpr int I_WIN = 216 * 16, I_BR = 3 * 32 * 8, I_OUT = 32 * 16;
    for (int it = gw; it < I_WIN + I_BR + I_OUT; it += NGW) {
        int r = it;
        if (r < I_WIN) { wt_tile(INP(8) + (size_t)l * 1024 * INW, INW, CmWin(), WSP(bf16_t, O_WINP), 1024, (r / 16) * 32, (r % 16) * 64, scr, lane); continue; } r -= I_WIN;
        if (r < I_BR) { const int n = r / 256, q = r % 256; wt_tile(INP(16) + ((size_t)l * 3 + n) * 512 * 1024, 1024, CmId(), WSP(bf16_t, O_WBR) + (size_t)n * 1024 * 512, 512, (q / 8) * 32, (q % 8) * 64, scr, lane); continue; } r -= I_BR;
        wt_tile(INP(17) + (size_t)l * 1024 * 1024, 1024, CmId(), WSP(bf16_t, O_WOUT), 1024, (r / 16) * 32, (r % 16) * 64, scr, lane);
    }
    const float* wuq = INP(14) + (size_t)l * 256 * 768; const float* wukv = INP(15) + (size_t)l * 128 * 1024; const float* gq = INP(12) + l * 256; const float* gkv = INP(13) + l * 128; bf16_t* WC = WSP(bf16_t, O_WC);
    for (int i = blockIdx.x * 512 + tid; i < 1792 * 384; i += gridDim.x * 512) {
        const int pp = i / 384, k = i % 384; float v = 0.f;
        if (pp < 768) { const int pn = pp >> 8, q = pp & 255, bj = q >> 7, wc = (q >> 5) & 3, j = q & 31; const int gi = pn * 8 + bj * 4 + wc, head = gi / 3, part = gi - head * 3;
            const int p = part < 2 ? head * 96 + part * 32 + j : head * 96 + 64 + 16 * ((j >> 2) & 1) + 4 * (j >> 3) + (j & 3);
            if (k < 256) v = wuq[k * 768 + p] * gq[k]; }
        else { if (k >= 256) v = wukv[(k - 256) * 1024 + (pp - 768)] * gkv[k - 256]; }
        WC[i] = f2bf(v); }
}
struct CmUp { __device__ __forceinline__ int operator()(int p) const { return ((p >> 8) << 7) + (p & 127); } };
__device__ __forceinline__ void conv_weights_moe(const Frame& F, int l) {
    const int tid = opaque_tid(), lane = tid & 63, wave = __builtin_amdgcn_readfirstlane(tid >> 6); (void)lane; (void)wave;
    LAS float* scr = (LAS float*)F.lds + wave * (64 * 33);
    const int gw = blockIdx.x * 8 + wave, NGW = gridDim.x * 8;
    constexpr int I_UP = 32 * 16 * 16, I_DN = 32 * 32 * 4;
    for (int it = gw; it < I_UP + I_DN; it += NGW) {
        int r = it;
        if (r < I_UP) { const int e = r / 256, q = r % 256, p0 = (q / 16) * 32, k0 = (q % 16) * 64; const bool isw3 = (p0 >> 7) & 1;
            const float* W = (isw3 ? INP(21) : INP(20)) + ((size_t)l * 32 + e) * 1024 * 256;
            wt_tile(W, 256, CmUp(), WSP(bf16_t, O_WUP) + (size_t)e * 512 * 1024, 1024, p0, k0, scr, lane); continue; } r -= I_UP;
        { const int e = r / 128, q = r % 128; wt_tile(INP(22) + ((size_t)l * 32 + e) * 256 * 1024, 1024, CmId(), WSP(bf16_t, O_WDN) + (size_t)e * 1024 * 256, 256, (q / 4) * 32, (q % 4) * 64, scr, lane); }
    }
}

__device__ __forceinline__ void rp_load(const float* xs, float* xd, bool wx, const bf16_t* ym, const float* gt, int lane, f32x4 (&v)[4], float& rinv) {
    float ss = 0.f;
#pragma unroll
    for (int j = 0; j < 4; ++j) { const int c = 4 * lane + 256 * j; v[j] = *(const f32x4*)(xs + c);
        if (ym) { const uint2 y0 = *(const uint2*)(ym + c), y1 = *(const uint2*)(ym + 1024 + c); const f32x4 g4 = *(const f32x4*)(gt + c);
            v[j][0] += g4[0] * (bflo(y0.x) + bflo(y1.x)); v[j][1] += g4[1] * (bfhi(y0.x) + bfhi(y1.x)); v[j][2] += g4[2] * (bflo(y0.y) + bflo(y1.y)); v[j][3] += g4[3] * (bfhi(y0.y) + bfhi(y1.y)); }
        if (wx) *(f32x4*)(xd + c) = v[j];
        ss += v[j][0] * v[j][0] + v[j][1] * v[j][1] + v[j][2] * v[j][2] + v[j][3] * v[j][3]; }
    rinv = rsqrtf(wave_sum(ss) * (1.f / D) + EPS);
}
__device__ __forceinline__ void rp_mod(const f32x4 (&v)[4], float rinv, const float* gn, const float* mo, int sh_off, int sc_off, bf16_t* hp, int lane, f32x4 (&hv)[4]) {
#pragma unroll
    for (int j = 0; j < 4; ++j) { const int c = 4 * lane + 256 * j; const f32x4 g4 = *(const f32x4*)(gn + c), s4 = *(const f32x4*)(mo + sc_off + c), h4 = *(const f32x4*)(mo + sh_off + c);
        hv[j] = v[j] * rinv * g4 * (s4 + 1.f) + h4;
        *(uint2*)(hp + c) = make_uint2(pkbf(hv[j][0], hv[j][1]), pkbf(hv[j][2], hv[j][3])); }
}
__device__ __forceinline__ void phase_rowpass1(const Frame& F, int l, bool combine) {
    const int tid = opaque_tid(), lane = tid & 63, wave = __builtin_amdgcn_readfirstlane(tid >> 6); (void)lane; (void)wave;
    const int gw = blockIdx.x * 8 + wave, NGW = gridDim.x * 8;
    const float* xl = (l == 0) ? INP(0) : F.out; const float* xc = (l == 0) ? INP(2) : WSP(float, O_XC);
    const float* MODl = WSP(float, O_MOD) + (size_t)l * 5 * 6144; const float* MODp = WSP(float, O_MOD);
    for (int g = gw; g < G; g += NGW) { const RowInfo ri = rowinfo(g); const int mrow = ri.lat ? ri.b : 4; const size_t xo = xoff(ri);
        const float* xs = (ri.lat ? xl : xc) + xo; float* xd = (ri.lat ? F.out : WSP(float, O_XC)) + xo;
        f32x4 v[4], hv[4]; float rinv;
        rp_load(xs, xd, combine, combine ? WSP(bf16_t, O_YM2) + (size_t)g * 2048 : nullptr, MODp + (size_t)mrow * 6144 + 5120, lane, v, rinv);
        rp_mod(v, rinv, INP(6) + l * 1024, MODl + (size_t)mrow * 6144, 0, 1024, WSP(bf16_t, O_H) + (size_t)g * D, lane, hv); }
}
__device__ __forceinline__ void phase_rowpass2(const Frame& F, int l, bool last) {
    const int tid = opaque_tid(), lane = tid & 63, wave = __builtin_amdgcn_readfirstlane(tid >> 6); (void)lane; (void)wave;
    LAS float* WT = (LAS float*)F.lds;
    { const float* wrg = INP(18) + (size_t)l * 1024 * 4; const float* wre = INP(19) + (size_t)l * 1024 * 32;
      for (int i = tid; i < 1024 * 4; i += 512) WT[(i & 3) * 1024 + (i >> 2)] = wrg[i];
      for (int i = tid; i < 1024 * 32; i += 512) WT[(4 + (i & 31)) * 1024 + (i >> 5)] = wre[i]; }
    { int* perm = WSP(int, O_PERM); unsigned* goff = WSP(unsigned, O_GOFF);
      for (int i = blockIdx.x * 512 + tid; i < PMAX; i += gridDim.x * 512) { perm[i] = -1; goff[i] = 0u; } }
    if (tid < 32) ((LAS int*)(F.lds + 147456))[tid] = 0;
    __syncthreads();
    const int gw = blockIdx.x * 8 + wave, NGW = gridDim.x * 8;
    const float* MODl = WSP(float, O_MOD) + (size_t)l * 5 * 6144;
    int* route_e = WSP(int, O_ROUTE_E); float* route_w = WSP(float, O_ROUTE_W); LAS int* hist = (LAS int*)(F.lds + 147456);
    for (int g = gw; g < G; g += NGW) { const RowInfo ri = rowinfo(g); if (last && !ri.lat) continue;
        const int mrow = ri.lat ? ri.b : 4; const size_t xo = xoff(ri);
        const float* xs = (ri.lat ? F.out : WSP(float, O_XC)) + xo;
        f32x4 v[4], hv[4]; float rinv;
        rp_load(xs, nullptr, false, nullptr, nullptr, lane, v, rinv);
        rp_mod(v, rinv, INP(7) + l * 1024, MODl + (size_t)mrow * 6144, 3072, 4096, WSP(bf16_t, O_H) + (size_t)g * D, lane, hv);
        float lg[36];
#pragma unroll
        for (int c = 0; c < 36; ++c) { float p = 0.f;
#pragma unroll
            for (int j = 0; j < 4; ++j) { const f32x4 w4 = *(const LAS f32x4*)(WT + c * 1024 + 4 * lane + 256 * j); p += hv[j][0] * w4[0] + hv[j][1] * w4[1] + hv[j][2] * w4[2] + hv[j][3] * w4[3]; }
            lg[c] = wave_sum(p); }
        int gs = 0; float gm = lg[0];
#pragma unroll
        for (int j = 1; j < 4; ++j) if (lg[j] > gm) { gm = lg[j]; gs = j; }
        float gsum = 0.f;
#pragma unroll
        for (int j = 0; j < 4; ++j) gsum += expf(lg[j] - gm);
        const float gwt = 1.f / gsum;
        int i0s = 0, i1s = 1; float m0s = 0.f, m1s = 0.f;
#pragma unroll
        for (int gi = 0; gi < 4; ++gi) { int i0 = 0; float m0 = lg[4 + gi * 8];
#pragma unroll
            for (int j = 1; j < 8; ++j) if (lg[4 + gi * 8 + j] > m0) { m0 = lg[4 + gi * 8 + j]; i0 = j; }
            int i1 = -1; float m1 = -3.4e38f;
#pragma unroll
            for (int j = 0; j < 8; ++j) if (j != i0 && lg[4 + gi * 8 + j] > m1) { m1 = lg[4 + gi * 8 + j]; i1 = j; }
            if (gi == gs) { i0s = i0; i1s = i1; m0s = m0; m1s = m1; } }
        const float p1 = expf(m1s - m0s); const float w0 = gwt / (1.f + p1), w1 = gwt * p1 / (1.f + p1);
        if (lane == 0) { const int e0 = gs * 8 + i0s, e1 = gs * 8 + i1s; route_e[g * 2] = e0; route_e[g * 2 + 1] = e1; route_w[g * 2] = w0; route_w[g * 2 + 1] = w1;
            __hip_atomic_fetch_add(hist + e0, 1, __ATOMIC_RELAXED, __HIP_MEMORY_SCOPE_WORKGROUP); __hip_atomic_fetch_add(hist + e1, 1, __ATOMIC_RELAXED, __HIP_MEMORY_SCOPE_WORKGROUP); }
    }
    __syncthreads();
    if (tid < 32) WSP(int, O_WGH)[((size_t)l * 256 + blockIdx.x) * 32 + tid] = hist[tid];
}
__device__ __forceinline__ void phase_final(const Frame& F) {
    const int tid = opaque_tid(), lane = tid & 63, wave = __builtin_amdgcn_readfirstlane(tid >> 6); (void)lane; (void)wave;
    const int gw = blockIdx.x * 8 + wave, NGW = gridDim.x * 8; const float* MOD1 = WSP(float, O_MOD) + (size_t)5 * 6144;
    for (int lr = gw; lr < NB * SEQ; lr += NGW) { const int b = lr / SEQ, t = lr - b * SEQ; const int g = b * RPB + t; float* xp = F.out + (size_t)lr * D;
        f32x4 v[4]; float rinv; rp_load(xp, nullptr, false, WSP(bf16_t, O_YM2) + (size_t)g * 2048, MOD1 + (size_t)b * 6144 + 5120, lane, v, rinv);
#pragma unroll
        for (int j = 0; j < 4; ++j) { const int c = 4 * lane + 256 * j; const f32x4 g4 = *(const f32x4*)(INP(23) + c); *(f32x4*)(xp + c) = v[j] * rinv * g4; } }
}
__device__ __forceinline__ void phase_moe_scatter(const Frame& F, int l, bool last) {
    const int tid = opaque_tid(), lane = tid & 63, wave = __builtin_amdgcn_readfirstlane(tid >> 6);
    LAS int* tot = (LAS int*)F.lds; LAS int* bef = tot + 512; LAS int* base = tot + 1024; LAS int* lcur = tot + 1056;
    const int* WGH = WSP(int, O_WGH) + (size_t)l * 256 * 32; const int nwg = gridDim.x, me = blockIdx.x;
    { const int e = tid & 31, part = tid >> 5; int sa = 0, sb = 0;
      for (int w = part * 16; w < part * 16 + 16 && w < nwg; ++w) { const int c = WGH[w * 32 + e]; sa += c; if (w < me) sb += c; }
      tot[part * 32 + e] = sa; bef[part * 32 + e] = sb; }
    __syncthreads();
    int sa2 = 0, sb2 = 0;
    if (tid < 32) {
#pragma unroll
        for (int part = 0; part < 16; ++part) { sa2 += tot[part * 32 + tid]; sb2 += bef[part * 32 + tid]; } }
    __syncthreads();
    if (tid < 32) { tot[tid] = sa2; bef[tid] = sb2; lcur[tid] = 0; }
    __syncthreads();
    if (tid == 0) { int o = 0; int* tile_e = WSP(int, O_TILEE);
#pragma clang loop unroll(disable) vectorize(disable)
        for (int e = 0; e < 32; ++e) { base[e] = o + bef[e]; const int n = (tot[e] + 255) & ~255;
            if (me == 0) {
#pragma clang loop unroll(disable) vectorize(disable)
                for (int t = o >> 8; t < (o + n) >> 8; ++t) tile_e[t] = e; }
            o += n; }
        if (me == 0) tile_e[NTILE] = o >> 8; }
    __syncthreads();
    const int* route_e = WSP(int, O_ROUTE_E); const float* route_w = WSP(float, O_ROUTE_W); int* perm = WSP(int, O_PERM); float* posw = WSP(float, O_POSW); unsigned* goff = WSP(unsigned, O_GOFF);
    const int gw = blockIdx.x * 8 + wave, NGW = gridDim.x * 8;
    for (int g = gw; g < G; g += NGW) { const RowInfo ri = rowinfo(g); if (last && !ri.lat) continue;
        if (lane < 2) { const int i = g * 2 + lane; const int e = route_e[i]; const int pos = base[e] + __hip_atomic_fetch_add(lcur + e, 1, __ATOMIC_RELAXED, __HIP_MEMORY_SCOPE_WORKGROUP);
            perm[pos] = i; posw[pos] = route_w[i]; goff[pos] = (unsigned)g * 2048u; } }
}

#ifndef PROBE_DUP
#define PROBE_DUP 0
#endif
#define DUP(bit) for (int rep_ = 0; rep_ < (((PROBE_DUP) >> (bit)) & 1) + 1; ++rep_)
__global__ void __launch_bounds__(512, 2) hybrid_trunk_fwd(KP p) {
    extern __shared__ __attribute__((aligned(16))) unsigned char dynlds[];
    Frame F; F.lds = (LAS char*)dynlds; F.ws = p.ws; F.out = p.out;
    if (threadIdx.x == 0) { LAS unsigned long long* pp = (LAS unsigned long long*)(F.lds + LDS_PTR_OFF);
        pp[0] = (unsigned long long)p.in[0];
        pp[1] = (unsigned long long)p.in[1];
        pp[2] = (unsigned long long)p.in[2];
        pp[3] = (unsigned long long)p.in[3];
        pp[4] = (unsigned long long)p.in[4];
        pp[5] = (unsigned long long)p.in[5];
        pp[6] = (unsigned long long)p.in[6];
        pp[7] = (unsigned long long)p.in[7];
        pp[8] = (unsigned long long)p.in[8];
        pp[9] = (unsigned long long)p.in[9];
        pp[10] = (unsigned long long)p.in[10];
        pp[11] = (unsigned long long)p.in[11];
        pp[12] = (unsigned long long)p.in[12];
        pp[13] = (unsigned long long)p.in[13];
        pp[14] = (unsigned long long)p.in[14];
        pp[15] = (unsigned long long)p.in[15];
        pp[16] = (unsigned long long)p.in[16];
        pp[17] = (unsigned long long)p.in[17];
        pp[18] = (unsigned long long)p.in[18];
        pp[19] = (unsigned long long)p.in[19];
        pp[20] = (unsigned long long)p.in[20];
        pp[21] = (unsigned long long)p.in[21];
        pp[22] = (unsigned long long)p.in[22];
        pp[23] = (unsigned long long)p.in[23];
    }
    LAS unsigned char* glds = (LAS unsigned char*)dynlds;
    volatile LAS unsigned* barst = (volatile LAS unsigned*)(F.lds + LDS_BAR_OFF);
    if (threadIdx.x < 16) ((LAS unsigned*)(F.lds + LDS_BAR_OFF))[threadIdx.x] = 0u;
    __syncthreads();
    const bool multi = (p.ph_hi - p.ph_lo) > 1;
    XcdBarrier bar; bar.bar = (unsigned*)F.ws; bar.x = 0; bar.st = nullptr;
    if (multi) bar = xcd_barrier_post((unsigned*)F.ws, barst);
    int ph = 0;
#define PH_BEGIN if (ph >= p.ph_lo && ph < p.ph_hi) {
#define PH_END   if (ph + 1 < p.ph_hi) xcd_barrier(bar); else __syncthreads(); } ++ph;
    const int Gd = gridDim.x, cb = blockIdx.x;

    PH_BEGIN p0_mod(F); p0_tables(F); __syncthreads(); conv_weights_nonmoe(F, 0); PH_END

    for (int l = 0; l < 2; ++l) {
        const bool last = (l == 1);
        const float* MODl = WSP(float, O_MOD) + (size_t)l * 5 * 6144;
        PH_BEGIN phase_rowpass1(F, l, l > 0); PH_END
        PH_BEGIN
        { SchedStd S{}; S.A = WSP(bf16_t, O_H); S.Bt = WSP(bf16_t, O_WINP); S.K = 1024; S.nM = 132; S.nN = 15; S.G_ = Gd; S.c = cb; S.skipctx = 0; S.lda2 = 2048; S.ldb2 = 2048;
          EpiG1 E{}; E.AQ = WSP(bf16_t, O_AQ); E.AK = WSP(bf16_t, O_AK); E.AV = WSP(bf16_t, O_AV); E.BQ = WSP(bf16_t, O_BQ); E.BV = WSP(bf16_t, O_BV); E.BG = WSP(bf16_t, O_BG); E.BLF = WSP(f16_t, O_BLF); E.BLB = WSP(f16_t, O_BLB);
          E.CQKV = WSP(bf16_t, O_CQKV); E.CKR = WSP(bf16_t, O_CKR); E.RS = WSP(float, O_RS); E.ropa_c = WSP(float, O_ROPA_C); E.ropa_s = WSP(float, O_ROPA_S); E.ropc_c = WSP(float, O_ROPC_C); E.ropc_s = WSP(float, O_ROPC_S);
          E.LBl = WSP(float, O_LB) + l * 1024; E.rowoff = 0;
          DUP(0) gp::gemm_phase<EpiG1, SchedStd>(glds, S, E); }
        PH_END
        PH_BEGIN
        { SchedStd S{}; S.A = WSP(bf16_t, O_CQKV); S.Bt = WSP(bf16_t, O_WC); S.K = 384; S.nM = 132; S.nN = 7; S.G_ = Gd; S.c = cb; S.skipctx = 0; S.lda2 = 768; S.ldb2 = 768;
          EpiC E{}; E.CQ = WSP(bf16_t, O_CQ); E.CKV = WSP(bf16_t, O_CKV); E.RS = WSP(float, O_RS); E.ropc_c = WSP(float, O_ROPC_C); E.ropc_s = WSP(float, O_ROPC_S); E.pmoff = 0;
          DUP(1) gp::gemm_phase<EpiC, SchedStd>(glds, S, E); }
        __syncthreads();
        { AttnArgs a{}; a.Q = WSP(bf16_t, O_AQ); a.qld = 512; a.qhs = 64; a.K1 = WSP(bf16_t, O_AK); a.k1ld = 128; a.k1hs = 64; a.kvgroup = 4; a.K2 = nullptr; a.k2ld = 0; a.V = WSP(bf16_t, O_AV); a.vld = 128; a.vhs = 64;
          a.O = WSP(bf16_t, O_AQ); a.old = 512; a.ohs = 64; a.scale_l2 = 0.125f * LOG2E; a.sink = INP(9) + l * 8; a.window = 128;
          const int nqb = last ? 32 : 33;
          DUP(10) for (int u = cb; u < NB * 8 * nqb; u += Gd) { const int b = u / (8 * nqb), rem = u - b * 8 * nqb, h = rem / nqb, qb = rem - h * nqb; attn_unit<64>(F.lds, a, b, qb, h, ((PROBE_DUP >> 10) & 1) && rep_ == 0); } }
        __syncthreads();
        { ScanArgs a{}; a.BQ = WSP(bf16_t, O_BQ); a.BV = WSP(bf16_t, O_BV); a.BG = WSP(bf16_t, O_BG); a.BLF = WSP(f16_t, O_BLF); a.BLB = WSP(f16_t, O_BLB); a.ST = WSP(bf16_t, O_H); a.DS = WSP(float, O_DS); a.OB = WSP(bf16_t, O_BQ); a.gn = INP(11) + l * 512;
          DUP(2) for (int u = cb; u < NB * 8 * NCHK; u += Gd) { const int b = u / (8 * NCHK), rem = u - b * 8 * NCHK, h = rem / NCHK, k = rem - h * NCHK; scan_s1_unit(F.lds, a, b, h, k); } }
        PH_END
        PH_BEGIN
        { ScanArgs a{}; a.ST = WSP(bf16_t, O_H); a.DS = WSP(float, O_DS);
          for (int t = cb; t < NB * 8 * 2 * 4; t += Gd) scan_s2_task(a, t); }
        { AttnArgs a{}; a.Q = WSP(bf16_t, O_CQ); a.qld = 768; a.qhs = 96; a.K1 = WSP(bf16_t, O_CKV); a.k1ld = 1024; a.k1hs = 128; a.kvgroup = 1; a.K2 = WSP(bf16_t, O_CKR); a.k2ld = 32; a.V = WSP(bf16_t, O_CKV) + 64; a.vld = 1024; a.vhs = 128;
          a.O = WSP(bf16_t, O_OC); a.old = 512; a.ohs = 64; a.scale_l2 = 0.10206207261596577f * LOG2E; a.sink = nullptr; a.window = 0;
          const int nqb = last ? 32 : 33;
          DUP(3) for (int u = cb; u < NB * 8 * nqb; u += Gd) { const int b = u / (8 * nqb), rem = u - b * 8 * nqb, h = rem / nqb, qb = rem - h * nqb; attn_unit<96>(F.lds, a, b, qb, h); } }
        PH_END
        PH_BEGIN
        { ScanArgs a{}; a.BQ = WSP(bf16_t, O_BQ); a.BV = WSP(bf16_t, O_BV); a.BG = WSP(bf16_t, O_BG); a.BLF = WSP(f16_t, O_BLF); a.BLB = WSP(f16_t, O_BLB); a.ST = WSP(bf16_t, O_H); a.DS = WSP(float, O_DS); a.OB = WSP(bf16_t, O_BQ); a.gn = INP(11) + l * 512; a.skipctx_out = last ? 1 : 0;
          DUP(9) { a.pad = (((PROBE_DUP >> 9) & 1) && rep_ == 0) ? 1 : 0; for (int u = cb; u < NB * 8 * NCHK; u += Gd) { const int b = u / (8 * NCHK), rem = u - b * 8 * NCHK, h = rem / NCHK, k = rem - h * NCHK; scan_s3_unit(F.lds, a, b, h, k); } } }
        PH_END
        PH_BEGIN DUP(4) phase_rowpass1(F, l, false); PH_END
        PH_BEGIN
        { SchedStd S{}; S.A = WSP(bf16_t, O_H); S.Bt = WSP(bf16_t, O_WINP) + (size_t)3840 * 1024; S.K = 1024; S.nM = last ? 128 : 132; S.nN = 12; S.G_ = Gd; S.c = cb; S.skipctx = last ? 1 : 0; S.lda2 = 2048; S.ldb2 = 2048;
          EpiGate E{}; E.GATE = WSP(bf16_t, O_GATE); E.nstride = (long)G * 1024; E.ld = 1024;
          DUP(5) gp::gemm_phase<EpiGate, SchedStd>(glds, S, E); }
        PH_END
        PH_BEGIN
        { SchedMerge S{}; S.A0 = WSP(bf16_t, O_AQ); S.A1 = WSP(bf16_t, O_BQ); S.A2 = WSP(bf16_t, O_OC); S.Bt = WSP(bf16_t, O_WBR); S.nM = last ? 128 : 132; S.G_ = Gd; S.c = cb; S.skipctx = last ? 1 : 0; S.lda2 = 1024; S.ldb2 = 1024;
          EpiMerge E{}; E.GATE = WSP(bf16_t, O_GATE); E.nstride = (long)G * 1024; E.ld = 1024; E.Y = WSP(bf16_t, O_H);
          DUP(6) gp::gemm_phase<EpiMerge, SchedMerge>(glds, S, E); }
        PH_END
        PH_BEGIN
        { SchedStd S{}; S.A = WSP(bf16_t, O_H); S.Bt = WSP(bf16_t, O_WOUT); S.K = 1024; S.nM = last ? 128 : 132; S.nN = 4; S.G_ = Gd; S.c = cb; S.skipctx = last ? 1 : 0; S.lda2 = 2048; S.ldb2 = 2048;
          EpiOut E{}; E.xl_src = l == 0 ? INP(0) : F.out; E.xc_src = l == 0 ? INP(2) : WSP(float, O_XC); E.xl_dst = F.out; E.xc_dst = WSP(float, O_XC); E.mod = MODl; E.pmoff = 0;
          gp::gemm_phase<EpiOut, SchedStd>(glds, S, E); }
        PH_END
        PH_BEGIN phase_rowpass2(F, l, last); __syncthreads(); conv_weights_moe(F, l); if (!last) conv_weights_nonmoe(F, l + 1); PH_END
        PH_BEGIN phase_moe_scatter(F, l, last); PH_END
        PH_BEGIN
        { SchedMoE<true> S{}; S.A = WSP(bf16_t, O_H); S.Bt = WSP(bf16_t, O_WUP); S.tile_e = WSP(int, O_TILEE); S.goff = WSP(unsigned, O_GOFF); S.K = 1024; S.nM = WSP(int, O_TILEE)[NTILE]; S.nN = 2; S.G_ = Gd; S.c = cb; S.lda2 = 2048; S.ldb2 = 2048; S.strideB = 512 * 1024;
          EpiUp E{}; E.AUP = WSP(bf16_t, O_AUP);
          DUP(7) gp::gemm_phase<EpiUp, SchedMoE<true>>(glds, S, E); }
        PH_END
        PH_BEGIN
        { SchedMoE<false> S{}; S.A = WSP(bf16_t, O_AUP); S.Bt = WSP(bf16_t, O_WDN); S.tile_e = WSP(int, O_TILEE); S.goff = nullptr; S.K = 256; S.nM = WSP(int, O_TILEE)[NTILE]; S.nN = 4; S.G_ = Gd; S.c = cb; S.lda2 = 512; S.ldb2 = 512; S.strideB = 1024 * 256;
          EpiDown E{}; E.YM2 = WSP(bf16_t, O_YM2); E.perm = WSP(int, O_PERM); E.posw = WSP(float, O_POSW);
          DUP(8) gp::gemm_phase<EpiDown, SchedMoE<false>>(glds, S, E); }
        PH_END
    }
    PH_BEGIN phase_final(F); PH_END
#undef PH_BEGIN
#undef PH_END
}
constexpr int N_PHASES = 1 + 2 * 13 + 1;
}

#ifndef MK_N_LAUNCHES
#define MK_N_LAUNCHES 1
#endif
extern "C" void kernel_launch(void* const* d_in, const int* in_sizes, int n_in, void* d_out, int out_size, void* d_ws, size_t ws_size, hipStream_t stream) {
    static int grid = 0;
    if (grid == 0) {
        if (ws_size < WS_END) { grid = -1; return; }
        int dev = 0, cus = 0;
        if (hipGetDevice(&dev) != hipSuccess || hipDeviceGetAttribute(&cus, hipDeviceAttributeMultiprocessorCount, dev) != hipSuccess) { grid = -1; return; }
        if (hipFuncSetAttribute((const void*)hybrid_trunk_fwd, hipFuncAttributeMaxDynamicSharedMemorySize, LDS_BYTES) != hipSuccess) { grid = -1; return; }
        int per_cu = 0; (void)hipOccupancyMaxActiveBlocksPerMultiprocessor(&per_cu, (const void*)hybrid_trunk_fwd, 512, LDS_BYTES); (void)hipGetLastError();
        grid = cus;
    }
    if (grid < 0) return;
    (void)hipMemsetAsync(d_ws, 0, CTL_ZERO_BYTES, stream);
    KP p{}; for (int i = 0; i < 24; ++i) p.in[i] = (const float*)d_in[i]; p.out = (float*)d_out; p.ws = (char*)d_ws;
    (void)in_sizes; (void)n_in; (void)out_size;
    if (MK_N_LAUNCHES == 1) { p.ph_lo = 0; p.ph_hi = N_PHASES; hipLaunchKernelGGL(hybrid_trunk_fwd, dim3(grid), dim3(512), LDS_BYTES, stream, p); }
    else { for (int k = 0; k < N_PHASES; ++k) { p.ph_lo = k; p.ph_hi = k + 1; hipLaunchKernelGGL(hybrid_trunk_fwd, dim3(grid), dim3(512), LDS_BYTES, stream, p); } }
}
```

```cpp
#include <hip/hip_runtime.h>
#include <stdint.h>
#include <math.h>

namespace {
typedef unsigned short bf16_t;
typedef _Float16 f16_t;
typedef short bf16x8 __attribute__((ext_vector_type(8)));
typedef short s16x4 __attribute__((ext_vector_type(4)));
typedef float f32x4 __attribute__((ext_vector_type(4)));
typedef float f32x16 __attribute__((ext_vector_type(16)));
typedef unsigned u32x4 __attribute__((ext_vector_type(4)));
#define LAS __attribute__((address_space(3)))

constexpr int D = 1024, NB = 4, SEQ = 8192, CTXL = 256, RPB = SEQ + CTXL, G = NB * RPB;
constexpr int INW = 6816, MIXW = 3744, GATEW = 3072;
constexpr float EPS = 1e-6f;
constexpr float LOG2E = 1.4426950408889634f;
constexpr int PMAX = 75776;
constexpr int NTILE = PMAX / 256;

__device__ __forceinline__ float bf2f(bf16_t v) { return __uint_as_float(((unsigned)v) << 16); }
__device__ __forceinline__ bf16_t f2bf(float f) { unsigned u = __float_as_uint(f); u += 0x7fffu + ((u >> 16) & 1u); return (bf16_t)(u >> 16); }
typedef float f32x2v __attribute__((ext_vector_type(2)));
typedef __bf16 bf16x2v __attribute__((ext_vector_type(2)));
__device__ __forceinline__ unsigned pkbf(float lo, float hi) { const f32x2v v = {lo, hi}; const bf16x2v b = __builtin_convertvector(v, bf16x2v); return __builtin_bit_cast(unsigned, b); }
__device__ __forceinline__ unsigned pk2(float lo, float hi) { return (unsigned)f2bf(lo) | ((unsigned)f2bf(hi) << 16); }
__device__ __forceinline__ float silu_f(float v) { return v / (1.f + expf(-v)); }
__device__ __forceinline__ float sigmoid_f(float v) { return 1.f / (1.f + expf(-v)); }
__device__ __forceinline__ int opaque_tid() { int t = threadIdx.x; asm volatile("" : "+v"(t)); return t; }
struct RowInfo { int b, r; bool lat; };
__device__ __forceinline__ RowInfo rowinfo(int g) { RowInfo ri; ri.b = g / RPB; ri.r = g - ri.b * RPB; ri.lat = ri.r < SEQ; return ri; }
__device__ __forceinline__ size_t xoff(const RowInfo& ri) { return ri.lat ? ((size_t)ri.b * SEQ + ri.r) * D : ((size_t)ri.b * CTXL + (ri.r - SEQ)) * D; }
__device__ __forceinline__ int crow(int r, int hi) { return (r & 3) + 8 * (r >> 2) + 4 * hi; }
__device__ __forceinline__ unsigned cvtpk(float lo, float hi) { return pkbf(lo, hi); }
typedef short v4i16_t __attribute__((ext_vector_type(4)));
__device__ __forceinline__ s16x4 vtr(const LAS char* p) { return __builtin_bit_cast(s16x4, __builtin_amdgcn_ds_read_tr16_b64_v4i16((LAS v4i16_t*)p)); }
#define MFMA32(a, b, c) __builtin_amdgcn_mfma_f32_32x32x16_bf16(a, b, c, 0, 0, 0)
#define VTR_ASM(dst, addr, off) asm volatile("ds_read_b64_tr_b16 %0, %1 offset:" #off : "=v"(dst) : "v"(addr))

#ifndef PROBE_VARIANT
#define PROBE_VARIANT 0
#endif
struct AttnArgs { const bf16_t* Q; int qld, qhs; const bf16_t* K1; int k1ld, k1hs, kvgroup; const bf16_t* K2; int k2ld; const bf16_t* V; int vld, vhs;
                  bf16_t* O; int old, ohs; float scale_l2; const float* sink; int window; int pad; };
template <int DQK>
__device__ __forceinline__ void attn_unit(LAS char* lds, const AttnArgs& p, int b, int qb, int h, bool nostore = false) {
    constexpr int NS = DQK / 16, NCH = DQK / 8; constexpr float THR = 8.f;
    constexpr int KB = 0, VB = 49152, WSF = 81920;
    const int tid = opaque_tid(), lane = tid & 63, r32 = lane & 31, hi = lane >> 5, wid = tid >> 6;
    const int rb = b * RPB;
    const bool ctxq = (qb == 32);
    const int q0 = rb + (ctxq ? SEQ : qb * 256);
    int lat_k0 = 0, lat_k1 = 0;
    if (!ctxq) { if (p.window) { lat_k0 = qb * 256 - 128; if (lat_k0 < 0) lat_k0 = 0; lat_k1 = qb * 256 + 384; if (lat_k1 > SEQ) lat_k1 = SEQ; } else { lat_k0 = 0; lat_k1 = SEQ; } }
    const int ntiles = 4 + (lat_k1 - lat_k0) / 64;
    const int qrow = q0 + wid * 32 + r32;
    const int qpos = qb * 256 + wid * 32 + r32;
    const int wq0 = qb * 256 + wid * 32;
    LAS float* wsf = (LAS float*)(lds + WSF) + wid * 64;
    bf16x8 qr[NS];
#pragma unroll
    for (int s = 0; s < NS; ++s) qr[s] = *(const bf16x8*)(p.Q + (size_t)qrow * p.qld + h * p.qhs + 16 * s + 8 * hi);
    const int k1off = (h / p.kvgroup) * p.k1hs, voff = (h / p.kvgroup) * p.vhs;
    const int wv = __builtin_amdgcn_readfirstlane(wid);
    const bool k2nd = (NCH > 8) && (wv < NCH - 8);
    const size_t ksrc0 = (size_t)lane * p.k1ld + k1off + wv * 8, ksrc1 = (size_t)lane * p.k2ld + wv * 8;
    const size_t vsrc = (size_t)(16 * (wv & 3) + (lane >> 2)) * p.vld + voff + (wv >> 2) * 32 + (lane & 3) * 8;
#define AT_ROW0(it_) (rb + ((it_) >= 4 ? lat_k0 + 64 * ((it_) - 4) : SEQ + 64 * (it_)))
#define AT_DMAK(it_, slot_) do { const size_t kr0_ = (size_t)AT_ROW0(it_); \
        __builtin_amdgcn_global_load_lds((const unsigned*)(p.K1 + kr0_ * p.k1ld + ksrc0), (LAS unsigned*)(lds + KB + (slot_) * 12288 + wv * 1024), 16, 0, 0); \
        if (k2nd) __builtin_amdgcn_global_load_lds((const unsigned*)(p.K2 + kr0_ * p.k2ld + ksrc1), (LAS unsigned*)(lds + KB + (slot_) * 12288 + (8 + wv) * 1024), 16, 0, 0); } while (0)
#define AT_DMAV(it_, slot_) do { const size_t kr0_ = (size_t)AT_ROW0(it_); \
        __builtin_amdgcn_global_load_lds((const unsigned*)(p.V + kr0_ * p.vld + vsrc), (LAS unsigned*)(lds + VB + (slot_) * 8192 + wv * 1024), 16, 0, 0); } while (0)
#define AT_CLAMP(x_) ((x_) < ntiles ? (x_) : ntiles - 1)
#define AT_WAITBAR() do { if (k2nd) asm volatile("s_waitcnt vmcnt(6) lgkmcnt(0)" ::: "memory"); else asm volatile("s_waitcnt vmcnt(4) lgkmcnt(0)" ::: "memory"); __builtin_amdgcn_s_barrier(); asm volatile("" ::: "memory"); } while (0)
#define AT_QK(C0, C1, slot_) do { const LAS char* ldsK_ = lds + KB + (slot_) * 12288 + hi * 1024 + r32 * 16; C0 = negm; C1 = negm; bf16x8 kf_[2 * NS]; \
        _Pragma("unroll") for (int s = 0; s < NS; ++s) { kf_[2 * s] = *(const LAS bf16x8*)(ldsK_ + s * 2048); kf_[2 * s + 1] = *(const LAS bf16x8*)(ldsK_ + s * 2048 + 512); } \
        __builtin_amdgcn_sched_group_barrier(0x100, 2 * NS, 0); \
        _Pragma("unroll") for (int s = 0; s < NS; ++s) { C0 = MFMA32(kf_[2 * s], qr[s], C0); C1 = MFMA32(kf_[2 * s + 1], qr[s], C1); } } while (0)
#define AT_REF(C0, C1, T_, first) do { const int tr_ = (T_); \
        if (p.window && tr_ >= 4) { const int kpos0 = lat_k0 + 64 * (tr_ - 4); \
            _Pragma("unroll") for (int r = 0; r < 16; ++r) { const int kp = kpos0 + crow(r, hi); int d0 = qpos - kp; if (d0 < 0) d0 = -d0; int d1 = qpos - (kp + 32); if (d1 < 0) d1 = -d1; \
                if (d0 > p.window) C0[r] = -1e30f; if (d1 > p.window) C1[r] = -1e30f; } } \
        if ((first) || (tr_ & 7) == 0) { \
        float mx = fmaxf(fmaxf(C0[0], C0[1]), C1[0]); \
        _Pragma("unroll") for (int r = 2; r < 16; r += 2) mx = fmaxf(fmaxf(mx, C0[r]), C0[r + 1]); \
        _Pragma("unroll") for (int r = 1; r < 15; r += 2) mx = fmaxf(fmaxf(mx, C1[r]), C1[r + 1]); \
        mx = fmaxf(mx, C1[15]); mx = fmaxf(mx, __shfl_xor(mx, 32)); \
        if ((first) || __any(mx > THR)) { const float dl = (first) ? mx : fmaxf(mx, 0.f); \
            m += dl; const float alpha = __builtin_amdgcn_exp2f(-dl); l *= alpha; \
            _Pragma("unroll") for (int r = 0; r < 16; ++r) { C0[r] -= dl; C1[r] -= dl; negm[r] = -m; } \
            if (hi == 0) wsf[r32] = alpha; \
            _Pragma("unroll") for (int r = 0; r < 16; ++r) { const float f = wsf[crow(r, hi)]; o0[r] *= f; o1[r] *= f; } } } } while (0)
    f32x16 o0, o1, negm, cA0, cA1, cB0, cB1;
#pragma unroll
    for (int r = 0; r < 16; ++r) { o0[r] = 0.f; o1[r] = 0.f; negm[r] = 0.f; }
    float m = 0.f, l = 0.f;
    const int vlane = ((lane >> 4) & 1) * 32 + (lane & 3) * 8 + (4 * hi + ((lane & 15) >> 2)) * 64;
    asm volatile("s_waitcnt vmcnt(0) lgkmcnt(0)" ::: "memory"); __builtin_amdgcn_s_barrier(); asm volatile("" ::: "memory");
    AT_DMAK(0, 0); AT_DMAV(0, 0); AT_DMAK(AT_CLAMP(1), 1); AT_DMAV(AT_CLAMP(1), 1); AT_DMAK(AT_CLAMP(2), 2); AT_DMAV(AT_CLAMP(2), 2); AT_DMAK(AT_CLAMP(3), 3);
    asm volatile("s_waitcnt vmcnt(0)" ::: "memory"); __builtin_amdgcn_s_barrier(); asm volatile("" ::: "memory");
    AT_QK(cA0, cA1, 0);
    AT_REF(cA0, cA1, 0, true);
    asm volatile("s_waitcnt lgkmcnt(0)" ::: "memory"); __builtin_amdgcn_s_barrier(); asm volatile("" ::: "memory");
#define AT_SB() __builtin_amdgcn_sched_barrier(0)
#define AT_STEP(C0, C1, N0, N1, T_) do { const int t_ = (T_); const int t1_ = t_ + 1 < ntiles ? t_ + 1 : ntiles - 1; \
        AT_DMAK(AT_CLAMP(t_ + 4), t_ & 3); AT_DMAV(AT_CLAMP(t_ + 3), (t_ + 3) & 3); \
        const LAS char* ldsK_ = lds + KB + ((t_ + 1) & 3) * 12288 + hi * 1024 + r32 * 16; const unsigned vaddr_ = (unsigned)(size_t)(lds + VB + (t_ & 3) * 8192 + vlane); \
        bf16x8 kfa0, kfa1, kfb0, kfb1, kfc0, kfc1; bf16x8 vf_[8]; s16x4 ta_[16]; float rs0 = 0.f, rs1 = 0.f, rs2 = 0.f, rs3 = 0.f; u32x4 pw[4]; \
        kfa0 = *(const LAS bf16x8*)(ldsK_); kfa1 = *(const LAS bf16x8*)(ldsK_ + 512); kfb0 = *(const LAS bf16x8*)(ldsK_ + 2048); kfb1 = *(const LAS bf16x8*)(ldsK_ + 2048 + 512); AT_SB(); \
        if constexpr (NS == 6) { \
          kfc0 = *(const LAS bf16x8*)(ldsK_ + 4096); kfc1 = *(const LAS bf16x8*)(ldsK_ + 4096 + 512); N0 = MFMA32(kfa0, qr[0], negm); N1 = MFMA32(kfa1, qr[0], negm); C0[0] = (PROBE_VARIANT == 1 && p.pad) ? C0[0] * 0.5f : __builtin_amdgcn_exp2f(C0[0]); C0[1] = (PROBE_VARIANT == 1 && p.pad) ? C0[1] * 0.5f : __builtin_amdgcn_exp2f(C0[1]); C0[2] = (PROBE_VARIANT == 1 && p.pad) ? C0[2] * 0.5f : __builtin_amdgcn_exp2f(C0[2]); C0[3] = (PROBE_VARIANT == 1 && p.pad) ? C0[3] * 0.5f : __builtin_amdgcn_exp2f(C0[3]); C0[4] = (PROBE_VARIANT == 1 && p.pad) ? C0[4] * 0.5f : __builtin_amdgcn_exp2f(C0[4]); C0[5] = (PROBE_VARIANT == 1 && p.pad) ? C0[5] * 0.5f : __builtin_amdgcn_exp2f(C0[5]);  VTR_ASM(ta_[0], vaddr_, 0); VTR_ASM(ta_[1], vaddr_, 512); VTR_ASM(ta_[2], vaddr_, 4096); AT_SB(); \
          kfa0 = *(const LAS bf16x8*)(ldsK_ + 6144); kfa1 = *(const LAS bf16x8*)(ldsK_ + 6144 + 512); N0 = MFMA32(kfb0, qr[1], N0); N1 = MFMA32(kfb1, qr[1], N1); C0[6] = (PROBE_VARIANT == 1 && p.pad) ? C0[6] * 0.5f : __builtin_amdgcn_exp2f(C0[6]); C0[7] = (PROBE_VARIANT == 1 && p.pad) ? C0[7] * 0.5f : __builtin_amdgcn_exp2f(C0[7]); C0[8] = (PROBE_VARIANT == 1 && p.pad) ? C0[8] * 0.5f : __builtin_amdgcn_exp2f(C0[8]); C0[9] = (PROBE_VARIANT == 1 && p.pad) ? C0[9] * 0.5f : __builtin_amdgcn_exp2f(C0[9]); C0[10] = (PROBE_VARIANT == 1 && p.pad) ? C0[10] * 0.5f : __builtin_amdgcn_exp2f(C0[10]); C0[11] = (PROBE_VARIANT == 1 && p.pad) ? C0[11] * 0.5f : __builtin_amdgcn_exp2f(C0[11]); rs0 += C0[0]; rs1 += C0[1]; rs2 += C0[2]; rs3 += C0[3]; rs0 += C0[4]; rs1 += C0[5]; VTR_ASM(ta_[3], vaddr_, 4608); VTR_ASM(ta_[4], vaddr_, 1024); VTR_ASM(ta_[5], vaddr_, 1536); AT_SB(); \
          kfb0 = *(const LAS bf16x8*)(ldsK_ + 8192); kfb1 = *(const LAS bf16x8*)(ldsK_ + 8192 + 512); N0 = MFMA32(kfc0, qr[2], N0); N1 = MFMA32(kfc1, qr[2], N1); C0[12] = (PROBE_VARIANT == 1 && p.pad) ? C0[12] * 0.5f : __builtin_amdgcn_exp2f(C0[12]); C0[13] = (PROBE_VARIANT == 1 && p.pad) ? C0[13] * 0.5f : __builtin_amdgcn_exp2f(C0[13]); C0[14] = (PROBE_VARIANT == 1 && p.pad) ? C0[14] * 0.5f : __builtin_amdgcn_exp2f(C0[14]); C0[15] = (PROBE_VARIANT == 1 && p.pad) ? C0[15] * 0.5f : __builtin_amdgcn_exp2f(C0[15]); C1[0] = (PROBE_VARIANT == 1 && p.pad) ? C1[0] * 0.5f : __builtin_amdgcn_exp2f(C1[0]); C1[1] = (PROBE_VARIANT == 1 && p.pad) ? C1[1] * 0.5f : __builtin_amdgcn_exp2f(C1[1]); rs2 += C0[6]; rs3 += C0[7]; rs0 += C0[8]; rs1 += C0[9]; rs2 += C0[10]; rs3 += C0[11]; VTR_ASM(ta_[6], vaddr_, 5120); VTR_ASM(ta_[7], vaddr_, 5632); VTR_ASM(ta_[8], vaddr_, 2048); AT_SB(); \
          kfc0 = *(const LAS bf16x8*)(ldsK_ + 10240); kfc1 = *(const LAS bf16x8*)(ldsK_ + 10240 + 512); N0 = MFMA32(kfa0, qr[3], N0); N1 = MFMA32(kfa1, qr[3], N1); C1[2] = (PROBE_VARIANT == 1 && p.pad) ? C1[2] * 0.5f : __builtin_amdgcn_exp2f(C1[2]); C1[3] = (PROBE_VARIANT == 1 && p.pad) ? C1[3] * 0.5f : __builtin_amdgcn_exp2f(C1[3]); C1[4] = (PROBE_VARIANT == 1 && p.pad) ? C1[4] * 0.5f : __builtin_amdgcn_exp2f(C1[4]); C1[5] = (PROBE_VARIANT == 1 && p.pad) ? C1[5] * 0.5f : __builtin_amdgcn_exp2f(C1[5]); C1[6] = (PROBE_VARIANT == 1 && p.pad) ? C1[6] * 0.5f : __builtin_amdgcn_exp2f(C1[6]); C1[7] = (PROBE_VARIANT == 1 && p.pad) ? C1[7] * 0.5f : __builtin_amdgcn_exp2f(C1[7]); rs0 += C0[12]; rs1 += C0[13]; rs2 += C0[14]; rs3 += C0[15]; rs0 += C1[0]; rs1 += C1[1]; VTR_ASM(ta_[9], vaddr_, 2560); VTR_ASM(ta_[10], vaddr_, 6144); VTR_ASM(ta_[11], vaddr_, 6656); AT_SB(); \
          N0 = MFMA32(kfb0, qr[4], N0); N1 = MFMA32(kfb1, qr[4], N1); C1[8] = (PROBE_VARIANT == 1 && p.pad) ? C1[8] * 0.5f : __builtin_amdgcn_exp2f(C1[8]); C1[9] = (PROBE_VARIANT == 1 && p.pad) ? C1[9] * 0.5f : __builtin_amdgcn_exp2f(C1[9]); C1[10] = (PROBE_VARIANT == 1 && p.pad) ? C1[10] * 0.5f : __builtin_amdgcn_exp2f(C1[10]); C1[11] = (PROBE_VARIANT == 1 && p.pad) ? C1[11] * 0.5f : __builtin_amdgcn_exp2f(C1[11]); rs2 += C1[2]; rs3 += C1[3]; rs0 += C1[4]; rs1 += C1[5]; rs2 += C1[6]; rs3 += C1[7]; VTR_ASM(ta_[12], vaddr_, 3072); VTR_ASM(ta_[13], vaddr_, 3584); AT_SB(); \
          N0 = MFMA32(kfc0, qr[5], N0); N1 = MFMA32(kfc1, qr[5], N1); C1[12] = (PROBE_VARIANT == 1 && p.pad) ? C1[12] * 0.5f : __builtin_amdgcn_exp2f(C1[12]); C1[13] = (PROBE_VARIANT == 1 && p.pad) ? C1[13] * 0.5f : __builtin_amdgcn_exp2f(C1[13]); C1[14] = (PROBE_VARIANT == 1 && p.pad) ? C1[14] * 0.5f : __builtin_amdgcn_exp2f(C1[14]); C1[15] = (PROBE_VARIANT == 1 && p.pad) ? C1[15] * 0.5f : __builtin_amdgcn_exp2f(C1[15]); rs0 += C1[8]; rs1 += C1[9]; rs2 += C1[10]; rs3 += C1[11]; VTR_ASM(ta_[14], vaddr_, 7168); VTR_ASM(ta_[15], vaddr_, 7680); AT_SB(); \
          rs0 += C1[12]; rs1 += C1[13]; rs2 += C1[14]; rs3 += C1[15]; \
        } \
        if constexpr (NS == 4) { \
          kfc0 = *(const LAS bf16x8*)(ldsK_ + 4096); kfc1 = *(const LAS bf16x8*)(ldsK_ + 4096 + 512); N0 = MFMA32(kfa0, qr[0], negm); N1 = MFMA32(kfa1, qr[0], negm); C0[0] = (PROBE_VARIANT == 1 && p.pad) ? C0[0] * 0.5f : __builtin_amdgcn_exp2f(C0[0]); C0[1] = (PROBE_VARIANT == 1 && p.pad) ? C0[1] * 0.5f : __builtin_amdgcn_exp2f(C0[1]); C0[2] = (PROBE_VARIANT == 1 && p.pad) ? C0[2] * 0.5f : __builtin_amdgcn_exp2f(C0[2]); C0[3] = (PROBE_VARIANT == 1 && p.pad) ? C0[3] * 0.5f : __builtin_amdgcn_exp2f(C0[3]); C0[4] = (PROBE_VARIANT == 1 && p.pad) ? C0[4] * 0.5f : __builtin_amdgcn_exp2f(C0[4]); C0[5] = (PROBE_VARIANT == 1 && p.pad) ? C0[5] * 0.5f : __builtin_amdgcn_exp2f(C0[5]); C0[6] = (PROBE_VARIANT == 1 && p.pad) ? C0[6] * 0.5f : __builtin_amdgcn_exp2f(C0[6]); C0[7] = (PROBE_VARIANT == 1 && p.pad) ? C0[7] * 0.5f : __builtin_amdgcn_exp2f(C0[7]);  VTR_ASM(ta_[0], vaddr_, 0); VTR_ASM(ta_[1], vaddr_, 512); VTR_ASM(ta_[2], vaddr_, 4096); VTR_ASM(ta_[3], vaddr_, 4608); AT_SB(); \
          kfa0 = *(const LAS bf16x8*)(ldsK_ + 6144); kfa1 = *(const LAS bf16x8*)(ldsK_ + 6144 + 512); N0 = MFMA32(kfb0, qr[1], N0); N1 = MFMA32(kfb1, qr[1], N1); C0[8] = (PROBE_VARIANT == 1 && p.pad) ? C0[8] * 0.5f : __builtin_amdgcn_exp2f(C0[8]); C0[9] = (PROBE_VARIANT == 1 && p.pad) ? C0[9] * 0.5f : __builtin_amdgcn_exp2f(C0[9]); C0[10] = (PROBE_VARIANT == 1 && p.pad) ? C0[10] * 0.5f : __builtin_amdgcn_exp2f(C0[10]); C0[11] = (PROBE_VARIANT == 1 && p.pad) ? C0[11] * 0.5f : __builtin_amdgcn_exp2f(C0[11]); C0[12] = (PROBE_VARIANT == 1 && p.pad) ? C0[12] * 0.5f : __builtin_amdgcn_exp2f(C0[12]); C0[13] = (PROBE_VARIANT == 1 && p.pad) ? C0[13] * 0.5f : __builtin_amdgcn_exp2f(C0[13]); C0[14] = (PROBE_VARIANT == 1 && p.pad) ? C0[14] * 0.5f : __builtin_amdgcn_exp2f(C0[14]); C0[15] = (PROBE_VARIANT == 1 && p.pad) ? C0[15] * 0.5f : __builtin_amdgcn_exp2f(C0[15]); rs0 += C0[0]; rs1 += C0[1]; rs2 += C0[2]; rs3 += C0[3]; rs0 += C0[4]; rs1 += C0[5]; rs2 += C0[6]; rs3 += C0[7]; VTR_ASM(ta_[4], vaddr_, 1024); VTR_ASM(ta_[5], vaddr_, 1536); VTR_ASM(ta_[6], vaddr_, 5120); VTR_ASM(ta_[7], vaddr_, 5632); AT_SB(); \
          N0 = MFMA32(kfc0, qr[2], N0); N1 = MFMA32(kfc1, qr[2], N1); C1[0] = (PROBE_VARIANT == 1 && p.pad) ? C1[0] * 0.5f : __builtin_amdgcn_exp2f(C1[0]); C1[1] = (PROBE_VARIANT == 1 && p.pad) ? C1[1] * 0.5f : __builtin_amdgcn_exp2f(C1[1]); C1[2] = (PROBE_VARIANT == 1 && p.pad) ? C1[2] * 0.5f : __builtin_amdgcn_exp2f(C1[2]); C1[3] = (PROBE_VARIANT == 1 && p.pad) ? C1[3] * 0.5f : __builtin_amdgcn_exp2f(C1[3]); C1[4] = (PROBE_VARIANT == 1 && p.pad) ? C1[4] * 0.5f : __builtin_amdgcn_exp2f(C1[4]); C1[5] = (PROBE_VARIANT == 1 && p.pad) ? C1[5] * 0.5f : __builtin_amdgcn_exp2f(C1[5]); C1[6] = (PROBE_VARIANT == 1 && p.pad) ? C1[6] * 0.5f : __builtin_amdgcn_exp2f(C1[6]); C1[7] = (PROBE_VARIANT == 1 && p.pad) ? C1[7] * 0.5f : __builtin_amdgcn_exp2f(C1[7]); rs0 += C0[8]; rs1 += C0[9]; rs2 += C0[10]; rs3 += C0[11]; rs0 += C0[12]; rs1 += C0[13]; rs2 += C0[14]; rs3 += C0[15]; VTR_ASM(ta_[8], vaddr_, 2048); VTR_ASM(ta_[9], vaddr_, 2560); VTR_ASM(ta_[10], vaddr_, 6144); VTR_ASM(ta_[11], vaddr_, 6656); AT_SB(); \
          N0 = MFMA32(kfa0, qr[3], N0); N1 = MFMA32(kfa1, qr[3], N1); C1[8] = (PROBE_VARIANT == 1 && p.pad) ? C1[8] * 0.5f : __builtin_amdgcn_exp2f(C1[8]); C1[9] = (PROBE_VARIANT == 1 && p.pad) ? C1[9] * 0.5f : __builtin_amdgcn_exp2f(C1[9]); C1[10] = (PROBE_VARIANT == 1 && p.pad) ? C1[10] * 0.5f : __builtin_amdgcn_exp2f(C1[10]); C1[11] = (PROBE_VARIANT == 1 && p.pad) ? C1[11] * 0.5f : __builtin_amdgcn_exp2f(C1[11]); C1[12] = (PROBE_VARIANT == 1 && p.pad) ? C1[12] * 0.5f : __builtin_amdgcn_exp2f(C1[12]); C1[13] = (PROBE_VARIANT == 1 && p.pad) ? C1[13] * 0.5f : __builtin_amdgcn_exp2f(C1[13]); C1[14] = (PROBE_VARIANT == 1 && p.pad) ? C1[14] * 0.5f : __builtin_amdgcn_exp2f(C1[14]); C1[15] = (PROBE_VARIANT == 1 && p.pad) ? C1[15] * 0.5f : __builtin_amdgcn_exp2f(C1[15]); rs0 += C1[0]; rs1 += C1[1]; rs2 += C1[2]; rs3 += C1[3]; rs0 += C1[4]; rs1 += C1[5]; rs2 += C1[6]; rs3 += C1[7]; VTR_ASM(ta_[12], vaddr_, 3072); VTR_ASM(ta_[13], vaddr_, 3584); VTR_ASM(ta_[14], vaddr_, 7168); VTR_ASM(ta_[15], vaddr_, 7680); AT_SB(); \
          rs0 += C1[8]; rs1 += C1[9]; rs2 += C1[10]; rs3 += C1[11]; rs0 += C1[12]; rs1 += C1[13]; rs2 += C1[14]; rs3 += C1[15]; \
        } \
        l += (rs0 + rs1) + (rs2 + rs3); \
        asm volatile("s_waitcnt lgkmcnt(0)" ::: "memory"); AT_SB(); \
        _Pragma("unroll") for (int s = 0; s < 4; ++s) { vf_[2 * s] = (bf16x8){ta_[4 * s][0], ta_[4 * s][1], ta_[4 * s][2], ta_[4 * s][3], ta_[4 * s + 1][0], ta_[4 * s + 1][1], ta_[4 * s + 1][2], ta_[4 * s + 1][3]}; vf_[2 * s + 1] = (bf16x8){ta_[4 * s + 2][0], ta_[4 * s + 2][1], ta_[4 * s + 2][2], ta_[4 * s + 2][3], ta_[4 * s + 3][0], ta_[4 * s + 3][1], ta_[4 * s + 3][2], ta_[4 * s + 3][3]}; } \
        pw[0] = (u32x4){cvtpk(C0[0], C0[1]), cvtpk(C0[2], C0[3]), cvtpk(C0[4], C0[5]), cvtpk(C0[6], C0[7])}; pw[1] = (u32x4){cvtpk(C0[8], C0[9]), cvtpk(C0[10], C0[11]), cvtpk(C0[12], C0[13]), cvtpk(C0[14], C0[15])}; AT_SB(); \
        if (!(PROBE_VARIANT == 2 && p.pad)) { o0 = MFMA32(__builtin_bit_cast(bf16x8, pw[0]), vf_[0], o0); o1 = MFMA32(__builtin_bit_cast(bf16x8, pw[0]), vf_[1], o1); pw[2] = (u32x4){cvtpk(C1[0], C1[1]), cvtpk(C1[2], C1[3]), cvtpk(C1[4], C1[5]), cvtpk(C1[6], C1[7])}; AT_SB(); \
        o0 = MFMA32(__builtin_bit_cast(bf16x8, pw[1]), vf_[2], o0); o1 = MFMA32(__builtin_bit_cast(bf16x8, pw[1]), vf_[3], o1); pw[3] = (u32x4){cvtpk(C1[8], C1[9]), cvtpk(C1[10], C1[11]), cvtpk(C1[12], C1[13]), cvtpk(C1[14], C1[15])}; AT_SB(); \
        o0 = MFMA32(__builtin_bit_cast(bf16x8, pw[2]), vf_[4], o0); o1 = MFMA32(__builtin_bit_cast(bf16x8, pw[2]), vf_[5], o1); AT_SB(); \
        o0 = MFMA32(__builtin_bit_cast(bf16x8, pw[3]), vf_[6], o0); o1 = MFMA32(__builtin_bit_cast(bf16x8, pw[3]), vf_[7], o1); AT_SB(); } \
        AT_WAITBAR(); \
        if (t_ + 1 < ntiles) AT_REF(N0, N1, t1_, false); } while (0)
    for (int it = 0; it < ntiles; it += 2) {
        AT_STEP(cA0, cA1, cB0, cB1, it);
        AT_STEP(cB0, cB1, cA0, cA1, it + 1);
    }
#undef AT_ROW0
#undef AT_DMAK
#undef AT_DMAV
#undef AT_CLAMP
#undef AT_WAITBAR
#undef AT_REF
#undef AT_SB
#undef AT_QK
#undef AT_STEP
    float lt = l + __shfl_xor(l, 32);
    float fin = 1.f;
    if (p.sink) { const float sk = p.sink[h] * LOG2E; const float m2 = fmaxf(m, sk); fin = __builtin_amdgcn_exp2f(m - m2); lt = lt * fin + __builtin_amdgcn_exp2f(sk - m2); }
    const float sc = fin / lt;
    if (hi == 0) wsf[r32] = sc;
    bf16_t* Ob = p.O + (size_t)(q0 + wid * 32) * p.old + h * p.ohs + r32;
#pragma unroll
    for (int r = 0; r < 16; ++r) { const int qr_ = crow(r, hi); const float f = wsf[qr_];
        if (!nostore) { Ob[(size_t)qr_ * p.old] = f2bf(o0[r] * f); Ob[(size_t)qr_ * p.old + 32] = f2bf(o1[r] * f); } }
}

namespace gp {
constexpr int BM = 256, BK = 64, HALF = 128, HTB = HALF * BK * 2, STAGE_BYTES = 8 * HTB, NXCD = 8, WGM = 8;
__host__ __device__ __forceinline__ int lds_byte(int r, int c) { const int st = (r >> 4) * 2 + (c >> 5), rr = r & 15, cc = c & 31, ob = rr * 64 + cc * 2; return st * 1024 + (ob ^ (((ob >> 9) & 1) << 5)); }
__host__ __device__ __forceinline__ void stage_rc(int b, int& R, int& C) { const int st = b / 1024, sb = b % 1024, swz = sb ^ (((sb >> 9) & 1) << 5); R = (st >> 1) * 16 + swz / 64; C = (st & 1) * 32 + (swz % 64) / 2; }
__host__ __device__ __forceinline__ int perm32(int rho) { const int n = rho >> 4, i = rho & 15; return 8 * (i >> 2) + 4 * n + (i & 3); }

struct GUnit { const char* A; const char* B; int nt, pm, pn, tag; const unsigned* goff; };

__device__ __forceinline__ bool tile_order(int i, int G_, int c, int nM, int nN, int& pm, int& pn) {
    const int nwg = nM * nN; const long L = (long)i * G_ + c; if (L >= nwg) return false;
    int wgid = (int)L; { const int q = nwg / NXCD, r = nwg % NXCD, xcd = wgid % NXCD, off = wgid / NXCD; wgid = (xcd < r ? xcd * (q + 1) : r * (q + 1) + (xcd - r) * q) + off; }
    const int nig = WGM * nN, gid = wgid / nig, fm = gid * WGM, gsz = (nM - fm) < WGM ? (nM - fm) : WGM;
    pm = fm + ((wgid % nig) % gsz); pn = (wgid % nig) / gsz; return true;
}
__device__ __forceinline__ unsigned cvt_pk_bf16(float lo, float hi) { return pkbf(lo, hi); }

template <class Epi, class Sched>
__device__ __forceinline__ void gemm_phase(LAS unsigned char* lds, const Sched& S, const Epi& E) {
    constexpr bool GATHER = Sched::GATHER;
    const int tid = opaque_tid(), wid = __builtin_amdgcn_readfirstlane(tid >> 6), lane = tid & 63, wr = wid >> 2, wc = wid & 3, fr = lane & 15, fq = lane >> 4;
    const int lda2 = S.lda2, ldb2 = S.ldb2;
    unsigned voffA[2], voffB[2], rowA[2];
#pragma unroll
    for (int i = 0; i < 2; ++i) { int R, C; stage_rc(tid * 16 + i * 8192, R, C); const int Rb = Epi::PERM ? ((R & ~31) + perm32(R & 31)) : R;
        voffA[i] = GATHER ? (unsigned)C * 2u : (unsigned)R * (unsigned)lda2 + (unsigned)C * 2u; rowA[i] = (unsigned)R; voffB[i] = (unsigned)Rb * (unsigned)ldb2 + (unsigned)C * 2u; }
    const size_t hA = GATHER ? 0 : (size_t)HALF * lda2, hB = (size_t)HALF * ldb2;
    const unsigned ldsw = (unsigned)wid * 1024u;
    const int aoff = lds_byte(wr * 64 + fr, fq * 8), boff = lds_byte(wc * 32 + fr, fq * 8);
    constexpr size_t kstep = (size_t)(BK * 2);
#define GP_SA(b, h) (((b) * 2 + (h)) * HTB)
#define GP_SB(b, h) ((4 + (b) * 2 + (h)) * HTB)
#define GP_STAGE(bufoff, gbase, v0, v1) do { \
        __builtin_amdgcn_global_load_lds((const unsigned*)((const char*)(gbase) + (v0)), (LAS unsigned*)(lds + (bufoff) + ldsw), 16, 0, 0); \
        __builtin_amdgcn_global_load_lds((const unsigned*)((const char*)(gbase) + (v1)), (LAS unsigned*)(lds + (bufoff) + ldsw + 8192), 16, 0, 0); } while (0)
#define GP_LDA(dst, b, h) do { _Pragma("unroll") for (int m = 0; m < 4; ++m) _Pragma("unroll") for (int k = 0; k < 2; ++k) dst[m][k] = *(const LAS bf16x8*)(lds + GP_SA(b, h) + aoff + m * 2048 + k * 1024); } while (0)
#define GP_LDB(dst, b, h) do { _Pragma("unroll") for (int n = 0; n < 2; ++n) _Pragma("unroll") for (int k = 0; k < 2; ++k) dst[n][k] = *(const LAS bf16x8*)(lds + GP_SB(b, h) + boff + n * 2048 + k * 1024); } while (0)
#define GP_MMA(ai, bj, At, Bt) do { __builtin_amdgcn_s_setprio(1); _Pragma("unroll") for (int m = 0; m < 4; ++m) _Pragma("unroll") for (int n = 0; n < 2; ++n) _Pragma("unroll") for (int k = 0; k < 2; ++k) \
        acc[ai][bj][m][n] = __builtin_amdgcn_mfma_f32_16x16x32_bf16(Bt[n][k], At[m][k], acc[ai][bj][m][n], 0, 0, 0); __builtin_amdgcn_s_setprio(0); } while (0)
#define GP_WAIT_V(n) asm volatile("s_waitcnt vmcnt(" #n ")" ::: "memory")
#define GP_WAIT_L(n) asm volatile("s_waitcnt lgkmcnt(" #n ")" ::: "memory")
#define GP_BAR __builtin_amdgcn_s_barrier()
#define GP_SCHED __builtin_amdgcn_sched_barrier(0)
#define GP_GOFF(U, o0, o1, p0, p1) do { if (GATHER) { o0 = (U).goff[rowA[0]] + voffA[0]; o1 = (U).goff[rowA[1]] + voffA[1]; p0 = (U).goff[128 + rowA[0]] + voffA[0]; p1 = (U).goff[128 + rowA[1]] + voffA[1]; } \
        else { o0 = voffA[0]; o1 = voffA[1]; p0 = voffA[0]; p1 = voffA[1]; } } while (0)
    GUnit cur, nxt; int ui = 0;
    if (!S.next(0, cur)) return;
    f32x4 acc[2][2][4][2];
#pragma unroll
    for (int a = 0; a < 2; ++a)
#pragma unroll
        for (int b = 0; b < 2; ++b)
#pragma unroll
            for (int m = 0; m < 4; ++m)
#pragma unroll
                for (int n = 0; n < 2; ++n) acc[a][b][m][n] = (f32x4){0.f, 0.f, 0.f, 0.f};
    bf16x8 At[4][2], B0[2][2], B1[2][2];
    unsigned g00, g01, g10, g11;
    GP_GOFF(cur, g00, g01, g10, g11);
    const char* cA = cur.A; const char* cB = cur.B;
    GP_STAGE(GP_SB(0, 0), cB, voffB[0], voffB[1]); GP_STAGE(GP_SA(0, 0), cA, g00, g01); GP_STAGE(GP_SB(0, 1), cB + hB, voffB[0], voffB[1]); GP_STAGE(GP_SA(0, 1), cA + hA, g10, g11);
    if (wr == 1) GP_BAR;
    GP_WAIT_V(4); GP_BAR;
    GP_STAGE(GP_SB(1, 0), cB + kstep, voffB[0], voffB[1]); GP_STAGE(GP_SA(1, 0), cA + kstep, g00, g01); GP_STAGE(GP_SB(1, 1), cB + hB + kstep, voffB[0], voffB[1]);
    GP_WAIT_V(6); GP_BAR;
    for (;;) {
        const bool has_next = S.next(ui + 1, nxt);
        const char* nA = has_next ? nxt.A : cA; const char* nB = has_next ? nxt.B : cB;
        const int nt = cur.nt;
        for (int t = 0; t < nt; t += 2) {
            const bool last = (t == nt - 2);
            const char* a1 = cA + (size_t)(t + 1) * kstep;
            const char* a2 = last ? nA : cA + (size_t)(t + 2) * kstep; const char* b2 = last ? nB : cB + (size_t)(t + 2) * kstep;
            const char* a3 = a2 + kstep; const char* b3 = b2 + kstep;
            unsigned w00 = g00, w01 = g01, w10 = g10, w11 = g11;
            if (GATHER && last && has_next) { GP_GOFF(nxt, w00, w01, w10, w11); }
            GP_LDB(B0, 0, 0); GP_SCHED; GP_LDA(At, 0, 0); GP_STAGE(GP_SA(1, 1), a1 + hA, g10, g11);
            GP_WAIT_L(8); GP_BAR; GP_WAIT_L(0); GP_MMA(0, 0, At, B0); GP_BAR; GP_SCHED;
            GP_LDB(B1, 0, 1); GP_STAGE(GP_SB(0, 0), b2, voffB[0], voffB[1]);
            GP_BAR; GP_WAIT_L(0); GP_MMA(0, 1, At, B1); GP_BAR;
            GP_LDA(At, 0, 1); GP_STAGE(GP_SA(0, 0), a2, w00, w01);
            GP_BAR; GP_WAIT_L(0); GP_MMA(1, 0, At, B0); GP_BAR; GP_SCHED;
            GP_STAGE(GP_SB(0, 1), b2 + hB, voffB[0], voffB[1]);
            GP_WAIT_V(6); GP_BAR; GP_MMA(1, 1, At, B1); GP_BAR;
            GP_LDB(B0, 1, 0); GP_SCHED; GP_LDA(At, 1, 0); GP_STAGE(GP_SA(0, 1), a2 + hA, w10, w11);
            GP_WAIT_L(8); GP_BAR; GP_WAIT_L(0); GP_MMA(0, 0, At, B0); GP_BAR; GP_SCHED;
            GP_LDB(B1, 1, 1); GP_STAGE(GP_SB(1, 0), b3, voffB[0], voffB[1]);
            GP_BAR; GP_WAIT_L(0); GP_MMA(0, 1, At, B1); GP_BAR;
            GP_LDA(At, 1, 1); GP_STAGE(GP_SA(1, 0), a3, w00, w01);
            GP_BAR; GP_WAIT_L(0); GP_MMA(1, 0, At, B0); GP_BAR; GP_SCHED;
            GP_STAGE(GP_SB(1, 1), b3 + hB, voffB[0], voffB[1]);
            GP_WAIT_V(6); GP_BAR; GP_MMA(1, 1, At, B1); GP_BAR;
            if (GATHER && last) { g00 = w00; g01 = w01; g10 = w10; g11 = w11; }
        }
        { int fr_e = fr, fq_e = fq; asm volatile("" : "+v"(fr_e), "+v"(fq_e));
          E(acc, cur, wr, wc, fr_e, fq_e); }
        if (!has_next) break;
#pragma unroll
        for (int a = 0; a < 2; ++a)
#pragma unroll
            for (int b = 0; b < 2; ++b)
#pragma unroll
                for (int m = 0; m < 4; ++m)
#pragma unroll
                    for (int n = 0; n < 2; ++n) acc[a][b][m][n] = (f32x4){0.f, 0.f, 0.f, 0.f};
        cur = nxt; cA = nA; cB = nB; ++ui;
    }
    GP_WAIT_V(0);
    if (wr == 0) GP_BAR;
    GP_BAR;
#undef GP_SA
#undef GP_SB
#undef GP_STAGE
#undef GP_LDA
#undef GP_LDB
#undef GP_MMA
#undef GP_WAIT_V
#undef GP_WAIT_L
#undef GP_BAR
#undef GP_SCHED
#undef GP_GOFF
}
}

struct SchedStd {
    static constexpr bool GATHER = false;
    const bf16_t* A; const bf16_t* Bt; int K, nM, nN, G_, c, skipctx, lda2, ldb2;
    __device__ __forceinline__ bool next(int i, gp::GUnit& u) const {
        int pmv, pn; if (!gp::tile_order(i, G_, c, nM, nN, pmv, pn)) return false;
        const int pm = skipctx ? pmv + pmv / 32 : pmv;
        u.A = (const char*)(A + (size_t)pm * 256 * K); u.B = (const char*)(Bt + (size_t)pn * 256 * K); u.nt = K / 64; u.pm = pm; u.pn = pn; u.tag = 0; u.goff = nullptr; return true;
    }
};

__device__ __forceinline__ float fexp(float x) { return __builtin_amdgcn_exp2f(x * LOG2E); }
__device__ __forceinline__ float flog(float x) { return __builtin_amdgcn_logf(x) * 0.6931471805599453f; }
__device__ __forceinline__ float fsigmoid(float x) { return __builtin_amdgcn_rcpf(1.f + fexp(-x)); }
__device__ __forceinline__ float logf_gate_fast(float z, float lb) {
    if (lb <= 0.f) return fminf(z, 0.f) - flog(1.f + fexp(-fabsf(z)));
    return flog(lb + (1.f - lb) * fsigmoid(z));
}
__device__ __forceinline__ unsigned pkh2(float lo, float hi) { const f16_t a = (f16_t)lo, b = (f16_t)hi; return (unsigned)__builtin_bit_cast(unsigned short, a) | ((unsigned)__builtin_bit_cast(unsigned short, b) << 16); }

template <class T> __device__ __forceinline__ T* opq(T* p) { asm volatile("" : "+s"(p)); return p; }
struct EpiG1 {
    static constexpr bool PERM = true;
    bf16_t *AQ, *AK, *AV, *BQ, *BV, *BG; f16_t *BLF, *BLB; bf16_t *CQKV, *CKR; float* RS; const float *ropa_c, *ropa_s, *ropc_c, *ropc_s; const float* LBl; int rowoff;
    __device__ __forceinline__ void operator()(const f32x4 (&acc)[2][2][4][2], const gp::GUnit& u, int wr, int wc, int fr, int fq) const {
        const int pn = u.pn; const int pr = u.pm % 33; const bool lat = pr < 32;
        const int grow0 = u.pm * 256 + wr * 64 + fr; const int t0 = pr * 256 + wr * 64 + fr;
        if (pn < 3) {
            const int hh = pn * 4 + wc; bf16_t* dst; int ld, coff; bf16_t* const aq_ = opq(AQ); bf16_t* const ak_ = opq(AK); bf16_t* const av_ = opq(AV);
            if (hh < 8) { dst = aq_; ld = 512; coff = hh * 64; } else if (hh < 10) { dst = ak_; ld = 128; coff = (hh - 8) * 64; } else { dst = av_; ld = 128; coff = (hh - 10) * 64; }
            const bool rope = lat && hh < 10;
#pragma unroll
            for (int ai = 0; ai < 2; ++ai)
#pragma unroll
                for (int m = 0; m < 4; ++m) { const int grow = grow0 + ai * 128 + m * 16, t = t0 + ai * 128 + m * 16; const size_t row = (size_t)(grow - rowoff);
                    f32x4 x1a = acc[ai][0][m][0], x1b = acc[ai][0][m][1], x2a = acc[ai][1][m][0], x2b = acc[ai][1][m][1];
                    if (rope) { const f32x4 ca = *(const f32x4*)(ropa_c + t * 32 + 8 * fq), cb = *(const f32x4*)(ropa_c + t * 32 + 8 * fq + 4), sa = *(const f32x4*)(ropa_s + t * 32 + 8 * fq), sb = *(const f32x4*)(ropa_s + t * 32 + 8 * fq + 4);
                        const f32x4 o1a = x1a * ca - x2a * sa, o2a = x1a * sa + x2a * ca, o1b = x1b * cb - x2b * sb, o2b = x1b * sb + x2b * cb; x1a = o1a; x2a = o2a; x1b = o1b; x2b = o2b; }
                    if (hh < 8) { const float qs = 0.125f * LOG2E; x1a *= qs; x1b *= qs; x2a *= qs; x2b *= qs; }
                    bf16_t* p = dst + row * ld + coff + 8 * fq;
                    u32x4 w1, w2; w1.x = gp::cvt_pk_bf16(x1a[0], x1a[1]); w1.y = gp::cvt_pk_bf16(x1a[2], x1a[3]); w1.z = gp::cvt_pk_bf16(x1b[0], x1b[1]); w1.w = gp::cvt_pk_bf16(x1b[2], x1b[3]);
                    w2.x = gp::cvt_pk_bf16(x2a[0], x2a[1]); w2.y = gp::cvt_pk_bf16(x2a[2], x2a[3]); w2.z = gp::cvt_pk_bf16(x2b[0], x2b[1]); w2.w = gp::cvt_pk_bf16(x2b[2], x2b[3]);
                    *(u32x4*)p = w1; *(u32x4*)(p + 32) = w2; asm volatile("" ::: "memory"); }
        } else if (pn < 13) {
            const int q = pn - 3, which = q >> 1; const int cb0 = (q & 1) * 256 + wc * 32 + 8 * fq;
            if (which == 2 || which == 3) {
                f16_t* const blf_ = opq(BLF); f16_t* const blb_ = opq(BLB); f16_t* dst = which == 2 ? blf_ : blb_; const float* lbp = LBl + (which == 2 ? 0 : 512);
#pragma unroll
                for (int bj = 0; bj < 2; ++bj) { const int c0 = cb0 + bj * 128; const f32x4 la = *(const f32x4*)(lbp + c0), lb4 = *(const f32x4*)(lbp + c0 + 4);
#pragma unroll
                    for (int ai = 0; ai < 2; ++ai)
#pragma unroll
                        for (int m = 0; m < 4; ++m) { const size_t row = (size_t)(grow0 + ai * 128 + m * 16 - rowoff); const f32x4 v0 = acc[ai][bj][m][0], v1 = acc[ai][bj][m][1];
                            u32x4 w; w.x = pkh2(logf_gate_fast(v0[0], la[0]), logf_gate_fast(v0[1], la[1])); w.y = pkh2(logf_gate_fast(v0[2], la[2]), logf_gate_fast(v0[3], la[3]));
                            w.z = pkh2(logf_gate_fast(v1[0], lb4[0]), logf_gate_fast(v1[1], lb4[1])); w.w = pkh2(logf_gate_fast(v1[2], lb4[2]), logf_gate_fast(v1[3], lb4[3]));
                            *(u32x4*)(dst + row * 512 + c0) = w; } }
            } else {
                bf16_t* const bq_ = opq(BQ); bf16_t* const bv_ = opq(BV); bf16_t* const bg_ = opq(BG); bf16_t* dst = which == 0 ? bq_ : (which == 1 ? bv_ : bg_);
#pragma unroll
                for (int ai = 0; ai < 2; ++ai)
#pragma unroll
                    for (int m = 0; m < 4; ++m) { const size_t row = (size_t)(grow0 + ai * 128 + m * 16 - rowoff);
#pragma unroll
                        for (int bj = 0; bj < 2; ++bj) { const f32x4 v0 = acc[ai][bj][m][0], v1 = acc[ai][bj][m][1];
                            u32x4 w; w.x = gp::cvt_pk_bf16(v0[0], v0[1]); w.y = gp::cvt_pk_bf16(v0[2], v0[3]); w.z = gp::cvt_pk_bf16(v1[0], v1[1]); w.w = gp::cvt_pk_bf16(v1[2], v1[3]);
                            *(u32x4*)(dst + row * 512 + cb0 + bj * 128) = w; } }
            }
        } else if (pn == 13) {
#pragma unroll
            for (int ai = 0; ai < 2; ++ai)
#pragma unroll
                for (int m = 0; m < 4; ++m) { const int grow = grow0 + ai * 128 + m * 16; const size_t row = (size_t)(grow - rowoff); float ss = 0.f;
#pragma unroll
                    for (int bj = 0; bj < 2; ++bj) { const f32x4 v0 = acc[ai][bj][m][0], v1 = acc[ai][bj][m][1];
                        ss += v0[0] * v0[0] + v0[1] * v0[1] + v0[2] * v0[2] + v0[3] * v0[3] + v1[0] * v1[0] + v1[1] * v1[1] + v1[2] * v1[2] + v1[3] * v1[3];
                        u32x4 w; w.x = gp::cvt_pk_bf16(v0[0], v0[1]); w.y = gp::cvt_pk_bf16(v0[2], v0[3]); w.z = gp::cvt_pk_bf16(v1[0], v1[1]); w.w = gp::cvt_pk_bf16(v1[2], v1[3]);
                        *(u32x4*)(CQKV + row * 384 + bj * 128 + wc * 32 + 8 * fq) = w; }
                    ss += __shfl_xor(ss, 16); ss += __shfl_xor(ss, 32);
                    if (fq == 0) RS[(size_t)grow * 8 + wc] = ss; }
        } else {
#pragma unroll
            for (int ai = 0; ai < 2; ++ai)
#pragma unroll
                for (int m = 0; m < 4; ++m) { const int grow = grow0 + ai * 128 + m * 16, t = t0 + ai * 128 + m * 16; const size_t row = (size_t)(grow - rowoff);
                    const f32x4 v0 = acc[ai][0][m][0], v1 = acc[ai][0][m][1];
                    float ss = v0[0] * v0[0] + v0[1] * v0[1] + v0[2] * v0[2] + v0[3] * v0[3] + v1[0] * v1[0] + v1[1] * v1[1] + v1[2] * v1[2] + v1[3] * v1[3];
                    u32x4 w; w.x = gp::cvt_pk_bf16(v0[0], v0[1]); w.y = gp::cvt_pk_bf16(v0[2], v0[3]); w.z = gp::cvt_pk_bf16(v1[0], v1[1]); w.w = gp::cvt_pk_bf16(v1[2], v1[3]);
                    *(u32x4*)(CQKV + row * 384 + 256 + wc * 32 + 8 * fq) = w;
                    ss += __shfl_xor(ss, 16); ss += __shfl_xor(ss, 32);
                    if (fq == 0) RS[(size_t)grow * 8 + 4 + wc] = ss;
                    if (wc == 0) { f32x4 x1 = acc[ai][1][m][0], x2 = acc[ai][1][m][1];
                        if (lat) { const f32x4 cc = *(const f32x4*)(ropc_c + t * 16 + 4 * fq), sn = *(const f32x4*)(ropc_s + t * 16 + 4 * fq); const f32x4 o1 = x1 * cc - x2 * sn, o2 = x1 * sn + x2 * cc; x1 = o1; x2 = o2; }
                        *(uint2*)(CKR + row * 32 + 4 * fq) = make_uint2(gp::cvt_pk_bf16(x1[0], x1[1]), gp::cvt_pk_bf16(x1[2], x1[3]));
                        *(uint2*)(CKR + row * 32 + 16 + 4 * fq) = make_uint2(gp::cvt_pk_bf16(x2[0], x2[1]), gp::cvt_pk_bf16(x2[2], x2[3])); } }
        }
    }
};

struct EpiC {
    static constexpr bool PERM = true;
    bf16_t *CQ, *CKV; const float* RS; const float *ropc_c, *ropc_s; int pmoff;
    __device__ __forceinline__ void operator()(const f32x4 (&acc)[2][2][4][2], const gp::GUnit& u, int wr, int wc, int fr, int fq) const {
        const int pn = u.pn; const int pr = (u.pm + pmoff) % 33; const bool lat = pr < 32;
        const int grow0 = u.pm * 256 + wr * 64 + fr; const int t0 = pr * 256 + wr * 64 + fr;
#pragma unroll
        for (int ai = 0; ai < 2; ++ai)
#pragma unroll
            for (int m = 0; m < 4; ++m) { const size_t row = (size_t)(grow0 + ai * 128 + m * 16); const int t = t0 + ai * 128 + m * 16;
                if (pn < 3) { const f32x4 p4 = *(const f32x4*)(RS + row * 8); const float rq = rsqrtf(((p4[0] + p4[1]) + (p4[2] + p4[3])) * (1.f / 256.f) + EPS) * (0.10206207261596577f * LOG2E);
#pragma unroll
                    for (int bj = 0; bj < 2; ++bj) { const int gi = pn * 8 + bj * 4 + wc, head = gi / 3, part = gi - head * 3;
                        f32x4 v0 = acc[ai][bj][m][0] * rq, v1 = acc[ai][bj][m][1] * rq;
                        bf16_t* p = CQ + row * 768 + head * 96;
                        if (part < 2) { u32x4 w; w.x = gp::cvt_pk_bf16(v0[0], v0[1]); w.y = gp::cvt_pk_bf16(v0[2], v0[3]); w.z = gp::cvt_pk_bf16(v1[0], v1[1]); w.w = gp::cvt_pk_bf16(v1[2], v1[3]);
                            *(u32x4*)(p + part * 32 + 8 * fq) = w; }
                        else { if (lat) { const f32x4 cc = *(const f32x4*)(ropc_c + t * 16 + 4 * fq), sn = *(const f32x4*)(ropc_s + t * 16 + 4 * fq); const f32x4 o1 = v0 * cc - v1 * sn, o2 = v0 * sn + v1 * cc; v0 = o1; v1 = o2; }
                            *(uint2*)(p + 64 + 4 * fq) = make_uint2(gp::cvt_pk_bf16(v0[0], v0[1]), gp::cvt_pk_bf16(v0[2], v0[3]));
                            *(uint2*)(p + 80 + 4 * fq) = make_uint2(gp::cvt_pk_bf16(v1[0], v1[1]), gp::cvt_pk_bf16(v1[2], v1[3])); } }
                } else { const f32x4 p4 = *(const f32x4*)(RS + row * 8 + 4); const float rkv = rsqrtf(((p4[0] + p4[1]) + (p4[2] + p4[3])) * (1.f / 128.f) + EPS);
#pragma unroll
                    for (int bj = 0; bj < 2; ++bj) { const f32x4 v0 = acc[ai][bj][m][0] * rkv, v1 = acc[ai][bj][m][1] * rkv;
                        u32x4 w; w.x = gp::cvt_pk_bf16(v0[0], v0[1]); w.y = gp::cvt_pk_bf16(v0[2], v0[3]); w.z = gp::cvt_pk_bf16(v1[0], v1[1]); w.w = gp::cvt_pk_bf16(v1[2], v1[3]);
                        *(u32x4*)(CKV + row * 1024 + (pn - 3) * 256 + bj * 128 + wc * 32 + 8 * fq) = w; } }
                asm volatile("" ::: "memory"); }
    }
};
struct EpiGate {
    static constexpr bool PERM = true;
    bf16_t* GATE; long nstride; int ld;
    __device__ __forceinline__ void operator()(const f32x4 (&acc)[2][2][4][2], const gp::GUnit& u, int wr, int wc, int fr, int fq) const {
        const int n3 = u.pn >> 2; bf16_t* base = GATE + (size_t)n3 * nstride + (u.pn & 3) * 256 + wc * 32 + 8 * fq; const int row0 = u.pm * 256 + wr * 64 + fr;
#pragma unroll
        for (int ai = 0; ai < 2; ++ai)
#pragma unroll
            for (int m = 0; m < 4; ++m) { bf16_t* rp = base + (size_t)(row0 + ai * 128 + m * 16) * ld;
#pragma unroll
                for (int bj = 0; bj < 2; ++bj) { const f32x4 v0 = acc[ai][bj][m][0], v1 = acc[ai][bj][m][1];
                    u32x4 w; w.x = gp::cvt_pk_bf16(fsigmoid(v0[0]), fsigmoid(v0[1])); w.y = gp::cvt_pk_bf16(fsigmoid(v0[2]), fsigmoid(v0[3])); w.z = gp::cvt_pk_bf16(fsigmoid(v1[0]), fsigmoid(v1[1])); w.w = gp::cvt_pk_bf16(fsigmoid(v1[2]), fsigmoid(v1[3]));
                    *(u32x4*)(rp + bj * 128) = w; } }
    }
};
struct SchedMerge {
    static constexpr bool GATHER = false;
    const bf16_t *A0, *A1, *A2; const bf16_t* Bt; int nM, G_, c, skipctx, lda2, ldb2;
    __device__ __forceinline__ bool next(int i, gp::GUnit& u) const {
        const int j = i / 3, n = i - 3 * j; int pmv, pn; if (!gp::tile_order(j, G_, c, nM, 4, pmv, pn)) return false;
        const int pm = skipctx ? pmv + pmv / 32 : pmv;
        const bf16_t* a0 = opq(A0); const bf16_t* a1 = opq(A1); const bf16_t* a2 = opq(A2);
        const bf16_t* a = n == 0 ? a0 : (n == 1 ? a1 : a2);
        u.A = (const char*)(a + (size_t)pm * 256 * 512); u.B = (const char*)(Bt + (size_t)n * 1024 * 512 + (size_t)pn * 256 * 512); u.nt = 8; u.pm = pm; u.pn = pn; u.tag = n; u.goff = nullptr; return true;
    }
};
__device__ __forceinline__ float bflo(unsigned w) { return __uint_as_float(w << 16); }
__device__ __forceinline__ float bfhi(unsigned w) { return __uint_as_float(w & 0xffff0000u); }
struct EpiMerge {
    static constexpr bool PERM = true;
    const bf16_t* GATE; long nstride; int ld; bf16_t* Y;
    __device__ __forceinline__ void operator()(const f32x4 (&acc)[2][2][4][2], const gp::GUnit& u, int wr, int wc, int fr, int fq) const {
        const int n3 = u.tag; const int col = u.pn * 256 + wc * 32 + 8 * fq; const bf16_t* gb = GATE + (size_t)n3 * nstride + col; const int row0 = u.pm * 256 + wr * 64 + fr;
#pragma unroll
        for (int ai = 0; ai < 2; ++ai)
#pragma unroll
            for (int m = 0; m < 4; ++m) { const size_t row = (size_t)(row0 + ai * 128 + m * 16);
#pragma unroll
                for (int bj = 0; bj < 2; ++bj) { const u32x4 g = *(const u32x4*)(gb + row * ld + bj * 128); u32x4* yp = (u32x4*)(Y + row * 1024 + col + bj * 128);
                    const f32x4 v0 = acc[ai][bj][m][0], v1 = acc[ai][bj][m][1];
                    float r[8] = {v0[0] * bflo(g.x), v0[1] * bfhi(g.x), v0[2] * bflo(g.y), v0[3] * bfhi(g.y), v1[0] * bflo(g.z), v1[1] * bfhi(g.z), v1[2] * bflo(g.w), v1[3] * bfhi(g.w)};
                    if (n3 != 0) { const u32x4 o = __builtin_nontemporal_load(yp);     r[0] += bflo(o.x); r[1] += bfhi(o.x); r[2] += bflo(o.y); r[3] += bfhi(o.y); r[4] += bflo(o.z); r[5] += bfhi(o.z); r[6] += bflo(o.w); r[7] += bfhi(o.w); }
                    u32x4 w; w.x = gp::cvt_pk_bf16(r[0], r[1]); w.y = gp::cvt_pk_bf16(r[2], r[3]); w.z = gp::cvt_pk_bf16(r[4], r[5]); w.w = gp::cvt_pk_bf16(r[6], r[7]);
                    *yp = w; }
                asm volatile("" ::: "memory"); }
    }
};
struct EpiOut {
    static constexpr bool PERM = false;
    const float *xl_src, *xc_src; float *xl_dst, *xc_dst; const float* mod; int pmoff;
    __device__ __forceinline__ void operator()(const f32x4 (&acc)[2][2][4][2], const gp::GUnit& u, int wr, int wc, int fr, int fq) const {
        const int gpm = u.pm + pmoff, b = gpm / 33, pr = gpm - b * 33; const bool lat = pr < 32;
        const float* xs = opq(lat ? xl_src : xc_src); float* xd = opq(lat ? xl_dst : xc_dst);
        const size_t rbase = lat ? ((size_t)b * SEQ + pr * 256) : ((size_t)b * CTXL);
        const float* gt = mod + (size_t)(lat ? b : 4) * 6144 + 2048; const int col0 = u.pn * 256 + wc * 32 + 4 * fq;
#pragma unroll
        for (int ai = 0; ai < 2; ++ai)
#pragma unroll
            for (int m = 0; m < 4; ++m) { const size_t off = (rbase + ai * 128 + wr * 64 + m * 16 + fr) * D + col0;
#pragma unroll
                for (int bj = 0; bj < 2; ++bj)
#pragma unroll
                    for (int n = 0; n < 2; ++n) { const int cc = bj * 128 + n * 16; const f32x4 g4 = *(const f32x4*)(gt + col0 + cc); const f32x4 xv = *(const f32x4*)(xs + off + cc);
                        *(f32x4*)(xd + off + cc) = xv + g4 * acc[ai][bj][m][n]; }
                asm volatile("" ::: "memory"); }
    }
};
template <bool GATHER_> struct SchedMoE {
    static constexpr bool GATHER = GATHER_;
    const bf16_t* A; const bf16_t* Bt; const int* tile_e; const unsigned* goff; int K, nM, nN, G_, c, lda2, ldb2; long strideB;
    __device__ __forceinline__ bool next(int i, gp::GUnit& u) const {
        int pm, pn; if (!gp::tile_order(i, G_, c, nM, nN, pm, pn)) return false;
        const int e = tile_e[pm];
        u.A = GATHER ? (const char*)A : (const char*)(A + (size_t)pm * 256 * K); u.B = (const char*)(Bt + (size_t)e * strideB + (size_t)pn * 256 * K); u.nt = K / 64; u.pm = pm; u.pn = pn; u.tag = e;
        u.goff = GATHER ? goff + (size_t)pm * 256 : nullptr; return true;
    }
};
struct EpiUp {
    static constexpr bool PERM = true;
    bf16_t* AUP;
    __device__ __forceinline__ void operator()(const f32x4 (&acc)[2][2][4][2], const gp::GUnit& u, int wr, int wc, int fr, int fq) const {
        const int row0 = u.pm * 256 + wr * 64 + fr; bf16_t* base = AUP + u.pn * 128 + wc * 32 + 8 * fq;
#pragma unroll
        for (int ai = 0; ai < 2; ++ai)
#pragma unroll
            for (int m = 0; m < 4; ++m) { const f32x4 a0 = acc[ai][0][m][0], a1 = acc[ai][0][m][1], b0 = acc[ai][1][m][0], b1 = acc[ai][1][m][1];
                float r[8];
#pragma unroll
                for (int e = 0; e < 4; ++e) { r[e] = a0[e] * fsigmoid(a0[e]) * b0[e]; r[4 + e] = a1[e] * fsigmoid(a1[e]) * b1[e]; }
                u32x4 w; w.x = gp::cvt_pk_bf16(r[0], r[1]); w.y = gp::cvt_pk_bf16(r[2], r[3]); w.z = gp::cvt_pk_bf16(r[4], r[5]); w.w = gp::cvt_pk_bf16(r[6], r[7]);
                *(u32x4*)(base + (size_t)(row0 + ai * 128 + m * 16) * 256) = w; }
    }
};
struct EpiDown {
    static constexpr bool PERM = true;
    bf16_t* YM2; const int* perm; const float* posw;
    __device__ __forceinline__ void operator()(const f32x4 (&acc)[2][2][4][2], const gp::GUnit& u, int wr, int wc, int fr, int fq) const {
        const int row0 = u.pm * 256 + wr * 64 + fr; const int col = u.pn * 256 + wc * 32 + 8 * fq;
#pragma unroll
        for (int ai = 0; ai < 2; ++ai)
#pragma unroll
            for (int m = 0; m < 4; ++m) { const int pos = row0 + ai * 128 + m * 16; const int pe = perm[pos]; const float w8 = posw[pos];
                if (pe >= 0) {
#pragma unroll
                    for (int bj = 0; bj < 2; ++bj) { const f32x4 v0 = acc[ai][bj][m][0] * w8, v1 = acc[ai][bj][m][1] * w8;
                        u32x4 w; w.x = gp::cvt_pk_bf16(v0[0], v0[1]); w.y = gp::cvt_pk_bf16(v0[2], v0[3]); w.z = gp::cvt_pk_bf16(v1[0], v1[1]); w.w = gp::cvt_pk_bf16(v1[2], v1[3]);
                        *(u32x4*)(YM2 + (size_t)pe * 1024 + col + bj * 128) = w; } } }
    }
};
enum { MAP_WIN = 1, MAP_WC = 2, MAP_WUP = 3 };
__device__ __forceinline__ int colmap(int kind, int p) {
    if (kind == MAP_WIN) {
        if (p >= 3840) return MIXW + (p - 3840);
        const int pn = p >> 8, q = p & 255, bj = q >> 7, wc = (q >> 5) & 3, j = q & 31;
        if (pn < 3) return (pn * 4 + wc) * 64 + bj * 32 + j;
        if (pn < 14) return p;
        if (bj == 0) return p;
        if (wc != 0) return -1;
        return 3712 + 16 * ((j >> 2) & 1) + 4 * (j >> 3) + (j & 3);
    }
    return p;
}
constexpr int NCHK = RPB / 64;
struct ScanArgs { const bf16_t* BQ; const bf16_t* BV; const bf16_t* BG; const f16_t* BLF; const f16_t* BLB; bf16_t* ST; float* DS; bf16_t* OB; const float* gn; int in_off; int out_off; int skipctx_out; int pad; };
#define MFMA16(a, b, c) __builtin_amdgcn_mfma_f32_16x16x32_bf16(a, b, c, 0, 0, 0)
constexpr int SC_RAW = 0, SC_VT = 32768, SC_A = SC_VT + 9216;
__device__ __forceinline__ void scan_stage(LAS char* lds, const ScanArgs& a, size_t row0, int h, int tid) {
    LAS float* RAW = (LAS float*)(lds + SC_RAW); LAS bf16_t* VT = (LAS bf16_t*)(lds + SC_VT);
    const int row = tid >> 3, c8 = (tid & 7) * 8; const size_t off = (row0 + row) * 512 + h * 64 + c8;
    typedef _Float16 h8 __attribute__((ext_vector_type(8)));
    const h8 lf = *(const h8*)(a.BLF + off), lb = *(const h8*)(a.BLB + off); const bf16x8 v = *(const bf16x8*)(a.BV + off);
#pragma unroll
    for (int j = 0; j < 8; ++j) { RAW[row * 64 + c8 + j] = (float)lf[j]; RAW[4096 + row * 64 + c8 + j] = (float)lb[j]; VT[(c8 + j) * 72 + row] = (bf16_t)v[j]; }
}
__device__ __forceinline__ void scan_cumsum(LAS char* lds, LAS float* XCH, int tid, float (&lf)[16], float (&bc)[16], float& total) {
    LAS float* RAW = (LAS float*)(lds + SC_RAW);
    const int col = tid & 127, dir = col >> 6, d = col & 63, seg = tid >> 7;
#pragma unroll
    for (int j = 0; j < 16; ++j) lf[j] = RAW[dir * 4096 + (16 * seg + j) * 64 + d];
    if (dir == 0) { float c = 0.f;
#pragma unroll
        for (int j = 0; j < 16; ++j) { c += lf[j]; bc[j] = c; } }
    else { float c = 0.f;
#pragma unroll
        for (int j = 15; j >= 0; --j) { c += lf[j]; bc[j] = c; } }
    XCH[seg * 128 + col] = dir == 0 ? bc[15] : bc[0];
    __syncthreads();
    const float t0 = XCH[col], t1 = XCH[128 + col], t2 = XCH[256 + col], t3 = XCH[384 + col];
    total = (t0 + t1) + (t2 + t3);
    float off;
    if (dir == 0) off = seg == 0 ? 0.f : (seg == 1 ? t0 : (seg == 2 ? t0 + t1 : t0 + t1 + t2));
    else off = seg == 3 ? 0.f : (seg == 2 ? t3 : (seg == 1 ? t3 + t2 : t3 + t2 + t1));
#pragma unroll
    for (int j = 0; j < 16; ++j) bc[j] += off;
}
__device__ __forceinline__ void scan_s1_unit(LAS char* lds, const ScanArgs& a, int b, int h, int k) {
    const int tid = opaque_tid(), lane = tid & 63, wid = tid >> 6;
    LAS bf16_t* VT = (LAS bf16_t*)(lds + SC_VT); LAS bf16_t* KKT = (LAS bf16_t*)(lds + SC_A); LAS float* XCH = (LAS float*)(lds + SC_A + 18432);
    const size_t row0 = (size_t)b * RPB + 64 * k - a.in_off;
    scan_stage(lds, a, row0, h, tid);
    __syncthreads();
    float lf[16], bc[16], total; scan_cumsum(lds, XCH, tid, lf, bc, total);
    const int col = tid & 127, dir = col >> 6, d = col & 63, seg = tid >> 7;
    const size_t sidx = ((size_t)((b * 8 + h) * 2 + dir)) * NCHK + k;
    { unsigned w[8];
#pragma unroll
      for (int j = 0; j < 16; j += 2) { const float k0 = (1.f - fexp(lf[j])) * fexp(total - bc[j]), k1 = (1.f - fexp(lf[j + 1])) * fexp(total - bc[j + 1]); w[j >> 1] = pkbf(k0, k1); }
      LAS u32x4* kp = (LAS u32x4*)(KKT + (dir * 64 + d) * 72 + 16 * seg); kp[0] = (u32x4){w[0], w[1], w[2], w[3]}; kp[1] = (u32x4){w[4], w[5], w[6], w[7]};
      if (seg == 0) a.DS[sidx * 64 + d] = fexp(total); }
    __syncthreads();
    { const int wdir = wid >> 2, et = wid & 3, fr = lane & 15, fq = lane >> 4;
      f32x4 acc[4];
#pragma unroll
      for (int dt = 0; dt < 4; ++dt) acc[dt] = (f32x4){0.f, 0.f, 0.f, 0.f};
#pragma unroll
      for (int ks = 0; ks < 2; ++ks) { const bf16x8 af = *(const LAS bf16x8*)(VT + (16 * et + fr) * 72 + 32 * ks + 8 * fq);
#pragma unroll
          for (int dt = 0; dt < 4; ++dt) { const bf16x8 bfv = *(const LAS bf16x8*)(KKT + (wdir * 64 + 16 * dt + fr) * 72 + 32 * ks + 8 * fq); acc[dt] = MFMA16(af, bfv, acc[dt]); } }
      bf16_t* sp = a.ST + (((size_t)((b * 8 + h) * 2 + wdir)) * NCHK + k) * 4096;
#pragma unroll
      for (int dt = 0; dt < 4; ++dt)
#pragma unroll
          for (int r = 0; r < 4; ++r) sp[(16 * et + 4 * fq + r) * 64 + 16 * dt + fr] = f2bf(acc[dt][r]); }
    __syncthreads();
}
__device__ __forceinline__ void scan_s2_task(const ScanArgs& a, int task) {
    const int chain = task >> 2, quarter = task & 3, dir = chain & 1, tid = opaque_tid();
    const int e = 16 * quarter + (tid >> 5), d = 2 * (tid & 31);
    float s0 = 0.f, s1 = 0.f;
    for (int g = 0; g < NCHK; g += 12) {
        unsigned L[12]; float2 Dv[12]; unsigned* pp[12];
#pragma unroll
        for (int j = 0; j < 12; ++j) { const int step = g + j; const int k = dir == 0 ? (step < 4 ? 128 + step : step - 4) : (step < 4 ? 131 - step : 131 - step);
            const size_t idx = (size_t)chain * NCHK + k; pp[j] = (unsigned*)(a.ST + idx * 4096 + e * 64 + d); L[j] = *pp[j]; Dv[j] = *(const float2*)(a.DS + idx * 64 + d); }
#pragma unroll
        for (int j = 0; j < 12; ++j) { *pp[j] = pkbf(s0, s1); s0 = Dv[j].x * s0 + bflo(L[j]); s1 = Dv[j].y * s1 + bfhi(L[j]); }
    }
}
__device__ __forceinline__ void scan_s3_unit(LAS char* lds, const ScanArgs& a, int b, int h, int k) {
    const int tid = opaque_tid(), lane = tid & 63, wid = tid >> 6;
    LAS float* BC = (LAS float*)(lds + SC_RAW); LAS bf16_t* VT = (LAS bf16_t*)(lds + SC_VT);
    LAS bf16_t* STL = (LAS bf16_t*)(lds + SC_A);
    LAS float* XCH = (LAS float*)(lds + SC_A + 18432);
    LAS float* OSUM = (LAS float*)(lds + SC_A + 18432 + 2048);
    LAS bf16_t* PW = (LAS bf16_t*)(lds + SC_A + 18432 + 2048 + 16384) + wid * 3456;
    const size_t row0 = (size_t)b * RPB + 64 * k - a.in_off;
    scan_stage(lds, a, row0, h, tid);
    { const int sd = tid >> 8, e = (tid & 255) >> 2, c16 = (tid & 3) * 16;
      const bf16_t* sp = a.ST + (((size_t)((b * 8 + h) * 2 + sd)) * NCHK + k) * 4096 + e * 64 + c16;
      const u32x4 s0 = *(const u32x4*)sp, s1 = *(const u32x4*)(sp + 8);
      LAS u32x4* dp = (LAS u32x4*)(STL + (sd * 64 + e) * 72 + c16); dp[0] = s0; dp[1] = s1; }
    __syncthreads();
    { float lf[16], bc[16], total; scan_cumsum(lds, XCH, tid, lf, bc, total);
      const int col = tid & 127, dir = col >> 6, d = col & 63, seg = tid >> 7;
      __syncthreads();
#pragma unroll
      for (int j = 0; j < 16; ++j) BC[dir * 4096 + (16 * seg + j) * 64 + d] = bc[j]; }
    __syncthreads();
    const int dir = wid >> 2, si = wid & 3;
    LAS bf16_t* QP = PW; LAS bf16_t* KP = PW + 1152; LAS bf16_t* ATT = PW + 2304;
    const int erow = lane >> 2, dg = (lane & 3) * 16;
    const int fr = lane & 15, fq = lane >> 4;
    LAS const float* bcd = BC + dir * 4096;
    float refv[16];
    { const int rr = dir == 0 ? 16 * si - 1 : 16 * (si + 1);
#pragma unroll
      for (int j = 0; j < 16; ++j) refv[j] = (rr >= 0 && rr < 64) ? bcd[rr * 64 + dg + j] : 0.f; }
    float qv[16], bq[16];
    { const bf16_t* qp = a.BQ + (row0 + 16 * si + erow) * 512 + h * 64 + dg; const bf16x8 q0 = *(const bf16x8*)qp, q1 = *(const bf16x8*)(qp + 8);
#pragma unroll
      for (int j = 0; j < 8; ++j) { qv[j] = bf2f((bf16_t)q0[j]); qv[8 + j] = bf2f((bf16_t)q1[j]); }
#pragma unroll
      for (int j = 0; j < 16; ++j) bq[j] = bcd[(16 * si + erow) * 64 + dg + j]; }
    { unsigned w[8];
#pragma unroll
      for (int j = 0; j < 16; j += 2) w[j >> 1] = pkbf(qv[j] * fexp(bq[j] - refv[j]), qv[j + 1] * fexp(bq[j + 1] - refv[j + 1]));
      LAS u32x4* p = (LAS u32x4*)(QP + erow * 72 + dg); p[0] = (u32x4){w[0], w[1], w[2], w[3]}; p[1] = (u32x4){w[4], w[5], w[6], w[7]};
      LAS u32x4* z = (LAS u32x4*)(ATT + erow * 72 + dg); z[0] = (u32x4){0u, 0u, 0u, 0u}; z[1] = (u32x4){0u, 0u, 0u, 0u}; }
    const int j_lo = dir == 0 ? 0 : si, j_hi = dir == 0 ? si : 3;
    for (int jb = j_lo; jb <= j_hi; ++jb) {
        { const int sg = 16 * jb + erow; const int sn = dir == 0 ? sg - 1 : sg + 1; unsigned w[8];
#pragma unroll
          for (int j = 0; j < 16; j += 2) { float kk[2];
#pragma unroll
              for (int t = 0; t < 2; ++t) { const float bs = bcd[sg * 64 + dg + j + t]; const float bn = (sn >= 0 && sn < 64) ? bcd[sn * 64 + dg + j + t] : 0.f;
                  kk[t] = (1.f - fexp(bs - bn)) * fexp(fminf(refv[j + t] - bs, 60.f)); }
              w[j >> 1] = pkbf(kk[0], kk[1]); }
          LAS u32x4* p = (LAS u32x4*)(KP + erow * 72 + dg); p[0] = (u32x4){w[0], w[1], w[2], w[3]}; p[1] = (u32x4){w[4], w[5], w[6], w[7]}; }
        __builtin_amdgcn_wave_barrier(); asm volatile("s_waitcnt lgkmcnt(0)" ::: "memory");
        f32x4 c = (f32x4){0.f, 0.f, 0.f, 0.f};
#pragma unroll
        for (int ks = 0; ks < 2; ++ks) { const bf16x8 af = *(const LAS bf16x8*)(QP + fr * 72 + 32 * ks + 8 * fq), bfv = *(const LAS bf16x8*)(KP + fr * 72 + 32 * ks + 8 * fq); c = MFMA16(af, bfv, c); }
#pragma unroll
        for (int r = 0; r < 4; ++r) { const int tq = 4 * fq + r; float v = c[r];
            if (jb == si) { if (dir == 0 ? (fr > tq) : (fr < tq)) v = 0.f; }
            ATT[tq * 72 + 16 * jb + fr] = f2bf(v); }
        __builtin_amdgcn_wave_barrier(); asm volatile("s_waitcnt lgkmcnt(0)" ::: "memory");
    }
    { unsigned w[8];
#pragma unroll
      for (int j = 0; j < 16; j += 2) w[j >> 1] = pkbf(qv[j] * fexp(bq[j]), qv[j + 1] * fexp(bq[j + 1]));
      LAS u32x4* p = (LAS u32x4*)(QP + erow * 72 + dg); p[0] = (u32x4){w[0], w[1], w[2], w[3]}; p[1] = (u32x4){w[4], w[5], w[6], w[7]}; }
    __builtin_amdgcn_wave_barrier(); asm volatile("s_waitcnt lgkmcnt(0)" ::: "memory");
    f32x4 o[4];
#pragma unroll
    for (int n = 0; n < 4; ++n) o[n] = (f32x4){0.f, 0.f, 0.f, 0.f};
#pragma unroll
    for (int ks = 0; ks < 2; ++ks) { const bf16x8 aq = *(const LAS bf16x8*)(QP + fr * 72 + 32 * ks + 8 * fq), aa = *(const LAS bf16x8*)(ATT + fr * 72 + 32 * ks + 8 * fq);
#pragma unroll
        for (int n = 0; n < 4; ++n) { const bf16x8 bs = *(const LAS bf16x8*)(STL + (dir * 64 + 16 * n + fr) * 72 + 32 * ks + 8 * fq), bv = *(const LAS bf16x8*)(VT + (16 * n + fr) * 72 + 32 * ks + 8 * fq);
            o[n] = MFMA16(aq, bs, o[n]); o[n] = MFMA16(aa, bv, o[n]); } }
    if (dir == 0) {
#pragma unroll
        for (int n = 0; n < 4; ++n)
#pragma unroll
            for (int r = 0; r < 4; ++r) OSUM[(16 * si + 4 * fq + r) * 64 + 16 * n + fr] = o[n][r]; }
    __syncthreads();
    if (dir == 1) {
        const bool wr_out = !(a.skipctx_out && k >= 128) && !a.pad;
        float ss[4] = {0.f, 0.f, 0.f, 0.f};
#pragma unroll
        for (int n = 0; n < 4; ++n)
#pragma unroll
            for (int r = 0; r < 4; ++r) { o[n][r] += OSUM[(16 * si + 4 * fq + r) * 64 + 16 * n + fr]; ss[r] += o[n][r] * o[n][r]; }
#pragma unroll
        for (int r = 0; r < 4; ++r) { ss[r] += __shfl_xor(ss[r], 1); ss[r] += __shfl_xor(ss[r], 2); ss[r] += __shfl_xor(ss[r], 4); ss[r] += __shfl_xor(ss[r], 8); ss[r] = rsqrtf(ss[r] * (1.f / 64.f) + EPS); }
        if (wr_out) {
            const size_t orow0 = (size_t)b * RPB + 64 * k - a.out_off;
#pragma unroll
            for (int n = 0; n < 4; ++n)
#pragma unroll
                for (int r = 0; r < 4; ++r) { const int tq = 16 * si + 4 * fq + r, e = 16 * n + fr; const float gv = bf2f(a.BG[(row0 + tq) * 512 + h * 64 + e]);
                    a.OB[(orow0 + tq) * 512 + h * 64 + e] = f2bf(o[n][r] * ss[r] * a.gn[h * 64 + e] * gv * fsigmoid(gv)); }
        }
    }
    __syncthreads();
}
constexpr int SCAN_LDS = SC_A + 18432 + 2048 + 16384 + 8 * 6912;

#define XB_TMO      128
#define XB_XCNT(j)  (256  + 64 * (j))
#define XB_XSUB(j)  (1280 + 64 * (j))
#define XB_XGEN(j)  (2304 + 64 * (j))
#define XB_TOP      3328
#define XB_TOPGEN   3392
#define XCD_BAR_WORDS 3456
#define XB_SPIN_CAP (1u << 18)

__device__ __forceinline__ unsigned xb_ld(unsigned* p)              { return __hip_atomic_load(p, __ATOMIC_RELAXED, __HIP_MEMORY_SCOPE_AGENT); }
__device__ __forceinline__ unsigned xb_add(unsigned* p, unsigned v) { return __hip_atomic_fetch_add(p, v, __ATOMIC_RELAXED, __HIP_MEMORY_SCOPE_AGENT); }
__device__ __forceinline__ unsigned xb_xcc_id() { return (unsigned)__builtin_amdgcn_s_getreg((3 << 11) | 20) & 0xFu; }
#define XB_SPIN(cond, bar) do { unsigned _sp = 0; while (cond) { __builtin_amdgcn_s_sleep(1); \
    if ((++_sp & 255u) == 0u) { if (xb_ld(&(bar)[XB_TMO])) break; if (_sp > XB_SPIN_CAP) { atomicAdd(&(bar)[XB_TMO], 1u); break; } } } } while (0)

struct XcdBarrier {
    unsigned* bar; unsigned x;
    volatile LAS unsigned* st;
};

__device__ __forceinline__ XcdBarrier xcd_barrier_post(unsigned* bar, volatile LAS unsigned* st) {
    XcdBarrier b; b.bar = bar; b.x = xb_xcc_id(); b.st = st;
    if (threadIdx.x == 0) (void)xb_add(&bar[XB_XCNT(b.x)], 1u);
    return b;
}
__device__ __forceinline__ void xcd_barrier_complete(unsigned* bar, unsigned x, unsigned& nloc, unsigned& nx) {
    const unsigned G = gridDim.x * gridDim.y * gridDim.z;
    unsigned sum, cnt, mine, sp = 0u;
    for (;;) {
        sum = 0u; cnt = 0u; mine = 0u;
#pragma unroll
        for (unsigned j = 0; j < 16; ++j) { const unsigned c = xb_ld(&bar[XB_XCNT(j)]); sum += c; cnt += (c > 0u) ? 1u : 0u; mine = (j == x) ? c : mine; }
        if (sum == G) break;
        __builtin_amdgcn_s_sleep(1);
        if ((++sp & 255u) == 0u) { if (xb_ld(&bar[XB_TMO])) break; if (sp > XB_SPIN_CAP) { atomicAdd(&bar[XB_TMO], 1u); break; } }
    }
    nloc = mine > 0u ? mine : 1u; nx = cnt > 0u ? cnt : 1u;
}

__device__ __forceinline__ void xcd_barrier(const XcdBarrier& b) {
    asm volatile("s_waitcnt vmcnt(0)" ::: "memory");
    __syncthreads();
    if (threadIdx.x == 0) {
        unsigned* bar = b.bar;
        __builtin_amdgcn_s_waitcnt(0);
        unsigned nloc = b.st[0], nx = b.st[1];
        if (nloc == 0u) { xcd_barrier_complete(bar, b.x, nloc, nx); b.st[0] = nloc; b.st[1] = nx; }
        const unsigned old = xb_add(&bar[XB_XSUB(b.x)], 1u);
        const unsigned gen = old / nloc;
        if (old + 1u == (gen + 1u) * nloc) {
            __builtin_amdgcn_fence(__ATOMIC_RELEASE, "agent");
            asm volatile("s_waitcnt vmcnt(0)" ::: "memory");
            const unsigned og = xb_add(&bar[XB_TOP], 1u);
            const unsigned tg = og / nx;
            if (og + 1u == (tg + 1u) * nx) xb_add(&bar[XB_TOPGEN], 1u);
            else XB_SPIN(xb_ld(&bar[XB_TOPGEN]) == tg, bar);
            __builtin_amdgcn_fence(__ATOMIC_ACQUIRE, "agent");
            xb_add(&bar[XB_XGEN(b.x)], 1u);
            asm volatile("s_waitcnt vmcnt(0)" ::: "memory");
        } else {
            XB_SPIN(xb_ld(&bar[XB_XGEN(b.x)]) == gen, bar);
            __builtin_amdgcn_fence(__ATOMIC_ACQUIRE, "agent");
            asm volatile("s_waitcnt vmcnt(0)" ::: "memory");
        }
    }
    __syncthreads();
}


constexpr size_t MiB = 1u << 20;
constexpr size_t CTL_ZERO_BYTES = 64 * 1024;
constexpr int CW_COUNTS = 8192, CW_CURSOR = 8192 + 128;
constexpr size_t O_MOD = 1 * MiB, O_LB = 1 * MiB + 512 * 1024, O_ROPA_C = 2 * MiB, O_ROPA_S = 3 * MiB, O_ROPC_C = 4 * MiB, O_ROPC_S = 4 * MiB + 512 * 1024, O_XC = 5 * MiB;
constexpr size_t O_ROUTE_E = 9 * MiB, O_ROUTE_W = 9 * MiB + 512 * 1024, O_PERM = 10 * MiB, O_POSW = 10 * MiB + 512 * 1024, O_GOFF = 11 * MiB, O_TILEE = 11 * MiB + 512 * 1024;
constexpr size_t O_WRT = 11 * MiB + 640 * 1024;
constexpr size_t O_RS = 12 * MiB, O_DS = 13 * MiB + 512 * 1024, O_WGH = 15 * MiB + 768 * 1024;
constexpr size_t O_WINP = 16 * MiB, O_WC = 30 * MiB, O_WBR = 32 * MiB, O_WOUT = 35 * MiB;
constexpr size_t O_H = 38 * MiB;
constexpr size_t O_AQ = 104 * MiB, O_AK = 137 * MiB, O_AV = 145 * MiB + 512 * 1024;
constexpr size_t O_BQ = 154 * MiB, O_BV = 187 * MiB, O_BG = 220 * MiB, O_BLF = 253 * MiB, O_BLB = 286 * MiB;
constexpr size_t O_CQKV = 319 * MiB, O_CKR = 344 * MiB, O_CQ = 347 * MiB, O_CKV = 397 * MiB, O_OC = 463 * MiB, WS_END = 496 * MiB;
constexpr size_t O_GATE = 187 * MiB;
constexpr size_t O_YM2 = 154 * MiB, O_AUP = 104 * MiB, O_WUP = 397 * MiB, O_WDN = 429 * MiB;
constexpr int LDS_BYTES = 163840, LDS_BAR_OFF = LDS_BYTES - 64, LDS_PTR_OFF = LDS_BYTES - 512;

struct KP { const float* in[24]; float* out; char* ws; int ph_lo, ph_hi; unsigned long long mask; };
struct Frame {
    LAS char* lds; char* ws; float* out;
};
#define WSP(T, off) ((T*)(F.ws + (off)))
__device__ __forceinline__ const float* in_ptr(const Frame& F, int k) { const volatile LAS unsigned* q = (const volatile LAS unsigned*)(F.lds + LDS_PTR_OFF + 8 * k);
    unsigned lo = q[0], hi = q[1]; lo = __builtin_amdgcn_readfirstlane(lo); hi = __builtin_amdgcn_readfirstlane(hi); return (const float*)(((unsigned long long)hi << 32) | lo); }
#define INP(k) in_ptr(F, k)
__device__ __forceinline__ float wave_sum_dpp(float v) {
    int x = __builtin_bit_cast(int, v);
#define DPP_ADD(ctrl, rmask) x = __builtin_bit_cast(int, __builtin_bit_cast(float, x) + __builtin_bit_cast(float, __builtin_amdgcn_update_dpp(0, x, ctrl, rmask, 0xF, false)))
    DPP_ADD(0xB1, 0xF);
    DPP_ADD(0x4E, 0xF);
    DPP_ADD(0x141, 0xF);
    DPP_ADD(0x140, 0xF);
    DPP_ADD(0x142, 0xA);
    DPP_ADD(0x143, 0xC);
#undef DPP_ADD
    return __builtin_bit_cast(float, __builtin_amdgcn_readlane(x, 63));
}
__device__ __forceinline__ float wave_sum(float v) {
#pragma unroll
    for (int o = 32; o >= 1; o >>= 1) v += __shfl_xor(v, o);
    return v;
}

__device__ __forceinline__ void p0_mod(const Frame& F) {
    const int tid = opaque_tid(), lane = tid & 63, wave = __builtin_amdgcn_readfirstlane(tid >> 6); (void)lane; (void)wave;
    LAS float* sc = (LAS float*)F.lds;
    LAS float* red = (LAS float*)(F.lds + 20480);
    for (int i = tid; i < 5 * 1024; i += 512) { const int r = i >> 10, k = i & 1023; const float v = r < 4 ? INP(1)[r * 1024 + k] : INP(3)[k]; sc[i] = v / (1.f + expf(-v)); }
    __syncthreads();
    float* MOD = WSP(float, O_MOD);
    for (int u = blockIdx.x; u < 2 * 96; u += gridDim.x) { const int l = u / 96, j = (u % 96) * 64 + lane;
        const float* w = INP(4) + (size_t)l * 1024 * 6144 + j; float a0 = 0.f, a1 = 0.f, a2 = 0.f, a3 = 0.f, a4 = 0.f;
#pragma unroll 8
        for (int kk = 0; kk < 128; ++kk) { const int k = wave * 128 + kk; const float wv = w[(size_t)k * 6144]; a0 += sc[k] * wv; a1 += sc[1024 + k] * wv; a2 += sc[2048 + k] * wv; a3 += sc[3072 + k] * wv; a4 += sc[4096 + k] * wv; }
        red[(wave * 5 + 0) * 64 + lane] = a0; red[(wave * 5 + 1) * 64 + lane] = a1; red[(wave * 5 + 2) * 64 + lane] = a2; red[(wave * 5 + 3) * 64 + lane] = a3; red[(wave * 5 + 4) * 64 + lane] = a4;
        __syncthreads();
        if (tid < 320) { const int r = tid >> 6, ln = tid & 63; float s = 0.f;
#pragma unroll
            for (int w8 = 0; w8 < 8; ++w8) s += red[(w8 * 5 + r) * 64 + ln];
            const int jj = (u % 96) * 64 + ln; MOD[(size_t)(l * 5 + r) * 6144 + jj] = s + INP(5)[l * 6144 + jj]; }
        __syncthreads();
    }
}
__device__ __forceinline__ void p0_tables(const Frame& F) {
    const int tid = opaque_tid(), lane = tid & 63, wave = __builtin_amdgcn_readfirstlane(tid >> 6); (void)lane; (void)wave;
    float* ropa_c = WSP(float, O_ROPA_C); float* ropa_s = WSP(float, O_ROPA_S); float* ropc_c = WSP(float, O_ROPC_C); float* ropc_s = WSP(float, O_ROPC_S); float* LB = WSP(float, O_LB);
    for (int i = blockIdx.x * 512 + tid; i < 8192 * 32; i += gridDim.x * 512) {
        { const int t = i >> 5, j = i & 31, row = t >> 6, col = t & 63, f = j & 15; const float inv = powf(10000.f, -(float)f / 16.f); const float ang = (j < 16 ? (float)row : (float)col) * inv;
          ropa_c[i] = (float)cos((double)ang); ropa_s[i] = (float)sin((double)ang); }
        if (i < 8192 * 16) { const int t = i >> 4, j = i & 15, row = t >> 6, col = t & 63, f = j & 7; const float inv = powf(10000.f, -(float)f / 8.f); const float ang = (j < 8 ? (float)row : (float)col) * inv;
          ropc_c[i] = (float)cos((double)ang); ropc_s[i] = (float)sin((double)ang); }
        if (i < 2 * 36 * 1024) { const int l = i / (36 * 1024), r2 = i - l * 36 * 1024, c = r2 >> 10, k = r2 & 1023;
          WSP(float, O_WRT)[i] = c < 4 ? INP(18)[(size_t)l * 1024 * 4 + k * 4 + c] : INP(19)[(size_t)l * 1024 * 32 + k * 32 + (c - 4)]; }
        if (i < 2048) { const int l = i >> 10, rest = i & 1023; if (l == 0) LB[i] = 0.f; else { const float a0 = INP(10)[rest], a1 = INP(10)[1024 + rest]; LB[i] = 1.f / (1.f + expf(a0 - a1)); } }
    }
}
template <class CM> __device__ __forceinline__ void wt_tile(const float* W, int ldw, const CM& cm, bf16_t* Bt, int K, int p0, int k0, LAS float* scr, int lane) {
    const int p4 = (lane & 7) * 4; const int c = cm(p0 + p4);
#pragma unroll
    for (int i = 0; i < 8; ++i) { const int kk = i * 8 + (lane >> 3); f32x4 v = (f32x4){0.f, 0.f, 0.f, 0.f};
        if (c >= 0) v = *(const f32x4*)(W + (size_t)(k0 + kk) * ldw + c);
        scr[kk * 33 + p4] = v[0]; scr[kk * 33 + p4 + 1] = v[1]; scr[kk * 33 + p4 + 2] = v[2]; scr[kk * 33 + p4 + 3] = v[3]; }
    asm volatile("s_waitcnt lgkmcnt(0)" ::: "memory"); __builtin_amdgcn_wave_barrier();
#pragma unroll 8
    for (int pi = 0; pi < 32; ++pi) Bt[(size_t)(p0 + pi) * K + k0 + lane] = f2bf(scr[lane * 33 + pi]);
    asm volatile("s_waitcnt lgkmcnt(0)" ::: "memory"); __builtin_amdgcn_wave_barrier();
}
struct CmWin { __device__ __forceinline__ int operator()(int p) const { return colmap(MAP_WIN, p); } };
struct CmId { __device__ __forceinline__ int operator()(int p) const { return p; } };
__device__ __forceinline__ void conv_weights_nonmoe(const Frame& F, int l) {
    const int tid = opaque_tid(), lane = tid & 63, wave = __builtin_amdgcn_readfirstlane(tid >> 6); (void)lane; (void)wave;
    LAS float* scr = (LAS float*)F.lds + wave * (64 * 33);
    const int gw = blockIdx.x * 8 + wave, NGW = gridDim.x * 8;
    constexpr int I_WIN = 216 * 16, I_BR = 3 * 32 * 8, I_OUT = 32 * 16;
    for (int it = gw; it < I_WIN + I_BR + I_OUT; it += NGW) {
        int r = it;
        if (r < I_WIN) { wt_tile(INP(8) + (size_t)l * 1024 * INW, INW, CmWin(), WSP(bf16_t, O_WINP), 1024, (r / 16) * 32, (r % 16) * 64, scr, lane); continue; } r -= I_WIN;
        if (r < I_BR) { const int n = r / 256, q = r % 256; wt_tile(INP(16) + ((size_t)l * 3 + n) * 512 * 1024, 1024, CmId(), WSP(bf16_t, O_WBR) + (size_t)n * 1024 * 512, 512, (q / 8) * 32, (q % 8) * 64, scr, lane); continue; } r -= I_BR;
        wt_tile(INP(17) + (size_t)l * 1024 * 1024, 1024, CmId(), WSP(bf16_t, O_WOUT), 1024, (r / 16) * 32, (r % 16) * 64, scr, lane);
    }
    const float* wuq = INP(14) + (size_t)l * 256 * 768; const float* wukv = INP(15) + (size_t)l * 128 * 1024; const float* gq = INP(12) + l * 256; const float* gkv = INP(13) + l * 128; bf16_t* WC = WSP(bf16_t, O_WC);
    for (int i = blockIdx.x * 512 + tid; i < 1792 * 384; i += gridDim.x * 512) {
        const int pp = i / 384, k = i % 384; float v = 0.f;
        if (pp < 768) { const int pn = pp >> 8, q = pp & 255, bj = q >> 7, wc = (q >> 5) & 3, j = q & 31; const int gi = pn * 8 + bj * 4 + wc, head = gi / 3, part = gi - head * 3;
            const int p = part < 2 ? head * 96 + part * 32 + j : head * 96 + 64 + 16 * ((j >> 2) & 1) + 4 * (j >> 3) + (j & 3);
            if (k < 256) v = wuq[k * 768 + p] * gq[k]; }
        else { if (k >= 256) v = wukv[(k - 256) * 1024 + (pp - 768)] * gkv[k - 256]; }
        WC[i] = f2bf(v); }
}
struct CmUp { __device__ __forceinline__ int operator()(int p) const { return ((p >> 8) << 7) + (p & 127); } };
__device__ __forceinline__ void conv_weights_moe(const Frame& F, int l) {
    const int tid = opaque_tid(), lane = tid & 63, wave = __builtin_amdgcn_readfirstlane(tid >> 6); (void)lane; (void)wave;
    LAS float* scr = (LAS float*)F.lds + wave * (64 * 33);
    const int gw = blockIdx.x * 8 + wave, NGW = gridDim.x * 8;
    constexpr int I_UP = 32 * 16 * 16, I_DN = 32 * 32 * 4;
    for (int it = gw; it < I_UP + I_DN; it += NGW) {
        int r = it;
        if (r < I_UP) { const int e = r / 256, q = r % 256, p0 = (q / 16) * 32, k0 = (q % 16) * 64; const bool isw3 = (p0 >> 7) & 1;
            const float* W = (isw3 ? INP(21) : INP(20)) + ((size_t)l * 32 + e) * 1024 * 256;
            wt_tile(W, 256, CmUp(), WSP(bf16_t, O_WUP) + (size_t)e * 512 * 1024, 1024, p0, k0, scr, lane); continue; } r -= I_UP;
        { const int e = r / 128, q = r % 128; wt_tile(INP(22) + ((size_t)l * 32 + e) * 256 * 1024, 1024, CmId(), WSP(bf16_t, O_WDN) + (size_t)e * 1024 * 256, 256, (q / 4) * 32, (q % 4) * 64, scr, lane); }
    }
}

__device__ __forceinline__ void rp_load(const float* xs, float* xd, bool wx, const bf16_t* ym, const float* gt, int lane, f32x4 (&v)[4], float& rinv) {
    float ss = 0.f;
#pragma unroll
    for (int j = 0; j < 4; ++j) { const int c = 4 * lane + 256 * j; v[j] = *(const f32x4*)(xs + c);
        if (ym) { const uint2 y0 = *(const uint2*)(ym + c), y1 = *(const uint2*)(ym + 1024 + c); const f32x4 g4 = *(const f32x4*)(gt + c);
            v[j][0] += g4[0] * (bflo(y0.x) + bflo(y1.x)); v[j][1] += g4[1] * (bfhi(y0.x) + bfhi(y1.x)); v[j][2] += g4[2] * (bflo(y0.y) + bflo(y1.y)); v[j][3] += g4[3] * (bfhi(y0.y) + bfhi(y1.y)); }
        if (wx) *(f32x4*)(xd + c) = v[j];
        ss += v[j][0] * v[j][0] + v[j][1] * v[j][1] + v[j][2] * v[j][2] + v[j][3] * v[j][3]; }
    rinv = rsqrtf(wave_sum(ss) * (1.f / D) + EPS);
}
__device__ __forceinline__ void rp_mod(const f32x4 (&v)[4], float rinv, const float* gn, const float* mo, int sh_off, int sc_off, bf16_t* hp, int lane, f32x4 (&hv)[4]) {
#pragma unroll
    for (int j = 0; j < 4; ++j) { const int c = 4 * lane + 256 * j; const f32x4 g4 = *(const f32x4*)(gn + c), s4 = *(const f32x4*)(mo + sc_off + c), h4 = *(const f32x4*)(mo + sh_off + c);
        hv[j] = v[j] * rinv * g4 * (s4 + 1.f) + h4;
        *(uint2*)(hp + c) = make_uint2(pkbf(hv[j][0], hv[j][1]), pkbf(hv[j][2], hv[j][3])); }
}
__device__ __forceinline__ void phase_rowpass1(const Frame& F, int l, bool combine, size_t h_off) {
    const int tid = opaque_tid(), lane = tid & 63, wave = __builtin_amdgcn_readfirstlane(tid >> 6); (void)lane; (void)wave;
    const int gw = blockIdx.x * 8 + wave, NGW = gridDim.x * 8;
    const float* xl = (l == 0) ? INP(0) : F.out; const float* xc = (l == 0) ? INP(2) : WSP(float, O_XC);
    const float* MODl = WSP(float, O_MOD) + (size_t)l * 5 * 6144; const float* MODp = WSP(float, O_MOD);
    for (int g = gw; g < G; g += NGW) { const RowInfo ri = rowinfo(g); const int mrow = ri.lat ? ri.b : 4; const size_t xo = xoff(ri);
        const float* xs = (ri.lat ? xl : xc) + xo; float* xd = (ri.lat ? F.out : WSP(float, O_XC)) + xo;
        f32x4 v[4], hv[4]; float rinv;
        rp_load(xs, xd, combine, combine ? WSP(bf16_t, O_YM2) + (size_t)g * 2048 : nullptr, MODp + (size_t)mrow * 6144 + 5120, lane, v, rinv);
        rp_mod(v, rinv, INP(6) + l * 1024, MODl + (size_t)mrow * 6144, 0, 1024, WSP(bf16_t, h_off) + (size_t)g * D, lane, hv); }
}
__device__ __forceinline__ void phase_rowpass2(const Frame& F, int l, bool last) {
    const int tid = opaque_tid(), lane = tid & 63, wave = __builtin_amdgcn_readfirstlane(tid >> 6); (void)lane; (void)wave;
    LAS float* WT = (LAS float*)F.lds;
    { const f32x4* src = (const f32x4*)(WSP(float, O_WRT) + (size_t)l * 36 * 1024);
      for (int i = tid; i < 36 * 256; i += 512) ((LAS f32x4*)WT)[i] = src[i]; }
    { int* perm = WSP(int, O_PERM); unsigned* goff = WSP(unsigned, O_GOFF);
      for (int i = blockIdx.x * 512 + tid; i < PMAX; i += gridDim.x * 512) { perm[i] = -1; goff[i] = 0u; } }
    if (tid < 32) ((LAS int*)(F.lds + 147456))[tid] = 0;
    __syncthreads();
    const int gw = blockIdx.x * 8 + wave, NGW = gridDim.x * 8;
    const float* MODl = WSP(float, O_MOD) + (size_t)l * 5 * 6144;
    int* route_e = WSP(int, O_ROUTE_E); float* route_w = WSP(float, O_ROUTE_W); LAS int* hist = (LAS int*)(F.lds + 147456);
    for (int g = gw; g < G; g += NGW) { const RowInfo ri = rowinfo(g); if (last && !ri.lat) continue;
        const int mrow = ri.lat ? ri.b : 4; const size_t xo = xoff(ri);
        const float* xs = (ri.lat ? F.out : WSP(float, O_XC)) + xo;
        f32x4 v[4], hv[4]; float rinv;
        rp_load(xs, nullptr, false, nullptr, nullptr, lane, v, rinv);
        rp_mod(v, rinv, INP(7) + l * 1024, MODl + (size_t)mrow * 6144, 3072, 4096, WSP(bf16_t, O_H) + (size_t)g * D, lane, hv);
        float lg[36];
#pragma unroll
        for (int c = 0; c < 36; ++c) { float p = 0.f;
#pragma unroll
            for (int j = 0; j < 4; ++j) { const f32x4 w4 = *(const LAS f32x4*)(WT + c * 1024 + 4 * lane + 256 * j); p += hv[j][0] * w4[0] + hv[j][1] * w4[1] + hv[j][2] * w4[2] + hv[j][3] * w4[3]; }
            lg[c] = wave_sum_dpp(p); }
        int gs = 0; float gm = lg[0];
#pragma unroll
        for (int j = 1; j < 4; ++j) if (lg[j] > gm) { gm = lg[j]; gs = j; }
        float gsum = 0.f;
#pragma unroll
        for (int j = 0; j < 4; ++j) gsum += expf(lg[j] - gm);
        const float gwt = 1.f / gsum;
        int i0s = 0, i1s = 1; float m0s = 0.f, m1s = 0.f;
#pragma unroll
        for (int gi = 0; gi < 4; ++gi) { int i0 = 0; float m0 = lg[4 + gi * 8];
#pragma unroll
            for (int j = 1; j < 8; ++j) if (lg[4 + gi * 8 + j] > m0) { m0 = lg[4 + gi * 8 + j]; i0 = j; }
            int i1 = -1; float m1 = -3.4e38f;
#pragma unroll
            for (int j = 0; j < 8; ++j) if (j != i0 && lg[4 + gi * 8 + j] > m1) { m1 = lg[4 + gi * 8 + j]; i1 = j; }
            if (gi == gs) { i0s = i0; i1s = i1; m0s = m0; m1s = m1; } }
        const float p1 = expf(m1s - m0s); const float w0 = gwt / (1.f + p1), w1 = gwt * p1 / (1.f + p1);
        if (lane == 0) { const int e0 = gs * 8 + i0s, e1 = gs * 8 + i1s; route_e[g * 2] = e0; route_e[g * 2 + 1] = e1; route_w[g * 2] = w0; route_w[g * 2 + 1] = w1;
            __hip_atomic_fetch_add(hist + e0, 1, __ATOMIC_RELAXED, __HIP_MEMORY_SCOPE_WORKGROUP); __hip_atomic_fetch_add(hist + e1, 1, __ATOMIC_RELAXED, __HIP_MEMORY_SCOPE_WORKGROUP); }
    }
    __syncthreads();
    if (tid < 32) WSP(int, O_WGH)[((size_t)l * 256 + blockIdx.x) * 32 + tid] = hist[tid];
}
__device__ __forceinline__ void phase_final(const Frame& F) {
    const int tid = opaque_tid(), lane = tid & 63, wave = __builtin_amdgcn_readfirstlane(tid >> 6); (void)lane; (void)wave;
    const int gw = blockIdx.x * 8 + wave, NGW = gridDim.x * 8; const float* MOD1 = WSP(float, O_MOD) + (size_t)5 * 6144;
    for (int lr = gw; lr < NB * SEQ; lr += NGW) { const int b = lr / SEQ, t = lr - b * SEQ; const int g = b * RPB + t; float* xp = F.out + (size_t)lr * D;
        f32x4 v[4]; float rinv; rp_load(xp, nullptr, false, WSP(bf16_t, O_YM2) + (size_t)g * 2048, MOD1 + (size_t)b * 6144 + 5120, lane, v, rinv);
#pragma unroll
        for (int j = 0; j < 4; ++j) { const int c = 4 * lane + 256 * j; const f32x4 g4 = *(const f32x4*)(INP(23) + c); *(f32x4*)(xp + c) = v[j] * rinv * g4; } }
}
__device__ __forceinline__ void phase_moe_scatter(const Frame& F, int l, bool last) {
    const int tid = opaque_tid(), lane = tid & 63, wave = __builtin_amdgcn_readfirstlane(tid >> 6);
    LAS int* tot = (LAS int*)F.lds; LAS int* bef = tot + 512; LAS int* base = tot + 1024; LAS int* lcur = tot + 1056;
    const int* WGH = WSP(int, O_WGH) + (size_t)l * 256 * 32; const int nwg = gridDim.x, me = blockIdx.x;
    { const int e = tid & 31, part = tid >> 5; int sa = 0, sb = 0;
      for (int w = part * 16; w < part * 16 + 16 && w < nwg; ++w) { const int c = WGH[w * 32 + e]; sa += c; if (w < me) sb += c; }
      tot[part * 32 + e] = sa; bef[part * 32 + e] = sb; }
    __syncthreads();
    int sa2 = 0, sb2 = 0;
    if (tid < 32) {
#pragma unroll
        for (int part = 0; part < 16; ++part) { sa2 += tot[part * 32 + tid]; sb2 += bef[part * 32 + tid]; } }
    __syncthreads();
    if (tid < 32) { tot[tid] = sa2; bef[tid] = sb2; lcur[tid] = 0; }
    __syncthreads();
    if (tid == 0) { int o = 0; int* tile_e = WSP(int, O_TILEE);
#pragma clang loop unroll(disable) vectorize(disable)
        for (int e = 0; e < 32; ++e) { base[e] = o + bef[e]; const int n = (tot[e] + 255) & ~255;
            if (me == 0) {
#pragma clang loop unroll(disable) vectorize(disable)
                for (int t = o >> 8; t < (o + n) >> 8; ++t) tile_e[t] = e; }
            o += n; }
        if (me == 0) tile_e[NTILE] = o >> 8; }
    __syncthreads();
    const int* route_e = WSP(int, O_ROUTE_E); const float* route_w = WSP(float, O_ROUTE_W); int* perm = WSP(int, O_PERM); float* posw = WSP(float, O_POSW); unsigned* goff = WSP(unsigned, O_GOFF);
    const int gw = blockIdx.x * 8 + wave, NGW = gridDim.x * 8;
    for (int j0 = 0; j0 * NGW < G; j0 += 32) { const int g = gw + (j0 + (lane >> 1)) * NGW;
        if (g < G) { const RowInfo ri = rowinfo(g); if (!(last && !ri.lat)) { const int i = g * 2 + (lane & 1); const int e = route_e[i];
            const int pos = base[e] + __hip_atomic_fetch_add(lcur + e, 1, __ATOMIC_RELAXED, __HIP_MEMORY_SCOPE_WORKGROUP);
            perm[pos] = i; posw[pos] = route_w[i]; goff[pos] = (unsigned)g * 2048u; } } }
}

#ifndef PROBE_DUP
#define PROBE_DUP 0
#endif
#ifndef PROBE_EXTRA_MASK
#define PROBE_EXTRA_MASK 0ull
#endif
#define DUP(bit) for (int rep_ = 0; rep_ < (((PROBE_DUP) >> (bit)) & 1) + 1; ++rep_)
__global__ void __launch_bounds__(512, 2) hybrid_trunk_fwd(KP p) {
    extern __shared__ __attribute__((aligned(16))) unsigned char dynlds[];
    Frame F; F.lds = (LAS char*)dynlds; F.ws = p.ws; F.out = p.out;
    if (threadIdx.x == 0) { LAS unsigned long long* pp = (LAS unsigned long long*)(F.lds + LDS_PTR_OFF);
        pp[0] = (unsigned long long)p.in[0];
        pp[1] = (unsigned long long)p.in[1];
        pp[2] = (unsigned long long)p.in[2];
        pp[3] = (unsigned long long)p.in[3];
        pp[4] = (unsigned long long)p.in[4];
        pp[5] = (unsigned long long)p.in[5];
        pp[6] = (unsigned long long)p.in[6];
        pp[7] = (unsigned long long)p.in[7];
        pp[8] = (unsigned long long)p.in[8];
        pp[9] = (unsigned long long)p.in[9];
        pp[10] = (unsigned long long)p.in[10];
        pp[11] = (unsigned long long)p.in[11];
        pp[12] = (unsigned long long)p.in[12];
        pp[13] = (unsigned long long)p.in[13];
        pp[14] = (unsigned long long)p.in[14];
        pp[15] = (unsigned long long)p.in[15];
        pp[16] = (unsigned long long)p.in[16];
        pp[17] = (unsigned long long)p.in[17];
        pp[18] = (unsigned long long)p.in[18];
        pp[19] = (unsigned long long)p.in[19];
        pp[20] = (unsigned long long)p.in[20];
        pp[21] = (unsigned long long)p.in[21];
        pp[22] = (unsigned long long)p.in[22];
        pp[23] = (unsigned long long)p.in[23];
    }
    LAS unsigned char* glds = (LAS unsigned char*)dynlds;
    volatile LAS unsigned* barst = (volatile LAS unsigned*)(F.lds + LDS_BAR_OFF);
    if (threadIdx.x < 16) ((LAS unsigned*)(F.lds + LDS_BAR_OFF))[threadIdx.x] = 0u;
    __syncthreads();
    const bool multi = (p.ph_hi - p.ph_lo) > 1;
    XcdBarrier bar; bar.bar = (unsigned*)F.ws; bar.x = 0; bar.st = nullptr;
    if (multi) bar = xcd_barrier_post((unsigned*)F.ws, barst);
    int ph = 0;
#define PH_BEGIN if (ph >= p.ph_lo && ph < p.ph_hi && (p.mask == 0ull || ((p.mask >> ph) & 1ull))) {
#define PH_END   if (ph + 1 < p.ph_hi) xcd_barrier(bar); else __syncthreads(); } ++ph;
    const int Gd = gridDim.x, cb = blockIdx.x;

    PH_BEGIN p0_mod(F); p0_tables(F); __syncthreads(); conv_weights_nonmoe(F, 0); PH_END

    for (int l = 0; l < 2; ++l) {
        const bool last = (l == 1);
        const float* MODl = WSP(float, O_MOD) + (size_t)l * 5 * 6144;
        PH_BEGIN phase_rowpass1(F, l, l > 0, O_H); PH_END
        PH_BEGIN
        { SchedStd S{}; S.A = WSP(bf16_t, O_H); S.Bt = WSP(bf16_t, O_WINP); S.K = 1024; S.nM = 132; S.nN = 15; S.G_ = Gd; S.c = cb; S.skipctx = 0; S.lda2 = 2048; S.ldb2 = 2048;
          EpiG1 E{}; E.AQ = WSP(bf16_t, O_AQ); E.AK = WSP(bf16_t, O_AK); E.AV = WSP(bf16_t, O_AV); E.BQ = WSP(bf16_t, O_BQ); E.BV = WSP(bf16_t, O_BV); E.BG = WSP(bf16_t, O_BG); E.BLF = WSP(f16_t, O_BLF); E.BLB = WSP(f16_t, O_BLB);
          E.CQKV = WSP(bf16_t, O_CQKV); E.CKR = WSP(bf16_t, O_CKR); E.RS = WSP(float, O_RS); E.ropa_c = WSP(float, O_ROPA_C); E.ropa_s = WSP(float, O_ROPA_S); E.ropc_c = WSP(float, O_ROPC_C); E.ropc_s = WSP(float, O_ROPC_S);
          E.LBl = WSP(float, O_LB) + l * 1024; E.rowoff = 0;
          DUP(0) gp::gemm_phase<EpiG1, SchedStd>(glds, S, E); }
        PH_END
        PH_BEGIN
        { SchedStd S{}; S.A = WSP(bf16_t, O_CQKV); S.Bt = WSP(bf16_t, O_WC); S.K = 384; S.nM = 132; S.nN = 7; S.G_ = Gd; S.c = cb; S.skipctx = 0; S.lda2 = 768; S.ldb2 = 768;
          EpiC E{}; E.CQ = WSP(bf16_t, O_CQ); E.CKV = WSP(bf16_t, O_CKV); E.RS = WSP(float, O_RS); E.ropc_c = WSP(float, O_ROPC_C); E.ropc_s = WSP(float, O_ROPC_S); E.pmoff = 0;
          DUP(1) gp::gemm_phase<EpiC, SchedStd>(glds, S, E); }
        __syncthreads();
        { AttnArgs a{}; a.Q = WSP(bf16_t, O_AQ); a.qld = 512; a.qhs = 64; a.K1 = WSP(bf16_t, O_AK); a.k1ld = 128; a.k1hs = 64; a.kvgroup = 4; a.K2 = nullptr; a.k2ld = 0; a.V = WSP(bf16_t, O_AV); a.vld = 128; a.vhs = 64;
          a.O = WSP(bf16_t, O_AQ); a.old = 512; a.ohs = 64; a.scale_l2 = 0.125f * LOG2E; a.sink = INP(9) + l * 8; a.window = 128;
          const int nqb = last ? 32 : 33;
          DUP(10) for (int u = cb; u < NB * 8 * nqb; u += Gd) { int b, h, qb; if (u < NB * 8 * 32) { b = u >> 8; h = (u >> 5) & 7; qb = u & 31; } else { const int r_ = u - NB * 8 * 32; b = r_ >> 3; h = r_ & 7; qb = 32; }
              attn_unit<64>(F.lds, a, b, qb, h, ((PROBE_DUP >> 10) & 1) && rep_ == 0); } }
        __syncthreads();
        { ScanArgs a{}; a.BQ = WSP(bf16_t, O_BQ); a.BV = WSP(bf16_t, O_BV); a.BG = WSP(bf16_t, O_BG); a.BLF = WSP(f16_t, O_BLF); a.BLB = WSP(f16_t, O_BLB); a.ST = WSP(bf16_t, O_H); a.DS = WSP(float, O_DS); a.OB = WSP(bf16_t, O_BQ); a.gn = INP(11) + l * 512;
          DUP(2) for (int u = cb; u < NB * 8 * NCHK; u += Gd) { const int b = u / (8 * NCHK), rem = u - b * 8 * NCHK, h = rem / NCHK, k = rem - h * NCHK; scan_s1_unit(F.lds, a, b, h, k); } }
        PH_END
        PH_BEGIN
        { ScanArgs a{}; a.ST = WSP(bf16_t, O_H); a.DS = WSP(float, O_DS);
          for (int t = cb; t < NB * 8 * 2 * 4; t += Gd) scan_s2_task(a, t); }
        { AttnArgs a{}; a.Q = WSP(bf16_t, O_CQ); a.qld = 768; a.qhs = 96; a.K1 = WSP(bf16_t, O_CKV); a.k1ld = 1024; a.k1hs = 128; a.kvgroup = 1; a.K2 = WSP(bf16_t, O_CKR); a.k2ld = 32; a.V = WSP(bf16_t, O_CKV) + 64; a.vld = 1024; a.vhs = 128;
          a.O = WSP(bf16_t, O_OC); a.old = 512; a.ohs = 64; a.scale_l2 = 0.10206207261596577f * LOG2E; a.sink = nullptr; a.window = 0; a.pad = (PROBE_VARIANT && p.mask != 0ull) ? 1 : 0;
          const int nqb = last ? 32 : 33;
          DUP(3) for (int u = cb; u < NB * 8 * nqb; u += Gd) { int b, h, qb; if (u < NB * 8 * 32) { b = u >> 8; h = (u >> 5) & 7; qb = u & 31; } else { const int r_ = u - NB * 8 * 32; b = r_ >> 3; h = r_ & 7; qb = 32; }
              attn_unit<96>(F.lds, a, b, qb, h); } }
        PH_END
        PH_BEGIN
        { ScanArgs a{}; a.BQ = WSP(bf16_t, O_BQ); a.BV = WSP(bf16_t, O_BV); a.BG = WSP(bf16_t, O_BG); a.BLF = WSP(f16_t, O_BLF); a.BLB = WSP(f16_t, O_BLB); a.ST = WSP(bf16_t, O_H); a.DS = WSP(float, O_DS); a.OB = WSP(bf16_t, O_BQ); a.gn = INP(11) + l * 512; a.skipctx_out = last ? 1 : 0;
          DUP(9) { a.pad = (((PROBE_DUP >> 9) & 1) && rep_ == 0) ? 1 : 0; for (int u = cb; u < NB * 8 * NCHK; u += Gd) { const int b = u / (8 * NCHK), rem = u - b * 8 * NCHK, h = rem / NCHK, k = rem - h * NCHK; scan_s3_unit(F.lds, a, b, h, k); } } }
        phase_rowpass1(F, l, false, O_CKV);
        PH_END
        PH_BEGIN
        { SchedStd S{}; S.A = WSP(bf16_t, O_CKV); S.Bt = WSP(bf16_t, O_WINP) + (size_t)3840 * 1024; S.K = 1024; S.nM = last ? 128 : 132; S.nN = 12; S.G_ = Gd; S.c = cb; S.skipctx = last ? 1 : 0; S.lda2 = 2048; S.ldb2 = 2048;
          EpiGate E{}; E.GATE = WSP(bf16_t, O_GATE); E.nstride = (long)G * 1024; E.ld = 1024;
          DUP(5) gp::gemm_phase<EpiGate, SchedStd>(glds, S, E); }
        PH_END
        PH_BEGIN
        { SchedMerge S{}; S.A0 = WSP(bf16_t, O_AQ); S.A1 = WSP(bf16_t, O_BQ); S.A2 = WSP(bf16_t, O_OC); S.Bt = WSP(bf16_t, O_WBR); S.nM = last ? 128 : 132; S.G_ = Gd; S.c = cb; S.skipctx = last ? 1 : 0; S.lda2 = 1024; S.ldb2 = 1024;
          EpiMerge E{}; E.GATE = WSP(bf16_t, O_GATE); E.nstride = (long)G * 1024; E.ld = 1024; E.Y = WSP(bf16_t, O_H);
          DUP(6) gp::gemm_phase<EpiMerge, SchedMerge>(glds, S, E); }
        PH_END
        PH_BEGIN
        { SchedStd S{}; S.A = WSP(bf16_t, O_H); S.Bt = WSP(bf16_t, O_WOUT); S.K = 1024; S.nM = last ? 128 : 132; S.nN = 4; S.G_ = Gd; S.c = cb; S.skipctx = last ? 1 : 0; S.lda2 = 2048; S.ldb2 = 2048;
          EpiOut E{}; E.xl_src = l == 0 ? INP(0) : F.out; E.xc_src = l == 0 ? INP(2) : WSP(float, O_XC); E.xl_dst = F.out; E.xc_dst = WSP(float, O_XC); E.mod = MODl; E.pmoff = 0;
          gp::gemm_phase<EpiOut, SchedStd>(glds, S, E); }
        PH_END
        PH_BEGIN phase_rowpass2(F, l, last); __syncthreads(); conv_weights_moe(F, l); if (!last) conv_weights_nonmoe(F, l + 1); PH_END
        PH_BEGIN phase_moe_scatter(F, l, last); PH_END
        PH_BEGIN
        { SchedMoE<true> S{}; S.A = WSP(bf16_t, O_H); S.Bt = WSP(bf16_t, O_WUP); S.tile_e = WSP(int, O_TILEE); S.goff = WSP(unsigned, O_GOFF); S.K = 1024; S.nM = WSP(int, O_TILEE)[NTILE]; S.nN = 2; S.G_ = Gd; S.c = cb; S.lda2 = 2048; S.ldb2 = 2048; S.strideB = 512 * 1024;
          EpiUp E{}; E.AUP = WSP(bf16_t, O_AUP);
          DUP(7) gp::gemm_phase<EpiUp, SchedMoE<true>>(glds, S, E); }
        PH_END
        PH_BEGIN
        { SchedMoE<false> S{}; S.A = WSP(bf16_t, O_AUP); S.Bt = WSP(bf16_t, O_WDN); S.tile_e = WSP(int, O_TILEE); S.goff = nullptr; S.K = 256; S.nM = WSP(int, O_TILEE)[NTILE]; S.nN = 4; S.G_ = Gd; S.c = cb; S.lda2 = 512; S.ldb2 = 512; S.strideB = 1024 * 256;
          EpiDown E{}; E.YM2 = WSP(bf16_t, O_YM2); E.perm = WSP(int, O_PERM); E.posw = WSP(float, O_POSW);
          DUP(8) gp::gemm_phase<EpiDown, SchedMoE<false>>(glds, S, E); }
        PH_END
    }
    PH_BEGIN phase_final(F); PH_END
#undef PH_BEGIN
#undef PH_END
}
constexpr int N_PHASES = 1 + 2 * 12 + 1;
}

#ifndef MK_N_LAUNCHES
#define MK_N_LAUNCHES 1
#endif
extern "C" void kernel_launch(void* const* d_in, const int* in_sizes, int n_in, void* d_out, int out_size, void* d_ws, size_t ws_size, hipStream_t stream) {
    static int grid = 0;
    if (grid == 0) {
        if (ws_size < WS_END) { grid = -1; return; }
        int dev = 0, cus = 0;
        if (hipGetDevice(&dev) != hipSuccess || hipDeviceGetAttribute(&cus, hipDeviceAttributeMultiprocessorCount, dev) != hipSuccess) { grid = -1; return; }
        if (hipFuncSetAttribute((const void*)hybrid_trunk_fwd, hipFuncAttributeMaxDynamicSharedMemorySize, LDS_BYTES) != hipSuccess) { grid = -1; return; }
        int per_cu = 0; (void)hipOccupancyMaxActiveBlocksPerMultiprocessor(&per_cu, (const void*)hybrid_trunk_fwd, 512, LDS_BYTES); (void)hipGetLastError();
        grid = cus;
    }
    if (grid < 0) return;
    (void)hipMemsetAsync(d_ws, 0, CTL_ZERO_BYTES, stream);
    KP p{}; for (int i = 0; i < 24; ++i) p.in[i] = (const float*)d_in[i]; p.out = (float*)d_out; p.ws = (char*)d_ws;
    (void)in_sizes; (void)n_in; (void)out_size;
    if (MK_N_LAUNCHES == 1) { p.ph_lo = 0; p.ph_hi = N_PHASES; hipLaunchKernelGGL(hybrid_trunk_fwd, dim3(grid), dim3(512), LDS_BYTES, stream, p);
        if (PROBE_EXTRA_MASK) { (void)hipMemsetAsync(d_ws, 0, CTL_ZERO_BYTES, stream); p.mask = PROBE_EXTRA_MASK; hipLaunchKernelGGL(hybrid_trunk_fwd, dim3(grid), dim3(512), LDS_BYTES, stream, p); } }
    else { for (int k = 0; k < N_PHASES; ++k) { p.ph_lo = k; p.ph_hi = k + 1; hipLaunchKernelGGL(hybrid_trunk_fwd, dim3(grid), dim3(512), LDS_BYTES, stream, p); } }
}
```

```cpp
#include <hip/hip_runtime.h>
#include <stdint.h>
#include <math.h>

namespace {
typedef unsigned short bf16_t;
typedef _Float16 f16_t;
typedef short bf16x8 __attribute__((ext_vector_type(8)));
typedef short s16x4 __attribute__((ext_vector_type(4)));
typedef float f32x4 __attribute__((ext_vector_type(4)));
typedef float f32x16 __attribute__((ext_vector_type(16)));
typedef unsigned u32x4 __attribute__((ext_vector_type(4)));
#define LAS __attribute__((address_space(3)))

constexpr int D = 1024, NB = 4, SEQ = 8192, CTXL = 256, RPB = SEQ + CTXL, G = NB * RPB;
constexpr int INW = 6816, MIXW = 3744, GATEW = 3072;
constexpr float EPS = 1e-6f;
constexpr float LOG2E = 1.4426950408889634f;
constexpr int PMAX = 75776;
constexpr int NTILE = PMAX / 256;

__device__ __forceinline__ float bf2f(bf16_t v) { return __uint_as_float(((unsigned)v) << 16); }
__device__ __forceinline__ bf16_t f2bf(float f) { unsigned u = __float_as_uint(f); u += 0x7fffu + ((u >> 16) & 1u); return (bf16_t)(u >> 16); }
typedef float f32x2v __attribute__((ext_vector_type(2)));
typedef __bf16 bf16x2v __attribute__((ext_vector_type(2)));
__device__ __forceinline__ unsigned pkbf(float lo, float hi) { const f32x2v v = {lo, hi}; const bf16x2v b = __builtin_convertvector(v, bf16x2v); return __builtin_bit_cast(unsigned, b); }
__device__ __forceinline__ unsigned pk2(float lo, float hi) { return (unsigned)f2bf(lo) | ((unsigned)f2bf(hi) << 16); }
__device__ __forceinline__ float silu_f(float v) { return v / (1.f + expf(-v)); }
__device__ __forceinline__ float sigmoid_f(float v) { return 1.f / (1.f + expf(-v)); }
__device__ __forceinline__ int opaque_tid() { int t = threadIdx.x; asm volatile("" : "+v"(t)); return t; }
struct RowInfo { int b, r; bool lat; };
__device__ __forceinline__ RowInfo rowinfo(int g) { RowInfo ri; ri.b = g / RPB; ri.r = g - ri.b * RPB; ri.lat = ri.r < SEQ; return ri; }
__device__ __forceinline__ size_t xoff(const RowInfo& ri) { return ri.lat ? ((size_t)ri.b * SEQ + ri.r) * D : ((size_t)ri.b * CTXL + (ri.r - SEQ)) * D; }
__device__ __forceinline__ int crow(int r, int hi) { return (r & 3) + 8 * (r >> 2) + 4 * hi; }
__device__ __forceinline__ unsigned cvtpk(float lo, float hi) { return pkbf(lo, hi); }
typedef short v4i16_t __attribute__((ext_vector_type(4)));
__device__ __forceinline__ s16x4 vtr(const LAS char* p) { return __builtin_bit_cast(s16x4, __builtin_amdgcn_ds_read_tr16_b64_v4i16((LAS v4i16_t*)p)); }
#define MFMA32(a, b, c) __builtin_amdgcn_mfma_f32_32x32x16_bf16(a, b, c, 0, 0, 0)
#define VTR_ASM(dst, addr, off) asm volatile("ds_read_b64_tr_b16 %0, %1 offset:" #off : "=v"(dst) : "v"(addr))

#ifndef PROBE_VARIANT
#define PROBE_VARIANT 0
#endif
struct AttnArgs { const bf16_t* Q; int qld, qhs; const bf16_t* K1; int k1ld, k1hs, kvgroup; const bf16_t* K2; int k2ld; const bf16_t* V; int vld, vhs;
                  bf16_t* O; int old, ohs; float scale_l2; const float* sink; int window; int pad; };
template <int DQK>
__device__ __forceinline__ void attn_unit(LAS char* lds, const AttnArgs& p, int b, int qb, int h, bool nostore = false) {
    constexpr int NS = DQK / 16, NCH = DQK / 8; constexpr float THR = 8.f;
    constexpr int KB = 0, VB = 49152, WSF = 81920;
    const int tid = opaque_tid(), lane = tid & 63, r32 = lane & 31, hi = lane >> 5, wid = tid >> 6;
    const int rb = b * RPB;
    const bool ctxq = (qb == 32);
    const int q0 = rb + (ctxq ? SEQ : qb * 256);
    int lat_k0 = 0, lat_k1 = 0;
    if (!ctxq) { if (p.window) { lat_k0 = qb * 256 - 128; if (lat_k0 < 0) lat_k0 = 0; lat_k1 = qb * 256 + 384; if (lat_k1 > SEQ) lat_k1 = SEQ; } else { lat_k0 = 0; lat_k1 = SEQ; } }
    const int ntiles = 4 + (lat_k1 - lat_k0) / 64;
    const int qrow = q0 + wid * 32 + r32;
    const int qpos = qb * 256 + wid * 32 + r32;
    const int wq0 = qb * 256 + wid * 32;
    LAS float* wsf = (LAS float*)(lds + WSF) + wid * 64;
    bf16x8 qr[NS];
#pragma unroll
    for (int s = 0; s < NS; ++s) qr[s] = *(const bf16x8*)(p.Q + (size_t)qrow * p.qld + h * p.qhs + 16 * s + 8 * hi);
    const int k1off = (h / p.kvgroup) * p.k1hs, voff = (h / p.kvgroup) * p.vhs;
    const int wv = __builtin_amdgcn_readfirstlane(wid);
    const bool k2nd = (NCH > 8) && (wv < NCH - 8);
    const size_t ksrc0 = (size_t)lane * p.k1ld + k1off + wv * 8, ksrc1 = (size_t)lane * p.k2ld + wv * 8;
    const size_t vsrc = (size_t)(16 * (wv & 3) + (lane >> 2)) * p.vld + voff + (wv >> 2) * 32 + (lane & 3) * 8;
#define AT_ROW0(it_) (rb + ((it_) >= 4 ? lat_k0 + 64 * ((it_) - 4) : SEQ + 64 * (it_)))
#define AT_DMAK(it_, slot_) do { const size_t kr0_ = (size_t)AT_ROW0(it_); \
        __builtin_amdgcn_global_load_lds((const unsigned*)(p.K1 + kr0_ * p.k1ld + ksrc0), (LAS unsigned*)(lds + KB + (slot_) * 12288 + wv * 1024), 16, 0, 0); \
        if (k2nd) __builtin_amdgcn_global_load_lds((const unsigned*)(p.K2 + kr0_ * p.k2ld + ksrc1), (LAS unsigned*)(lds + KB + (slot_) * 12288 + (8 + wv) * 1024), 16, 0, 0); } while (0)
#define AT_DMAV(it_, slot_) do { const size_t kr0_ = (size_t)AT_ROW0(it_); \
        __builtin_amdgcn_global_load_lds((const unsigned*)(p.V + kr0_ * p.vld + vsrc), (LAS unsigned*)(lds + VB + (slot_) * 8192 + wv * 1024), 16, 0, 0); } while (0)
#define AT_CLAMP(x_) ((x_) < ntiles ? (x_) : ntiles - 1)
#define AT_WAITBAR() do { if (k2nd) asm volatile("s_waitcnt vmcnt(6) lgkmcnt(0)" ::: "memory"); else asm volatile("s_waitcnt vmcnt(4) lgkmcnt(0)" ::: "memory"); __builtin_amdgcn_s_barrier(); asm volatile("" ::: "memory"); } while (0)
#define AT_QK(C0, C1, slot_) do { const LAS char* ldsK_ = lds + KB + (slot_) * 12288 + hi * 1024 + r32 * 16; C0 = negm; C1 = negm; bf16x8 kf_[2 * NS]; \
        _Pragma("unroll") for (int s = 0; s < NS; ++s) { kf_[2 * s] = *(const LAS bf16x8*)(ldsK_ + s * 2048); kf_[2 * s + 1] = *(const LAS bf16x8*)(ldsK_ + s * 2048 + 512); } \
        __builtin_amdgcn_sched_group_barrier(0x100, 2 * NS, 0); \
        _Pragma("unroll") for (int s = 0; s < NS; ++s) { C0 = MFMA32(kf_[2 * s], qr[s], C0); C1 = MFMA32(kf_[2 * s + 1], qr[s], C1); } } while (0)
#define AT_REF(C0, C1, T_, first) do { const int tr_ = (T_); \
        if (p.window && tr_ >= 4) { const int kpos0 = lat_k0 + 64 * (tr_ - 4); \
            _Pragma("unroll") for (int r = 0; r < 16; ++r) { const int kp = kpos0 + crow(r, hi); int d0 = qpos - kp; if (d0 < 0) d0 = -d0; int d1 = qpos - (kp + 32); if (d1 < 0) d1 = -d1; \
                if (d0 > p.window) C0[r] = -1e30f; if (d1 > p.window) C1[r] = -1e30f; } } \
        if ((first) || (tr_ & 7) == 0) { \
        float mx = fmaxf(fmaxf(C0[0], C0[1]), C1[0]); \
        _Pragma("unroll") for (int r = 2; r < 16; r += 2) mx = fmaxf(fmaxf(mx, C0[r]), C0[r + 1]); \
        _Pragma("unroll") for (int r = 1; r < 15; r += 2) mx = fmaxf(fmaxf(mx, C1[r]), C1[r + 1]); \
        mx = fmaxf(mx, C1[15]); mx = fmaxf(mx, __shfl_xor(mx, 32)); \
        if ((first) || __any(mx > THR)) { const float dl = (first) ? mx : fmaxf(mx, 0.f); \
            m += dl; const float alpha = __builtin_amdgcn_exp2f(-dl); l *= alpha; \
            _Pragma("unroll") for (int r = 0; r < 16; ++r) { C0[r] -= dl; C1[r] -= dl; negm[r] = -m; } \
            if (hi == 0) wsf[r32] = alpha; \
            _Pragma("unroll") for (int r = 0; r < 16; ++r) { const float f = wsf[crow(r, hi)]; o0[r] *= f; o1[r] *= f; } } } } while (0)
    f32x16 o0, o1, negm, cA0, cA1, cB0, cB1;
#pragma unroll
    for (int r = 0; r < 16; ++r) { o0[r] = 0.f; o1[r] = 0.f; negm[r] = 0.f; }
    float m = 0.f, l = 0.f;
    const int vlane = ((lane >> 4) & 1) * 32 + (lane & 3) * 8 + (4 * hi + ((lane & 15) >> 2)) * 64;
    asm volatile("s_waitcnt vmcnt(0) lgkmcnt(0)" ::: "memory"); __builtin_amdgcn_s_barrier(); asm volatile("" ::: "memory");
    AT_DMAK(0, 0); AT_DMAV(0, 0); AT_DMAK(AT_CLAMP(1), 1); AT_DMAV(AT_CLAMP(1), 1); AT_DMAK(AT_CLAMP(2), 2); AT_DMAV(AT_CLAMP(2), 2); AT_DMAK(AT_CLAMP(3), 3);
    asm volatile("s_waitcnt vmcnt(0)" ::: "memory"); __builtin_amdgcn_s_barrier(); asm volatile("" ::: "memory");
    AT_QK(cA0, cA1, 0);
    AT_REF(cA0, cA1, 0, true);
    asm volatile("s_waitcnt lgkmcnt(0)" ::: "memory"); __builtin_amdgcn_s_barrier(); asm volatile("" ::: "memory");
#define AT_SB() __builtin_amdgcn_sched_barrier(0)
#define AT_STEP(C0, C1, N0, N1, T_) do { const int t_ = (T_); const int t1_ = t_ + 1 < ntiles ? t_ + 1 : ntiles - 1; \
        AT_DMAK(AT_CLAMP(t_ + 4), t_ & 3); AT_DMAV(AT_CLAMP(t_ + 3), (t_ + 3) & 3); \
        const LAS char* ldsK_ = lds + KB + ((t_ + 1) & 3) * 12288 + hi * 1024 + r32 * 16; const unsigned vaddr_ = (unsigned)(size_t)(lds + VB + (t_ & 3) * 8192 + vlane); \
        bf16x8 kfa0, kfa1, kfb0, kfb1, kfc0, kfc1; bf16x8 vf_[8]; s16x4 ta_[16]; float rs0 = 0.f, rs1 = 0.f, rs2 = 0.f, rs3 = 0.f; u32x4 pw[4]; \
        kfa0 = *(const LAS bf16x8*)(ldsK_); kfa1 = *(const LAS bf16x8*)(ldsK_ + 512); kfb0 = *(const LAS bf16x8*)(ldsK_ + 2048); kfb1 = *(const LAS bf16x8*)(ldsK_ + 2048 + 512); AT_SB(); \
        if constexpr (NS == 6) { \
          kfc0 = *(const LAS bf16x8*)(ldsK_ + 4096); kfc1 = *(const LAS bf16x8*)(ldsK_ + 4096 + 512); N0 = MFMA32(kfa0, qr[0], negm); N1 = MFMA32(kfa1, qr[0], negm); C0[0] = (PROBE_VARIANT == 1 && p.pad) ? C0[0] * 0.5f : __builtin_amdgcn_exp2f(C0[0]); C0[1] = (PROBE_VARIANT == 1 && p.pad) ? C0[1] * 0.5f : __builtin_amdgcn_exp2f(C0[1]); C0[2] = (PROBE_VARIANT == 1 && p.pad) ? C0[2] * 0.5f : __builtin_amdgcn_exp2f(C0[2]); C0[3] = (PROBE_VARIANT == 1 && p.pad) ? C0[3] * 0.5f : __builtin_amdgcn_exp2f(C0[3]); C0[4] = (PROBE_VARIANT == 1 && p.pad) ? C0[4] * 0.5f : __builtin_amdgcn_exp2f(C0[4]); C0[5] = (PROBE_VARIANT == 1 && p.pad) ? C0[5] * 0.5f : __builtin_amdgcn_exp2f(C0[5]);  VTR_ASM(ta_[0], vaddr_, 0); VTR_ASM(ta_[1], vaddr_, 512); VTR_ASM(ta_[2], vaddr_, 4096); AT_SB(); \
          kfa0 = *(const LAS bf16x8*)(ldsK_ + 6144); kfa1 = *(const LAS bf16x8*)(ldsK_ + 6144 + 512); N0 = MFMA32(kfb0, qr[1], N0); N1 = MFMA32(kfb1, qr[1], N1); C0[6] = (PROBE_VARIANT == 1 && p.pad) ? C0[6] * 0.5f : __builtin_amdgcn_exp2f(C0[6]); C0[7] = (PROBE_VARIANT == 1 && p.pad) ? C0[7] * 0.5f : __builtin_amdgcn_exp2f(C0[7]); C0[8] = (PROBE_VARIANT == 1 && p.pad) ? C0[8] * 0.5f : __builtin_amdgcn_exp2f(C0[8]); C0[9] = (PROBE_VARIANT == 1 && p.pad) ? C0[9] * 0.5f : __builtin_amdgcn_exp2f(C0[9]); C0[10] = (PROBE_VARIANT == 1 && p.pad) ? C0[10] * 0.5f : __builtin_amdgcn_exp2f(C0[10]); C0[11] = (PROBE_VARIANT == 1 && p.pad) ? C0[11] * 0.5f : __builtin_amdgcn_exp2f(C0[11]); rs0 += C0[0]; rs1 += C0[1]; rs2 += C0[2]; rs3 += C0[3]; rs0 += C0[4]; rs1 += C0[5]; VTR_ASM(ta_[3], vaddr_, 4608); VTR_ASM(ta_[4], vaddr_, 1024); VTR_ASM(ta_[5], vaddr_, 1536); AT_SB(); \
          kfb0 = *(const LAS bf16x8*)(ldsK_ + 8192); kfb1 = *(const LAS bf16x8*)(ldsK_ + 8192 + 512); N0 = MFMA32(kfc0, qr[2], N0); N1 = MFMA32(kfc1, qr[2], N1); C0[12] = (PROBE_VARIANT == 1 && p.pad) ? C0[12] * 0.5f : __builtin_amdgcn_exp2f(C0[12]); C0[13] = (PROBE_VARIANT == 1 && p.pad) ? C0[13] * 0.5f : __builtin_amdgcn_exp2f(C0[13]); C0[14] = (PROBE_VARIANT == 1 && p.pad) ? C0[14] * 0.5f : __builtin_amdgcn_exp2f(C0[14]); C0[15] = (PROBE_VARIANT == 1 && p.pad) ? C0[15] * 0.5f : __builtin_amdgcn_exp2f(C0[15]); C1[0] = (PROBE_VARIANT == 1 && p.pad) ? C1[0] * 0.5f : __builtin_amdgcn_exp2f(C1[0]); C1[1] = (PROBE_VARIANT == 1 && p.pad) ? C1[1] * 0.5f : __builtin_amdgcn_exp2f(C1[1]); rs2 += C0[6]; rs3 += C0[7]; rs0 += C0[8]; rs1 += C0[9]; rs2 += C0[10]; rs3 += C0[11]; VTR_ASM(ta_[6], vaddr_, 5120); VTR_ASM(ta_[7], vaddr_, 5632); VTR_ASM(ta_[8], vaddr_, 2048); AT_SB(); \
          kfc0 = *(const LAS bf16x8*)(ldsK_ + 10240); kfc1 = *(const LAS bf16x8*)(ldsK_ + 10240 + 512); N0 = MFMA32(kfa0, qr[3], N0); N1 = MFMA32(kfa1, qr[3], N1); C1[2] = (PROBE_VARIANT == 1 && p.pad) ? C1[2] * 0.5f : __builtin_amdgcn_exp2f(C1[2]); C1[3] = (PROBE_VARIANT == 1 && p.pad) ? C1[3] * 0.5f : __builtin_amdgcn_exp2f(C1[3]); C1[4] = (PROBE_VARIANT == 1 && p.pad) ? C1[4] * 0.5f : __builtin_amdgcn_exp2f(C1[4]); C1[5] = (PROBE_VARIANT == 1 && p.pad) ? C1[5] * 0.5f : __builtin_amdgcn_exp2f(C1[5]); C1[6] = (PROBE_VARIANT == 1 && p.pad) ? C1[6] * 0.5f : __builtin_amdgcn_exp2f(C1[6]); C1[7] = (PROBE_VARIANT == 1 && p.pad) ? C1[7] * 0.5f : __builtin_amdgcn_exp2f(C1[7]); rs0 += C0[12]; rs1 += C0[13]; rs2 += C0[14]; rs3 += C0[15]; rs0 += C1[0]; rs1 += C1[1]; VTR_ASM(ta_[9], vaddr_, 2560); VTR_ASM(ta_[10], vaddr_, 6144); VTR_ASM(ta_[11], vaddr_, 6656); AT_SB(); \
          N0 = MFMA32(kfb0, qr[4], N0); N1 = MFMA32(kfb1, qr[4], N1); C1[8] = (PROBE_VARIANT == 1 && p.pad) ? C1[8] * 0.5f : __builtin_amdgcn_exp2f(C1[8]); C1[9] = (PROBE_VARIANT == 1 && p.pad) ? C1[9] * 0.5f : __builtin_amdgcn_exp2f(C1[9]); C1[10] = (PROBE_VARIANT == 1 && p.pad) ? C1[10] * 0.5f : __builtin_amdgcn_exp2f(C1[10]); C1[11] = (PROBE_VARIANT == 1 && p.pad) ? C1[11] * 0.5f : __builtin_amdgcn_exp2f(C1[11]); rs2 += C1[2]; rs3 += C1[3]; rs0 += C1[4]; rs1 += C1[5]; rs2 += C1[6]; rs3 += C1[7]; VTR_ASM(ta_[12], vaddr_, 3072); VTR_ASM(ta_[13], vaddr_, 3584); AT_SB(); \
          N0 = MFMA32(kfc0, qr[5], N0); N1 = MFMA32(kfc1, qr[5], N1); C1[12] = (PROBE_VARIANT == 1 && p.pad) ? C1[12] * 0.5f : __builtin_amdgcn_exp2f(C1[12]); C1[13] = (PROBE_VARIANT == 1 && p.pad) ? C1[13] * 0.5f : __builtin_amdgcn_exp2f(C1[13]); C1[14] = (PROBE_VARIANT == 1 && p.pad) ? C1[14] * 0.5f : __builtin_amdgcn_exp2f(C1[14]); C1[15] = (PROBE_VARIANT == 1 && p.pad) ? C1[15] * 0.5f : __builtin_amdgcn_exp2f(C1[15]); rs0 += C1[8]; rs1 += C1[9]; rs2 += C1[10]; rs3 += C1[11]; VTR_ASM(ta_[14], vaddr_, 7168); VTR_ASM(ta_[15], vaddr_, 7680); AT_SB(); \
          rs0 += C1[12]; rs1 += C1[13]; rs2 += C1[14]; rs3 += C1[15]; \
        } \
        if constexpr (NS == 4) { \
          kfc0 = *(const LAS bf16x8*)(ldsK_ + 4096); kfc1 = *(const LAS bf16x8*)(ldsK_ + 4096 + 512); N0 = MFMA32(kfa0, qr[0], negm); N1 = MFMA32(kfa1, qr[0], negm); C0[0] = (PROBE_VARIANT == 1 && p.pad) ? C0[0] * 0.5f : __builtin_amdgcn_exp2f(C0[0]); C0[1] = (PROBE_VARIANT == 1 && p.pad) ? C0[1] * 0.5f : __builtin_amdgcn_exp2f(C0[1]); C0[2] = (PROBE_VARIANT == 1 && p.pad) ? C0[2] * 0.5f : __builtin_amdgcn_exp2f(C0[2]); C0[3] = (PROBE_VARIANT == 1 && p.pad) ? C0[3] * 0.5f : __builtin_amdgcn_exp2f(C0[3]); C0[4] = (PROBE_VARIANT == 1 && p.pad) ? C0[4] * 0.5f : __builtin_amdgcn_exp2f(C0[4]); C0[5] = (PROBE_VARIANT == 1 && p.pad) ? C0[5] * 0.5f : __builtin_amdgcn_exp2f(C0[5]); C0[6] = (PROBE_VARIANT == 1 && p.pad) ? C0[6] * 0.5f : __builtin_amdgcn_exp2f(C0[6]); C0[7] = (PROBE_VARIANT == 1 && p.pad) ? C0[7] * 0.5f : __builtin_amdgcn_exp2f(C0[7]);  VTR_ASM(ta_[0], vaddr_, 0); VTR_ASM(ta_[1], vaddr_, 512); VTR_ASM(ta_[2], vaddr_, 4096); VTR_ASM(ta_[3], vaddr_, 4608); AT_SB(); \
          kfa0 = *(const LAS bf16x8*)(ldsK_ + 6144); kfa1 = *(const LAS bf16x8*)(ldsK_ + 6144 + 512); N0 = MFMA32(kfb0, qr[1], N0); N1 = MFMA32(kfb1, qr[1], N1); C0[8] = (PROBE_VARIANT == 1 && p.pad) ? C0[8] * 0.5f : __builtin_amdgcn_exp2f(C0[8]); C0[9] = (PROBE_VARIANT == 1 && p.pad) ? C0[9] * 0.5f : __builtin_amdgcn_exp2f(C0[9]); C0[10] = (PROBE_VARIANT == 1 && p.pad) ? C0[10] * 0.5f : __builtin_amdgcn_exp2f(C0[10]); C0[11] = (PROBE_VARIANT == 1 && p.pad) ? C0[11] * 0.5f : __builtin_amdgcn_exp2f(C0[11]); C0[12] = (PROBE_VARIANT == 1 && p.pad) ? C0[12] * 0.5f : __builtin_amdgcn_exp2f(C0[12]); C0[13] = (PROBE_VARIANT == 1 && p.pad) ? C0[13] * 0.5f : __builtin_amdgcn_exp2f(C0[13]); C0[14] = (PROBE_VARIANT == 1 && p.pad) ? C0[14] * 0.5f : __builtin_amdgcn_exp2f(C0[14]); C0[15] = (PROBE_VARIANT == 1 && p.pad) ? C0[15] * 0.5f : __builtin_amdgcn_exp2f(C0[15]); rs0 += C0[0]; rs1 += C0[1]; rs2 += C0[2]; rs3 += C0[3]; rs0 += C0[4]; rs1 += C0[5]; rs2 += C0[6]; rs3 += C0[7]; VTR_ASM(ta_[4], vaddr_, 1024); VTR_ASM(ta_[5], vaddr_, 1536); VTR_ASM(ta_[6], vaddr_, 5120); VTR_ASM(ta_[7], vaddr_, 5632); AT_SB(); \
          N0 = MFMA32(kfc0, qr[2], N0); N1 = MFMA32(kfc1, qr[2], N1); C1[0] = (PROBE_VARIANT == 1 && p.pad) ? C1[0] * 0.5f : __builtin_amdgcn_exp2f(C1[0]); C1[1] = (PROBE_VARIANT == 1 && p.pad) ? C1[1] * 0.5f : __builtin_amdgcn_exp2f(C1[1]); C1[2] = (PROBE_VARIANT == 1 && p.pad) ? C1[2] * 0.5f : __builtin_amdgcn_exp2f(C1[2]); C1[3] = (PROBE_VARIANT == 1 && p.pad) ? C1[3] * 0.5f : __builtin_amdgcn_exp2f(C1[3]); C1[4] = (PROBE_VARIANT == 1 && p.pad) ? C1[4] * 0.5f : __builtin_amdgcn_exp2f(C1[4]); C1[5] = (PROBE_VARIANT == 1 && p.pad) ? C1[5] * 0.5f : __builtin_amdgcn_exp2f(C1[5]); C1[6] = (PROBE_VARIANT == 1 && p.pad) ? C1[6] * 0.5f : __builtin_amdgcn_exp2f(C1[6]); C1[7] = (PROBE_VARIANT == 1 && p.pad) ? C1[7] * 0.5f : __builtin_amdgcn_exp2f(C1[7]); rs0 += C0[8]; rs1 += C0[9]; rs2 += C0[10]; rs3 += C0[11]; rs0 += C0[12]; rs1 += C0[13]; rs2 += C0[14]; rs3 += C0[15]; VTR_ASM(ta_[8], vaddr_, 2048); VTR_ASM(ta_[9], vaddr_, 2560); VTR_ASM(ta_[10], vaddr_, 6144); VTR_ASM(ta_[11], vaddr_, 6656); AT_SB(); \
          N0 = MFMA32(kfa0, qr[3], N0); N1 = MFMA32(kfa1, qr[3], N1); C1[8] = (PROBE_VARIANT == 1 && p.pad) ? C1[8] * 0.5f : __builtin_amdgcn_exp2f(C1[8]); C1[9] = (PROBE_VARIANT == 1 && p.pad) ? C1[9] * 0.5f : __builtin_amdgcn_exp2f(C1[9]); C1[10] = (PROBE_VARIANT == 1 && p.pad) ? C1[10] * 0.5f : __builtin_amdgcn_exp2f(C1[10]); C1[11] = (PROBE_VARIANT == 1 && p.pad) ? C1[11] * 0.5f : __builtin_amdgcn_exp2f(C1[11]); C1[12] = (PROBE_VARIANT == 1 && p.pad) ? C1[12] * 0.5f : __builtin_amdgcn_exp2f(C1[12]); C1[13] = (PROBE_VARIANT == 1 && p.pad) ? C1[13] * 0.5f : __builtin_amdgcn_exp2f(C1[13]); C1[14] = (PROBE_VARIANT == 1 && p.pad) ? C1[14] * 0.5f : __builtin_amdgcn_exp2f(C1[14]); C1[15] = (PROBE_VARIANT == 1 && p.pad) ? C1[15] * 0.5f : __builtin_amdgcn_exp2f(C1[15]); rs0 += C1[0]; rs1 += C1[1]; rs2 += C1[2]; rs3 += C1[3]; rs0 += C1[4]; rs1 += C1[5]; rs2 += C1[6]; rs3 += C1[7]; VTR_ASM(ta_[12], vaddr_, 3072); VTR_ASM(ta_[13], vaddr_, 3584); VTR_ASM(ta_[14], vaddr_, 7168); VTR_ASM(ta_[15], vaddr_, 7680); AT_SB(); \
          rs0 += C1[8]; rs1 += C1[9]; rs2 += C1[10]; rs3 += C1[11]; rs0 += C1[12]; rs1 += C1[13]; rs2 += C1[14]; rs3 += C1[15]; \
        } \
        l += (rs0 + rs1) + (rs2 + rs3); \
        asm volatile("s_waitcnt lgkmcnt(0)" ::: "memory"); AT_SB(); \
        _Pragma("unroll") for (int s = 0; s < 4; ++s) { vf_[2 * s] = (bf16x8){ta_[4 * s][0], ta_[4 * s][1], ta_[4 * s][2], ta_[4 * s][3], ta_[4 * s + 1][0], ta_[4 * s + 1][1], ta_[4 * s + 1][2], ta_[4 * s + 1][3]}; vf_[2 * s + 1] = (bf16x8){ta_[4 * s + 2][0], ta_[4 * s + 2][1], ta_[4 * s + 2][2], ta_[4 * s + 2][3], ta_[4 * s + 3][0], ta_[4 * s + 3][1], ta_[4 * s + 3][2], ta_[4 * s + 3][3]}; } \
        pw[0] = (u32x4){cvtpk(C0[0], C0[1]), cvtpk(C0[2], C0[3]), cvtpk(C0[4], C0[5]), cvtpk(C0[6], C0[7])}; pw[1] = (u32x4){cvtpk(C0[8], C0[9]), cvtpk(C0[10], C0[11]), cvtpk(C0[12], C0[13]), cvtpk(C0[14], C0[15])}; AT_SB(); \
        if (!(PROBE_VARIANT == 2 && p.pad)) { o0 = MFMA32(__builtin_bit_cast(bf16x8, pw[0]), vf_[0], o0); o1 = MFMA32(__builtin_bit_cast(bf16x8, pw[0]), vf_[1], o1); pw[2] = (u32x4){cvtpk(C1[0], C1[1]), cvtpk(C1[2], C1[3]), cvtpk(C1[4], C1[5]), cvtpk(C1[6], C1[7])}; AT_SB(); \
        o0 = MFMA32(__builtin_bit_cast(bf16x8, pw[1]), vf_[2], o0); o1 = MFMA32(__builtin_bit_cast(bf16x8, pw[1]), vf_[3], o1); pw[3] = (u32x4){cvtpk(C1[8], C1[9]), cvtpk(C1[10], C1[11]), cvtpk(C1[12], C1[13]), cvtpk(C1[14], C1[15])}; AT_SB(); \
        o0 = MFMA32(__builtin_bit_cast(bf16x8, pw[2]), vf_[4], o0); o1 = MFMA32(__builtin_bit_cast(bf16x8, pw[2]), vf_[5], o1); AT_SB(); \
        o0 = MFMA32(__builtin_bit_cast(bf16x8, pw[3]), vf_[6], o0); o1 = MFMA32(__builtin_bit_cast(bf16x8, pw[3]), vf_[7], o1); AT_SB(); } \
        AT_WAITBAR(); \
        if (t_ + 1 < ntiles) AT_REF(N0, N1, t1_, false); } while (0)
    for (int it = 0; it < ntiles; it += 2) {
        AT_STEP(cA0, cA1, cB0, cB1, it);
        AT_STEP(cB0, cB1, cA0, cA1, it + 1);
    }
#undef AT_ROW0
#undef AT_DMAK
#undef AT_DMAV
#undef AT_CLAMP
#undef AT_WAITBAR
#undef AT_REF
#undef AT_SB
#undef AT_QK
#undef AT_STEP
    float lt = l + __shfl_xor(l, 32);
    float fin = 1.f;
    if (p.sink) { const float sk = p.sink[h] * LOG2E; const float m2 = fmaxf(m, sk); fin = __builtin_amdgcn_exp2f(m - m2); lt = lt * fin + __builtin_amdgcn_exp2f(sk - m2); }
    const float sc = fin / lt;
    if (hi == 0) wsf[r32] = sc;
    bf16_t* Ob = p.O + (size_t)(q0 + wid * 32) * p.old + h * p.ohs + r32;
#pragma unroll
    for (int r = 0; r < 16; ++r) { const int qr_ = crow(r, hi); const float f = wsf[qr_];
        if (!nostore) { Ob[(size_t)qr_ * p.old] = f2bf(o0[r] * f); Ob[(size_t)qr_ * p.old + 32] = f2bf(o1[r] * f); } }
}

namespace gp {
constexpr int BM = 256, BK = 64, HALF = 128, HTB = HALF * BK * 2, STAGE_BYTES = 8 * HTB, NXCD = 8, WGM = 8;
__host__ __device__ __forceinline__ int lds_byte(int r, int c) { const int st = (r >> 4) * 2 + (c >> 5), rr = r & 15, cc = c & 31, ob = rr * 64 + cc * 2; return st * 1024 + (ob ^ (((ob >> 9) & 1) << 5)); }
__host__ __device__ __forceinline__ void stage_rc(int b, int& R, int& C) { const int st = b / 1024, sb = b % 1024, swz = sb ^ (((sb >> 9) & 1) << 5); R = (st >> 1) * 16 + swz / 64; C = (st & 1) * 32 + (swz % 64) / 2; }
__host__ __device__ __forceinline__ int perm32(int rho) { const int n = rho >> 4, i = rho & 15; return 8 * (i >> 2) + 4 * n + (i & 3); }

struct GUnit { const char* A; const char* B; int nt, pm, pn, tag; const unsigned* goff; };

__device__ __forceinline__ bool tile_order(int i, int G_, int c, int nM, int nN, int& pm, int& pn) {
    const int nwg = nM * nN; const long L = (long)i * G_ + c; if (L >= nwg) return false;
    int wgid = (int)L; { const int q = nwg / NXCD, r = nwg % NXCD, xcd = wgid % NXCD, off = wgid / NXCD; wgid = (xcd < r ? xcd * (q + 1) : r * (q + 1) + (xcd - r) * q) + off; }
    const int nig = WGM * nN, gid = wgid / nig, fm = gid * WGM, gsz = (nM - fm) < WGM ? (nM - fm) : WGM;
    pm = fm + ((wgid % nig) % gsz); pn = (wgid % nig) / gsz; return true;
}
__device__ __forceinline__ unsigned cvt_pk_bf16(float lo, float hi) { return pkbf(lo, hi); }

template <class Epi, class Sched>
__device__ __forceinline__ void gemm_phase(LAS unsigned char* lds, const Sched& S, const Epi& E) {
    constexpr bool GATHER = Sched::GATHER;
    const int tid = opaque_tid(), wid = __builtin_amdgcn_readfirstlane(tid >> 6), lane = tid & 63, wr = wid >> 2, wc = wid & 3, fr = lane & 15, fq = lane >> 4;
    const int lda2 = S.lda2, ldb2 = S.ldb2;
    unsigned voffA[2], voffB[2], rowA[2];
#pragma unroll
    for (int i = 0; i < 2; ++i) { int R, C; stage_rc(tid * 16 + i * 8192, R, C); const int Rb = Epi::PERM ? ((R & ~31) + perm32(R & 31)) : R;
        voffA[i] = GATHER ? (unsigned)C * 2u : (unsigned)R * (unsigned)lda2 + (unsigned)C * 2u; rowA[i] = (unsigned)R; voffB[i] = (unsigned)Rb * (unsigned)ldb2 + (unsigned)C * 2u; }
    const size_t hA = GATHER ? 0 : (size_t)HALF * lda2, hB = (size_t)HALF * ldb2;
    const unsigned ldsw = (unsigned)wid * 1024u;
    const int aoff = lds_byte(wr * 64 + fr, fq * 8), boff = lds_byte(wc * 32 + fr, fq * 8);
    constexpr size_t kstep = (size_t)(BK * 2);
#define GP_SA(b, h) (((b) * 2 + (h)) * HTB)
#define GP_SB(b, h) ((4 + (b) * 2 + (h)) * HTB)
#define GP_STAGE(bufoff, gbase, v0, v1) do { \
        __builtin_amdgcn_global_load_lds((const unsigned*)((const char*)(gbase) + (v0)), (LAS unsigned*)(lds + (bufoff) + ldsw), 16, 0, 0); \
        __builtin_amdgcn_global_load_lds((const unsigned*)((const char*)(gbase) + (v1)), (LAS unsigned*)(lds + (bufoff) + ldsw + 8192), 16, 0, 0); } while (0)
#define GP_LDA(dst, b, h) do { _Pragma("unroll") for (int m = 0; m < 4; ++m) _Pragma("unroll") for (int k = 0; k < 2; ++k) dst[m][k] = *(const LAS bf16x8*)(lds + GP_SA(b, h) + aoff + m * 2048 + k * 1024); } while (0)
#define GP_LDB(dst, b, h) do { _Pragma("unroll") for (int n = 0; n < 2; ++n) _Pragma("unroll") for (int k = 0; k < 2; ++k) dst[n][k] = *(const LAS bf16x8*)(lds + GP_SB(b, h) + boff + n * 2048 + k * 1024); } while (0)
#define GP_MMA(ai, bj, At, Bt) do { __builtin_amdgcn_s_setprio(1); _Pragma("unroll") for (int m = 0; m < 4; ++m) _Pragma("unroll") for (int n = 0; n < 2; ++n) _Pragma("unroll") for (int k = 0; k < 2; ++k) \
        acc[ai][bj][m][n] = __builtin_amdgcn_mfma_f32_16x16x32_bf16(Bt[n][k], At[m][k], acc[ai][bj][m][n], 0, 0, 0); __builtin_amdgcn_s_setprio(0); } while (0)
#define GP_WAIT_V(n) asm volatile("s_waitcnt vmcnt(" #n ")" ::: "memory")
#define GP_WAIT_L(n) asm volatile("s_waitcnt lgkmcnt(" #n ")" ::: "memory")
#define GP_BAR __builtin_amdgcn_s_barrier()
#define GP_SCHED __builtin_amdgcn_sched_barrier(0)
#define GP_GOFF(U, o0, o1, p0, p1) do { if (GATHER) { o0 = (U).goff[rowA[0]] + voffA[0]; o1 = (U).goff[rowA[1]] + voffA[1]; p0 = (U).goff[128 + rowA[0]] + voffA[0]; p1 = (U).goff[128 + rowA[1]] + voffA[1]; } \
        else { o0 = voffA[0]; o1 = voffA[1]; p0 = voffA[0]; p1 = voffA[1]; } } while (0)
    GUnit cur, nxt; int ui = 0;
    if (!S.next(0, cur)) return;
    f32x4 acc[2][2][4][2];
#pragma unroll
    for (int a = 0; a < 2; ++a)
#pragma unroll
        for (int b = 0; b < 2; ++b)
#pragma unroll
            for (int m = 0; m < 4; ++m)
#pragma unroll
                for (int n = 0; n < 2; ++n) acc[a][b][m][n] = (f32x4){0.f, 0.f, 0.f, 0.f};
    bf16x8 At[4][2], B0[2][2], B1[2][2];
    unsigned g00, g01, g10, g11;
    GP_GOFF(cur, g00, g01, g10, g11);
    const char* cA = cur.A; const char* cB = cur.B;
    GP_STAGE(GP_SB(0, 0), cB, voffB[0], voffB[1]); GP_STAGE(GP_SA(0, 0), cA, g00, g01); GP_STAGE(GP_SB(0, 1), cB + hB, voffB[0], voffB[1]); GP_STAGE(GP_SA(0, 1), cA + hA, g10, g11);
    if (wr == 1) GP_BAR;
    GP_WAIT_V(4); GP_BAR;
    GP_STAGE(GP_SB(1, 0), cB + kstep, voffB[0], voffB[1]); GP_STAGE(GP_SA(1, 0), cA + kstep, g00, g01); GP_STAGE(GP_SB(1, 1), cB + hB + kstep, voffB[0], voffB[1]);
    GP_WAIT_V(6); GP_BAR;
    for (;;) {
        const bool has_next = S.next(ui + 1, nxt);
        const char* nA = has_next ? nxt.A : cA; const char* nB = has_next ? nxt.B : cB;
        const int nt = cur.nt;
        for (int t = 0; t < nt; t += 2) {
            const bool last = (t == nt - 2);
            const char* a1 = cA + (size_t)(t + 1) * kstep;
            const char* a2 = last ? nA : cA + (size_t)(t + 2) * kstep; const char* b2 = last ? nB : cB + (size_t)(t + 2) * kstep;
            const char* a3 = a2 + kstep; const char* b3 = b2 + kstep;
            unsigned w00 = g00, w01 = g01, w10 = g10, w11 = g11;
            if (GATHER && last && has_next) { GP_GOFF(nxt, w00, w01, w10, w11); }
            GP_LDB(B0, 0, 0); GP_SCHED; GP_LDA(At, 0, 0); GP_STAGE(GP_SA(1, 1), a1 + hA, g10, g11);
            GP_WAIT_L(8); GP_BAR; GP_WAIT_L(0); GP_MMA(0, 0, At, B0); GP_BAR; GP_SCHED;
            GP_LDB(B1, 0, 1); GP_STAGE(GP_SB(0, 0), b2, voffB[0], voffB[1]);
            GP_BAR; GP_WAIT_L(0); GP_MMA(0, 1, At, B1); GP_BAR;
            GP_LDA(At, 0, 1); GP_STAGE(GP_SA(0, 0), a2, w00, w01);
            GP_BAR; GP_WAIT_L(0); GP_MMA(1, 0, At, B0); GP_BAR; GP_SCHED;
            GP_STAGE(GP_SB(0, 1), b2 + hB, voffB[0], voffB[1]);
            GP_WAIT_V(6); GP_BAR; GP_MMA(1, 1, At, B1); GP_BAR;
            GP_LDB(B0, 1, 0); GP_SCHED; GP_LDA(At, 1, 0); GP_STAGE(GP_SA(0, 1), a2 + hA, w10, w11);
            GP_WAIT_L(8); GP_BAR; GP_WAIT_L(0); GP_MMA(0, 0, At, B0); GP_BAR; GP_SCHED;
            GP_LDB(B1, 1, 1); GP_STAGE(GP_SB(1, 0), b3, voffB[0], voffB[1]);
            GP_BAR; GP_WAIT_L(0); GP_MMA(0, 1, At, B1); GP_BAR;
            GP_LDA(At, 1, 1); GP_STAGE(GP_SA(1, 0), a3, w00, w01);
            GP_BAR; GP_WAIT_L(0); GP_MMA(1, 0, At, B0); GP_BAR; GP_SCHED;
            GP_STAGE(GP_SB(1, 1), b3 + hB, voffB[0], voffB[1]);
            GP_WAIT_V(6); GP_BAR; GP_MMA(1, 1, At, B1); GP_BAR;
            if (GATHER && last) { g00 = w00; g01 = w01; g10 = w10; g11 = w11; }
        }
        { int fr_e = fr, fq_e = fq; asm volatile("" : "+v"(fr_e), "+v"(fq_e));
          E(acc, cur, wr, wc, fr_e, fq_e); }
        if (!has_next) break;
#pragma unroll
        for (int a = 0; a < 2; ++a)
#pragma unroll
            for (int b = 0; b < 2; ++b)
#pragma unroll
                for (int m = 0; m < 4; ++m)
#pragma unroll
                    for (int n = 0; n < 2; ++n) acc[a][b][m][n] = (f32x4){0.f, 0.f, 0.f, 0.f};
        cur = nxt; cA = nA; cB = nB; ++ui;
    }
    GP_WAIT_V(0);
    if (wr == 0) GP_BAR;
    GP_BAR;
#undef GP_SA
#undef GP_SB
#undef GP_STAGE
#undef GP_LDA
#undef GP_LDB
#undef GP_MMA
#undef GP_WAIT_V
#undef GP_WAIT_L
#undef GP_BAR
#undef GP_SCHED
#undef GP_GOFF
}
}

struct SchedStd {
    static constexpr bool GATHER = false;
    const bf16_t* A; const bf16_t* Bt; int K, nM, nN, G_, c, skipctx, lda2, ldb2;
    __device__ __forceinline__ bool next(int i, gp::GUnit& u) const {
        int pmv, pn; if (!gp::tile_order(i, G_, c, nM, nN, pmv, pn)) return false;
        const int pm = skipctx ? pmv + pmv / 32 : pmv;
        u.A = (const char*)(A + (size_t)pm * 256 * K); u.B = (const char*)(Bt + (size_t)pn * 256 * K); u.nt = K / 64; u.pm = pm; u.pn = pn; u.tag = 0; u.goff = nullptr; return true;
    }
};

__device__ __forceinline__ float fexp(float x) { return __builtin_amdgcn_exp2f(x * LOG2E); }
__device__ __forceinline__ float flog(float x) { return __builtin_amdgcn_logf(x) * 0.6931471805599453f; }
__device__ __forceinline__ float fsigmoid(float x) { return __builtin_amdgcn_rcpf(1.f + fexp(-x)); }
__device__ __forceinline__ float logf_gate_fast(float z, float lb) {
    if (lb <= 0.f) return fminf(z, 0.f) - flog(1.f + fexp(-fabsf(z)));
    return flog(lb + (1.f - lb) * fsigmoid(z));
}
__device__ __forceinline__ unsigned pkh2(float lo, float hi) { const f16_t a = (f16_t)lo, b = (f16_t)hi; return (unsigned)__builtin_bit_cast(unsigned short, a) | ((unsigned)__builtin_bit_cast(unsigned short, b) << 16); }

template <class T> __device__ __forceinline__ T* opq(T* p) { asm volatile("" : "+s"(p)); return p; }
struct EpiG1 {
    static constexpr bool PERM = true;
    bf16_t *AQ, *AK, *AV, *BQ, *BV, *BG; f16_t *BLF, *BLB; bf16_t *CQKV, *CKR; float* RS; const float *ropa_c, *ropa_s, *ropc_c, *ropc_s; const float* LBl; int rowoff;
    __device__ __forceinline__ void operator()(const f32x4 (&acc)[2][2][4][2], const gp::GUnit& u, int wr, int wc, int fr, int fq) const {
        const int pn = u.pn; const int pr = u.pm % 33; const bool lat = pr < 32;
        const int grow0 = u.pm * 256 + wr * 64 + fr; const int t0 = pr * 256 + wr * 64 + fr;
        if (pn < 3) {
            const int hh = pn * 4 + wc; bf16_t* dst; int ld, coff; bf16_t* const aq_ = opq(AQ); bf16_t* const ak_ = opq(AK); bf16_t* const av_ = opq(AV);
            if (hh < 8) { dst = aq_; ld = 512; coff = hh * 64; } else if (hh < 10) { dst = ak_; ld = 128; coff = (hh - 8) * 64; } else { dst = av_; ld = 128; coff = (hh - 10) * 64; }
            const bool rope = lat && hh < 10;
#pragma unroll
            for (int ai = 0; ai < 2; ++ai)
#pragma unroll
                for (int m = 0; m < 4; ++m) { const int grow = grow0 + ai * 128 + m * 16, t = t0 + ai * 128 + m * 16; const size_t row = (size_t)(grow - rowoff);
                    f32x4 x1a = acc[ai][0][m][0], x1b = acc[ai][0][m][1], x2a = acc[ai][1][m][0], x2b = acc[ai][1][m][1];
                    if (rope) { const f32x4 ca = *(const f32x4*)(ropa_c + t * 32 + 8 * fq), cb = *(const f32x4*)(ropa_c + t * 32 + 8 * fq + 4), sa = *(const f32x4*)(ropa_s + t * 32 + 8 * fq), sb = *(const f32x4*)(ropa_s + t * 32 + 8 * fq + 4);
                        const f32x4 o1a = x1a * ca - x2a * sa, o2a = x1a * sa + x2a * ca, o1b = x1b * cb - x2b * sb, o2b = x1b * sb + x2b * cb; x1a = o1a; x2a = o2a; x1b = o1b; x2b = o2b; }
                    if (hh < 8) { const float qs = 0.125f * LOG2E; x1a *= qs; x1b *= qs; x2a *= qs; x2b *= qs; }
                    bf16_t* p = dst + row * ld + coff + 8 * fq;
                    u32x4 w1, w2; w1.x = gp::cvt_pk_bf16(x1a[0], x1a[1]); w1.y = gp::cvt_pk_bf16(x1a[2], x1a[3]); w1.z = gp::cvt_pk_bf16(x1b[0], x1b[1]); w1.w = gp::cvt_pk_bf16(x1b[2], x1b[3]);
                    w2.x = gp::cvt_pk_bf16(x2a[0], x2a[1]); w2.y = gp::cvt_pk_bf16(x2a[2], x2a[3]); w2.z = gp::cvt_pk_bf16(x2b[0], x2b[1]); w2.w = gp::cvt_pk_bf16(x2b[2], x2b[3]);
                    *(u32x4*)p = w1; *(u32x4*)(p + 32) = w2; asm volatile("" ::: "memory"); }
        } else if (pn < 13) {
            const int q = pn - 3, which = q >> 1; const int cb0 = (q & 1) * 256 + wc * 32 + 8 * fq;
            if (which == 2 || which == 3) {
                f16_t* const blf_ = opq(BLF); f16_t* const blb_ = opq(BLB); f16_t* dst = which == 2 ? blf_ : blb_; const float* lbp = LBl + (which == 2 ? 0 : 512);
#pragma unroll
                for (int bj = 0; bj < 2; ++bj) { const int c0 = cb0 + bj * 128; const f32x4 la = *(const f32x4*)(lbp + c0), lb4 = *(const f32x4*)(lbp + c0 + 4);
#pragma unroll
                    for (int ai = 0; ai < 2; ++ai)
#pragma unroll
                        for (int m = 0; m < 4; ++m) { const size_t row = (size_t)(grow0 + ai * 128 + m * 16 - rowoff); const f32x4 v0 = acc[ai][bj][m][0], v1 = acc[ai][bj][m][1];
                            u32x4 w; w.x = pkh2(logf_gate_fast(v0[0], la[0]), logf_gate_fast(v0[1], la[1])); w.y = pkh2(logf_gate_fast(v0[2], la[2]), logf_gate_fast(v0[3], la[3]));
                            w.z = pkh2(logf_gate_fast(v1[0], lb4[0]), logf_gate_fast(v1[1], lb4[1])); w.w = pkh2(logf_gate_fast(v1[2], lb4[2]), logf_gate_fast(v1[3], lb4[3]));
                            *(u32x4*)(dst + row * 512 + c0) = w; } }
            } else {
                bf16_t* const bq_ = opq(BQ); bf16_t* const bv_ = opq(BV); bf16_t* const bg_ = opq(BG); bf16_t* dst = which == 0 ? bq_ : (which == 1 ? bv_ : bg_);
#pragma unroll
                for (int ai = 0; ai < 2; ++ai)
#pragma unroll
                    for (int m = 0; m < 4; ++m) { const size_t row = (size_t)(grow0 + ai * 128 + m * 16 - rowoff);
#pragma unroll
                        for (int bj = 0; bj < 2; ++bj) { const f32x4 v0 = acc[ai][bj][m][0], v1 = acc[ai][bj][m][1];
                            u32x4 w; w.x = gp::cvt_pk_bf16(v0[0], v0[1]); w.y = gp::cvt_pk_bf16(v0[2], v0[3]); w.z = gp::cvt_pk_bf16(v1[0], v1[1]); w.w = gp::cvt_pk_bf16(v1[2], v1[3]);
                            *(u32x4*)(dst + row * 512 + cb0 + bj * 128) = w; } }
            }
        } else if (pn == 13) {
#pragma unroll
            for (int ai = 0; ai < 2; ++ai)
#pragma unroll
                for (int m = 0; m < 4; ++m) { const int grow = grow0 + ai * 128 + m * 16; const size_t row = (size_t)(grow - rowoff); float ss = 0.f;
#pragma unroll
                    for (int bj = 0; bj < 2; ++bj) { const f32x4 v0 = acc[ai][bj][m][0], v1 = acc[ai][bj][m][1];
                        ss += v0[0] * v0[0] + v0[1] * v0[1] + v0[2] * v0[2] + v0[3] * v0[3] + v1[0] * v1[0] + v1[1] * v1[1] + v1[2] * v1[2] + v1[3] * v1[3];
                        u32x4 w; w.x = gp::cvt_pk_bf16(v0[0], v0[1]); w.y = gp::cvt_pk_bf16(v0[2], v0[3]); w.z = gp::cvt_pk_bf16(v1[0], v1[1]); w.w = gp::cvt_pk_bf16(v1[2], v1[3]);
                        *(u32x4*)(CQKV + row * 384 + bj * 128 + wc * 32 + 8 * fq) = w; }
                    ss += __shfl_xor(ss, 16); ss += __shfl_xor(ss, 32);
                    if (fq == 0) RS[(size_t)grow * 8 + wc] = ss; }
        } else {
#pragma unroll
            for (int ai = 0; ai < 2; ++ai)
#pragma unroll
                for (int m = 0; m < 4; ++m) { const int grow = grow0 + ai * 128 + m * 16, t = t0 + ai * 128 + m * 16; const size_t row = (size_t)(grow - rowoff);
                    const f32x4 v0 = acc[ai][0][m][0], v1 = acc[ai][0][m][1];
                    float ss = v0[0] * v0[0] + v0[1] * v0[1] + v0[2] * v0[2] + v0[3] * v0[3] + v1[0] * v1[0] + v1[1] * v1[1] + v1[2] * v1[2] + v1[3] * v1[3];
                    u32x4 w; w.x = gp::cvt_pk_bf16(v0[0], v0[1]); w.y = gp::cvt_pk_bf16(v0[2], v0[3]); w.z = gp::cvt_pk_bf16(v1[0], v1[1]); w.w = gp::cvt_pk_bf16(v1[2], v1[3]);
                    *(u32x4*)(CQKV + row * 384 + 256 + wc * 32 + 8 * fq) = w;
                    ss += __shfl_xor(ss, 16); ss += __shfl_xor(ss, 32);
                    if (fq == 0) RS[(size_t)grow * 8 + 4 + wc] = ss;
                    if (wc == 0) { f32x4 x1 = acc[ai][1][m][0], x2 = acc[ai][1][m][1];
                        if (lat) { const f32x4 cc = *(const f32x4*)(ropc_c + t * 16 + 4 * fq), sn = *(const f32x4*)(ropc_s + t * 16 + 4 * fq); const f32x4 o1 = x1 * cc - x2 * sn, o2 = x1 * sn + x2 * cc; x1 = o1; x2 = o2; }
                        *(uint2*)(CKR + row * 32 + 4 * fq) = make_uint2(gp::cvt_pk_bf16(x1[0], x1[1]), gp::cvt_pk_bf16(x1[2], x1[3]));
                        *(uint2*)(CKR + row * 32 + 16 + 4 * fq) = make_uint2(gp::cvt_pk_bf16(x2[0], x2[1]), gp::cvt_pk_bf16(x2[2], x2[3])); } }
        }
    }
};

struct EpiC {
    static constexpr bool PERM = true;
    bf16_t *CQ, *CKV; const float* RS; const float *ropc_c, *ropc_s; int pmoff;
    __device__ __forceinline__ void operator()(const f32x4 (&acc)[2][2][4][2], const gp::GUnit& u, int wr, int wc, int fr, int fq) const {
        const int pn = u.pn; const int pr = (u.pm + pmoff) % 33; const bool lat = pr < 32;
        const int grow0 = u.pm * 256 + wr * 64 + fr; const int t0 = pr * 256 + wr * 64 + fr;
#pragma unroll
        for (int ai = 0; ai < 2; ++ai)
#pragma unroll
            for (int m = 0; m < 4; ++m) { const size_t row = (size_t)(grow0 + ai * 128 + m * 16); const int t = t0 + ai * 128 + m * 16;
                if (pn < 3) { const f32x4 p4 = *(const f32x4*)(RS + row * 8); const float rq = rsqrtf(((p4[0] + p4[1]) + (p4[2] + p4[3])) * (1.f / 256.f) + EPS) * (0.10206207261596577f * LOG2E);
#pragma unroll
                    for (int bj = 0; bj < 2; ++bj) { const int gi = pn * 8 + bj * 4 + wc, head = gi / 3, part = gi - head * 3;
                        f32x4 v0 = acc[ai][bj][m][0] * rq, v1 = acc[ai][bj][m][1] * rq;
                        bf16_t* p = CQ + row * 768 + head * 96;
                        if (part < 2) { u32x4 w; w.x = gp::cvt_pk_bf16(v0[0], v0[1]); w.y = gp::cvt_pk_bf16(v0[2], v0[3]); w.z = gp::cvt_pk_bf16(v1[0], v1[1]); w.w = gp::cvt_pk_bf16(v1[2], v1[3]);
                            *(u32x4*)(p + part * 32 + 8 * fq) = w; }
                        else { if (lat) { const f32x4 cc = *(const f32x4*)(ropc_c + t * 16 + 4 * fq), sn = *(const f32x4*)(ropc_s + t * 16 + 4 * fq); const f32x4 o1 = v0 * cc - v1 * sn, o2 = v0 * sn + v1 * cc; v0 = o1; v1 = o2; }
                            *(uint2*)(p + 64 + 4 * fq) = make_uint2(gp::cvt_pk_bf16(v0[0], v0[1]), gp::cvt_pk_bf16(v0[2], v0[3]));
                            *(uint2*)(p + 80 + 4 * fq) = make_uint2(gp::cvt_pk_bf16(v1[0], v1[1]), gp::cvt_pk_bf16(v1[2], v1[3])); } }
                } else { const f32x4 p4 = *(const f32x4*)(RS + row * 8 + 4); const float rkv = rsqrtf(((p4[0] + p4[1]) + (p4[2] + p4[3])) * (1.f / 128.f) + EPS);
#pragma unroll
                    for (int bj = 0; bj < 2; ++bj) { const f32x4 v0 = acc[ai][bj][m][0] * rkv, v1 = acc[ai][bj][m][1] * rkv;
                        u32x4 w; w.x = gp::cvt_pk_bf16(v0[0], v0[1]); w.y = gp::cvt_pk_bf16(v0[2], v0[3]); w.z = gp::cvt_pk_bf16(v1[0], v1[1]); w.w = gp::cvt_pk_bf16(v1[2], v1[3]);
                        *(u32x4*)(CKV + row * 1024 + (pn - 3) * 256 + bj * 128 + wc * 32 + 8 * fq) = w; } }
                asm volatile("" ::: "memory"); }
    }
};
struct EpiGate {
    static constexpr bool PERM = true;
    bf16_t* GATE; long nstride; int ld;
    __device__ __forceinline__ void operator()(const f32x4 (&acc)[2][2][4][2], const gp::GUnit& u, int wr, int wc, int fr, int fq) const {
        const int n3 = u.pn >> 2; bf16_t* base = GATE + (size_t)n3 * nstride + (u.pn & 3) * 256 + wc * 32 + 8 * fq; const int row0 = u.pm * 256 + wr * 64 + fr;
#pragma unroll
        for (int ai = 0; ai < 2; ++ai)
#pragma unroll
            for (int m = 0; m < 4; ++m) { bf16_t* rp = base + (size_t)(row0 + ai * 128 + m * 16) * ld;
#pragma unroll
                for (int bj = 0; bj < 2; ++bj) { const f32x4 v0 = acc[ai][bj][m][0], v1 = acc[ai][bj][m][1];
                    u32x4 w; w.x = gp::cvt_pk_bf16(fsigmoid(v0[0]), fsigmoid(v0[1])); w.y = gp::cvt_pk_bf16(fsigmoid(v0[2]), fsigmoid(v0[3])); w.z = gp::cvt_pk_bf16(fsigmoid(v1[0]), fsigmoid(v1[1])); w.w = gp::cvt_pk_bf16(fsigmoid(v1[2]), fsigmoid(v1[3]));
                    *(u32x4*)(rp + bj * 128) = w; } }
    }
};
struct SchedMerge {
    static constexpr bool GATHER = false;
    const bf16_t *A0, *A1, *A2; const bf16_t* Bt; int nM, G_, c, skipctx, lda2, ldb2;
    __device__ __forceinline__ bool next(int i, gp::GUnit& u) const {
        const int j = i / 3, n = i - 3 * j; int pmv, pn; if (!gp::tile_order(j, G_, c, nM, 4, pmv, pn)) return false;
        const int pm = skipctx ? pmv + pmv / 32 : pmv;
        const bf16_t* a0 = opq(A0); const bf16_t* a1 = opq(A1); const bf16_t* a2 = opq(A2);
        const bf16_t* a = n == 0 ? a0 : (n == 1 ? a1 : a2);
        u.A = (const char*)(a + (size_t)pm * 256 * 512); u.B = (const char*)(Bt + (size_t)n * 1024 * 512 + (size_t)pn * 256 * 512); u.nt = 8; u.pm = pm; u.pn = pn; u.tag = n; u.goff = nullptr; return true;
    }
};
__device__ __forceinline__ float bflo(unsigned w) { return __uint_as_float(w << 16); }
__device__ __forceinline__ float bfhi(unsigned w) { return __uint_as_float(w & 0xffff0000u); }
struct EpiMerge {
    static constexpr bool PERM = true;
    const bf16_t* GATE; long nstride; int ld; bf16_t* Y;
    __device__ __forceinline__ void operator()(const f32x4 (&acc)[2][2][4][2], const gp::GUnit& u, int wr, int wc, int fr, int fq) const {
        const int n3 = u.tag; const int col = u.pn * 256 + wc * 32 + 8 * fq; const bf16_t* gb = GATE + (size_t)n3 * nstride + col; const int row0 = u.pm * 256 + wr * 64 + fr;
#pragma unroll
        for (int ai = 0; ai < 2; ++ai)
#pragma unroll
            for (int m = 0; m < 4; ++m) { const size_t row = (size_t)(row0 + ai * 128 + m * 16);
#pragma unroll
                for (int bj = 0; bj < 2; ++bj) { const u32x4 g = *(const u32x4*)(gb + row * ld + bj * 128); u32x4* yp = (u32x4*)(Y + row * 1024 + col + bj * 128);
                    const f32x4 v0 = acc[ai][bj][m][0], v1 = acc[ai][bj][m][1];
                    float r[8] = {v0[0] * bflo(g.x), v0[1] * bfhi(g.x), v0[2] * bflo(g.y), v0[3] * bfhi(g.y), v1[0] * bflo(g.z), v1[1] * bfhi(g.z), v1[2] * bflo(g.w), v1[3] * bfhi(g.w)};
                    if (n3 != 0) { const u32x4 o = __builtin_nontemporal_load(yp);     r[0] += bflo(o.x); r[1] += bfhi(o.x); r[2] += bflo(o.y); r[3] += bfhi(o.y); r[4] += bflo(o.z); r[5] += bfhi(o.z); r[6] += bflo(o.w); r[7] += bfhi(o.w); }
                    u32x4 w; w.x = gp::cvt_pk_bf16(r[0], r[1]); w.y = gp::cvt_pk_bf16(r[2], r[3]); w.z = gp::cvt_pk_bf16(r[4], r[5]); w.w = gp::cvt_pk_bf16(r[6], r[7]);
                    *yp = w; }
                asm volatile("" ::: "memory"); }
    }
};
struct EpiOut {
    static constexpr bool PERM = false;
    const float *xl_src, *xc_src; float *xl_dst, *xc_dst; const float* mod; int pmoff;
    __device__ __forceinline__ void operator()(const f32x4 (&acc)[2][2][4][2], const gp::GUnit& u, int wr, int wc, int fr, int fq) const {
        const int gpm = u.pm + pmoff, b = gpm / 33, pr = gpm - b * 33; const bool lat = pr < 32;
        const float* xs = opq(lat ? xl_src : xc_src); float* xd = opq(lat ? xl_dst : xc_dst);
        const size_t rbase = lat ? ((size_t)b * SEQ + pr * 256) : ((size_t)b * CTXL);
        const float* gt = mod + (size_t)(lat ? b : 4) * 6144 + 2048; const int col0 = u.pn * 256 + wc * 32 + 4 * fq;
#pragma unroll
        for (int ai = 0; ai < 2; ++ai)
#pragma unroll
            for (int m = 0; m < 4; ++m) { const size_t off = (rbase + ai * 128 + wr * 64 + m * 16 + fr) * D + col0;
#pragma unroll
                for (int bj = 0; bj < 2; ++bj)
#pragma unroll
                    for (int n = 0; n < 2; ++n) { const int cc = bj * 128 + n * 16; const f32x4 g4 = *(const f32x4*)(gt + col0 + cc); const f32x4 xv = *(const f32x4*)(xs + off + cc);
                        *(f32x4*)(xd + off + cc) = xv + g4 * acc[ai][bj][m][n]; }
                asm volatile("" ::: "memory"); }
    }
};
template <bool GATHER_> struct SchedMoE {
    static constexpr bool GATHER = GATHER_;
    const bf16_t* A; const bf16_t* Bt; const int* tile_e; const unsigned* goff; int K, nM, nN, G_, c, lda2, ldb2; long strideB;
    __device__ __forceinline__ bool next(int i, gp::GUnit& u) const {
        int pm, pn; if (!gp::tile_order(i, G_, c, nM, nN, pm, pn)) return false;
        const int e = tile_e[pm];
        u.A = GATHER ? (const char*)A : (const char*)(A + (size_t)pm * 256 * K); u.B = (const char*)(Bt + (size_t)e * strideB + (size_t)pn * 256 * K); u.nt = K / 64; u.pm = pm; u.pn = pn; u.tag = e;
        u.goff = GATHER ? goff + (size_t)pm * 256 : nullptr; return true;
    }
};
struct EpiUp {
    static constexpr bool PERM = true;
    bf16_t* AUP;
    __device__ __forceinline__ void operator()(const f32x4 (&acc)[2][2][4][2], const gp::GUnit& u, int wr, int wc, int fr, int fq) const {
        const int row0 = u.pm * 256 + wr * 64 + fr; bf16_t* base = AUP + u.pn * 128 + wc * 32 + 8 * fq;
#pragma unroll
        for (int ai = 0; ai < 2; ++ai)
#pragma unroll
            for (int m = 0; m < 4; ++m) { const f32x4 a0 = acc[ai][0][m][0], a1 = acc[ai][0][m][1], b0 = acc[ai][1][m][0], b1 = acc[ai][1][m][1];
                float r[8];
#pragma unroll
                for (int e = 0; e < 4; ++e) { r[e] = a0[e] * fsigmoid(a0[e]) * b0[e]; r[4 + e] = a1[e] * fsigmoid(a1[e]) * b1[e]; }
                u32x4 w; w.x = gp::cvt_pk_bf16(r[0], r[1]); w.y = gp::cvt_pk_bf16(r[2], r[3]); w.z = gp::cvt_pk_bf16(r[4], r[5]); w.w = gp::cvt_pk_bf16(r[6], r[7]);
                *(u32x4*)(base + (size_t)(row0 + ai * 128 + m * 16) * 256) = w; }
    }
};
struct EpiDown {
    static constexpr bool PERM = true;
    bf16_t* YM2; const int* perm; const float* posw;
    __device__ __forceinline__ void operator()(const f32x4 (&acc)[2][2][4][2], const gp::GUnit& u, int wr, int wc, int fr, int fq) const {
        const int row0 = u.pm * 256 + wr * 64 + fr; const int col = u.pn * 256 + wc * 32 + 8 * fq;
#pragma unroll
        for (int ai = 0; ai < 2; ++ai)
#pragma unroll
            for (int m = 0; m < 4; ++m) { const int pos = row0 + ai * 128 + m * 16; const int pe = perm[pos]; const float w8 = posw[pos];
                if (pe >= 0) {
#pragma unroll
                    for (int bj = 0; bj < 2; ++bj) { const f32x4 v0 = acc[ai][bj][m][0] * w8, v1 = acc[ai][bj][m][1] * w8;
                        u32x4 w; w.x = gp::cvt_pk_bf16(v0[0], v0[1]); w.y = gp::cvt_pk_bf16(v0[2], v0[3]); w.z = gp::cvt_pk_bf16(v1[0], v1[1]); w.w = gp::cvt_pk_bf16(v1[2], v1[3]);
                        *(u32x4*)(YM2 + (size_t)pe * 1024 + col + bj * 128) = w; } } }
    }
};
enum { MAP_WIN = 1, MAP_WC = 2, MAP_WUP = 3 };
__device__ __forceinline__ int colmap(int kind, int p) {
    if (kind == MAP_WIN) {
        if (p >= 3840) return MIXW + (p - 3840);
        const int pn = p >> 8, q = p & 255, bj = q >> 7, wc = (q >> 5) & 3, j = q & 31;
        if (pn < 3) return (pn * 4 + wc) * 64 + bj * 32 + j;
        if (pn < 14) return p;
        if (bj == 0) return p;
        if (wc != 0) return -1;
        return 3712 + 16 * ((j >> 2) & 1) + 4 * (j >> 3) + (j & 3);
    }
    return p;
}
constexpr int NCHK = RPB / 64;
struct ScanArgs { const bf16_t* BQ; const bf16_t* BV; const bf16_t* BG; const f16_t* BLF; const f16_t* BLB; bf16_t* ST; float* DS; bf16_t* OB; const float* gn; int in_off; int out_off; int skipctx_out; int pad; };
#define MFMA16(a, b, c) __builtin_amdgcn_mfma_f32_16x16x32_bf16(a, b, c, 0, 0, 0)
constexpr int BCS = 68;
constexpr int SC_RAW = 0, SC_VT = 2 * 64 * BCS * 4, SC_A = SC_VT + 9216;
__device__ __forceinline__ void scan_stage(LAS char* lds, const ScanArgs& a, size_t row0, int h, int tid) {
    LAS float* RAW = (LAS float*)(lds + SC_RAW); LAS bf16_t* VT = (LAS bf16_t*)(lds + SC_VT);
    const int row = tid >> 3, c8 = (tid & 7) * 8; const size_t off = (row0 + row) * 512 + h * 64 + c8;
    typedef _Float16 h8 __attribute__((ext_vector_type(8)));
    const h8 lf = *(const h8*)(a.BLF + off), lb = *(const h8*)(a.BLB + off);
    const int vrow = tid & 63, vc8 = (tid >> 6) * 8; const bf16x8 v = *(const bf16x8*)(a.BV + (row0 + vrow) * 512 + h * 64 + vc8);
    *(LAS f32x4*)(RAW + row * BCS + c8) = (f32x4){(float)lf[0], (float)lf[1], (float)lf[2], (float)lf[3]}; *(LAS f32x4*)(RAW + row * BCS + c8 + 4) = (f32x4){(float)lf[4], (float)lf[5], (float)lf[6], (float)lf[7]};
    *(LAS f32x4*)(RAW + 64 * BCS + row * BCS + c8) = (f32x4){(float)lb[0], (float)lb[1], (float)lb[2], (float)lb[3]}; *(LAS f32x4*)(RAW + 64 * BCS + row * BCS + c8 + 4) = (f32x4){(float)lb[4], (float)lb[5], (float)lb[6], (float)lb[7]};
#pragma unroll
    for (int j = 0; j < 8; ++j) VT[(vc8 + j) * 72 + vrow] = (bf16_t)v[j];
}
__device__ __forceinline__ void scan_cumsum(LAS char* lds, LAS float* XCH, int tid, float (&lf)[16], float (&bc)[16], float& total) {
    LAS float* RAW = (LAS float*)(lds + SC_RAW);
    const int col = tid & 127, dir = col >> 6, d = col & 63, seg = tid >> 7;
#pragma unroll
    for (int j = 0; j < 16; ++j) lf[j] = RAW[dir * 64 * BCS + (16 * seg + j) * BCS + d];
    if (dir == 0) { float c = 0.f;
#pragma unroll
        for (int j = 0; j < 16; ++j) { c += lf[j]; bc[j] = c; } }
    else { float c = 0.f;
#pragma unroll
        for (int j = 15; j >= 0; --j) { c += lf[j]; bc[j] = c; } }
    XCH[seg * 128 + col] = dir == 0 ? bc[15] : bc[0];
    __syncthreads();
    const float t0 = XCH[col], t1 = XCH[128 + col], t2 = XCH[256 + col], t3 = XCH[384 + col];
    total = (t0 + t1) + (t2 + t3);
    float off;
    if (dir == 0) off = seg == 0 ? 0.f : (seg == 1 ? t0 : (seg == 2 ? t0 + t1 : t0 + t1 + t2));
    else off = seg == 3 ? 0.f : (seg == 2 ? t3 : (seg == 1 ? t3 + t2 : t3 + t2 + t1));
#pragma unroll
    for (int j = 0; j < 16; ++j) bc[j] += off;
}
__device__ __forceinline__ void scan_s1_unit(LAS char* lds, const ScanArgs& a, int b, int h, int k) {
    const int tid = opaque_tid(), lane = tid & 63, wid = tid >> 6;
    LAS bf16_t* VT = (LAS bf16_t*)(lds + SC_VT); LAS bf16_t* KKT = (LAS bf16_t*)(lds + SC_A); LAS float* XCH = (LAS float*)(lds + SC_A + 18432);
    const size_t row0 = (size_t)b * RPB + 64 * k - a.in_off;
    scan_stage(lds, a, row0, h, tid);
    __syncthreads();
    float lf[16], bc[16], total; scan_cumsum(lds, XCH, tid, lf, bc, total);
    const int col = tid & 127, dir = col >> 6, d = col & 63, seg = tid >> 7;
    const size_t sidx = ((size_t)((b * 8 + h) * 2 + dir)) * NCHK + k;
    { unsigned w[8];
#pragma unroll
      for (int j = 0; j < 16; j += 2) { const float k0 = (1.f - fexp(lf[j])) * fexp(total - bc[j]), k1 = (1.f - fexp(lf[j + 1])) * fexp(total - bc[j + 1]); w[j >> 1] = pkbf(k0, k1); }
      LAS u32x4* kp = (LAS u32x4*)(KKT + (dir * 64 + d) * 72 + 16 * seg); kp[0] = (u32x4){w[0], w[1], w[2], w[3]}; kp[1] = (u32x4){w[4], w[5], w[6], w[7]};
      if (seg == 0) a.DS[sidx * 64 + d] = fexp(total); }
    __syncthreads();
    { const int wdir = wid >> 2, et = wid & 3, fr = lane & 15, fq = lane >> 4;
      f32x4 acc[4];
#pragma unroll
      for (int dt = 0; dt < 4; ++dt) acc[dt] = (f32x4){0.f, 0.f, 0.f, 0.f};
#pragma unroll
      for (int ks = 0; ks < 2; ++ks) { const bf16x8 af = *(const LAS bf16x8*)(VT + (16 * et + fr) * 72 + 32 * ks + 8 * fq);
#pragma unroll
          for (int dt = 0; dt < 4; ++dt) { const bf16x8 bfv = *(const LAS bf16x8*)(KKT + (wdir * 64 + 16 * dt + fr) * 72 + 32 * ks + 8 * fq); acc[dt] = MFMA16(af, bfv, acc[dt]); } }
      bf16_t* sp = a.ST + (((size_t)((b * 8 + h) * 2 + wdir)) * NCHK + k) * 4096;
#pragma unroll
      for (int dt = 0; dt < 4; ++dt)
#pragma unroll
          for (int r = 0; r < 4; ++r) sp[(16 * et + 4 * fq + r) * 64 + 16 * dt + fr] = f2bf(acc[dt][r]); }
    __syncthreads();
}
__device__ __forceinline__ void scan_s2_task(const ScanArgs& a, int task) {
    const int chain = task >> 2, quarter = task & 3, dir = chain & 1, tid = opaque_tid();
    const int e = 16 * quarter + (tid >> 5), d = 2 * (tid & 31);
    float s0 = 0.f, s1 = 0.f;
    for (int g = 0; g < NCHK; g += 12) {
        unsigned L[12]; float2 Dv[12]; unsigned* pp[12];
#pragma unroll
        for (int j = 0; j < 12; ++j) { const int step = g + j; const int k = dir == 0 ? (step < 4 ? 128 + step : step - 4) : (step < 4 ? 131 - step : 131 - step);
            const size_t idx = (size_t)chain * NCHK + k; pp[j] = (unsigned*)(a.ST + idx * 4096 + e * 64 + d); L[j] = *pp[j]; Dv[j] = *(const float2*)(a.DS + idx * 64 + d); }
#pragma unroll
        for (int j = 0; j < 12; ++j) { *pp[j] = pkbf(s0, s1); s0 = Dv[j].x * s0 + bflo(L[j]); s1 = Dv[j].y * s1 + bfhi(L[j]); }
    }
}
__device__ __forceinline__ void scan_s3_unit(LAS char* lds, const ScanArgs& a, int b, int h, int k) {
    const int tid = opaque_tid(), lane = tid & 63, wid = tid >> 6;
    LAS float* BC = (LAS float*)(lds + SC_RAW); LAS bf16_t* VT = (LAS bf16_t*)(lds + SC_VT);
    LAS bf16_t* STL = (LAS bf16_t*)(lds + SC_A);
    LAS float* XCH = (LAS float*)(lds + SC_A + 18432);
    LAS float* OSUM = (LAS float*)(lds + SC_A + 18432 + 2048);
    LAS bf16_t* PW = (LAS bf16_t*)(lds + SC_A + 18432 + 2048 + 17408) + wid * 3456;
    const size_t row0 = (size_t)b * RPB + 64 * k - a.in_off;
    bf16x8 q0_, q1_; bf16_t gpre[16];
    { const int dir_ = wid >> 2, si_ = wid & 3, erow_ = lane >> 2, dg_ = (lane & 3) * 16, fr_ = lane & 15, fq_ = lane >> 4;
      const bf16_t* qp = a.BQ + (row0 + 16 * si_ + erow_) * 512 + h * 64 + dg_; q0_ = *(const bf16x8*)qp; q1_ = *(const bf16x8*)(qp + 8);
      if (dir_ == 1) {
#pragma unroll
          for (int n = 0; n < 4; ++n)
#pragma unroll
              for (int r = 0; r < 4; ++r) gpre[n * 4 + r] = a.BG[(row0 + 16 * si_ + 4 * fq_ + r) * 512 + h * 64 + 16 * n + fr_]; }
      else {
#pragma unroll
          for (int i = 0; i < 16; ++i) gpre[i] = 0; } }
    scan_stage(lds, a, row0, h, tid);
    { const int sd = tid >> 8, e = (tid & 255) >> 2, c16 = (tid & 3) * 16;
      const bf16_t* sp = a.ST + (((size_t)((b * 8 + h) * 2 + sd)) * NCHK + k) * 4096 + e * 64 + c16;
      const u32x4 s0 = *(const u32x4*)sp, s1 = *(const u32x4*)(sp + 8);
      LAS u32x4* dp = (LAS u32x4*)(STL + (sd * 64 + e) * 72 + c16); dp[0] = s0; dp[1] = s1; }
    __syncthreads();
    { float lf[16], bc[16], total; scan_cumsum(lds, XCH, tid, lf, bc, total);
      const int col = tid & 127, dir = col >> 6, d = col & 63, seg = tid >> 7;
      __syncthreads();
#pragma unroll
      for (int j = 0; j < 16; ++j) BC[dir * 64 * BCS + (16 * seg + j) * BCS + d] = bc[j]; }
    __syncthreads();
    const int dir = wid >> 2, si = wid & 3;
    LAS bf16_t* QP = PW; LAS bf16_t* KP = PW + 1152; LAS bf16_t* ATT = PW + 2304;
    const int erow = lane >> 2, dg = (lane & 3) * 16;
    const int fr = lane & 15, fq = lane >> 4;
    LAS const float* bcd = BC + dir * 64 * BCS;
    float refv[16];
    { const int rr = dir == 0 ? 16 * si - 1 : 16 * (si + 1);
#pragma unroll
      for (int j = 0; j < 16; j += 4) { f32x4 t4 = (f32x4){0.f, 0.f, 0.f, 0.f}; if (rr >= 0 && rr < 64) t4 = *(const LAS f32x4*)(bcd + rr * BCS + dg + j); refv[j] = t4[0]; refv[j + 1] = t4[1]; refv[j + 2] = t4[2]; refv[j + 3] = t4[3]; } }
    float qv[16], bq[16];
    {
#pragma unroll
      for (int j = 0; j < 8; ++j) { qv[j] = bf2f((bf16_t)q0_[j]); qv[8 + j] = bf2f((bf16_t)q1_[j]); }
#pragma unroll
      for (int j = 0; j < 16; j += 4) { const f32x4 t4 = *(const LAS f32x4*)(bcd + (16 * si + erow) * BCS + dg + j); bq[j] = t4[0]; bq[j + 1] = t4[1]; bq[j + 2] = t4[2]; bq[j + 3] = t4[3]; } }
    { unsigned w[8];
#pragma unroll
      for (int j = 0; j < 16; j += 2) w[j >> 1] = pkbf(qv[j] * fexp(bq[j] - refv[j]), qv[j + 1] * fexp(bq[j + 1] - refv[j + 1]));
      LAS u32x4* p = (LAS u32x4*)(QP + erow * 72 + dg); p[0] = (u32x4){w[0], w[1], w[2], w[3]}; p[1] = (u32x4){w[4], w[5], w[6], w[7]};
      LAS u32x4* z = (LAS u32x4*)(ATT + erow * 72 + dg); z[0] = (u32x4){0u, 0u, 0u, 0u}; z[1] = (u32x4){0u, 0u, 0u, 0u}; }
    const int j_lo = dir == 0 ? 0 : si, j_hi = dir == 0 ? si : 3;
    for (int jb = j_lo; jb <= j_hi; ++jb) {
        { const int sg = 16 * jb + erow; const int sn = dir == 0 ? sg - 1 : sg + 1; unsigned w[8];
#pragma unroll
          for (int j = 0; j < 16; j += 4) { const f32x4 bs4 = *(const LAS f32x4*)(bcd + sg * BCS + dg + j); f32x4 bn4 = (f32x4){0.f, 0.f, 0.f, 0.f}; if (sn >= 0 && sn < 64) bn4 = *(const LAS f32x4*)(bcd + sn * BCS + dg + j);
              float kk[4];
#pragma unroll
              for (int t = 0; t < 4; ++t) kk[t] = (1.f - fexp(bs4[t] - bn4[t])) * fexp(fminf(refv[j + t] - bs4[t], 60.f));
              w[j >> 1] = pkbf(kk[0], kk[1]); w[(j >> 1) + 1] = pkbf(kk[2], kk[3]); }
          LAS u32x4* p = (LAS u32x4*)(KP + erow * 72 + dg); p[0] = (u32x4){w[0], w[1], w[2], w[3]}; p[1] = (u32x4){w[4], w[5], w[6], w[7]}; }
        __builtin_amdgcn_wave_barrier(); asm volatile("s_waitcnt lgkmcnt(0)" ::: "memory");
        f32x4 c = (f32x4){0.f, 0.f, 0.f, 0.f};
#pragma unroll
        for (int ks = 0; ks < 2; ++ks) { const bf16x8 af = *(const LAS bf16x8*)(QP + fr * 72 + 32 * ks + 8 * fq), bfv = *(const LAS bf16x8*)(KP + fr * 72 + 32 * ks + 8 * fq); c = MFMA16(af, bfv, c); }
#pragma unroll
        for (int r = 0; r < 4; ++r) { const int tq = 4 * fq + r; float v = c[r];
            if (jb == si) { if (dir == 0 ? (fr > tq) : (fr < tq)) v = 0.f; }
            ATT[tq * 72 + 16 * jb + fr] = f2bf(v); }
        __builtin_amdgcn_wave_barrier(); asm volatile("s_waitcnt lgkmcnt(0)" ::: "memory");
    }
    { unsigned w[8];
#pragma unroll
      for (int j = 0; j < 16; j += 2) w[j >> 1] = pkbf(qv[j] * fexp(bq[j]), qv[j + 1] * fexp(bq[j + 1]));
      LAS u32x4* p = (LAS u32x4*)(QP + erow * 72 + dg); p[0] = (u32x4){w[0], w[1], w[2], w[3]}; p[1] = (u32x4){w[4], w[5], w[6], w[7]}; }
    __builtin_amdgcn_wave_barrier(); asm volatile("s_waitcnt lgkmcnt(0)" ::: "memory");
    f32x4 o[4];
#pragma unroll
    for (int n = 0; n < 4; ++n) o[n] = (f32x4){0.f, 0.f, 0.f, 0.f};
#pragma unroll
    for (int ks = 0; ks < 2; ++ks) { const bf16x8 aq = *(const LAS bf16x8*)(QP + fr * 72 + 32 * ks + 8 * fq), aa = *(const LAS bf16x8*)(ATT + fr * 72 + 32 * ks + 8 * fq);
#pragma unroll
        for (int n = 0; n < 4; ++n) { const bf16x8 bs = *(const LAS bf16x8*)(STL + (dir * 64 + 16 * n + fr) * 72 + 32 * ks + 8 * fq), bv = *(const LAS bf16x8*)(VT + (16 * n + fr) * 72 + 32 * ks + 8 * fq);
            o[n] = MFMA16(aq, bs, o[n]); o[n] = MFMA16(aa, bv, o[n]); } }
    if (dir == 0) {
#pragma unroll
        for (int n = 0; n < 4; ++n)
#pragma unroll
            for (int r = 0; r < 4; ++r) OSUM[(16 * si + 4 * fq + r) * 68 + 16 * n + fr] = o[n][r]; }
    __syncthreads();
    if (dir == 1) {
        const bool wr_out = !(a.skipctx_out && k >= 128) && !a.pad;
        float ss[4] = {0.f, 0.f, 0.f, 0.f};
#pragma unroll
        for (int n = 0; n < 4; ++n)
#pragma unroll
            for (int r = 0; r < 4; ++r) { o[n][r] += OSUM[(16 * si + 4 * fq + r) * 68 + 16 * n + fr]; ss[r] += o[n][r] * o[n][r]; }
#pragma unroll
        for (int r = 0; r < 4; ++r) { ss[r] += __shfl_xor(ss[r], 1); ss[r] += __shfl_xor(ss[r], 2); ss[r] += __shfl_xor(ss[r], 4); ss[r] += __shfl_xor(ss[r], 8); ss[r] = rsqrtf(ss[r] * (1.f / 64.f) + EPS); }
        if (wr_out) {
            const size_t orow0 = (size_t)b * RPB + 64 * k - a.out_off;
#pragma unroll
            for (int n = 0; n < 4; ++n)
#pragma unroll
                for (int r = 0; r < 4; ++r) { const int tq = 16 * si + 4 * fq + r, e = 16 * n + fr; const float gv = bf2f(gpre[n * 4 + r]);
                    a.OB[(orow0 + tq) * 512 + h * 64 + e] = f2bf(o[n][r] * ss[r] * a.gn[h * 64 + e] * gv * fsigmoid(gv)); }
        }
    }
    __syncthreads();
}
constexpr int SCAN_LDS = SC_A + 18432 + 2048 + 17408 + 8 * 6912;

#define XB_TMO      128
#define XB_XCNT(j)  (256  + 64 * (j))
#define XB_XSUB(j)  (1280 + 64 * (j))
#define XB_XGEN(j)  (2304 + 64 * (j))
#define XB_TOP      3328
#define XB_TOPGEN   3392
#define XCD_BAR_WORDS 3456
#define XB_SPIN_CAP (1u << 18)

__device__ __forceinline__ unsigned xb_ld(unsigned* p)              { return __hip_atomic_load(p, __ATOMIC_RELAXED, __HIP_MEMORY_SCOPE_AGENT); }
__device__ __forceinline__ unsigned xb_add(unsigned* p, unsigned v) { return __hip_atomic_fetch_add(p, v, __ATOMIC_RELAXED, __HIP_MEMORY_SCOPE_AGENT); }
__device__ __forceinline__ unsigned xb_xcc_id() { return (unsigned)__builtin_amdgcn_s_getreg((3 << 11) | 20) & 0xFu; }
#define XB_SPIN(cond, bar) do { unsigned _sp = 0; while (cond) { __builtin_amdgcn_s_sleep(1); \
    if ((++_sp & 255u) == 0u) { if (xb_ld(&(bar)[XB_TMO])) break; if (_sp > XB_SPIN_CAP) { atomicAdd(&(bar)[XB_TMO], 1u); break; } } } } while (0)

struct XcdBarrier {
    unsigned* bar; unsigned x;
    volatile LAS unsigned* st;
};

__device__ __forceinline__ XcdBarrier xcd_barrier_post(unsigned* bar, volatile LAS unsigned* st) {
    XcdBarrier b; b.bar = bar; b.x = xb_xcc_id(); b.st = st;
    if (threadIdx.x == 0) (void)xb_add(&bar[XB_XCNT(b.x)], 1u);
    return b;
}
__device__ __forceinline__ void xcd_barrier_complete(unsigned* bar, unsigned x, unsigned& nloc, unsigned& nx) {
    const unsigned G = gridDim.x * gridDim.y * gridDim.z;
    unsigned sum, cnt, mine, sp = 0u;
    for (;;) {
        sum = 0u; cnt = 0u; mine = 0u;
#pragma unroll
        for (unsigned j = 0; j < 16; ++j) { const unsigned c = xb_ld(&bar[XB_XCNT(j)]); sum += c; cnt += (c > 0u) ? 1u : 0u; mine = (j == x) ? c : mine; }
        if (sum == G) break;
        __builtin_amdgcn_s_sleep(1);
        if ((++sp & 255u) == 0u) { if (xb_ld(&bar[XB_TMO])) break; if (sp > XB_SPIN_CAP) { atomicAdd(&bar[XB_TMO], 1u); break; } }
    }
    nloc = mine > 0u ? mine : 1u; nx = cnt > 0u ? cnt : 1u;
}

__device__ __forceinline__ void xcd_barrier(const XcdBarrier& b) {
    asm volatile("s_waitcnt vmcnt(0)" ::: "memory");
    __syncthreads();
    if (threadIdx.x == 0) {
        unsigned* bar = b.bar;
        __builtin_amdgcn_s_waitcnt(0);
        unsigned nloc = b.st[0], nx = b.st[1];
        if (nloc == 0u) { xcd_barrier_complete(bar, b.x, nloc, nx); b.st[0] = nloc; b.st[1] = nx; }
        const unsigned old = xb_add(&bar[XB_XSUB(b.x)], 1u);
        const unsigned gen = old / nloc;
        if (old + 1u == (gen + 1u) * nloc) {
            __builtin_amdgcn_fence(__ATOMIC_RELEASE, "agent");
            asm volatile("s_waitcnt vmcnt(0)" ::: "memory");
            const unsigned og = xb_add(&bar[XB_TOP], 1u);
            const unsigned tg = og / nx;
            if (og + 1u == (tg + 1u) * nx) xb_add(&bar[XB_TOPGEN], 1u);
            else XB_SPIN(xb_ld(&bar[XB_TOPGEN]) == tg, bar);
            __builtin_amdgcn_fence(__ATOMIC_ACQUIRE, "agent");
            xb_add(&bar[XB_XGEN(b.x)], 1u);
            asm volatile("s_waitcnt vmcnt(0)" ::: "memory");
        } else {
            XB_SPIN(xb_ld(&bar[XB_XGEN(b.x)]) == gen, bar);
            __builtin_amdgcn_fence(__ATOMIC_ACQUIRE, "agent");
            asm volatile("s_waitcnt vmcnt(0)" ::: "memory");
        }
    }
    __syncthreads();
}


constexpr size_t MiB = 1u << 20;
constexpr size_t CTL_ZERO_BYTES = 64 * 1024;
constexpr int CW_COUNTS = 8192, CW_CURSOR = 8192 + 128;
constexpr size_t O_MOD = 1 * MiB, O_LB = 1 * MiB + 512 * 1024, O_ROPA_C = 2 * MiB, O_ROPA_S = 3 * MiB, O_ROPC_C = 4 * MiB, O_ROPC_S = 4 * MiB + 512 * 1024, O_XC = 5 * MiB;
constexpr size_t O_ROUTE_E = 9 * MiB, O_ROUTE_W = 9 * MiB + 512 * 1024, O_PERM = 10 * MiB, O_POSW = 10 * MiB + 512 * 1024, O_GOFF = 11 * MiB, O_TILEE = 11 * MiB + 512 * 1024;
constexpr size_t O_WRT = 11 * MiB + 640 * 1024;
constexpr size_t O_RS = 12 * MiB, O_DS = 13 * MiB + 512 * 1024, O_WGH = 15 * MiB + 768 * 1024;
constexpr size_t O_WINP = 16 * MiB, O_WC = 30 * MiB, O_WBR = 32 * MiB, O_WOUT = 35 * MiB;
constexpr size_t O_H = 38 * MiB;
constexpr size_t O_AQ = 104 * MiB, O_AK = 137 * MiB, O_AV = 145 * MiB + 512 * 1024;
constexpr size_t O_BQ = 154 * MiB, O_BV = 187 * MiB, O_BG = 220 * MiB, O_BLF = 253 * MiB, O_BLB = 286 * MiB;
constexpr size_t O_CQKV = 319 * MiB, O_CKR = 344 * MiB, O_CQ = 347 * MiB, O_CKV = 397 * MiB, O_OC = 463 * MiB, O_WRB = 496 * MiB, WS_END = 497 * MiB;
constexpr size_t O_GATE = 187 * MiB;
constexpr size_t O_YM2 = 154 * MiB, O_AUP = 104 * MiB, O_WUP = 397 * MiB, O_WDN = 429 * MiB;
constexpr int LDS_BYTES = 163840, LDS_BAR_OFF = LDS_BYTES - 64, LDS_PTR_OFF = LDS_BYTES - 512;

struct KP { const float* in[24]; float* out; char* ws; int ph_lo, ph_hi; unsigned long long mask; };
struct Frame {
    LAS char* lds; char* ws; float* out;
};
#define WSP(T, off) ((T*)(F.ws + (off)))
__device__ __forceinline__ const float* in_ptr(const Frame& F, int k) { const volatile LAS unsigned* q = (const volatile LAS unsigned*)(F.lds + LDS_PTR_OFF + 8 * k);
    unsigned lo = q[0], hi = q[1]; lo = __builtin_amdgcn_readfirstlane(lo); hi = __builtin_amdgcn_readfirstlane(hi); return (const float*)(((unsigned long long)hi << 32) | lo); }
#define INP(k) in_ptr(F, k)
__device__ __forceinline__ float wave_sum_dpp(float v) {
    int x = __builtin_bit_cast(int, v);
#define DPP_ADD(ctrl, rmask) x = __builtin_bit_cast(int, __builtin_bit_cast(float, x) + __builtin_bit_cast(float, __builtin_amdgcn_update_dpp(0, x, ctrl, rmask, 0xF, false)))
    DPP_ADD(0xB1, 0xF);
    DPP_ADD(0x4E, 0xF);
    DPP_ADD(0x141, 0xF);
    DPP_ADD(0x140, 0xF);
    DPP_ADD(0x142, 0xA);
    DPP_ADD(0x143, 0xC);
#undef DPP_ADD
    return __builtin_bit_cast(float, __builtin_amdgcn_readlane(x, 63));
}
__device__ __forceinline__ float wave_sum(float v) {
#pragma unroll
    for (int o = 32; o >= 1; o >>= 1) v += __shfl_xor(v, o);
    return v;
}

__device__ __forceinline__ void p0_mod(const Frame& F) {
    const int tid = opaque_tid(), lane = tid & 63, wave = __builtin_amdgcn_readfirstlane(tid >> 6); (void)lane; (void)wave;
    LAS float* sc = (LAS float*)F.lds;
    LAS float* red = (LAS float*)(F.lds + 20480);
    for (int i = tid; i < 5 * 1024; i += 512) { const int r = i >> 10, k = i & 1023; const float v = r < 4 ? INP(1)[r * 1024 + k] : INP(3)[k]; sc[i] = v / (1.f + expf(-v)); }
    __syncthreads();
    float* MOD = WSP(float, O_MOD);
    for (int u = blockIdx.x; u < 2 * 96; u += gridDim.x) { const int l = u / 96, j = (u % 96) * 64 + lane;
        const float* w = INP(4) + (size_t)l * 1024 * 6144 + j; float a0 = 0.f, a1 = 0.f, a2 = 0.f, a3 = 0.f, a4 = 0.f;
#pragma unroll 8
        for (int kk = 0; kk < 128; ++kk) { const int k = wave * 128 + kk; const float wv = w[(size_t)k * 6144]; a0 += sc[k] * wv; a1 += sc[1024 + k] * wv; a2 += sc[2048 + k] * wv; a3 += sc[3072 + k] * wv; a4 += sc[4096 + k] * wv; }
        red[(wave * 5 + 0) * 64 + lane] = a0; red[(wave * 5 + 1) * 64 + lane] = a1; red[(wave * 5 + 2) * 64 + lane] = a2; red[(wave * 5 + 3) * 64 + lane] = a3; red[(wave * 5 + 4) * 64 + lane] = a4;
        __syncthreads();
        if (tid < 320) { const int r = tid >> 6, ln = tid & 63; float s = 0.f;
#pragma unroll
            for (int w8 = 0; w8 < 8; ++w8) s += red[(w8 * 5 + r) * 64 + ln];
            const int jj = (u % 96) * 64 + ln; MOD[(size_t)(l * 5 + r) * 6144 + jj] = s + INP(5)[l * 6144 + jj]; }
        __syncthreads();
    }
}
__device__ __forceinline__ void p0_tables(const Frame& F) {
    const int tid = opaque_tid(), lane = tid & 63, wave = __builtin_amdgcn_readfirstlane(tid >> 6); (void)lane; (void)wave;
    float* ropa_c = WSP(float, O_ROPA_C); float* ropa_s = WSP(float, O_ROPA_S); float* ropc_c = WSP(float, O_ROPC_C); float* ropc_s = WSP(float, O_ROPC_S); float* LB = WSP(float, O_LB);
    for (int i = blockIdx.x * 512 + tid; i < 8192 * 32; i += gridDim.x * 512) {
        { const int t = i >> 5, j = i & 31, row = t >> 6, col = t & 63, f = j & 15; const float inv = powf(10000.f, -(float)f / 16.f); const float ang = (j < 16 ? (float)row : (float)col) * inv;
          ropa_c[i] = (float)cos((double)ang); ropa_s[i] = (float)sin((double)ang); }
        if (i < 8192 * 16) { const int t = i >> 4, j = i & 15, row = t >> 6, col = t & 63, f = j & 7; const float inv = powf(10000.f, -(float)f / 8.f); const float ang = (j < 8 ? (float)row : (float)col) * inv;
          ropc_c[i] = (float)cos((double)ang); ropc_s[i] = (float)sin((double)ang); }
        for (int i2 = i; i2 < 2 * 256 * 1024; i2 += 8192 * 32) { const int l = i2 >> 18, pp = (i2 >> 10) & 255, k = i2 & 1023;
          const int bj = pp >> 7, wc = (pp >> 5) & 3, n = (pp >> 4) & 1, fq = (pp >> 2) & 3, e = pp & 3; float v = 0.f;
          if (wc == 0) { if (bj == 0) v = INP(19)[(size_t)l * 1024 * 32 + k * 32 + fq * 8 + 4 * n + e]; else if (n == 0 && e == 0) v = INP(18)[(size_t)l * 1024 * 4 + k * 4 + fq]; }
          WSP(bf16_t, O_WRB)[i2] = f2bf(v); }
        if (i < 2048) { const int l = i >> 10, rest = i & 1023; if (l == 0) LB[i] = 0.f; else { const float a0 = INP(10)[rest], a1 = INP(10)[1024 + rest]; LB[i] = 1.f / (1.f + expf(a0 - a1)); } }
    }
}
template <class CM> __device__ __forceinline__ void wt_tile(const float* W, int ldw, const CM& cm, bf16_t* Bt, int K, int p0, int k0, LAS float* scr, int lane) {
    const int p4 = (lane & 7) * 4; const int c = cm(p0 + p4);
#pragma unroll
    for (int i = 0; i < 8; ++i) { const int kk = i * 8 + (lane >> 3); f32x4 v = (f32x4){0.f, 0.f, 0.f, 0.f};
        if (c >= 0) v = *(const f32x4*)(W + (size_t)(k0 + kk) * ldw + c);
        scr[kk * 33 + p4] = v[0]; scr[kk * 33 + p4 + 1] = v[1]; scr[kk * 33 + p4 + 2] = v[2]; scr[kk * 33 + p4 + 3] = v[3]; }
    asm volatile("s_waitcnt lgkmcnt(0)" ::: "memory"); __builtin_amdgcn_wave_barrier();
#pragma unroll 8
    for (int pi = 0; pi < 32; ++pi) Bt[(size_t)(p0 + pi) * K + k0 + lane] = f2bf(scr[lane * 33 + pi]);
    asm volatile("s_waitcnt lgkmcnt(0)" ::: "memory"); __builtin_amdgcn_wave_barrier();
}
struct CmWin { __device__ __forceinline__ int operator()(int p) const { return colmap(MAP_WIN, p); } };
struct CmId { __device__ __forceinline__ int operator()(int p) const { return p; } };
__device__ __forceinline__ void conv_weights_nonmoe(const Frame& F, int l) {
    const int tid = opaque_tid(), lane = tid & 63, wave = __builtin_amdgcn_readfirstlane(tid >> 6); (void)lane; (void)wave;
    LAS float* scr = (LAS float*)F.lds + wave * (64 * 33);
    const int gw = blockIdx.x * 8 + wave, NGW = gridDim.x * 8;
    constexpr int I_WIN = 216 * 16, I_BR = 3 * 32 * 8, I_OUT = 32 * 16;
    for (int it = gw; it < I_WIN + I_BR + I_OUT; it += NGW) {
        int r = it;
        if (r < I_WIN) { wt_tile(INP(8) + (size_t)l * 1024 * INW, INW, CmWin(), WSP(bf16_t, O_WINP), 1024, (r / 16) * 32, (r % 16) * 64, scr, lane); continue; } r -= I_WIN;
        if (r < I_BR) { const int n = r / 256, q = r % 256; wt_tile(INP(16) + ((size_t)l * 3 + n) * 512 * 1024, 1024, CmId(), WSP(bf16_t, O_WBR) + (size_t)n * 1024 * 512, 512, (q / 8) * 32, (q % 8) * 64, scr, lane); continue; } r -= I_BR;
        wt_tile(INP(17) + (size_t)l * 1024 * 1024, 1024, CmId(), WSP(bf16_t, O_WOUT), 1024, (r / 16) * 32, (r % 16) * 64, scr, lane);
    }
    const float* wuq = INP(14) + (size_t)l * 256 * 768; const float* wukv = INP(15) + (size_t)l * 128 * 1024; const float* gq = INP(12) + l * 256; const float* gkv = INP(13) + l * 128; bf16_t* WC = WSP(bf16_t, O_WC);
    for (int i = blockIdx.x * 512 + tid; i < 1792 * 384; i += gridDim.x * 512) {
        const int pp = i / 384, k = i % 384; float v = 0.f;
        if (pp < 768) { const int pn = pp >> 8, q = pp & 255, bj = q >> 7, wc = (q >> 5) & 3, j = q & 31; const int gi = pn * 8 + bj * 4 + wc, head = gi / 3, part = gi - head * 3;
            const int p = part < 2 ? head * 96 + part * 32 + j : head * 96 + 64 + 16 * ((j >> 2) & 1) + 4 * (j >> 3) + (j & 3);
            if (k < 256) v = wuq[k * 768 + p] * gq[k]; }
        else { if (k >= 256) v = wukv[(k - 256) * 1024 + (pp - 768)] * gkv[k - 256]; }
        WC[i] = f2bf(v); }
}
struct CmUp { __device__ __forceinline__ int operator()(int p) const { return ((p >> 8) << 7) + (p & 127); } };
__device__ __forceinline__ void conv_weights_moe(const Frame& F, int l) {
    const int tid = opaque_tid(), lane = tid & 63, wave = __builtin_amdgcn_readfirstlane(tid >> 6); (void)lane; (void)wave;
    LAS float* scr = (LAS float*)F.lds + wave * (64 * 33);
    const int gw = blockIdx.x * 8 + wave, NGW = gridDim.x * 8;
    constexpr int I_UP = 32 * 16 * 16, I_DN = 32 * 32 * 4;
    for (int it = gw; it < I_UP + I_DN; it += NGW) {
        int r = it;
        if (r < I_UP) { const int e = r / 256, q = r % 256, p0 = (q / 16) * 32, k0 = (q % 16) * 64; const bool isw3 = (p0 >> 7) & 1;
            const float* W = (isw3 ? INP(21) : INP(20)) + ((size_t)l * 32 + e) * 1024 * 256;
            wt_tile(W, 256, CmUp(), WSP(bf16_t, O_WUP) + (size_t)e * 512 * 1024, 1024, p0, k0, scr, lane); continue; } r -= I_UP;
        { const int e = r / 128, q = r % 128; wt_tile(INP(22) + ((size_t)l * 32 + e) * 256 * 1024, 1024, CmId(), WSP(bf16_t, O_WDN) + (size_t)e * 1024 * 256, 256, (q / 4) * 32, (q % 4) * 64, scr, lane); }
    }
}

__device__ __forceinline__ void rp_load(const float* xs, float* xd, bool wx, const bf16_t* ym, const float* gt, int lane, f32x4 (&v)[4], float& rinv) {
    float ss = 0.f;
#pragma unroll
    for (int j = 0; j < 4; ++j) { const int c = 4 * lane + 256 * j; v[j] = *(const f32x4*)(xs + c);
        if (ym) { const uint2 y0 = *(const uint2*)(ym + c), y1 = *(const uint2*)(ym + 1024 + c); const f32x4 g4 = *(const f32x4*)(gt + c);
            v[j][0] += g4[0] * (bflo(y0.x) + bflo(y1.x)); v[j][1] += g4[1] * (bfhi(y0.x) + bfhi(y1.x)); v[j][2] += g4[2] * (bflo(y0.y) + bflo(y1.y)); v[j][3] += g4[3] * (bfhi(y0.y) + bfhi(y1.y)); }
        if (wx) *(f32x4*)(xd + c) = v[j];
        ss += v[j][0] * v[j][0] + v[j][1] * v[j][1] + v[j][2] * v[j][2] + v[j][3] * v[j][3]; }
    rinv = rsqrtf(wave_sum(ss) * (1.f / D) + EPS);
}
__device__ __forceinline__ void rp_mod(const f32x4 (&v)[4], float rinv, const float* gn, const float* mo, int sh_off, int sc_off, bf16_t* hp, int lane, f32x4 (&hv)[4]) {
#pragma unroll
    for (int j = 0; j < 4; ++j) { const int c = 4 * lane + 256 * j; const f32x4 g4 = *(const f32x4*)(gn + c), s4 = *(const f32x4*)(mo + sc_off + c), h4 = *(const f32x4*)(mo + sh_off + c);
        hv[j] = v[j] * rinv * g4 * (s4 + 1.f) + h4;
        *(uint2*)(hp + c) = make_uint2(pkbf(hv[j][0], hv[j][1]), pkbf(hv[j][2], hv[j][3])); }
}
__device__ __forceinline__ void phase_rowpass1(const Frame& F, int l, bool combine, size_t h_off) {
    const int tid = opaque_tid(), lane = tid & 63, wave = __builtin_amdgcn_readfirstlane(tid >> 6); (void)lane; (void)wave;
    const int gw = blockIdx.x * 8 + wave, NGW = gridDim.x * 8;
    const float* xl = (l == 0) ? INP(0) : F.out; const float* xc = (l == 0) ? INP(2) : WSP(float, O_XC);
    const float* MODl = WSP(float, O_MOD) + (size_t)l * 5 * 6144; const float* MODp = WSP(float, O_MOD);
    for (int g = gw; g < G; g += NGW) { const RowInfo ri = rowinfo(g); const int mrow = ri.lat ? ri.b : 4; const size_t xo = xoff(ri);
        const float* xs = (ri.lat ? xl : xc) + xo; float* xd = (ri.lat ? F.out : WSP(float, O_XC)) + xo;
        f32x4 v[4], hv[4]; float rinv;
        rp_load(xs, xd, combine, combine ? WSP(bf16_t, O_YM2) + (size_t)g * 2048 : nullptr, MODp + (size_t)mrow * 6144 + 5120, lane, v, rinv);
        rp_mod(v, rinv, INP(6) + l * 1024, MODl + (size_t)mrow * 6144, 0, 1024, WSP(bf16_t, h_off) + (size_t)g * D, lane, hv); }
}
__device__ __forceinline__ void phase_rowpass2(const Frame& F, int l, bool last) {
    const int tid = opaque_tid(), lane = tid & 63, wave = __builtin_amdgcn_readfirstlane(tid >> 6);
    { int* perm = WSP(int, O_PERM); unsigned* goff = WSP(unsigned, O_GOFF);
      for (int i = blockIdx.x * 512 + tid; i < PMAX; i += gridDim.x * 512) { perm[i] = -1; goff[i] = 0u; } }
    const int gw = blockIdx.x * 8 + wave, NGW = gridDim.x * 8;
    const float* MODl = WSP(float, O_MOD) + (size_t)l * 5 * 6144;
    for (int g = gw; g < G; g += NGW) { const RowInfo ri = rowinfo(g); if (last && !ri.lat) continue;
        const int mrow = ri.lat ? ri.b : 4; const size_t xo = xoff(ri);
        const float* xs = (ri.lat ? F.out : WSP(float, O_XC)) + xo;
        f32x4 v[4], hv[4]; float rinv;
        rp_load(xs, nullptr, false, nullptr, nullptr, lane, v, rinv);
        rp_mod(v, rinv, INP(7) + l * 1024, MODl + (size_t)mrow * 6144, 3072, 4096, WSP(bf16_t, O_H) + (size_t)g * D, lane, hv); }
}
struct EpiRoute {
    static constexpr bool PERM = false;
    int* route_e; float* route_w; LAS int* hist;
    __device__ __forceinline__ void operator()(const f32x4 (&acc)[2][2][4][2], const gp::GUnit& u, int wr, int wc, int fr, int fq) const {
        if (wc != 0) return;
#pragma unroll
        for (int ai = 0; ai < 2; ++ai)
#pragma unroll
            for (int m = 0; m < 4; ++m) { const int row = u.pm * 256 + ai * 128 + wr * 64 + m * 16 + fr;
                float el[8];
#pragma unroll
                for (int e = 0; e < 4; ++e) { el[e] = acc[ai][0][m][0][e]; el[4 + e] = acc[ai][0][m][1][e]; }
                const float gl = acc[ai][1][m][0][0];
                int i0 = 0; float m0 = el[0];
#pragma unroll
                for (int j = 1; j < 8; ++j) if (el[j] > m0) { m0 = el[j]; i0 = j; }
                int i1 = -1; float m1 = -3.4e38f;
#pragma unroll
                for (int j = 0; j < 8; ++j) if (j != i0 && el[j] > m1) { m1 = el[j]; i1 = j; }
                float gmax = gl; int gidx = fq;
#pragma unroll
                for (int off = 16; off <= 32; off <<= 1) { const float og = __shfl_xor(gmax, off); const int oi = __shfl_xor(gidx, off); if (og > gmax || (og == gmax && oi < gidx)) { gmax = og; gidx = oi; } }
                float gs = expf(gl - gmax); gs += __shfl_xor(gs, 16); gs += __shfl_xor(gs, 32);
                if (fq == gidx) { const float gwt = 1.f / gs, p1 = expf(m1 - m0); const int e0 = fq * 8 + i0, e1 = fq * 8 + i1;
                    route_e[row * 2] = e0; route_e[row * 2 + 1] = e1; route_w[row * 2] = gwt / (1.f + p1); route_w[row * 2 + 1] = gwt * p1 / (1.f + p1);
                    __hip_atomic_fetch_add(hist + e0, 1, __ATOMIC_RELAXED, __HIP_MEMORY_SCOPE_WORKGROUP); __hip_atomic_fetch_add(hist + e1, 1, __ATOMIC_RELAXED, __HIP_MEMORY_SCOPE_WORKGROUP); } }
    }
};
__device__ __forceinline__ void phase_final(const Frame& F) {
    const int tid = opaque_tid(), lane = tid & 63, wave = __builtin_amdgcn_readfirstlane(tid >> 6); (void)lane; (void)wave;
    const int gw = blockIdx.x * 8 + wave, NGW = gridDim.x * 8; const float* MOD1 = WSP(float, O_MOD) + (size_t)5 * 6144;
    for (int lr = gw; lr < NB * SEQ; lr += NGW) { const int b = lr / SEQ, t = lr - b * SEQ; const int g = b * RPB + t; float* xp = F.out + (size_t)lr * D;
        f32x4 v[4]; float rinv; rp_load(xp, nullptr, false, WSP(bf16_t, O_YM2) + (size_t)g * 2048, MOD1 + (size_t)b * 6144 + 5120, lane, v, rinv);
#pragma unroll
        for (int j = 0; j < 4; ++j) { const int c = 4 * lane + 256 * j; const f32x4 g4 = *(const f32x4*)(INP(23) + c); *(f32x4*)(xp + c) = v[j] * rinv * g4; } }
}
__device__ __forceinline__ void phase_moe_scatter(const Frame& F, int l, bool last) {
    const int tid = opaque_tid(), lane = tid & 63, wave = __builtin_amdgcn_readfirstlane(tid >> 6);
    LAS int* tot = (LAS int*)F.lds; LAS int* bef = tot + 512; LAS int* base = tot + 1024; LAS int* lcur = tot + 1056;
    const int* WGH = WSP(int, O_WGH) + (size_t)l * 256 * 32; const int nwg = gridDim.x, me = blockIdx.x;
    { const int e = tid & 31, part = tid >> 5; int sa = 0, sb = 0;
      for (int w = part * 16; w < part * 16 + 16 && w < nwg; ++w) { const int c = WGH[w * 32 + e]; sa += c; if (w < me) sb += c; }
      tot[part * 32 + e] = sa; bef[part * 32 + e] = sb; }
    __syncthreads();
    int sa2 = 0, sb2 = 0;
    if (tid < 32) {
#pragma unroll
        for (int part = 0; part < 16; ++part) { sa2 += tot[part * 32 + tid]; sb2 += bef[part * 32 + tid]; } }
    __syncthreads();
    if (tid < 32) { tot[tid] = sa2; bef[tid] = sb2; lcur[tid] = 0; }
    __syncthreads();
    if (tid == 0) { int o = 0; int* tile_e = WSP(int, O_TILEE);
#pragma clang loop unroll(disable) vectorize(disable)
        for (int e = 0; e < 32; ++e) { base[e] = o + bef[e]; const int n = (tot[e] + 255) & ~255;
            if (me == 0) {
#pragma clang loop unroll(disable) vectorize(disable)
                for (int t = o >> 8; t < (o + n) >> 8; ++t) tile_e[t] = e; }
            o += n; }
        if (me == 0) tile_e[NTILE] = o >> 8; }
    __syncthreads();
    const int* route_e = WSP(int, O_ROUTE_E); const float* route_w = WSP(float, O_ROUTE_W); int* perm = WSP(int, O_PERM); float* posw = WSP(float, O_POSW); unsigned* goff = WSP(unsigned, O_GOFF);
    { int pmv, pn;
      if (gp::tile_order(0, (int)gridDim.x, (int)blockIdx.x, last ? 128 : 132, 1, pmv, pn)) { const int pm = last ? pmv + pmv / 32 : pmv; const int g = pm * 256 + (tid >> 1); const int i = g * 2 + (tid & 1);
          const int e = route_e[i]; const int pos = base[e] + __hip_atomic_fetch_add(lcur + e, 1, __ATOMIC_RELAXED, __HIP_MEMORY_SCOPE_WORKGROUP);
          perm[pos] = i; posw[pos] = route_w[i]; goff[pos] = (unsigned)g * 2048u; } }
    (void)lane; (void)wave;
}

#ifndef PROBE_DUP
#define PROBE_DUP 0
#endif
#ifndef PROBE_EXTRA_MASK
#define PROBE_EXTRA_MASK 0ull
#endif
#define DUP(bit) for (int rep_ = 0; rep_ < (((PROBE_DUP) >> (bit)) & 1) + 1; ++rep_)
__global__ void __launch_bounds__(512, 2) hybrid_trunk_fwd(KP p) {
    extern __shared__ __attribute__((aligned(16))) unsigned char dynlds[];
    Frame F; F.lds = (LAS char*)dynlds; F.ws = p.ws; F.out = p.out;
    if (threadIdx.x == 0) { LAS unsigned long long* pp = (LAS unsigned long long*)(F.lds + LDS_PTR_OFF);
        pp[0] = (unsigned long long)p.in[0];
        pp[1] = (unsigned long long)p.in[1];
        pp[2] = (unsigned long long)p.in[2];
        pp[3] = (unsigned long long)p.in[3];
        pp[4] = (unsigned long long)p.in[4];
        pp[5] = (unsigned long long)p.in[5];
        pp[6] = (unsigned long long)p.in[6];
        pp[7] = (unsigned long long)p.in[7];
        pp[8] = (unsigned long long)p.in[8];
        pp[9] = (unsigned long long)p.in[9];
        pp[10] = (unsigned long long)p.in[10];
        pp[11] = (unsigned long long)p.in[11];
        pp[12] = (unsigned long long)p.in[12];
        pp[13] = (unsigned long long)p.in[13];
        pp[14] = (unsigned long long)p.in[14];
        pp[15] = (unsigned long long)p.in[15];
        pp[16] = (unsigned long long)p.in[16];
        pp[17] = (unsigned long long)p.in[17];
        pp[18] = (unsigned long long)p.in[18];
        pp[19] = (unsigned long long)p.in[19];
        pp[20] = (unsigned long long)p.in[20];
        pp[21] = (unsigned long long)p.in[21];
        pp[22] = (unsigned long long)p.in[22];
        pp[23] = (unsigned long long)p.in[23];
    }
    LAS unsigned char* glds = (LAS unsigned char*)dynlds;
    volatile LAS unsigned* barst = (volatile LAS unsigned*)(F.lds + LDS_BAR_OFF);
    if (threadIdx.x < 16) ((LAS unsigned*)(F.lds + LDS_BAR_OFF))[threadIdx.x] = 0u;
    __syncthreads();
    const bool multi = (p.ph_hi - p.ph_lo) > 1;
    XcdBarrier bar; bar.bar = (unsigned*)F.ws; bar.x = 0; bar.st = nullptr;
    if (multi) bar = xcd_barrier_post((unsigned*)F.ws, barst);
    int ph = 0;
#define PH_BEGIN if (ph >= p.ph_lo && ph < p.ph_hi && (p.mask == 0ull || ((p.mask >> ph) & 1ull))) {
#define PH_END   if (ph + 1 < p.ph_hi) xcd_barrier(bar); else __syncthreads(); } ++ph;
    const int Gd = gridDim.x, cb = blockIdx.x;

    PH_BEGIN p0_mod(F); p0_tables(F); __syncthreads(); conv_weights_nonmoe(F, 0); PH_END

    for (int l = 0; l < 2; ++l) {
        const bool last = (l == 1);
        const float* MODl = WSP(float, O_MOD) + (size_t)l * 5 * 6144;
        PH_BEGIN phase_rowpass1(F, l, l > 0, O_H); PH_END
        PH_BEGIN
        { SchedStd S{}; S.A = WSP(bf16_t, O_H); S.Bt = WSP(bf16_t, O_WINP); S.K = 1024; S.nM = 132; S.nN = 15; S.G_ = Gd; S.c = cb; S.skipctx = 0; S.lda2 = 2048; S.ldb2 = 2048;
          EpiG1 E{}; E.AQ = WSP(bf16_t, O_AQ); E.AK = WSP(bf16_t, O_AK); E.AV = WSP(bf16_t, O_AV); E.BQ = WSP(bf16_t, O_BQ); E.BV = WSP(bf16_t, O_BV); E.BG = WSP(bf16_t, O_BG); E.BLF = WSP(f16_t, O_BLF); E.BLB = WSP(f16_t, O_BLB);
          E.CQKV = WSP(bf16_t, O_CQKV); E.CKR = WSP(bf16_t, O_CKR); E.RS = WSP(float, O_RS); E.ropa_c = WSP(float, O_ROPA_C); E.ropa_s = WSP(float, O_ROPA_S); E.ropc_c = WSP(float, O_ROPC_C); E.ropc_s = WSP(float, O_ROPC_S);
          E.LBl = WSP(float, O_LB) + l * 1024; E.rowoff = 0;
          DUP(0) gp::gemm_phase<EpiG1, SchedStd>(glds, S, E); }
        PH_END
        PH_BEGIN
        { SchedStd S{}; S.A = WSP(bf16_t, O_CQKV); S.Bt = WSP(bf16_t, O_WC); S.K = 384; S.nM = 132; S.nN = 7; S.G_ = Gd; S.c = cb; S.skipctx = 0; S.lda2 = 768; S.ldb2 = 768;
          EpiC E{}; E.CQ = WSP(bf16_t, O_CQ); E.CKV = WSP(bf16_t, O_CKV); E.RS = WSP(float, O_RS); E.ropc_c = WSP(float, O_ROPC_C); E.ropc_s = WSP(float, O_ROPC_S); E.pmoff = 0;
          DUP(1) gp::gemm_phase<EpiC, SchedStd>(glds, S, E); }
        __syncthreads();
        { AttnArgs a{}; a.Q = WSP(bf16_t, O_AQ); a.qld = 512; a.qhs = 64; a.K1 = WSP(bf16_t, O_AK); a.k1ld = 128; a.k1hs = 64; a.kvgroup = 4; a.K2 = nullptr; a.k2ld = 0; a.V = WSP(bf16_t, O_AV); a.vld = 128; a.vhs = 64;
          a.O = WSP(bf16_t, O_AQ); a.old = 512; a.ohs = 64; a.scale_l2 = 0.125f * LOG2E; a.sink = INP(9) + l * 8; a.window = 128;
          const int nqb = last ? 32 : 33;
          DUP(10) for (int u = cb; u < NB * 8 * nqb; u += Gd) { int b, h, qb; if (u < NB * 8 * 32) { b = u >> 8; h = u & 7; qb = (u >> 3) & 31; }     else { const int r_ = u - NB * 8 * 32; b = r_ >> 3; h = r_ & 7; qb = 32; }
              attn_unit<64>(F.lds, a, b, qb, h, ((PROBE_DUP >> 10) & 1) && rep_ == 0); } }
        __syncthreads();
        { ScanArgs a{}; a.BQ = WSP(bf16_t, O_BQ); a.BV = WSP(bf16_t, O_BV); a.BG = WSP(bf16_t, O_BG); a.BLF = WSP(f16_t, O_BLF); a.BLB = WSP(f16_t, O_BLB); a.ST = WSP(bf16_t, O_H); a.DS = WSP(float, O_DS); a.OB = WSP(bf16_t, O_BQ); a.gn = INP(11) + l * 512;
          DUP(2) for (int u = cb; u < NB * 8 * NCHK; u += Gd) { const int b = u / (8 * NCHK), rem = u - b * 8 * NCHK, h = rem / NCHK, k = rem - h * NCHK; scan_s1_unit(F.lds, a, b, h, k); } }
        PH_END
        PH_BEGIN
        { ScanArgs a{}; a.ST = WSP(bf16_t, O_H); a.DS = WSP(float, O_DS);
          for (int t = cb; t < NB * 8 * 2 * 4; t += Gd) scan_s2_task(a, t); }
        { AttnArgs a{}; a.Q = WSP(bf16_t, O_CQ); a.qld = 768; a.qhs = 96; a.K1 = WSP(bf16_t, O_CKV); a.k1ld = 1024; a.k1hs = 128; a.kvgroup = 1; a.K2 = WSP(bf16_t, O_CKR); a.k2ld = 32; a.V = WSP(bf16_t, O_CKV) + 64; a.vld = 1024; a.vhs = 128;
          a.O = WSP(bf16_t, O_OC); a.old = 512; a.ohs = 64; a.scale_l2 = 0.10206207261596577f * LOG2E; a.sink = nullptr; a.window = 0; a.pad = (PROBE_VARIANT && p.mask != 0ull) ? 1 : 0;
          const int nqb = last ? 32 : 33;
          DUP(3) for (int u = cb; u < NB * 8 * nqb; u += Gd) { int b, h, qb; if (u < NB * 8 * 32) { b = u >> 8; h = u & 7; qb = (u >> 3) & 31; }     else { const int r_ = u - NB * 8 * 32; b = r_ >> 3; h = r_ & 7; qb = 32; }
              attn_unit<96>(F.lds, a, b, qb, h); } }
        PH_END
        PH_BEGIN
        { ScanArgs a{}; a.BQ = WSP(bf16_t, O_BQ); a.BV = WSP(bf16_t, O_BV); a.BG = WSP(bf16_t, O_BG); a.BLF = WSP(f16_t, O_BLF); a.BLB = WSP(f16_t, O_BLB); a.ST = WSP(bf16_t, O_H); a.DS = WSP(float, O_DS); a.OB = WSP(bf16_t, O_BQ); a.gn = INP(11) + l * 512; a.skipctx_out = last ? 1 : 0;
          DUP(9) { a.pad = (((PROBE_DUP >> 9) & 1) && rep_ == 0) ? 1 : 0; for (int u = cb; u < NB * 8 * NCHK; u += Gd) { const int b = u / (8 * NCHK), rem = u - b * 8 * NCHK, h = rem / NCHK, k = rem - h * NCHK; scan_s3_unit(F.lds, a, b, h, k); } } }
        phase_rowpass1(F, l, false, O_CKV);
        PH_END
        PH_BEGIN
        { SchedStd S{}; S.A = WSP(bf16_t, O_CKV); S.Bt = WSP(bf16_t, O_WINP) + (size_t)3840 * 1024; S.K = 1024; S.nM = last ? 128 : 132; S.nN = 12; S.G_ = Gd; S.c = cb; S.skipctx = last ? 1 : 0; S.lda2 = 2048; S.ldb2 = 2048;
          EpiGate E{}; E.GATE = WSP(bf16_t, O_GATE); E.nstride = (long)G * 1024; E.ld = 1024;
          DUP(5) gp::gemm_phase<EpiGate, SchedStd>(glds, S, E); }
        PH_END
        PH_BEGIN
        { SchedMerge S{}; S.A0 = WSP(bf16_t, O_AQ); S.A1 = WSP(bf16_t, O_BQ); S.A2 = WSP(bf16_t, O_OC); S.Bt = WSP(bf16_t, O_WBR); S.nM = last ? 128 : 132; S.G_ = Gd; S.c = cb; S.skipctx = last ? 1 : 0; S.lda2 = 1024; S.ldb2 = 1024;
          EpiMerge E{}; E.GATE = WSP(bf16_t, O_GATE); E.nstride = (long)G * 1024; E.ld = 1024; E.Y = WSP(bf16_t, O_H);
          DUP(6) gp::gemm_phase<EpiMerge, SchedMerge>(glds, S, E); }
        PH_END
        PH_BEGIN
        { SchedStd S{}; S.A = WSP(bf16_t, O_H); S.Bt = WSP(bf16_t, O_WOUT); S.K = 1024; S.nM = last ? 128 : 132; S.nN = 4; S.G_ = Gd; S.c = cb; S.skipctx = last ? 1 : 0; S.lda2 = 2048; S.ldb2 = 2048;
          EpiOut E{}; E.xl_src = l == 0 ? INP(0) : F.out; E.xc_src = l == 0 ? INP(2) : WSP(float, O_XC); E.xl_dst = F.out; E.xc_dst = WSP(float, O_XC); E.mod = MODl; E.pmoff = 0;
          gp::gemm_phase<EpiOut, SchedStd>(glds, S, E); }
        PH_END
        PH_BEGIN phase_rowpass2(F, l, last); PH_END
        PH_BEGIN
        { LAS int* hist = (LAS int*)(F.lds + 131072); const int t_ = opaque_tid();
          if (t_ < 32) hist[t_] = 0;
          __syncthreads();
          SchedStd S{}; S.A = WSP(bf16_t, O_H); S.Bt = WSP(bf16_t, O_WRB) + (size_t)l * 256 * 1024; S.K = 1024; S.nM = last ? 128 : 132; S.nN = 1; S.G_ = Gd; S.c = cb; S.skipctx = last ? 1 : 0; S.lda2 = 2048; S.ldb2 = 2048;
          EpiRoute E{}; E.route_e = WSP(int, O_ROUTE_E); E.route_w = WSP(float, O_ROUTE_W); E.hist = hist;
          gp::gemm_phase<EpiRoute, SchedStd>(glds, S, E);
          __syncthreads();
          { const int t2_ = opaque_tid(); if (t2_ < 32) WSP(int, O_WGH)[((size_t)l * 256 + cb) * 32 + t2_] = hist[t2_]; }
          __syncthreads(); }
        conv_weights_moe(F, l); if (!last) conv_weights_nonmoe(F, l + 1);
        PH_END
        PH_BEGIN phase_moe_scatter(F, l, last); PH_END
        PH_BEGIN
        { SchedMoE<true> S{}; S.A = WSP(bf16_t, O_H); S.Bt = WSP(bf16_t, O_WUP); S.tile_e = WSP(int, O_TILEE); S.goff = WSP(unsigned, O_GOFF); S.K = 1024; S.nM = WSP(int, O_TILEE)[NTILE]; S.nN = 2; S.G_ = Gd; S.c = cb; S.lda2 = 2048; S.ldb2 = 2048; S.strideB = 512 * 1024;
          EpiUp E{}; E.AUP = WSP(bf16_t, O_AUP);
          DUP(7) gp::gemm_phase<EpiUp, SchedMoE<true>>(glds, S, E); }
        PH_END
        PH_BEGIN
        { SchedMoE<false> S{}; S.A = WSP(bf16_t, O_AUP); S.Bt = WSP(bf16_t, O_WDN); S.tile_e = WSP(int, O_TILEE); S.goff = nullptr; S.K = 256; S.nM = WSP(int, O_TILEE)[NTILE]; S.nN = 4; S.G_ = Gd; S.c = cb; S.lda2 = 512; S.ldb2 = 512; S.strideB = 1024 * 256;
          EpiDown E{}; E.YM2 = WSP(bf16_t, O_YM2); E.perm = WSP(int, O_PERM); E.posw = WSP(float, O_POSW);
          DUP(8) gp::gemm_phase<EpiDown, SchedMoE<false>>(glds, S, E); }
        PH_END
    }
    PH_BEGIN phase_final(F); PH_END
#undef PH_BEGIN
#undef PH_END
}
constexpr int N_PHASES = 1 + 2 * 13 + 1;
}

#ifndef MK_N_LAUNCHES
#define MK_N_LAUNCHES 1
#endif
extern "C" void kernel_launch(void* const* d_in, const int* in_sizes, int n_in, void* d_out, int out_size, void* d_ws, size_t ws_size, hipStream_t stream) {
    static int grid = 0;
    if (grid == 0) {
        if (ws_size < WS_END) { grid = -1; return; }
        int dev = 0, cus = 0;
        if (hipGetDevice(&dev) != hipSuccess || hipDeviceGetAttribute(&cus, hipDeviceAttributeMultiprocessorCount, dev) != hipSuccess) { grid = -1; return; }
        if (hipFuncSetAttribute((const void*)hybrid_trunk_fwd, hipFuncAttributeMaxDynamicSharedMemorySize, LDS_BYTES) != hipSuccess) { grid = -1; return; }
        int per_cu = 0; (void)hipOccupancyMaxActiveBlocksPerMultiprocessor(&per_cu, (const void*)hybrid_trunk_fwd, 512, LDS_BYTES); (void)hipGetLastError();
        grid = cus;
    }
    if (grid < 0) return;
    (void)hipMemsetAsync(d_ws, 0, CTL_ZERO_BYTES, stream);
    KP p{}; for (int i = 0; i < 24; ++i) p.in[i] = (const float*)d_in[i]; p.out = (float*)d_out; p.ws = (char*)d_ws;
    (void)in_sizes; (void)n_in; (void)out_size;
    if (MK_N_LAUNCHES == 1) { p.ph_lo = 0; p.ph_hi = N_PHASES; hipLaunchKernelGGL(hybrid_trunk_fwd, dim3(grid), dim3(512), LDS_BYTES, stream, p);
        if (PROBE_EXTRA_MASK) { (void)hipMemsetAsync(d_ws, 0, CTL_ZERO_BYTES, stream); p.mask = PROBE_EXTRA_MASK; hipLaunchKernelGGL(hybrid_trunk_fwd, dim3(grid), dim3(512), LDS_BYTES, stream, p); } }
    else { for (int k = 0; k < N_PHASES; ++k) { p.ph_lo = k; p.ph_hi = k + 1; hipLaunchKernelGGL(hybrid_trunk_fwd, dim3(grid), dim3(512), LDS_BYTES, stream, p); } }
}
```

```cpp
#include <hip/hip_runtime.h>
#include <stdint.h>
#include <math.h>

namespace {
typedef unsigned short bf16_t;
typedef _Float16 f16_t;
typedef short bf16x8 __attribute__((ext_vector_type(8)));
typedef short s16x4 __attribute__((ext_vector_type(4)));
typedef float f32x4 __attribute__((ext_vector_type(4)));
typedef float f32x16 __attribute__((ext_vector_type(16)));
typedef unsigned u32x4 __attribute__((ext_vector_type(4)));
#define LAS __attribute__((address_space(3)))

constexpr int D = 1024, NB = 4, SEQ = 8192, CTXL = 256, RPB = SEQ + CTXL, G = NB * RPB;
constexpr int INW = 6816, MIXW = 3744, GATEW = 3072;
constexpr float EPS = 1e-6f;
constexpr float LOG2E = 1.4426950408889634f;
constexpr int PMAX = 75776;
constexpr int NTILE = PMAX / 256;

__device__ __forceinline__ float bf2f(bf16_t v) { return __uint_as_float(((unsigned)v) << 16); }
__device__ __forceinline__ bf16_t f2bf(float f) { unsigned u = __float_as_uint(f); u += 0x7fffu + ((u >> 16) & 1u); return (bf16_t)(u >> 16); }
typedef float f32x2v __attribute__((ext_vector_type(2)));
typedef __bf16 bf16x2v __attribute__((ext_vector_type(2)));
__device__ __forceinline__ unsigned pkbf(float lo, float hi) { const f32x2v v = {lo, hi}; const bf16x2v b = __builtin_convertvector(v, bf16x2v); return __builtin_bit_cast(unsigned, b); }
__device__ __forceinline__ unsigned pk2(float lo, float hi) { return (unsigned)f2bf(lo) | ((unsigned)f2bf(hi) << 16); }
__device__ __forceinline__ float silu_f(float v) { return v / (1.f + expf(-v)); }
__device__ __forceinline__ float sigmoid_f(float v) { return 1.f / (1.f + expf(-v)); }
__device__ __forceinline__ int opaque_tid(int wv) { int t = (wv << 6) | (int)__builtin_amdgcn_mbcnt_hi(~0u, __builtin_amdgcn_mbcnt_lo(~0u, 0u)); asm volatile("" : "+v"(t)); return t; }
struct RowInfo { int b, r; bool lat; };
__device__ __forceinline__ RowInfo rowinfo(int g) { RowInfo ri; ri.b = g / RPB; ri.r = g - ri.b * RPB; ri.lat = ri.r < SEQ; return ri; }
__device__ __forceinline__ size_t xoff(const RowInfo& ri) { return ri.lat ? ((size_t)ri.b * SEQ + ri.r) * D : ((size_t)ri.b * CTXL + (ri.r - SEQ)) * D; }
__device__ __forceinline__ int crow(int r, int hi) { return (r & 3) + 8 * (r >> 2) + 4 * hi; }
__device__ __forceinline__ unsigned cvtpk(float lo, float hi) { return pkbf(lo, hi); }
typedef short v4i16_t __attribute__((ext_vector_type(4)));
__device__ __forceinline__ s16x4 vtr(const LAS char* p) { return __builtin_bit_cast(s16x4, __builtin_amdgcn_ds_read_tr16_b64_v4i16((LAS v4i16_t*)p)); }
#define MFMA32(a, b, c) __builtin_amdgcn_mfma_f32_32x32x16_bf16(a, b, c, 0, 0, 0)
#define VTR_ASM(dst, addr, off) asm volatile("ds_read_b64_tr_b16 %0, %1 offset:" #off : "=v"(dst) : "v"(addr))

#ifndef PROBE_VARIANT
#define PROBE_VARIANT 0
#endif
struct AttnArgs { const bf16_t* Q; int qld, qhs; const bf16_t* K1; int k1ld, k1hs, kvgroup; const bf16_t* K2; int k2ld; const bf16_t* V; int vld, vhs;
                  bf16_t* O; int old, ohs; float scale_l2; const float* sink; int window; int pad; };
template <int DQK>
__device__ __forceinline__ void attn_unit(LAS char* lds, const AttnArgs& p, int wv0, int b, int qb, int h, bool nostore = false) {
    constexpr int NS = DQK / 16, NCH = DQK / 8; constexpr float THR = 8.f;
    constexpr int KB = 0, VB = 49152, WSF = 81920;
    const int tid = opaque_tid(wv0), lane = tid & 63, r32 = lane & 31, hi = lane >> 5, wid = tid >> 6;
    const int rb = b * RPB;
    const bool ctxq = (qb == 32);
    const int q0 = rb + (ctxq ? SEQ : qb * 256);
    int lat_k0 = 0, lat_k1 = 0;
    if (!ctxq) { if (p.window) { lat_k0 = qb * 256 - 128; if (lat_k0 < 0) lat_k0 = 0; lat_k1 = qb * 256 + 384; if (lat_k1 > SEQ) lat_k1 = SEQ; } else { lat_k0 = 0; lat_k1 = SEQ; } }
    const int ntiles = 4 + (lat_k1 - lat_k0) / 64;
    const int qrow = q0 + wid * 32 + r32;
    const int qpos = qb * 256 + wid * 32 + r32;
    const int wq0 = qb * 256 + wid * 32;
    LAS float* wsf = (LAS float*)(lds + WSF) + wid * 64;
    bf16x8 qr[NS];
#pragma unroll
    for (int s = 0; s < NS; ++s) qr[s] = *(const bf16x8*)(p.Q + (size_t)qrow * p.qld + h * p.qhs + 16 * s + 8 * hi);
    const int k1off = (h / p.kvgroup) * p.k1hs, voff = (h / p.kvgroup) * p.vhs;
    const int wv = __builtin_amdgcn_readfirstlane(wid);
    const bool k2nd = (NCH > 8) && (wv < NCH - 8);
    const size_t ksrc0 = (size_t)lane * p.k1ld + k1off + wv * 8, ksrc1 = (size_t)lane * p.k2ld + wv * 8;
    const size_t vsrc = (size_t)(16 * (wv & 3) + (lane >> 2)) * p.vld + voff + (wv >> 2) * 32 + (lane & 3) * 8;
#define AT_ROW0(it_) (rb + ((it_) >= 4 ? lat_k0 + 64 * ((it_) - 4) : SEQ + 64 * (it_)))
#define AT_DMAK(it_, slot_) do { const size_t kr0_ = (size_t)AT_ROW0(it_); \
        __builtin_amdgcn_global_load_lds((const unsigned*)(p.K1 + kr0_ * p.k1ld + ksrc0), (LAS unsigned*)(lds + KB + (slot_) * 12288 + wv * 1024), 16, 0, 0); \
        if (k2nd) __builtin_amdgcn_global_load_lds((const unsigned*)(p.K2 + kr0_ * p.k2ld + ksrc1), (LAS unsigned*)(lds + KB + (slot_) * 12288 + (8 + wv) * 1024), 16, 0, 0); } while (0)
#define AT_DMAV(it_, slot_) do { const size_t kr0_ = (size_t)AT_ROW0(it_); \
        __builtin_amdgcn_global_load_lds((const unsigned*)(p.V + kr0_ * p.vld + vsrc), (LAS unsigned*)(lds + VB + (slot_) * 8192 + wv * 1024), 16, 0, 0); } while (0)
#define AT_CLAMP(x_) ((x_) < ntiles ? (x_) : ntiles - 1)
#define AT_WAITBAR() do { if (k2nd) asm volatile("s_waitcnt vmcnt(6) lgkmcnt(0)" ::: "memory"); else asm volatile("s_waitcnt vmcnt(4) lgkmcnt(0)" ::: "memory"); __builtin_amdgcn_s_barrier(); asm volatile("" ::: "memory"); } while (0)
#define AT_QK(C0, C1, slot_) do { const LAS char* ldsK_ = lds + KB + (slot_) * 12288 + hi * 1024 + r32 * 16; C0 = negm; C1 = negm; bf16x8 kf_[2 * NS]; \
        _Pragma("unroll") for (int s = 0; s < NS; ++s) { kf_[2 * s] = *(const LAS bf16x8*)(ldsK_ + s * 2048); kf_[2 * s + 1] = *(const LAS bf16x8*)(ldsK_ + s * 2048 + 512); } \
        __builtin_amdgcn_sched_group_barrier(0x100, 2 * NS, 0); \
        _Pragma("unroll") for (int s = 0; s < NS; ++s) { C0 = MFMA32(kf_[2 * s], qr[s], C0); C1 = MFMA32(kf_[2 * s + 1], qr[s], C1); } } while (0)
#define AT_REF(C0, C1, T_, first) do { const int tr_ = (T_); \
        if (p.window && tr_ >= 4) { const int kpos0 = lat_k0 + 64 * (tr_ - 4); \
            _Pragma("unroll") for (int r = 0; r < 16; ++r) { const int kp = kpos0 + crow(r, hi); int d0 = qpos - kp; if (d0 < 0) d0 = -d0; int d1 = qpos - (kp + 32); if (d1 < 0) d1 = -d1; \
                if (d0 > p.window) C0[r] = -1e30f; if (d1 > p.window) C1[r] = -1e30f; } } \
        if ((first) || (tr_ & 7) == 0) { \
        float mx = fmaxf(fmaxf(C0[0], C0[1]), C1[0]); \
        _Pragma("unroll") for (int r = 2; r < 16; r += 2) mx = fmaxf(fmaxf(mx, C0[r]), C0[r + 1]); \
        _Pragma("unroll") for (int r = 1; r < 15; r += 2) mx = fmaxf(fmaxf(mx, C1[r]), C1[r + 1]); \
        mx = fmaxf(mx, C1[15]); mx = fmaxf(mx, __shfl_xor(mx, 32)); \
        if ((first) || __any(mx > THR)) { const float dl = (first) ? mx : fmaxf(mx, 0.f); \
            m += dl; const float alpha = __builtin_amdgcn_exp2f(-dl); l *= alpha; \
            _Pragma("unroll") for (int r = 0; r < 16; ++r) { C0[r] -= dl; C1[r] -= dl; negm[r] = -m; } \
            if (hi == 0) wsf[r32] = alpha; \
            _Pragma("unroll") for (int r = 0; r < 16; ++r) { const float f = wsf[crow(r, hi)]; o0[r] *= f; o1[r] *= f; } } } } while (0)
    f32x16 o0, o1, negm, cA0, cA1, cB0, cB1;
#pragma unroll
    for (int r = 0; r < 16; ++r) { o0[r] = 0.f; o1[r] = 0.f; negm[r] = 0.f; }
    float m = 0.f, l = 0.f;
    const int vlane = ((lane >> 4) & 1) * 32 + (lane & 3) * 8 + (4 * hi + ((lane & 15) >> 2)) * 64;
    asm volatile("s_waitcnt vmcnt(0) lgkmcnt(0)" ::: "memory"); __builtin_amdgcn_s_barrier(); asm volatile("" ::: "memory");
    AT_DMAK(0, 0); AT_DMAV(0, 0); AT_DMAK(AT_CLAMP(1), 1); AT_DMAV(AT_CLAMP(1), 1); AT_DMAK(AT_CLAMP(2), 2); AT_DMAV(AT_CLAMP(2), 2); AT_DMAK(AT_CLAMP(3), 3);
    asm volatile("s_waitcnt vmcnt(0)" ::: "memory"); __builtin_amdgcn_s_barrier(); asm volatile("" ::: "memory");
    AT_QK(cA0, cA1, 0);
    AT_REF(cA0, cA1, 0, true);
    asm volatile("s_waitcnt lgkmcnt(0)" ::: "memory"); __builtin_amdgcn_s_barrier(); asm volatile("" ::: "memory");
#define AT_SB() __builtin_amdgcn_sched_barrier(0)
#define AT_STEP(C0, C1, N0, N1, T_) do { const int t_ = (T_); const int t1_ = t_ + 1 < ntiles ? t_ + 1 : ntiles - 1; \
        AT_DMAK(AT_CLAMP(t_ + 4), t_ & 3); AT_DMAV(AT_CLAMP(t_ + 3), (t_ + 3) & 3); \
        const LAS char* ldsK_ = lds + KB + ((t_ + 1) & 3) * 12288 + hi * 1024 + r32 * 16; const unsigned vaddr_ = (unsigned)(size_t)(lds + VB + (t_ & 3) * 8192 + vlane); \
        bf16x8 kfa0, kfa1, kfb0, kfb1, kfc0, kfc1; bf16x8 vf_[8]; s16x4 ta_[16]; float rs0 = 0.f, rs1 = 0.f, rs2 = 0.f, rs3 = 0.f; u32x4 pw[4]; \
        kfa0 = *(const LAS bf16x8*)(ldsK_); kfa1 = *(const LAS bf16x8*)(ldsK_ + 512); kfb0 = *(const LAS bf16x8*)(ldsK_ + 2048); kfb1 = *(const LAS bf16x8*)(ldsK_ + 2048 + 512); AT_SB(); \
        if constexpr (NS == 6) { \
          kfc0 = *(const LAS bf16x8*)(ldsK_ + 4096); kfc1 = *(const LAS bf16x8*)(ldsK_ + 4096 + 512); N0 = MFMA32(kfa0, qr[0], negm); N1 = MFMA32(kfa1, qr[0], negm); C0[0] = (PROBE_VARIANT == 1 && p.pad) ? C0[0] * 0.5f : __builtin_amdgcn_exp2f(C0[0]); C0[1] = (PROBE_VARIANT == 1 && p.pad) ? C0[1] * 0.5f : __builtin_amdgcn_exp2f(C0[1]); C0[2] = (PROBE_VARIANT == 1 && p.pad) ? C0[2] * 0.5f : __builtin_amdgcn_exp2f(C0[2]); C0[3] = (PROBE_VARIANT == 1 && p.pad) ? C0[3] * 0.5f : __builtin_amdgcn_exp2f(C0[3]); C0[4] = (PROBE_VARIANT == 1 && p.pad) ? C0[4] * 0.5f : __builtin_amdgcn_exp2f(C0[4]); C0[5] = (PROBE_VARIANT == 1 && p.pad) ? C0[5] * 0.5f : __builtin_amdgcn_exp2f(C0[5]);  VTR_ASM(ta_[0], vaddr_, 0); VTR_ASM(ta_[1], vaddr_, 512); VTR_ASM(ta_[2], vaddr_, 4096); AT_SB(); \
          kfa0 = *(const LAS bf16x8*)(ldsK_ + 6144); kfa1 = *(const LAS bf16x8*)(ldsK_ + 6144 + 512); N0 = MFMA32(kfb0, qr[1], N0); N1 = MFMA32(kfb1, qr[1], N1); C0[6] = (PROBE_VARIANT == 1 && p.pad) ? C0[6] * 0.5f : __builtin_amdgcn_exp2f(C0[6]); C0[7] = (PROBE_VARIANT == 1 && p.pad) ? C0[7] * 0.5f : __builtin_amdgcn_exp2f(C0[7]); C0[8] = (PROBE_VARIANT == 1 && p.pad) ? C0[8] * 0.5f : __builtin_amdgcn_exp2f(C0[8]); C0[9] = (PROBE_VARIANT == 1 && p.pad) ? C0[9] * 0.5f : __builtin_amdgcn_exp2f(C0[9]); C0[10] = (PROBE_VARIANT == 1 && p.pad) ? C0[10] * 0.5f : __builtin_amdgcn_exp2f(C0[10]); C0[11] = (PROBE_VARIANT == 1 && p.pad) ? C0[11] * 0.5f : __builtin_amdgcn_exp2f(C0[11]); rs0 += C0[0]; rs1 += C0[1]; rs2 += C0[2]; rs3 += C0[3]; rs0 += C0[4]; rs1 += C0[5]; VTR_ASM(ta_[3], vaddr_, 4608); VTR_ASM(ta_[4], vaddr_, 1024); VTR_ASM(ta_[5], vaddr_, 1536); AT_SB(); \
          kfb0 = *(const LAS bf16x8*)(ldsK_ + 8192); kfb1 = *(const LAS bf16x8*)(ldsK_ + 8192 + 512); N0 = MFMA32(kfc0, qr[2], N0); N1 = MFMA32(kfc1, qr[2], N1); C0[12] = (PROBE_VARIANT == 1 && p.pad) ? C0[12] * 0.5f : __builtin_amdgcn_exp2f(C0[12]); C0[13] = (PROBE_VARIANT == 1 && p.pad) ? C0[13] * 0.5f : __builtin_amdgcn_exp2f(C0[13]); C0[14] = (PROBE_VARIANT == 1 && p.pad) ? C0[14] * 0.5f : __builtin_amdgcn_exp2f(C0[14]); C0[15] = (PROBE_VARIANT == 1 && p.pad) ? C0[15] * 0.5f : __builtin_amdgcn_exp2f(C0[15]); C1[0] = (PROBE_VARIANT == 1 && p.pad) ? C1[0] * 0.5f : __builtin_amdgcn_exp2f(C1[0]); C1[1] = (PROBE_VARIANT == 1 && p.pad) ? C1[1] * 0.5f : __builtin_amdgcn_exp2f(C1[1]); rs2 += C0[6]; rs3 += C0[7]; rs0 += C0[8]; rs1 += C0[9]; rs2 += C0[10]; rs3 += C0[11]; VTR_ASM(ta_[6], vaddr_, 5120); VTR_ASM(ta_[7], vaddr_, 5632); VTR_ASM(ta_[8], vaddr_, 2048); AT_SB(); \
          kfc0 = *(const LAS bf16x8*)(ldsK_ + 10240); kfc1 = *(const LAS bf16x8*)(ldsK_ + 10240 + 512); N0 = MFMA32(kfa0, qr[3], N0); N1 = MFMA32(kfa1, qr[3], N1); C1[2] = (PROBE_VARIANT == 1 && p.pad) ? C1[2] * 0.5f : __builtin_amdgcn_exp2f(C1[2]); C1[3] = (PROBE_VARIANT == 1 && p.pad) ? C1[3] * 0.5f : __builtin_amdgcn_exp2f(C1[3]); C1[4] = (PROBE_VARIANT == 1 && p.pad) ? C1[4] * 0.5f : __builtin_amdgcn_exp2f(C1[4]); C1[5] = (PROBE_VARIANT == 1 && p.pad) ? C1[5] * 0.5f : __builtin_amdgcn_exp2f(C1[5]); C1[6] = (PROBE_VARIANT == 1 && p.pad) ? C1[6] * 0.5f : __builtin_amdgcn_exp2f(C1[6]); C1[7] = (PROBE_VARIANT == 1 && p.pad) ? C1[7] * 0.5f : __builtin_amdgcn_exp2f(C1[7]); rs0 += C0[12]; rs1 += C0[13]; rs2 += C0[14]; rs3 += C0[15]; rs0 += C1[0]; rs1 += C1[1]; VTR_ASM(ta_[9], vaddr_, 2560); VTR_ASM(ta_[10], vaddr_, 6144); VTR_ASM(ta_[11], vaddr_, 6656); AT_SB(); \
          N0 = MFMA32(kfb0, qr[4], N0); N1 = MFMA32(kfb1, qr[4], N1); C1[8] = (PROBE_VARIANT == 1 && p.pad) ? C1[8] * 0.5f : __builtin_amdgcn_exp2f(C1[8]); C1[9] = (PROBE_VARIANT == 1 && p.pad) ? C1[9] * 0.5f : __builtin_amdgcn_exp2f(C1[9]); C1[10] = (PROBE_VARIANT == 1 && p.pad) ? C1[10] * 0.5f : __builtin_amdgcn_exp2f(C1[10]); C1[11] = (PROBE_VARIANT == 1 && p.pad) ? C1[11] * 0.5f : __builtin_amdgcn_exp2f(C1[11]); rs2 += C1[2]; rs3 += C1[3]; rs0 += C1[4]; rs1 += C1[5]; rs2 += C1[6]; rs3 += C1[7]; VTR_ASM(ta_[12], vaddr_, 3072); VTR_ASM(ta_[13], vaddr_, 3584); AT_SB(); \
          N0 = MFMA32(kfc0, qr[5], N0); N1 = MFMA32(kfc1, qr[5], N1); C1[12] = (PROBE_VARIANT == 1 && p.pad) ? C1[12] * 0.5f : __builtin_amdgcn_exp2f(C1[12]); C1[13] = (PROBE_VARIANT == 1 && p.pad) ? C1[13] * 0.5f : __builtin_amdgcn_exp2f(C1[13]); C1[14] = (PROBE_VARIANT == 1 && p.pad) ? C1[14] * 0.5f : __builtin_amdgcn_exp2f(C1[14]); C1[15] = (PROBE_VARIANT == 1 && p.pad) ? C1[15] * 0.5f : __builtin_amdgcn_exp2f(C1[15]); rs0 += C1[8]; rs1 += C1[9]; rs2 += C1[10]; rs3 += C1[11]; VTR_ASM(ta_[14], vaddr_, 7168); VTR_ASM(ta_[15], vaddr_, 7680); AT_SB(); \
          rs0 += C1[12]; rs1 += C1[13]; rs2 += C1[14]; rs3 += C1[15]; \
        } \
        if constexpr (NS == 4) { \
          kfc0 = *(const LAS bf16x8*)(ldsK_ + 4096); kfc1 = *(const LAS bf16x8*)(ldsK_ + 4096 + 512); N0 = MFMA32(kfa0, qr[0], negm); N1 = MFMA32(kfa1, qr[0], negm); C0[0] = (PROBE_VARIANT == 1 && p.pad) ? C0[0] * 0.5f : __builtin_amdgcn_exp2f(C0[0]); C0[1] = (PROBE_VARIANT == 1 && p.pad) ? C0[1] * 0.5f : __builtin_amdgcn_exp2f(C0[1]); C0[2] = (PROBE_VARIANT == 1 && p.pad) ? C0[2] * 0.5f : __builtin_amdgcn_exp2f(C0[2]); C0[3] = (PROBE_VARIANT == 1 && p.pad) ? C0[3] * 0.5f : __builtin_amdgcn_exp2f(C0[3]); C0[4] = (PROBE_VARIANT == 1 && p.pad) ? C0[4] * 0.5f : __builtin_amdgcn_exp2f(C0[4]); C0[5] = (PROBE_VARIANT == 1 && p.pad) ? C0[5] * 0.5f : __builtin_amdgcn_exp2f(C0[5]); C0[6] = (PROBE_VARIANT == 1 && p.pad) ? C0[6] * 0.5f : __builtin_amdgcn_exp2f(C0[6]); C0[7] = (PROBE_VARIANT == 1 && p.pad) ? C0[7] * 0.5f : __builtin_amdgcn_exp2f(C0[7]);  VTR_ASM(ta_[0], vaddr_, 0); VTR_ASM(ta_[1], vaddr_, 512); VTR_ASM(ta_[2], vaddr_, 4096); VTR_ASM(ta_[3], vaddr_, 4608); AT_SB(); \
          kfa0 = *(const LAS bf16x8*)(ldsK_ + 6144); kfa1 = *(const LAS bf16x8*)(ldsK_ + 6144 + 512); N0 = MFMA32(kfb0, qr[1], N0); N1 = MFMA32(kfb1, qr[1], N1); C0[8] = (PROBE_VARIANT == 1 && p.pad) ? C0[8] * 0.5f : __builtin_amdgcn_exp2f(C0[8]); C0[9] = (PROBE_VARIANT == 1 && p.pad) ? C0[9] * 0.5f : __builtin_amdgcn_exp2f(C0[9]); C0[10] = (PROBE_VARIANT == 1 && p.pad) ? C0[10] * 0.5f : __builtin_amdgcn_exp2f(C0[10]); C0[11] = (PROBE_VARIANT == 1 && p.pad) ? C0[11] * 0.5f : __builtin_amdgcn_exp2f(C0[11]); C0[12] = (PROBE_VARIANT == 1 && p.pad) ? C0[12] * 0.5f : __builtin_amdgcn_exp2f(C0[12]); C0[13] = (PROBE_VARIANT == 1 && p.pad) ? C0[13] * 0.5f : __builtin_amdgcn_exp2f(C0[13]); C0[14] = (PROBE_VARIANT == 1 && p.pad) ? C0[14] * 0.5f : __builtin_amdgcn_exp2f(C0[14]); C0[15] = (PROBE_VARIANT == 1 && p.pad) ? C0[15] * 0.5f : __builtin_amdgcn_exp2f(C0[15]); rs0 += C0[0]; rs1 += C0[1]; rs2 += C0[2]; rs3 += C0[3]; rs0 += C0[4]; rs1 += C0[5]; rs2 += C0[6]; rs3 += C0[7]; VTR_ASM(ta_[4], vaddr_, 1024); VTR_ASM(ta_[5], vaddr_, 1536); VTR_ASM(ta_[6], vaddr_, 5120); VTR_ASM(ta_[7], vaddr_, 5632); AT_SB(); \
          N0 = MFMA32(kfc0, qr[2], N0); N1 = MFMA32(kfc1, qr[2], N1); C1[0] = (PROBE_VARIANT == 1 && p.pad) ? C1[0] * 0.5f : __builtin_amdgcn_exp2f(C1[0]); C1[1] = (PROBE_VARIANT == 1 && p.pad) ? C1[1] * 0.5f : __builtin_amdgcn_exp2f(C1[1]); C1[2] = (PROBE_VARIANT == 1 && p.pad) ? C1[2] * 0.5f : __builtin_amdgcn_exp2f(C1[2]); C1[3] = (PROBE_VARIANT == 1 && p.pad) ? C1[3] * 0.5f : __builtin_amdgcn_exp2f(C1[3]); C1[4] = (PROBE_VARIANT == 1 && p.pad) ? C1[4] * 0.5f : __builtin_amdgcn_exp2f(C1[4]); C1[5] = (PROBE_VARIANT == 1 && p.pad) ? C1[5] * 0.5f : __builtin_amdgcn_exp2f(C1[5]); C1[6] = (PROBE_VARIANT == 1 && p.pad) ? C1[6] * 0.5f : __builtin_amdgcn_exp2f(C1[6]); C1[7] = (PROBE_VARIANT == 1 && p.pad) ? C1[7] * 0.5f : __builtin_amdgcn_exp2f(C1[7]); rs0 += C0[8]; rs1 += C0[9]; rs2 += C0[10]; rs3 += C0[11]; rs0 += C0[12]; rs1 += C0[13]; rs2 += C0[14]; rs3 += C0[15]; VTR_ASM(ta_[8], vaddr_, 2048); VTR_ASM(ta_[9], vaddr_, 2560); VTR_ASM(ta_[10], vaddr_, 6144); VTR_ASM(ta_[11], vaddr_, 6656); AT_SB(); \
          N0 = MFMA32(kfa0, qr[3], N0); N1 = MFMA32(kfa1, qr[3], N1); C1[8] = (PROBE_VARIANT == 1 && p.pad) ? C1[8] * 0.5f : __builtin_amdgcn_exp2f(C1[8]); C1[9] = (PROBE_VARIANT == 1 && p.pad) ? C1[9] * 0.5f : __builtin_amdgcn_exp2f(C1[9]); C1[10] = (PROBE_VARIANT == 1 && p.pad) ? C1[10] * 0.5f : __builtin_amdgcn_exp2f(C1[10]); C1[11] = (PROBE_VARIANT == 1 && p.pad) ? C1[11] * 0.5f : __builtin_amdgcn_exp2f(C1[11]); C1[12] = (PROBE_VARIANT == 1 && p.pad) ? C1[12] * 0.5f : __builtin_amdgcn_exp2f(C1[12]); C1[13] = (PROBE_VARIANT == 1 && p.pad) ? C1[13] * 0.5f : __builtin_amdgcn_exp2f(C1[13]); C1[14] = (PROBE_VARIANT == 1 && p.pad) ? C1[14] * 0.5f : __builtin_amdgcn_exp2f(C1[14]); C1[15] = (PROBE_VARIANT == 1 && p.pad) ? C1[15] * 0.5f : __builtin_amdgcn_exp2f(C1[15]); rs0 += C1[0]; rs1 += C1[1]; rs2 += C1[2]; rs3 += C1[3]; rs0 += C1[4]; rs1 += C1[5]; rs2 += C1[6]; rs3 += C1[7]; VTR_ASM(ta_[12], vaddr_, 3072); VTR_ASM(ta_[13], vaddr_, 3584); VTR_ASM(ta_[14], vaddr_, 7168); VTR_ASM(ta_[15], vaddr_, 7680); AT_SB(); \
          rs0 += C1[8]; rs1 += C1[9]; rs2 += C1[10]; rs3 += C1[11]; rs0 += C1[12]; rs1 += C1[13]; rs2 += C1[14]; rs3 += C1[15]; \
        } \
        l += (rs0 + rs1) + (rs2 + rs3); \
        asm volatile("s_waitcnt lgkmcnt(0)" ::: "memory"); AT_SB(); \
        _Pragma("unroll") for (int s = 0; s < 4; ++s) { vf_[2 * s] = (bf16x8){ta_[4 * s][0], ta_[4 * s][1], ta_[4 * s][2], ta_[4 * s][3], ta_[4 * s + 1][0], ta_[4 * s + 1][1], ta_[4 * s + 1][2], ta_[4 * s + 1][3]}; vf_[2 * s + 1] = (bf16x8){ta_[4 * s + 2][0], ta_[4 * s + 2][1], ta_[4 * s + 2][2], ta_[4 * s + 2][3], ta_[4 * s + 3][0], ta_[4 * s + 3][1], ta_[4 * s + 3][2], ta_[4 * s + 3][3]}; } \
        pw[0] = (u32x4){cvtpk(C0[0], C0[1]), cvtpk(C0[2], C0[3]), cvtpk(C0[4], C0[5]), cvtpk(C0[6], C0[7])}; pw[1] = (u32x4){cvtpk(C0[8], C0[9]), cvtpk(C0[10], C0[11]), cvtpk(C0[12], C0[13]), cvtpk(C0[14], C0[15])}; AT_SB(); \
        if (!(PROBE_VARIANT == 2 && p.pad)) { o0 = MFMA32(__builtin_bit_cast(bf16x8, pw[0]), vf_[0], o0); o1 = MFMA32(__builtin_bit_cast(bf16x8, pw[0]), vf_[1], o1); pw[2] = (u32x4){cvtpk(C1[0], C1[1]), cvtpk(C1[2], C1[3]), cvtpk(C1[4], C1[5]), cvtpk(C1[6], C1[7])}; AT_SB(); \
        o0 = MFMA32(__builtin_bit_cast(bf16x8, pw[1]), vf_[2], o0); o1 = MFMA32(__builtin_bit_cast(bf16x8, pw[1]), vf_[3], o1); pw[3] = (u32x4){cvtpk(C1[8], C1[9]), cvtpk(C1[10], C1[11]), cvtpk(C1[12], C1[13]), cvtpk(C1[14], C1[15])}; AT_SB(); \
        o0 = MFMA32(__builtin_bit_cast(bf16x8, pw[2]), vf_[4], o0); o1 = MFMA32(__builtin_bit_cast(bf16x8, pw[2]), vf_[5], o1); AT_SB(); \
        o0 = MFMA32(__builtin_bit_cast(bf16x8, pw[3]), vf_[6], o0); o1 = MFMA32(__builtin_bit_cast(bf16x8, pw[3]), vf_[7], o1); AT_SB(); } \
        AT_WAITBAR(); \
        if (t_ + 1 < ntiles) AT_REF(N0, N1, t1_, false); } while (0)
    for (int it = 0; it < ntiles; it += 2) {
        AT_STEP(cA0, cA1, cB0, cB1, it);
        AT_STEP(cB0, cB1, cA0, cA1, it + 1);
    }
#undef AT_ROW0
#undef AT_DMAK
#undef AT_DMAV
#undef AT_CLAMP
#undef AT_WAITBAR
#undef AT_REF
#undef AT_SB
#undef AT_QK
#undef AT_STEP
    float lt = l + __shfl_xor(l, 32);
    float fin = 1.f;
    if (p.sink) { const float sk = p.sink[h] * LOG2E; const float m2 = fmaxf(m, sk); fin = __builtin_amdgcn_exp2f(m - m2); lt = lt * fin + __builtin_amdgcn_exp2f(sk - m2); }
    const float sc = fin / lt;
    if (hi == 0) wsf[r32] = sc;
    bf16_t* Ob = p.O + (size_t)(q0 + wid * 32) * p.old + h * p.ohs + r32;
#pragma unroll
    for (int r = 0; r < 16; ++r) { const int qr_ = crow(r, hi); const float f = wsf[qr_];
        if (!nostore) { Ob[(size_t)qr_ * p.old] = f2bf(o0[r] * f); Ob[(size_t)qr_ * p.old + 32] = f2bf(o1[r] * f); } }
}

namespace gp {
constexpr int BM = 256, BK = 64, HALF = 128, HTB = HALF * BK * 2, STAGE_BYTES = 8 * HTB, NXCD = 8, WGM = 8;
__host__ __device__ __forceinline__ int lds_byte(int r, int c) { const int st = (r >> 4) * 2 + (c >> 5), rr = r & 15, cc = c & 31, ob = rr * 64 + cc * 2; return st * 1024 + (ob ^ (((ob >> 9) & 1) << 5)); }
__host__ __device__ __forceinline__ void stage_rc(int b, int& R, int& C) { const int st = b / 1024, sb = b % 1024, swz = sb ^ (((sb >> 9) & 1) << 5); R = (st >> 1) * 16 + swz / 64; C = (st & 1) * 32 + (swz % 64) / 2; }
__host__ __device__ __forceinline__ int perm32(int rho) { const int n = rho >> 4, i = rho & 15; return 8 * (i >> 2) + 4 * n + (i & 3); }

struct GUnit { const char* A; const char* B; int nt, pm, pn, tag; const unsigned* goff; };

__device__ __forceinline__ bool tile_order(int i, int G_, int c, int nM, int nN, int& pm, int& pn) {
    const int nwg = nM * nN; const long L = (long)i * G_ + c; if (L >= nwg) return false;
    int wgid = (int)L; { const int q = nwg / NXCD, r = nwg % NXCD, xcd = wgid % NXCD, off = wgid / NXCD; wgid = (xcd < r ? xcd * (q + 1) : r * (q + 1) + (xcd - r) * q) + off; }
    const int nig = WGM * nN, gid = wgid / nig, fm = gid * WGM, gsz = (nM - fm) < WGM ? (nM - fm) : WGM;
    pm = fm + ((wgid % nig) % gsz); pn = (wgid % nig) / gsz; return true;
}
__device__ __forceinline__ unsigned cvt_pk_bf16(float lo, float hi) { return pkbf(lo, hi); }

template <class Epi, class Sched>
__device__ __forceinline__ void gemm_phase(LAS unsigned char* lds, const Sched& S, const Epi& E, int wv0) {
    constexpr bool GATHER = Sched::GATHER;
    const int tid = opaque_tid(wv0), wid = __builtin_amdgcn_readfirstlane(tid >> 6), lane = tid & 63, wr = wid >> 2, wc = wid & 3, fr = lane & 15, fq = lane >> 4;
    const int lda2 = S.lda2, ldb2 = S.ldb2;
    unsigned voffA[2], voffB[2], rowA[2];
#pragma unroll
    for (int i = 0; i < 2; ++i) { int R, C; stage_rc(tid * 16 + i * 8192, R, C); const int Rb = Epi::PERM ? ((R & ~31) + perm32(R & 31)) : R;
        voffA[i] = GATHER ? (unsigned)C * 2u : (unsigned)R * (unsigned)lda2 + (unsigned)C * 2u; rowA[i] = (unsigned)R; voffB[i] = (unsigned)Rb * (unsigned)ldb2 + (unsigned)C * 2u; }
    const size_t hA = GATHER ? 0 : (size_t)HALF * lda2, hB = (size_t)HALF * ldb2;
    const unsigned ldsw = (unsigned)wid * 1024u;
    const int aoff = lds_byte(wr * 64 + fr, fq * 8), boff = lds_byte(wc * 32 + fr, fq * 8);
    constexpr size_t kstep = (size_t)(BK * 2);
#define GP_SA(b, h) (((b) * 2 + (h)) * HTB)
#define GP_SB(b, h) ((4 + (b) * 2 + (h)) * HTB)
#define GP_STAGE(bufoff, gbase, v0, v1) do { \
        __builtin_amdgcn_global_load_lds((const unsigned*)((const char*)(gbase) + (v0)), (LAS unsigned*)(lds + (bufoff) + ldsw), 16, 0, 0); \
        __builtin_amdgcn_global_load_lds((const unsigned*)((const char*)(gbase) + (v1)), (LAS unsigned*)(lds + (bufoff) + ldsw + 8192), 16, 0, 0); } while (0)
#define GP_LDA(dst, b, h) do { _Pragma("unroll") for (int m = 0; m < 4; ++m) _Pragma("unroll") for (int k = 0; k < 2; ++k) dst[m][k] = *(const LAS bf16x8*)(lds + GP_SA(b, h) + aoff + m * 2048 + k * 1024); } while (0)
#define GP_LDB(dst, b, h) do { _Pragma("unroll") for (int n = 0; n < 2; ++n) _Pragma("unroll") for (int k = 0; k < 2; ++k) dst[n][k] = *(const LAS bf16x8*)(lds + GP_SB(b, h) + boff + n * 2048 + k * 1024); } while (0)
#define GP_MMA(ai, bj, At, Bt) do { __builtin_amdgcn_s_setprio(1); _Pragma("unroll") for (int m = 0; m < 4; ++m) _Pragma("unroll") for (int n = 0; n < 2; ++n) _Pragma("unroll") for (int k = 0; k < 2; ++k) \
        acc[ai][bj][m][n] = __builtin_amdgcn_mfma_f32_16x16x32_bf16(Bt[n][k], At[m][k], acc[ai][bj][m][n], 0, 0, 0); __builtin_amdgcn_s_setprio(0); } while (0)
#define GP_WAIT_V(n) asm volatile("s_waitcnt vmcnt(" #n ")" ::: "memory")
#define GP_WAIT_L(n) asm volatile("s_waitcnt lgkmcnt(" #n ")" ::: "memory")
#define GP_BAR __builtin_amdgcn_s_barrier()
#define GP_SCHED __builtin_amdgcn_sched_barrier(0)
#define GP_GOFF(U, o0, o1, p0, p1) do { if (GATHER) { o0 = (U).goff[rowA[0]] + voffA[0]; o1 = (U).goff[rowA[1]] + voffA[1]; p0 = (U).goff[128 + rowA[0]] + voffA[0]; p1 = (U).goff[128 + rowA[1]] + voffA[1]; } \
        else { o0 = voffA[0]; o1 = voffA[1]; p0 = voffA[0]; p1 = voffA[1]; } } while (0)
    GUnit cur, nxt; int ui = 0;
    if (!S.next(0, cur)) return;
    f32x4 acc[2][2][4][2];
#pragma unroll
    for (int a = 0; a < 2; ++a)
#pragma unroll
        for (int b = 0; b < 2; ++b)
#pragma unroll
            for (int m = 0; m < 4; ++m)
#pragma unroll
                for (int n = 0; n < 2; ++n) acc[a][b][m][n] = (f32x4){0.f, 0.f, 0.f, 0.f};
    bf16x8 At[4][2], B0[2][2], B1[2][2];
    unsigned g00, g01, g10, g11;
    GP_GOFF(cur, g00, g01, g10, g11);
    const char* cA = cur.A; const char* cB = cur.B;
    GP_STAGE(GP_SB(0, 0), cB, voffB[0], voffB[1]); GP_STAGE(GP_SA(0, 0), cA, g00, g01); GP_STAGE(GP_SB(0, 1), cB + hB, voffB[0], voffB[1]); GP_STAGE(GP_SA(0, 1), cA + hA, g10, g11);
    if (wr == 1) GP_BAR;
    GP_WAIT_V(4); GP_BAR;
    GP_STAGE(GP_SB(1, 0), cB + kstep, voffB[0], voffB[1]); GP_STAGE(GP_SA(1, 0), cA + kstep, g00, g01); GP_STAGE(GP_SB(1, 1), cB + hB + kstep, voffB[0], voffB[1]);
    GP_WAIT_V(6); GP_BAR;
    for (;;) {
        const bool has_next = S.next(ui + 1, nxt);
        const char* nA = has_next ? nxt.A : cA; const char* nB = has_next ? nxt.B : cB;
        const int nt = cur.nt;
        for (int t = 0; t < nt; t += 2) {
            const bool last = (t == nt - 2);
            const char* a1 = cA + (size_t)(t + 1) * kstep;
            const char* a2 = last ? nA : cA + (size_t)(t + 2) * kstep; const char* b2 = last ? nB : cB + (size_t)(t + 2) * kstep;
            const char* a3 = a2 + kstep; const char* b3 = b2 + kstep;
            unsigned w00 = g00, w01 = g01, w10 = g10, w11 = g11;
            if (GATHER && last && has_next) { GP_GOFF(nxt, w00, w01, w10, w11); }
            GP_LDB(B0, 0, 0); GP_SCHED; GP_LDA(At, 0, 0); GP_STAGE(GP_SA(1, 1), a1 + hA, g10, g11);
            GP_WAIT_L(8); GP_BAR; GP_WAIT_L(0); GP_MMA(0, 0, At, B0); GP_BAR; GP_SCHED;
            GP_LDB(B1, 0, 1); GP_STAGE(GP_SB(0, 0), b2, voffB[0], voffB[1]);
            GP_BAR; GP_WAIT_L(0); GP_MMA(0, 1, At, B1); GP_BAR;
            GP_LDA(At, 0, 1); GP_STAGE(GP_SA(0, 0), a2, w00, w01);
            GP_BAR; GP_WAIT_L(0); GP_MMA(1, 0, At, B0); GP_BAR; GP_SCHED;
            GP_STAGE(GP_SB(0, 1), b2 + hB, voffB[0], voffB[1]);
            GP_WAIT_V(6); GP_BAR; GP_MMA(1, 1, At, B1); GP_BAR;
            GP_LDB(B0, 1, 0); GP_SCHED; GP_LDA(At, 1, 0); GP_STAGE(GP_SA(0, 1), a2 + hA, w10, w11);
            GP_WAIT_L(8); GP_BAR; GP_WAIT_L(0); GP_MMA(0, 0, At, B0); GP_BAR; GP_SCHED;
            GP_LDB(B1, 1, 1); GP_STAGE(GP_SB(1, 0), b3, voffB[0], voffB[1]);
            GP_BAR; GP_WAIT_L(0); GP_MMA(0, 1, At, B1); GP_BAR;
            GP_LDA(At, 1, 1); GP_STAGE(GP_SA(1, 0), a3, w00, w01);
            GP_BAR; GP_WAIT_L(0); GP_MMA(1, 0, At, B0); GP_BAR; GP_SCHED;
            GP_STAGE(GP_SB(1, 1), b3 + hB, voffB[0], voffB[1]);
            GP_WAIT_V(6); GP_BAR; GP_MMA(1, 1, At, B1); GP_BAR;
            if (GATHER && last) { g00 = w00; g01 = w01; g10 = w10; g11 = w11; }
        }
        { int fr_e = fr, fq_e = fq; asm volatile("" : "+v"(fr_e), "+v"(fq_e));
          E(acc, cur, wr, wc, fr_e, fq_e); }
        if (!has_next) break;
#pragma unroll
        for (int a = 0; a < 2; ++a)
#pragma unroll
            for (int b = 0; b < 2; ++b)
#pragma unroll
                for (int m = 0; m < 4; ++m)
#pragma unroll
                    for (int n = 0; n < 2; ++n) acc[a][b][m][n] = (f32x4){0.f, 0.f, 0.f, 0.f};
        cur = nxt; cA = nA; cB = nB; ++ui;
    }
    GP_WAIT_V(0);
    if (wr == 0) GP_BAR;
    GP_BAR;
#undef GP_SA
#undef GP_SB
#undef GP_STAGE
#undef GP_LDA
#undef GP_LDB
#undef GP_MMA
#undef GP_WAIT_V
#undef GP_WAIT_L
#undef GP_BAR
#undef GP_SCHED
#undef GP_GOFF
}
}

struct SchedStd {
    static constexpr bool GATHER = false;
    const bf16_t* A; const bf16_t* Bt; int K, nM, nN, G_, c, skipctx, lda2, ldb2;
    __device__ __forceinline__ bool next(int i, gp::GUnit& u) const {
        int pmv, pn; if (!gp::tile_order(i, G_, c, nM, nN, pmv, pn)) return false;
        const int pm = skipctx ? pmv + pmv / 32 : pmv;
        u.A = (const char*)(A + (size_t)pm * 256 * K); u.B = (const char*)(Bt + (size_t)pn * 256 * K); u.nt = K / 64; u.pm = pm; u.pn = pn; u.tag = 0; u.goff = nullptr; return true;
    }
};

__device__ __forceinline__ float fexp(float x) { return __builtin_amdgcn_exp2f(x * LOG2E); }
__device__ __forceinline__ float flog(float x) { return __builtin_amdgcn_logf(x) * 0.6931471805599453f; }
__device__ __forceinline__ float fsigmoid(float x) { return __builtin_amdgcn_rcpf(1.f + fexp(-x)); }
__device__ __forceinline__ float logf_gate_fast(float z, float lb) {
    if (lb <= 0.f) return fminf(z, 0.f) - flog(1.f + fexp(-fabsf(z)));
    return flog(lb + (1.f - lb) * fsigmoid(z));
}
__device__ __forceinline__ unsigned pkh2(float lo, float hi) { const f16_t a = (f16_t)lo, b = (f16_t)hi; return (unsigned)__builtin_bit_cast(unsigned short, a) | ((unsigned)__builtin_bit_cast(unsigned short, b) << 16); }

template <class T> __device__ __forceinline__ T* opq(T* p) { asm volatile("" : "+s"(p)); return p; }
struct EpiG1 {
    static constexpr bool PERM = true;
    bf16_t *AQ, *AK, *AV, *BQ, *BV, *BG; f16_t *BLF, *BLB; bf16_t *CQKV, *CKR; float* RS; const float *ropa_c, *ropa_s, *ropc_c, *ropc_s; const float* LBl; int rowoff;
    __device__ __forceinline__ void operator()(const f32x4 (&acc)[2][2][4][2], const gp::GUnit& u, int wr, int wc, int fr, int fq) const {
        const int pn = u.pn; const int pr = u.pm % 33; const bool lat = pr < 32;
        const int grow0 = u.pm * 256 + wr * 64 + fr; const int t0 = pr * 256 + wr * 64 + fr;
        if (pn < 3) {
            const int hh = pn * 4 + wc; bf16_t* dst; int ld, coff; bf16_t* const aq_ = opq(AQ); bf16_t* const ak_ = opq(AK); bf16_t* const av_ = opq(AV);
            if (hh < 8) { dst = aq_; ld = 512; coff = hh * 64; } else if (hh < 10) { dst = ak_; ld = 128; coff = (hh - 8) * 64; } else { dst = av_; ld = 128; coff = (hh - 10) * 64; }
            const bool rope = lat && hh < 10;
#pragma unroll
            for (int ai = 0; ai < 2; ++ai)
#pragma unroll
                for (int m = 0; m < 4; ++m) { const int grow = grow0 + ai * 128 + m * 16, t = t0 + ai * 128 + m * 16; const size_t row = (size_t)(grow - rowoff);
                    f32x4 x1a = acc[ai][0][m][0], x1b = acc[ai][0][m][1], x2a = acc[ai][1][m][0], x2b = acc[ai][1][m][1];
                    if (rope) { const f32x4 ca = *(const f32x4*)(ropa_c + t * 32 + 8 * fq), cb = *(const f32x4*)(ropa_c + t * 32 + 8 * fq + 4), sa = *(const f32x4*)(ropa_s + t * 32 + 8 * fq), sb = *(const f32x4*)(ropa_s + t * 32 + 8 * fq + 4);
                        const f32x4 o1a = x1a * ca - x2a * sa, o2a = x1a * sa + x2a * ca, o1b = x1b * cb - x2b * sb, o2b = x1b * sb + x2b * cb; x1a = o1a; x2a = o2a; x1b = o1b; x2b = o2b; }
                    if (hh < 8) { const float qs = 0.125f * LOG2E; x1a *= qs; x1b *= qs; x2a *= qs; x2b *= qs; }
                    bf16_t* p = dst + row * ld + coff + 8 * fq;
                    u32x4 w1, w2; w1.x = gp::cvt_pk_bf16(x1a[0], x1a[1]); w1.y = gp::cvt_pk_bf16(x1a[2], x1a[3]); w1.z = gp::cvt_pk_bf16(x1b[0], x1b[1]); w1.w = gp::cvt_pk_bf16(x1b[2], x1b[3]);
                    w2.x = gp::cvt_pk_bf16(x2a[0], x2a[1]); w2.y = gp::cvt_pk_bf16(x2a[2], x2a[3]); w2.z = gp::cvt_pk_bf16(x2b[0], x2b[1]); w2.w = gp::cvt_pk_bf16(x2b[2], x2b[3]);
                    *(u32x4*)p = w1; *(u32x4*)(p + 32) = w2; if (m == 3) asm volatile("" ::: "memory"); }
        } else if (pn < 13) {
            const int q = pn - 3, which = q >> 1; const int cb0 = (q & 1) * 256 + wc * 32 + 8 * fq;
            if (which == 2 || which == 3) {
                f16_t* const blf_ = opq(BLF); f16_t* const blb_ = opq(BLB); f16_t* dst = which == 2 ? blf_ : blb_; const float* lbp = LBl + (which == 2 ? 0 : 512);
#pragma unroll
                for (int bj = 0; bj < 2; ++bj) { const int c0 = cb0 + bj * 128; const f32x4 la = *(const f32x4*)(lbp + c0), lb4 = *(const f32x4*)(lbp + c0 + 4);
#pragma unroll
                    for (int ai = 0; ai < 2; ++ai)
#pragma unroll
                        for (int m = 0; m < 4; ++m) { const size_t row = (size_t)(grow0 + ai * 128 + m * 16 - rowoff); const f32x4 v0 = acc[ai][bj][m][0], v1 = acc[ai][bj][m][1];
                            u32x4 w; w.x = pkh2(logf_gate_fast(v0[0], la[0]), logf_gate_fast(v0[1], la[1])); w.y = pkh2(logf_gate_fast(v0[2], la[2]), logf_gate_fast(v0[3], la[3]));
                            w.z = pkh2(logf_gate_fast(v1[0], lb4[0]), logf_gate_fast(v1[1], lb4[1])); w.w = pkh2(logf_gate_fast(v1[2], lb4[2]), logf_gate_fast(v1[3], lb4[3]));
                            *(u32x4*)(dst + row * 512 + c0) = w; } }
            } else {
                bf16_t* const bq_ = opq(BQ); bf16_t* const bv_ = opq(BV); bf16_t* const bg_ = opq(BG); bf16_t* dst = which == 0 ? bq_ : (which == 1 ? bv_ : bg_);
#pragma unroll
                for (int ai = 0; ai < 2; ++ai)
#pragma unroll
                    for (int m = 0; m < 4; ++m) { const size_t row = (size_t)(grow0 + ai * 128 + m * 16 - rowoff);
#pragma unroll
                        for (int bj = 0; bj < 2; ++bj) { const f32x4 v0 = acc[ai][bj][m][0], v1 = acc[ai][bj][m][1];
                            u32x4 w; w.x = gp::cvt_pk_bf16(v0[0], v0[1]); w.y = gp::cvt_pk_bf16(v0[2], v0[3]); w.z = gp::cvt_pk_bf16(v1[0], v1[1]); w.w = gp::cvt_pk_bf16(v1[2], v1[3]);
                            *(u32x4*)(dst + row * 512 + cb0 + bj * 128) = w; } }
            }
        } else if (pn == 13) {
#pragma unroll
            for (int ai = 0; ai < 2; ++ai)
#pragma unroll
                for (int m = 0; m < 4; ++m) { const int grow = grow0 + ai * 128 + m * 16; const size_t row = (size_t)(grow - rowoff); float ss = 0.f;
#pragma unroll
                    for (int bj = 0; bj < 2; ++bj) { const f32x4 v0 = acc[ai][bj][m][0], v1 = acc[ai][bj][m][1];
                        ss += v0[0] * v0[0] + v0[1] * v0[1] + v0[2] * v0[2] + v0[3] * v0[3] + v1[0] * v1[0] + v1[1] * v1[1] + v1[2] * v1[2] + v1[3] * v1[3];
                        u32x4 w; w.x = gp::cvt_pk_bf16(v0[0], v0[1]); w.y = gp::cvt_pk_bf16(v0[2], v0[3]); w.z = gp::cvt_pk_bf16(v1[0], v1[1]); w.w = gp::cvt_pk_bf16(v1[2], v1[3]);
                        *(u32x4*)(CQKV + row * 384 + bj * 128 + wc * 32 + 8 * fq) = w; }
                    ss += __shfl_xor(ss, 16); ss += __shfl_xor(ss, 32);
                    if (fq == 0) RS[(size_t)grow * 8 + wc] = ss; }
        } else {
#pragma unroll
            for (int ai = 0; ai < 2; ++ai)
#pragma unroll
                for (int m = 0; m < 4; ++m) { const int grow = grow0 + ai * 128 + m * 16, t = t0 + ai * 128 + m * 16; const size_t row = (size_t)(grow - rowoff);
                    const f32x4 v0 = acc[ai][0][m][0], v1 = acc[ai][0][m][1];
                    float ss = v0[0] * v0[0] + v0[1] * v0[1] + v0[2] * v0[2] + v0[3] * v0[3] + v1[0] * v1[0] + v1[1] * v1[1] + v1[2] * v1[2] + v1[3] * v1[3];
                    u32x4 w; w.x = gp::cvt_pk_bf16(v0[0], v0[1]); w.y = gp::cvt_pk_bf16(v0[2], v0[3]); w.z = gp::cvt_pk_bf16(v1[0], v1[1]); w.w = gp::cvt_pk_bf16(v1[2], v1[3]);
                    *(u32x4*)(CQKV + row * 384 + 256 + wc * 32 + 8 * fq) = w;
                    ss += __shfl_xor(ss, 16); ss += __shfl_xor(ss, 32);
                    if (fq == 0) RS[(size_t)grow * 8 + 4 + wc] = ss;
                    if (wc == 0) { f32x4 x1 = acc[ai][1][m][0], x2 = acc[ai][1][m][1];
                        if (lat) { const f32x4 cc = *(const f32x4*)(ropc_c + t * 16 + 4 * fq), sn = *(const f32x4*)(ropc_s + t * 16 + 4 * fq); const f32x4 o1 = x1 * cc - x2 * sn, o2 = x1 * sn + x2 * cc; x1 = o1; x2 = o2; }
                        *(uint2*)(CKR + row * 32 + 4 * fq) = make_uint2(gp::cvt_pk_bf16(x1[0], x1[1]), gp::cvt_pk_bf16(x1[2], x1[3]));
                        *(uint2*)(CKR + row * 32 + 16 + 4 * fq) = make_uint2(gp::cvt_pk_bf16(x2[0], x2[1]), gp::cvt_pk_bf16(x2[2], x2[3])); } }
        }
    }
};

struct EpiC {
    static constexpr bool PERM = true;
    bf16_t *CQ, *CKV; const float* RS; const float *ropc_c, *ropc_s; int pmoff;
    __device__ __forceinline__ void operator()(const f32x4 (&acc)[2][2][4][2], const gp::GUnit& u, int wr, int wc, int fr, int fq) const {
        const int pn = u.pn; const int pr = (u.pm + pmoff) % 33; const bool lat = pr < 32;
        const int grow0 = u.pm * 256 + wr * 64 + fr; const int t0 = pr * 256 + wr * 64 + fr;
        f32x4 rs4[2][4];
#pragma unroll
        for (int ai = 0; ai < 2; ++ai)
#pragma unroll
            for (int m = 0; m < 4; ++m) rs4[ai][m] = *(const f32x4*)(RS + (size_t)(grow0 + ai * 128 + m * 16) * 8 + (pn < 3 ? 0 : 4));
#pragma unroll
        for (int ai = 0; ai < 2; ++ai)
#pragma unroll
            for (int m = 0; m < 4; ++m) { const size_t row = (size_t)(grow0 + ai * 128 + m * 16); const int t = t0 + ai * 128 + m * 16;
                if (pn < 3) { const f32x4 p4 = rs4[ai][m]; const float rq = rsqrtf(((p4[0] + p4[1]) + (p4[2] + p4[3])) * (1.f / 256.f) + EPS) * (0.10206207261596577f * LOG2E);
#pragma unroll
                    for (int bj = 0; bj < 2; ++bj) { const int gi = pn * 8 + bj * 4 + wc, head = gi / 3, part = gi - head * 3;
                        f32x4 v0 = acc[ai][bj][m][0] * rq, v1 = acc[ai][bj][m][1] * rq;
                        bf16_t* p = CQ + row * 768 + head * 96;
                        if (part < 2) { u32x4 w; w.x = gp::cvt_pk_bf16(v0[0], v0[1]); w.y = gp::cvt_pk_bf16(v0[2], v0[3]); w.z = gp::cvt_pk_bf16(v1[0], v1[1]); w.w = gp::cvt_pk_bf16(v1[2], v1[3]);
                            *(u32x4*)(p + part * 32 + 8 * fq) = w; }
                        else { if (lat) { const f32x4 cc = *(const f32x4*)(ropc_c + t * 16 + 4 * fq), sn = *(const f32x4*)(ropc_s + t * 16 + 4 * fq); const f32x4 o1 = v0 * cc - v1 * sn, o2 = v0 * sn + v1 * cc; v0 = o1; v1 = o2; }
                            *(uint2*)(p + 64 + 4 * fq) = make_uint2(gp::cvt_pk_bf16(v0[0], v0[1]), gp::cvt_pk_bf16(v0[2], v0[3]));
                            *(uint2*)(p + 80 + 4 * fq) = make_uint2(gp::cvt_pk_bf16(v1[0], v1[1]), gp::cvt_pk_bf16(v1[2], v1[3])); } }
                } else { const f32x4 p4 = rs4[ai][m]; const float rkv = rsqrtf(((p4[0] + p4[1]) + (p4[2] + p4[3])) * (1.f / 128.f) + EPS);
#pragma unroll
                    for (int bj = 0; bj < 2; ++bj) { const f32x4 v0 = acc[ai][bj][m][0] * rkv, v1 = acc[ai][bj][m][1] * rkv;
                        u32x4 w; w.x = gp::cvt_pk_bf16(v0[0], v0[1]); w.y = gp::cvt_pk_bf16(v0[2], v0[3]); w.z = gp::cvt_pk_bf16(v1[0], v1[1]); w.w = gp::cvt_pk_bf16(v1[2], v1[3]);
                        *(u32x4*)(CKV + row * 1024 + (pn - 3) * 256 + bj * 128 + wc * 32 + 8 * fq) = w; } } }
    }
};
struct EpiGate {
    static constexpr bool PERM = true;
    bf16_t* GATE; long nstride; int ld;
    __device__ __forceinline__ void operator()(const f32x4 (&acc)[2][2][4][2], const gp::GUnit& u, int wr, int wc, int fr, int fq) const {
        const int n3 = u.pn >> 2; bf16_t* base = GATE + (size_t)n3 * nstride + (u.pn & 3) * 256 + wc * 32 + 8 * fq; const int row0 = u.pm * 256 + wr * 64 + fr;
#pragma unroll
        for (int ai = 0; ai < 2; ++ai)
#pragma unroll
            for (int m = 0; m < 4; ++m) { bf16_t* rp = base + (size_t)(row0 + ai * 128 + m * 16) * ld;
#pragma unroll
                for (int bj = 0; bj < 2; ++bj) { const f32x4 v0 = acc[ai][bj][m][0], v1 = acc[ai][bj][m][1];
                    u32x4 w; w.x = gp::cvt_pk_bf16(fsigmoid(v0[0]), fsigmoid(v0[1])); w.y = gp::cvt_pk_bf16(fsigmoid(v0[2]), fsigmoid(v0[3])); w.z = gp::cvt_pk_bf16(fsigmoid(v1[0]), fsigmoid(v1[1])); w.w = gp::cvt_pk_bf16(fsigmoid(v1[2]), fsigmoid(v1[3]));
                    *(u32x4*)(rp + bj * 128) = w; } }
    }
};
struct SchedMerge {
    static constexpr bool GATHER = false;
    const bf16_t *A0, *A1, *A2; const bf16_t* Bt; int nM, G_, c, skipctx, lda2, ldb2;
    __device__ __forceinline__ bool next(int i, gp::GUnit& u) const {
        int pmv, pn12; if (!gp::tile_order(i, G_, c, nM, 12, pmv, pn12)) return false;
        const int n = pn12 >> 2, pn = pn12 & 3;
        const int pm = skipctx ? pmv + pmv / 32 : pmv;
        const bf16_t* a0 = opq(A0); const bf16_t* a1 = opq(A1); const bf16_t* a2 = opq(A2);
        const bf16_t* a = n == 0 ? a0 : (n == 1 ? a1 : a2);
        u.A = (const char*)(a + (size_t)pm * 256 * 512); u.B = (const char*)(Bt + (size_t)n * 1024 * 512 + (size_t)pn * 256 * 512); u.nt = 8; u.pm = pm; u.pn = pn; u.tag = n; u.goff = nullptr; return true;
    }
};
__device__ __forceinline__ float bflo(unsigned w) { return __uint_as_float(w << 16); }
__device__ __forceinline__ float bfhi(unsigned w) { return __uint_as_float(w & 0xffff0000u); }
struct EpiMerge {
    static constexpr bool PERM = true;
    bf16_t* GATE; long nstride; int ld;
    __device__ __forceinline__ void operator()(const f32x4 (&acc)[2][2][4][2], const gp::GUnit& u, int wr, int wc, int fr, int fq) const {
        if (PROBE_VARIANT == 3 && ld < 0) return;
        const int n3 = u.tag; const int col = u.pn * 256 + wc * 32 + 8 * fq; bf16_t* gb = GATE + (size_t)n3 * nstride + col; const int row0 = u.pm * 256 + wr * 64 + fr;
#pragma unroll
        for (int ai = 0; ai < 2; ++ai) { u32x4 g[4][2];
#pragma unroll
            for (int m = 0; m < 4; ++m)
#pragma unroll
                for (int bj = 0; bj < 2; ++bj) g[m][bj] = *(const u32x4*)(gb + (size_t)(row0 + ai * 128 + m * 16) * ld + bj * 128);
#pragma unroll
            for (int m = 0; m < 4; ++m)
#pragma unroll
                for (int bj = 0; bj < 2; ++bj) { const u32x4 gg = g[m][bj]; const f32x4 v0 = acc[ai][bj][m][0], v1 = acc[ai][bj][m][1];
                    u32x4 w; w.x = gp::cvt_pk_bf16(v0[0] * bflo(gg.x), v0[1] * bfhi(gg.x)); w.y = gp::cvt_pk_bf16(v0[2] * bflo(gg.y), v0[3] * bfhi(gg.y));
                    w.z = gp::cvt_pk_bf16(v1[0] * bflo(gg.z), v1[1] * bfhi(gg.z)); w.w = gp::cvt_pk_bf16(v1[2] * bflo(gg.w), v1[3] * bfhi(gg.w));
                    *(u32x4*)(gb + (size_t)(row0 + ai * 128 + m * 16) * ld + bj * 128) = w; }
            asm volatile("" ::: "memory"); }
    }
};
struct EpiOut {
    static constexpr bool PERM = false;
    const float *xl_src, *xc_src; float *xl_dst, *xc_dst; const float* mod; int pmoff;
    __device__ __forceinline__ void operator()(const f32x4 (&acc)[2][2][4][2], const gp::GUnit& u, int wr, int wc, int fr, int fq) const {
        const int gpm = u.pm + pmoff, b = gpm / 33, pr = gpm - b * 33; const bool lat = pr < 32;
        const float* xs = opq(lat ? xl_src : xc_src); float* xd = opq(lat ? xl_dst : xc_dst);
        const size_t rbase = lat ? ((size_t)b * SEQ + pr * 256) : ((size_t)b * CTXL);
        const float* gt = mod + (size_t)(lat ? b : 4) * 6144 + 2048; const int col0 = u.pn * 256 + wc * 32 + 4 * fq;
        f32x4 g4[2][2];
#pragma unroll
        for (int bj = 0; bj < 2; ++bj)
#pragma unroll
            for (int n = 0; n < 2; ++n) g4[bj][n] = *(const f32x4*)(gt + col0 + bj * 128 + n * 16);
#pragma unroll
        for (int ai = 0; ai < 2; ++ai) { f32x4 xv[4][2][2];
#pragma unroll
            for (int m = 0; m < 4; ++m) { const size_t off = (rbase + ai * 128 + wr * 64 + m * 16 + fr) * D + col0;
#pragma unroll
                for (int bj = 0; bj < 2; ++bj)
#pragma unroll
                    for (int n = 0; n < 2; ++n) xv[m][bj][n] = *(const f32x4*)(xs + off + bj * 128 + n * 16); }
#pragma unroll
            for (int m = 0; m < 4; ++m) { const size_t off = (rbase + ai * 128 + wr * 64 + m * 16 + fr) * D + col0;
#pragma unroll
                for (int bj = 0; bj < 2; ++bj)
#pragma unroll
                    for (int n = 0; n < 2; ++n) *(f32x4*)(xd + off + bj * 128 + n * 16) = xv[m][bj][n] + g4[bj][n] * acc[ai][bj][m][n]; }
            asm volatile("" ::: "memory"); }
    }
};
template <bool GATHER_> struct SchedMoE {
    static constexpr bool GATHER = GATHER_;
    const bf16_t* A; const bf16_t* Bt; const int* tile_e; const unsigned* goff; int K, nM, nN, G_, c, lda2, ldb2; long strideB;
    __device__ __forceinline__ bool next(int i, gp::GUnit& u) const {
        int pm, pn; if (!gp::tile_order(i, G_, c, nM, nN, pm, pn)) return false;
        const int e = tile_e[pm];
        u.A = GATHER ? (const char*)A : (const char*)(A + (size_t)pm * 256 * K); u.B = (const char*)(Bt + (size_t)e * strideB + (size_t)pn * 256 * K); u.nt = K / 64; u.pm = pm; u.pn = pn; u.tag = e;
        u.goff = GATHER ? goff + (size_t)pm * 256 : nullptr; return true;
    }
};
struct EpiUp {
    static constexpr bool PERM = true;
    bf16_t* AUP;
    __device__ __forceinline__ void operator()(const f32x4 (&acc)[2][2][4][2], const gp::GUnit& u, int wr, int wc, int fr, int fq) const {
        const int row0 = u.pm * 256 + wr * 64 + fr; bf16_t* base = AUP + u.pn * 128 + wc * 32 + 8 * fq;
#pragma unroll
        for (int ai = 0; ai < 2; ++ai)
#pragma unroll
            for (int m = 0; m < 4; ++m) { const f32x4 a0 = acc[ai][0][m][0], a1 = acc[ai][0][m][1], b0 = acc[ai][1][m][0], b1 = acc[ai][1][m][1];
                float r[8];
#pragma unroll
                for (int e = 0; e < 4; ++e) { r[e] = a0[e] * fsigmoid(a0[e]) * b0[e]; r[4 + e] = a1[e] * fsigmoid(a1[e]) * b1[e]; }
                u32x4 w; w.x = gp::cvt_pk_bf16(r[0], r[1]); w.y = gp::cvt_pk_bf16(r[2], r[3]); w.z = gp::cvt_pk_bf16(r[4], r[5]); w.w = gp::cvt_pk_bf16(r[6], r[7]);
                *(u32x4*)(base + (size_t)(row0 + ai * 128 + m * 16) * 256) = w; }
    }
};
struct EpiDown {
    static constexpr bool PERM = true;
    bf16_t* YM2; const int* perm; const float* posw;
    __device__ __forceinline__ void operator()(const f32x4 (&acc)[2][2][4][2], const gp::GUnit& u, int wr, int wc, int fr, int fq) const {
        const int row0 = u.pm * 256 + wr * 64 + fr; const int col = u.pn * 256 + wc * 32 + 8 * fq;
#pragma unroll
        for (int ai = 0; ai < 2; ++ai)
#pragma unroll
            for (int m = 0; m < 4; ++m) { const int pos = row0 + ai * 128 + m * 16; const int pe = perm[pos]; const float w8 = posw[pos];
                if (pe >= 0) {
#pragma unroll
                    for (int bj = 0; bj < 2; ++bj) { const f32x4 v0 = acc[ai][bj][m][0] * w8, v1 = acc[ai][bj][m][1] * w8;
                        u32x4 w; w.x = gp::cvt_pk_bf16(v0[0], v0[1]); w.y = gp::cvt_pk_bf16(v0[2], v0[3]); w.z = gp::cvt_pk_bf16(v1[0], v1[1]); w.w = gp::cvt_pk_bf16(v1[2], v1[3]);
                        *(u32x4*)(YM2 + (size_t)pe * 1024 + col + bj * 128) = w; } } }
    }
};
enum { MAP_WIN = 1, MAP_WC = 2, MAP_WUP = 3 };
__device__ __forceinline__ int colmap(int kind, int p) {
    if (kind == MAP_WIN) {
        if (p >= 3840) return MIXW + (p - 3840);
        const int pn = p >> 8, q = p & 255, bj = q >> 7, wc = (q >> 5) & 3, j = q & 31;
        if (pn < 3) return (pn * 4 + wc) * 64 + bj * 32 + j;
        if (pn < 14) return p;
        if (bj == 0) return p;
        if (wc != 0) return -1;
        return 3712 + 16 * ((j >> 2) & 1) + 4 * (j >> 3) + (j & 3);
    }
    return p;
}
constexpr int NCHK = RPB / 64;
struct ScanArgs { const bf16_t* BQ; const bf16_t* BV; const bf16_t* BG; const f16_t* BLF; const f16_t* BLB; bf16_t* ST; float* DS; bf16_t* OB; const float* gn; int in_off; int out_off; int skipctx_out; int pad; };
#define MFMA16(a, b, c) __builtin_amdgcn_mfma_f32_16x16x32_bf16(a, b, c, 0, 0, 0)
constexpr int BCS = 68;
constexpr int SC_RAW = 0, SC_VT = 2 * 64 * BCS * 4, SC_A = SC_VT + 9216;
__device__ __forceinline__ void scan_stage(LAS char* lds, const ScanArgs& a, size_t row0, int h, int tid) {
    LAS float* RAW = (LAS float*)(lds + SC_RAW); LAS bf16_t* VT = (LAS bf16_t*)(lds + SC_VT);
    const int row = tid >> 3, c8 = (tid & 7) * 8; const size_t off = (row0 + row) * 512 + h * 64 + c8;
    typedef _Float16 h8 __attribute__((ext_vector_type(8)));
    const h8 lf = *(const h8*)(a.BLF + off), lb = *(const h8*)(a.BLB + off);
    const int vrow = tid & 63, vc8 = (tid >> 6) * 8; const bf16x8 v = *(const bf16x8*)(a.BV + (row0 + vrow) * 512 + h * 64 + vc8);
    *(LAS f32x4*)(RAW + row * BCS + c8) = (f32x4){(float)lf[0], (float)lf[1], (float)lf[2], (float)lf[3]}; *(LAS f32x4*)(RAW + row * BCS + c8 + 4) = (f32x4){(float)lf[4], (float)lf[5], (float)lf[6], (float)lf[7]};
    *(LAS f32x4*)(RAW + 64 * BCS + row * BCS + c8) = (f32x4){(float)lb[0], (float)lb[1], (float)lb[2], (float)lb[3]}; *(LAS f32x4*)(RAW + 64 * BCS + row * BCS + c8 + 4) = (f32x4){(float)lb[4], (float)lb[5], (float)lb[6], (float)lb[7]};
#pragma unroll
    for (int j = 0; j < 8; ++j) VT[(vc8 + j) * 72 + vrow] = (bf16_t)v[j];
}
__device__ __forceinline__ void scan_cumsum(LAS char* lds, LAS float* XCH, int tid, float (&lf)[16], float (&bc)[16], float& total) {
    LAS float* RAW = (LAS float*)(lds + SC_RAW);
    const int col = tid & 127, dir = col >> 6, d = col & 63, seg = tid >> 7;
#pragma unroll
    for (int j = 0; j < 16; ++j) lf[j] = RAW[dir * 64 * BCS + (16 * seg + j) * BCS + d];
    if (dir == 0) { float c = 0.f;
#pragma unroll
        for (int j = 0; j < 16; ++j) { c += lf[j]; bc[j] = c; } }
    else { float c = 0.f;
#pragma unroll
        for (int j = 15; j >= 0; --j) { c += lf[j]; bc[j] = c; } }
    XCH[seg * 128 + col] = dir == 0 ? bc[15] : bc[0];
    __syncthreads();
    const float t0 = XCH[col], t1 = XCH[128 + col], t2 = XCH[256 + col], t3 = XCH[384 + col];
    total = (t0 + t1) + (t2 + t3);
    float off;
    if (dir == 0) off = seg == 0 ? 0.f : (seg == 1 ? t0 : (seg == 2 ? t0 + t1 : t0 + t1 + t2));
    else off = seg == 3 ? 0.f : (seg == 2 ? t3 : (seg == 1 ? t3 + t2 : t3 + t2 + t1));
#pragma unroll
    for (int j = 0; j < 16; ++j) bc[j] += off;
}
__device__ __forceinline__ void scan_s1_unit(LAS char* lds, const ScanArgs& a, int wv0, int b, int h, int k) {
    const int tid = opaque_tid(wv0), lane = tid & 63, wid = tid >> 6;
    LAS bf16_t* VT = (LAS bf16_t*)(lds + SC_VT); LAS bf16_t* KKT = (LAS bf16_t*)(lds + SC_A); LAS float* XCH = (LAS float*)(lds + SC_A + 18432);
    const size_t row0 = (size_t)b * RPB + 64 * k - a.in_off;
    scan_stage(lds, a, row0, h, tid);
    __syncthreads();
    float lf[16], bc[16], total; scan_cumsum(lds, XCH, tid, lf, bc, total);
    const int col = tid & 127, dir = col >> 6, d = col & 63, seg = tid >> 7;
    const size_t sidx = ((size_t)((b * 8 + h) * 2 + dir)) * NCHK + k;
    { unsigned w[8];
#pragma unroll
      for (int j = 0; j < 16; j += 2) { const float k0 = (1.f - fexp(lf[j])) * fexp(total - bc[j]), k1 = (1.f - fexp(lf[j + 1])) * fexp(total - bc[j + 1]); w[j >> 1] = pkbf(k0, k1); }
      LAS u32x4* kp = (LAS u32x4*)(KKT + (dir * 64 + d) * 72 + 16 * seg); kp[0] = (u32x4){w[0], w[1], w[2], w[3]}; kp[1] = (u32x4){w[4], w[5], w[6], w[7]};
      if (seg == 0) a.DS[sidx * 64 + d] = fexp(total); }
    __syncthreads();
    { const int wdir = wid >> 2, et = wid & 3, fr = lane & 15, fq = lane >> 4;
      f32x4 acc[4];
#pragma unroll
      for (int dt = 0; dt < 4; ++dt) acc[dt] = (f32x4){0.f, 0.f, 0.f, 0.f};
#pragma unroll
      for (int ks = 0; ks < 2; ++ks) { const bf16x8 af = *(const LAS bf16x8*)(VT + (16 * et + fr) * 72 + 32 * ks + 8 * fq);
#pragma unroll
          for (int dt = 0; dt < 4; ++dt) { const bf16x8 bfv = *(const LAS bf16x8*)(KKT + (wdir * 64 + 16 * dt + fr) * 72 + 32 * ks + 8 * fq); acc[dt] = MFMA16(af, bfv, acc[dt]); } }
      bf16_t* sp = a.ST + (((size_t)((b * 8 + h) * 2 + wdir)) * NCHK + k) * 4096;
#pragma unroll
      for (int dt = 0; dt < 4; ++dt)
#pragma unroll
          for (int r = 0; r < 4; ++r) sp[(16 * et + 4 * fq + r) * 64 + 16 * dt + fr] = f2bf(acc[dt][r]); }
    __syncthreads();
}
__device__ __forceinline__ void scan_s2_task(const ScanArgs& a, int wv0, int task) {
    const int chain = task >> 2, quarter = task & 3, dir = chain & 1, tid = opaque_tid(wv0);
    const int e = 16 * quarter + (tid >> 5), d = 2 * (tid & 31);
    float s0 = 0.f, s1 = 0.f;
    for (int g = 0; g < NCHK; g += 12) {
        unsigned L[12]; float2 Dv[12]; unsigned* pp[12];
#pragma unroll
        for (int j = 0; j < 12; ++j) { const int step = g + j; const int k = dir == 0 ? (step < 4 ? 128 + step : step - 4) : (step < 4 ? 131 - step : 131 - step);
            const size_t idx = (size_t)chain * NCHK + k; pp[j] = (unsigned*)(a.ST + idx * 4096 + e * 64 + d); L[j] = *pp[j]; Dv[j] = *(const float2*)(a.DS + idx * 64 + d); }
#pragma unroll
        for (int j = 0; j < 12; ++j) { *pp[j] = pkbf(s0, s1); s0 = Dv[j].x * s0 + bflo(L[j]); s1 = Dv[j].y * s1 + bfhi(L[j]); }
    }
}
__device__ __forceinline__ void scan_s3_unit(LAS char* lds, const ScanArgs& a, int wv0, int b, int h, int k) {
    const int tid = opaque_tid(wv0), lane = tid & 63, wid = tid >> 6;
    LAS float* BC = (LAS float*)(lds + SC_RAW); LAS bf16_t* VT = (LAS bf16_t*)(lds + SC_VT);
    LAS bf16_t* STL = (LAS bf16_t*)(lds + SC_A);
    LAS float* XCH = (LAS float*)(lds + SC_A + 18432);
    LAS float* OSUM = (LAS float*)(lds + SC_A + 18432 + 2048);
    LAS bf16_t* PW = (LAS bf16_t*)(lds + SC_A + 18432 + 2048 + 17408) + wid * 3456;
    const size_t row0 = (size_t)b * RPB + 64 * k - a.in_off;
    bf16x8 q0_, q1_; bf16_t gpre[16];
    { const int dir_ = wid >> 2, si_ = wid & 3, erow_ = lane >> 2, dg_ = (lane & 3) * 16, fr_ = lane & 15, fq_ = lane >> 4;
      const bf16_t* qp = a.BQ + (row0 + 16 * si_ + erow_) * 512 + h * 64 + dg_; q0_ = *(const bf16x8*)qp; q1_ = *(const bf16x8*)(qp + 8);
      if (dir_ == 1) {
#pragma unroll
          for (int n = 0; n < 4; ++n)
#pragma unroll
              for (int r = 0; r < 4; ++r) gpre[n * 4 + r] = a.BG[(row0 + 16 * si_ + 4 * fq_ + r) * 512 + h * 64 + 16 * n + fr_]; }
      else {
#pragma unroll
          for (int i = 0; i < 16; ++i) gpre[i] = 0; } }
    scan_stage(lds, a, row0, h, tid);
    { const int sd = tid >> 8, e = (tid & 255) >> 2, c16 = (tid & 3) * 16;
      const bf16_t* sp = a.ST + (((size_t)((b * 8 + h) * 2 + sd)) * NCHK + k) * 4096 + e * 64 + c16;
      const u32x4 s0 = *(const u32x4*)sp, s1 = *(const u32x4*)(sp + 8);
      LAS u32x4* dp = (LAS u32x4*)(STL + (sd * 64 + e) * 72 + c16); dp[0] = s0; dp[1] = s1; }
    __syncthreads();
    { float lf[16], bc[16], total; scan_cumsum(lds, XCH, tid, lf, bc, total);
      const int col = tid & 127, dir = col >> 6, d = col & 63, seg = tid >> 7;
      __syncthreads();
#pragma unroll
      for (int j = 0; j < 16; ++j) BC[dir * 64 * BCS + (16 * seg + j) * BCS + d] = bc[j]; }
    __syncthreads();
    const int dir = wid >> 2, si = wid & 3;
    LAS bf16_t* QP = PW; LAS bf16_t* KP = PW + 1152; LAS bf16_t* ATT = PW + 2304;
    const int erow = lane >> 2, dg = (lane & 3) * 16;
    const int fr = lane & 15, fq = lane >> 4;
    LAS const float* bcd = BC + dir * 64 * BCS;
    float refv[16];
    { const int rr = dir == 0 ? 16 * si - 1 : 16 * (si + 1);
#pragma unroll
      for (int j = 0; j < 16; j += 4) { f32x4 t4 = (f32x4){0.f, 0.f, 0.f, 0.f}; if (rr >= 0 && rr < 64) t4 = *(const LAS f32x4*)(bcd + rr * BCS + dg + j); refv[j] = t4[0]; refv[j + 1] = t4[1]; refv[j + 2] = t4[2]; refv[j + 3] = t4[3]; } }
    float qv[16], bq[16];
    {
#pragma unroll
      for (int j = 0; j < 8; ++j) { qv[j] = bf2f((bf16_t)q0_[j]); qv[8 + j] = bf2f((bf16_t)q1_[j]); }
#pragma unroll
      for (int j = 0; j < 16; j += 4) { const f32x4 t4 = *(const LAS f32x4*)(bcd + (16 * si + erow) * BCS + dg + j); bq[j] = t4[0]; bq[j + 1] = t4[1]; bq[j + 2] = t4[2]; bq[j + 3] = t4[3]; } }
    { unsigned w[8];
#pragma unroll
      for (int j = 0; j < 16; j += 2) w[j >> 1] = pkbf(qv[j] * fexp(bq[j] - refv[j]), qv[j + 1] * fexp(bq[j + 1] - refv[j + 1]));
      LAS u32x4* p = (LAS u32x4*)(QP + erow * 72 + dg); p[0] = (u32x4){w[0], w[1], w[2], w[3]}; p[1] = (u32x4){w[4], w[5], w[6], w[7]};
      LAS u32x4* z = (LAS u32x4*)(ATT + erow * 72 + dg); z[0] = (u32x4){0u, 0u, 0u, 0u}; z[1] = (u32x4){0u, 0u, 0u, 0u}; }
    const int j_lo = dir == 0 ? 0 : si, j_hi = dir == 0 ? si : 3;
    for (int jb = j_lo; jb <= j_hi; ++jb) {
        { const int sg = 16 * jb + erow; const int sn = dir == 0 ? sg - 1 : sg + 1; unsigned w[8];
#pragma unroll
          for (int j = 0; j < 16; j += 4) { const f32x4 bs4 = *(const LAS f32x4*)(bcd + sg * BCS + dg + j); f32x4 bn4 = (f32x4){0.f, 0.f, 0.f, 0.f}; if (sn >= 0 && sn < 64) bn4 = *(const LAS f32x4*)(bcd + sn * BCS + dg + j);
              float kk[4];
#pragma unroll
              for (int t = 0; t < 4; ++t) kk[t] = (1.f - fexp(bs4[t] - bn4[t])) * fexp(fminf(refv[j + t] - bs4[t], 60.f));
              w[j >> 1] = pkbf(kk[0], kk[1]); w[(j >> 1) + 1] = pkbf(kk[2], kk[3]); }
          LAS u32x4* p = (LAS u32x4*)(KP + erow * 72 + dg); p[0] = (u32x4){w[0], w[1], w[2], w[3]}; p[1] = (u32x4){w[4], w[5], w[6], w[7]}; }
        __builtin_amdgcn_wave_barrier(); asm volatile("s_waitcnt lgkmcnt(0)" ::: "memory");
        f32x4 c = (f32x4){0.f, 0.f, 0.f, 0.f};
#pragma unroll
        for (int ks = 0; ks < 2; ++ks) { const bf16x8 af = *(const LAS bf16x8*)(QP + fr * 72 + 32 * ks + 8 * fq), bfv = *(const LAS bf16x8*)(KP + fr * 72 + 32 * ks + 8 * fq); c = MFMA16(af, bfv, c); }
#pragma unroll
        for (int r = 0; r < 4; ++r) { const int tq = 4 * fq + r; float v = c[r];
            if (jb == si) { if (dir == 0 ? (fr > tq) : (fr < tq)) v = 0.f; }
            ATT[tq * 72 + 16 * jb + fr] = f2bf(v); }
        __builtin_amdgcn_wave_barrier(); asm volatile("s_waitcnt lgkmcnt(0)" ::: "memory");
    }
    { unsigned w[8];
#pragma unroll
      for (int j = 0; j < 16; j += 2) w[j >> 1] = pkbf(qv[j] * fexp(bq[j]), qv[j + 1] * fexp(bq[j + 1]));
      LAS u32x4* p = (LAS u32x4*)(QP + erow * 72 + dg); p[0] = (u32x4){w[0], w[1], w[2], w[3]}; p[1] = (u32x4){w[4], w[5], w[6], w[7]}; }
    __builtin_amdgcn_wave_barrier(); asm volatile("s_waitcnt lgkmcnt(0)" ::: "memory");
    f32x4 o[4];
#pragma unroll
    for (int n = 0; n < 4; ++n) o[n] = (f32x4){0.f, 0.f, 0.f, 0.f};
#pragma unroll
    for (int ks = 0; ks < 2; ++ks) { const bf16x8 aq = *(const LAS bf16x8*)(QP + fr * 72 + 32 * ks + 8 * fq), aa = *(const LAS bf16x8*)(ATT + fr * 72 + 32 * ks + 8 * fq);
#pragma unroll
        for (int n = 0; n < 4; ++n) { const bf16x8 bs = *(const LAS bf16x8*)(STL + (dir * 64 + 16 * n + fr) * 72 + 32 * ks + 8 * fq), bv = *(const LAS bf16x8*)(VT + (16 * n + fr) * 72 + 32 * ks + 8 * fq);
            o[n] = MFMA16(aq, bs, o[n]); o[n] = MFMA16(aa, bv, o[n]); } }
    if (dir == 0) {
#pragma unroll
        for (int n = 0; n < 4; ++n)
#pragma unroll
            for (int r = 0; r < 4; ++r) OSUM[(16 * si + 4 * fq + r) * 68 + 16 * n + fr] = o[n][r]; }
    __syncthreads();
    if (dir == 1) {
        const bool wr_out = !(a.skipctx_out && k >= 128) && !a.pad;
        float ss[4] = {0.f, 0.f, 0.f, 0.f};
#pragma unroll
        for (int n = 0; n < 4; ++n)
#pragma unroll
            for (int r = 0; r < 4; ++r) { o[n][r] += OSUM[(16 * si + 4 * fq + r) * 68 + 16 * n + fr]; ss[r] += o[n][r] * o[n][r]; }
#pragma unroll
        for (int r = 0; r < 4; ++r) { ss[r] += __shfl_xor(ss[r], 1); ss[r] += __shfl_xor(ss[r], 2); ss[r] += __shfl_xor(ss[r], 4); ss[r] += __shfl_xor(ss[r], 8); ss[r] = rsqrtf(ss[r] * (1.f / 64.f) + EPS); }
        if (wr_out) {
            const size_t orow0 = (size_t)b * RPB + 64 * k - a.out_off;
#pragma unroll
            for (int n = 0; n < 4; ++n)
#pragma unroll
                for (int r = 0; r < 4; ++r) { const int tq = 16 * si + 4 * fq + r, e = 16 * n + fr; const float gv = bf2f(gpre[n * 4 + r]);
                    a.OB[(orow0 + tq) * 512 + h * 64 + e] = f2bf(o[n][r] * ss[r] * a.gn[h * 64 + e] * gv * fsigmoid(gv)); }
        }
    }
    __syncthreads();
}
constexpr int SCAN_LDS = SC_A + 18432 + 2048 + 17408 + 8 * 6912;

#define XB_TMO      128
#define XB_XCNT(j)  (256  + 64 * (j))
#define XB_XSUB(j)  (1280 + 64 * (j))
#define XB_XGEN(j)  (2304 + 64 * (j))
#define XB_TOP      3328
#define XB_TOPGEN   3392
#define XCD_BAR_WORDS 3456
#define XB_SPIN_CAP (1u << 18)

__device__ __forceinline__ unsigned xb_ld(unsigned* p)              { return __hip_atomic_load(p, __ATOMIC_RELAXED, __HIP_MEMORY_SCOPE_AGENT); }
__device__ __forceinline__ unsigned xb_add(unsigned* p, unsigned v) { return __hip_atomic_fetch_add(p, v, __ATOMIC_RELAXED, __HIP_MEMORY_SCOPE_AGENT); }
__device__ __forceinline__ unsigned xb_xcc_id() { return (unsigned)__builtin_amdgcn_s_getreg((3 << 11) | 20) & 0xFu; }
#define XB_SPIN(cond, bar) do { unsigned _sp = 0; while (cond) { __builtin_amdgcn_s_sleep(1); \
    if ((++_sp & 255u) == 0u) { if (xb_ld(&(bar)[XB_TMO])) break; if (_sp > XB_SPIN_CAP) { atomicAdd(&(bar)[XB_TMO], 1u); break; } } } } while (0)

struct XcdBarrier {
    unsigned* bar; unsigned x;
    volatile LAS unsigned* st;
};

__device__ __forceinline__ XcdBarrier xcd_barrier_post(unsigned* bar, volatile LAS unsigned* st) {
    XcdBarrier b; b.bar = bar; b.x = xb_xcc_id(); b.st = st;
    if (threadIdx.x == 0) (void)xb_add(&bar[XB_XCNT(b.x)], 1u);
    return b;
}
__device__ __forceinline__ void xcd_barrier_complete(unsigned* bar, unsigned x, unsigned& nloc, unsigned& nx) {
    const unsigned G = gridDim.x * gridDim.y * gridDim.z;
    unsigned sum, cnt, mine, sp = 0u;
    for (;;) {
        sum = 0u; cnt = 0u; mine = 0u;
#pragma unroll
        for (unsigned j = 0; j < 16; ++j) { const unsigned c = xb_ld(&bar[XB_XCNT(j)]); sum += c; cnt += (c > 0u) ? 1u : 0u; mine = (j == x) ? c : mine; }
        if (sum == G) break;
        __builtin_amdgcn_s_sleep(1);
        if ((++sp & 255u) == 0u) { if (xb_ld(&bar[XB_TMO])) break; if (sp > XB_SPIN_CAP) { atomicAdd(&bar[XB_TMO], 1u); break; } }
    }
    nloc = mine > 0u ? mine : 1u; nx = cnt > 0u ? cnt : 1u;
}

__device__ __forceinline__ void xcd_barrier(const XcdBarrier& b) {
    asm volatile("s_waitcnt vmcnt(0)" ::: "memory");
    __syncthreads();
    if (threadIdx.x == 0) {
        unsigned* bar = b.bar;
        __builtin_amdgcn_s_waitcnt(0);
        unsigned nloc = b.st[0], nx = b.st[1];
        if (nloc == 0u) { xcd_barrier_complete(bar, b.x, nloc, nx); b.st[0] = nloc; b.st[1] = nx; }
        const unsigned old = xb_add(&bar[XB_XSUB(b.x)], 1u);
        const unsigned gen = old / nloc;
        if (old + 1u == (gen + 1u) * nloc) {
            __builtin_amdgcn_fence(__ATOMIC_RELEASE, "agent");
            asm volatile("s_waitcnt vmcnt(0)" ::: "memory");
            const unsigned og = xb_add(&bar[XB_TOP], 1u);
            const unsigned tg = og / nx;
            if (og + 1u == (tg + 1u) * nx) xb_add(&bar[XB_TOPGEN], 1u);
            else XB_SPIN(xb_ld(&bar[XB_TOPGEN]) == tg, bar);
            __builtin_amdgcn_fence(__ATOMIC_ACQUIRE, "agent");
            xb_add(&bar[XB_XGEN(b.x)], 1u);
            asm volatile("s_waitcnt vmcnt(0)" ::: "memory");
        } else {
            XB_SPIN(xb_ld(&bar[XB_XGEN(b.x)]) == gen, bar);
            __builtin_amdgcn_fence(__ATOMIC_ACQUIRE, "agent");
            asm volatile("s_waitcnt vmcnt(0)" ::: "memory");
        }
    }
    __syncthreads();
}


constexpr size_t MiB = 1u << 20;
constexpr size_t CTL_ZERO_BYTES = 64 * 1024;
constexpr int CW_COUNTS = 8192, CW_CURSOR = 8192 + 128;
constexpr size_t O_MOD = 1 * MiB, O_LB = 1 * MiB + 512 * 1024, O_ROPA_C = 2 * MiB, O_ROPA_S = 3 * MiB, O_ROPC_C = 4 * MiB, O_ROPC_S = 4 * MiB + 512 * 1024, O_XC = 5 * MiB;
constexpr size_t O_ROUTE_E = 9 * MiB, O_ROUTE_W = 9 * MiB + 512 * 1024, O_PERM = 10 * MiB, O_POSW = 10 * MiB + 512 * 1024, O_GOFF = 11 * MiB, O_TILEE = 11 * MiB + 512 * 1024;
constexpr size_t O_WRT = 11 * MiB + 640 * 1024;
constexpr size_t O_RS = 12 * MiB, O_DS = 13 * MiB + 512 * 1024, O_WGH = 15 * MiB + 768 * 1024;
constexpr size_t O_WINP = 16 * MiB, O_WC = 30 * MiB, O_WBR = 32 * MiB, O_WOUT = 35 * MiB;
constexpr size_t O_H = 38 * MiB;
constexpr size_t O_AQ = 104 * MiB, O_AK = 137 * MiB, O_AV = 145 * MiB + 512 * 1024;
constexpr size_t O_BQ = 154 * MiB, O_BV = 187 * MiB, O_BG = 220 * MiB, O_BLF = 253 * MiB, O_BLB = 286 * MiB;
constexpr size_t O_CQKV = 319 * MiB, O_CKR = 344 * MiB, O_CQ = 347 * MiB, O_CKV = 397 * MiB, O_OC = 463 * MiB, O_WRB = 496 * MiB, WS_END = 497 * MiB;
constexpr size_t O_GATE = 187 * MiB;
constexpr size_t O_YM2 = 154 * MiB, O_AUP = 104 * MiB, O_WUP = 397 * MiB, O_WDN = 429 * MiB;
constexpr int LDS_BYTES = 163840, LDS_BAR_OFF = LDS_BYTES - 64, LDS_PTR_OFF = LDS_BYTES - 512;

struct KP { const float* in[24]; float* out; char* ws; int ph_lo, ph_hi; unsigned long long mask; };
struct Frame {
    LAS char* lds; char* ws; float* out; int wv0;
};
#define WSP(T, off) ((T*)(F.ws + (off)))
__device__ __forceinline__ const float* in_ptr(const Frame& F, int k) { const volatile LAS unsigned* q = (const volatile LAS unsigned*)(F.lds + LDS_PTR_OFF + 8 * k);
    unsigned lo = q[0], hi = q[1]; lo = __builtin_amdgcn_readfirstlane(lo); hi = __builtin_amdgcn_readfirstlane(hi); return (const float*)(((unsigned long long)hi << 32) | lo); }
#define INP(k) in_ptr(F, k)
__device__ __forceinline__ float wave_sum_dpp(float v) {
    int x = __builtin_bit_cast(int, v);
#define DPP_ADD(ctrl, rmask) x = __builtin_bit_cast(int, __builtin_bit_cast(float, x) + __builtin_bit_cast(float, __builtin_amdgcn_update_dpp(0, x, ctrl, rmask, 0xF, false)))
    DPP_ADD(0xB1, 0xF);
    DPP_ADD(0x4E, 0xF);
    DPP_ADD(0x141, 0xF);
    DPP_ADD(0x140, 0xF);
    DPP_ADD(0x142, 0xA);
    DPP_ADD(0x143, 0xC);
#undef DPP_ADD
    return __builtin_bit_cast(float, __builtin_amdgcn_readlane(x, 63));
}
__device__ __forceinline__ float wave_sum(float v) {
#pragma unroll
    for (int o = 32; o >= 1; o >>= 1) v += __shfl_xor(v, o);
    return v;
}

__device__ __forceinline__ void p0_mod(const Frame& F) {
    const int tid = opaque_tid(F.wv0), lane = tid & 63, wave = __builtin_amdgcn_readfirstlane(tid >> 6); (void)lane; (void)wave;
    LAS float* sc = (LAS float*)F.lds;
    LAS float* red = (LAS float*)(F.lds + 20480);
    for (int i = tid; i < 5 * 1024; i += 512) { const int r = i >> 10, k = i & 1023; const float v = r < 4 ? INP(1)[r * 1024 + k] : INP(3)[k]; sc[i] = v / (1.f + expf(-v)); }
    __syncthreads();
    float* MOD = WSP(float, O_MOD);
    for (int u = blockIdx.x; u < 2 * 96; u += gridDim.x) { const int l = u / 96, j = (u % 96) * 64 + lane;
        const float* w = INP(4) + (size_t)l * 1024 * 6144 + j; float a0 = 0.f, a1 = 0.f, a2 = 0.f, a3 = 0.f, a4 = 0.f;
#pragma unroll 8
        for (int kk = 0; kk < 128; ++kk) { const int k = wave * 128 + kk; const float wv = w[(size_t)k * 6144]; a0 += sc[k] * wv; a1 += sc[1024 + k] * wv; a2 += sc[2048 + k] * wv; a3 += sc[3072 + k] * wv; a4 += sc[4096 + k] * wv; }
        red[(wave * 5 + 0) * 64 + lane] = a0; red[(wave * 5 + 1) * 64 + lane] = a1; red[(wave * 5 + 2) * 64 + lane] = a2; red[(wave * 5 + 3) * 64 + lane] = a3; red[(wave * 5 + 4) * 64 + lane] = a4;
        __syncthreads();
        if (tid < 320) { const int r = tid >> 6, ln = tid & 63; float s = 0.f;
#pragma unroll
            for (int w8 = 0; w8 < 8; ++w8) s += red[(w8 * 5 + r) * 64 + ln];
            const int jj = (u % 96) * 64 + ln; MOD[(size_t)(l * 5 + r) * 6144 + jj] = s + INP(5)[l * 6144 + jj]; }
        __syncthreads();
    }
}
__device__ __forceinline__ void p0_tables(const Frame& F) {
    const int tid = opaque_tid(F.wv0), lane = tid & 63, wave = __builtin_amdgcn_readfirstlane(tid >> 6); (void)lane; (void)wave;
    float* ropa_c = WSP(float, O_ROPA_C); float* ropa_s = WSP(float, O_ROPA_S); float* ropc_c = WSP(float, O_ROPC_C); float* ropc_s = WSP(float, O_ROPC_S); float* LB = WSP(float, O_LB);
    for (int i = blockIdx.x * 512 + tid; i < 8192 * 32; i += gridDim.x * 512) {
        { const int t = i >> 5, j = i & 31, row = t >> 6, col = t & 63, f = j & 15; const float inv = powf(10000.f, -(float)f / 16.f); const float ang = (j < 16 ? (float)row : (float)col) * inv;
          ropa_c[i] = (float)cos((double)ang); ropa_s[i] = (float)sin((double)ang); }
        if (i < 8192 * 16) { const int t = i >> 4, j = i & 15, row = t >> 6, col = t & 63, f = j & 7; const float inv = powf(10000.f, -(float)f / 8.f); const float ang = (j < 8 ? (float)row : (float)col) * inv;
          ropc_c[i] = (float)cos((double)ang); ropc_s[i] = (float)sin((double)ang); }
        for (int i2 = i; i2 < 2 * 256 * 1024; i2 += 8192 * 32) { const int l = i2 >> 18, pp = (i2 >> 10) & 255, k = i2 & 1023;
          const int bj = pp >> 7, wc = (pp >> 5) & 3, n = (pp >> 4) & 1, fq = (pp >> 2) & 3, e = pp & 3; float v = 0.f;
          if (wc == 0) { if (bj == 0) v = INP(19)[(size_t)l * 1024 * 32 + k * 32 + fq * 8 + 4 * n + e]; else if (n == 0 && e == 0) v = INP(18)[(size_t)l * 1024 * 4 + k * 4 + fq]; }
          WSP(bf16_t, O_WRB)[i2] = f2bf(v); }
        if (i < 2048) { const int l = i >> 10, rest = i & 1023; if (l == 0) LB[i] = 0.f; else { const float a0 = INP(10)[rest], a1 = INP(10)[1024 + rest]; LB[i] = 1.f / (1.f + expf(a0 - a1)); } }
    }
}
template <class CM> __device__ __forceinline__ void wt_tile(const float* W, int ldw, const CM& cm, bf16_t* Bt, int K, int p0, int k0, LAS float* scr, int lane) {
    const int p4 = (lane & 7) * 4; const int c = cm(p0 + p4);
#pragma unroll
    for (int i = 0; i < 8; ++i) { const int kk = i * 8 + (lane >> 3); f32x4 v = (f32x4){0.f, 0.f, 0.f, 0.f};
        if (c >= 0) v = *(const f32x4*)(W + (size_t)(k0 + kk) * ldw + c);
        scr[kk * 33 + p4] = v[0]; scr[kk * 33 + p4 + 1] = v[1]; scr[kk * 33 + p4 + 2] = v[2]; scr[kk * 33 + p4 + 3] = v[3]; }
    asm volatile("s_waitcnt lgkmcnt(0)" ::: "memory"); __builtin_amdgcn_wave_barrier();
#pragma unroll 8
    for (int pi = 0; pi < 32; ++pi) Bt[(size_t)(p0 + pi) * K + k0 + lane] = f2bf(scr[lane * 33 + pi]);
    asm volatile("s_waitcnt lgkmcnt(0)" ::: "memory"); __builtin_amdgcn_wave_barrier();
}
struct CmWin { __device__ __forceinline__ int operator()(int p) const { return colmap(MAP_WIN, p); } };
struct CmId { __device__ __forceinline__ int operator()(int p) const { return p; } };
__device__ __forceinline__ void conv_weights_nonmoe(const Frame& F, int l) {
    const int tid = opaque_tid(F.wv0), lane = tid & 63, wave = __builtin_amdgcn_readfirstlane(tid >> 6); (void)lane; (void)wave;
    LAS float* scr = (LAS float*)F.lds + wave * (64 * 33);
    const int gw = blockIdx.x * 8 + wave, NGW = gridDim.x * 8;
    constexpr int I_WIN = 216 * 16, I_BR = 3 * 32 * 8, I_OUT = 32 * 16;
    for (int it = gw; it < I_WIN + I_BR + I_OUT; it += NGW) {
        int r = it;
        if (r < I_WIN) { wt_tile(INP(8) + (size_t)l * 1024 * INW, INW, CmWin(), WSP(bf16_t, O_WINP), 1024, (r / 16) * 32, (r % 16) * 64, scr, lane); continue; } r -= I_WIN;
        if (r < I_BR) { const int n = r / 256, q = r % 256; wt_tile(INP(16) + ((size_t)l * 3 + n) * 512 * 1024, 1024, CmId(), WSP(bf16_t, O_WBR) + (size_t)n * 1024 * 512, 512, (q / 8) * 32, (q % 8) * 64, scr, lane); continue; } r -= I_BR;
        wt_tile(INP(17) + (size_t)l * 1024 * 1024, 1024, CmId(), WSP(bf16_t, O_WOUT), 1024, (r / 16) * 32, (r % 16) * 64, scr, lane);
    }
    const float* wuq = INP(14) + (size_t)l * 256 * 768; const float* wukv = INP(15) + (size_t)l * 128 * 1024; const float* gq = INP(12) + l * 256; const float* gkv = INP(13) + l * 128; bf16_t* WC = WSP(bf16_t, O_WC);
    for (int i = blockIdx.x * 512 + tid; i < 1792 * 384; i += gridDim.x * 512) {
        const int pp = i / 384, k = i % 384; float v = 0.f;
        if (pp < 768) { const int pn = pp >> 8, q = pp & 255, bj = q >> 7, wc = (q >> 5) & 3, j = q & 31; const int gi = pn * 8 + bj * 4 + wc, head = gi / 3, part = gi - head * 3;
            const int p = part < 2 ? head * 96 + part * 32 + j : head * 96 + 64 + 16 * ((j >> 2) & 1) + 4 * (j >> 3) + (j & 3);
            if (k < 256) v = wuq[k * 768 + p] * gq[k]; }
        else { if (k >= 256) v = wukv[(k - 256) * 1024 + (pp - 768)] * gkv[k - 256]; }
        WC[i] = f2bf(v); }
}
struct CmUp { __device__ __forceinline__ int operator()(int p) const { return ((p >> 8) << 7) + (p & 127); } };
__device__ __forceinline__ void conv_weights_moe(const Frame& F, int l) {
    const int tid = opaque_tid(F.wv0), lane = tid & 63, wave = __builtin_amdgcn_readfirstlane(tid >> 6); (void)lane; (void)wave;
    LAS float* scr = (LAS float*)F.lds + wave * (64 * 33);
    const int gw = blockIdx.x * 8 + wave, NGW = gridDim.x * 8;
    constexpr int I_UP = 32 * 16 * 16, I_DN = 32 * 32 * 4;
    for (int it = gw; it < I_UP + I_DN; it += NGW) {
        int r = it;
        if (r < I_UP) { const int e = r / 256, q = r % 256, p0 = (q / 16) * 32, k0 = (q % 16) * 64; const bool isw3 = (p0 >> 7) & 1;
            const float* W = (isw3 ? INP(21) : INP(20)) + ((size_t)l * 32 + e) * 1024 * 256;
            wt_tile(W, 256, CmUp(), WSP(bf16_t, O_WUP) + (size_t)e * 512 * 1024, 1024, p0, k0, scr, lane); continue; } r -= I_UP;
        { const int e = r / 128, q = r % 128; wt_tile(INP(22) + ((size_t)l * 32 + e) * 256 * 1024, 1024, CmId(), WSP(bf16_t, O_WDN) + (size_t)e * 1024 * 256, 256, (q / 4) * 32, (q % 4) * 64, scr, lane); }
    }
}

__device__ __forceinline__ void rp_load(const float* xs, float* xd, bool wx, const bf16_t* ym, const float* gt, int lane, f32x4 (&v)[4], float& rinv) {
    float ss = 0.f;
#pragma unroll
    for (int j = 0; j < 4; ++j) { const int c = 4 * lane + 256 * j; v[j] = *(const f32x4*)(xs + c);
        if (ym) { const uint2 y0 = *(const uint2*)(ym + c), y1 = *(const uint2*)(ym + 1024 + c); const f32x4 g4 = *(const f32x4*)(gt + c);
            v[j][0] += g4[0] * (bflo(y0.x) + bflo(y1.x)); v[j][1] += g4[1] * (bfhi(y0.x) + bfhi(y1.x)); v[j][2] += g4[2] * (bflo(y0.y) + bflo(y1.y)); v[j][3] += g4[3] * (bfhi(y0.y) + bfhi(y1.y)); }
        if (wx) *(f32x4*)(xd + c) = v[j];
        ss += v[j][0] * v[j][0] + v[j][1] * v[j][1] + v[j][2] * v[j][2] + v[j][3] * v[j][3]; }
    rinv = rsqrtf(wave_sum(ss) * (1.f / D) + EPS);
}
__device__ __forceinline__ void rp_mod(const f32x4 (&v)[4], float rinv, const float* gn, const float* mo, int sh_off, int sc_off, bf16_t* hp, int lane, f32x4 (&hv)[4]) {
#pragma unroll
    for (int j = 0; j < 4; ++j) { const int c = 4 * lane + 256 * j; const f32x4 g4 = *(const f32x4*)(gn + c), s4 = *(const f32x4*)(mo + sc_off + c), h4 = *(const f32x4*)(mo + sh_off + c);
        hv[j] = v[j] * rinv * g4 * (s4 + 1.f) + h4;
        *(uint2*)(hp + c) = make_uint2(pkbf(hv[j][0], hv[j][1]), pkbf(hv[j][2], hv[j][3])); }
}
__device__ __forceinline__ void phase_rowpass1(const Frame& F, int l, bool combine, size_t h_off) {
    const int tid = opaque_tid(F.wv0), lane = tid & 63, wave = __builtin_amdgcn_readfirstlane(tid >> 6); (void)lane; (void)wave;
    const int gw = blockIdx.x * 8 + wave, NGW = gridDim.x * 8;
    const float* xl = (l == 0) ? INP(0) : F.out; const float* xc = (l == 0) ? INP(2) : WSP(float, O_XC);
    const float* MODl = WSP(float, O_MOD) + (size_t)l * 5 * 6144; const float* MODp = WSP(float, O_MOD);
    for (int g = gw; g < G; g += NGW) { const RowInfo ri = rowinfo(g); const int mrow = ri.lat ? ri.b : 4; const size_t xo = xoff(ri);
        const float* xs = (ri.lat ? xl : xc) + xo; float* xd = (ri.lat ? F.out : WSP(float, O_XC)) + xo;
        f32x4 v[4], hv[4]; float rinv;
        rp_load(xs, xd, combine, combine ? WSP(bf16_t, O_YM2) + (size_t)g * 2048 : nullptr, MODp + (size_t)mrow * 6144 + 5120, lane, v, rinv);
        rp_mod(v, rinv, INP(6) + l * 1024, MODl + (size_t)mrow * 6144, 0, 1024, WSP(bf16_t, h_off) + (size_t)g * D, lane, hv); }
}
__device__ __forceinline__ void phase_rowpass2(const Frame& F, int l, bool last) {
    const int tid = opaque_tid(F.wv0), lane = tid & 63, wave = __builtin_amdgcn_readfirstlane(tid >> 6);
    { int* perm = WSP(int, O_PERM); unsigned* goff = WSP(unsigned, O_GOFF);
      for (int i = blockIdx.x * 512 + tid; i < PMAX; i += gridDim.x * 512) { perm[i] = -1; goff[i] = 0u; } }
    const int gw = blockIdx.x * 8 + wave, NGW = gridDim.x * 8;
    const float* MODl = WSP(float, O_MOD) + (size_t)l * 5 * 6144;
    for (int g = gw; g < G; g += NGW) { const RowInfo ri = rowinfo(g); if (last && !ri.lat) continue;
        const int mrow = ri.lat ? ri.b : 4; const size_t xo = xoff(ri);
        const float* xs = (ri.lat ? F.out : WSP(float, O_XC)) + xo;
        f32x4 v[4], hv[4]; float rinv;
        rp_load(xs, nullptr, false, nullptr, nullptr, lane, v, rinv);
        rp_mod(v, rinv, INP(7) + l * 1024, MODl + (size_t)mrow * 6144, 3072, 4096, WSP(bf16_t, O_H) + (size_t)g * D, lane, hv); }
}
struct EpiRoute {
    static constexpr bool PERM = false;
    int* route_e; float* route_w; LAS int* hist;
    __device__ __forceinline__ void operator()(const f32x4 (&acc)[2][2][4][2], const gp::GUnit& u, int wr, int wc, int fr, int fq) const {
        if (wc != 0) return;
#pragma unroll
        for (int ai = 0; ai < 2; ++ai)
#pragma unroll
            for (int m = 0; m < 4; ++m) { const int row = u.pm * 256 + ai * 128 + wr * 64 + m * 16 + fr;
                float el[8];
#pragma unroll
                for (int e = 0; e < 4; ++e) { el[e] = acc[ai][0][m][0][e]; el[4 + e] = acc[ai][0][m][1][e]; }
                const float gl = acc[ai][1][m][0][0];
                int i0 = 0; float m0 = el[0];
#pragma unroll
                for (int j = 1; j < 8; ++j) if (el[j] > m0) { m0 = el[j]; i0 = j; }
                int i1 = -1; float m1 = -3.4e38f;
#pragma unroll
                for (int j = 0; j < 8; ++j) if (j != i0 && el[j] > m1) { m1 = el[j]; i1 = j; }
                float gmax = gl; int gidx = fq;
#pragma unroll
                for (int off = 16; off <= 32; off <<= 1) { const float og = __shfl_xor(gmax, off); const int oi = __shfl_xor(gidx, off); if (og > gmax || (og == gmax && oi < gidx)) { gmax = og; gidx = oi; } }
                float gs = expf(gl - gmax); gs += __shfl_xor(gs, 16); gs += __shfl_xor(gs, 32);
                if (fq == gidx) { const float gwt = 1.f / gs, p1 = expf(m1 - m0); const int e0 = fq * 8 + i0, e1 = fq * 8 + i1;
                    route_e[row * 2] = e0; route_e[row * 2 + 1] = e1; route_w[row * 2] = gwt / (1.f + p1); route_w[row * 2 + 1] = gwt * p1 / (1.f + p1);
                    __hip_atomic_fetch_add(hist + e0, 1, __ATOMIC_RELAXED, __HIP_MEMORY_SCOPE_WORKGROUP); __hip_atomic_fetch_add(hist + e1, 1, __ATOMIC_RELAXED, __HIP_MEMORY_SCOPE_WORKGROUP); } }
    }
};
__device__ __forceinline__ void phase_final(const Frame& F) {
    const int tid = opaque_tid(F.wv0), lane = tid & 63, wave = __builtin_amdgcn_readfirstlane(tid >> 6); (void)lane; (void)wave;
    const int gw = blockIdx.x * 8 + wave, NGW = gridDim.x * 8; const float* MOD1 = WSP(float, O_MOD) + (size_t)5 * 6144;
    for (int lr = gw; lr < NB * SEQ; lr += NGW) { const int b = lr / SEQ, t = lr - b * SEQ; const int g = b * RPB + t; float* xp = F.out + (size_t)lr * D;
        f32x4 v[4]; float rinv; rp_load(xp, nullptr, false, WSP(bf16_t, O_YM2) + (size_t)g * 2048, MOD1 + (size_t)b * 6144 + 5120, lane, v, rinv);
#pragma unroll
        for (int j = 0; j < 4; ++j) { const int c = 4 * lane + 256 * j; const f32x4 g4 = *(const f32x4*)(INP(23) + c); *(f32x4*)(xp + c) = v[j] * rinv * g4; } }
}
__device__ __forceinline__ void phase_moe_scatter(const Frame& F, int l, bool last) {
    const int tid = opaque_tid(F.wv0), lane = tid & 63, wave = __builtin_amdgcn_readfirstlane(tid >> 6);
    LAS int* tot = (LAS int*)F.lds; LAS int* bef = tot + 512; LAS int* base = tot + 1024; LAS int* lcur = tot + 1056;
    const int* WGH = WSP(int, O_WGH) + (size_t)l * 256 * 32; const int nwg = gridDim.x, me = blockIdx.x;
    { const int e = tid & 31, part = tid >> 5; int sa = 0, sb = 0;
      for (int w = part * 16; w < part * 16 + 16 && w < nwg; ++w) { const int c = WGH[w * 32 + e]; sa += c; if (w < me) sb += c; }
      tot[part * 32 + e] = sa; bef[part * 32 + e] = sb; }
    __syncthreads();
    int sa2 = 0, sb2 = 0;
    if (tid < 32) {
#pragma unroll
        for (int part = 0; part < 16; ++part) { sa2 += tot[part * 32 + tid]; sb2 += bef[part * 32 + tid]; } }
    __syncthreads();
    if (tid < 32) { tot[tid] = sa2; bef[tid] = sb2; lcur[tid] = 0; }
    __syncthreads();
    if (tid == 0) { int o = 0; int* tile_e = WSP(int, O_TILEE);
#pragma clang loop unroll(disable) vectorize(disable)
        for (int e = 0; e < 32; ++e) { base[e] = o + bef[e]; const int n = (tot[e] + 255) & ~255;
            if (me == 0) {
#pragma clang loop unroll(disable) vectorize(disable)
                for (int t = o >> 8; t < (o + n) >> 8; ++t) tile_e[t] = e; }
            o += n; }
        if (me == 0) tile_e[NTILE] = o >> 8; }
    __syncthreads();
    const int* route_e = WSP(int, O_ROUTE_E); const float* route_w = WSP(float, O_ROUTE_W); int* perm = WSP(int, O_PERM); float* posw = WSP(float, O_POSW); unsigned* goff = WSP(unsigned, O_GOFF);
    { int pmv, pn;
      if (gp::tile_order(0, (int)gridDim.x, (int)blockIdx.x, last ? 128 : 132, 1, pmv, pn)) { const int pm = last ? pmv + pmv / 32 : pmv; const int g = pm * 256 + (tid >> 1); const int i = g * 2 + (tid & 1);
          const int e = route_e[i]; const int pos = base[e] + __hip_atomic_fetch_add(lcur + e, 1, __ATOMIC_RELAXED, __HIP_MEMORY_SCOPE_WORKGROUP);
          perm[pos] = i; posw[pos] = route_w[i]; goff[pos] = (unsigned)g * 2048u; } }
    (void)lane; (void)wave;
}

#ifndef PROBE_DUP
#define PROBE_DUP 0
#endif
#ifndef PROBE_EXTRA_MASK
#define PROBE_EXTRA_MASK 0ull
#endif
#define DUP(bit) for (int rep_ = 0; rep_ < (((PROBE_DUP) >> (bit)) & 1) + 1; ++rep_)
__global__ void __launch_bounds__(512, 2) hybrid_trunk_fwd(KP p) {
    extern __shared__ __attribute__((aligned(16))) unsigned char dynlds[];
    Frame F; F.lds = (LAS char*)dynlds; F.ws = p.ws; F.out = p.out; F.wv0 = __builtin_amdgcn_readfirstlane((int)(threadIdx.x >> 6));
    if (threadIdx.x == 0) { LAS unsigned long long* pp = (LAS unsigned long long*)(F.lds + LDS_PTR_OFF);
        pp[0] = (unsigned long long)p.in[0];
        pp[1] = (unsigned long long)p.in[1];
        pp[2] = (unsigned long long)p.in[2];
        pp[3] = (unsigned long long)p.in[3];
        pp[4] = (unsigned long long)p.in[4];
        pp[5] = (unsigned long long)p.in[5];
        pp[6] = (unsigned long long)p.in[6];
        pp[7] = (unsigned long long)p.in[7];
        pp[8] = (unsigned long long)p.in[8];
        pp[9] = (unsigned long long)p.in[9];
        pp[10] = (unsigned long long)p.in[10];
        pp[11] = (unsigned long long)p.in[11];
        pp[12] = (unsigned long long)p.in[12];
        pp[13] = (unsigned long long)p.in[13];
        pp[14] = (unsigned long long)p.in[14];
        pp[15] = (unsigned long long)p.in[15];
        pp[16] = (unsigned long long)p.in[16];
        pp[17] = (unsigned long long)p.in[17];
        pp[18] = (unsigned long long)p.in[18];
        pp[19] = (unsigned long long)p.in[19];
        pp[20] = (unsigned long long)p.in[20];
        pp[21] = (unsigned long long)p.in[21];
        pp[22] = (unsigned long long)p.in[22];
        pp[23] = (unsigned long long)p.in[23];
    }
    LAS unsigned char* glds = (LAS unsigned char*)dynlds;
    volatile LAS unsigned* barst = (volatile LAS unsigned*)(F.lds + LDS_BAR_OFF);
    if (threadIdx.x < 16) ((LAS unsigned*)(F.lds + LDS_BAR_OFF))[threadIdx.x] = 0u;
    __syncthreads();
    const bool multi = (p.ph_hi - p.ph_lo) > 1;
    XcdBarrier bar; bar.bar = (unsigned*)F.ws; bar.x = 0; bar.st = nullptr;
    if (multi) bar = xcd_barrier_post((unsigned*)F.ws, barst);
    int ph = 0;
#define PH_BEGIN if (ph >= p.ph_lo && ph < p.ph_hi && (p.mask == 0ull || ((p.mask >> ph) & 1ull))) {
#define PH_END   if (ph + 1 < p.ph_hi) xcd_barrier(bar); else __syncthreads(); } ++ph;
    const int Gd = gridDim.x, cb = blockIdx.x;

    PH_BEGIN p0_mod(F); p0_tables(F); __syncthreads(); conv_weights_nonmoe(F, 0); PH_END

    for (int l = 0; l < 2; ++l) {
        const bool last = (l == 1);
        const float* MODl = WSP(float, O_MOD) + (size_t)l * 5 * 6144;
        PH_BEGIN phase_rowpass1(F, l, l > 0, O_H); PH_END
        PH_BEGIN
        { SchedStd S{}; S.A = WSP(bf16_t, O_H); S.Bt = WSP(bf16_t, O_WINP); S.K = 1024; S.nM = 132; S.nN = 15; S.G_ = Gd; S.c = cb; S.skipctx = 0; S.lda2 = 2048; S.ldb2 = 2048;
          EpiG1 E{}; E.AQ = WSP(bf16_t, O_AQ); E.AK = WSP(bf16_t, O_AK); E.AV = WSP(bf16_t, O_AV); E.BQ = WSP(bf16_t, O_BQ); E.BV = WSP(bf16_t, O_BV); E.BG = WSP(bf16_t, O_BG); E.BLF = WSP(f16_t, O_BLF); E.BLB = WSP(f16_t, O_BLB);
          E.CQKV = WSP(bf16_t, O_CQKV); E.CKR = WSP(bf16_t, O_CKR); E.RS = WSP(float, O_RS); E.ropa_c = WSP(float, O_ROPA_C); E.ropa_s = WSP(float, O_ROPA_S); E.ropc_c = WSP(float, O_ROPC_C); E.ropc_s = WSP(float, O_ROPC_S);
          E.LBl = WSP(float, O_LB) + l * 1024; E.rowoff = 0;
          DUP(0) gp::gemm_phase<EpiG1, SchedStd>(glds, S, E, F.wv0); }
        PH_END
        PH_BEGIN
        { SchedStd S{}; S.A = WSP(bf16_t, O_CQKV); S.Bt = WSP(bf16_t, O_WC); S.K = 384; S.nM = 132; S.nN = 7; S.G_ = Gd; S.c = cb; S.skipctx = 0; S.lda2 = 768; S.ldb2 = 768;
          EpiC E{}; E.CQ = WSP(bf16_t, O_CQ); E.CKV = WSP(bf16_t, O_CKV); E.RS = WSP(float, O_RS); E.ropc_c = WSP(float, O_ROPC_C); E.ropc_s = WSP(float, O_ROPC_S); E.pmoff = 0;
          DUP(1) gp::gemm_phase<EpiC, SchedStd>(glds, S, E, F.wv0); }
        __syncthreads();
        { AttnArgs a{}; a.Q = WSP(bf16_t, O_AQ); a.qld = 512; a.qhs = 64; a.K1 = WSP(bf16_t, O_AK); a.k1ld = 128; a.k1hs = 64; a.kvgroup = 4; a.K2 = nullptr; a.k2ld = 0; a.V = WSP(bf16_t, O_AV); a.vld = 128; a.vhs = 64;
          a.O = WSP(bf16_t, O_AQ); a.old = 512; a.ohs = 64; a.scale_l2 = 0.125f * LOG2E; a.sink = INP(9) + l * 8; a.window = 128;
          const int nqb = last ? 32 : 33;
          DUP(10) for (int u = cb; u < NB * 8 * nqb; u += Gd) { int b, h, qb; if (u < NB * 8 * 32) { b = u >> 8; h = u & 7; qb = (u >> 3) & 31; }     else { const int r_ = u - NB * 8 * 32; b = r_ >> 3; h = r_ & 7; qb = 32; }
              attn_unit<64>(F.lds, a, F.wv0, b, qb, h, ((PROBE_DUP >> 10) & 1) && rep_ == 0); } }
        __syncthreads();
        { ScanArgs a{}; a.BQ = WSP(bf16_t, O_BQ); a.BV = WSP(bf16_t, O_BV); a.BG = WSP(bf16_t, O_BG); a.BLF = WSP(f16_t, O_BLF); a.BLB = WSP(f16_t, O_BLB); a.ST = WSP(bf16_t, O_H); a.DS = WSP(float, O_DS); a.OB = WSP(bf16_t, O_BQ); a.gn = INP(11) + l * 512;
          DUP(2) for (int u = cb; u < NB * 8 * NCHK; u += Gd) { const int b = u / (8 * NCHK), rem = u - b * 8 * NCHK, h = rem / NCHK, k = rem - h * NCHK; scan_s1_unit(F.lds, a, F.wv0, b, h, k); } }
        PH_END
        PH_BEGIN
        { ScanArgs a{}; a.ST = WSP(bf16_t, O_H); a.DS = WSP(float, O_DS);
          for (int t = cb; t < NB * 8 * 2 * 4; t += Gd) scan_s2_task(a, F.wv0, t); }
        { AttnArgs a{}; a.Q = WSP(bf16_t, O_CQ); a.qld = 768; a.qhs = 96; a.K1 = WSP(bf16_t, O_CKV); a.k1ld = 1024; a.k1hs = 128; a.kvgroup = 1; a.K2 = WSP(bf16_t, O_CKR); a.k2ld = 32; a.V = WSP(bf16_t, O_CKV) + 64; a.vld = 1024; a.vhs = 128;
          a.O = WSP(bf16_t, O_OC); a.old = 512; a.ohs = 64; a.scale_l2 = 0.10206207261596577f * LOG2E; a.sink = nullptr; a.window = 0; a.pad = (PROBE_VARIANT && p.mask != 0ull) ? 1 : 0;
          const int nqb = last ? 32 : 33;
          DUP(3) for (int u = cb; u < NB * 8 * nqb; u += Gd) { int b, h, qb; if (u < NB * 8 * 32) { b = u >> 8; h = u & 7; qb = (u >> 3) & 31; }     else { const int r_ = u - NB * 8 * 32; b = r_ >> 3; h = r_ & 7; qb = 32; }
              attn_unit<96>(F.lds, a, F.wv0, b, qb, h); } }
        PH_END
        PH_BEGIN
        { ScanArgs a{}; a.BQ = WSP(bf16_t, O_BQ); a.BV = WSP(bf16_t, O_BV); a.BG = WSP(bf16_t, O_BG); a.BLF = WSP(f16_t, O_BLF); a.BLB = WSP(f16_t, O_BLB); a.ST = WSP(bf16_t, O_H); a.DS = WSP(float, O_DS); a.OB = WSP(bf16_t, O_BQ); a.gn = INP(11) + l * 512; a.skipctx_out = last ? 1 : 0;
          DUP(9) { a.pad = (((PROBE_DUP >> 9) & 1) && rep_ == 0) ? 1 : 0; for (int u = cb; u < NB * 8 * NCHK; u += Gd) { const int b = u / (8 * NCHK), rem = u - b * 8 * NCHK, h = rem / NCHK, k = rem - h * NCHK; scan_s3_unit(F.lds, a, F.wv0, b, h, k); } } }
        phase_rowpass1(F, l, false, O_CKV);
        PH_END
        PH_BEGIN
        { SchedStd S{}; S.A = WSP(bf16_t, O_CKV); S.Bt = WSP(bf16_t, O_WINP) + (size_t)3840 * 1024; S.K = 1024; S.nM = last ? 128 : 132; S.nN = 12; S.G_ = Gd; S.c = cb; S.skipctx = last ? 1 : 0; S.lda2 = 2048; S.ldb2 = 2048;
          EpiGate E{}; E.GATE = WSP(bf16_t, O_GATE); E.nstride = (long)G * 1024; E.ld = 1024;
          DUP(5) gp::gemm_phase<EpiGate, SchedStd>(glds, S, E, F.wv0); }
        PH_END
        PH_BEGIN
        { SchedMerge S{}; S.A0 = WSP(bf16_t, O_AQ); S.A1 = WSP(bf16_t, O_BQ); S.A2 = WSP(bf16_t, O_OC); S.Bt = WSP(bf16_t, O_WBR); S.nM = last ? 128 : 132; S.G_ = Gd; S.c = cb; S.skipctx = last ? 1 : 0; S.lda2 = 1024; S.ldb2 = 1024;
          EpiMerge E{}; E.GATE = WSP(bf16_t, O_GATE); E.nstride = (long)G * 1024; E.ld = (PROBE_VARIANT == 3 && p.mask != 0ull) ? -1 : 1024;
          gp::gemm_phase<EpiMerge, SchedMerge>(glds, S, E, F.wv0); }
        PH_END
        PH_BEGIN
        { const int tid_ = opaque_tid(F.wv0), lane_ = tid_ & 63, wave_ = __builtin_amdgcn_readfirstlane(tid_ >> 6); const bf16_t* U = WSP(bf16_t, O_GATE); bf16_t* Y = WSP(bf16_t, O_H);
          for (int g = cb * 8 + wave_; g < G; g += Gd * 8) { if (last && (g % RPB) >= SEQ) continue;
#pragma unroll
              for (int j = 0; j < 2; ++j) { const size_t o = (size_t)g * 1024 + 8 * lane_ + 512 * j;
                  const u32x4 a = *(const u32x4*)(U + o), b2 = *(const u32x4*)(U + (size_t)G * 1024 + o), c2 = *(const u32x4*)(U + (size_t)2 * G * 1024 + o);
                  u32x4 w; w.x = pkbf(bflo(a.x) + bflo(b2.x) + bflo(c2.x), bfhi(a.x) + bfhi(b2.x) + bfhi(c2.x)); w.y = pkbf(bflo(a.y) + bflo(b2.y) + bflo(c2.y), bfhi(a.y) + bfhi(b2.y) + bfhi(c2.y));
                  w.z = pkbf(bflo(a.z) + bflo(b2.z) + bflo(c2.z), bfhi(a.z) + bfhi(b2.z) + bfhi(c2.z)); w.w = pkbf(bflo(a.w) + bflo(b2.w) + bflo(c2.w), bfhi(a.w) + bfhi(b2.w) + bfhi(c2.w));
                  *(u32x4*)(Y + o) = w; } } }
        PH_END
        PH_BEGIN
        { SchedStd S{}; S.A = WSP(bf16_t, O_H); S.Bt = WSP(bf16_t, O_WOUT); S.K = 1024; S.nM = last ? 128 : 132; S.nN = 4; S.G_ = Gd; S.c = cb; S.skipctx = last ? 1 : 0; S.lda2 = 2048; S.ldb2 = 2048;
          EpiOut E{}; E.xl_src = l == 0 ? INP(0) : F.out; E.xc_src = l == 0 ? INP(2) : WSP(float, O_XC); E.xl_dst = F.out; E.xc_dst = WSP(float, O_XC); E.mod = MODl; E.pmoff = 0;
          gp::gemm_phase<EpiOut, SchedStd>(glds, S, E, F.wv0); }
        PH_END
        PH_BEGIN phase_rowpass2(F, l, last); PH_END
        PH_BEGIN
        { LAS int* hist = (LAS int*)(F.lds + 131072); const int t_ = opaque_tid(F.wv0);
          if (t_ < 32) hist[t_] = 0;
          __syncthreads();
          SchedStd S{}; S.A = WSP(bf16_t, O_H); S.Bt = WSP(bf16_t, O_WRB) + (size_t)l * 256 * 1024; S.K = 1024; S.nM = last ? 128 : 132; S.nN = 1; S.G_ = Gd; S.c = cb; S.skipctx = last ? 1 : 0; S.lda2 = 2048; S.ldb2 = 2048;
          EpiRoute E{}; E.route_e = WSP(int, O_ROUTE_E); E.route_w = WSP(float, O_ROUTE_W); E.hist = hist;
          gp::gemm_phase<EpiRoute, SchedStd>(glds, S, E, F.wv0);
          __syncthreads();
          { const int t2_ = opaque_tid(F.wv0); if (t2_ < 32) WSP(int, O_WGH)[((size_t)l * 256 + cb) * 32 + t2_] = hist[t2_]; }
          __syncthreads(); }
        conv_weights_moe(F, l); if (!last) conv_weights_nonmoe(F, l + 1);
        PH_END
        PH_BEGIN phase_moe_scatter(F, l, last); PH_END
        PH_BEGIN
        { SchedMoE<true> S{}; S.A = WSP(bf16_t, O_H); S.Bt = WSP(bf16_t, O_WUP); S.tile_e = WSP(int, O_TILEE); S.goff = WSP(unsigned, O_GOFF); S.K = 1024; S.nM = WSP(int, O_TILEE)[NTILE]; S.nN = 2; S.G_ = Gd; S.c = cb; S.lda2 = 2048; S.ldb2 = 2048; S.strideB = 512 * 1024;
          EpiUp E{}; E.AUP = WSP(bf16_t, O_AUP);
          DUP(7) gp::gemm_phase<EpiUp, SchedMoE<true>>(glds, S, E, F.wv0); }
        PH_END
        PH_BEGIN
        { SchedMoE<false> S{}; S.A = WSP(bf16_t, O_AUP); S.Bt = WSP(bf16_t, O_WDN); S.tile_e = WSP(int, O_TILEE); S.goff = nullptr; S.K = 256; S.nM = WSP(int, O_TILEE)[NTILE]; S.nN = 4; S.G_ = Gd; S.c = cb; S.lda2 = 512; S.ldb2 = 512; S.strideB = 1024 * 256;
          EpiDown E{}; E.YM2 = WSP(bf16_t, O_YM2); E.perm = WSP(int, O_PERM); E.posw = WSP(float, O_POSW);
          DUP(8) gp::gemm_phase<EpiDown, SchedMoE<false>>(glds, S, E, F.wv0); }
        PH_END
    }
    PH_BEGIN phase_final(F); PH_END
#undef PH_BEGIN
#undef PH_END
}
constexpr int N_PHASES = 1 + 2 * 14 + 1;
}

#ifndef MK_N_LAUNCHES
#define MK_N_LAUNCHES 1
#endif
extern "C" void kernel_launch(void* const* d_in, const int* in_sizes, int n_in, void* d_out, int out_size, void* d_ws, size_t ws_size, hipStream_t stream) {
    static int grid = 0;
    if (grid == 0) {
        if (ws_size < WS_END) { grid = -1; return; }
        int dev = 0, cus = 0;
        if (hipGetDevice(&dev) != hipSuccess || hipDeviceGetAttribute(&cus, hipDeviceAttributeMultiprocessorCount, dev) != hipSuccess) { grid = -1; return; }
        if (hipFuncSetAttribute((const void*)hybrid_trunk_fwd, hipFuncAttributeMaxDynamicSharedMemorySize, LDS_BYTES) != hipSuccess) { grid = -1; return; }
        int per_cu = 0; (void)hipOccupancyMaxActiveBlocksPerMultiprocessor(&per_cu, (const void*)hybrid_trunk_fwd, 512, LDS_BYTES); (void)hipGetLastError();
        grid = cus;
    }
    if (grid < 0) return;
    (void)hipMemsetAsync(d_ws, 0, CTL_ZERO_BYTES, stream);
    KP p{}; for (int i = 0; i < 24; ++i) p.in[i] = (const float*)d_in[i]; p.out = (float*)d_out; p.ws = (char*)d_ws;
    (void)in_sizes; (void)n_in; (void)out_size;
    if (MK_N_LAUNCHES == 1) { p.ph_lo = 0; p.ph_hi = N_PHASES; hipLaunchKernelGGL(hybrid_trunk_fwd, dim3(grid), dim3(512), LDS_BYTES, stream, p);
        if (PROBE_EXTRA_MASK) { (void)hipMemsetAsync(d_ws, 0, CTL_ZERO_BYTES, stream); p.mask = PROBE_EXTRA_MASK; hipLaunchKernelGGL(hybrid_trunk_fwd, dim3(grid), dim3(512), LDS_BYTES, stream, p); } }
    else { for (int k = 0; k < N_PHASES; ++k) { p.ph_lo = k; p.ph_hi = k + 1; hipLaunchKernelGGL(hybrid_trunk_fwd, dim3(grid), dim3(512), LDS_BYTES, stream, p); } }
}
```

```cpp
#include <hip/hip_runtime.h>
#include <stdint.h>
#include <math.h>

namespace {
typedef unsigned short bf16_t;
typedef _Float16 f16_t;
typedef short bf16x8 __attribute__((ext_vector_type(8)));
typedef short s16x4 __attribute__((ext_vector_type(4)));
typedef float f32x4 __attribute__((ext_vector_type(4)));
typedef float f32x16 __attribute__((ext_vector_type(16)));
typedef unsigned u32x4 __attribute__((ext_vector_type(4)));
#define LAS __attribute__((address_space(3)))

constexpr int D = 1024, NB = 4, SEQ = 8192, CTXL = 256, RPB = SEQ + CTXL, G = NB * RPB;
constexpr int INW = 6816, MIXW = 3744, GATEW = 3072;
constexpr float EPS = 1e-6f;
constexpr float LOG2E = 1.4426950408889634f;
constexpr int PMAX = 75776;
constexpr int NTILE = PMAX / 256;

__device__ __forceinline__ float bf2f(bf16_t v) { return __uint_as_float(((unsigned)v) << 16); }
__device__ __forceinline__ bf16_t f2bf(float f) { unsigned u = __float_as_uint(f); u += 0x7fffu + ((u >> 16) & 1u); return (bf16_t)(u >> 16); }
typedef float f32x2v __attribute__((ext_vector_type(2)));
typedef __bf16 bf16x2v __attribute__((ext_vector_type(2)));
__device__ __forceinline__ unsigned pkbf(float lo, float hi) { const f32x2v v = {lo, hi}; const bf16x2v b = __builtin_convertvector(v, bf16x2v); return __builtin_bit_cast(unsigned, b); }
__device__ __forceinline__ unsigned pk2(float lo, float hi) { return (unsigned)f2bf(lo) | ((unsigned)f2bf(hi) << 16); }
__device__ __forceinline__ float silu_f(float v) { return v / (1.f + expf(-v)); }
__device__ __forceinline__ float sigmoid_f(float v) { return 1.f / (1.f + expf(-v)); }
__device__ __forceinline__ int opaque_tid(int wv) { int t = (wv << 6) | (int)__builtin_amdgcn_mbcnt_hi(~0u, __builtin_amdgcn_mbcnt_lo(~0u, 0u)); asm volatile("" : "+v"(t)); return t; }
struct RowInfo { int b, r; bool lat; };
__device__ __forceinline__ RowInfo rowinfo(int g) { RowInfo ri; ri.b = g / RPB; ri.r = g - ri.b * RPB; ri.lat = ri.r < SEQ; return ri; }
__device__ __forceinline__ size_t xoff(const RowInfo& ri) { return ri.lat ? ((size_t)ri.b * SEQ + ri.r) * D : ((size_t)ri.b * CTXL + (ri.r - SEQ)) * D; }
__device__ __forceinline__ int crow(int r, int hi) { return (r & 3) + 8 * (r >> 2) + 4 * hi; }
__device__ __forceinline__ unsigned cvtpk(float lo, float hi) { return pkbf(lo, hi); }
typedef short v4i16_t __attribute__((ext_vector_type(4)));
__device__ __forceinline__ s16x4 vtr(const LAS char* p) { return __builtin_bit_cast(s16x4, __builtin_amdgcn_ds_read_tr16_b64_v4i16((LAS v4i16_t*)p)); }
#define MFMA32(a, b, c) __builtin_amdgcn_mfma_f32_32x32x16_bf16(a, b, c, 0, 0, 0)
#ifndef PROBE_VARIANT
#define PROBE_VARIANT 0
#endif
#if PROBE_VARIANT == 4
#define VTR_ASM(dst, addr, off) do { if (!p.pad) asm volatile("ds_read_b64_tr_b16 %0, %1 offset:" #off : "=v"(dst) : "v"(addr)); else asm volatile("" : "=v"(dst)); } while (0)
#else
#define VTR_ASM(dst, addr, off) asm volatile("ds_read_b64_tr_b16 %0, %1 offset:" #off : "=v"(dst) : "v"(addr))
#endif
struct AttnArgs { const bf16_t* Q; int qld, qhs; const bf16_t* K1; int k1ld, k1hs, kvgroup; const bf16_t* K2; int k2ld; const bf16_t* V; int vld, vhs;
                  bf16_t* O; int old, ohs; float scale_l2; const float* sink; int window; int pad; };
template <int DQK, int VAR = 0>
__device__ __forceinline__ void attn_unit(LAS char* lds, const AttnArgs& p, int wv0, int b, int qb, int h, bool nostore = false) {
    constexpr int NS = DQK / 16, NCH = DQK / 8; constexpr float THR = 8.f;
    constexpr int KB = 0, VB = 49152, WSF = 81920;
    const int tid = opaque_tid(wv0), lane = tid & 63, r32 = lane & 31, hi = lane >> 5, wid = tid >> 6;
    const int rb = b * RPB;
    const bool ctxq = (qb == 32);
    const int q0 = rb + (ctxq ? SEQ : qb * 256);
    int lat_k0 = 0, lat_k1 = 0;
    if (!ctxq) { if (p.window) { lat_k0 = qb * 256 - 128; if (lat_k0 < 0) lat_k0 = 0; lat_k1 = qb * 256 + 384; if (lat_k1 > SEQ) lat_k1 = SEQ; } else { lat_k0 = 0; lat_k1 = SEQ; } }
    const int ntiles = 4 + (lat_k1 - lat_k0) / 64;
    const int qrow = q0 + wid * 32 + r32;
    const int qpos = qb * 256 + wid * 32 + r32;
    const int wq0 = qb * 256 + wid * 32;
    LAS float* wsf = (LAS float*)(lds + WSF) + wid * 64;
    bf16x8 qr[NS];
#pragma unroll
    for (int s = 0; s < NS; ++s) qr[s] = *(const bf16x8*)(p.Q + (size_t)qrow * p.qld + h * p.qhs + 16 * s + 8 * hi);
    const int k1off = (h / p.kvgroup) * p.k1hs, voff = (h / p.kvgroup) * p.vhs;
    const int wv = __builtin_amdgcn_readfirstlane(wid);
    const bool k2nd = (NCH > 8) && (wv < NCH - 8);
    const size_t ksrc0 = (size_t)lane * p.k1ld + k1off + wv * 8, ksrc1 = (size_t)lane * p.k2ld + wv * 8;
    const size_t vsrc = (size_t)(16 * (wv & 3) + (lane >> 2)) * p.vld + voff + (wv >> 2) * 32 + (lane & 3) * 8;
#define AT_ROW0(it_) (rb + ((it_) >= 4 ? lat_k0 + 64 * ((it_) - 4) : SEQ + 64 * (it_)))
#define AT_DMAK(it_, slot_) do { if constexpr (VAR == 8) break; const size_t kr0_ = (size_t)AT_ROW0(it_); \
        __builtin_amdgcn_global_load_lds((const unsigned*)(p.K1 + kr0_ * p.k1ld + ksrc0), (LAS unsigned*)(lds + KB + (slot_) * 12288 + wv * 1024), 16, 0, 0); \
        if (k2nd) __builtin_amdgcn_global_load_lds((const unsigned*)(p.K2 + kr0_ * p.k2ld + ksrc1), (LAS unsigned*)(lds + KB + (slot_) * 12288 + (8 + wv) * 1024), 16, 0, 0); } while (0)
#define AT_DMAV(it_, slot_) do { if constexpr (VAR == 8) break; const size_t kr0_ = (size_t)AT_ROW0(it_); \
        __builtin_amdgcn_global_load_lds((const unsigned*)(p.V + kr0_ * p.vld + vsrc), (LAS unsigned*)(lds + VB + (slot_) * 8192 + wv * 1024), 16, 0, 0); } while (0)
#define AT_CLAMP(x_) ((x_) < ntiles ? (x_) : ntiles - 1)
#define AT_WAITBAR() do { if (k2nd) asm volatile("s_waitcnt vmcnt(6) lgkmcnt(0)" ::: "memory"); else asm volatile("s_waitcnt vmcnt(4) lgkmcnt(0)" ::: "memory"); if constexpr (VAR != 7) __builtin_amdgcn_s_barrier(); asm volatile("" ::: "memory"); } while (0)
#define AT_QK(C0, C1, slot_) do { const LAS char* ldsK_ = lds + KB + (slot_) * 12288 + hi * 1024 + r32 * 16; C0 = negm; C1 = negm; bf16x8 kf_[2 * NS]; \
        _Pragma("unroll") for (int s = 0; s < NS; ++s) { kf_[2 * s] = *(const LAS bf16x8*)(ldsK_ + s * 2048); kf_[2 * s + 1] = *(const LAS bf16x8*)(ldsK_ + s * 2048 + 512); } \
        __builtin_amdgcn_sched_group_barrier(0x100, 2 * NS, 0); \
        _Pragma("unroll") for (int s = 0; s < NS; ++s) { C0 = MFMA32(kf_[2 * s], qr[s], C0); C1 = MFMA32(kf_[2 * s + 1], qr[s], C1); } } while (0)
#define AT_REF(C0, C1, T_, first) do { const int tr_ = (T_); \
        if (p.window && tr_ >= 4) { const int kpos0 = lat_k0 + 64 * (tr_ - 4); \
            _Pragma("unroll") for (int r = 0; r < 16; ++r) { const int kp = kpos0 + crow(r, hi); int d0 = qpos - kp; if (d0 < 0) d0 = -d0; int d1 = qpos - (kp + 32); if (d1 < 0) d1 = -d1; \
                if (d0 > p.window) C0[r] = -1e30f; if (d1 > p.window) C1[r] = -1e30f; } } \
        if ((first) || (tr_ & 7) == 0) { \
        float mx = fmaxf(fmaxf(C0[0], C0[1]), C1[0]); \
        _Pragma("unroll") for (int r = 2; r < 16; r += 2) mx = fmaxf(fmaxf(mx, C0[r]), C0[r + 1]); \
        _Pragma("unroll") for (int r = 1; r < 15; r += 2) mx = fmaxf(fmaxf(mx, C1[r]), C1[r + 1]); \
        mx = fmaxf(mx, C1[15]); mx = fmaxf(mx, __shfl_xor(mx, 32)); \
        if ((first) || __any(mx > THR)) { const float dl = (first) ? mx : fmaxf(mx, 0.f); \
            m += dl; const float alpha = __builtin_amdgcn_exp2f(-dl); l *= alpha; \
            _Pragma("unroll") for (int r = 0; r < 16; ++r) { C0[r] -= dl; C1[r] -= dl; negm[r] = -m; } \
            if (hi == 0) wsf[r32] = alpha; \
            _Pragma("unroll") for (int r = 0; r < 16; ++r) { const float f = wsf[crow(r, hi)]; o0[r] *= f; o1[r] *= f; } } } } while (0)
    f32x16 o0, o1, negm, cA0, cA1, cB0, cB1;
#pragma unroll
    for (int r = 0; r < 16; ++r) { o0[r] = 0.f; o1[r] = 0.f; negm[r] = 0.f; }
    float m = 0.f, l = 0.f;
    const int vlane = ((lane >> 4) & 1) * 32 + (lane & 3) * 8 + (4 * hi + ((lane & 15) >> 2)) * 64;
    asm volatile("s_waitcnt vmcnt(0) lgkmcnt(0)" ::: "memory"); __builtin_amdgcn_s_barrier(); asm volatile("" ::: "memory");
    AT_DMAK(0, 0); AT_DMAV(0, 0); AT_DMAK(AT_CLAMP(1), 1); AT_DMAV(AT_CLAMP(1), 1); AT_DMAK(AT_CLAMP(2), 2); AT_DMAV(AT_CLAMP(2), 2); AT_DMAK(AT_CLAMP(3), 3);
    asm volatile("s_waitcnt vmcnt(0)" ::: "memory"); __builtin_amdgcn_s_barrier(); asm volatile("" ::: "memory");
    AT_QK(cA0, cA1, 0);
    AT_REF(cA0, cA1, 0, true);
    asm volatile("s_waitcnt lgkmcnt(0)" ::: "memory"); __builtin_amdgcn_s_barrier(); asm volatile("" ::: "memory");
#define AT_SB() __builtin_amdgcn_sched_barrier(0)
#define AT_PIN2(x, y) asm volatile("" : "+v"(x), "+v"(y))
#define AT_PIN1(x) asm volatile("" : "+v"(x))
#define AT_PINRS() asm volatile("" : "+v"(rs0), "+v"(rs1), "+v"(rs2), "+v"(rs3))
#define AT_LDK(dst, addr_, off) asm volatile("ds_read_b128 %0, %1 offset:" #off : "=v"(dst) : "v"(addr_))
#define AT_WAITK(n, a, b) asm volatile("s_waitcnt lgkmcnt(" #n ")" : "+v"(a), "+v"(b))
#define AT_WAITV8(n, a, b, c, d, e, f, g, h) asm volatile("s_waitcnt lgkmcnt(" #n ")" : "+v"(a), "+v"(b), "+v"(c), "+v"(d), "+v"(e), "+v"(f), "+v"(g), "+v"(h))
#define AT_WAITV4(n, a, b, c, d) asm volatile("s_waitcnt lgkmcnt(" #n ")" : "+v"(a), "+v"(b), "+v"(c), "+v"(d))
#define AT_EXP(X) do { if constexpr (VAR != 6) X = __builtin_amdgcn_exp2f(X); } while (0)
#define AT_STEP(C0, C1, N0, N1, T_) do { const int t_ = (T_); const int t1_ = t_ + 1 < ntiles ? t_ + 1 : ntiles - 1; \
        AT_DMAK(AT_CLAMP(t_ + 4), t_ & 3); AT_DMAV(AT_CLAMP(t_ + 3), (t_ + 3) & 3); \
        const unsigned kaddr_ = (unsigned)(size_t)(lds + KB + ((t_ + 1) & 3) * 12288 + hi * 1024 + r32 * 16); const unsigned vaddr_ = (unsigned)(size_t)(lds + VB + (t_ & 3) * 8192 + vlane); \
        bf16x8 kfa0, kfa1, kfb0, kfb1, kfc0, kfc1; bf16x8 vf_[8]; s16x4 ta_[16]; float rs0 = 0.f, rs1 = 0.f, rs2 = 0.f, rs3 = 0.f; u32x4 pw[4]; \
        AT_LDK(kfa0, kaddr_, 0); AT_LDK(kfa1, kaddr_, 512); AT_LDK(kfb0, kaddr_, 2048); AT_LDK(kfb1, kaddr_, 2560); AT_SB(); \
        if constexpr (NS == 6) { \
          AT_LDK(kfc0, kaddr_, 4096); AT_LDK(kfc1, kaddr_, 4608); AT_WAITK(4, kfa0, kfa1); N0 = MFMA32(kfa0, qr[0], negm); AT_PIN1(N0); AT_EXP(C0[0]); AT_EXP(C0[1]); AT_EXP(C0[2]);  VTR_ASM(ta_[0], vaddr_, 0); AT_SB(); \
          N1 = MFMA32(kfa1, qr[0], negm); AT_PIN1(N1); AT_EXP(C0[3]); AT_EXP(C0[4]); AT_EXP(C0[5]);  VTR_ASM(ta_[1], vaddr_, 512); VTR_ASM(ta_[2], vaddr_, 4096); AT_SB(); \
          AT_LDK(kfa0, kaddr_, 6144); AT_LDK(kfa1, kaddr_, 6656); AT_WAITK(7, kfb0, kfb1); N0 = MFMA32(kfb0, qr[1], N0); AT_PIN1(N0); AT_EXP(C0[6]); AT_EXP(C0[7]); AT_EXP(C0[8]); VTR_ASM(ta_[3], vaddr_, 4608); AT_SB(); \
          N1 = MFMA32(kfb1, qr[1], N1); AT_PIN1(N1); AT_EXP(C0[9]); AT_EXP(C0[10]); AT_EXP(C0[11]); VTR_ASM(ta_[4], vaddr_, 1024); VTR_ASM(ta_[5], vaddr_, 1536); AT_SB(); \
          AT_LDK(kfb0, kaddr_, 8192); AT_LDK(kfb1, kaddr_, 8704); AT_WAITK(10, kfc0, kfc1); N0 = MFMA32(kfc0, qr[2], N0); AT_PIN1(N0); AT_EXP(C0[12]); AT_EXP(C0[13]); AT_EXP(C0[14]); VTR_ASM(ta_[6], vaddr_, 5120); AT_SB(); \
          N1 = MFMA32(kfc1, qr[2], N1); AT_PIN1(N1); AT_EXP(C0[15]); AT_EXP(C1[0]); AT_EXP(C1[1]); VTR_ASM(ta_[7], vaddr_, 5632); VTR_ASM(ta_[8], vaddr_, 2048); AT_SB(); \
          AT_LDK(kfc0, kaddr_, 10240); AT_LDK(kfc1, kaddr_, 10752); AT_WAITK(10, kfa0, kfa1); N0 = MFMA32(kfa0, qr[3], N0); AT_PIN1(N0); AT_EXP(C1[2]); AT_EXP(C1[3]); AT_EXP(C1[4]); VTR_ASM(ta_[9], vaddr_, 2560); AT_SB(); \
          N1 = MFMA32(kfa1, qr[3], N1); AT_PIN1(N1); AT_EXP(C1[5]); AT_EXP(C1[6]); AT_EXP(C1[7]); VTR_ASM(ta_[10], vaddr_, 6144); VTR_ASM(ta_[11], vaddr_, 6656); AT_SB(); \
           AT_WAITK(8, kfb0, kfb1); N0 = MFMA32(kfb0, qr[4], N0); AT_PIN1(N0); AT_EXP(C1[8]); AT_EXP(C1[9]); VTR_ASM(ta_[12], vaddr_, 3072); AT_SB(); \
          N1 = MFMA32(kfb1, qr[4], N1); AT_PIN1(N1); AT_EXP(C1[10]); AT_EXP(C1[11]); VTR_ASM(ta_[13], vaddr_, 3584); AT_SB(); \
           AT_WAITK(5, kfc0, kfc1); N0 = MFMA32(kfc0, qr[5], N0); AT_PIN1(N0); AT_EXP(C1[12]); AT_EXP(C1[13]); VTR_ASM(ta_[14], vaddr_, 7168); AT_SB(); \
          N1 = MFMA32(kfc1, qr[5], N1); AT_PIN1(N1); AT_EXP(C1[14]); AT_EXP(C1[15]); VTR_ASM(ta_[15], vaddr_, 7680); AT_SB(); \
          \
        } \
        if constexpr (NS == 4) { \
          AT_LDK(kfc0, kaddr_, 4096); AT_LDK(kfc1, kaddr_, 4608); AT_WAITK(4, kfa0, kfa1); N0 = MFMA32(kfa0, qr[0], negm); AT_PIN1(N0); AT_EXP(C0[0]); AT_EXP(C0[1]); AT_EXP(C0[2]); AT_EXP(C0[3]);  VTR_ASM(ta_[0], vaddr_, 0); AT_SB(); \
          N1 = MFMA32(kfa1, qr[0], negm); AT_PIN1(N1); AT_EXP(C0[4]); AT_EXP(C0[5]); AT_EXP(C0[6]); AT_EXP(C0[7]);  VTR_ASM(ta_[1], vaddr_, 512); VTR_ASM(ta_[2], vaddr_, 4096); VTR_ASM(ta_[3], vaddr_, 4608); AT_SB(); \
          AT_LDK(kfa0, kaddr_, 6144); AT_LDK(kfa1, kaddr_, 6656); AT_WAITK(8, kfb0, kfb1); N0 = MFMA32(kfb0, qr[1], N0); AT_PIN1(N0); AT_EXP(C0[8]); AT_EXP(C0[9]); AT_EXP(C0[10]); AT_EXP(C0[11]); VTR_ASM(ta_[4], vaddr_, 1024); AT_SB(); \
          N1 = MFMA32(kfb1, qr[1], N1); AT_PIN1(N1); AT_EXP(C0[12]); AT_EXP(C0[13]); AT_EXP(C0[14]); AT_EXP(C0[15]); VTR_ASM(ta_[5], vaddr_, 1536); VTR_ASM(ta_[6], vaddr_, 5120); VTR_ASM(ta_[7], vaddr_, 5632); AT_SB(); \
           AT_WAITK(10, kfc0, kfc1); N0 = MFMA32(kfc0, qr[2], N0); AT_PIN1(N0); AT_EXP(C1[0]); AT_EXP(C1[1]); AT_EXP(C1[2]); AT_EXP(C1[3]); VTR_ASM(ta_[8], vaddr_, 2048); AT_SB(); \
          N1 = MFMA32(kfc1, qr[2], N1); AT_PIN1(N1); AT_EXP(C1[4]); AT_EXP(C1[5]); AT_EXP(C1[6]); AT_EXP(C1[7]); VTR_ASM(ta_[9], vaddr_, 2560); VTR_ASM(ta_[10], vaddr_, 6144); VTR_ASM(ta_[11], vaddr_, 6656); AT_SB(); \
           AT_WAITK(8, kfa0, kfa1); N0 = MFMA32(kfa0, qr[3], N0); AT_PIN1(N0); AT_EXP(C1[8]); AT_EXP(C1[9]); AT_EXP(C1[10]); AT_EXP(C1[11]); VTR_ASM(ta_[12], vaddr_, 3072); AT_SB(); \
          N1 = MFMA32(kfa1, qr[3], N1); AT_PIN1(N1); AT_EXP(C1[12]); AT_EXP(C1[13]); AT_EXP(C1[14]); AT_EXP(C1[15]); VTR_ASM(ta_[13], vaddr_, 3584); VTR_ASM(ta_[14], vaddr_, 7168); VTR_ASM(ta_[15], vaddr_, 7680); AT_SB(); \
          \
        } \
        if constexpr (NS == 6) AT_WAITV8(9, ta_[0], ta_[1], ta_[2], ta_[3], ta_[4], ta_[5], ta_[6], ta_[7]); else AT_WAITV8(8, ta_[0], ta_[1], ta_[2], ta_[3], ta_[4], ta_[5], ta_[6], ta_[7]); AT_SB(); \
        vf_[0] = (bf16x8){ta_[0][0], ta_[0][1], ta_[0][2], ta_[0][3], ta_[1][0], ta_[1][1], ta_[1][2], ta_[1][3]}; vf_[1] = (bf16x8){ta_[2][0], ta_[2][1], ta_[2][2], ta_[2][3], ta_[3][0], ta_[3][1], ta_[3][2], ta_[3][3]}; vf_[2] = (bf16x8){ta_[4][0], ta_[4][1], ta_[4][2], ta_[4][3], ta_[5][0], ta_[5][1], ta_[5][2], ta_[5][3]}; vf_[3] = (bf16x8){ta_[6][0], ta_[6][1], ta_[6][2], ta_[6][3], ta_[7][0], ta_[7][1], ta_[7][2], ta_[7][3]}; \
        pw[0] = (u32x4){cvtpk(C0[0], C0[1]), cvtpk(C0[2], C0[3]), cvtpk(C0[4], C0[5]), cvtpk(C0[6], C0[7])}; AT_SB(); \
        if (!(PROBE_VARIANT == 2 && p.pad)) { \
        o0 = MFMA32(__builtin_bit_cast(bf16x8, pw[0]), vf_[0], o0); AT_PIN1(o0); pw[1].x = cvtpk(C0[8], C0[9]); pw[1].y = cvtpk(C0[10], C0[11]); rs0 += C0[0]; rs1 += C0[1]; rs2 += C0[2]; rs3 += C0[3]; AT_PINRS(); AT_SB(); \
        o1 = MFMA32(__builtin_bit_cast(bf16x8, pw[0]), vf_[1], o1); AT_PIN1(o1); pw[1].z = cvtpk(C0[12], C0[13]); pw[1].w = cvtpk(C0[14], C0[15]); rs0 += C0[4]; rs1 += C0[5]; rs2 += C0[6]; rs3 += C0[7]; AT_PINRS(); AT_SB(); \
        o0 = MFMA32(__builtin_bit_cast(bf16x8, pw[1]), vf_[2], o0); AT_PIN1(o0); pw[2].x = cvtpk(C1[0], C1[1]); pw[2].y = cvtpk(C1[2], C1[3]); rs0 += C0[8]; rs1 += C0[9]; rs2 += C0[10]; rs3 += C0[11]; AT_PINRS(); AT_SB(); \
        o1 = MFMA32(__builtin_bit_cast(bf16x8, pw[1]), vf_[3], o1); AT_PIN1(o1); pw[2].z = cvtpk(C1[4], C1[5]); pw[2].w = cvtpk(C1[6], C1[7]); rs0 += C0[12]; rs1 += C0[13]; rs2 += C0[14]; rs3 += C0[15]; AT_PINRS(); AT_SB(); \
        AT_WAITV4(4, ta_[8], ta_[9], ta_[10], ta_[11]); vf_[4] = (bf16x8){ta_[8][0], ta_[8][1], ta_[8][2], ta_[8][3], ta_[9][0], ta_[9][1], ta_[9][2], ta_[9][3]}; vf_[5] = (bf16x8){ta_[10][0], ta_[10][1], ta_[10][2], ta_[10][3], ta_[11][0], ta_[11][1], ta_[11][2], ta_[11][3]}; \
        o0 = MFMA32(__builtin_bit_cast(bf16x8, pw[2]), vf_[4], o0); AT_PIN1(o0); pw[3].x = cvtpk(C1[8], C1[9]); pw[3].y = cvtpk(C1[10], C1[11]); rs0 += C1[0]; rs1 += C1[1]; rs2 += C1[2]; rs3 += C1[3]; AT_PINRS(); AT_SB(); \
        o1 = MFMA32(__builtin_bit_cast(bf16x8, pw[2]), vf_[5], o1); AT_PIN1(o1); pw[3].z = cvtpk(C1[12], C1[13]); pw[3].w = cvtpk(C1[14], C1[15]); rs0 += C1[4]; rs1 += C1[5]; rs2 += C1[6]; rs3 += C1[7]; AT_PINRS(); AT_SB(); \
        AT_WAITV4(0, ta_[12], ta_[13], ta_[14], ta_[15]); vf_[6] = (bf16x8){ta_[12][0], ta_[12][1], ta_[12][2], ta_[12][3], ta_[13][0], ta_[13][1], ta_[13][2], ta_[13][3]}; vf_[7] = (bf16x8){ta_[14][0], ta_[14][1], ta_[14][2], ta_[14][3], ta_[15][0], ta_[15][1], ta_[15][2], ta_[15][3]}; \
        o0 = MFMA32(__builtin_bit_cast(bf16x8, pw[3]), vf_[6], o0); AT_PIN1(o0); rs0 += C1[8]; rs1 += C1[9]; rs2 += C1[10]; rs3 += C1[11]; AT_PINRS(); AT_SB(); \
        o1 = MFMA32(__builtin_bit_cast(bf16x8, pw[3]), vf_[7], o1); AT_PIN1(o1); rs0 += C1[12]; rs1 += C1[13]; rs2 += C1[14]; rs3 += C1[15]; AT_PINRS(); AT_SB(); } \
        l += (rs0 + rs1) + (rs2 + rs3); \
        AT_WAITBAR(); \
        if (t_ + 1 < ntiles) AT_REF(N0, N1, t1_, false); } while (0)
    for (int it = 0; it < ntiles; it += 2) {
        AT_STEP(cA0, cA1, cB0, cB1, it);
        AT_STEP(cB0, cB1, cA0, cA1, it + 1);
    }
#undef AT_ROW0
#undef AT_DMAK
#undef AT_DMAV
#undef AT_CLAMP
#undef AT_WAITBAR
#undef AT_REF
#undef AT_SB
#undef AT_PIN2
#undef AT_PIN1
#undef AT_PINRS
#undef AT_LDK
#undef AT_WAITK
#undef AT_WAITV8
#undef AT_WAITV4
#undef AT_EXP
#undef AT_QK
#undef AT_STEP
    float lt = l + __shfl_xor(l, 32);
    float fin = 1.f;
    if (p.sink) { const float sk = p.sink[h] * LOG2E; const float m2 = fmaxf(m, sk); fin = __builtin_amdgcn_exp2f(m - m2); lt = lt * fin + __builtin_amdgcn_exp2f(sk - m2); }
    const float sc = fin / lt;
    if (hi == 0) wsf[r32] = sc;
    bf16_t* Ob = p.O + (size_t)(q0 + wid * 32) * p.old + h * p.ohs + r32;
#pragma unroll
    for (int r = 0; r < 16; ++r) { const int qr_ = crow(r, hi); const float f = wsf[qr_];
        if (!nostore) { Ob[(size_t)qr_ * p.old] = f2bf(o0[r] * f); Ob[(size_t)qr_ * p.old + 32] = f2bf(o1[r] * f); } }
}

namespace gp {
constexpr int BM = 256, BK = 64, HALF = 128, HTB = HALF * BK * 2, STAGE_BYTES = 8 * HTB, NXCD = 8, WGM = 8;
__host__ __device__ __forceinline__ int lds_byte(int r, int c) { const int st = (r >> 4) * 2 + (c >> 5), rr = r & 15, cc = c & 31, ob = rr * 64 + cc * 2; return st * 1024 + (ob ^ (((ob >> 9) & 1) << 5)); }
__host__ __device__ __forceinline__ void stage_rc(int b, int& R, int& C) { const int st = b / 1024, sb = b % 1024, swz = sb ^ (((sb >> 9) & 1) << 5); R = (st >> 1) * 16 + swz / 64; C = (st & 1) * 32 + (swz % 64) / 2; }
__host__ __device__ __forceinline__ int perm32(int rho) { const int n = rho >> 4, i = rho & 15; return 8 * (i >> 2) + 4 * n + (i & 3); }

struct GUnit { const char* A; const char* B; int nt, pm, pn, tag; const unsigned* goff; int lda2, ldb2; };

__device__ __forceinline__ bool tile_order(int i, int G_, int c, int nM, int nN, int& pm, int& pn) {
    const int nwg = nM * nN; const long L = (long)i * G_ + c; if (L >= nwg) return false;
    int wgid = (int)L; { const int q = nwg / NXCD, r = nwg % NXCD, xcd = wgid % NXCD, off = wgid / NXCD; wgid = (xcd < r ? xcd * (q + 1) : r * (q + 1) + (xcd - r) * q) + off; }
    const int nig = WGM * nN, gid = wgid / nig, fm = gid * WGM, gsz = (nM - fm) < WGM ? (nM - fm) : WGM;
    pm = fm + ((wgid % nig) % gsz); pn = (wgid % nig) / gsz; return true;
}
__device__ __forceinline__ unsigned cvt_pk_bf16(float lo, float hi) { return pkbf(lo, hi); }

template <class Epi, class Sched>
__device__ __forceinline__ void gemm_phase(LAS unsigned char* lds, const Sched& S, const Epi& E, int wv0) {
    constexpr bool GATHER = Sched::GATHER; constexpr bool VS = Sched::VARSTRIDE;
    const int tid = opaque_tid(wv0), wid = __builtin_amdgcn_readfirstlane(tid >> 6), lane = tid & 63, wr = wid >> 2, wc = wid & 3, fr = lane & 15, fq = lane >> 4;
    const int lda2 = S.lda2, ldb2 = S.ldb2;
    unsigned voffA[2], voffB[2], rowA[2], rowB[2], colb[2];
#pragma unroll
    for (int i = 0; i < 2; ++i) { int R, C; stage_rc(tid * 16 + i * 8192, R, C); const int Rb = Epi::PERM ? ((R & ~31) + perm32(R & 31)) : R;
        voffA[i] = GATHER ? (unsigned)C * 2u : (unsigned)R * (unsigned)lda2 + (unsigned)C * 2u; rowA[i] = (unsigned)R; voffB[i] = (unsigned)Rb * (unsigned)ldb2 + (unsigned)C * 2u; rowB[i] = (unsigned)Rb; colb[i] = (unsigned)C * 2u; }
    size_t hA = GATHER ? 0 : (size_t)HALF * lda2, hB = (size_t)HALF * ldb2;
    const unsigned ldsw = (unsigned)wid * 1024u;
    const int aoff = lds_byte(wr * 64 + fr, fq * 8), boff = lds_byte(wc * 32 + fr, fq * 8);
    constexpr size_t kstep = (size_t)(BK * 2);
#define GP_SA(b, h) (((b) * 2 + (h)) * HTB)
#define GP_SB(b, h) ((4 + (b) * 2 + (h)) * HTB)
#define GP_STAGE(bufoff, gbase, v0, v1) do { \
        __builtin_amdgcn_global_load_lds((const unsigned*)((const char*)(gbase) + (v0)), (LAS unsigned*)(lds + (bufoff) + ldsw), 16, 0, 0); \
        __builtin_amdgcn_global_load_lds((const unsigned*)((const char*)(gbase) + (v1)), (LAS unsigned*)(lds + (bufoff) + ldsw + 8192), 16, 0, 0); } while (0)
#define GP_LDA(dst, b, h) do { _Pragma("unroll") for (int m = 0; m < 4; ++m) _Pragma("unroll") for (int k = 0; k < 2; ++k) dst[m][k] = *(const LAS bf16x8*)(lds + GP_SA(b, h) + aoff + m * 2048 + k * 1024); } while (0)
#define GP_LDB(dst, b, h) do { _Pragma("unroll") for (int n = 0; n < 2; ++n) _Pragma("unroll") for (int k = 0; k < 2; ++k) dst[n][k] = *(const LAS bf16x8*)(lds + GP_SB(b, h) + boff + n * 2048 + k * 1024); } while (0)
#define GP_MMA(ai, bj, At, Bt) do { __builtin_amdgcn_s_setprio(1); _Pragma("unroll") for (int m = 0; m < 4; ++m) _Pragma("unroll") for (int n = 0; n < 2; ++n) _Pragma("unroll") for (int k = 0; k < 2; ++k) \
        acc[ai][bj][m][n] = __builtin_amdgcn_mfma_f32_16x16x32_bf16(Bt[n][k], At[m][k], acc[ai][bj][m][n], 0, 0, 0); __builtin_amdgcn_s_setprio(0); } while (0)
#define GP_WAIT_V(n) asm volatile("s_waitcnt vmcnt(" #n ")" ::: "memory")
#define GP_WAIT_L(n) asm volatile("s_waitcnt lgkmcnt(" #n ")" ::: "memory")
#define GP_BAR __builtin_amdgcn_s_barrier()
#define GP_SCHED __builtin_amdgcn_sched_barrier(0)
#define GP_GOFF(U, o0, o1, p0, p1) do { if (GATHER) { o0 = (U).goff[rowA[0]] + voffA[0]; o1 = (U).goff[rowA[1]] + voffA[1]; p0 = (U).goff[128 + rowA[0]] + voffA[0]; p1 = (U).goff[128 + rowA[1]] + voffA[1]; } \
        else { o0 = voffA[0]; o1 = voffA[1]; p0 = voffA[0]; p1 = voffA[1]; } } while (0)
    GUnit cur, nxt; int ui = 0;
    if (!S.next(0, cur)) return;
    f32x4 acc[2][2][4][2];
#pragma unroll
    for (int a = 0; a < 2; ++a)
#pragma unroll
        for (int b = 0; b < 2; ++b)
#pragma unroll
            for (int m = 0; m < 4; ++m)
#pragma unroll
                for (int n = 0; n < 2; ++n) acc[a][b][m][n] = (f32x4){0.f, 0.f, 0.f, 0.f};
    bf16x8 At[4][2], B0[2][2], B1[2][2];
    unsigned g00, g01, g10, g11;
    if (VS) { voffA[0] = rowA[0] * (unsigned)cur.lda2 + colb[0]; voffA[1] = rowA[1] * (unsigned)cur.lda2 + colb[1]; voffB[0] = rowB[0] * (unsigned)cur.ldb2 + colb[0]; voffB[1] = rowB[1] * (unsigned)cur.ldb2 + colb[1];
              hA = (size_t)HALF * cur.lda2; hB = (size_t)HALF * cur.ldb2; }
    GP_GOFF(cur, g00, g01, g10, g11);
    const char* cA = cur.A; const char* cB = cur.B;
    GP_STAGE(GP_SB(0, 0), cB, voffB[0], voffB[1]); GP_STAGE(GP_SA(0, 0), cA, g00, g01); GP_STAGE(GP_SB(0, 1), cB + hB, voffB[0], voffB[1]); GP_STAGE(GP_SA(0, 1), cA + hA, g10, g11);
    if (wr == 1) GP_BAR;
    GP_WAIT_V(4); GP_BAR;
    GP_STAGE(GP_SB(1, 0), cB + kstep, voffB[0], voffB[1]); GP_STAGE(GP_SA(1, 0), cA + kstep, g00, g01); GP_STAGE(GP_SB(1, 1), cB + hB + kstep, voffB[0], voffB[1]);
    GP_WAIT_V(6); GP_BAR;
    for (;;) {
        const bool has_next = S.next(ui + 1, nxt);
        const char* nA = has_next ? nxt.A : cA; const char* nB = has_next ? nxt.B : cB;
        const int nt = cur.nt;
        for (int t = 0; t < nt; t += 2) {
            const bool last = (t == nt - 2);
            const char* a1 = cA + (size_t)(t + 1) * kstep;
            const char* a2 = last ? nA : cA + (size_t)(t + 2) * kstep; const char* b2 = last ? nB : cB + (size_t)(t + 2) * kstep;
            const char* a3 = a2 + kstep; const char* b3 = b2 + kstep;
            unsigned w00 = g00, w01 = g01, w10 = g10, w11 = g11, wB0 = voffB[0], wB1 = voffB[1]; size_t whA = hA, whB = hB;
            if (GATHER && last && has_next) { GP_GOFF(nxt, w00, w01, w10, w11); }
            if (VS && last && has_next) { w00 = w10 = rowA[0] * (unsigned)nxt.lda2 + colb[0]; w01 = w11 = rowA[1] * (unsigned)nxt.lda2 + colb[1]; wB0 = rowB[0] * (unsigned)nxt.ldb2 + colb[0]; wB1 = rowB[1] * (unsigned)nxt.ldb2 + colb[1];
                whA = (size_t)HALF * nxt.lda2; whB = (size_t)HALF * nxt.ldb2; }
            GP_LDB(B0, 0, 0); GP_SCHED; GP_LDA(At, 0, 0); GP_STAGE(GP_SA(1, 1), a1 + hA, g10, g11);
            GP_WAIT_L(8); GP_BAR; GP_WAIT_L(0); GP_MMA(0, 0, At, B0); GP_BAR; GP_SCHED;
            GP_LDB(B1, 0, 1); GP_STAGE(GP_SB(0, 0), b2, wB0, wB1);
            GP_BAR; GP_WAIT_L(0); GP_MMA(0, 1, At, B1); GP_BAR;
            GP_LDA(At, 0, 1); GP_STAGE(GP_SA(0, 0), a2, w00, w01);
            GP_BAR; GP_WAIT_L(0); GP_MMA(1, 0, At, B0); GP_BAR; GP_SCHED;
            GP_STAGE(GP_SB(0, 1), b2 + whB, wB0, wB1);
            GP_WAIT_V(6); GP_BAR; GP_MMA(1, 1, At, B1); GP_BAR;
            GP_LDB(B0, 1, 0); GP_SCHED; GP_LDA(At, 1, 0); GP_STAGE(GP_SA(0, 1), a2 + whA, w10, w11);
            GP_WAIT_L(8); GP_BAR; GP_WAIT_L(0); GP_MMA(0, 0, At, B0); GP_BAR; GP_SCHED;
            GP_LDB(B1, 1, 1); GP_STAGE(GP_SB(1, 0), b3, wB0, wB1);
            GP_BAR; GP_WAIT_L(0); GP_MMA(0, 1, At, B1); GP_BAR;
            GP_LDA(At, 1, 1); GP_STAGE(GP_SA(1, 0), a3, w00, w01);
            GP_BAR; GP_WAIT_L(0); GP_MMA(1, 0, At, B0); GP_BAR; GP_SCHED;
            GP_STAGE(GP_SB(1, 1), b3 + whB, wB0, wB1);
            GP_WAIT_V(6); GP_BAR; GP_MMA(1, 1, At, B1); GP_BAR;
            if ((GATHER || VS) && last) { g00 = w00; g01 = w01; g10 = w10; g11 = w11; }
            if (VS && last) { voffB[0] = wB0; voffB[1] = wB1; hA = whA; hB = whB; }
        }
        { int fr_e = fr, fq_e = fq; asm volatile("" : "+v"(fr_e), "+v"(fq_e));
          E(acc, cur, wr, wc, fr_e, fq_e); }
        if (!has_next) break;
#pragma unroll
        for (int a = 0; a < 2; ++a)
#pragma unroll
            for (int b = 0; b < 2; ++b)
#pragma unroll
                for (int m = 0; m < 4; ++m)
#pragma unroll
                    for (int n = 0; n < 2; ++n) acc[a][b][m][n] = (f32x4){0.f, 0.f, 0.f, 0.f};
        cur = nxt; cA = nA; cB = nB; ++ui;
    }
    GP_WAIT_V(0);
    if (wr == 0) GP_BAR;
    GP_BAR;
#undef GP_SA
#undef GP_SB
#undef GP_STAGE
#undef GP_LDA
#undef GP_LDB
#undef GP_MMA
#undef GP_WAIT_V
#undef GP_WAIT_L
#undef GP_BAR
#undef GP_SCHED
#undef GP_GOFF
}
}

struct SchedStd {
    static constexpr bool GATHER = false; static constexpr bool VARSTRIDE = false;
    const bf16_t* A; const bf16_t* Bt; int K, nM, nN, G_, c, skipctx, lda2, ldb2;
    __device__ __forceinline__ bool next(int i, gp::GUnit& u) const {
        int pmv, pn; if (!gp::tile_order(i, G_, c, nM, nN, pmv, pn)) return false;
        const int pm = skipctx ? pmv + pmv / 32 : pmv;
        u.A = (const char*)(A + (size_t)pm * 256 * K); u.B = (const char*)(Bt + (size_t)pn * 256 * K); u.nt = K / 64; u.pm = pm; u.pn = pn; u.tag = 0; u.goff = nullptr; return true;
    }
};

__device__ __forceinline__ float fexp(float x) { return __builtin_amdgcn_exp2f(x * LOG2E); }
__device__ __forceinline__ float flog(float x) { return __builtin_amdgcn_logf(x) * 0.6931471805599453f; }
__device__ __forceinline__ float fsigmoid(float x) { return __builtin_amdgcn_rcpf(1.f + fexp(-x)); }
__device__ __forceinline__ float logf_gate_fast(float z, float lb) {
    if (lb <= 0.f) return fminf(z, 0.f) - flog(1.f + fexp(-fabsf(z)));
    return flog(lb + (1.f - lb) * fsigmoid(z));
}
__device__ __forceinline__ unsigned pkh2(float lo, float hi) { const f16_t a = (f16_t)lo, b = (f16_t)hi; return (unsigned)__builtin_bit_cast(unsigned short, a) | ((unsigned)__builtin_bit_cast(unsigned short, b) << 16); }

template <class T> __device__ __forceinline__ T* opq(T* p) { asm volatile("" : "+s"(p)); return p; }
struct EpiG1 {
    static constexpr bool PERM = true;
    bf16_t *AQ, *AK, *AV, *BQ, *BV, *BG; f16_t *BLF, *BLB; bf16_t *CQKV, *CKR; float* RS; const float *ropa_c, *ropa_s, *ropc_c, *ropc_s; const float* LBl; int rowoff;
    __device__ __forceinline__ void operator()(const f32x4 (&acc)[2][2][4][2], const gp::GUnit& u, int wr, int wc, int fr, int fq) const {
        const int pn = u.pn; const int pr = u.pm % 33; const bool lat = pr < 32;
        const int grow0 = u.pm * 256 + wr * 64 + fr; const int t0 = pr * 256 + wr * 64 + fr;
        if (pn < 3) {
            const int hh = pn * 4 + wc; bf16_t* dst; int ld, coff; bf16_t* const aq_ = opq(AQ); bf16_t* const ak_ = opq(AK); bf16_t* const av_ = opq(AV);
            if (hh < 8) { dst = aq_; ld = 512; coff = hh * 64; } else if (hh < 10) { dst = ak_; ld = 128; coff = (hh - 8) * 64; } else { dst = av_; ld = 128; coff = (hh - 10) * 64; }
            const bool rope = lat && hh < 10;
#pragma unroll
            for (int ai = 0; ai < 2; ++ai)
#pragma unroll
                for (int m = 0; m < 4; ++m) { const int grow = grow0 + ai * 128 + m * 16, t = t0 + ai * 128 + m * 16; const size_t row = (size_t)(grow - rowoff);
                    f32x4 x1a = acc[ai][0][m][0], x1b = acc[ai][0][m][1], x2a = acc[ai][1][m][0], x2b = acc[ai][1][m][1];
                    if (rope) { const f32x4 ca = *(const f32x4*)(ropa_c + t * 32 + 8 * fq), cb = *(const f32x4*)(ropa_c + t * 32 + 8 * fq + 4), sa = *(const f32x4*)(ropa_s + t * 32 + 8 * fq), sb = *(const f32x4*)(ropa_s + t * 32 + 8 * fq + 4);
                        const f32x4 o1a = x1a * ca - x2a * sa, o2a = x1a * sa + x2a * ca, o1b = x1b * cb - x2b * sb, o2b = x1b * sb + x2b * cb; x1a = o1a; x2a = o2a; x1b = o1b; x2b = o2b; }
                    if (hh < 8) { const float qs = 0.125f * LOG2E; x1a *= qs; x1b *= qs; x2a *= qs; x2b *= qs; }
                    bf16_t* p = dst + row * ld + coff + 8 * fq;
                    u32x4 w1, w2; w1.x = gp::cvt_pk_bf16(x1a[0], x1a[1]); w1.y = gp::cvt_pk_bf16(x1a[2], x1a[3]); w1.z = gp::cvt_pk_bf16(x1b[0], x1b[1]); w1.w = gp::cvt_pk_bf16(x1b[2], x1b[3]);
                    w2.x = gp::cvt_pk_bf16(x2a[0], x2a[1]); w2.y = gp::cvt_pk_bf16(x2a[2], x2a[3]); w2.z = gp::cvt_pk_bf16(x2b[0], x2b[1]); w2.w = gp::cvt_pk_bf16(x2b[2], x2b[3]);
                    *(u32x4*)p = w1; *(u32x4*)(p + 32) = w2; if (m == 3) asm volatile("" ::: "memory"); }
        } else if (pn < 13) {
            const int q = pn - 3, which = q >> 1; const int cb0 = (q & 1) * 256 + wc * 32 + 8 * fq;
            if (which == 2 || which == 3) {
                f16_t* const blf_ = opq(BLF); f16_t* const blb_ = opq(BLB); f16_t* dst = which == 2 ? blf_ : blb_; const float* lbp = LBl + (which == 2 ? 0 : 512);
#pragma unroll
                for (int bj = 0; bj < 2; ++bj) { const int c0 = cb0 + bj * 128; const f32x4 la = *(const f32x4*)(lbp + c0), lb4 = *(const f32x4*)(lbp + c0 + 4);
#pragma unroll
                    for (int ai = 0; ai < 2; ++ai)
#pragma unroll
                        for (int m = 0; m < 4; ++m) { const size_t row = (size_t)(grow0 + ai * 128 + m * 16 - rowoff); const f32x4 v0 = acc[ai][bj][m][0], v1 = acc[ai][bj][m][1];
                            u32x4 w; w.x = pkh2(logf_gate_fast(v0[0], la[0]), logf_gate_fast(v0[1], la[1])); w.y = pkh2(logf_gate_fast(v0[2], la[2]), logf_gate_fast(v0[3], la[3]));
                            w.z = pkh2(logf_gate_fast(v1[0], lb4[0]), logf_gate_fast(v1[1], lb4[1])); w.w = pkh2(logf_gate_fast(v1[2], lb4[2]), logf_gate_fast(v1[3], lb4[3]));
                            *(u32x4*)(dst + row * 512 + c0) = w; } }
            } else {
                bf16_t* const bq_ = opq(BQ); bf16_t* const bv_ = opq(BV); bf16_t* const bg_ = opq(BG); bf16_t* dst = which == 0 ? bq_ : (which == 1 ? bv_ : bg_);
#pragma unroll
                for (int ai = 0; ai < 2; ++ai)
#pragma unroll
                    for (int m = 0; m < 4; ++m) { const size_t row = (size_t)(grow0 + ai * 128 + m * 16 - rowoff);
#pragma unroll
                        for (int bj = 0; bj < 2; ++bj) { const f32x4 v0 = acc[ai][bj][m][0], v1 = acc[ai][bj][m][1];
                            u32x4 w; w.x = gp::cvt_pk_bf16(v0[0], v0[1]); w.y = gp::cvt_pk_bf16(v0[2], v0[3]); w.z = gp::cvt_pk_bf16(v1[0], v1[1]); w.w = gp::cvt_pk_bf16(v1[2], v1[3]);
                            *(u32x4*)(dst + row * 512 + cb0 + bj * 128) = w; } }
            }
        } else if (pn == 13) {
#pragma unroll
            for (int ai = 0; ai < 2; ++ai)
#pragma unroll
                for (int m = 0; m < 4; ++m) { const int grow = grow0 + ai * 128 + m * 16; const size_t row = (size_t)(grow - rowoff); float ss = 0.f;
#pragma unroll
                    for (int bj = 0; bj < 2; ++bj) { const f32x4 v0 = acc[ai][bj][m][0], v1 = acc[ai][bj][m][1];
                        ss += v0[0] * v0[0] + v0[1] * v0[1] + v0[2] * v0[2] + v0[3] * v0[3] + v1[0] * v1[0] + v1[1] * v1[1] + v1[2] * v1[2] + v1[3] * v1[3];
                        u32x4 w; w.x = gp::cvt_pk_bf16(v0[0], v0[1]); w.y = gp::cvt_pk_bf16(v0[2], v0[3]); w.z = gp::cvt_pk_bf16(v1[0], v1[1]); w.w = gp::cvt_pk_bf16(v1[2], v1[3]);
                        *(u32x4*)(CQKV + row * 384 + bj * 128 + wc * 32 + 8 * fq) = w; }
                    ss += __shfl_xor(ss, 16); ss += __shfl_xor(ss, 32);
                    if (fq == 0) RS[(size_t)grow * 8 + wc] = ss; }
        } else {
#pragma unroll
            for (int ai = 0; ai < 2; ++ai)
#pragma unroll
                for (int m = 0; m < 4; ++m) { const int grow = grow0 + ai * 128 + m * 16, t = t0 + ai * 128 + m * 16; const size_t row = (size_t)(grow - rowoff);
                    const f32x4 v0 = acc[ai][0][m][0], v1 = acc[ai][0][m][1];
                    float ss = v0[0] * v0[0] + v0[1] * v0[1] + v0[2] * v0[2] + v0[3] * v0[3] + v1[0] * v1[0] + v1[1] * v1[1] + v1[2] * v1[2] + v1[3] * v1[3];
                    u32x4 w; w.x = gp::cvt_pk_bf16(v0[0], v0[1]); w.y = gp::cvt_pk_bf16(v0[2], v0[3]); w.z = gp::cvt_pk_bf16(v1[0], v1[1]); w.w = gp::cvt_pk_bf16(v1[2], v1[3]);
                    *(u32x4*)(CQKV + row * 384 + 256 + wc * 32 + 8 * fq) = w;
                    ss += __shfl_xor(ss, 16); ss += __shfl_xor(ss, 32);
                    if (fq == 0) RS[(size_t)grow * 8 + 4 + wc] = ss;
                    if (wc == 0) { f32x4 x1 = acc[ai][1][m][0], x2 = acc[ai][1][m][1];
                        if (lat) { const f32x4 cc = *(const f32x4*)(ropc_c + t * 16 + 4 * fq), sn = *(const f32x4*)(ropc_s + t * 16 + 4 * fq); const f32x4 o1 = x1 * cc - x2 * sn, o2 = x1 * sn + x2 * cc; x1 = o1; x2 = o2; }
                        *(uint2*)(CKR + row * 32 + 4 * fq) = make_uint2(gp::cvt_pk_bf16(x1[0], x1[1]), gp::cvt_pk_bf16(x1[2], x1[3]));
                        *(uint2*)(CKR + row * 32 + 16 + 4 * fq) = make_uint2(gp::cvt_pk_bf16(x2[0], x2[1]), gp::cvt_pk_bf16(x2[2], x2[3])); } }
        }
    }
};

struct EpiC {
    static constexpr bool PERM = true;
    bf16_t *CQ, *CKV; const float* RS; const float *ropc_c, *ropc_s; int pmoff;
    __device__ __forceinline__ void operator()(const f32x4 (&acc)[2][2][4][2], const gp::GUnit& u, int wr, int wc, int fr, int fq) const {
        const int pn = u.pn; const int pr = (u.pm + pmoff) % 33; const bool lat = pr < 32;
        const int grow0 = u.pm * 256 + wr * 64 + fr; const int t0 = pr * 256 + wr * 64 + fr;
        f32x4 rs4[2][4];
#pragma unroll
        for (int ai = 0; ai < 2; ++ai)
#pragma unroll
            for (int m = 0; m < 4; ++m) rs4[ai][m] = *(const f32x4*)(RS + (size_t)(grow0 + ai * 128 + m * 16) * 8 + (pn < 3 ? 0 : 4));
#pragma unroll
        for (int ai = 0; ai < 2; ++ai)
#pragma unroll
            for (int m = 0; m < 4; ++m) { const size_t row = (size_t)(grow0 + ai * 128 + m * 16); const int t = t0 + ai * 128 + m * 16;
                if (pn < 3) { const f32x4 p4 = rs4[ai][m]; const float rq = rsqrtf(((p4[0] + p4[1]) + (p4[2] + p4[3])) * (1.f / 256.f) + EPS) * (0.10206207261596577f * LOG2E);
#pragma unroll
                    for (int bj = 0; bj < 2; ++bj) { const int gi = pn * 8 + bj * 4 + wc, head = gi / 3, part = gi - head * 3;
                        f32x4 v0 = acc[ai][bj][m][0] * rq, v1 = acc[ai][bj][m][1] * rq;
                        bf16_t* p = CQ + row * 768 + head * 96;
                        if (part < 2) { u32x4 w; w.x = gp::cvt_pk_bf16(v0[0], v0[1]); w.y = gp::cvt_pk_bf16(v0[2], v0[3]); w.z = gp::cvt_pk_bf16(v1[0], v1[1]); w.w = gp::cvt_pk_bf16(v1[2], v1[3]);
                            *(u32x4*)(p + part * 32 + 8 * fq) = w; }
                        else { if (lat) { const f32x4 cc = *(const f32x4*)(ropc_c + t * 16 + 4 * fq), sn = *(const f32x4*)(ropc_s + t * 16 + 4 * fq); const f32x4 o1 = v0 * cc - v1 * sn, o2 = v0 * sn + v1 * cc; v0 = o1; v1 = o2; }
                            *(uint2*)(p + 64 + 4 * fq) = make_uint2(gp::cvt_pk_bf16(v0[0], v0[1]), gp::cvt_pk_bf16(v0[2], v0[3]));
                            *(uint2*)(p + 80 + 4 * fq) = make_uint2(gp::cvt_pk_bf16(v1[0], v1[1]), gp::cvt_pk_bf16(v1[2], v1[3])); } }
                } else { const f32x4 p4 = rs4[ai][m]; const float rkv = rsqrtf(((p4[0] + p4[1]) + (p4[2] + p4[3])) * (1.f / 128.f) + EPS);
#pragma unroll
                    for (int bj = 0; bj < 2; ++bj) { const f32x4 v0 = acc[ai][bj][m][0] * rkv, v1 = acc[ai][bj][m][1] * rkv;
                        u32x4 w; w.x = gp::cvt_pk_bf16(v0[0], v0[1]); w.y = gp::cvt_pk_bf16(v0[2], v0[3]); w.z = gp::cvt_pk_bf16(v1[0], v1[1]); w.w = gp::cvt_pk_bf16(v1[2], v1[3]);
                        *(u32x4*)(CKV + row * 1024 + (pn - 3) * 256 + bj * 128 + wc * 32 + 8 * fq) = w; } } }
    }
};
struct EpiGate {
    static constexpr bool PERM = true;
    bf16_t* GATE; long nstride; int ld;
    __device__ __forceinline__ void operator()(const f32x4 (&acc)[2][2][4][2], const gp::GUnit& u, int wr, int wc, int fr, int fq) const {
        const int n3 = u.pn >> 2; bf16_t* base = GATE + (size_t)n3 * nstride + (u.pn & 3) * 256 + wc * 32 + 8 * fq; const int row0 = u.pm * 256 + wr * 64 + fr;
#pragma unroll
        for (int ai = 0; ai < 2; ++ai)
#pragma unroll
            for (int m = 0; m < 4; ++m) { bf16_t* rp = base + (size_t)(row0 + ai * 128 + m * 16) * ld;
#pragma unroll
                for (int bj = 0; bj < 2; ++bj) { const f32x4 v0 = acc[ai][bj][m][0], v1 = acc[ai][bj][m][1];
                    u32x4 w; w.x = gp::cvt_pk_bf16(fsigmoid(v0[0]), fsigmoid(v0[1])); w.y = gp::cvt_pk_bf16(fsigmoid(v0[2]), fsigmoid(v0[3])); w.z = gp::cvt_pk_bf16(fsigmoid(v1[0]), fsigmoid(v1[1])); w.w = gp::cvt_pk_bf16(fsigmoid(v1[2]), fsigmoid(v1[3]));
                    *(u32x4*)(rp + bj * 128) = w; } }
    }
};
struct SchedMerge {
    static constexpr bool GATHER = false; static constexpr bool VARSTRIDE = false;
    const bf16_t *A0, *A1, *A2; const bf16_t* Bt; int nM, G_, c, skipctx, lda2, ldb2;
    __device__ __forceinline__ bool next(int i, gp::GUnit& u) const {
        int pmv, pn12; if (!gp::tile_order(i, G_, c, nM, 12, pmv, pn12)) return false;
        const int n = pn12 >> 2, pn = pn12 & 3;
        const int pm = skipctx ? pmv + pmv / 32 : pmv;
        const bf16_t* a0 = opq(A0); const bf16_t* a1 = opq(A1); const bf16_t* a2 = opq(A2);
        const bf16_t* a = n == 0 ? a0 : (n == 1 ? a1 : a2);
        u.A = (const char*)(a + (size_t)pm * 256 * 512); u.B = (const char*)(Bt + (size_t)n * 1024 * 512 + (size_t)pn * 256 * 512); u.nt = 8; u.pm = pm; u.pn = pn; u.tag = n; u.goff = nullptr; return true;
    }
};
__device__ __forceinline__ float bflo(unsigned w) { return __uint_as_float(w << 16); }
__device__ __forceinline__ float bfhi(unsigned w) { return __uint_as_float(w & 0xffff0000u); }
struct EpiMerge {
    static constexpr bool PERM = true;
    bf16_t* GATE; long nstride; int ld;
    __device__ __forceinline__ void operator()(const f32x4 (&acc)[2][2][4][2], const gp::GUnit& u, int wr, int wc, int fr, int fq) const {
        if (PROBE_VARIANT == 3 && ld < 0) return;
        const int n3 = u.tag; const int col = u.pn * 256 + wc * 32 + 8 * fq; bf16_t* gb = GATE + (size_t)n3 * nstride + col; const int row0 = u.pm * 256 + wr * 64 + fr;
#pragma unroll
        for (int ai = 0; ai < 2; ++ai) { u32x4 g[4][2];
#pragma unroll
            for (int m = 0; m < 4; ++m)
#pragma unroll
                for (int bj = 0; bj < 2; ++bj) g[m][bj] = *(const u32x4*)(gb + (size_t)(row0 + ai * 128 + m * 16) * ld + bj * 128);
#pragma unroll
            for (int m = 0; m < 4; ++m)
#pragma unroll
                for (int bj = 0; bj < 2; ++bj) { const u32x4 gg = g[m][bj]; const f32x4 v0 = acc[ai][bj][m][0], v1 = acc[ai][bj][m][1];
                    u32x4 w; w.x = gp::cvt_pk_bf16(v0[0] * bflo(gg.x), v0[1] * bfhi(gg.x)); w.y = gp::cvt_pk_bf16(v0[2] * bflo(gg.y), v0[3] * bfhi(gg.y));
                    w.z = gp::cvt_pk_bf16(v1[0] * bflo(gg.z), v1[1] * bfhi(gg.z)); w.w = gp::cvt_pk_bf16(v1[2] * bflo(gg.w), v1[3] * bfhi(gg.w));
                    *(u32x4*)(gb + (size_t)(row0 + ai * 128 + m * 16) * ld + bj * 128) = w; }
            asm volatile("" ::: "memory"); }
    }
};
struct SchedGM {
    static constexpr bool GATHER = false; static constexpr bool VARSTRIDE = true;
    const bf16_t *A0, *A1, *A2, *Ag; const bf16_t *Bbr, *Bg; int nM, G_, c, skipctx, lda2, ldb2;
    __device__ __forceinline__ bool next(int i, gp::GUnit& u) const {
        int pmv, pn12; if (!gp::tile_order(i >> 1, G_, c, nM, 12, pmv, pn12)) return false;
        const int kind = i & 1, n = pn12 >> 2, pn = pn12 & 3;
        const int pm = skipctx ? pmv + pmv / 32 : pmv;
        const bf16_t* a0 = opq(A0); const bf16_t* a1 = opq(A1); const bf16_t* a2 = opq(A2); const bf16_t* ag = opq(Ag);
        const bf16_t* a = n == 0 ? a0 : (n == 1 ? a1 : a2);
        if (kind == 0) { u.A = (const char*)(a + (size_t)pm * 256 * 512); u.B = (const char*)(Bbr + (size_t)n * 1024 * 512 + (size_t)pn * 256 * 512); u.nt = 8; u.lda2 = 1024; u.ldb2 = 1024; }
        else { u.A = (const char*)(ag + (size_t)pm * 256 * 1024); u.B = (const char*)(Bg + (size_t)pn12 * 256 * 1024); u.nt = 16; u.lda2 = 2048; u.ldb2 = 2048; }
        u.pm = pm; u.pn = pn; u.tag = n + 4 * kind; u.goff = nullptr; return true;
    }
};
struct EpiGM {
    static constexpr bool PERM = true;
    bf16_t* U; long nstride; int ld;
    __device__ __forceinline__ void operator()(const f32x4 (&acc)[2][2][4][2], const gp::GUnit& u, int wr, int wc, int fr, int fq) const {
        const int n3 = u.tag & 3; const int col = u.pn * 256 + wc * 32 + 8 * fq; bf16_t* gb = U + (size_t)n3 * nstride + col; const int row0 = u.pm * 256 + wr * 64 + fr;
        if (u.tag < 4) {
#pragma unroll
            for (int ai = 0; ai < 2; ++ai)
#pragma unroll
                for (int m = 0; m < 4; ++m)
#pragma unroll
                    for (int bj = 0; bj < 2; ++bj) { const f32x4 v0 = acc[ai][bj][m][0], v1 = acc[ai][bj][m][1];
                        u32x4 w; w.x = gp::cvt_pk_bf16(v0[0], v0[1]); w.y = gp::cvt_pk_bf16(v0[2], v0[3]); w.z = gp::cvt_pk_bf16(v1[0], v1[1]); w.w = gp::cvt_pk_bf16(v1[2], v1[3]);
                        *(u32x4*)(gb + (size_t)(row0 + ai * 128 + m * 16) * ld + bj * 128) = w; }
        } else {
#pragma unroll
            for (int ai = 0; ai < 2; ++ai) { u32x4 z[4][2];
#pragma unroll
                for (int m = 0; m < 4; ++m)
#pragma unroll
                    for (int bj = 0; bj < 2; ++bj) z[m][bj] = *(const u32x4*)(gb + (size_t)(row0 + ai * 128 + m * 16) * ld + bj * 128);
#pragma unroll
                for (int m = 0; m < 4; ++m)
#pragma unroll
                    for (int bj = 0; bj < 2; ++bj) { const u32x4 zz = z[m][bj]; const f32x4 v0 = acc[ai][bj][m][0], v1 = acc[ai][bj][m][1];
                        u32x4 w; w.x = gp::cvt_pk_bf16(fsigmoid(v0[0]) * bflo(zz.x), fsigmoid(v0[1]) * bfhi(zz.x)); w.y = gp::cvt_pk_bf16(fsigmoid(v0[2]) * bflo(zz.y), fsigmoid(v0[3]) * bfhi(zz.y));
                        w.z = gp::cvt_pk_bf16(fsigmoid(v1[0]) * bflo(zz.z), fsigmoid(v1[1]) * bfhi(zz.z)); w.w = gp::cvt_pk_bf16(fsigmoid(v1[2]) * bflo(zz.w), fsigmoid(v1[3]) * bfhi(zz.w));
                        *(u32x4*)(gb + (size_t)(row0 + ai * 128 + m * 16) * ld + bj * 128) = w; }
                asm volatile("" ::: "memory"); }
        }
    }
};
struct EpiOut {
    static constexpr bool PERM = false;
    const float *xl_src, *xc_src; float *xl_dst, *xc_dst; const float* mod; int pmoff;
    __device__ __forceinline__ void operator()(const f32x4 (&acc)[2][2][4][2], const gp::GUnit& u, int wr, int wc, int fr, int fq) const {
        const int gpm = u.pm + pmoff, b = gpm / 33, pr = gpm - b * 33; const bool lat = pr < 32;
        const float* xs = opq(lat ? xl_src : xc_src); float* xd = opq(lat ? xl_dst : xc_dst);
        const size_t rbase = lat ? ((size_t)b * SEQ + pr * 256) : ((size_t)b * CTXL);
        const float* gt = mod + (size_t)(lat ? b : 4) * 6144 + 2048; const int col0 = u.pn * 256 + wc * 32 + 4 * fq;
        f32x4 g4[2][2];
#pragma unroll
        for (int bj = 0; bj < 2; ++bj)
#pragma unroll
            for (int n = 0; n < 2; ++n) g4[bj][n] = *(const f32x4*)(gt + col0 + bj * 128 + n * 16);
#pragma unroll
        for (int ai = 0; ai < 2; ++ai) { f32x4 xv[4][2][2];
#pragma unroll
            for (int m = 0; m < 4; ++m) { const size_t off = (rbase + ai * 128 + wr * 64 + m * 16 + fr) * D + col0;
#pragma unroll
                for (int bj = 0; bj < 2; ++bj)
#pragma unroll
                    for (int n = 0; n < 2; ++n) xv[m][bj][n] = *(const f32x4*)(xs + off + bj * 128 + n * 16); }
#pragma unroll
            for (int m = 0; m < 4; ++m) { const size_t off = (rbase + ai * 128 + wr * 64 + m * 16 + fr) * D + col0;
#pragma unroll
                for (int bj = 0; bj < 2; ++bj)
#pragma unroll
                    for (int n = 0; n < 2; ++n) *(f32x4*)(xd + off + bj * 128 + n * 16) = xv[m][bj][n] + g4[bj][n] * acc[ai][bj][m][n]; }
            asm volatile("" ::: "memory"); }
    }
};
template <bool GATHER_> struct SchedMoE {
    static constexpr bool GATHER = GATHER_; static constexpr bool VARSTRIDE = false;
    const bf16_t* A; const bf16_t* Bt; const int* tile_e; const unsigned* goff; int K, nM, nN, G_, c, lda2, ldb2; long strideB;
    __device__ __forceinline__ bool next(int i, gp::GUnit& u) const {
        int pm, pn; if (!gp::tile_order(i, G_, c, nM, nN, pm, pn)) return false;
        const int e = tile_e[pm];
        u.A = GATHER ? (const char*)A : (const char*)(A + (size_t)pm * 256 * K); u.B = (const char*)(Bt + (size_t)e * strideB + (size_t)pn * 256 * K); u.nt = K / 64; u.pm = pm; u.pn = pn; u.tag = e;
        u.goff = GATHER ? goff + (size_t)pm * 256 : nullptr; return true;
    }
};
struct EpiUp {
    static constexpr bool PERM = true;
    bf16_t* AUP;
    __device__ __forceinline__ void operator()(const f32x4 (&acc)[2][2][4][2], const gp::GUnit& u, int wr, int wc, int fr, int fq) const {
        const int row0 = u.pm * 256 + wr * 64 + fr; bf16_t* base = AUP + u.pn * 128 + wc * 32 + 8 * fq;
#pragma unroll
        for (int ai = 0; ai < 2; ++ai)
#pragma unroll
            for (int m = 0; m < 4; ++m) { const f32x4 a0 = acc[ai][0][m][0], a1 = acc[ai][0][m][1], b0 = acc[ai][1][m][0], b1 = acc[ai][1][m][1];
                float r[8];
#pragma unroll
                for (int e = 0; e < 4; ++e) { r[e] = a0[e] * fsigmoid(a0[e]) * b0[e]; r[4 + e] = a1[e] * fsigmoid(a1[e]) * b1[e]; }
                u32x4 w; w.x = gp::cvt_pk_bf16(r[0], r[1]); w.y = gp::cvt_pk_bf16(r[2], r[3]); w.z = gp::cvt_pk_bf16(r[4], r[5]); w.w = gp::cvt_pk_bf16(r[6], r[7]);
                *(u32x4*)(base + (size_t)(row0 + ai * 128 + m * 16) * 256) = w; }
    }
};
struct EpiDown {
    static constexpr bool PERM = true;
    bf16_t* YM2; const int* perm; const float* posw;
    __device__ __forceinline__ void operator()(const f32x4 (&acc)[2][2][4][2], const gp::GUnit& u, int wr, int wc, int fr, int fq) const {
        const int row0 = u.pm * 256 + wr * 64 + fr; const int col = u.pn * 256 + wc * 32 + 8 * fq;
#pragma unroll
        for (int ai = 0; ai < 2; ++ai)
#pragma unroll
            for (int m = 0; m < 4; ++m) { const int pos = row0 + ai * 128 + m * 16; const int pe = perm[pos]; const float w8 = posw[pos];
                if (pe >= 0) {
#pragma unroll
                    for (int bj = 0; bj < 2; ++bj) { const f32x4 v0 = acc[ai][bj][m][0] * w8, v1 = acc[ai][bj][m][1] * w8;
                        u32x4 w; w.x = gp::cvt_pk_bf16(v0[0], v0[1]); w.y = gp::cvt_pk_bf16(v0[2], v0[3]); w.z = gp::cvt_pk_bf16(v1[0], v1[1]); w.w = gp::cvt_pk_bf16(v1[2], v1[3]);
                        *(u32x4*)(YM2 + (size_t)pe * 1024 + col + bj * 128) = w; } } }
    }
};
enum { MAP_WIN = 1, MAP_WC = 2, MAP_WUP = 3 };
__device__ __forceinline__ int colmap(int kind, int p) {
    if (kind == MAP_WIN) {
        if (p >= 3840) return MIXW + (p - 3840);
        const int pn = p >> 8, q = p & 255, bj = q >> 7, wc = (q >> 5) & 3, j = q & 31;
        if (pn < 3) return (pn * 4 + wc) * 64 + bj * 32 + j;
        if (pn < 14) return p;
        if (bj == 0) return p;
        if (wc != 0) return -1;
        return 3712 + 16 * ((j >> 2) & 1) + 4 * (j >> 3) + (j & 3);
    }
    return p;
}
constexpr int NCHK = RPB / 64;
struct ScanArgs { const bf16_t* BQ; const bf16_t* BV; const bf16_t* BG; const f16_t* BLF; const f16_t* BLB; bf16_t* ST; float* DS; bf16_t* OB; const float* gn; int in_off; int out_off; int skipctx_out; int pad; };
#define MFMA16(a, b, c) __builtin_amdgcn_mfma_f32_16x16x32_bf16(a, b, c, 0, 0, 0)
constexpr int BCS = 68;
constexpr int SC_RAW = 0, SC_VT = 2 * 64 * BCS * 4, SC_A = SC_VT + 9216;
__device__ __forceinline__ void scan_stage(LAS char* lds, const ScanArgs& a, size_t row0, int h, int tid) {
    LAS float* RAW = (LAS float*)(lds + SC_RAW); LAS bf16_t* VT = (LAS bf16_t*)(lds + SC_VT);
    const int row = tid >> 3, c8 = (tid & 7) * 8; const size_t off = (row0 + row) * 512 + h * 64 + c8;
    typedef _Float16 h8 __attribute__((ext_vector_type(8)));
    const h8 lf = *(const h8*)(a.BLF + off), lb = *(const h8*)(a.BLB + off);
    const int vrow = tid & 63, vc8 = (tid >> 6) * 8; const bf16x8 v = *(const bf16x8*)(a.BV + (row0 + vrow) * 512 + h * 64 + vc8);
    *(LAS f32x4*)(RAW + row * BCS + c8) = (f32x4){(float)lf[0], (float)lf[1], (float)lf[2], (float)lf[3]}; *(LAS f32x4*)(RAW + row * BCS + c8 + 4) = (f32x4){(float)lf[4], (float)lf[5], (float)lf[6], (float)lf[7]};
    *(LAS f32x4*)(RAW + 64 * BCS + row * BCS + c8) = (f32x4){(float)lb[0], (float)lb[1], (float)lb[2], (float)lb[3]}; *(LAS f32x4*)(RAW + 64 * BCS + row * BCS + c8 + 4) = (f32x4){(float)lb[4], (float)lb[5], (float)lb[6], (float)lb[7]};
#pragma unroll
    for (int j = 0; j < 8; ++j) VT[(vc8 + j) * 72 + vrow] = (bf16_t)v[j];
}
__device__ __forceinline__ void scan_cumsum(LAS char* lds, LAS float* XCH, int tid, float (&lf)[16], float (&bc)[16], float& total) {
    LAS float* RAW = (LAS float*)(lds + SC_RAW);
    const int col = tid & 127, dir = col >> 6, d = col & 63, seg = tid >> 7;
#pragma unroll
    for (int j = 0; j < 16; ++j) lf[j] = RAW[dir * 64 * BCS + (16 * seg + j) * BCS + d];
    if (dir == 0) { float c = 0.f;
#pragma unroll
        for (int j = 0; j < 16; ++j) { c += lf[j]; bc[j] = c; } }
    else { float c = 0.f;
#pragma unroll
        for (int j = 15; j >= 0; --j) { c += lf[j]; bc[j] = c; } }
    XCH[seg * 128 + col] = dir == 0 ? bc[15] : bc[0];
    __syncthreads();
    const float t0 = XCH[col], t1 = XCH[128 + col], t2 = XCH[256 + col], t3 = XCH[384 + col];
    total = (t0 + t1) + (t2 + t3);
    float off;
    if (dir == 0) off = seg == 0 ? 0.f : (seg == 1 ? t0 : (seg == 2 ? t0 + t1 : t0 + t1 + t2));
    else off = seg == 3 ? 0.f : (seg == 2 ? t3 : (seg == 1 ? t3 + t2 : t3 + t2 + t1));
#pragma unroll
    for (int j = 0; j < 16; ++j) bc[j] += off;
}
__device__ __forceinline__ void scan_s1_unit(LAS char* lds, const ScanArgs& a, int wv0, int b, int h, int k) {
    const int tid = opaque_tid(wv0), lane = tid & 63, wid = tid >> 6;
    LAS bf16_t* VT = (LAS bf16_t*)(lds + SC_VT); LAS bf16_t* KKT = (LAS bf16_t*)(lds + SC_A); LAS float* XCH = (LAS float*)(lds + SC_A + 18432);
    const size_t row0 = (size_t)b * RPB + 64 * k - a.in_off;
    scan_stage(lds, a, row0, h, tid);
    __syncthreads();
    float lf[16], bc[16], total; scan_cumsum(lds, XCH, tid, lf, bc, total);
    const int col = tid & 127, dir = col >> 6, d = col & 63, seg = tid >> 7;
    const size_t sidx = ((size_t)((b * 8 + h) * 2 + dir)) * NCHK + k;
    { unsigned w[8];
#pragma unroll
      for (int j = 0; j < 16; j += 2) { const float k0 = (1.f - fexp(lf[j])) * fexp(total - bc[j]), k1 = (1.f - fexp(lf[j + 1])) * fexp(total - bc[j + 1]); w[j >> 1] = pkbf(k0, k1); }
      LAS u32x4* kp = (LAS u32x4*)(KKT + (dir * 64 + d) * 72 + 16 * seg); kp[0] = (u32x4){w[0], w[1], w[2], w[3]}; kp[1] = (u32x4){w[4], w[5], w[6], w[7]};
      if (seg == 0) a.DS[sidx * 64 + d] = fexp(total); }
    __syncthreads();
    { const int wdir = wid >> 2, et = wid & 3, fr = lane & 15, fq = lane >> 4;
      f32x4 acc[4];
#pragma unroll
      for (int dt = 0; dt < 4; ++dt) acc[dt] = (f32x4){0.f, 0.f, 0.f, 0.f};
#pragma unroll
      for (int ks = 0; ks < 2; ++ks) { const bf16x8 af = *(const LAS bf16x8*)(VT + (16 * et + fr) * 72 + 32 * ks + 8 * fq);
#pragma unroll
          for (int dt = 0; dt < 4; ++dt) { const bf16x8 bfv = *(const LAS bf16x8*)(KKT + (wdir * 64 + 16 * dt + fr) * 72 + 32 * ks + 8 * fq); acc[dt] = MFMA16(af, bfv, acc[dt]); } }
      bf16_t* sp = a.ST + (((size_t)((b * 8 + h) * 2 + wdir)) * NCHK + k) * 4096;
#pragma unroll
      for (int dt = 0; dt < 4; ++dt)
#pragma unroll
          for (int r = 0; r < 4; ++r) sp[(16 * et + 4 * fq + r) * 64 + 16 * dt + fr] = f2bf(acc[dt][r]); }
    __syncthreads();
}
__device__ __forceinline__ void scan_s2_task(const ScanArgs& a, int wv0, int task) {
    const int chain = task >> 2, quarter = task & 3, dir = chain & 1, tid = opaque_tid(wv0);
    const int e = 16 * quarter + (tid >> 5), d = 2 * (tid & 31);
    float s0 = 0.f, s1 = 0.f;
    for (int g = 0; g < NCHK; g += 12) {
        unsigned L[12]; float2 Dv[12]; unsigned* pp[12];
#pragma unroll
        for (int j = 0; j < 12; ++j) { const int step = g + j; const int k = dir == 0 ? (step < 4 ? 128 + step : step - 4) : (step < 4 ? 131 - step : 131 - step);
            const size_t idx = (size_t)chain * NCHK + k; pp[j] = (unsigned*)(a.ST + idx * 4096 + e * 64 + d); L[j] = *pp[j]; Dv[j] = *(const float2*)(a.DS + idx * 64 + d); }
#pragma unroll
        for (int j = 0; j < 12; ++j) { *pp[j] = pkbf(s0, s1); s0 = Dv[j].x * s0 + bflo(L[j]); s1 = Dv[j].y * s1 + bfhi(L[j]); }
    }
}
__device__ __forceinline__ void scan_s3_unit(LAS char* lds, const ScanArgs& a, int wv0, int b, int h, int k) {
    const int tid = opaque_tid(wv0), lane = tid & 63, wid = tid >> 6;
    LAS float* BC = (LAS float*)(lds + SC_RAW); LAS bf16_t* VT = (LAS bf16_t*)(lds + SC_VT);
    LAS bf16_t* STL = (LAS bf16_t*)(lds + SC_A);
    LAS float* XCH = (LAS float*)(lds + SC_A + 18432);
    LAS float* OSUM = (LAS float*)(lds + SC_A + 18432 + 2048);
    LAS bf16_t* PW = (LAS bf16_t*)(lds + SC_A + 18432 + 2048 + 17408) + wid * 3456;
    const size_t row0 = (size_t)b * RPB + 64 * k - a.in_off;
    bf16x8 q0_, q1_; bf16_t gpre[16];
    { const int dir_ = wid >> 2, si_ = wid & 3, erow_ = lane >> 2, dg_ = (lane & 3) * 16, fr_ = lane & 15, fq_ = lane >> 4;
      const bf16_t* qp = a.BQ + (row0 + 16 * si_ + erow_) * 512 + h * 64 + dg_; q0_ = *(const bf16x8*)qp; q1_ = *(const bf16x8*)(qp + 8);
      if (dir_ == 1) {
#pragma unroll
          for (int n = 0; n < 4; ++n)
#pragma unroll
              for (int r = 0; r < 4; ++r) gpre[n * 4 + r] = a.BG[(row0 + 16 * si_ + 4 * fq_ + r) * 512 + h * 64 + 16 * n + fr_]; }
      else {
#pragma unroll
          for (int i = 0; i < 16; ++i) gpre[i] = 0; } }
    scan_stage(lds, a, row0, h, tid);
    { const int sd = tid >> 8, e = (tid & 255) >> 2, c16 = (tid & 3) * 16;
      const bf16_t* sp = a.ST + (((size_t)((b * 8 + h) * 2 + sd)) * NCHK + k) * 4096 + e * 64 + c16;
      const u32x4 s0 = *(const u32x4*)sp, s1 = *(const u32x4*)(sp + 8);
      LAS u32x4* dp = (LAS u32x4*)(STL + (sd * 64 + e) * 72 + c16); dp[0] = s0; dp[1] = s1; }
    __syncthreads();
    { float lf[16], bc[16], total; scan_cumsum(lds, XCH, tid, lf, bc, total);
      const int col = tid & 127, dir = col >> 6, d = col & 63, seg = tid >> 7;
      __syncthreads();
#pragma unroll
      for (int j = 0; j < 16; ++j) BC[dir * 64 * BCS + (16 * seg + j) * BCS + d] = bc[j]; }
    __syncthreads();
    const int dir = wid >> 2, si = wid & 3;
    LAS bf16_t* QP = PW; LAS bf16_t* KP = PW + 1152; LAS bf16_t* ATT = PW + 2304;
    const int erow = lane >> 2, dg = (lane & 3) * 16;
    const int fr = lane & 15, fq = lane >> 4;
    LAS const float* bcd = BC + dir * 64 * BCS;
    float refv[16];
    { const int rr = dir == 0 ? 16 * si - 1 : 16 * (si + 1);
#pragma unroll
      for (int j = 0; j < 16; j += 4) { f32x4 t4 = (f32x4){0.f, 0.f, 0.f, 0.f}; if (rr >= 0 && rr < 64) t4 = *(const LAS f32x4*)(bcd + rr * BCS + dg + j); refv[j] = t4[0]; refv[j + 1] = t4[1]; refv[j + 2] = t4[2]; refv[j + 3] = t4[3]; } }
    float qv[16], bq[16];
    {
#pragma unroll
      for (int j = 0; j < 8; ++j) { qv[j] = bf2f((bf16_t)q0_[j]); qv[8 + j] = bf2f((bf16_t)q1_[j]); }
#pragma unroll
      for (int j = 0; j < 16; j += 4) { const f32x4 t4 = *(const LAS f32x4*)(bcd + (16 * si + erow) * BCS + dg + j); bq[j] = t4[0]; bq[j + 1] = t4[1]; bq[j + 2] = t4[2]; bq[j + 3] = t4[3]; } }
    { unsigned w[8];
#pragma unroll
      for (int j = 0; j < 16; j += 2) w[j >> 1] = pkbf(qv[j] * fexp(bq[j] - refv[j]), qv[j + 1] * fexp(bq[j + 1] - refv[j + 1]));
      LAS u32x4* p = (LAS u32x4*)(QP + erow * 72 + dg); p[0] = (u32x4){w[0], w[1], w[2], w[3]}; p[1] = (u32x4){w[4], w[5], w[6], w[7]};
      LAS u32x4* z = (LAS u32x4*)(ATT + erow * 72 + dg); z[0] = (u32x4){0u, 0u, 0u, 0u}; z[1] = (u32x4){0u, 0u, 0u, 0u}; }
    const int j_lo = dir == 0 ? 0 : si, j_hi = dir == 0 ? si : 3;
    for (int jb = j_lo; jb <= j_hi; ++jb) {
        { const int sg = 16 * jb + erow; const int sn = dir == 0 ? sg - 1 : sg + 1; unsigned w[8];
#pragma unroll
          for (int j = 0; j < 16; j += 4) { const f32x4 bs4 = *(const LAS f32x4*)(bcd + sg * BCS + dg + j); f32x4 bn4 = (f32x4){0.f, 0.f, 0.f, 0.f}; if (sn >= 0 && sn < 64) bn4 = *(const LAS f32x4*)(bcd + sn * BCS + dg + j);
              float kk[4];
#pragma unroll
              for (int t = 0; t < 4; ++t) kk[t] = (1.f - fexp(bs4[t] - bn4[t])) * fexp(fminf(refv[j + t] - bs4[t], 60.f));
              w[j >> 1] = pkbf(kk[0], kk[1]); w[(j >> 1) + 1] = pkbf(kk[2], kk[3]); }
          LAS u32x4* p = (LAS u32x4*)(KP + erow * 72 + dg); p[0] = (u32x4){w[0], w[1], w[2], w[3]}; p[1] = (u32x4){w[4], w[5], w[6], w[7]}; }
        __builtin_amdgcn_wave_barrier(); asm volatile("s_waitcnt lgkmcnt(0)" ::: "memory");
        f32x4 c = (f32x4){0.f, 0.f, 0.f, 0.f};
#pragma unroll
        for (int ks = 0; ks < 2; ++ks) { const bf16x8 af = *(const LAS bf16x8*)(QP + fr * 72 + 32 * ks + 8 * fq), bfv = *(const LAS bf16x8*)(KP + fr * 72 + 32 * ks + 8 * fq); c = MFMA16(af, bfv, c); }
#pragma unroll
        for (int r = 0; r < 4; ++r) { const int tq = 4 * fq + r; float v = c[r];
            if (jb == si) { if (dir == 0 ? (fr > tq) : (fr < tq)) v = 0.f; }
            ATT[tq * 72 + 16 * jb + fr] = f2bf(v); }
        __builtin_amdgcn_wave_barrier(); asm volatile("s_waitcnt lgkmcnt(0)" ::: "memory");
    }
    { unsigned w[8];
#pragma unroll
      for (int j = 0; j < 16; j += 2) w[j >> 1] = pkbf(qv[j] * fexp(bq[j]), qv[j + 1] * fexp(bq[j + 1]));
      LAS u32x4* p = (LAS u32x4*)(QP + erow * 72 + dg); p[0] = (u32x4){w[0], w[1], w[2], w[3]}; p[1] = (u32x4){w[4], w[5], w[6], w[7]}; }
    __builtin_amdgcn_wave_barrier(); asm volatile("s_waitcnt lgkmcnt(0)" ::: "memory");
    f32x4 o[4];
#pragma unroll
    for (int n = 0; n < 4; ++n) o[n] = (f32x4){0.f, 0.f, 0.f, 0.f};
#pragma unroll
    for (int ks = 0; ks < 2; ++ks) { const bf16x8 aq = *(const LAS bf16x8*)(QP + fr * 72 + 32 * ks + 8 * fq), aa = *(const LAS bf16x8*)(ATT + fr * 72 + 32 * ks + 8 * fq);
#pragma unroll
        for (int n = 0; n < 4; ++n) { const bf16x8 bs = *(const LAS bf16x8*)(STL + (dir * 64 + 16 * n + fr) * 72 + 32 * ks + 8 * fq), bv = *(const LAS bf16x8*)(VT + (16 * n + fr) * 72 + 32 * ks + 8 * fq);
            o[n] = MFMA16(aq, bs, o[n]); o[n] = MFMA16(aa, bv, o[n]); } }
    if (dir == 0) {
#pragma unroll
        for (int n = 0; n < 4; ++n)
#pragma unroll
            for (int r = 0; r < 4; ++r) OSUM[(16 * si + 4 * fq + r) * 68 + 16 * n + fr] = o[n][r]; }
    __syncthreads();
    if (dir == 1) {
        const bool wr_out = !(a.skipctx_out && k >= 128) && !a.pad;
        float ss[4] = {0.f, 0.f, 0.f, 0.f};
#pragma unroll
        for (int n = 0; n < 4; ++n)
#pragma unroll
            for (int r = 0; r < 4; ++r) { o[n][r] += OSUM[(16 * si + 4 * fq + r) * 68 + 16 * n + fr]; ss[r] += o[n][r] * o[n][r]; }
#pragma unroll
        for (int r = 0; r < 4; ++r) { ss[r] += __shfl_xor(ss[r], 1); ss[r] += __shfl_xor(ss[r], 2); ss[r] += __shfl_xor(ss[r], 4); ss[r] += __shfl_xor(ss[r], 8); ss[r] = rsqrtf(ss[r] * (1.f / 64.f) + EPS); }
        if (wr_out) {
            const size_t orow0 = (size_t)b * RPB + 64 * k - a.out_off;
#pragma unroll
            for (int n = 0; n < 4; ++n)
#pragma unroll
                for (int r = 0; r < 4; ++r) { const int tq = 16 * si + 4 * fq + r, e = 16 * n + fr; const float gv = bf2f(gpre[n * 4 + r]);
                    a.OB[(orow0 + tq) * 512 + h * 64 + e] = f2bf(o[n][r] * ss[r] * a.gn[h * 64 + e] * gv * fsigmoid(gv)); }
        }
    }
    __syncthreads();
}
constexpr int SCAN_LDS = SC_A + 18432 + 2048 + 17408 + 8 * 6912;

#define XB_TMO      128
#define XB_XCNT(j)  (256  + 64 * (j))
#define XB_XSUB(j)  (1280 + 64 * (j))
#define XB_XGEN(j)  (2304 + 64 * (j))
#define XB_TOP      3328
#define XB_TOPGEN   3392
#define XCD_BAR_WORDS 3456
#define XB_SPIN_CAP (1u << 18)

__device__ __forceinline__ unsigned xb_ld(unsigned* p)              { return __hip_atomic_load(p, __ATOMIC_RELAXED, __HIP_MEMORY_SCOPE_AGENT); }
__device__ __forceinline__ unsigned xb_add(unsigned* p, unsigned v) { return __hip_atomic_fetch_add(p, v, __ATOMIC_RELAXED, __HIP_MEMORY_SCOPE_AGENT); }
__device__ __forceinline__ unsigned xb_xcc_id() { return (unsigned)__builtin_amdgcn_s_getreg((3 << 11) | 20) & 0xFu; }
#define XB_SPIN(cond, bar) do { unsigned _sp = 0; while (cond) { __builtin_amdgcn_s_sleep(1); \
    if ((++_sp & 255u) == 0u) { if (xb_ld(&(bar)[XB_TMO])) break; if (_sp > XB_SPIN_CAP) { atomicAdd(&(bar)[XB_TMO], 1u); break; } } } } while (0)

struct XcdBarrier {
    unsigned* bar; unsigned x;
    volatile LAS unsigned* st;
};

__device__ __forceinline__ XcdBarrier xcd_barrier_post(unsigned* bar, volatile LAS unsigned* st) {
    XcdBarrier b; b.bar = bar; b.x = xb_xcc_id(); b.st = st;
    if (threadIdx.x == 0) (void)xb_add(&bar[XB_XCNT(b.x)], 1u);
    return b;
}
__device__ __forceinline__ void xcd_barrier_complete(unsigned* bar, unsigned x, unsigned& nloc, unsigned& nx) {
    const unsigned G = gridDim.x * gridDim.y * gridDim.z;
    unsigned sum, cnt, mine, sp = 0u;
    for (;;) {
        sum = 0u; cnt = 0u; mine = 0u;
#pragma unroll
        for (unsigned j = 0; j < 16; ++j) { const unsigned c = xb_ld(&bar[XB_XCNT(j)]); sum += c; cnt += (c > 0u) ? 1u : 0u; mine = (j == x) ? c : mine; }
        if (sum == G) break;
        __builtin_amdgcn_s_sleep(1);
        if ((++sp & 255u) == 0u) { if (xb_ld(&bar[XB_TMO])) break; if (sp > XB_SPIN_CAP) { atomicAdd(&bar[XB_TMO], 1u); break; } }
    }
    nloc = mine > 0u ? mine : 1u; nx = cnt > 0u ? cnt : 1u;
}

__device__ __forceinline__ void xcd_barrier(const XcdBarrier& b) {
    asm volatile("s_waitcnt vmcnt(0)" ::: "memory");
    __syncthreads();
    if (threadIdx.x == 0) {
        unsigned* bar = b.bar;
        __builtin_amdgcn_s_waitcnt(0);
        unsigned nloc = b.st[0], nx = b.st[1];
        if (nloc == 0u) { xcd_barrier_complete(bar, b.x, nloc, nx); b.st[0] = nloc; b.st[1] = nx; }
        const unsigned old = xb_add(&bar[XB_XSUB(b.x)], 1u);
        const unsigned gen = old / nloc;
        if (old + 1u == (gen + 1u) * nloc) {
            __builtin_amdgcn_fence(__ATOMIC_RELEASE, "agent");
            asm volatile("s_waitcnt vmcnt(0)" ::: "memory");
            const unsigned og = xb_add(&bar[XB_TOP], 1u);
            const unsigned tg = og / nx;
            if (og + 1u == (tg + 1u) * nx) xb_add(&bar[XB_TOPGEN], 1u);
            else XB_SPIN(xb_ld(&bar[XB_TOPGEN]) == tg, bar);
            __builtin_amdgcn_fence(__ATOMIC_ACQUIRE, "agent");
            xb_add(&bar[XB_XGEN(b.x)], 1u);
            asm volatile("s_waitcnt vmcnt(0)" ::: "memory");
        } else {
            XB_SPIN(xb_ld(&bar[XB_XGEN(b.x)]) == gen, bar);
            __builtin_amdgcn_fence(__ATOMIC_ACQUIRE, "agent");
            asm volatile("s_waitcnt vmcnt(0)" ::: "memory");
        }
    }
    __syncthreads();
}


constexpr size_t MiB = 1u << 20;
constexpr size_t CTL_ZERO_BYTES = 64 * 1024;
constexpr int CW_COUNTS = 8192, CW_CURSOR = 8192 + 128;
constexpr size_t O_MOD = 1 * MiB, O_LB = 1 * MiB + 512 * 1024, O_ROPA_C = 2 * MiB, O_ROPA_S = 3 * MiB, O_ROPC_C = 4 * MiB, O_ROPC_S = 4 * MiB + 512 * 1024, O_XC = 5 * MiB;
constexpr size_t O_ROUTE_E = 9 * MiB, O_ROUTE_W = 9 * MiB + 512 * 1024, O_PERM = 10 * MiB, O_POSW = 10 * MiB + 512 * 1024, O_GOFF = 11 * MiB, O_TILEE = 11 * MiB + 512 * 1024;
constexpr size_t O_WRT = 11 * MiB + 640 * 1024;
constexpr size_t O_RS = 12 * MiB, O_DS = 13 * MiB + 512 * 1024, O_WGH = 15 * MiB + 768 * 1024;
constexpr size_t O_WINP = 16 * MiB, O_WC = 30 * MiB, O_WBR = 32 * MiB, O_WOUT = 35 * MiB;
constexpr size_t O_H = 38 * MiB;
constexpr size_t O_AQ = 104 * MiB, O_AK = 137 * MiB, O_AV = 145 * MiB + 512 * 1024;
constexpr size_t O_BQ = 154 * MiB, O_BV = 187 * MiB, O_BG = 220 * MiB, O_BLF = 253 * MiB, O_BLB = 286 * MiB;
constexpr size_t O_CQKV = 319 * MiB, O_CKR = 344 * MiB, O_CQ = 347 * MiB, O_CKV = 397 * MiB, O_OC = 463 * MiB, O_WRB = 496 * MiB, WS_END = 497 * MiB;
constexpr size_t O_GATE = 187 * MiB;
constexpr size_t O_YM2 = 154 * MiB, O_AUP = 104 * MiB, O_WUP = 397 * MiB, O_WDN = 429 * MiB;
constexpr int LDS_BYTES = 163840, LDS_BAR_OFF = LDS_BYTES - 64, LDS_PTR_OFF = LDS_BYTES - 512;

struct KP { const float* in[24]; float* out; char* ws; int ph_lo, ph_hi; unsigned long long mask; };
struct Frame {
    LAS char* lds; char* ws; float* out; int wv0;
};
#define WSP(T, off) ((T*)(F.ws + (off)))
__device__ __forceinline__ const float* in_ptr(const Frame& F, int k) { const volatile LAS unsigned* q = (const volatile LAS unsigned*)(F.lds + LDS_PTR_OFF + 8 * k);
    unsigned lo = q[0], hi = q[1]; lo = __builtin_amdgcn_readfirstlane(lo); hi = __builtin_amdgcn_readfirstlane(hi); return (const float*)(((unsigned long long)hi << 32) | lo); }
#define INP(k) in_ptr(F, k)
__device__ __forceinline__ float wave_sum_dpp(float v) {
    int x = __builtin_bit_cast(int, v);
#define DPP_ADD(ctrl, rmask) x = __builtin_bit_cast(int, __builtin_bit_cast(float, x) + __builtin_bit_cast(float, __builtin_amdgcn_update_dpp(0, x, ctrl, rmask, 0xF, false)))
    DPP_ADD(0xB1, 0xF);
    DPP_ADD(0x4E, 0xF);
    DPP_ADD(0x141, 0xF);
    DPP_ADD(0x140, 0xF);
    DPP_ADD(0x142, 0xA);
    DPP_ADD(0x143, 0xC);
#undef DPP_ADD
    return __builtin_bit_cast(float, __builtin_amdgcn_readlane(x, 63));
}
__device__ __forceinline__ float wave_sum(float v) {
#pragma unroll
    for (int o = 32; o >= 1; o >>= 1) v += __shfl_xor(v, o);
    return v;
}

__device__ __forceinline__ void p0_mod(const Frame& F) {
    const int tid = opaque_tid(F.wv0), lane = tid & 63, wave = __builtin_amdgcn_readfirstlane(tid >> 6); (void)lane; (void)wave;
    LAS float* sc = (LAS float*)F.lds;
    LAS float* red = (LAS float*)(F.lds + 20480);
    for (int i = tid; i < 5 * 1024; i += 512) { const int r = i >> 10, k = i & 1023; const float v = r < 4 ? INP(1)[r * 1024 + k] : INP(3)[k]; sc[i] = v / (1.f + expf(-v)); }
    __syncthreads();
    float* MOD = WSP(float, O_MOD);
    for (int u = blockIdx.x; u < 2 * 96; u += gridDim.x) { const int l = u / 96, j = (u % 96) * 64 + lane;
        const float* w = INP(4) + (size_t)l * 1024 * 6144 + j; float a0 = 0.f, a1 = 0.f, a2 = 0.f, a3 = 0.f, a4 = 0.f;
#pragma unroll 8
        for (int kk = 0; kk < 128; ++kk) { const int k = wave * 128 + kk; const float wv = w[(size_t)k * 6144]; a0 += sc[k] * wv; a1 += sc[1024 + k] * wv; a2 += sc[2048 + k] * wv; a3 += sc[3072 + k] * wv; a4 += sc[4096 + k] * wv; }
        red[(wave * 5 + 0) * 64 + lane] = a0; red[(wave * 5 + 1) * 64 + lane] = a1; red[(wave * 5 + 2) * 64 + lane] = a2; red[(wave * 5 + 3) * 64 + lane] = a3; red[(wave * 5 + 4) * 64 + lane] = a4;
        __syncthreads();
        if (tid < 320) { const int r = tid >> 6, ln = tid & 63; float s = 0.f;
#pragma unroll
            for (int w8 = 0; w8 < 8; ++w8) s += red[(w8 * 5 + r) * 64 + ln];
            const int jj = (u % 96) * 64 + ln; MOD[(size_t)(l * 5 + r) * 6144 + jj] = s + INP(5)[l * 6144 + jj]; }
        __syncthreads();
    }
}
__device__ __forceinline__ void p0_tables(const Frame& F) {
    const int tid = opaque_tid(F.wv0), lane = tid & 63, wave = __builtin_amdgcn_readfirstlane(tid >> 6); (void)lane; (void)wave;
    float* ropa_c = WSP(float, O_ROPA_C); float* ropa_s = WSP(float, O_ROPA_S); float* ropc_c = WSP(float, O_ROPC_C); float* ropc_s = WSP(float, O_ROPC_S); float* LB = WSP(float, O_LB);
    for (int i = blockIdx.x * 512 + tid; i < 8192 * 32; i += gridDim.x * 512) {
        { const int t = i >> 5, j = i & 31, row = t >> 6, col = t & 63, f = j & 15; const float inv = powf(10000.f, -(float)f / 16.f); const float ang = (j < 16 ? (float)row : (float)col) * inv;
          ropa_c[i] = (float)cos((double)ang); ropa_s[i] = (float)sin((double)ang); }
        if (i < 8192 * 16) { const int t = i >> 4, j = i & 15, row = t >> 6, col = t & 63, f = j & 7; const float inv = powf(10000.f, -(float)f / 8.f); const float ang = (j < 8 ? (float)row : (float)col) * inv;
          ropc_c[i] = (float)cos((double)ang); ropc_s[i] = (float)sin((double)ang); }
        for (int i2 = i; i2 < 2 * 256 * 1024; i2 += 8192 * 32) { const int l = i2 >> 18, pp = (i2 >> 10) & 255, k = i2 & 1023;
          const int bj = pp >> 7, wc = (pp >> 5) & 3, n = (pp >> 4) & 1, fq = (pp >> 2) & 3, e = pp & 3; float v = 0.f;
          if (wc == 0) { if (bj == 0) v = INP(19)[(size_t)l * 1024 * 32 + k * 32 + fq * 8 + 4 * n + e]; else if (n == 0 && e == 0) v = INP(18)[(size_t)l * 1024 * 4 + k * 4 + fq]; }
          WSP(bf16_t, O_WRB)[i2] = f2bf(v); }
        if (i < 2048) { const int l = i >> 10, rest = i & 1023; if (l == 0) LB[i] = 0.f; else { const float a0 = INP(10)[rest], a1 = INP(10)[1024 + rest]; LB[i] = 1.f / (1.f + expf(a0 - a1)); } }
    }
}
template <class CM> __device__ __forceinline__ void wt_tile(const float* W, int ldw, const CM& cm, bf16_t* Bt, int K, int p0, int k0, LAS float* scr, int lane) {
    const int p4 = (lane & 7) * 4; const int c = cm(p0 + p4);
#pragma unroll
    for (int i = 0; i < 8; ++i) { const int kk = i * 8 + (lane >> 3); f32x4 v = (f32x4){0.f, 0.f, 0.f, 0.f};
        if (c >= 0) v = *(const f32x4*)(W + (size_t)(k0 + kk) * ldw + c);
        scr[kk * 33 + p4] = v[0]; scr[kk * 33 + p4 + 1] = v[1]; scr[kk * 33 + p4 + 2] = v[2]; scr[kk * 33 + p4 + 3] = v[3]; }
    asm volatile("s_waitcnt lgkmcnt(0)" ::: "memory"); __builtin_amdgcn_wave_barrier();
#pragma unroll 8
    for (int pi = 0; pi < 32; ++pi) Bt[(size_t)(p0 + pi) * K + k0 + lane] = f2bf(scr[lane * 33 + pi]);
    asm volatile("s_waitcnt lgkmcnt(0)" ::: "memory"); __builtin_amdgcn_wave_barrier();
}
struct CmWin { __device__ __forceinline__ int operator()(int p) const { return colmap(MAP_WIN, p); } };
struct CmId { __device__ __forceinline__ int operator()(int p) const { return p; } };
__device__ __forceinline__ void conv_weights_nonmoe(const Frame& F, int l) {
    const int tid = opaque_tid(F.wv0), lane = tid & 63, wave = __builtin_amdgcn_readfirstlane(tid >> 6); (void)lane; (void)wave;
    LAS float* scr = (LAS float*)F.lds + wave * (64 * 33);
    const int gw = blockIdx.x * 8 + wave, NGW = gridDim.x * 8;
    constexpr int I_WIN = 216 * 16, I_BR = 3 * 32 * 8, I_OUT = 32 * 16;
    for (int it = gw; it < I_WIN + I_BR + I_OUT; it += NGW) {
        int r = it;
        if (r < I_WIN) { wt_tile(INP(8) + (size_t)l * 1024 * INW, INW, CmWin(), WSP(bf16_t, O_WINP), 1024, (r / 16) * 32, (r % 16) * 64, scr, lane); continue; } r -= I_WIN;
        if (r < I_BR) { const int n = r / 256, q = r % 256; wt_tile(INP(16) + ((size_t)l * 3 + n) * 512 * 1024, 1024, CmId(), WSP(bf16_t, O_WBR) + (size_t)n * 1024 * 512, 512, (q / 8) * 32, (q % 8) * 64, scr, lane); continue; } r -= I_BR;
        wt_tile(INP(17) + (size_t)l * 1024 * 1024, 1024, CmId(), WSP(bf16_t, O_WOUT), 1024, (r / 16) * 32, (r % 16) * 64, scr, lane);
    }
    const float* wuq = INP(14) + (size_t)l * 256 * 768; const float* wukv = INP(15) + (size_t)l * 128 * 1024; const float* gq = INP(12) + l * 256; const float* gkv = INP(13) + l * 128; bf16_t* WC = WSP(bf16_t, O_WC);
    for (int i = blockIdx.x * 512 + tid; i < 1792 * 384; i += gridDim.x * 512) {
        const int pp = i / 384, k = i % 384; float v = 0.f;
        if (pp < 768) { const int pn = pp >> 8, q = pp & 255, bj = q >> 7, wc = (q >> 5) & 3, j = q & 31; const int gi = pn * 8 + bj * 4 + wc, head = gi / 3, part = gi - head * 3;
            const int p = part < 2 ? head * 96 + part * 32 + j : head * 96 + 64 + 16 * ((j >> 2) & 1) + 4 * (j >> 3) + (j & 3);
            if (k < 256) v = wuq[k * 768 + p] * gq[k]; }
        else { if (k >= 256) v = wukv[(k - 256) * 1024 + (pp - 768)] * gkv[k - 256]; }
        WC[i] = f2bf(v); }
}
struct CmUp { __device__ __forceinline__ int operator()(int p) const { return ((p >> 8) << 7) + (p & 127); } };
__device__ __forceinline__ void conv_weights_moe(const Frame& F, int l) {
    const int tid = opaque_tid(F.wv0), lane = tid & 63, wave = __builtin_amdgcn_readfirstlane(tid >> 6); (void)lane; (void)wave;
    LAS float* scr = (LAS float*)F.lds + wave * (64 * 33);
    const int gw = blockIdx.x * 8 + wave, NGW = gridDim.x * 8;
    constexpr int I_UP = 32 * 16 * 16, I_DN = 32 * 32 * 4;
    for (int it = gw; it < I_UP + I_DN; it += NGW) {
        int r = it;
        if (r < I_UP) { const int e = r / 256, q = r % 256, p0 = (q / 16) * 32, k0 = (q % 16) * 64; const bool isw3 = (p0 >> 7) & 1;
            const float* W = (isw3 ? INP(21) : INP(20)) + ((size_t)l * 32 + e) * 1024 * 256;
            wt_tile(W, 256, CmUp(), WSP(bf16_t, O_WUP) + (size_t)e * 512 * 1024, 1024, p0, k0, scr, lane); continue; } r -= I_UP;
        { const int e = r / 128, q = r % 128; wt_tile(INP(22) + ((size_t)l * 32 + e) * 256 * 1024, 1024, CmId(), WSP(bf16_t, O_WDN) + (size_t)e * 1024 * 256, 256, (q / 4) * 32, (q % 4) * 64, scr, lane); }
    }
}

__device__ __forceinline__ void rp_load(const float* xs, float* xd, bool wx, const bf16_t* ym, const float* gt, int lane, f32x4 (&v)[4], float& rinv) {
    float ss = 0.f;
#pragma unroll
    for (int j = 0; j < 4; ++j) { const int c = 4 * lane + 256 * j; v[j] = *(const f32x4*)(xs + c);
        if (ym) { const uint2 y0 = *(const uint2*)(ym + c), y1 = *(const uint2*)(ym + 1024 + c); const f32x4 g4 = *(const f32x4*)(gt + c);
            v[j][0] += g4[0] * (bflo(y0.x) + bflo(y1.x)); v[j][1] += g4[1] * (bfhi(y0.x) + bfhi(y1.x)); v[j][2] += g4[2] * (bflo(y0.y) + bflo(y1.y)); v[j][3] += g4[3] * (bfhi(y0.y) + bfhi(y1.y)); }
        if (wx) *(f32x4*)(xd + c) = v[j];
        ss += v[j][0] * v[j][0] + v[j][1] * v[j][1] + v[j][2] * v[j][2] + v[j][3] * v[j][3]; }
    rinv = rsqrtf(wave_sum(ss) * (1.f / D) + EPS);
}
__device__ __forceinline__ void rp_mod(const f32x4 (&v)[4], float rinv, const float* gn, const float* mo, int sh_off, int sc_off, bf16_t* hp, int lane, f32x4 (&hv)[4]) {
#pragma unroll
    for (int j = 0; j < 4; ++j) { const int c = 4 * lane + 256 * j; const f32x4 g4 = *(const f32x4*)(gn + c), s4 = *(const f32x4*)(mo + sc_off + c), h4 = *(const f32x4*)(mo + sh_off + c);
        hv[j] = v[j] * rinv * g4 * (s4 + 1.f) + h4;
        *(uint2*)(hp + c) = make_uint2(pkbf(hv[j][0], hv[j][1]), pkbf(hv[j][2], hv[j][3])); }
}
__device__ __forceinline__ void phase_rowpass1(const Frame& F, int l, bool combine, size_t h_off) {
    const int tid = opaque_tid(F.wv0), lane = tid & 63, wave = __builtin_amdgcn_readfirstlane(tid >> 6); (void)lane; (void)wave;
    const int gw = blockIdx.x * 8 + wave, NGW = gridDim.x * 8;
    const float* xl = (l == 0) ? INP(0) : F.out; const float* xc = (l == 0) ? INP(2) : WSP(float, O_XC);
    const float* MODl = WSP(float, O_MOD) + (size_t)l * 5 * 6144; const float* MODp = WSP(float, O_MOD);
    for (int g = gw; g < G; g += NGW) { const RowInfo ri = rowinfo(g); const int mrow = ri.lat ? ri.b : 4; const size_t xo = xoff(ri);
        const float* xs = (ri.lat ? xl : xc) + xo; float* xd = (ri.lat ? F.out : WSP(float, O_XC)) + xo;
        f32x4 v[4], hv[4]; float rinv;
        rp_load(xs, xd, combine, combine ? WSP(bf16_t, O_YM2) + (size_t)g * 2048 : nullptr, MODp + (size_t)mrow * 6144 + 5120, lane, v, rinv);
        rp_mod(v, rinv, INP(6) + l * 1024, MODl + (size_t)mrow * 6144, 0, 1024, WSP(bf16_t, h_off) + (size_t)g * D, lane, hv); }
}
__device__ __forceinline__ void phase_rowpass2(const Frame& F, int l, bool last) {
    const int tid = opaque_tid(F.wv0), lane = tid & 63, wave = __builtin_amdgcn_readfirstlane(tid >> 6);
    { int* perm = WSP(int, O_PERM); unsigned* goff = WSP(unsigned, O_GOFF);
      for (int i = blockIdx.x * 512 + tid; i < PMAX; i += gridDim.x * 512) { perm[i] = -1; goff[i] = 0u; } }
    const int gw = blockIdx.x * 8 + wave, NGW = gridDim.x * 8;
    const float* MODl = WSP(float, O_MOD) + (size_t)l * 5 * 6144;
    for (int g = gw; g < G; g += NGW) { const RowInfo ri = rowinfo(g); if (last && !ri.lat) continue;
        const int mrow = ri.lat ? ri.b : 4; const size_t xo = xoff(ri);
        const float* xs = (ri.lat ? F.out : WSP(float, O_XC)) + xo;
        f32x4 v[4], hv[4]; float rinv;
        rp_load(xs, nullptr, false, nullptr, nullptr, lane, v, rinv);
        rp_mod(v, rinv, INP(7) + l * 1024, MODl + (size_t)mrow * 6144, 3072, 4096, WSP(bf16_t, O_H) + (size_t)g * D, lane, hv); }
}
struct EpiRoute {
    static constexpr bool PERM = false;
    int* route_e; float* route_w; LAS int* hist;
    __device__ __forceinline__ void operator()(const f32x4 (&acc)[2][2][4][2], const gp::GUnit& u, int wr, int wc, int fr, int fq) const {
        if (wc != 0) return;
#pragma unroll
        for (int ai = 0; ai < 2; ++ai)
#pragma unroll
            for (int m = 0; m < 4; ++m) { const int row = u.pm * 256 + ai * 128 + wr * 64 + m * 16 + fr;
                float el[8];
#pragma unroll
                for (int e = 0; e < 4; ++e) { el[e] = acc[ai][0][m][0][e]; el[4 + e] = acc[ai][0][m][1][e]; }
                const float gl = acc[ai][1][m][0][0];
                int i0 = 0; float m0 = el[0];
#pragma unroll
                for (int j = 1; j < 8; ++j) if (el[j] > m0) { m0 = el[j]; i0 = j; }
                int i1 = -1; float m1 = -3.4e38f;
#pragma unroll
                for (int j = 0; j < 8; ++j) if (j != i0 && el[j] > m1) { m1 = el[j]; i1 = j; }
                float gmax = gl; int gidx = fq;
#pragma unroll
                for (int off = 16; off <= 32; off <<= 1) { const float og = __shfl_xor(gmax, off); const int oi = __shfl_xor(gidx, off); if (og > gmax || (og == gmax && oi < gidx)) { gmax = og; gidx = oi; } }
                float gs = expf(gl - gmax); gs += __shfl_xor(gs, 16); gs += __shfl_xor(gs, 32);
                if (fq == gidx) { const float gwt = 1.f / gs, p1 = expf(m1 - m0); const int e0 = fq * 8 + i0, e1 = fq * 8 + i1;
                    route_e[row * 2] = e0; route_e[row * 2 + 1] = e1; route_w[row * 2] = gwt / (1.f + p1); route_w[row * 2 + 1] = gwt * p1 / (1.f + p1);
                    __hip_atomic_fetch_add(hist + e0, 1, __ATOMIC_RELAXED, __HIP_MEMORY_SCOPE_WORKGROUP); __hip_atomic_fetch_add(hist + e1, 1, __ATOMIC_RELAXED, __HIP_MEMORY_SCOPE_WORKGROUP); } }
    }
};
__device__ __forceinline__ void phase_final(const Frame& F) {
    const int tid = opaque_tid(F.wv0), lane = tid & 63, wave = __builtin_amdgcn_readfirstlane(tid >> 6); (void)lane; (void)wave;
    const int gw = blockIdx.x * 8 + wave, NGW = gridDim.x * 8; const float* MOD1 = WSP(float, O_MOD) + (size_t)5 * 6144;
    for (int lr = gw; lr < NB * SEQ; lr += NGW) { const int b = lr / SEQ, t = lr - b * SEQ; const int g = b * RPB + t; float* xp = F.out + (size_t)lr * D;
        f32x4 v[4]; float rinv; rp_load(xp, nullptr, false, WSP(bf16_t, O_YM2) + (size_t)g * 2048, MOD1 + (size_t)b * 6144 + 5120, lane, v, rinv);
#pragma unroll
        for (int j = 0; j < 4; ++j) { const int c = 4 * lane + 256 * j; const f32x4 g4 = *(const f32x4*)(INP(23) + c); *(f32x4*)(xp + c) = v[j] * rinv * g4; } }
}
__device__ __forceinline__ void phase_moe_scatter(const Frame& F, int l, bool last) {
    const int tid = opaque_tid(F.wv0), lane = tid & 63, wave = __builtin_amdgcn_readfirstlane(tid >> 6);
    LAS int* tot = (LAS int*)F.lds; LAS int* bef = tot + 512; LAS int* base = tot + 1024; LAS int* lcur = tot + 1056;
    const int* WGH = WSP(int, O_WGH) + (size_t)l * 256 * 32; const int nwg = gridDim.x, me = blockIdx.x;
    { const int e = tid & 31, part = tid >> 5; int sa = 0, sb = 0;
      for (int w = part * 16; w < part * 16 + 16 && w < nwg; ++w) { const int c = WGH[w * 32 + e]; sa += c; if (w < me) sb += c; }
      tot[part * 32 + e] = sa; bef[part * 32 + e] = sb; }
    __syncthreads();
    int sa2 = 0, sb2 = 0;
    if (tid < 32) {
#pragma unroll
        for (int part = 0; part < 16; ++part) { sa2 += tot[part * 32 + tid]; sb2 += bef[part * 32 + tid]; } }
    __syncthreads();
    if (tid < 32) { tot[tid] = sa2; bef[tid] = sb2; lcur[tid] = 0; }
    __syncthreads();
    if (tid == 0) { int o = 0; int* tile_e = WSP(int, O_TILEE);
#pragma clang loop unroll(disable) vectorize(disable)
        for (int e = 0; e < 32; ++e) { base[e] = o + bef[e]; const int n = (tot[e] + 255) & ~255;
            if (me == 0) {
#pragma clang loop unroll(disable) vectorize(disable)
                for (int t = o >> 8; t < (o + n) >> 8; ++t) tile_e[t] = e; }
            o += n; }
        if (me == 0) tile_e[NTILE] = o >> 8; }
    __syncthreads();
    const int* route_e = WSP(int, O_ROUTE_E); const float* route_w = WSP(float, O_ROUTE_W); int* perm = WSP(int, O_PERM); float* posw = WSP(float, O_POSW); unsigned* goff = WSP(unsigned, O_GOFF);
    { int pmv, pn;
      if (gp::tile_order(0, (int)gridDim.x, (int)blockIdx.x, last ? 128 : 132, 1, pmv, pn)) { const int pm = last ? pmv + pmv / 32 : pmv; const int g = pm * 256 + (tid >> 1); const int i = g * 2 + (tid & 1);
          const int e = route_e[i]; const int pos = base[e] + __hip_atomic_fetch_add(lcur + e, 1, __ATOMIC_RELAXED, __HIP_MEMORY_SCOPE_WORKGROUP);
          perm[pos] = i; posw[pos] = route_w[i]; goff[pos] = (unsigned)g * 2048u; } }
    (void)lane; (void)wave;
}

#ifndef PROBE_DUP
#define PROBE_DUP 0
#endif
#ifndef PROBE_EXTRA_MASK
#define PROBE_EXTRA_MASK 0ull
#endif
#define DUP(bit) for (int rep_ = 0; rep_ < (((PROBE_DUP) >> (bit)) & 1) + 1; ++rep_)
__global__ void __launch_bounds__(512, 2) hybrid_trunk_fwd(KP p) {
    extern __shared__ __attribute__((aligned(16))) unsigned char dynlds[];
    Frame F; F.lds = (LAS char*)dynlds; F.ws = p.ws; F.out = p.out; F.wv0 = __builtin_amdgcn_readfirstlane((int)(threadIdx.x >> 6));
    if (threadIdx.x == 0) { LAS unsigned long long* pp = (LAS unsigned long long*)(F.lds + LDS_PTR_OFF);
        pp[0] = (unsigned long long)p.in[0];
        pp[1] = (unsigned long long)p.in[1];
        pp[2] = (unsigned long long)p.in[2];
        pp[3] = (unsigned long long)p.in[3];
        pp[4] = (unsigned long long)p.in[4];
        pp[5] = (unsigned long long)p.in[5];
        pp[6] = (unsigned long long)p.in[6];
        pp[7] = (unsigned long long)p.in[7];
        pp[8] = (unsigned long long)p.in[8];
        pp[9] = (unsigned long long)p.in[9];
        pp[10] = (unsigned long long)p.in[10];
        pp[11] = (unsigned long long)p.in[11];
        pp[12] = (unsigned long long)p.in[12];
        pp[13] = (unsigned long long)p.in[13];
        pp[14] = (unsigned long long)p.in[14];
        pp[15] = (unsigned long long)p.in[15];
        pp[16] = (unsigned long long)p.in[16];
        pp[17] = (unsigned long long)p.in[17];
        pp[18] = (unsigned long long)p.in[18];
        pp[19] = (unsigned long long)p.in[19];
        pp[20] = (unsigned long long)p.in[20];
        pp[21] = (unsigned long long)p.in[21];
        pp[22] = (unsigned long long)p.in[22];
        pp[23] = (unsigned long long)p.in[23];
    }
    LAS unsigned char* glds = (LAS unsigned char*)dynlds;
    volatile LAS unsigned* barst = (volatile LAS unsigned*)(F.lds + LDS_BAR_OFF);
    if (threadIdx.x < 16) ((LAS unsigned*)(F.lds + LDS_BAR_OFF))[threadIdx.x] = 0u;
    __syncthreads();
    const bool multi = (p.ph_hi - p.ph_lo) > 1;
    XcdBarrier bar; bar.bar = (unsigned*)F.ws; bar.x = 0; bar.st = nullptr;
    if (multi) bar = xcd_barrier_post((unsigned*)F.ws, barst);
    int ph = 0;
#define PH_BEGIN if (ph >= p.ph_lo && ph < p.ph_hi && (p.mask == 0ull || ((p.mask >> ph) & 1ull))) {
#define PH_END   if (ph + 1 < p.ph_hi) xcd_barrier(bar); else __syncthreads(); } ++ph;
    const int Gd = gridDim.x, cb = blockIdx.x;

    PH_BEGIN p0_mod(F); p0_tables(F); __syncthreads(); conv_weights_nonmoe(F, 0); PH_END

    for (int l = 0; l < 2; ++l) {
        const bool last = (l == 1);
        const float* MODl = WSP(float, O_MOD) + (size_t)l * 5 * 6144;
        PH_BEGIN phase_rowpass1(F, l, l > 0, O_H); PH_END
        PH_BEGIN
        { SchedStd S{}; S.A = WSP(bf16_t, O_H); S.Bt = WSP(bf16_t, O_WINP); S.K = 1024; S.nM = 132; S.nN = 15; S.G_ = Gd; S.c = cb; S.skipctx = 0; S.lda2 = 2048; S.ldb2 = 2048;
          EpiG1 E{}; E.AQ = WSP(bf16_t, O_AQ); E.AK = WSP(bf16_t, O_AK); E.AV = WSP(bf16_t, O_AV); E.BQ = WSP(bf16_t, O_BQ); E.BV = WSP(bf16_t, O_BV); E.BG = WSP(bf16_t, O_BG); E.BLF = WSP(f16_t, O_BLF); E.BLB = WSP(f16_t, O_BLB);
          E.CQKV = WSP(bf16_t, O_CQKV); E.CKR = WSP(bf16_t, O_CKR); E.RS = WSP(float, O_RS); E.ropa_c = WSP(float, O_ROPA_C); E.ropa_s = WSP(float, O_ROPA_S); E.ropc_c = WSP(float, O_ROPC_C); E.ropc_s = WSP(float, O_ROPC_S);
          E.LBl = WSP(float, O_LB) + l * 1024; E.rowoff = 0;
          DUP(0) gp::gemm_phase<EpiG1, SchedStd>(glds, S, E, F.wv0); }
        PH_END
        PH_BEGIN
        { SchedStd S{}; S.A = WSP(bf16_t, O_CQKV); S.Bt = WSP(bf16_t, O_WC); S.K = 384; S.nM = 132; S.nN = 7; S.G_ = Gd; S.c = cb; S.skipctx = 0; S.lda2 = 768; S.ldb2 = 768;
          EpiC E{}; E.CQ = WSP(bf16_t, O_CQ); E.CKV = WSP(bf16_t, O_CKV); E.RS = WSP(float, O_RS); E.ropc_c = WSP(float, O_ROPC_C); E.ropc_s = WSP(float, O_ROPC_S); E.pmoff = 0;
          DUP(1) gp::gemm_phase<EpiC, SchedStd>(glds, S, E, F.wv0); }
        __syncthreads();
        { AttnArgs a{}; a.Q = WSP(bf16_t, O_AQ); a.qld = 512; a.qhs = 64; a.K1 = WSP(bf16_t, O_AK); a.k1ld = 128; a.k1hs = 64; a.kvgroup = 4; a.K2 = nullptr; a.k2ld = 0; a.V = WSP(bf16_t, O_AV); a.vld = 128; a.vhs = 64;
          a.O = WSP(bf16_t, O_AQ); a.old = 512; a.ohs = 64; a.scale_l2 = 0.125f * LOG2E; a.sink = INP(9) + l * 8; a.window = 128;
          const int nqb = last ? 32 : 33;
          DUP(10) for (int u = cb; u < NB * 8 * nqb; u += Gd) { int b, h, qb; if (u < NB * 8 * 32) { b = u >> 8; h = u & 7; qb = (u >> 3) & 31; }     else { const int r_ = u - NB * 8 * 32; b = r_ >> 3; h = r_ & 7; qb = 32; }
              attn_unit<64>(F.lds, a, F.wv0, b, qb, h, ((PROBE_DUP >> 10) & 1) && rep_ == 0); } }
        __syncthreads();
        { ScanArgs a{}; a.BQ = WSP(bf16_t, O_BQ); a.BV = WSP(bf16_t, O_BV); a.BG = WSP(bf16_t, O_BG); a.BLF = WSP(f16_t, O_BLF); a.BLB = WSP(f16_t, O_BLB); a.ST = WSP(bf16_t, O_H); a.DS = WSP(float, O_DS); a.OB = WSP(bf16_t, O_BQ); a.gn = INP(11) + l * 512;
          DUP(2) for (int u = cb; u < NB * 8 * NCHK; u += Gd) { const int b = u / (8 * NCHK), rem = u - b * 8 * NCHK, h = rem / NCHK, k = rem - h * NCHK; scan_s1_unit(F.lds, a, F.wv0, b, h, k); } }
        PH_END
        PH_BEGIN
        { ScanArgs a{}; a.ST = WSP(bf16_t, O_H); a.DS = WSP(float, O_DS);
          for (int t = cb; t < NB * 8 * 2 * 4; t += Gd) scan_s2_task(a, F.wv0, t); }
        { AttnArgs a{}; a.Q = WSP(bf16_t, O_CQ); a.qld = 768; a.qhs = 96; a.K1 = WSP(bf16_t, O_CKV); a.k1ld = 1024; a.k1hs = 128; a.kvgroup = 1; a.K2 = WSP(bf16_t, O_CKR); a.k2ld = 32; a.V = WSP(bf16_t, O_CKV) + 64; a.vld = 1024; a.vhs = 128;
          a.O = WSP(bf16_t, O_OC); a.old = 512; a.ohs = 64; a.scale_l2 = 0.10206207261596577f * LOG2E; a.sink = nullptr; a.window = 0; a.pad = (PROBE_VARIANT && p.mask != 0ull) ? 1 : 0;
          const int nqb = last ? 32 : 33;
          DUP(3) for (int u = cb; u < NB * 8 * nqb; u += Gd) { int b, h, qb; if (u < NB * 8 * 32) { b = u >> 8; h = u & 7; qb = (u >> 3) & 31; }     else { const int r_ = u - NB * 8 * 32; b = r_ >> 3; h = r_ & 7; qb = 32; }
              if (PROBE_VARIANT >= 6 && p.mask != 0ull) attn_unit<96, PROBE_VARIANT>(F.lds, a, F.wv0, b, qb, h); else attn_unit<96>(F.lds, a, F.wv0, b, qb, h); } }
        PH_END
        PH_BEGIN
        { ScanArgs a{}; a.BQ = WSP(bf16_t, O_BQ); a.BV = WSP(bf16_t, O_BV); a.BG = WSP(bf16_t, O_BG); a.BLF = WSP(f16_t, O_BLF); a.BLB = WSP(f16_t, O_BLB); a.ST = WSP(bf16_t, O_H); a.DS = WSP(float, O_DS); a.OB = WSP(bf16_t, O_BQ); a.gn = INP(11) + l * 512; a.skipctx_out = last ? 1 : 0;
          DUP(9) { a.pad = (((PROBE_DUP >> 9) & 1) && rep_ == 0) ? 1 : 0; for (int u = cb; u < NB * 8 * NCHK; u += Gd) { const int b = u / (8 * NCHK), rem = u - b * 8 * NCHK, h = rem / NCHK, k = rem - h * NCHK; scan_s3_unit(F.lds, a, F.wv0, b, h, k); } } }
        phase_rowpass1(F, l, false, O_CKV);
        PH_END
        PH_BEGIN
        { SchedGM S{}; S.A0 = WSP(bf16_t, O_AQ); S.A1 = WSP(bf16_t, O_BQ); S.A2 = WSP(bf16_t, O_OC); S.Ag = WSP(bf16_t, O_CKV); S.Bbr = WSP(bf16_t, O_WBR); S.Bg = WSP(bf16_t, O_WINP) + (size_t)3840 * 1024;
          S.nM = last ? 128 : 132; S.G_ = Gd; S.c = cb; S.skipctx = last ? 1 : 0; S.lda2 = 1024; S.ldb2 = 1024;
          EpiGM E{}; E.U = WSP(bf16_t, O_GATE); E.nstride = (long)G * 1024; E.ld = 1024;
          gp::gemm_phase<EpiGM, SchedGM>(glds, S, E, F.wv0); }
        PH_END
        PH_BEGIN
        { const int tid_ = opaque_tid(F.wv0), lane_ = tid_ & 63, wave_ = __builtin_amdgcn_readfirstlane(tid_ >> 6); const bf16_t* U = WSP(bf16_t, O_GATE); bf16_t* Y = WSP(bf16_t, O_H);
          for (int g = cb * 8 + wave_; g < G; g += Gd * 8) { if (last && (g % RPB) >= SEQ) continue;
#pragma unroll
              for (int j = 0; j < 2; ++j) { const size_t o = (size_t)g * 1024 + 8 * lane_ + 512 * j;
                  const u32x4 a = *(const u32x4*)(U + o), b2 = *(const u32x4*)(U + (size_t)G * 1024 + o), c2 = *(const u32x4*)(U + (size_t)2 * G * 1024 + o);
                  u32x4 w; w.x = pkbf(bflo(a.x) + bflo(b2.x) + bflo(c2.x), bfhi(a.x) + bfhi(b2.x) + bfhi(c2.x)); w.y = pkbf(bflo(a.y) + bflo(b2.y) + bflo(c2.y), bfhi(a.y) + bfhi(b2.y) + bfhi(c2.y));
                  w.z = pkbf(bflo(a.z) + bflo(b2.z) + bflo(c2.z), bfhi(a.z) + bfhi(b2.z) + bfhi(c2.z)); w.w = pkbf(bflo(a.w) + bflo(b2.w) + bflo(c2.w), bfhi(a.w) + bfhi(b2.w) + bfhi(c2.w));
                  *(u32x4*)(Y + o) = w; } } }
        PH_END
        PH_BEGIN
        { SchedStd S{}; S.A = WSP(bf16_t, O_H); S.Bt = WSP(bf16_t, O_WOUT); S.K = 1024; S.nM = last ? 128 : 132; S.nN = 4; S.G_ = Gd; S.c = cb; S.skipctx = last ? 1 : 0; S.lda2 = 2048; S.ldb2 = 2048;
          EpiOut E{}; E.xl_src = l == 0 ? INP(0) : F.out; E.xc_src = l == 0 ? INP(2) : WSP(float, O_XC); E.xl_dst = F.out; E.xc_dst = WSP(float, O_XC); E.mod = MODl; E.pmoff = 0;
          gp::gemm_phase<EpiOut, SchedStd>(glds, S, E, F.wv0); }
        PH_END
        PH_BEGIN phase_rowpass2(F, l, last); PH_END
        PH_BEGIN
        { LAS int* hist = (LAS int*)(F.lds + 131072); const int t_ = opaque_tid(F.wv0);
          if (t_ < 32) hist[t_] = 0;
          __syncthreads();
          SchedStd S{}; S.A = WSP(bf16_t, O_H); S.Bt = WSP(bf16_t, O_WRB) + (size_t)l * 256 * 1024; S.K = 1024; S.nM = last ? 128 : 132; S.nN = 1; S.G_ = Gd; S.c = cb; S.skipctx = last ? 1 : 0; S.lda2 = 2048; S.ldb2 = 2048;
          EpiRoute E{}; E.route_e = WSP(int, O_ROUTE_E); E.route_w = WSP(float, O_ROUTE_W); E.hist = hist;
          gp::gemm_phase<EpiRoute, SchedStd>(glds, S, E, F.wv0);
          __syncthreads();
          { const int t2_ = opaque_tid(F.wv0); if (t2_ < 32) WSP(int, O_WGH)[((size_t)l * 256 + cb) * 32 + t2_] = hist[t2_]; }
          __syncthreads(); }
        conv_weights_moe(F, l); if (!last) conv_weights_nonmoe(F, l + 1);
        PH_END
        PH_BEGIN phase_moe_scatter(F, l, last); PH_END
        PH_BEGIN
        { SchedMoE<true> S{}; S.A = WSP(bf16_t, O_H); S.Bt = WSP(bf16_t, O_WUP); S.tile_e = WSP(int, O_TILEE); S.goff = WSP(unsigned, O_GOFF); S.K = 1024; S.nM = WSP(int, O_TILEE)[NTILE]; S.nN = 2; S.G_ = Gd; S.c = cb; S.lda2 = 2048; S.ldb2 = 2048; S.strideB = 512 * 1024;
          EpiUp E{}; E.AUP = WSP(bf16_t, O_AUP);
          DUP(7) gp::gemm_phase<EpiUp, SchedMoE<true>>(glds, S, E, F.wv0); }
        PH_END
        PH_BEGIN
        { SchedMoE<false> S{}; S.A = WSP(bf16_t, O_AUP); S.Bt = WSP(bf16_t, O_WDN); S.tile_e = WSP(int, O_TILEE); S.goff = nullptr; S.K = 256; S.nM = WSP(int, O_TILEE)[NTILE]; S.nN = 4; S.G_ = Gd; S.c = cb; S.lda2 = 512; S.ldb2 = 512; S.strideB = 1024 * 256;
          EpiDown E{}; E.YM2 = WSP(bf16_t, O_YM2); E.perm = WSP(int, O_PERM); E.posw = WSP(float, O_POSW);
          DUP(8) gp::gemm_phase<EpiDown, SchedMoE<false>>(glds, S, E, F.wv0); }
        PH_END
    }
    PH_BEGIN phase_final(F); PH_END
#undef PH_BEGIN
#undef PH_END
}
constexpr int N_PHASES = 1 + 2 * 13 + 1;
}

#ifndef MK_N_LAUNCHES
#define MK_N_LAUNCHES 1
#endif
extern "C" void kernel_launch(void* const* d_in, const int* in_sizes, int n_in, void* d_out, int out_size, void* d_ws, size_t ws_size, hipStream_t stream) {
    static int grid = 0;
    if (grid == 0) {
        if (ws_size < WS_END) { grid = -1; return; }
        int dev = 0, cus = 0;
        if (hipGetDevice(&dev) != hipSuccess || hipDeviceGetAttribute(&cus, hipDeviceAttributeMultiprocessorCount, dev) != hipSuccess) { grid = -1; return; }
        if (hipFuncSetAttribute((const void*)hybrid_trunk_fwd, hipFuncAttributeMaxDynamicSharedMemorySize, LDS_BYTES) != hipSuccess) { grid = -1; return; }
        int per_cu = 0; (void)hipOccupancyMaxActiveBlocksPerMultiprocessor(&per_cu, (const void*)hybrid_trunk_fwd, 512, LDS_BYTES); (void)hipGetLastError();
        grid = cus;
    }
    if (grid < 0) return;
    (void)hipMemsetAsync(d_ws, 0, CTL_ZERO_BYTES, stream);
    KP p{}; for (int i = 0; i < 24; ++i) p.in[i] = (const float*)d_in[i]; p.out = (float*)d_out; p.ws = (char*)d_ws;
    (void)in_sizes; (void)n_in; (void)out_size;
    if (MK_N_LAUNCHES == 1) { p.ph_lo = 0; p.ph_hi = N_PHASES; hipLaunchKernelGGL(hybrid_trunk_fwd, dim3(grid), dim3(512), LDS_BYTES, stream, p);
        if (PROBE_EXTRA_MASK) { (void)hipMemsetAsync(d_ws, 0, CTL_ZERO_BYTES, stream); p.mask = PROBE_EXTRA_MASK; hipLaunchKernelGGL(hybrid_trunk_fwd, dim3(grid), dim3(512), LDS_BYTES, stream, p); } }
    else { for (int k = 0; k < N_PHASES; ++k) { p.ph_lo = k; p.ph_hi = k + 1; hipLaunchKernelGGL(hybrid_trunk_fwd, dim3(grid), dim3(512), LDS_BYTES, stream, p); } }
}
```

```cpp
#include <hip/hip_runtime.h>
#include <stdint.h>
#include <math.h>

namespace {
typedef unsigned short bf16_t;
typedef _Float16 f16_t;
typedef short bf16x8 __attribute__((ext_vector_type(8)));
typedef short s16x4 __attribute__((ext_vector_type(4)));
typedef float f32x4 __attribute__((ext_vector_type(4)));
typedef float f32x16 __attribute__((ext_vector_type(16)));
typedef unsigned u32x4 __attribute__((ext_vector_type(4)));
#define LAS __attribute__((address_space(3)))

constexpr int D = 1024, NB = 4, SEQ = 8192, CTXL = 256, RPB = SEQ + CTXL, G = NB * RPB;
constexpr int INW = 6816, MIXW = 3744, GATEW = 3072;
constexpr float EPS = 1e-6f;
constexpr float LOG2E = 1.4426950408889634f;
constexpr int PMAX = 75776;
constexpr int NTILE = PMAX / 256;

__device__ __forceinline__ float bf2f(bf16_t v) { return __uint_as_float(((unsigned)v) << 16); }
__device__ __forceinline__ bf16_t f2bf(float f) { unsigned u = __float_as_uint(f); u += 0x7fffu + ((u >> 16) & 1u); return (bf16_t)(u >> 16); }
typedef float f32x2v __attribute__((ext_vector_type(2)));
typedef __bf16 bf16x2v __attribute__((ext_vector_type(2)));
__device__ __forceinline__ unsigned pkbf(float lo, float hi) { const f32x2v v = {lo, hi}; const bf16x2v b = __builtin_convertvector(v, bf16x2v); return __builtin_bit_cast(unsigned, b); }
__device__ __forceinline__ unsigned pk2(float lo, float hi) { return (unsigned)f2bf(lo) | ((unsigned)f2bf(hi) << 16); }
__device__ __forceinline__ float silu_f(float v) { return v / (1.f + expf(-v)); }
__device__ __forceinline__ float sigmoid_f(float v) { return 1.f / (1.f + expf(-v)); }
__device__ __forceinline__ int opaque_tid(int wv) { unsigned z; asm volatile("s_mov_b32 %0, 0" : "=s"(z));
    int t = (wv << 6) | (int)__builtin_amdgcn_mbcnt_hi(~0u, __builtin_amdgcn_mbcnt_lo(~0u, z)); asm volatile("" : "+v"(t)); return t; }
__device__ __forceinline__ float shxl(float v, int k, int lane) { return __builtin_bit_cast(float, __builtin_amdgcn_ds_bpermute((lane ^ k) << 2, __builtin_bit_cast(int, v))); }
__device__ __forceinline__ int shxli(int v, int k, int lane) { return __builtin_amdgcn_ds_bpermute((lane ^ k) << 2, v); }
struct RowInfo { int b, r; bool lat; };
__device__ __forceinline__ RowInfo rowinfo(int g) { RowInfo ri; ri.b = g / RPB; ri.r = g - ri.b * RPB; ri.lat = ri.r < SEQ; return ri; }
__device__ __forceinline__ size_t xoff(const RowInfo& ri) { return ri.lat ? ((size_t)ri.b * SEQ + ri.r) * D : ((size_t)ri.b * CTXL + (ri.r - SEQ)) * D; }
__device__ __forceinline__ int crow(int r, int hi) { return (r & 3) + 8 * (r >> 2) + 4 * hi; }
__device__ __forceinline__ unsigned cvtpk(float lo, float hi) { return pkbf(lo, hi); }
typedef short v4i16_t __attribute__((ext_vector_type(4)));
__device__ __forceinline__ s16x4 vtr(const LAS char* p) { return __builtin_bit_cast(s16x4, __builtin_amdgcn_ds_read_tr16_b64_v4i16((LAS v4i16_t*)p)); }
#define MFMA32(a, b, c) __builtin_amdgcn_mfma_f32_32x32x16_bf16(a, b, c, 0, 0, 0)
#ifndef PROBE_VARIANT
#define PROBE_VARIANT 0
#endif
#if PROBE_VARIANT == 4
#define VTR_ASM(dst, addr, off) do { if (!p.pad) asm volatile("ds_read_b64_tr_b16 %0, %1 offset:" #off : "=v"(dst) : "v"(addr)); else asm volatile("" : "=v"(dst)); } while (0)
#else
#define VTR_ASM(dst, addr, off) asm volatile("ds_read_b64_tr_b16 %0, %1 offset:" #off : "=v"(dst) : "v"(addr))
#endif
struct AttnArgs { const bf16_t* Q; int qld, qhs; const bf16_t* K1; int k1ld, k1hs, kvgroup; const bf16_t* K2; int k2ld; const bf16_t* V; int vld, vhs;
                  bf16_t* O; int old, ohs; float scale_l2; const float* sink; int window; int pad; };
template <int DQK, int VAR = 0>
__device__ __forceinline__ void attn_unit(LAS char* lds, const AttnArgs& p, int wv0, int b, int qb, int h, bool nostore = false) {
    constexpr int NS = DQK / 16, NCH = DQK / 8; constexpr float THR = 8.f;
    constexpr int KB = 0, VB = 49152, WSF = 81920;
    const int tid = opaque_tid(wv0), lane = tid & 63, r32 = lane & 31, hi = lane >> 5, wid = tid >> 6;
    const int rb = b * RPB;
    const bool ctxq = (qb == 32);
    const int q0 = rb + (ctxq ? SEQ : qb * 256);
    int lat_k0 = 0, lat_k1 = 0;
    if (!ctxq) { if (p.window) { lat_k0 = qb * 256 - 128; if (lat_k0 < 0) lat_k0 = 0; lat_k1 = qb * 256 + 384; if (lat_k1 > SEQ) lat_k1 = SEQ; } else { lat_k0 = 0; lat_k1 = SEQ; } }
    const int ntiles = 4 + (lat_k1 - lat_k0) / 64;
    const int qrow = q0 + wid * 32 + r32;
    const int qpos = qb * 256 + wid * 32 + r32;
    const int wq0 = qb * 256 + wid * 32;
    LAS float* wsf = (LAS float*)(lds + WSF) + wid * 64;
    bf16x8 qr[NS];
#pragma unroll
    for (int s = 0; s < NS; ++s) qr[s] = *(const bf16x8*)(p.Q + (size_t)qrow * p.qld + h * p.qhs + 16 * s + 8 * hi);
    const int k1off = (h / p.kvgroup) * p.k1hs, voff = (h / p.kvgroup) * p.vhs;
    const int wv = __builtin_amdgcn_readfirstlane(wid);
    const bool k2nd = (NCH > 8) && (wv < NCH - 8);
    const size_t ksrc0 = (size_t)lane * p.k1ld + k1off + wv * 8, ksrc1 = (size_t)lane * p.k2ld + wv * 8;
    const size_t vsrc = (size_t)(16 * (wv & 3) + (lane >> 2)) * p.vld + voff + (wv >> 2) * 32 + (lane & 3) * 8;
#define AT_ROW0(it_) (rb + ((it_) >= 4 ? lat_k0 + 64 * ((it_) - 4) : SEQ + 64 * (it_)))
#define AT_DMAK(it_, slot_) do { if constexpr (VAR == 8) break; const size_t kr0_ = (size_t)AT_ROW0(it_); \
        __builtin_amdgcn_global_load_lds((const unsigned*)(p.K1 + kr0_ * p.k1ld + ksrc0), (LAS unsigned*)(lds + KB + (slot_) * 12288 + wv * 1024), 16, 0, 0); \
        if (k2nd) __builtin_amdgcn_global_load_lds((const unsigned*)(p.K2 + kr0_ * p.k2ld + ksrc1), (LAS unsigned*)(lds + KB + (slot_) * 12288 + (8 + wv) * 1024), 16, 0, 0); } while (0)
#define AT_DMAV(it_, slot_) do { if constexpr (VAR == 8) break; const size_t kr0_ = (size_t)AT_ROW0(it_); \
        __builtin_amdgcn_global_load_lds((const unsigned*)(p.V + kr0_ * p.vld + vsrc), (LAS unsigned*)(lds + VB + (slot_) * 8192 + wv * 1024), 16, 0, 0); } while (0)
#define AT_CLAMP(x_) ((x_) < ntiles ? (x_) : ntiles - 1)
#define AT_WAITBAR() do { if (k2nd) asm volatile("s_waitcnt vmcnt(6) lgkmcnt(0)" ::: "memory"); else asm volatile("s_waitcnt vmcnt(4) lgkmcnt(0)" ::: "memory"); if constexpr (VAR != 7) __builtin_amdgcn_s_barrier(); asm volatile("" ::: "memory"); } while (0)
#define AT_QK(C0, C1, slot_) do { const LAS char* ldsK_ = lds + KB + (slot_) * 12288 + hi * 1024 + r32 * 16; C0 = negm; C1 = negm; bf16x8 kf_[2 * NS]; \
        _Pragma("unroll") for (int s = 0; s < NS; ++s) { kf_[2 * s] = *(const LAS bf16x8*)(ldsK_ + s * 2048); kf_[2 * s + 1] = *(const LAS bf16x8*)(ldsK_ + s * 2048 + 512); } \
        __builtin_amdgcn_sched_group_barrier(0x100, 2 * NS, 0); \
        _Pragma("unroll") for (int s = 0; s < NS; ++s) { C0 = MFMA32(kf_[2 * s], qr[s], C0); C1 = MFMA32(kf_[2 * s + 1], qr[s], C1); } } while (0)
#define AT_REF(C0, C1, T_, first) do { const int tr_ = (T_); \
        if (p.window && tr_ >= 4) { const int kpos0 = lat_k0 + 64 * (tr_ - 4); \
            _Pragma("unroll") for (int r = 0; r < 16; ++r) { const int kp = kpos0 + crow(r, hi); int d0 = qpos - kp; if (d0 < 0) d0 = -d0; int d1 = qpos - (kp + 32); if (d1 < 0) d1 = -d1; \
                if (d0 > p.window) C0[r] = -1e30f; if (d1 > p.window) C1[r] = -1e30f; } } \
        if ((first) || (tr_ & 7) == 0) { \
        float mx = fmaxf(fmaxf(C0[0], C0[1]), C1[0]); \
        _Pragma("unroll") for (int r = 2; r < 16; r += 2) mx = fmaxf(fmaxf(mx, C0[r]), C0[r + 1]); \
        _Pragma("unroll") for (int r = 1; r < 15; r += 2) mx = fmaxf(fmaxf(mx, C1[r]), C1[r + 1]); \
        mx = fmaxf(mx, C1[15]); mx = fmaxf(mx, shxl(mx, 32, lane)); \
        if ((first) || __any(mx > THR)) { const float dl = (first) ? mx : fmaxf(mx, 0.f); \
            m += dl; const float alpha = __builtin_amdgcn_exp2f(-dl); l *= alpha; \
            _Pragma("unroll") for (int r = 0; r < 16; ++r) { C0[r] -= dl; C1[r] -= dl; negm[r] = -m; } \
            if (hi == 0) wsf[r32] = alpha; \
            _Pragma("unroll") for (int r = 0; r < 16; ++r) { const float f = wsf[crow(r, hi)]; o0[r] *= f; o1[r] *= f; } } } } while (0)
    f32x16 o0, o1, negm, cA0, cA1, cB0, cB1;
#pragma unroll
    for (int r = 0; r < 16; ++r) { o0[r] = 0.f; o1[r] = 0.f; negm[r] = 0.f; }
    float m = 0.f, l = 0.f;
    const int vlane = ((lane >> 4) & 1) * 32 + (lane & 3) * 8 + (4 * hi + ((lane & 15) >> 2)) * 64;
    asm volatile("s_waitcnt vmcnt(0) lgkmcnt(0)" ::: "memory"); __builtin_amdgcn_s_barrier(); asm volatile("" ::: "memory");
    AT_DMAK(0, 0); AT_DMAV(0, 0); AT_DMAK(AT_CLAMP(1), 1); AT_DMAV(AT_CLAMP(1), 1); AT_DMAK(AT_CLAMP(2), 2); AT_DMAV(AT_CLAMP(2), 2); AT_DMAK(AT_CLAMP(3), 3);
    asm volatile("s_waitcnt vmcnt(0)" ::: "memory"); __builtin_amdgcn_s_barrier(); asm volatile("" ::: "memory");
    AT_QK(cA0, cA1, 0);
    AT_REF(cA0, cA1, 0, true);
    asm volatile("s_waitcnt lgkmcnt(0)" ::: "memory"); __builtin_amdgcn_s_barrier(); asm volatile("" ::: "memory");
#define AT_SB() __builtin_amdgcn_sched_barrier(0)
#define AT_PIN2(x, y) asm volatile("" : "+v"(x), "+v"(y))
#define AT_PIN1(x) asm volatile("" : "+v"(x))
#define AT_PINRS() asm volatile("" : "+v"(rs0), "+v"(rs1), "+v"(rs2), "+v"(rs3))
#define AT_LDK(dst, addr_, off) asm volatile("ds_read_b128 %0, %1 offset:" #off : "=v"(dst) : "v"(addr_))
#define AT_WAITK(n, a, b) asm volatile("s_waitcnt lgkmcnt(" #n ")" : "+v"(a), "+v"(b))
#define AT_WAITV8(n, a, b, c, d, e, f, g, h) asm volatile("s_waitcnt lgkmcnt(" #n ")" : "+v"(a), "+v"(b), "+v"(c), "+v"(d), "+v"(e), "+v"(f), "+v"(g), "+v"(h))
#define AT_WAITV4(n, a, b, c, d) asm volatile("s_waitcnt lgkmcnt(" #n ")" : "+v"(a), "+v"(b), "+v"(c), "+v"(d))
#define AT_EXP(X) do { if constexpr (VAR != 6) X = __builtin_amdgcn_exp2f(X); } while (0)
#define AT_STEP(C0, C1, N0, N1, T_) do { const int t_ = (T_); const int t1_ = t_ + 1 < ntiles ? t_ + 1 : ntiles - 1; \
        AT_DMAK(AT_CLAMP(t_ + 4), t_ & 3); AT_DMAV(AT_CLAMP(t_ + 3), (t_ + 3) & 3); \
        const unsigned kaddr_ = (unsigned)(size_t)(lds + KB + ((t_ + 1) & 3) * 12288 + hi * 1024 + r32 * 16); const unsigned vaddr_ = (unsigned)(size_t)(lds + VB + (t_ & 3) * 8192 + vlane); \
        bf16x8 kfa0, kfa1, kfb0, kfb1, kfc0, kfc1; bf16x8 vf_[8]; s16x4 ta_[16]; float rs0 = 0.f, rs1 = 0.f, rs2 = 0.f, rs3 = 0.f; u32x4 pw[4]; \
        AT_LDK(kfa0, kaddr_, 0); AT_LDK(kfa1, kaddr_, 512); AT_LDK(kfb0, kaddr_, 2048); AT_LDK(kfb1, kaddr_, 2560); AT_SB(); \
        if constexpr (NS == 6) { \
          AT_LDK(kfc0, kaddr_, 4096); AT_LDK(kfc1, kaddr_, 4608); AT_WAITK(4, kfa0, kfa1); N0 = MFMA32(kfa0, qr[0], negm); AT_PIN1(N0); AT_EXP(C0[0]); AT_EXP(C0[1]); AT_EXP(C0[2]);  VTR_ASM(ta_[0], vaddr_, 0); AT_SB(); \
          N1 = MFMA32(kfa1, qr[0], negm); AT_PIN1(N1); AT_EXP(C0[3]); AT_EXP(C0[4]); AT_EXP(C0[5]);  VTR_ASM(ta_[1], vaddr_, 512); VTR_ASM(ta_[2], vaddr_, 4096); AT_SB(); \
          AT_LDK(kfa0, kaddr_, 6144); AT_LDK(kfa1, kaddr_, 6656); AT_WAITK(7, kfb0, kfb1); N0 = MFMA32(kfb0, qr[1], N0); AT_PIN1(N0); AT_EXP(C0[6]); AT_EXP(C0[7]); AT_EXP(C0[8]); VTR_ASM(ta_[3], vaddr_, 4608); AT_SB(); \
          N1 = MFMA32(kfb1, qr[1], N1); AT_PIN1(N1); AT_EXP(C0[9]); AT_EXP(C0[10]); AT_EXP(C0[11]); VTR_ASM(ta_[4], vaddr_, 1024); VTR_ASM(ta_[5], vaddr_, 1536); AT_SB(); \
          AT_LDK(kfb0, kaddr_, 8192); AT_LDK(kfb1, kaddr_, 8704); AT_WAITK(10, kfc0, kfc1); N0 = MFMA32(kfc0, qr[2], N0); AT_PIN1(N0); AT_EXP(C0[12]); AT_EXP(C0[13]); AT_EXP(C0[14]); VTR_ASM(ta_[6], vaddr_, 5120); AT_SB(); \
          N1 = MFMA32(kfc1, qr[2], N1); AT_PIN1(N1); AT_EXP(C0[15]); AT_EXP(C1[0]); AT_EXP(C1[1]); VTR_ASM(ta_[7], vaddr_, 5632); VTR_ASM(ta_[8], vaddr_, 2048); AT_SB(); \
          AT_LDK(kfc0, kaddr_, 10240); AT_LDK(kfc1, kaddr_, 10752); AT_WAITK(10, kfa0, kfa1); N0 = MFMA32(kfa0, qr[3], N0); AT_PIN1(N0); AT_EXP(C1[2]); AT_EXP(C1[3]); AT_EXP(C1[4]); VTR_ASM(ta_[9], vaddr_, 2560); AT_SB(); \
          N1 = MFMA32(kfa1, qr[3], N1); AT_PIN1(N1); AT_EXP(C1[5]); AT_EXP(C1[6]); AT_EXP(C1[7]); VTR_ASM(ta_[10], vaddr_, 6144); VTR_ASM(ta_[11], vaddr_, 6656); AT_SB(); \
           AT_WAITK(8, kfb0, kfb1); N0 = MFMA32(kfb0, qr[4], N0); AT_PIN1(N0); AT_EXP(C1[8]); AT_EXP(C1[9]); VTR_ASM(ta_[12], vaddr_, 3072); AT_SB(); \
          N1 = MFMA32(kfb1, qr[4], N1); AT_PIN1(N1); AT_EXP(C1[10]); AT_EXP(C1[11]); VTR_ASM(ta_[13], vaddr_, 3584); AT_SB(); \
           AT_WAITK(5, kfc0, kfc1); N0 = MFMA32(kfc0, qr[5], N0); AT_PIN1(N0); AT_EXP(C1[12]); AT_EXP(C1[13]); VTR_ASM(ta_[14], vaddr_, 7168); AT_SB(); \
          N1 = MFMA32(kfc1, qr[5], N1); AT_PIN1(N1); AT_EXP(C1[14]); AT_EXP(C1[15]); VTR_ASM(ta_[15], vaddr_, 7680); AT_SB(); \
          \
        } \
        if constexpr (NS == 4) { \
          AT_LDK(kfc0, kaddr_, 4096); AT_LDK(kfc1, kaddr_, 4608); AT_WAITK(4, kfa0, kfa1); N0 = MFMA32(kfa0, qr[0], negm); AT_PIN1(N0); AT_EXP(C0[0]); AT_EXP(C0[1]); AT_EXP(C0[2]); AT_EXP(C0[3]);  VTR_ASM(ta_[0], vaddr_, 0); AT_SB(); \
          N1 = MFMA32(kfa1, qr[0], negm); AT_PIN1(N1); AT_EXP(C0[4]); AT_EXP(C0[5]); AT_EXP(C0[6]); AT_EXP(C0[7]);  VTR_ASM(ta_[1], vaddr_, 512); VTR_ASM(ta_[2], vaddr_, 4096); VTR_ASM(ta_[3], vaddr_, 4608); AT_SB(); \
          AT_LDK(kfa0, kaddr_, 6144); AT_LDK(kfa1, kaddr_, 6656); AT_WAITK(8, kfb0, kfb1); N0 = MFMA32(kfb0, qr[1], N0); AT_PIN1(N0); AT_EXP(C0[8]); AT_EXP(C0[9]); AT_EXP(C0[10]); AT_EXP(C0[11]); VTR_ASM(ta_[4], vaddr_, 1024); AT_SB(); \
          N1 = MFMA32(kfb1, qr[1], N1); AT_PIN1(N1); AT_EXP(C0[12]); AT_EXP(C0[13]); AT_EXP(C0[14]); AT_EXP(C0[15]); VTR_ASM(ta_[5], vaddr_, 1536); VTR_ASM(ta_[6], vaddr_, 5120); VTR_ASM(ta_[7], vaddr_, 5632); AT_SB(); \
           AT_WAITK(10, kfc0, kfc1); N0 = MFMA32(kfc0, qr[2], N0); AT_PIN1(N0); AT_EXP(C1[0]); AT_EXP(C1[1]); AT_EXP(C1[2]); AT_EXP(C1[3]); VTR_ASM(ta_[8], vaddr_, 2048); AT_SB(); \
          N1 = MFMA32(kfc1, qr[2], N1); AT_PIN1(N1); AT_EXP(C1[4]); AT_EXP(C1[5]); AT_EXP(C1[6]); AT_EXP(C1[7]); VTR_ASM(ta_[9], vaddr_, 2560); VTR_ASM(ta_[10], vaddr_, 6144); VTR_ASM(ta_[11], vaddr_, 6656); AT_SB(); \
           AT_WAITK(8, kfa0, kfa1); N0 = MFMA32(kfa0, qr[3], N0); AT_PIN1(N0); AT_EXP(C1[8]); AT_EXP(C1[9]); AT_EXP(C1[10]); AT_EXP(C1[11]); VTR_ASM(ta_[12], vaddr_, 3072); AT_SB(); \
          N1 = MFMA32(kfa1, qr[3], N1); AT_PIN1(N1); AT_EXP(C1[12]); AT_EXP(C1[13]); AT_EXP(C1[14]); AT_EXP(C1[15]); VTR_ASM(ta_[13], vaddr_, 3584); VTR_ASM(ta_[14], vaddr_, 7168); VTR_ASM(ta_[15], vaddr_, 7680); AT_SB(); \
          \
        } \
        if constexpr (NS == 6) AT_WAITV8(9, ta_[0], ta_[1], ta_[2], ta_[3], ta_[4], ta_[5], ta_[6], ta_[7]); else AT_WAITV8(8, ta_[0], ta_[1], ta_[2], ta_[3], ta_[4], ta_[5], ta_[6], ta_[7]); AT_SB(); \
        vf_[0] = (bf16x8){ta_[0][0], ta_[0][1], ta_[0][2], ta_[0][3], ta_[1][0], ta_[1][1], ta_[1][2], ta_[1][3]}; vf_[1] = (bf16x8){ta_[2][0], ta_[2][1], ta_[2][2], ta_[2][3], ta_[3][0], ta_[3][1], ta_[3][2], ta_[3][3]}; vf_[2] = (bf16x8){ta_[4][0], ta_[4][1], ta_[4][2], ta_[4][3], ta_[5][0], ta_[5][1], ta_[5][2], ta_[5][3]}; vf_[3] = (bf16x8){ta_[6][0], ta_[6][1], ta_[6][2], ta_[6][3], ta_[7][0], ta_[7][1], ta_[7][2], ta_[7][3]}; \
        pw[0] = (u32x4){cvtpk(C0[0], C0[1]), cvtpk(C0[2], C0[3]), cvtpk(C0[4], C0[5]), cvtpk(C0[6], C0[7])}; AT_SB(); \
        if (!(PROBE_VARIANT == 2 && p.pad)) { \
        o0 = MFMA32(__builtin_bit_cast(bf16x8, pw[0]), vf_[0], o0); AT_PIN1(o0); pw[1].x = cvtpk(C0[8], C0[9]); pw[1].y = cvtpk(C0[10], C0[11]); rs0 += C0[0]; rs1 += C0[1]; rs2 += C0[2]; rs3 += C0[3]; AT_PINRS(); AT_SB(); \
        o1 = MFMA32(__builtin_bit_cast(bf16x8, pw[0]), vf_[1], o1); AT_PIN1(o1); pw[1].z = cvtpk(C0[12], C0[13]); pw[1].w = cvtpk(C0[14], C0[15]); rs0 += C0[4]; rs1 += C0[5]; rs2 += C0[6]; rs3 += C0[7]; AT_PINRS(); AT_SB(); \
        o0 = MFMA32(__builtin_bit_cast(bf16x8, pw[1]), vf_[2], o0); AT_PIN1(o0); pw[2].x = cvtpk(C1[0], C1[1]); pw[2].y = cvtpk(C1[2], C1[3]); rs0 += C0[8]; rs1 += C0[9]; rs2 += C0[10]; rs3 += C0[11]; AT_PINRS(); AT_SB(); \
        o1 = MFMA32(__builtin_bit_cast(bf16x8, pw[1]), vf_[3], o1); AT_PIN1(o1); pw[2].z = cvtpk(C1[4], C1[5]); pw[2].w = cvtpk(C1[6], C1[7]); rs0 += C0[12]; rs1 += C0[13]; rs2 += C0[14]; rs3 += C0[15]; AT_PINRS(); AT_SB(); \
        AT_WAITV4(4, ta_[8], ta_[9], ta_[10], ta_[11]); vf_[4] = (bf16x8){ta_[8][0], ta_[8][1], ta_[8][2], ta_[8][3], ta_[9][0], ta_[9][1], ta_[9][2], ta_[9][3]}; vf_[5] = (bf16x8){ta_[10][0], ta_[10][1], ta_[10][2], ta_[10][3], ta_[11][0], ta_[11][1], ta_[11][2], ta_[11][3]}; \
        o0 = MFMA32(__builtin_bit_cast(bf16x8, pw[2]), vf_[4], o0); AT_PIN1(o0); pw[3].x = cvtpk(C1[8], C1[9]); pw[3].y = cvtpk(C1[10], C1[11]); rs0 += C1[0]; rs1 += C1[1]; rs2 += C1[2]; rs3 += C1[3]; AT_PINRS(); AT_SB(); \
        o1 = MFMA32(__builtin_bit_cast(bf16x8, pw[2]), vf_[5], o1); AT_PIN1(o1); pw[3].z = cvtpk(C1[12], C1[13]); pw[3].w = cvtpk(C1[14], C1[15]); rs0 += C1[4]; rs1 += C1[5]; rs2 += C1[6]; rs3 += C1[7]; AT_PINRS(); AT_SB(); \
        AT_WAITV4(0, ta_[12], ta_[13], ta_[14], ta_[15]); vf_[6] = (bf16x8){ta_[12][0], ta_[12][1], ta_[12][2], ta_[12][3], ta_[13][0], ta_[13][1], ta_[13][2], ta_[13][3]}; vf_[7] = (bf16x8){ta_[14][0], ta_[14][1], ta_[14][2], ta_[14][3], ta_[15][0], ta_[15][1], ta_[15][2], ta_[15][3]}; \
        o0 = MFMA32(__builtin_bit_cast(bf16x8, pw[3]), vf_[6], o0); AT_PIN1(o0); rs0 += C1[8]; rs1 += C1[9]; rs2 += C1[10]; rs3 += C1[11]; AT_PINRS(); AT_SB(); \
        o1 = MFMA32(__builtin_bit_cast(bf16x8, pw[3]), vf_[7], o1); AT_PIN1(o1); rs0 += C1[12]; rs1 += C1[13]; rs2 += C1[14]; rs3 += C1[15]; AT_PINRS(); AT_SB(); } \
        l += (rs0 + rs1) + (rs2 + rs3); \
        AT_WAITBAR(); \
        if (t_ + 1 < ntiles) AT_REF(N0, N1, t1_, false); } while (0)
    for (int it = 0; it < ntiles; it += 2) {
        AT_STEP(cA0, cA1, cB0, cB1, it);
        AT_STEP(cB0, cB1, cA0, cA1, it + 1);
    }
#undef AT_ROW0
#undef AT_DMAK
#undef AT_DMAV
#undef AT_CLAMP
#undef AT_WAITBAR
#undef AT_REF
#undef AT_SB
#undef AT_PIN2
#undef AT_PIN1
#undef AT_PINRS
#undef AT_LDK
#undef AT_WAITK
#undef AT_WAITV8
#undef AT_WAITV4
#undef AT_EXP
#undef AT_QK
#undef AT_STEP
    float lt = l + shxl(l, 32, lane);
    float fin = 1.f;
    if (p.sink) { const float sk = p.sink[h] * LOG2E; const float m2 = fmaxf(m, sk); fin = __builtin_amdgcn_exp2f(m - m2); lt = lt * fin + __builtin_amdgcn_exp2f(sk - m2); }
    const float sc = fin / lt;
    if (hi == 0) wsf[r32] = sc;
    bf16_t* Ob = p.O + (size_t)(q0 + wid * 32) * p.old + h * p.ohs + r32;
#pragma unroll
    for (int r = 0; r < 16; ++r) { const int qr_ = crow(r, hi); const float f = wsf[qr_];
        if (!nostore) { Ob[(size_t)qr_ * p.old] = f2bf(o0[r] * f); Ob[(size_t)qr_ * p.old + 32] = f2bf(o1[r] * f); } }
}

namespace gp {
constexpr int BM = 256, BK = 64, HALF = 128, HTB = HALF * BK * 2, STAGE_BYTES = 8 * HTB, NXCD = 8, WGM = 8;
__host__ __device__ __forceinline__ int lds_byte(int r, int c) { const int st = (r >> 4) * 2 + (c >> 5), rr = r & 15, cc = c & 31, ob = rr * 64 + cc * 2; return st * 1024 + (ob ^ (((ob >> 9) & 1) << 5)); }
__host__ __device__ __forceinline__ void stage_rc(int b, int& R, int& C) { const int st = b / 1024, sb = b % 1024, swz = sb ^ (((sb >> 9) & 1) << 5); R = (st >> 1) * 16 + swz / 64; C = (st & 1) * 32 + (swz % 64) / 2; }
__host__ __device__ __forceinline__ int perm32(int rho) { const int n = rho >> 4, i = rho & 15; return 8 * (i >> 2) + 4 * n + (i & 3); }

struct GUnit { const char* A; const char* B; int nt, pm, pn, tag; const unsigned* goff; int lda2, ldb2; };

__device__ __forceinline__ bool tile_order(int i, int G_, int c, int nM, int nN, int& pm, int& pn) {
    const int nwg = nM * nN; const long L = (long)i * G_ + c; if (L >= nwg) return false;
    int wgid = (int)L; { const int q = nwg / NXCD, r = nwg % NXCD, xcd = wgid % NXCD, off = wgid / NXCD; wgid = (xcd < r ? xcd * (q + 1) : r * (q + 1) + (xcd - r) * q) + off; }
    const int nig = WGM * nN, gid = wgid / nig, fm = gid * WGM, gsz = (nM - fm) < WGM ? (nM - fm) : WGM;
    pm = fm + ((wgid % nig) % gsz); pn = (wgid % nig) / gsz; return true;
}
__device__ __forceinline__ unsigned cvt_pk_bf16(float lo, float hi) { return pkbf(lo, hi); }

template <class Epi, class Sched>
__device__ __forceinline__ void gemm_phase(LAS unsigned char* lds, const Sched& S, const Epi& E, int wv0) {
    constexpr bool GATHER = Sched::GATHER; constexpr bool VS = Sched::VARSTRIDE;
    const int tid = opaque_tid(wv0), wid = __builtin_amdgcn_readfirstlane(tid >> 6), lane = tid & 63, wr = wid >> 2, wc = wid & 3, fr = lane & 15, fq = lane >> 4;
    const int lda2 = S.lda2, ldb2 = S.ldb2;
    unsigned voffA[2], voffB[2], rowA[2], rowB[2], colb[2];
#pragma unroll
    for (int i = 0; i < 2; ++i) { int R, C; stage_rc(tid * 16 + i * 8192, R, C); const int Rb = Epi::PERM ? ((R & ~31) + perm32(R & 31)) : R;
        voffA[i] = GATHER ? (unsigned)C * 2u : (unsigned)R * (unsigned)lda2 + (unsigned)C * 2u; rowA[i] = (unsigned)R; voffB[i] = (unsigned)Rb * (unsigned)ldb2 + (unsigned)C * 2u; rowB[i] = (unsigned)Rb; colb[i] = (unsigned)C * 2u; }
    size_t hA = GATHER ? 0 : (size_t)HALF * lda2, hB = (size_t)HALF * ldb2;
    const unsigned ldsw = (unsigned)wid * 1024u;
    const int aoff = lds_byte(wr * 64 + fr, fq * 8), boff = lds_byte(wc * 32 + fr, fq * 8);
    constexpr size_t kstep = (size_t)(BK * 2);
#define GP_SA(b, h) (((b) * 2 + (h)) * HTB)
#define GP_SB(b, h) ((4 + (b) * 2 + (h)) * HTB)
#define GP_STAGE(bufoff, gbase, v0, v1) do { \
        __builtin_amdgcn_global_load_lds((const unsigned*)((const char*)(gbase) + (v0)), (LAS unsigned*)(lds + (bufoff) + ldsw), 16, 0, 0); \
        __builtin_amdgcn_global_load_lds((const unsigned*)((const char*)(gbase) + (v1)), (LAS unsigned*)(lds + (bufoff) + ldsw + 8192), 16, 0, 0); } while (0)
#define GP_LDA(dst, b, h) do { _Pragma("unroll") for (int m = 0; m < 4; ++m) _Pragma("unroll") for (int k = 0; k < 2; ++k) dst[m][k] = *(const LAS bf16x8*)(lds + GP_SA(b, h) + aoff + m * 2048 + k * 1024); } while (0)
#define GP_LDB(dst, b, h) do { _Pragma("unroll") for (int n = 0; n < 2; ++n) _Pragma("unroll") for (int k = 0; k < 2; ++k) dst[n][k] = *(const LAS bf16x8*)(lds + GP_SB(b, h) + boff + n * 2048 + k * 1024); } while (0)
#define GP_MMA(ai, bj, At, Bt) do { __builtin_amdgcn_s_setprio(1); _Pragma("unroll") for (int m = 0; m < 4; ++m) _Pragma("unroll") for (int n = 0; n < 2; ++n) _Pragma("unroll") for (int k = 0; k < 2; ++k) \
        acc[ai][bj][m][n] = __builtin_amdgcn_mfma_f32_16x16x32_bf16(Bt[n][k], At[m][k], acc[ai][bj][m][n], 0, 0, 0); __builtin_amdgcn_s_setprio(0); } while (0)
#define GP_WAIT_V(n) asm volatile("s_waitcnt vmcnt(" #n ")" ::: "memory")
#define GP_WAIT_L(n) asm volatile("s_waitcnt lgkmcnt(" #n ")" ::: "memory")
#define GP_BAR __builtin_amdgcn_s_barrier()
#define GP_SCHED __builtin_amdgcn_sched_barrier(0)
#define GP_GOFF(U, o0, o1, p0, p1) do { if (GATHER) { o0 = (U).goff[rowA[0]] + voffA[0]; o1 = (U).goff[rowA[1]] + voffA[1]; p0 = (U).goff[128 + rowA[0]] + voffA[0]; p1 = (U).goff[128 + rowA[1]] + voffA[1]; } \
        else { o0 = voffA[0]; o1 = voffA[1]; p0 = voffA[0]; p1 = voffA[1]; } } while (0)
    GUnit cur, nxt; int ui = 0;
    if (!S.next(0, cur)) return;
    f32x4 acc[2][2][4][2];
#pragma unroll
    for (int a = 0; a < 2; ++a)
#pragma unroll
        for (int b = 0; b < 2; ++b)
#pragma unroll
            for (int m = 0; m < 4; ++m)
#pragma unroll
                for (int n = 0; n < 2; ++n) acc[a][b][m][n] = (f32x4){0.f, 0.f, 0.f, 0.f};
    bf16x8 At[4][2], B0[2][2], B1[2][2];
    unsigned g00, g01, g10, g11;
    if (VS) { voffA[0] = rowA[0] * (unsigned)cur.lda2 + colb[0]; voffA[1] = rowA[1] * (unsigned)cur.lda2 + colb[1]; voffB[0] = rowB[0] * (unsigned)cur.ldb2 + colb[0]; voffB[1] = rowB[1] * (unsigned)cur.ldb2 + colb[1];
              hA = (size_t)HALF * cur.lda2; hB = (size_t)HALF * cur.ldb2; }
    GP_GOFF(cur, g00, g01, g10, g11);
    const char* cA = cur.A; const char* cB = cur.B;
    GP_STAGE(GP_SB(0, 0), cB, voffB[0], voffB[1]); GP_STAGE(GP_SA(0, 0), cA, g00, g01); GP_STAGE(GP_SB(0, 1), cB + hB, voffB[0], voffB[1]); GP_STAGE(GP_SA(0, 1), cA + hA, g10, g11);
    if (wr == 1) GP_BAR;
    GP_WAIT_V(4); GP_BAR;
    GP_STAGE(GP_SB(1, 0), cB + kstep, voffB[0], voffB[1]); GP_STAGE(GP_SA(1, 0), cA + kstep, g00, g01); GP_STAGE(GP_SB(1, 1), cB + hB + kstep, voffB[0], voffB[1]);
    GP_WAIT_V(6); GP_BAR;
    for (;;) {
        const bool has_next = S.next(ui + 1, nxt);
        const char* nA = has_next ? nxt.A : cA; const char* nB = has_next ? nxt.B : cB;
        const int nt = cur.nt;
        for (int t = 0; t < nt; t += 2) {
            const bool last = (t == nt - 2);
            const char* a1 = cA + (size_t)(t + 1) * kstep;
            const char* a2 = last ? nA : cA + (size_t)(t + 2) * kstep; const char* b2 = last ? nB : cB + (size_t)(t + 2) * kstep;
            const char* a3 = a2 + kstep; const char* b3 = b2 + kstep;
            unsigned w00 = g00, w01 = g01, w10 = g10, w11 = g11, wB0 = voffB[0], wB1 = voffB[1]; size_t whA = hA, whB = hB;
            if (GATHER && last && has_next) { GP_GOFF(nxt, w00, w01, w10, w11); }
            if (VS && last && has_next) { w00 = w10 = rowA[0] * (unsigned)nxt.lda2 + colb[0]; w01 = w11 = rowA[1] * (unsigned)nxt.lda2 + colb[1]; wB0 = rowB[0] * (unsigned)nxt.ldb2 + colb[0]; wB1 = rowB[1] * (unsigned)nxt.ldb2 + colb[1];
                whA = (size_t)HALF * nxt.lda2; whB = (size_t)HALF * nxt.ldb2; }
            GP_LDB(B0, 0, 0); GP_SCHED; GP_LDA(At, 0, 0); GP_STAGE(GP_SA(1, 1), a1 + hA, g10, g11);
            GP_WAIT_L(8); GP_BAR; GP_WAIT_L(0); GP_MMA(0, 0, At, B0); GP_BAR; GP_SCHED;
            GP_LDB(B1, 0, 1); GP_STAGE(GP_SB(0, 0), b2, wB0, wB1);
            GP_BAR; GP_WAIT_L(0); GP_MMA(0, 1, At, B1); GP_BAR;
            GP_LDA(At, 0, 1); GP_STAGE(GP_SA(0, 0), a2, w00, w01);
            GP_BAR; GP_WAIT_L(0); GP_MMA(1, 0, At, B0); GP_BAR; GP_SCHED;
            GP_STAGE(GP_SB(0, 1), b2 + whB, wB0, wB1);
            GP_WAIT_V(6); GP_BAR; GP_MMA(1, 1, At, B1); GP_BAR;
            GP_LDB(B0, 1, 0); GP_SCHED; GP_LDA(At, 1, 0); GP_STAGE(GP_SA(0, 1), a2 + whA, w10, w11);
            GP_WAIT_L(8); GP_BAR; GP_WAIT_L(0); GP_MMA(0, 0, At, B0); GP_BAR; GP_SCHED;
            GP_LDB(B1, 1, 1); GP_STAGE(GP_SB(1, 0), b3, wB0, wB1);
            GP_BAR; GP_WAIT_L(0); GP_MMA(0, 1, At, B1); GP_BAR;
            GP_LDA(At, 1, 1); GP_STAGE(GP_SA(1, 0), a3, w00, w01);
            GP_BAR; GP_WAIT_L(0); GP_MMA(1, 0, At, B0); GP_BAR; GP_SCHED;
            GP_STAGE(GP_SB(1, 1), b3 + whB, wB0, wB1);
            GP_WAIT_V(6); GP_BAR; GP_MMA(1, 1, At, B1); GP_BAR;
            if ((GATHER || VS) && last) { g00 = w00; g01 = w01; g10 = w10; g11 = w11; }
            if (VS && last) { voffB[0] = wB0; voffB[1] = wB1; hA = whA; hB = whB; }
        }
        { int fr_e = fr, fq_e = fq; asm volatile("" : "+v"(fr_e), "+v"(fq_e));
          E(acc, cur, wr, wc, fr_e, fq_e); }
        if (!has_next) break;
#pragma unroll
        for (int a = 0; a < 2; ++a)
#pragma unroll
            for (int b = 0; b < 2; ++b)
#pragma unroll
                for (int m = 0; m < 4; ++m)
#pragma unroll
                    for (int n = 0; n < 2; ++n) acc[a][b][m][n] = (f32x4){0.f, 0.f, 0.f, 0.f};
        cur = nxt; cA = nA; cB = nB; ++ui;
    }
    GP_WAIT_V(0);
    if (wr == 0) GP_BAR;
    GP_BAR;
#undef GP_SA
#undef GP_SB
#undef GP_STAGE
#undef GP_LDA
#undef GP_LDB
#undef GP_MMA
#undef GP_WAIT_V
#undef GP_WAIT_L
#undef GP_BAR
#undef GP_SCHED
#undef GP_GOFF
}
}

struct SchedStd {
    static constexpr bool GATHER = false; static constexpr bool VARSTRIDE = false;
    const bf16_t* A; const bf16_t* Bt; int K, nM, nN, G_, c, skipctx, lda2, ldb2;
    __device__ __forceinline__ bool next(int i, gp::GUnit& u) const {
        int pmv, pn; if (!gp::tile_order(i, G_, c, nM, nN, pmv, pn)) return false;
        const int pm = skipctx ? pmv + pmv / 32 : pmv;
        u.A = (const char*)(A + (size_t)pm * 256 * K); u.B = (const char*)(Bt + (size_t)pn * 256 * K); u.nt = K / 64; u.pm = pm; u.pn = pn; u.tag = 0; u.goff = nullptr; return true;
    }
};

__device__ __forceinline__ float fexp(float x) { return __builtin_amdgcn_exp2f(x * LOG2E); }
__device__ __forceinline__ float flog(float x) { return __builtin_amdgcn_logf(x) * 0.6931471805599453f; }
__device__ __forceinline__ float fsigmoid(float x) { return __builtin_amdgcn_rcpf(1.f + fexp(-x)); }
__device__ __forceinline__ float logf_gate_fast(float z, float lb) {
    if (lb <= 0.f) return fminf(z, 0.f) - flog(1.f + fexp(-fabsf(z)));
    return flog(lb + (1.f - lb) * fsigmoid(z));
}
__device__ __forceinline__ unsigned pkh2(float lo, float hi) { const f16_t a = (f16_t)lo, b = (f16_t)hi; return (unsigned)__builtin_bit_cast(unsigned short, a) | ((unsigned)__builtin_bit_cast(unsigned short, b) << 16); }

template <class T> __device__ __forceinline__ T* opq(T* p) { asm volatile("" : "+s"(p)); return p; }
struct EpiG1 {
    static constexpr bool PERM = true;
    bf16_t *AQ, *AK, *AV, *BQ, *BV, *BG; f16_t *BLF, *BLB; bf16_t *CQKV, *CKR; float* RS; const float *ropa_c, *ropa_s, *ropc_c, *ropc_s; const float* LBl; int rowoff;
    __device__ __forceinline__ void operator()(const f32x4 (&acc)[2][2][4][2], const gp::GUnit& u, int wr, int wc, int fr, int fq) const {
        const int pn = u.pn; const int pr = u.pm % 33; const bool lat = pr < 32;
        const int grow0 = u.pm * 256 + wr * 64 + fr; const int t0 = pr * 256 + wr * 64 + fr;
        if (pn < 3) {
            const int hh = pn * 4 + wc; bf16_t* dst; int ld, coff; bf16_t* const aq_ = opq(AQ); bf16_t* const ak_ = opq(AK); bf16_t* const av_ = opq(AV);
            if (hh < 8) { dst = aq_; ld = 512; coff = hh * 64; } else if (hh < 10) { dst = ak_; ld = 128; coff = (hh - 8) * 64; } else { dst = av_; ld = 128; coff = (hh - 10) * 64; }
            const bool rope = lat && hh < 10;
#pragma unroll
            for (int ai = 0; ai < 2; ++ai)
#pragma unroll
                for (int m = 0; m < 4; ++m) { const int grow = grow0 + ai * 128 + m * 16, t = t0 + ai * 128 + m * 16; const size_t row = (size_t)(grow - rowoff);
                    f32x4 x1a = acc[ai][0][m][0], x1b = acc[ai][0][m][1], x2a = acc[ai][1][m][0], x2b = acc[ai][1][m][1];
                    if (rope) { const f32x4 ca = *(const f32x4*)(ropa_c + t * 32 + 8 * fq), cb = *(const f32x4*)(ropa_c + t * 32 + 8 * fq + 4), sa = *(const f32x4*)(ropa_s + t * 32 + 8 * fq), sb = *(const f32x4*)(ropa_s + t * 32 + 8 * fq + 4);
                        const f32x4 o1a = x1a * ca - x2a * sa, o2a = x1a * sa + x2a * ca, o1b = x1b * cb - x2b * sb, o2b = x1b * sb + x2b * cb; x1a = o1a; x2a = o2a; x1b = o1b; x2b = o2b; }
                    if (hh < 8) { const float qs = 0.125f * LOG2E; x1a *= qs; x1b *= qs; x2a *= qs; x2b *= qs; }
                    bf16_t* p = dst + row * ld + coff + 8 * fq;
                    u32x4 w1, w2; w1.x = gp::cvt_pk_bf16(x1a[0], x1a[1]); w1.y = gp::cvt_pk_bf16(x1a[2], x1a[3]); w1.z = gp::cvt_pk_bf16(x1b[0], x1b[1]); w1.w = gp::cvt_pk_bf16(x1b[2], x1b[3]);
                    w2.x = gp::cvt_pk_bf16(x2a[0], x2a[1]); w2.y = gp::cvt_pk_bf16(x2a[2], x2a[3]); w2.z = gp::cvt_pk_bf16(x2b[0], x2b[1]); w2.w = gp::cvt_pk_bf16(x2b[2], x2b[3]);
                    *(u32x4*)p = w1; *(u32x4*)(p + 32) = w2; if (m == 3) asm volatile("" ::: "memory"); }
        } else if (pn < 13) {
            const int q = pn - 3, which = q >> 1; const int cb0 = (q & 1) * 256 + wc * 32 + 8 * fq;
            if (which == 2 || which == 3) {
                f16_t* const blf_ = opq(BLF); f16_t* const blb_ = opq(BLB); f16_t* dst = which == 2 ? blf_ : blb_; const float* lbp = LBl + (which == 2 ? 0 : 512);
#pragma unroll
                for (int bj = 0; bj < 2; ++bj) { const int c0 = cb0 + bj * 128; const f32x4 la = *(const f32x4*)(lbp + c0), lb4 = *(const f32x4*)(lbp + c0 + 4);
#pragma unroll
                    for (int ai = 0; ai < 2; ++ai)
#pragma unroll
                        for (int m = 0; m < 4; ++m) { const size_t row = (size_t)(grow0 + ai * 128 + m * 16 - rowoff); const f32x4 v0 = acc[ai][bj][m][0], v1 = acc[ai][bj][m][1];
                            u32x4 w; w.x = pkh2(logf_gate_fast(v0[0], la[0]), logf_gate_fast(v0[1], la[1])); w.y = pkh2(logf_gate_fast(v0[2], la[2]), logf_gate_fast(v0[3], la[3]));
                            w.z = pkh2(logf_gate_fast(v1[0], lb4[0]), logf_gate_fast(v1[1], lb4[1])); w.w = pkh2(logf_gate_fast(v1[2], lb4[2]), logf_gate_fast(v1[3], lb4[3]));
                            *(u32x4*)(dst + row * 512 + c0) = w; } }
            } else {
                bf16_t* const bq_ = opq(BQ); bf16_t* const bv_ = opq(BV); bf16_t* const bg_ = opq(BG); bf16_t* dst = which == 0 ? bq_ : (which == 1 ? bv_ : bg_);
#pragma unroll
                for (int ai = 0; ai < 2; ++ai)
#pragma unroll
                    for (int m = 0; m < 4; ++m) { const size_t row = (size_t)(grow0 + ai * 128 + m * 16 - rowoff);
#pragma unroll
                        for (int bj = 0; bj < 2; ++bj) { const f32x4 v0 = acc[ai][bj][m][0], v1 = acc[ai][bj][m][1];
                            u32x4 w; w.x = gp::cvt_pk_bf16(v0[0], v0[1]); w.y = gp::cvt_pk_bf16(v0[2], v0[3]); w.z = gp::cvt_pk_bf16(v1[0], v1[1]); w.w = gp::cvt_pk_bf16(v1[2], v1[3]);
                            *(u32x4*)(dst + row * 512 + cb0 + bj * 128) = w; } }
            }
        } else if (pn == 13) {
#pragma unroll
            for (int ai = 0; ai < 2; ++ai)
#pragma unroll
                for (int m = 0; m < 4; ++m) { const int grow = grow0 + ai * 128 + m * 16; const size_t row = (size_t)(grow - rowoff); float ss = 0.f;
#pragma unroll
                    for (int bj = 0; bj < 2; ++bj) { const f32x4 v0 = acc[ai][bj][m][0], v1 = acc[ai][bj][m][1];
                        ss += v0[0] * v0[0] + v0[1] * v0[1] + v0[2] * v0[2] + v0[3] * v0[3] + v1[0] * v1[0] + v1[1] * v1[1] + v1[2] * v1[2] + v1[3] * v1[3];
                        u32x4 w; w.x = gp::cvt_pk_bf16(v0[0], v0[1]); w.y = gp::cvt_pk_bf16(v0[2], v0[3]); w.z = gp::cvt_pk_bf16(v1[0], v1[1]); w.w = gp::cvt_pk_bf16(v1[2], v1[3]);
                        *(u32x4*)(CQKV + row * 384 + bj * 128 + wc * 32 + 8 * fq) = w; }
                    ss += shxl(ss, 16, fr | (fq << 4)); ss += shxl(ss, 32, fr | (fq << 4));
                    if (fq == 0) RS[(size_t)grow * 8 + wc] = ss; }
        } else {
#pragma unroll
            for (int ai = 0; ai < 2; ++ai)
#pragma unroll
                for (int m = 0; m < 4; ++m) { const int grow = grow0 + ai * 128 + m * 16, t = t0 + ai * 128 + m * 16; const size_t row = (size_t)(grow - rowoff);
                    const f32x4 v0 = acc[ai][0][m][0], v1 = acc[ai][0][m][1];
                    float ss = v0[0] * v0[0] + v0[1] * v0[1] + v0[2] * v0[2] + v0[3] * v0[3] + v1[0] * v1[0] + v1[1] * v1[1] + v1[2] * v1[2] + v1[3] * v1[3];
                    u32x4 w; w.x = gp::cvt_pk_bf16(v0[0], v0[1]); w.y = gp::cvt_pk_bf16(v0[2], v0[3]); w.z = gp::cvt_pk_bf16(v1[0], v1[1]); w.w = gp::cvt_pk_bf16(v1[2], v1[3]);
                    *(u32x4*)(CQKV + row * 384 + 256 + wc * 32 + 8 * fq) = w;
                    ss += shxl(ss, 16, fr | (fq << 4)); ss += shxl(ss, 32, fr | (fq << 4));
                    if (fq == 0) RS[(size_t)grow * 8 + 4 + wc] = ss;
                    if (wc == 0) { f32x4 x1 = acc[ai][1][m][0], x2 = acc[ai][1][m][1];
                        if (lat) { const f32x4 cc = *(const f32x4*)(ropc_c + t * 16 + 4 * fq), sn = *(const f32x4*)(ropc_s + t * 16 + 4 * fq); const f32x4 o1 = x1 * cc - x2 * sn, o2 = x1 * sn + x2 * cc; x1 = o1; x2 = o2; }
                        *(uint2*)(CKR + row * 32 + 4 * fq) = make_uint2(gp::cvt_pk_bf16(x1[0], x1[1]), gp::cvt_pk_bf16(x1[2], x1[3]));
                        *(uint2*)(CKR + row * 32 + 16 + 4 * fq) = make_uint2(gp::cvt_pk_bf16(x2[0], x2[1]), gp::cvt_pk_bf16(x2[2], x2[3])); } }
        }
    }
};

struct EpiC {
    static constexpr bool PERM = true;
    bf16_t *CQ, *CKV; const float* RS; const float *ropc_c, *ropc_s; int pmoff;
    __device__ __forceinline__ void operator()(const f32x4 (&acc)[2][2][4][2], const gp::GUnit& u, int wr, int wc, int fr, int fq) const {
        const int pn = u.pn; const int pr = (u.pm + pmoff) % 33; const bool lat = pr < 32;
        const int grow0 = u.pm * 256 + wr * 64 + fr; const int t0 = pr * 256 + wr * 64 + fr;
        f32x4 rs4[2][4];
#pragma unroll
        for (int ai = 0; ai < 2; ++ai)
#pragma unroll
            for (int m = 0; m < 4; ++m) rs4[ai][m] = *(const f32x4*)(RS + (size_t)(grow0 + ai * 128 + m * 16) * 8 + (pn < 3 ? 0 : 4));
#pragma unroll
        for (int ai = 0; ai < 2; ++ai)
#pragma unroll
            for (int m = 0; m < 4; ++m) { const size_t row = (size_t)(grow0 + ai * 128 + m * 16); const int t = t0 + ai * 128 + m * 16;
                if (pn < 3) { const f32x4 p4 = rs4[ai][m]; const float rq = rsqrtf(((p4[0] + p4[1]) + (p4[2] + p4[3])) * (1.f / 256.f) + EPS) * (0.10206207261596577f * LOG2E);
#pragma unroll
                    for (int bj = 0; bj < 2; ++bj) { const int gi = pn * 8 + bj * 4 + wc, head = gi / 3, part = gi - head * 3;
                        f32x4 v0 = acc[ai][bj][m][0] * rq, v1 = acc[ai][bj][m][1] * rq;
                        bf16_t* p = CQ + row * 768 + head * 96;
                        if (part < 2) { u32x4 w; w.x = gp::cvt_pk_bf16(v0[0], v0[1]); w.y = gp::cvt_pk_bf16(v0[2], v0[3]); w.z = gp::cvt_pk_bf16(v1[0], v1[1]); w.w = gp::cvt_pk_bf16(v1[2], v1[3]);
                            *(u32x4*)(p + part * 32 + 8 * fq) = w; }
                        else { if (lat) { const f32x4 cc = *(const f32x4*)(ropc_c + t * 16 + 4 * fq), sn = *(const f32x4*)(ropc_s + t * 16 + 4 * fq); const f32x4 o1 = v0 * cc - v1 * sn, o2 = v0 * sn + v1 * cc; v0 = o1; v1 = o2; }
                            *(uint2*)(p + 64 + 4 * fq) = make_uint2(gp::cvt_pk_bf16(v0[0], v0[1]), gp::cvt_pk_bf16(v0[2], v0[3]));
                            *(uint2*)(p + 80 + 4 * fq) = make_uint2(gp::cvt_pk_bf16(v1[0], v1[1]), gp::cvt_pk_bf16(v1[2], v1[3])); } }
                } else { const f32x4 p4 = rs4[ai][m]; const float rkv = rsqrtf(((p4[0] + p4[1]) + (p4[2] + p4[3])) * (1.f / 128.f) + EPS);
#pragma unroll
                    for (int bj = 0; bj < 2; ++bj) { const f32x4 v0 = acc[ai][bj][m][0] * rkv, v1 = acc[ai][bj][m][1] * rkv;
                        u32x4 w; w.x = gp::cvt_pk_bf16(v0[0], v0[1]); w.y = gp::cvt_pk_bf16(v0[2], v0[3]); w.z = gp::cvt_pk_bf16(v1[0], v1[1]); w.w = gp::cvt_pk_bf16(v1[2], v1[3]);
                        *(u32x4*)(CKV + row * 1024 + (pn - 3) * 256 + bj * 128 + wc * 32 + 8 * fq) = w; } } }
    }
};
struct EpiGate {
    static constexpr bool PERM = true;
    bf16_t* GATE; long nstride; int ld;
    __device__ __forceinline__ void operator()(const f32x4 (&acc)[2][2][4][2], const gp::GUnit& u, int wr, int wc, int fr, int fq) const {
        const int n3 = u.pn >> 2; bf16_t* base = GATE + (size_t)n3 * nstride + (u.pn & 3) * 256 + wc * 32 + 8 * fq; const int row0 = u.pm * 256 + wr * 64 + fr;
#pragma unroll
        for (int ai = 0; ai < 2; ++ai)
#pragma unroll
            for (int m = 0; m < 4; ++m) { bf16_t* rp = base + (size_t)(row0 + ai * 128 + m * 16) * ld;
#pragma unroll
                for (int bj = 0; bj < 2; ++bj) { const f32x4 v0 = acc[ai][bj][m][0], v1 = acc[ai][bj][m][1];
                    u32x4 w; w.x = gp::cvt_pk_bf16(fsigmoid(v0[0]), fsigmoid(v0[1])); w.y = gp::cvt_pk_bf16(fsigmoid(v0[2]), fsigmoid(v0[3])); w.z = gp::cvt_pk_bf16(fsigmoid(v1[0]), fsigmoid(v1[1])); w.w = gp::cvt_pk_bf16(fsigmoid(v1[2]), fsigmoid(v1[3]));
                    *(u32x4*)(rp + bj * 128) = w; } }
    }
};
struct SchedMerge {
    static constexpr bool GATHER = false; static constexpr bool VARSTRIDE = false;
    const bf16_t *A0, *A1, *A2; const bf16_t* Bt; int nM, G_, c, skipctx, lda2, ldb2;
    __device__ __forceinline__ bool next(int i, gp::GUnit& u) const {
        int pmv, pn12; if (!gp::tile_order(i, G_, c, nM, 12, pmv, pn12)) return false;
        const int n = pn12 >> 2, pn = pn12 & 3;
        const int pm = skipctx ? pmv + pmv / 32 : pmv;
        const bf16_t* a0 = opq(A0); const bf16_t* a1 = opq(A1); const bf16_t* a2 = opq(A2);
        const bf16_t* a = n == 0 ? a0 : (n == 1 ? a1 : a2);
        u.A = (const char*)(a + (size_t)pm * 256 * 512); u.B = (const char*)(Bt + (size_t)n * 1024 * 512 + (size_t)pn * 256 * 512); u.nt = 8; u.pm = pm; u.pn = pn; u.tag = n; u.goff = nullptr; return true;
    }
};
__device__ __forceinline__ float bflo(unsigned w) { return __uint_as_float(w << 16); }
__device__ __forceinline__ float bfhi(unsigned w) { return __uint_as_float(w & 0xffff0000u); }
struct EpiMerge {
    static constexpr bool PERM = true;
    bf16_t* GATE; long nstride; int ld;
    __device__ __forceinline__ void operator()(const f32x4 (&acc)[2][2][4][2], const gp::GUnit& u, int wr, int wc, int fr, int fq) const {
        if (PROBE_VARIANT == 3 && ld < 0) return;
        const int n3 = u.tag; const int col = u.pn * 256 + wc * 32 + 8 * fq; bf16_t* gb = GATE + (size_t)n3 * nstride + col; const int row0 = u.pm * 256 + wr * 64 + fr;
#pragma unroll
        for (int ai = 0; ai < 2; ++ai) { u32x4 g[4][2];
#pragma unroll
            for (int m = 0; m < 4; ++m)
#pragma unroll
                for (int bj = 0; bj < 2; ++bj) g[m][bj] = *(const u32x4*)(gb + (size_t)(row0 + ai * 128 + m * 16) * ld + bj * 128);
#pragma unroll
            for (int m = 0; m < 4; ++m)
#pragma unroll
                for (int bj = 0; bj < 2; ++bj) { const u32x4 gg = g[m][bj]; const f32x4 v0 = acc[ai][bj][m][0], v1 = acc[ai][bj][m][1];
                    u32x4 w; w.x = gp::cvt_pk_bf16(v0[0] * bflo(gg.x), v0[1] * bfhi(gg.x)); w.y = gp::cvt_pk_bf16(v0[2] * bflo(gg.y), v0[3] * bfhi(gg.y));
                    w.z = gp::cvt_pk_bf16(v1[0] * bflo(gg.z), v1[1] * bfhi(gg.z)); w.w = gp::cvt_pk_bf16(v1[2] * bflo(gg.w), v1[3] * bfhi(gg.w));
                    *(u32x4*)(gb + (size_t)(row0 + ai * 128 + m * 16) * ld + bj * 128) = w; }
            asm volatile("" ::: "memory"); }
    }
};
struct SchedGM {
    static constexpr bool GATHER = false; static constexpr bool VARSTRIDE = true;
    const bf16_t *A0, *A1, *A2, *Ag; const bf16_t *Bbr, *Bg; int nM, G_, c, skipctx, lda2, ldb2;
    __device__ __forceinline__ bool next(int i, gp::GUnit& u) const {
        int pmv, pn12; if (!gp::tile_order(i >> 1, G_, c, nM, 12, pmv, pn12)) return false;
        const int kind = i & 1, n = pn12 >> 2, pn = pn12 & 3;
        const int pm = skipctx ? pmv + pmv / 32 : pmv;
        const bf16_t* a0 = opq(A0); const bf16_t* a1 = opq(A1); const bf16_t* a2 = opq(A2); const bf16_t* ag = opq(Ag);
        const bf16_t* a = n == 0 ? a0 : (n == 1 ? a1 : a2);
        if (kind == 0) { u.A = (const char*)(a + (size_t)pm * 256 * 512); u.B = (const char*)(Bbr + (size_t)n * 1024 * 512 + (size_t)pn * 256 * 512); u.nt = 8; u.lda2 = 1024; u.ldb2 = 1024; }
        else { u.A = (const char*)(ag + (size_t)pm * 256 * 1024); u.B = (const char*)(Bg + (size_t)pn12 * 256 * 1024); u.nt = 16; u.lda2 = 2048; u.ldb2 = 2048; }
        u.pm = pm; u.pn = pn; u.tag = n + 4 * kind; u.goff = nullptr; return true;
    }
};
struct EpiGM {
    static constexpr bool PERM = true;
    bf16_t* U; long nstride; int ld;
    __device__ __forceinline__ void operator()(const f32x4 (&acc)[2][2][4][2], const gp::GUnit& u, int wr, int wc, int fr, int fq) const {
        const int n3 = u.tag & 3; const int col = u.pn * 256 + wc * 32 + 8 * fq; bf16_t* gb = U + (size_t)n3 * nstride + col; const int row0 = u.pm * 256 + wr * 64 + fr;
        if (u.tag < 4) {
#pragma unroll
            for (int ai = 0; ai < 2; ++ai)
#pragma unroll
                for (int m = 0; m < 4; ++m)
#pragma unroll
                    for (int bj = 0; bj < 2; ++bj) { const f32x4 v0 = acc[ai][bj][m][0], v1 = acc[ai][bj][m][1];
                        u32x4 w; w.x = gp::cvt_pk_bf16(v0[0], v0[1]); w.y = gp::cvt_pk_bf16(v0[2], v0[3]); w.z = gp::cvt_pk_bf16(v1[0], v1[1]); w.w = gp::cvt_pk_bf16(v1[2], v1[3]);
                        *(u32x4*)(gb + (size_t)(row0 + ai * 128 + m * 16) * ld + bj * 128) = w; }
        } else {
#pragma unroll
            for (int ai = 0; ai < 2; ++ai) { u32x4 z[4][2];
#pragma unroll
                for (int m = 0; m < 4; ++m)
#pragma unroll
                    for (int bj = 0; bj < 2; ++bj) z[m][bj] = *(const u32x4*)(gb + (size_t)(row0 + ai * 128 + m * 16) * ld + bj * 128);
#pragma unroll
                for (int m = 0; m < 4; ++m)
#pragma unroll
                    for (int bj = 0; bj < 2; ++bj) { const u32x4 zz = z[m][bj]; const f32x4 v0 = acc[ai][bj][m][0], v1 = acc[ai][bj][m][1];
                        u32x4 w; w.x = gp::cvt_pk_bf16(fsigmoid(v0[0]) * bflo(zz.x), fsigmoid(v0[1]) * bfhi(zz.x)); w.y = gp::cvt_pk_bf16(fsigmoid(v0[2]) * bflo(zz.y), fsigmoid(v0[3]) * bfhi(zz.y));
                        w.z = gp::cvt_pk_bf16(fsigmoid(v1[0]) * bflo(zz.z), fsigmoid(v1[1]) * bfhi(zz.z)); w.w = gp::cvt_pk_bf16(fsigmoid(v1[2]) * bflo(zz.w), fsigmoid(v1[3]) * bfhi(zz.w));
                        *(u32x4*)(gb + (size_t)(row0 + ai * 128 + m * 16) * ld + bj * 128) = w; }
                asm volatile("" ::: "memory"); }
        }
    }
};
struct EpiOut {
    static constexpr bool PERM = false;
    const float *xl_src, *xc_src; float *xl_dst, *xc_dst; const float* mod; int pmoff;
    __device__ __forceinline__ void operator()(const f32x4 (&acc)[2][2][4][2], const gp::GUnit& u, int wr, int wc, int fr, int fq) const {
        const int gpm = u.pm + pmoff, b = gpm / 33, pr = gpm - b * 33; const bool lat = pr < 32;
        const float* xs = opq(lat ? xl_src : xc_src); float* xd = opq(lat ? xl_dst : xc_dst);
        const size_t rbase = lat ? ((size_t)b * SEQ + pr * 256) : ((size_t)b * CTXL);
        const float* gt = mod + (size_t)(lat ? b : 4) * 6144 + 2048; const int col0 = u.pn * 256 + wc * 32 + 4 * fq;
        f32x4 g4[2][2];
#pragma unroll
        for (int bj = 0; bj < 2; ++bj)
#pragma unroll
            for (int n = 0; n < 2; ++n) g4[bj][n] = *(const f32x4*)(gt + col0 + bj * 128 + n * 16);
#pragma unroll
        for (int ai = 0; ai < 2; ++ai) { f32x4 xv[4][2][2];
#pragma unroll
            for (int m = 0; m < 4; ++m) { const size_t off = (rbase + ai * 128 + wr * 64 + m * 16 + fr) * D + col0;
#pragma unroll
                for (int bj = 0; bj < 2; ++bj)
#pragma unroll
                    for (int n = 0; n < 2; ++n) xv[m][bj][n] = *(const f32x4*)(xs + off + bj * 128 + n * 16); }
#pragma unroll
            for (int m = 0; m < 4; ++m) { const size_t off = (rbase + ai * 128 + wr * 64 + m * 16 + fr) * D + col0;
#pragma unroll
                for (int bj = 0; bj < 2; ++bj)
#pragma unroll
                    for (int n = 0; n < 2; ++n) *(f32x4*)(xd + off + bj * 128 + n * 16) = xv[m][bj][n] + g4[bj][n] * acc[ai][bj][m][n]; }
            asm volatile("" ::: "memory"); }
    }
};
template <bool GATHER_> struct SchedMoE {
    static constexpr bool GATHER = GATHER_; static constexpr bool VARSTRIDE = false;
    const bf16_t* A; const bf16_t* Bt; const int* tile_e; const unsigned* goff; int K, nM, nN, G_, c, lda2, ldb2; long strideB;
    __device__ __forceinline__ bool next(int i, gp::GUnit& u) const {
        int pm, pn; if (!gp::tile_order(i, G_, c, nM, nN, pm, pn)) return false;
        const int e = tile_e[pm];
        u.A = GATHER ? (const char*)A : (const char*)(A + (size_t)pm * 256 * K); u.B = (const char*)(Bt + (size_t)e * strideB + (size_t)pn * 256 * K); u.nt = K / 64; u.pm = pm; u.pn = pn; u.tag = e;
        u.goff = GATHER ? goff + (size_t)pm * 256 : nullptr; return true;
    }
};
struct EpiUp {
    static constexpr bool PERM = true;
    bf16_t* AUP;
    __device__ __forceinline__ void operator()(const f32x4 (&acc)[2][2][4][2], const gp::GUnit& u, int wr, int wc, int fr, int fq) const {
        const int row0 = u.pm * 256 + wr * 64 + fr; bf16_t* base = AUP + u.pn * 128 + wc * 32 + 8 * fq;
#pragma unroll
        for (int ai = 0; ai < 2; ++ai)
#pragma unroll
            for (int m = 0; m < 4; ++m) { const f32x4 a0 = acc[ai][0][m][0], a1 = acc[ai][0][m][1], b0 = acc[ai][1][m][0], b1 = acc[ai][1][m][1];
                float r[8];
#pragma unroll
                for (int e = 0; e < 4; ++e) { r[e] = a0[e] * fsigmoid(a0[e]) * b0[e]; r[4 + e] = a1[e] * fsigmoid(a1[e]) * b1[e]; }
                u32x4 w; w.x = gp::cvt_pk_bf16(r[0], r[1]); w.y = gp::cvt_pk_bf16(r[2], r[3]); w.z = gp::cvt_pk_bf16(r[4], r[5]); w.w = gp::cvt_pk_bf16(r[6], r[7]);
                *(u32x4*)(base + (size_t)(row0 + ai * 128 + m * 16) * 256) = w; }
    }
};
struct EpiDown {
    static constexpr bool PERM = true;
    bf16_t* YM2; const int* perm; const float* posw;
    __device__ __forceinline__ void operator()(const f32x4 (&acc)[2][2][4][2], const gp::GUnit& u, int wr, int wc, int fr, int fq) const {
        const int row0 = u.pm * 256 + wr * 64 + fr; const int col = u.pn * 256 + wc * 32 + 8 * fq;
        int pe8[2][4]; float w88[2][4];
#pragma unroll
        for (int ai = 0; ai < 2; ++ai)
#pragma unroll
            for (int m = 0; m < 4; ++m) { const int pos = row0 + ai * 128 + m * 16; pe8[ai][m] = perm[pos]; w88[ai][m] = posw[pos]; }
#pragma unroll
        for (int ai = 0; ai < 2; ++ai)
#pragma unroll
            for (int m = 0; m < 4; ++m) { const int pe = pe8[ai][m]; const float w8 = w88[ai][m];
                if (pe >= 0) {
#pragma unroll
                    for (int bj = 0; bj < 2; ++bj) { const f32x4 v0 = acc[ai][bj][m][0] * w8, v1 = acc[ai][bj][m][1] * w8;
                        u32x4 w; w.x = gp::cvt_pk_bf16(v0[0], v0[1]); w.y = gp::cvt_pk_bf16(v0[2], v0[3]); w.z = gp::cvt_pk_bf16(v1[0], v1[1]); w.w = gp::cvt_pk_bf16(v1[2], v1[3]);
                        *(u32x4*)(YM2 + (size_t)pe * 1024 + col + bj * 128) = w; } } }
    }
};
enum { MAP_WIN = 1, MAP_WC = 2, MAP_WUP = 3 };
__device__ __forceinline__ int colmap(int kind, int p) {
    if (kind == MAP_WIN) {
        if (p >= 3840) return MIXW + (p - 3840);
        const int pn = p >> 8, q = p & 255, bj = q >> 7, wc = (q >> 5) & 3, j = q & 31;
        if (pn < 3) return (pn * 4 + wc) * 64 + bj * 32 + j;
        if (pn < 14) return p;
        if (bj == 0) return p;
        if (wc != 0) return -1;
        return 3712 + 16 * ((j >> 2) & 1) + 4 * (j >> 3) + (j & 3);
    }
    return p;
}
constexpr int NCHK = RPB / 64;
struct ScanArgs { const bf16_t* BQ; const bf16_t* BV; const bf16_t* BG; const f16_t* BLF; const f16_t* BLB; bf16_t* ST; float* DS; bf16_t* OB; const float* gn; int in_off; int out_off; int skipctx_out; int pad; };
#define MFMA16(a, b, c) __builtin_amdgcn_mfma_f32_16x16x32_bf16(a, b, c, 0, 0, 0)
constexpr int BCS = 68;
constexpr int SC_RAW = 0, SC_VT = 2 * 64 * BCS * 4, SC_A = SC_VT + 9216;
typedef _Float16 sc_h8 __attribute__((ext_vector_type(8)));
struct StageRegs { sc_h8 lf, lb; bf16x8 v; };
__device__ __forceinline__ void scan_stage_load(const ScanArgs& a, size_t row0, int h, int tid, StageRegs& R) {
    const int row = tid >> 3, c8 = (tid & 7) * 8; const size_t off = (row0 + row) * 512 + h * 64 + c8;
    R.lf = *(const sc_h8*)(a.BLF + off); R.lb = *(const sc_h8*)(a.BLB + off);
    const int vrow = tid & 63, vc8 = (tid >> 6) * 8; R.v = *(const bf16x8*)(a.BV + (row0 + vrow) * 512 + h * 64 + vc8);
}
__device__ __forceinline__ void scan_stage_store(LAS char* lds, int tid, const StageRegs& R) {
    LAS float* RAW = (LAS float*)(lds + SC_RAW); LAS bf16_t* VT = (LAS bf16_t*)(lds + SC_VT);
    const int row = tid >> 3, c8 = (tid & 7) * 8; const int vrow = tid & 63, vc8 = (tid >> 6) * 8; const sc_h8 lf = R.lf, lb = R.lb; const bf16x8 v = R.v;
    *(LAS f32x4*)(RAW + row * BCS + c8) = (f32x4){(float)lf[0], (float)lf[1], (float)lf[2], (float)lf[3]}; *(LAS f32x4*)(RAW + row * BCS + c8 + 4) = (f32x4){(float)lf[4], (float)lf[5], (float)lf[6], (float)lf[7]};
    *(LAS f32x4*)(RAW + 64 * BCS + row * BCS + c8) = (f32x4){(float)lb[0], (float)lb[1], (float)lb[2], (float)lb[3]}; *(LAS f32x4*)(RAW + 64 * BCS + row * BCS + c8 + 4) = (f32x4){(float)lb[4], (float)lb[5], (float)lb[6], (float)lb[7]};
#pragma unroll
    for (int j = 0; j < 8; ++j) VT[(vc8 + j) * 72 + vrow] = (bf16_t)v[j];
}
__device__ __forceinline__ void scan_stage(LAS char* lds, const ScanArgs& a, size_t row0, int h, int tid) { StageRegs R; scan_stage_load(a, row0, h, tid, R); scan_stage_store(lds, tid, R); }
__device__ __forceinline__ void scan_cumsum(LAS char* lds, LAS float* XCH, int tid, float (&lf)[16], float (&bc)[16], float& total) {
    LAS float* RAW = (LAS float*)(lds + SC_RAW);
    const int col = tid & 127, dir = col >> 6, d = col & 63, seg = tid >> 7;
#pragma unroll
    for (int j = 0; j < 16; ++j) lf[j] = RAW[dir * 64 * BCS + (16 * seg + j) * BCS + d];
    if (dir == 0) { float c = 0.f;
#pragma unroll
        for (int j = 0; j < 16; ++j) { c += lf[j]; bc[j] = c; } }
    else { float c = 0.f;
#pragma unroll
        for (int j = 15; j >= 0; --j) { c += lf[j]; bc[j] = c; } }
    XCH[seg * 128 + col] = dir == 0 ? bc[15] : bc[0];
    __syncthreads();
    const float t0 = XCH[col], t1 = XCH[128 + col], t2 = XCH[256 + col], t3 = XCH[384 + col];
    total = (t0 + t1) + (t2 + t3);
    float off;
    if (dir == 0) off = seg == 0 ? 0.f : (seg == 1 ? t0 : (seg == 2 ? t0 + t1 : t0 + t1 + t2));
    else off = seg == 3 ? 0.f : (seg == 2 ? t3 : (seg == 1 ? t3 + t2 : t3 + t2 + t1));
#pragma unroll
    for (int j = 0; j < 16; ++j) bc[j] += off;
}
__device__ __forceinline__ void scan_s1_unit(LAS char* lds, const ScanArgs& a, int wv0, int b, int h, int k, bool hasnext, int nb, int nh, int nk) {
    const int tid = opaque_tid(wv0), lane = tid & 63, wid = tid >> 6;
    LAS bf16_t* VT = (LAS bf16_t*)(lds + SC_VT); LAS bf16_t* KKT = (LAS bf16_t*)(lds + SC_A); LAS float* XCH = (LAS float*)(lds + SC_A + 18432);
    const size_t row0 = (size_t)b * RPB + 64 * k - a.in_off;
    __syncthreads();
    float lf[16], bc[16], total; scan_cumsum(lds, XCH, tid, lf, bc, total);
    const int col = tid & 127, dir = col >> 6, d = col & 63, seg = tid >> 7;
    const size_t sidx = ((size_t)((b * 8 + h) * 2 + dir)) * NCHK + k;
    { unsigned w[8];
#pragma unroll
      for (int j = 0; j < 16; j += 2) { const float k0 = (1.f - fexp(lf[j])) * fexp(total - bc[j]), k1 = (1.f - fexp(lf[j + 1])) * fexp(total - bc[j + 1]); w[j >> 1] = pkbf(k0, k1); }
      LAS u32x4* kp = (LAS u32x4*)(KKT + (dir * 64 + d) * 72 + 16 * seg); kp[0] = (u32x4){w[0], w[1], w[2], w[3]}; kp[1] = (u32x4){w[4], w[5], w[6], w[7]};
      if (seg == 0) a.DS[sidx * 64 + d] = fexp(total); }
    __syncthreads();
    StageRegs R; if (hasnext) scan_stage_load(a, (size_t)nb * RPB + 64 * nk - a.in_off, nh, tid, R);
    { const int wdir = wid >> 2, et = wid & 3, fr = lane & 15, fq = lane >> 4;
      f32x4 acc[4];
#pragma unroll
      for (int dt = 0; dt < 4; ++dt) acc[dt] = (f32x4){0.f, 0.f, 0.f, 0.f};
#pragma unroll
      for (int ks = 0; ks < 2; ++ks) { const bf16x8 af = *(const LAS bf16x8*)(VT + (16 * et + fr) * 72 + 32 * ks + 8 * fq);
#pragma unroll
          for (int dt = 0; dt < 4; ++dt) { const bf16x8 bfv = *(const LAS bf16x8*)(KKT + (wdir * 64 + 16 * dt + fr) * 72 + 32 * ks + 8 * fq); acc[dt] = MFMA16(af, bfv, acc[dt]); } }
      bf16_t* sp = a.ST + (((size_t)((b * 8 + h) * 2 + wdir)) * NCHK + k) * 4096;
#pragma unroll
      for (int dt = 0; dt < 4; ++dt)
#pragma unroll
          for (int r = 0; r < 4; ++r) sp[(16 * et + 4 * fq + r) * 64 + 16 * dt + fr] = f2bf(acc[dt][r]); }
    __syncthreads();
    if (hasnext) scan_stage_store(lds, tid, R);
}
__device__ __forceinline__ void scan_s2_task(const ScanArgs& a, int wv0, int task) {
    const int chain = task >> 2, quarter = task & 3, dir = chain & 1, tid = opaque_tid(wv0);
    const int e = 16 * quarter + (tid >> 5), d = 2 * (tid & 31);
    float s0 = 0.f, s1 = 0.f;
    for (int g = 0; g < NCHK; g += 12) {
        unsigned L[12]; float2 Dv[12]; unsigned* pp[12];
#pragma unroll
        for (int j = 0; j < 12; ++j) { const int step = g + j; const int k = dir == 0 ? (step < 4 ? 128 + step : step - 4) : (step < 4 ? 131 - step : 131 - step);
            const size_t idx = (size_t)chain * NCHK + k; pp[j] = (unsigned*)(a.ST + idx * 4096 + e * 64 + d); L[j] = *pp[j]; Dv[j] = *(const float2*)(a.DS + idx * 64 + d); }
#pragma unroll
        for (int j = 0; j < 12; ++j) { *pp[j] = pkbf(s0, s1); s0 = Dv[j].x * s0 + bflo(L[j]); s1 = Dv[j].y * s1 + bfhi(L[j]); }
    }
}
__device__ __forceinline__ void s3_state_load(const ScanArgs& a, int b, int h, int k, int tid, u32x4& s0, u32x4& s1) {
    const int sd = tid >> 8, e = (tid & 255) >> 2, c16 = (tid & 3) * 16; const bf16_t* sp = a.ST + (((size_t)((b * 8 + h) * 2 + sd)) * NCHK + k) * 4096 + e * 64 + c16; s0 = *(const u32x4*)sp; s1 = *(const u32x4*)(sp + 8); }
__device__ __forceinline__ void s3_state_store(LAS bf16_t* STL, int tid, const u32x4& s0, const u32x4& s1) {
    const int sd = tid >> 8, e = (tid & 255) >> 2, c16 = (tid & 3) * 16; LAS u32x4* dp = (LAS u32x4*)(STL + (sd * 64 + e) * 72 + c16); dp[0] = s0; dp[1] = s1; }
__device__ __forceinline__ void scan_s3_unit(LAS char* lds, const ScanArgs& a, int wv0, int b, int h, int k, bool hasnext, int nb, int nh, int nk) {
    const int tid = opaque_tid(wv0), lane = tid & 63, wid = tid >> 6;
    LAS float* BC = (LAS float*)(lds + SC_RAW); LAS bf16_t* VT = (LAS bf16_t*)(lds + SC_VT);
    LAS bf16_t* STL = (LAS bf16_t*)(lds + SC_A);
    LAS float* XCH = (LAS float*)(lds + SC_A + 18432);
    LAS float* OSUM = (LAS float*)(lds + SC_A + 18432 + 2048);
    LAS bf16_t* PW = (LAS bf16_t*)(lds + SC_A + 18432 + 2048 + 17408) + wid * 3456;
    const size_t row0 = (size_t)b * RPB + 64 * k - a.in_off;
    bf16x8 q0_, q1_; bf16_t gpre[16];
    { const int dir_ = wid >> 2, si_ = wid & 3, erow_ = lane >> 2, dg_ = (lane & 3) * 16, fr_ = lane & 15, fq_ = lane >> 4;
      const bf16_t* qp = a.BQ + (row0 + 16 * si_ + erow_) * 512 + h * 64 + dg_; q0_ = *(const bf16x8*)qp; q1_ = *(const bf16x8*)(qp + 8);
      if (dir_ == 1) {
#pragma unroll
          for (int n = 0; n < 4; ++n)
#pragma unroll
              for (int r = 0; r < 4; ++r) gpre[n * 4 + r] = a.BG[(row0 + 16 * si_ + 4 * fq_ + r) * 512 + h * 64 + 16 * n + fr_]; }
      else {
#pragma unroll
          for (int i = 0; i < 16; ++i) gpre[i] = 0; } }
    __syncthreads();
    { float lf[16], bc[16], total; scan_cumsum(lds, XCH, tid, lf, bc, total);
      const int col = tid & 127, dir = col >> 6, d = col & 63, seg = tid >> 7;
      __syncthreads();
#pragma unroll
      for (int j = 0; j < 16; ++j) BC[dir * 64 * BCS + (16 * seg + j) * BCS + d] = bc[j]; }
    __syncthreads();
    StageRegs Rn; u32x4 ns0, ns1;
    if (hasnext) { scan_stage_load(a, (size_t)nb * RPB + 64 * nk - a.in_off, nh, tid, Rn); s3_state_load(a, nb, nh, nk, tid, ns0, ns1); }
    const int dir = wid >> 2, si = wid & 3;
    LAS bf16_t* QP = PW; LAS bf16_t* KP = PW + 1152; LAS bf16_t* ATT = PW + 2304;
    const int erow = lane >> 2, dg = (lane & 3) * 16;
    const int fr = lane & 15, fq = lane >> 4;
    LAS const float* bcd = BC + dir * 64 * BCS;
    float refv[16];
    { const int rr = dir == 0 ? 16 * si - 1 : 16 * (si + 1);
#pragma unroll
      for (int j = 0; j < 16; j += 4) { f32x4 t4 = (f32x4){0.f, 0.f, 0.f, 0.f}; if (rr >= 0 && rr < 64) t4 = *(const LAS f32x4*)(bcd + rr * BCS + dg + j); refv[j] = t4[0]; refv[j + 1] = t4[1]; refv[j + 2] = t4[2]; refv[j + 3] = t4[3]; } }
    float qv[16], bq[16];
    {
#pragma unroll
      for (int j = 0; j < 8; ++j) { qv[j] = bf2f((bf16_t)q0_[j]); qv[8 + j] = bf2f((bf16_t)q1_[j]); }
#pragma unroll
      for (int j = 0; j < 16; j += 4) { const f32x4 t4 = *(const LAS f32x4*)(bcd + (16 * si + erow) * BCS + dg + j); bq[j] = t4[0]; bq[j + 1] = t4[1]; bq[j + 2] = t4[2]; bq[j + 3] = t4[3]; } }
    { unsigned w[8];
#pragma unroll
      for (int j = 0; j < 16; j += 2) w[j >> 1] = pkbf(qv[j] * fexp(bq[j] - refv[j]), qv[j + 1] * fexp(bq[j + 1] - refv[j + 1]));
      LAS u32x4* p = (LAS u32x4*)(QP + erow * 72 + dg); p[0] = (u32x4){w[0], w[1], w[2], w[3]}; p[1] = (u32x4){w[4], w[5], w[6], w[7]};
      LAS u32x4* z = (LAS u32x4*)(ATT + erow * 72 + dg); z[0] = (u32x4){0u, 0u, 0u, 0u}; z[1] = (u32x4){0u, 0u, 0u, 0u}; }
    const int j_lo = dir == 0 ? 0 : si, j_hi = dir == 0 ? si : 3;
    for (int jb = j_lo; jb <= j_hi; ++jb) {
        { const int sg = 16 * jb + erow; const int sn = dir == 0 ? sg - 1 : sg + 1; unsigned w[8];
#pragma unroll
          for (int j = 0; j < 16; j += 4) { const f32x4 bs4 = *(const LAS f32x4*)(bcd + sg * BCS + dg + j); f32x4 bn4 = (f32x4){0.f, 0.f, 0.f, 0.f}; if (sn >= 0 && sn < 64) bn4 = *(const LAS f32x4*)(bcd + sn * BCS + dg + j);
              float kk[4];
#pragma unroll
              for (int t = 0; t < 4; ++t) kk[t] = (1.f - fexp(bs4[t] - bn4[t])) * fexp(fminf(refv[j + t] - bs4[t], 60.f));
              w[j >> 1] = pkbf(kk[0], kk[1]); w[(j >> 1) + 1] = pkbf(kk[2], kk[3]); }
          LAS u32x4* p = (LAS u32x4*)(KP + erow * 72 + dg); p[0] = (u32x4){w[0], w[1], w[2], w[3]}; p[1] = (u32x4){w[4], w[5], w[6], w[7]}; }
        __builtin_amdgcn_wave_barrier(); asm volatile("s_waitcnt lgkmcnt(0)" ::: "memory");
        f32x4 c = (f32x4){0.f, 0.f, 0.f, 0.f};
#pragma unroll
        for (int ks = 0; ks < 2; ++ks) { const bf16x8 af = *(const LAS bf16x8*)(QP + fr * 72 + 32 * ks + 8 * fq), bfv = *(const LAS bf16x8*)(KP + fr * 72 + 32 * ks + 8 * fq); c = MFMA16(af, bfv, c); }
#pragma unroll
        for (int r = 0; r < 4; ++r) { const int tq = 4 * fq + r; float v = c[r];
            if (jb == si) { if (dir == 0 ? (fr > tq) : (fr < tq)) v = 0.f; }
            ATT[tq * 72 + 16 * jb + fr] = f2bf(v); }
        __builtin_amdgcn_wave_barrier(); asm volatile("s_waitcnt lgkmcnt(0)" ::: "memory");
    }
    { unsigned w[8];
#pragma unroll
      for (int j = 0; j < 16; j += 2) w[j >> 1] = pkbf(qv[j] * fexp(bq[j]), qv[j + 1] * fexp(bq[j + 1]));
      LAS u32x4* p = (LAS u32x4*)(QP + erow * 72 + dg); p[0] = (u32x4){w[0], w[1], w[2], w[3]}; p[1] = (u32x4){w[4], w[5], w[6], w[7]}; }
    __builtin_amdgcn_wave_barrier(); asm volatile("s_waitcnt lgkmcnt(0)" ::: "memory");
    f32x4 o[4];
#pragma unroll
    for (int n = 0; n < 4; ++n) o[n] = (f32x4){0.f, 0.f, 0.f, 0.f};
#pragma unroll
    for (int ks = 0; ks < 2; ++ks) { const bf16x8 aq = *(const LAS bf16x8*)(QP + fr * 72 + 32 * ks + 8 * fq), aa = *(const LAS bf16x8*)(ATT + fr * 72 + 32 * ks + 8 * fq);
#pragma unroll
        for (int n = 0; n < 4; ++n) { const bf16x8 bs = *(const LAS bf16x8*)(STL + (dir * 64 + 16 * n + fr) * 72 + 32 * ks + 8 * fq), bv = *(const LAS bf16x8*)(VT + (16 * n + fr) * 72 + 32 * ks + 8 * fq);
            o[n] = MFMA16(aq, bs, o[n]); o[n] = MFMA16(aa, bv, o[n]); } }
    if (dir == 0) {
#pragma unroll
        for (int n = 0; n < 4; ++n)
#pragma unroll
            for (int r = 0; r < 4; ++r) OSUM[(16 * si + 4 * fq + r) * 68 + 16 * n + fr] = o[n][r]; }
    __syncthreads();
    if (hasnext) { scan_stage_store(lds, tid, Rn); s3_state_store(STL, tid, ns0, ns1); }
    if (dir == 1) {
        const bool wr_out = !(a.skipctx_out && k >= 128) && !a.pad;
        float ss[4] = {0.f, 0.f, 0.f, 0.f};
#pragma unroll
        for (int n = 0; n < 4; ++n)
#pragma unroll
            for (int r = 0; r < 4; ++r) { o[n][r] += OSUM[(16 * si + 4 * fq + r) * 68 + 16 * n + fr]; ss[r] += o[n][r] * o[n][r]; }
#pragma unroll
        for (int r = 0; r < 4; ++r) { ss[r] += shxl(ss[r], 1, lane); ss[r] += shxl(ss[r], 2, lane); ss[r] += shxl(ss[r], 4, lane); ss[r] += shxl(ss[r], 8, lane); ss[r] = rsqrtf(ss[r] * (1.f / 64.f) + EPS); }
        if (wr_out) {
            const size_t orow0 = (size_t)b * RPB + 64 * k - a.out_off;
#pragma unroll
            for (int n = 0; n < 4; ++n)
#pragma unroll
                for (int r = 0; r < 4; ++r) { const int tq = 16 * si + 4 * fq + r, e = 16 * n + fr; const float gv = bf2f(gpre[n * 4 + r]);
                    a.OB[(orow0 + tq) * 512 + h * 64 + e] = f2bf(o[n][r] * ss[r] * a.gn[h * 64 + e] * gv * fsigmoid(gv)); }
        }
    }
    __syncthreads();
}
constexpr int SCAN_LDS = SC_A + 18432 + 2048 + 17408 + 8 * 6912;

#define XB_TMO      128
#define XB_XCNT(j)  (256  + 64 * (j))
#define XB_XSUB(j)  (1280 + 64 * (j))
#define XB_XGEN(j)  (2304 + 64 * (j))
#define XB_TOP      3328
#define XB_TOPGEN   3392
#define XCD_BAR_WORDS 3456
#define XB_SPIN_CAP (1u << 18)

__device__ __forceinline__ unsigned xb_ld(unsigned* p)              { return __hip_atomic_load(p, __ATOMIC_RELAXED, __HIP_MEMORY_SCOPE_AGENT); }
__device__ __forceinline__ unsigned xb_add(unsigned* p, unsigned v) { return __hip_atomic_fetch_add(p, v, __ATOMIC_RELAXED, __HIP_MEMORY_SCOPE_AGENT); }
__device__ __forceinline__ unsigned xb_xcc_id() { return (unsigned)__builtin_amdgcn_s_getreg((3 << 11) | 20) & 0xFu; }
#define XB_SPIN(cond, bar) do { unsigned _sp = 0; while (cond) { __builtin_amdgcn_s_sleep(1); \
    if ((++_sp & 255u) == 0u) { if (xb_ld(&(bar)[XB_TMO])) break; if (_sp > XB_SPIN_CAP) { atomicAdd(&(bar)[XB_TMO], 1u); break; } } } } while (0)

struct XcdBarrier {
    unsigned* bar; unsigned x;
    volatile LAS unsigned* st;
};

__device__ __forceinline__ XcdBarrier xcd_barrier_post(unsigned* bar, volatile LAS unsigned* st) {
    XcdBarrier b; b.bar = bar; b.x = xb_xcc_id(); b.st = st;
    if (threadIdx.x == 0) (void)xb_add(&bar[XB_XCNT(b.x)], 1u);
    return b;
}
__device__ __forceinline__ void xcd_barrier_complete(unsigned* bar, unsigned x, unsigned& nloc, unsigned& nx) {
    const unsigned G = gridDim.x * gridDim.y * gridDim.z;
    unsigned sum, cnt, mine, sp = 0u;
    for (;;) {
        sum = 0u; cnt = 0u; mine = 0u;
#pragma unroll
        for (unsigned j = 0; j < 16; ++j) { const unsigned c = xb_ld(&bar[XB_XCNT(j)]); sum += c; cnt += (c > 0u) ? 1u : 0u; mine = (j == x) ? c : mine; }
        if (sum == G) break;
        __builtin_amdgcn_s_sleep(1);
        if ((++sp & 255u) == 0u) { if (xb_ld(&bar[XB_TMO])) break; if (sp > XB_SPIN_CAP) { atomicAdd(&bar[XB_TMO], 1u); break; } }
    }
    nloc = mine > 0u ? mine : 1u; nx = cnt > 0u ? cnt : 1u;
}

__device__ __forceinline__ void xcd_barrier(const XcdBarrier& b) {
    asm volatile("s_waitcnt vmcnt(0)" ::: "memory");
    __syncthreads();
    if (threadIdx.x == 0) {
        unsigned* bar = b.bar;
        __builtin_amdgcn_s_waitcnt(0);
        unsigned nloc = b.st[0], nx = b.st[1];
        if (nloc == 0u) { xcd_barrier_complete(bar, b.x, nloc, nx); b.st[0] = nloc; b.st[1] = nx; }
        const unsigned old = xb_add(&bar[XB_XSUB(b.x)], 1u);
        const unsigned gen = old / nloc;
        if (old + 1u == (gen + 1u) * nloc) {
            __builtin_amdgcn_fence(__ATOMIC_RELEASE, "agent");
            asm volatile("s_waitcnt vmcnt(0)" ::: "memory");
            const unsigned og = xb_add(&bar[XB_TOP], 1u);
            const unsigned tg = og / nx;
            if (og + 1u == (tg + 1u) * nx) xb_add(&bar[XB_TOPGEN], 1u);
            else XB_SPIN(xb_ld(&bar[XB_TOPGEN]) == tg, bar);
            __builtin_amdgcn_fence(__ATOMIC_ACQUIRE, "agent");
            xb_add(&bar[XB_XGEN(b.x)], 1u);
            asm volatile("s_waitcnt vmcnt(0)" ::: "memory");
        } else {
            XB_SPIN(xb_ld(&bar[XB_XGEN(b.x)]) == gen, bar);
            __builtin_amdgcn_fence(__ATOMIC_ACQUIRE, "agent");
            asm volatile("s_waitcnt vmcnt(0)" ::: "memory");
        }
    }
    __syncthreads();
}


constexpr size_t MiB = 1u << 20;
constexpr size_t CTL_ZERO_BYTES = 64 * 1024;
constexpr int CW_COUNTS = 8192, CW_CURSOR = 8192 + 128;
constexpr size_t O_MOD = 1 * MiB, O_LB = 1 * MiB + 512 * 1024, O_ROPA_C = 2 * MiB, O_ROPA_S = 3 * MiB, O_ROPC_C = 4 * MiB, O_ROPC_S = 4 * MiB + 512 * 1024, O_XC = 5 * MiB;
constexpr size_t O_ROUTE_E = 9 * MiB, O_ROUTE_W = 9 * MiB + 512 * 1024, O_PERM = 10 * MiB, O_POSW = 10 * MiB + 512 * 1024, O_GOFF = 11 * MiB, O_TILEE = 11 * MiB + 512 * 1024;
constexpr size_t O_WRT = 11 * MiB + 640 * 1024;
constexpr size_t O_RS = 12 * MiB, O_DS = 13 * MiB + 512 * 1024, O_WGH = 15 * MiB + 768 * 1024;
constexpr size_t O_WINP = 16 * MiB, O_WC = 30 * MiB, O_WBR = 32 * MiB, O_WOUT = 35 * MiB;
constexpr size_t O_H = 38 * MiB;
constexpr size_t O_AQ = 104 * MiB, O_AK = 137 * MiB, O_AV = 145 * MiB + 512 * 1024;
constexpr size_t O_BQ = 154 * MiB, O_BV = 187 * MiB, O_BG = 220 * MiB, O_BLF = 253 * MiB, O_BLB = 286 * MiB;
constexpr size_t O_CQKV = 319 * MiB, O_CKR = 344 * MiB, O_CQ = 347 * MiB, O_CKV = 397 * MiB, O_OC = 463 * MiB, O_WRB = 496 * MiB, WS_END = 497 * MiB;
constexpr size_t O_GATE = 187 * MiB;
constexpr size_t O_YM2 = 154 * MiB, O_AUP = 104 * MiB, O_WUP = 397 * MiB, O_WDN = 429 * MiB;
constexpr int LDS_BYTES = 163840, LDS_BAR_OFF = LDS_BYTES - 64, LDS_PTR_OFF = LDS_BYTES - 512;

struct KP { const float* in[24]; float* out; char* ws; int ph_lo, ph_hi; unsigned long long mask; };
struct Frame {
    LAS char* lds; char* ws; float* out; int wv0;
};
#define WSP(T, off) ((T*)(F.ws + (off)))
__device__ __forceinline__ const float* in_ptr(const Frame& F, int k) { const volatile LAS unsigned* q = (const volatile LAS unsigned*)(F.lds + LDS_PTR_OFF + 8 * k);
    unsigned lo = q[0], hi = q[1]; lo = __builtin_amdgcn_readfirstlane(lo); hi = __builtin_amdgcn_readfirstlane(hi); return (const float*)(((unsigned long long)hi << 32) | lo); }
#define INP(k) in_ptr(F, k)
__device__ __forceinline__ float wave_sum_dpp(float v) {
    int x = __builtin_bit_cast(int, v);
#define DPP_ADD(ctrl, rmask) x = __builtin_bit_cast(int, __builtin_bit_cast(float, x) + __builtin_bit_cast(float, __builtin_amdgcn_update_dpp(0, x, ctrl, rmask, 0xF, false)))
    DPP_ADD(0xB1, 0xF);
    DPP_ADD(0x4E, 0xF);
    DPP_ADD(0x141, 0xF);
    DPP_ADD(0x140, 0xF);
    DPP_ADD(0x142, 0xA);
    DPP_ADD(0x143, 0xC);
#undef DPP_ADD
    return __builtin_bit_cast(float, __builtin_amdgcn_readlane(x, 63));
}
__device__ __forceinline__ float wave_sum(float v) {
#pragma unroll
    for (int o = 32; o >= 1; o >>= 1) v += __shfl_xor(v, o);
    return v;
}

__device__ __forceinline__ void p0_mod(const Frame& F) {
    const int tid = opaque_tid(F.wv0), lane = tid & 63, wave = __builtin_amdgcn_readfirstlane(tid >> 6); (void)lane; (void)wave;
    LAS float* sc = (LAS float*)F.lds;
    LAS float* red = (LAS float*)(F.lds + 20480);
    for (int i = tid; i < 5 * 1024; i += 512) { const int r = i >> 10, k = i & 1023; const float v = r < 4 ? INP(1)[r * 1024 + k] : INP(3)[k]; sc[i] = v / (1.f + expf(-v)); }
    __syncthreads();
    float* MOD = WSP(float, O_MOD);
    for (int u = blockIdx.x; u < 2 * 96; u += gridDim.x) { const int l = u / 96, j = (u % 96) * 64 + lane;
        const float* w = INP(4) + (size_t)l * 1024 * 6144 + j; float a0 = 0.f, a1 = 0.f, a2 = 0.f, a3 = 0.f, a4 = 0.f;
#pragma unroll 8
        for (int kk = 0; kk < 128; ++kk) { const int k = wave * 128 + kk; const float wv = w[(size_t)k * 6144]; a0 += sc[k] * wv; a1 += sc[1024 + k] * wv; a2 += sc[2048 + k] * wv; a3 += sc[3072 + k] * wv; a4 += sc[4096 + k] * wv; }
        red[(wave * 5 + 0) * 64 + lane] = a0; red[(wave * 5 + 1) * 64 + lane] = a1; red[(wave * 5 + 2) * 64 + lane] = a2; red[(wave * 5 + 3) * 64 + lane] = a3; red[(wave * 5 + 4) * 64 + lane] = a4;
        __syncthreads();
        if (tid < 320) { const int r = tid >> 6, ln = tid & 63; float s = 0.f;
#pragma unroll
            for (int w8 = 0; w8 < 8; ++w8) s += red[(w8 * 5 + r) * 64 + ln];
            const int jj = (u % 96) * 64 + ln; MOD[(size_t)(l * 5 + r) * 6144 + jj] = s + INP(5)[l * 6144 + jj]; }
        __syncthreads();
    }
}
__device__ __forceinline__ void p0_tables(const Frame& F) {
    const int tid = opaque_tid(F.wv0), lane = tid & 63, wave = __builtin_amdgcn_readfirstlane(tid >> 6); (void)lane; (void)wave;
    float* ropa_c = WSP(float, O_ROPA_C); float* ropa_s = WSP(float, O_ROPA_S); float* ropc_c = WSP(float, O_ROPC_C); float* ropc_s = WSP(float, O_ROPC_S); float* LB = WSP(float, O_LB);
    for (int i = blockIdx.x * 512 + tid; i < 8192 * 32; i += gridDim.x * 512) {
        { const int t = i >> 5, j = i & 31, row = t >> 6, col = t & 63, f = j & 15; const float inv = powf(10000.f, -(float)f / 16.f); const float ang = (j < 16 ? (float)row : (float)col) * inv;
          ropa_c[i] = (float)cos((double)ang); ropa_s[i] = (float)sin((double)ang); }
        if (i < 8192 * 16) { const int t = i >> 4, j = i & 15, row = t >> 6, col = t & 63, f = j & 7; const float inv = powf(10000.f, -(float)f / 8.f); const float ang = (j < 8 ? (float)row : (float)col) * inv;
          ropc_c[i] = (float)cos((double)ang); ropc_s[i] = (float)sin((double)ang); }
        for (int i2 = i; i2 < 2 * 256 * 1024; i2 += 8192 * 32) { const int l = i2 >> 18, pp = (i2 >> 10) & 255, k = i2 & 1023;
          const int bj = pp >> 7, wc = (pp >> 5) & 3, n = (pp >> 4) & 1, fq = (pp >> 2) & 3, e = pp & 3; float v = 0.f;
          if (wc == 0) { if (bj == 0) v = INP(19)[(size_t)l * 1024 * 32 + k * 32 + fq * 8 + 4 * n + e]; else if (n == 0 && e == 0) v = INP(18)[(size_t)l * 1024 * 4 + k * 4 + fq]; }
          WSP(bf16_t, O_WRB)[i2] = f2bf(v); }
        if (i < 2048) { const int l = i >> 10, rest = i & 1023; if (l == 0) LB[i] = 0.f; else { const float a0 = INP(10)[rest], a1 = INP(10)[1024 + rest]; LB[i] = 1.f / (1.f + expf(a0 - a1)); } }
    }
}
template <class CM> __device__ __forceinline__ void wt_tile(const float* W, int ldw, const CM& cm, bf16_t* Bt, int K, int p0, int k0, LAS float* scr, int lane) {
    const int p4 = (lane & 7) * 4; const int c = cm(p0 + p4);
#pragma unroll
    for (int i = 0; i < 8; ++i) { const int kk = i * 8 + (lane >> 3); f32x4 v = (f32x4){0.f, 0.f, 0.f, 0.f};
        if (c >= 0) v = *(const f32x4*)(W + (size_t)(k0 + kk) * ldw + c);
        scr[kk * 33 + p4] = v[0]; scr[kk * 33 + p4 + 1] = v[1]; scr[kk * 33 + p4 + 2] = v[2]; scr[kk * 33 + p4 + 3] = v[3]; }
    asm volatile("s_waitcnt lgkmcnt(0)" ::: "memory"); __builtin_amdgcn_wave_barrier();
#pragma unroll 8
    for (int pi = 0; pi < 32; ++pi) Bt[(size_t)(p0 + pi) * K + k0 + lane] = f2bf(scr[lane * 33 + pi]);
    asm volatile("s_waitcnt lgkmcnt(0)" ::: "memory"); __builtin_amdgcn_wave_barrier();
}
struct WtDesc { const float* src; size_t ldw8; bf16_t* dst; int K; };
template <class CM> __device__ __forceinline__ WtDesc wt_desc(const float* W, int ldw, const CM& cm, bf16_t* Bt, int K, int p0, int k0, int lane) {
    const int p4 = (lane & 7) * 4; const int c = cm(p0 + p4); WtDesc d; d.src = c >= 0 ? W + (size_t)(k0 + (lane >> 3)) * ldw + c : nullptr; d.ldw8 = (size_t)ldw * 8; d.dst = Bt + (size_t)p0 * K + k0; d.K = K; return d; }
__device__ __forceinline__ void wt_load(const WtDesc& d, f32x4 (&v)[8]) {
#pragma unroll
    for (int i = 0; i < 8; ++i) { v[i] = (f32x4){0.f, 0.f, 0.f, 0.f}; if (d.src) v[i] = *(const f32x4*)(d.src + (size_t)i * d.ldw8); } }
__device__ __forceinline__ void wt_store(const WtDesc& d, const f32x4 (&v)[8], LAS float* scr, int lane) {
    const int p4 = (lane & 7) * 4;
#pragma unroll
    for (int i = 0; i < 8; ++i) { const int kk = i * 8 + (lane >> 3); scr[kk * 33 + p4] = v[i][0]; scr[kk * 33 + p4 + 1] = v[i][1]; scr[kk * 33 + p4 + 2] = v[i][2]; scr[kk * 33 + p4 + 3] = v[i][3]; }
    asm volatile("s_waitcnt lgkmcnt(0)" ::: "memory"); __builtin_amdgcn_wave_barrier();
    const int p = lane >> 1, kh = (lane & 1) * 32; bf16_t* o = d.dst + (size_t)p * d.K + kh;
#pragma unroll
    for (int s4 = 0; s4 < 4; ++s4) { const LAS float* r = scr + (kh + s4 * 8) * 33 + p;
        u32x4 w; w.x = pkbf(r[0], r[33]); w.y = pkbf(r[66], r[99]); w.z = pkbf(r[132], r[165]); w.w = pkbf(r[198], r[231]); *(u32x4*)(o + s4 * 8) = w; }
    asm volatile("s_waitcnt lgkmcnt(0)" ::: "memory"); __builtin_amdgcn_wave_barrier();
}
template <class Dec> __device__ __forceinline__ void wt_run(const Dec& dec, int first, int total, int stride, LAS float* scr, int lane) {
    if (first >= total) return;
    WtDesc cur = dec(first); f32x4 va[8]; wt_load(cur, va);
    for (int it = first; it < total; it += stride) { const int nx = it + stride; const bool hn = nx < total; WtDesc nxt = cur; f32x4 vb[8];
        if (hn) { nxt = dec(nx); wt_load(nxt, vb); }
        wt_store(cur, va, scr, lane);
        if (hn) { cur = nxt;
#pragma unroll
            for (int i = 0; i < 8; ++i) va[i] = vb[i]; } }
}
struct CmWin { __device__ __forceinline__ int operator()(int p) const { return colmap(MAP_WIN, p); } };
struct CmId { __device__ __forceinline__ int operator()(int p) const { return p; } };
__device__ __forceinline__ void conv_weights_nonmoe(const Frame& F, int l) {
    const int tid = opaque_tid(F.wv0), lane = tid & 63, wave = __builtin_amdgcn_readfirstlane(tid >> 6); (void)lane; (void)wave;
    LAS float* scr = (LAS float*)F.lds + wave * (64 * 33);
    const int gw = blockIdx.x * 8 + wave, NGW = gridDim.x * 8;
    constexpr int I_WIN = 216 * 16, I_BR = 3 * 32 * 8, I_OUT = 32 * 16;
    { const float* w_in = INP(8) + (size_t)l * 1024 * INW; const float* w_br = INP(16) + (size_t)l * 3 * 512 * 1024; const float* w_out = INP(17) + (size_t)l * 1024 * 1024; const Frame* Fp = &F;
      auto dec = [=](int it) -> WtDesc { const Frame& F = *Fp; int r = it;
          if (r < I_WIN) return wt_desc(w_in, INW, CmWin(), WSP(bf16_t, O_WINP), 1024, (r / 16) * 32, (r % 16) * 64, lane); r -= I_WIN;
          if (r < I_BR) { const int n = r / 256, q = r % 256; return wt_desc(w_br + (size_t)n * 512 * 1024, 1024, CmId(), WSP(bf16_t, O_WBR) + (size_t)n * 1024 * 512, 512, (q / 8) * 32, (q % 8) * 64, lane); } r -= I_BR;
          return wt_desc(w_out, 1024, CmId(), WSP(bf16_t, O_WOUT), 1024, (r / 16) * 32, (r % 16) * 64, lane); };
      wt_run(dec, gw, I_WIN + I_BR + I_OUT, NGW, scr, lane); }
    const float* wuq = INP(14) + (size_t)l * 256 * 768; const float* wukv = INP(15) + (size_t)l * 128 * 1024; const float* gq = INP(12) + l * 256; const float* gkv = INP(13) + l * 128; bf16_t* WC = WSP(bf16_t, O_WC);
    for (int i = blockIdx.x * 512 + tid; i < 1792 * 384; i += gridDim.x * 512) {
        const int pp = i / 384, k = i % 384; float v = 0.f;
        if (pp < 768) { const int pn = pp >> 8, q = pp & 255, bj = q >> 7, wc = (q >> 5) & 3, j = q & 31; const int gi = pn * 8 + bj * 4 + wc, head = gi / 3, part = gi - head * 3;
            const int p = part < 2 ? head * 96 + part * 32 + j : head * 96 + 64 + 16 * ((j >> 2) & 1) + 4 * (j >> 3) + (j & 3);
            if (k < 256) v = wuq[k * 768 + p] * gq[k]; }
        else { if (k >= 256) v = wukv[(k - 256) * 1024 + (pp - 768)] * gkv[k - 256]; }
        WC[i] = f2bf(v); }
}
struct CmUp { __device__ __forceinline__ int operator()(int p) const { return ((p >> 8) << 7) + (p & 127); } };
__device__ __forceinline__ void conv_weights_moe(const Frame& F, int l) {
    const int tid = opaque_tid(F.wv0), lane = tid & 63, wave = __builtin_amdgcn_readfirstlane(tid >> 6); (void)lane; (void)wave;
    LAS float* scr = (LAS float*)F.lds + wave * (64 * 33);
    const int gw = blockIdx.x * 8 + wave, NGW = gridDim.x * 8;
    constexpr int I_UP = 32 * 16 * 16, I_DN = 32 * 32 * 4;
    { const float* w1 = INP(20) + (size_t)l * 32 * 1024 * 256; const float* w3 = INP(21) + (size_t)l * 32 * 1024 * 256; const float* w2 = INP(22) + (size_t)l * 32 * 256 * 1024; const Frame* Fp = &F;
      auto dec = [=](int it) -> WtDesc { const Frame& F = *Fp; int r = it;
          if (r < I_UP) { const int e = r / 256, q = r % 256, p0 = (q / 16) * 32, k0 = (q % 16) * 64; const bool isw3 = (p0 >> 7) & 1;
              return wt_desc((isw3 ? w3 : w1) + (size_t)e * 1024 * 256, 256, CmUp(), WSP(bf16_t, O_WUP) + (size_t)e * 512 * 1024, 1024, p0, k0, lane); } r -= I_UP;
          const int e = r / 128, q = r % 128; return wt_desc(w2 + (size_t)e * 256 * 1024, 1024, CmId(), WSP(bf16_t, O_WDN) + (size_t)e * 1024 * 256, 256, (q / 4) * 32, (q % 4) * 64, lane); };
      wt_run(dec, gw, I_UP + I_DN, NGW, scr, lane); }
}

__device__ __forceinline__ void rp_load(const float* xs, float* xd, bool wx, const bf16_t* ym, const float* gt, int lane, f32x4 (&v)[4], float& rinv) {
    float ss = 0.f;
#pragma unroll
    for (int j = 0; j < 4; ++j) { const int c = 4 * lane + 256 * j; v[j] = *(const f32x4*)(xs + c);
        if (ym) { const uint2 y0 = *(const uint2*)(ym + c), y1 = *(const uint2*)(ym + 1024 + c); const f32x4 g4 = *(const f32x4*)(gt + c);
            v[j][0] += g4[0] * (bflo(y0.x) + bflo(y1.x)); v[j][1] += g4[1] * (bfhi(y0.x) + bfhi(y1.x)); v[j][2] += g4[2] * (bflo(y0.y) + bflo(y1.y)); v[j][3] += g4[3] * (bfhi(y0.y) + bfhi(y1.y)); }
        if (wx) *(f32x4*)(xd + c) = v[j];
        ss += v[j][0] * v[j][0] + v[j][1] * v[j][1] + v[j][2] * v[j][2] + v[j][3] * v[j][3]; }
    rinv = rsqrtf(wave_sum_dpp(ss) * (1.f / D) + EPS);
}
__device__ __forceinline__ void rp_mod(const f32x4 (&v)[4], float rinv, const float* gn, const float* mo, int sh_off, int sc_off, bf16_t* hp, int lane, f32x4 (&hv)[4]) {
#pragma unroll
    for (int j = 0; j < 4; ++j) { const int c = 4 * lane + 256 * j; const f32x4 g4 = *(const f32x4*)(gn + c), s4 = *(const f32x4*)(mo + sc_off + c), h4 = *(const f32x4*)(mo + sh_off + c);
        hv[j] = v[j] * rinv * g4 * (s4 + 1.f) + h4;
        *(uint2*)(hp + c) = make_uint2(pkbf(hv[j][0], hv[j][1]), pkbf(hv[j][2], hv[j][3])); }
}
__device__ __forceinline__ void phase_rowpass1(const Frame& F, int l, bool combine, size_t h_off) {
    const int tid = opaque_tid(F.wv0), lane = tid & 63, wave = __builtin_amdgcn_readfirstlane(tid >> 6); (void)lane; (void)wave;
    const int gw = blockIdx.x * 8 + wave, NGW = gridDim.x * 8;
    const float* xl = (l == 0) ? INP(0) : F.out; const float* xc = (l == 0) ? INP(2) : WSP(float, O_XC);
    const float* MODl = WSP(float, O_MOD) + (size_t)l * 5 * 6144; const float* MODp = WSP(float, O_MOD);
    for (int g = gw; g < G; g += NGW) { const RowInfo ri = rowinfo(g); const int mrow = ri.lat ? ri.b : 4; const size_t xo = xoff(ri);
        const float* xs = (ri.lat ? xl : xc) + xo; float* xd = (ri.lat ? F.out : WSP(float, O_XC)) + xo;
        f32x4 v[4], hv[4]; float rinv;
        rp_load(xs, xd, combine, combine ? WSP(bf16_t, O_YM2) + (size_t)g * 2048 : nullptr, MODp + (size_t)mrow * 6144 + 5120, lane, v, rinv);
        rp_mod(v, rinv, INP(6) + l * 1024, MODl + (size_t)mrow * 6144, 0, 1024, WSP(bf16_t, h_off) + (size_t)g * D, lane, hv); }
}
__device__ __forceinline__ void phase_rowpass2(const Frame& F, int l, bool last) {
    const int tid = opaque_tid(F.wv0), lane = tid & 63, wave = __builtin_amdgcn_readfirstlane(tid >> 6);
    { int* perm = WSP(int, O_PERM); unsigned* goff = WSP(unsigned, O_GOFF);
      for (int i = blockIdx.x * 512 + tid; i < PMAX; i += gridDim.x * 512) { perm[i] = -1; goff[i] = 0u; } }
    const int gw = blockIdx.x * 8 + wave, NGW = gridDim.x * 8;
    const float* MODl = WSP(float, O_MOD) + (size_t)l * 5 * 6144;
    for (int g = gw; g < G; g += NGW) { const RowInfo ri = rowinfo(g); if (last && !ri.lat) continue;
        const int mrow = ri.lat ? ri.b : 4; const size_t xo = xoff(ri);
        const float* xs = (ri.lat ? F.out : WSP(float, O_XC)) + xo;
        f32x4 v[4], hv[4]; float rinv;
        rp_load(xs, nullptr, false, nullptr, nullptr, lane, v, rinv);
        rp_mod(v, rinv, INP(7) + l * 1024, MODl + (size_t)mrow * 6144, 3072, 4096, WSP(bf16_t, O_H) + (size_t)g * D, lane, hv); }
}
struct EpiRoute {
    static constexpr bool PERM = false;
    int* route_e; float* route_w; LAS int* hist;
    __device__ __forceinline__ void operator()(const f32x4 (&acc)[2][2][4][2], const gp::GUnit& u, int wr, int wc, int fr, int fq) const {
        if (wc != 0) return;
#pragma unroll
        for (int ai = 0; ai < 2; ++ai)
#pragma unroll
            for (int m = 0; m < 4; ++m) { const int row = u.pm * 256 + ai * 128 + wr * 64 + m * 16 + fr;
                float el[8];
#pragma unroll
                for (int e = 0; e < 4; ++e) { el[e] = acc[ai][0][m][0][e]; el[4 + e] = acc[ai][0][m][1][e]; }
                const float gl = acc[ai][1][m][0][0];
                int i0 = 0; float m0 = el[0];
#pragma unroll
                for (int j = 1; j < 8; ++j) if (el[j] > m0) { m0 = el[j]; i0 = j; }
                int i1 = -1; float m1 = -3.4e38f;
#pragma unroll
                for (int j = 0; j < 8; ++j) if (j != i0 && el[j] > m1) { m1 = el[j]; i1 = j; }
                float gmax = gl; int gidx = fq;
#pragma unroll
                for (int off = 16; off <= 32; off <<= 1) { const float og = shxl(gmax, off, fr | (fq << 4)); const int oi = shxli(gidx, off, fr | (fq << 4)); if (og > gmax || (og == gmax && oi < gidx)) { gmax = og; gidx = oi; } }
                float gs = expf(gl - gmax); gs += shxl(gs, 16, fr | (fq << 4)); gs += shxl(gs, 32, fr | (fq << 4));
                if (fq == gidx) { const float gwt = 1.f / gs, p1 = expf(m1 - m0); const int e0 = fq * 8 + i0, e1 = fq * 8 + i1;
                    route_e[row * 2] = e0; route_e[row * 2 + 1] = e1; route_w[row * 2] = gwt / (1.f + p1); route_w[row * 2 + 1] = gwt * p1 / (1.f + p1);
                    __hip_atomic_fetch_add(hist + e0, 1, __ATOMIC_RELAXED, __HIP_MEMORY_SCOPE_WORKGROUP); __hip_atomic_fetch_add(hist + e1, 1, __ATOMIC_RELAXED, __HIP_MEMORY_SCOPE_WORKGROUP); } }
    }
};
__device__ __forceinline__ void phase_final(const Frame& F) {
    const int tid = opaque_tid(F.wv0), lane = tid & 63, wave = __builtin_amdgcn_readfirstlane(tid >> 6); (void)lane; (void)wave;
    const int gw = blockIdx.x * 8 + wave, NGW = gridDim.x * 8; const float* MOD1 = WSP(float, O_MOD) + (size_t)5 * 6144;
    for (int lr = gw; lr < NB * SEQ; lr += NGW) { const int b = lr / SEQ, t = lr - b * SEQ; const int g = b * RPB + t; float* xp = F.out + (size_t)lr * D;
        f32x4 v[4]; float rinv; rp_load(xp, nullptr, false, WSP(bf16_t, O_YM2) + (size_t)g * 2048, MOD1 + (size_t)b * 6144 + 5120, lane, v, rinv);
#pragma unroll
        for (int j = 0; j < 4; ++j) { const int c = 4 * lane + 256 * j; const f32x4 g4 = *(const f32x4*)(INP(23) + c); *(f32x4*)(xp + c) = v[j] * rinv * g4; } }
}
__device__ __forceinline__ void phase_moe_scatter(const Frame& F, int l, bool last) {
    const int tid = opaque_tid(F.wv0), lane = tid & 63, wave = __builtin_amdgcn_readfirstlane(tid >> 6);
    LAS int* tot = (LAS int*)F.lds; LAS int* bef = tot + 512; LAS int* base = tot + 1024; LAS int* lcur = tot + 1056;
    const int* WGH = WSP(int, O_WGH) + (size_t)l * 256 * 32; const int nwg = gridDim.x, me = blockIdx.x;
    { const int e = tid & 31, part = tid >> 5; int sa = 0, sb = 0;
      for (int w = part * 16; w < part * 16 + 16 && w < nwg; ++w) { const int c = WGH[w * 32 + e]; sa += c; if (w < me) sb += c; }
      tot[part * 32 + e] = sa; bef[part * 32 + e] = sb; }
    __syncthreads();
    int sa2 = 0, sb2 = 0;
    if (tid < 32) {
#pragma unroll
        for (int part = 0; part < 16; ++part) { sa2 += tot[part * 32 + tid]; sb2 += bef[part * 32 + tid]; } }
    __syncthreads();
    if (tid < 32) { tot[tid] = sa2; bef[tid] = sb2; lcur[tid] = 0; }
    __syncthreads();
    if (tid == 0) { int o = 0; int* tile_e = WSP(int, O_TILEE);
#pragma clang loop unroll(disable) vectorize(disable)
        for (int e = 0; e < 32; ++e) { base[e] = o + bef[e]; const int n = (tot[e] + 255) & ~255;
            if (me == 0) {
#pragma clang loop unroll(disable) vectorize(disable)
                for (int t = o >> 8; t < (o + n) >> 8; ++t) tile_e[t] = e; }
            o += n; }
        if (me == 0) tile_e[NTILE] = o >> 8; }
    __syncthreads();
    const int* route_e = WSP(int, O_ROUTE_E); const float* route_w = WSP(float, O_ROUTE_W); int* perm = WSP(int, O_PERM); float* posw = WSP(float, O_POSW); unsigned* goff = WSP(unsigned, O_GOFF);
    { int pmv, pn;
      if (gp::tile_order(0, (int)gridDim.x, (int)blockIdx.x, last ? 128 : 132, 1, pmv, pn)) { const int pm = last ? pmv + pmv / 32 : pmv; const int g = pm * 256 + (tid >> 1); const int i = g * 2 + (tid & 1);
          const int e = route_e[i]; const int pos = base[e] + __hip_atomic_fetch_add(lcur + e, 1, __ATOMIC_RELAXED, __HIP_MEMORY_SCOPE_WORKGROUP);
          perm[pos] = i; posw[pos] = route_w[i]; goff[pos] = (unsigned)g * 2048u; } }
    (void)lane; (void)wave;
}

#ifndef PROBE_DUP
#define PROBE_DUP 0
#endif
#ifndef PROBE_EXTRA_MASK
#define PROBE_EXTRA_MASK 0ull
#endif
#define DUP(bit) for (int rep_ = 0; rep_ < (((PROBE_DUP) >> (bit)) & 1) + 1; ++rep_)
__global__ void __launch_bounds__(512, 2) hybrid_trunk_fwd(KP p) {
    extern __shared__ __attribute__((aligned(16))) unsigned char dynlds[];
    Frame F; F.lds = (LAS char*)dynlds; F.ws = p.ws; F.out = p.out; F.wv0 = __builtin_amdgcn_readfirstlane((int)(threadIdx.x >> 6));
    if (threadIdx.x == 0) { LAS unsigned long long* pp = (LAS unsigned long long*)(F.lds + LDS_PTR_OFF);
        pp[0] = (unsigned long long)p.in[0];
        pp[1] = (unsigned long long)p.in[1];
        pp[2] = (unsigned long long)p.in[2];
        pp[3] = (unsigned long long)p.in[3];
        pp[4] = (unsigned long long)p.in[4];
        pp[5] = (unsigned long long)p.in[5];
        pp[6] = (unsigned long long)p.in[6];
        pp[7] = (unsigned long long)p.in[7];
        pp[8] = (unsigned long long)p.in[8];
        pp[9] = (unsigned long long)p.in[9];
        pp[10] = (unsigned long long)p.in[10];
        pp[11] = (unsigned long long)p.in[11];
        pp[12] = (unsigned long long)p.in[12];
        pp[13] = (unsigned long long)p.in[13];
        pp[14] = (unsigned long long)p.in[14];
        pp[15] = (unsigned long long)p.in[15];
        pp[16] = (unsigned long long)p.in[16];
        pp[17] = (unsigned long long)p.in[17];
        pp[18] = (unsigned long long)p.in[18];
        pp[19] = (unsigned long long)p.in[19];
        pp[20] = (unsigned long long)p.in[20];
        pp[21] = (unsigned long long)p.in[21];
        pp[22] = (unsigned long long)p.in[22];
        pp[23] = (unsigned long long)p.in[23];
    }
    LAS unsigned char* glds = (LAS unsigned char*)dynlds;
    volatile LAS unsigned* barst = (volatile LAS unsigned*)(F.lds + LDS_BAR_OFF);
    if (threadIdx.x < 16) ((LAS unsigned*)(F.lds + LDS_BAR_OFF))[threadIdx.x] = 0u;
    __syncthreads();
    const bool multi = (p.ph_hi - p.ph_lo) > 1;
    XcdBarrier bar; bar.bar = (unsigned*)F.ws; bar.x = 0; bar.st = nullptr;
    if (multi) bar = xcd_barrier_post((unsigned*)F.ws, barst);
    int ph = 0;
#define PH_BEGIN if (ph >= p.ph_lo && ph < p.ph_hi && (p.mask == 0ull || ((p.mask >> ph) & 1ull))) {
#define PH_END   if (ph + 1 < p.ph_hi) xcd_barrier(bar); else __syncthreads(); } ++ph;
    const int Gd = gridDim.x, cb = blockIdx.x;

    PH_BEGIN p0_mod(F); p0_tables(F); __syncthreads(); conv_weights_nonmoe(F, 0); PH_END

    for (int l = 0; l < 2; ++l) {
        const bool last = (l == 1);
        const float* MODl = WSP(float, O_MOD) + (size_t)l * 5 * 6144;
        PH_BEGIN phase_rowpass1(F, l, l > 0, O_H); PH_END
        PH_BEGIN
        { SchedStd S{}; S.A = WSP(bf16_t, O_H); S.Bt = WSP(bf16_t, O_WINP); S.K = 1024; S.nM = 132; S.nN = 15; S.G_ = Gd; S.c = cb; S.skipctx = 0; S.lda2 = 2048; S.ldb2 = 2048;
          EpiG1 E{}; E.AQ = WSP(bf16_t, O_AQ); E.AK = WSP(bf16_t, O_AK); E.AV = WSP(bf16_t, O_AV); E.BQ = WSP(bf16_t, O_BQ); E.BV = WSP(bf16_t, O_BV); E.BG = WSP(bf16_t, O_BG); E.BLF = WSP(f16_t, O_BLF); E.BLB = WSP(f16_t, O_BLB);
          E.CQKV = WSP(bf16_t, O_CQKV); E.CKR = WSP(bf16_t, O_CKR); E.RS = WSP(float, O_RS); E.ropa_c = WSP(float, O_ROPA_C); E.ropa_s = WSP(float, O_ROPA_S); E.ropc_c = WSP(float, O_ROPC_C); E.ropc_s = WSP(float, O_ROPC_S);
          E.LBl = WSP(float, O_LB) + l * 1024; E.rowoff = 0;
          DUP(0) gp::gemm_phase<EpiG1, SchedStd>(glds, S, E, F.wv0); }
        PH_END
        PH_BEGIN
        { SchedStd S{}; S.A = WSP(bf16_t, O_CQKV); S.Bt = WSP(bf16_t, O_WC); S.K = 384; S.nM = 132; S.nN = 7; S.G_ = Gd; S.c = cb; S.skipctx = 0; S.lda2 = 768; S.ldb2 = 768;
          EpiC E{}; E.CQ = WSP(bf16_t, O_CQ); E.CKV = WSP(bf16_t, O_CKV); E.RS = WSP(float, O_RS); E.ropc_c = WSP(float, O_ROPC_C); E.ropc_s = WSP(float, O_ROPC_S); E.pmoff = 0;
          DUP(1) gp::gemm_phase<EpiC, SchedStd>(glds, S, E, F.wv0); }
        __syncthreads();
        { AttnArgs a{}; a.Q = WSP(bf16_t, O_AQ); a.qld = 512; a.qhs = 64; a.K1 = WSP(bf16_t, O_AK); a.k1ld = 128; a.k1hs = 64; a.kvgroup = 4; a.K2 = nullptr; a.k2ld = 0; a.V = WSP(bf16_t, O_AV); a.vld = 128; a.vhs = 64;
          a.O = WSP(bf16_t, O_AQ); a.old = 512; a.ohs = 64; a.scale_l2 = 0.125f * LOG2E; a.sink = INP(9) + l * 8; a.window = 128;
          const int nqb = last ? 32 : 33;
          DUP(10) for (int u = cb; u < NB * 8 * nqb; u += Gd) { int b, h, qb; if (u < NB * 8 * 32) { b = u >> 8; h = u & 7; qb = (u >> 3) & 31; }     else { const int r_ = u - NB * 8 * 32; b = r_ >> 3; h = r_ & 7; qb = 32; }
              attn_unit<64>(F.lds, a, F.wv0, b, qb, h, ((PROBE_DUP >> 10) & 1) && rep_ == 0); } }
        __syncthreads();
        { ScanArgs a{}; a.BQ = WSP(bf16_t, O_BQ); a.BV = WSP(bf16_t, O_BV); a.BG = WSP(bf16_t, O_BG); a.BLF = WSP(f16_t, O_BLF); a.BLB = WSP(f16_t, O_BLB); a.ST = WSP(bf16_t, O_H); a.DS = WSP(float, O_DS); a.OB = WSP(bf16_t, O_BQ); a.gn = INP(11) + l * 512;
          DUP(2) { const int tid_ = opaque_tid(F.wv0);
            if (cb < NB * 8 * NCHK) { const int b = cb / (8 * NCHK), rem = cb - b * 8 * NCHK, h = rem / NCHK, k = rem - h * NCHK; __syncthreads(); scan_stage(F.lds, a, (size_t)b * RPB + 64 * k - a.in_off, h, tid_); }
            for (int u = cb; u < NB * 8 * NCHK; u += Gd) { const int b = u / (8 * NCHK), rem = u - b * 8 * NCHK, h = rem / NCHK, k = rem - h * NCHK;
                const int un = u + Gd; const bool hn = un < NB * 8 * NCHK; const int nb_ = un / (8 * NCHK), nrem = un - nb_ * 8 * NCHK, nh_ = nrem / NCHK, nk_ = nrem - nh_ * NCHK;
                scan_s1_unit(F.lds, a, F.wv0, b, h, k, hn, nb_, nh_, nk_); } } }
        PH_END
        PH_BEGIN
        { ScanArgs a{}; a.ST = WSP(bf16_t, O_H); a.DS = WSP(float, O_DS);
          for (int t = cb; t < NB * 8 * 2 * 4; t += Gd) scan_s2_task(a, F.wv0, t); }
        { AttnArgs a{}; a.Q = WSP(bf16_t, O_CQ); a.qld = 768; a.qhs = 96; a.K1 = WSP(bf16_t, O_CKV); a.k1ld = 1024; a.k1hs = 128; a.kvgroup = 1; a.K2 = WSP(bf16_t, O_CKR); a.k2ld = 32; a.V = WSP(bf16_t, O_CKV) + 64; a.vld = 1024; a.vhs = 128;
          a.O = WSP(bf16_t, O_OC); a.old = 512; a.ohs = 64; a.scale_l2 = 0.10206207261596577f * LOG2E; a.sink = nullptr; a.window = 0; a.pad = (PROBE_VARIANT && p.mask != 0ull) ? 1 : 0;
          const int nqb = last ? 32 : 33;
          DUP(3) for (int u = cb; u < NB * 8 * nqb; u += Gd) { int b, h, qb; if (u < NB * 8 * 32) { b = u >> 8; h = u & 7; qb = (u >> 3) & 31; }     else { const int r_ = u - NB * 8 * 32; b = r_ >> 3; h = r_ & 7; qb = 32; }
              if (PROBE_VARIANT >= 6 && p.mask != 0ull) attn_unit<96, PROBE_VARIANT>(F.lds, a, F.wv0, b, qb, h); else attn_unit<96>(F.lds, a, F.wv0, b, qb, h); } }
        PH_END
        PH_BEGIN
        { ScanArgs a{}; a.BQ = WSP(bf16_t, O_BQ); a.BV = WSP(bf16_t, O_BV); a.BG = WSP(bf16_t, O_BG); a.BLF = WSP(f16_t, O_BLF); a.BLB = WSP(f16_t, O_BLB); a.ST = WSP(bf16_t, O_H); a.DS = WSP(float, O_DS); a.OB = WSP(bf16_t, O_BQ); a.gn = INP(11) + l * 512; a.skipctx_out = last ? 1 : 0;
          DUP(9) { a.pad = (((PROBE_DUP >> 9) & 1) && rep_ == 0) ? 1 : 0; const int tid_ = opaque_tid(F.wv0);
            if (cb < NB * 8 * NCHK) { const int b = cb / (8 * NCHK), rem = cb - b * 8 * NCHK, h = rem / NCHK, k = rem - h * NCHK; u32x4 t0, t1; __syncthreads(); scan_stage(F.lds, a, (size_t)b * RPB + 64 * k - a.in_off, h, tid_); s3_state_load(a, b, h, k, tid_, t0, t1); s3_state_store((LAS bf16_t*)(F.lds + SC_A), tid_, t0, t1); }
            for (int u = cb; u < NB * 8 * NCHK; u += Gd) { const int b = u / (8 * NCHK), rem = u - b * 8 * NCHK, h = rem / NCHK, k = rem - h * NCHK;
                const int un = u + Gd; const bool hn = un < NB * 8 * NCHK; const int nb_ = un / (8 * NCHK), nrem = un - nb_ * 8 * NCHK, nh_ = nrem / NCHK, nk_ = nrem - nh_ * NCHK;
                scan_s3_unit(F.lds, a, F.wv0, b, h, k, hn, nb_, nh_, nk_); } } }
        phase_rowpass1(F, l, false, O_CKV);
        PH_END
        PH_BEGIN
        { SchedGM S{}; S.A0 = WSP(bf16_t, O_AQ); S.A1 = WSP(bf16_t, O_BQ); S.A2 = WSP(bf16_t, O_OC); S.Ag = WSP(bf16_t, O_CKV); S.Bbr = WSP(bf16_t, O_WBR); S.Bg = WSP(bf16_t, O_WINP) + (size_t)3840 * 1024;
          S.nM = last ? 128 : 132; S.G_ = Gd; S.c = cb; S.skipctx = last ? 1 : 0; S.lda2 = 1024; S.ldb2 = 1024;
          EpiGM E{}; E.U = WSP(bf16_t, O_GATE); E.nstride = (long)G * 1024; E.ld = 1024;
          gp::gemm_phase<EpiGM, SchedGM>(glds, S, E, F.wv0); }
        PH_END
        PH_BEGIN
        { const int tid_ = opaque_tid(F.wv0), lane_ = tid_ & 63, wave_ = __builtin_amdgcn_readfirstlane(tid_ >> 6); const bf16_t* U = WSP(bf16_t, O_GATE); bf16_t* Y = WSP(bf16_t, O_H);
          for (int g = cb * 8 + wave_; g < G; g += Gd * 8) { if (last && (g % RPB) >= SEQ) continue;
#pragma unroll
              for (int j = 0; j < 2; ++j) { const size_t o = (size_t)g * 1024 + 8 * lane_ + 512 * j;
                  const u32x4 a = *(const u32x4*)(U + o), b2 = *(const u32x4*)(U + (size_t)G * 1024 + o), c2 = *(const u32x4*)(U + (size_t)2 * G * 1024 + o);
                  u32x4 w; w.x = pkbf(bflo(a.x) + bflo(b2.x) + bflo(c2.x), bfhi(a.x) + bfhi(b2.x) + bfhi(c2.x)); w.y = pkbf(bflo(a.y) + bflo(b2.y) + bflo(c2.y), bfhi(a.y) + bfhi(b2.y) + bfhi(c2.y));
                  w.z = pkbf(bflo(a.z) + bflo(b2.z) + bflo(c2.z), bfhi(a.z) + bfhi(b2.z) + bfhi(c2.z)); w.w = pkbf(bflo(a.w) + bflo(b2.w) + bflo(c2.w), bfhi(a.w) + bfhi(b2.w) + bfhi(c2.w));
                  *(u32x4*)(Y + o) = w; } } }
        PH_END
        PH_BEGIN
        { SchedStd S{}; S.A = WSP(bf16_t, O_H); S.Bt = WSP(bf16_t, O_WOUT); S.K = 1024; S.nM = last ? 128 : 132; S.nN = 4; S.G_ = Gd; S.c = cb; S.skipctx = last ? 1 : 0; S.lda2 = 2048; S.ldb2 = 2048;
          EpiOut E{}; E.xl_src = l == 0 ? INP(0) : F.out; E.xc_src = l == 0 ? INP(2) : WSP(float, O_XC); E.xl_dst = F.out; E.xc_dst = WSP(float, O_XC); E.mod = MODl; E.pmoff = 0;
          gp::gemm_phase<EpiOut, SchedStd>(glds, S, E, F.wv0); }
        PH_END
        PH_BEGIN phase_rowpass2(F, l, last); PH_END
        PH_BEGIN
        { LAS int* hist = (LAS int*)(F.lds + 131072); const int t_ = opaque_tid(F.wv0);
          if (t_ < 32) hist[t_] = 0;
          __syncthreads();
          SchedStd S{}; S.A = WSP(bf16_t, O_H); S.Bt = WSP(bf16_t, O_WRB) + (size_t)l * 256 * 1024; S.K = 1024; S.nM = last ? 128 : 132; S.nN = 1; S.G_ = Gd; S.c = cb; S.skipctx = last ? 1 : 0; S.lda2 = 2048; S.ldb2 = 2048;
          EpiRoute E{}; E.route_e = WSP(int, O_ROUTE_E); E.route_w = WSP(float, O_ROUTE_W); E.hist = hist;
          gp::gemm_phase<EpiRoute, SchedStd>(glds, S, E, F.wv0);
          __syncthreads();
          { const int t2_ = opaque_tid(F.wv0); if (t2_ < 32) WSP(int, O_WGH)[((size_t)l * 256 + cb) * 32 + t2_] = hist[t2_]; }
          __syncthreads(); }
        conv_weights_moe(F, l); if (!last) conv_weights_nonmoe(F, l + 1);
        PH_END
        PH_BEGIN phase_moe_scatter(F, l, last); PH_END
        PH_BEGIN
        { SchedMoE<true> S{}; S.A = WSP(bf16_t, O_H); S.Bt = WSP(bf16_t, O_WUP); S.tile_e = WSP(int, O_TILEE); S.goff = WSP(unsigned, O_GOFF); S.K = 1024; S.nM = WSP(int, O_TILEE)[NTILE]; S.nN = 2; S.G_ = Gd; S.c = cb; S.lda2 = 2048; S.ldb2 = 2048; S.strideB = 512 * 1024;
          EpiUp E{}; E.AUP = WSP(bf16_t, O_AUP);
          DUP(7) gp::gemm_phase<EpiUp, SchedMoE<true>>(glds, S, E, F.wv0); }
        PH_END
        PH_BEGIN
        { SchedMoE<false> S{}; S.A = WSP(bf16_t, O_AUP); S.Bt = WSP(bf16_t, O_WDN); S.tile_e = WSP(int, O_TILEE); S.goff = nullptr; S.K = 256; S.nM = WSP(int, O_TILEE)[NTILE]; S.nN = 4; S.G_ = Gd; S.c = cb; S.lda2 = 512; S.ldb2 = 512; S.strideB = 1024 * 256;
          EpiDown E{}; E.YM2 = WSP(bf16_t, O_YM2); E.perm = WSP(int, O_PERM); E.posw = WSP(float, O_POSW);
          DUP(8) gp::gemm_phase<EpiDown, SchedMoE<false>>(glds, S, E, F.wv0); }
        PH_END
    }
    PH_BEGIN phase_final(F); PH_END
#undef PH_BEGIN
#undef PH_END
}
constexpr int N_PHASES = 1 + 2 * 13 + 1;
}

#ifndef MK_N_LAUNCHES
#define MK_N_LAUNCHES 1
#endif
extern "C" void kernel_launch(void* const* d_in, const int* in_sizes, int n_in, void* d_out, int out_size, void* d_ws, size_t ws_size, hipStream_t stream) {
    static int grid = 0;
    if (grid == 0) {
        if (ws_size < WS_END) { grid = -1; return; }
        int dev = 0, cus = 0;
        if (hipGetDevice(&dev) != hipSuccess || hipDeviceGetAttribute(&cus, hipDeviceAttributeMultiprocessorCount, dev) != hipSuccess) { grid = -1; return; }
        if (hipFuncSetAttribute((const void*)hybrid_trunk_fwd, hipFuncAttributeMaxDynamicSharedMemorySize, LDS_BYTES) != hipSuccess) { grid = -1; return; }
        int per_cu = 0; (void)hipOccupancyMaxActiveBlocksPerMultiprocessor(&per_cu, (const void*)hybrid_trunk_fwd, 512, LDS_BYTES); (void)hipGetLastError();
        grid = cus;
    }
    if (grid < 0) return;
    (void)hipMemsetAsync(d_ws, 0, CTL_ZERO_BYTES, stream);
    KP p{}; for (int i = 0; i < 24; ++i) p.in[i] = (const float*)d_in[i]; p.out = (float*)d_out; p.ws = (char*)d_ws;
    (void)in_sizes; (void)n_in; (void)out_size;
    if (MK_N_LAUNCHES == 1) { p.ph_lo = 0; p.ph_hi = N_PHASES; hipLaunchKernelGGL(hybrid_trunk_fwd, dim3(grid), dim3(512), LDS_BYTES, stream, p);
        if (PROBE_EXTRA_MASK) { (void)hipMemsetAsync(d_ws, 0, CTL_ZERO_BYTES, stream); p.mask = PROBE_EXTRA_MASK; hipLaunchKernelGGL(hybrid_trunk_fwd, dim3(grid), dim3(512), LDS_BYTES, stream, p); } }
    else { for (int k = 0; k < N_PHASES; ++k) { p.ph_lo = k; p.ph_hi = k + 1; hipLaunchKernelGGL(hybrid_trunk_fwd, dim3(grid), dim3(512), LDS_BYTES, stream, p); } }
}
```

```cpp
#include <hip/hip_runtime.h>
#include <stdint.h>
#include <math.h>

namespace {
typedef unsigned short bf16_t;
typedef _Float16 f16_t;
typedef short bf16x8 __attribute__((ext_vector_type(8)));
typedef short s16x4 __attribute__((ext_vector_type(4)));
typedef float f32x4 __attribute__((ext_vector_type(4)));
typedef float f32x16 __attribute__((ext_vector_type(16)));
typedef unsigned u32x4 __attribute__((ext_vector_type(4)));
#define LAS __attribute__((address_space(3)))

constexpr int D = 1024, NB = 4, SEQ = 8192, CTXL = 256, RPB = SEQ + CTXL, G = NB * RPB;
constexpr int INW = 6816, MIXW = 3744, GATEW = 3072;
constexpr float EPS = 1e-6f;
constexpr float LOG2E = 1.4426950408889634f;
constexpr int PMAX = 75776;
constexpr int NTILE = PMAX / 256;

__device__ __forceinline__ float bf2f(bf16_t v) { return __uint_as_float(((unsigned)v) << 16); }
__device__ __forceinline__ bf16_t f2bf(float f) { unsigned u = __float_as_uint(f); u += 0x7fffu + ((u >> 16) & 1u); return (bf16_t)(u >> 16); }
typedef float f32x2v __attribute__((ext_vector_type(2)));
typedef __bf16 bf16x2v __attribute__((ext_vector_type(2)));
__device__ __forceinline__ unsigned pkbf(float lo, float hi) { const f32x2v v = {lo, hi}; const bf16x2v b = __builtin_convertvector(v, bf16x2v); return __builtin_bit_cast(unsigned, b); }
__device__ __forceinline__ unsigned pk2(float lo, float hi) { return (unsigned)f2bf(lo) | ((unsigned)f2bf(hi) << 16); }
__device__ __forceinline__ float silu_f(float v) { return v / (1.f + expf(-v)); }
__device__ __forceinline__ float sigmoid_f(float v) { return 1.f / (1.f + expf(-v)); }
__device__ __forceinline__ int opaque_tid(int wv) { unsigned z; asm volatile("s_mov_b32 %0, 0" : "=s"(z));
    int t = (wv << 6) | (int)__builtin_amdgcn_mbcnt_hi(~0u, __builtin_amdgcn_mbcnt_lo(~0u, z)); asm volatile("" : "+v"(t)); return t; }
__device__ __forceinline__ float shxl(float v, int k, int lane) { return __builtin_bit_cast(float, __builtin_amdgcn_ds_bpermute((lane ^ k) << 2, __builtin_bit_cast(int, v))); }
__device__ __forceinline__ int shxli(int v, int k, int lane) { return __builtin_amdgcn_ds_bpermute((lane ^ k) << 2, v); }
struct RowInfo { int b, r; bool lat; };
__device__ __forceinline__ RowInfo rowinfo(int g) { RowInfo ri; ri.b = g / RPB; ri.r = g - ri.b * RPB; ri.lat = ri.r < SEQ; return ri; }
__device__ __forceinline__ size_t xoff(const RowInfo& ri) { return ri.lat ? ((size_t)ri.b * SEQ + ri.r) * D : ((size_t)ri.b * CTXL + (ri.r - SEQ)) * D; }
__device__ __forceinline__ int crow(int r, int hi) { return (r & 3) + 8 * (r >> 2) + 4 * hi; }
__device__ __forceinline__ unsigned cvtpk(float lo, float hi) { return pkbf(lo, hi); }
typedef short v4i16_t __attribute__((ext_vector_type(4)));
__device__ __forceinline__ s16x4 vtr(const LAS char* p) { return __builtin_bit_cast(s16x4, __builtin_amdgcn_ds_read_tr16_b64_v4i16((LAS v4i16_t*)p)); }
#define MFMA32(a, b, c) __builtin_amdgcn_mfma_f32_32x32x16_bf16(a, b, c, 0, 0, 0)
#ifndef PROBE_VARIANT
#define PROBE_VARIANT 0
#endif
#if PROBE_VARIANT == 4
#define VTR_ASM(dst, addr, off) do { if (!p.pad) asm volatile("ds_read_b64_tr_b16 %0, %1 offset:" #off : "=v"(dst) : "v"(addr)); else asm volatile("" : "=v"(dst)); } while (0)
#else
#define VTR_ASM(dst, addr, off) asm volatile("ds_read_b64_tr_b16 %0, %1 offset:" #off : "=v"(dst) : "v"(addr))
#endif
struct AttnArgs { const bf16_t* Q; int qld, qhs; const bf16_t* K1; int k1ld, k1hs, kvgroup; const bf16_t* K2; int k2ld; const bf16_t* V; int vld, vhs;
                  bf16_t* O; int old, ohs; float scale_l2; const float* sink; int window; int pad; };
template <int DQK, int VAR = 0>
__device__ __forceinline__ void attn_unit(LAS char* lds, const AttnArgs& p, int wv0, int b, int qb, int h, bool nostore = false) {
    constexpr int NS = DQK / 16, NCH = DQK / 8; constexpr float THR = 8.f;
    constexpr int KB = 0, VB = 49152, WSF = 81920;
    const int tid = opaque_tid(wv0), lane = tid & 63, r32 = lane & 31, hi = lane >> 5, wid = tid >> 6;
    const int rb = b * RPB;
    const bool ctxq = (qb == 32);
    const int q0 = rb + (ctxq ? SEQ : qb * 256);
    int lat_k0 = 0, lat_k1 = 0;
    if (!ctxq) { if (p.window) { lat_k0 = qb * 256 - 128; if (lat_k0 < 0) lat_k0 = 0; lat_k1 = qb * 256 + 384; if (lat_k1 > SEQ) lat_k1 = SEQ; } else { lat_k0 = 0; lat_k1 = SEQ; } }
    const int ntiles = 4 + (lat_k1 - lat_k0) / 64;
    const int qrow = q0 + wid * 32 + r32;
    const int qpos = qb * 256 + wid * 32 + r32;
    const int wq0 = qb * 256 + wid * 32;
    LAS float* wsf = (LAS float*)(lds + WSF) + wid * 64;
    bf16x8 qr[NS];
#pragma unroll
    for (int s = 0; s < NS; ++s) qr[s] = *(const bf16x8*)(p.Q + (size_t)qrow * p.qld + h * p.qhs + 16 * s + 8 * hi);
    const int k1off = (h / p.kvgroup) * p.k1hs, voff = (h / p.kvgroup) * p.vhs;
    const int wv = __builtin_amdgcn_readfirstlane(wid);
    const bool k2nd = (NCH > 8) && (wv < NCH - 8);
    const size_t ksrc0 = (size_t)lane * p.k1ld + k1off + wv * 8, ksrc1 = (size_t)lane * p.k2ld + wv * 8;
    const size_t vsrc = (size_t)(16 * (wv & 3) + (lane >> 2)) * p.vld + voff + (wv >> 2) * 32 + (lane & 3) * 8;
#define AT_ROW0(it_) (rb + ((it_) >= 4 ? lat_k0 + 64 * ((it_) - 4) : SEQ + 64 * (it_)))
#define AT_DMAK(it_, slot_) do { if constexpr (VAR == 8) break; const size_t kr0_ = (size_t)AT_ROW0(it_); \
        __builtin_amdgcn_global_load_lds((const unsigned*)(p.K1 + kr0_ * p.k1ld + ksrc0), (LAS unsigned*)(lds + KB + (slot_) * 12288 + wv * 1024), 16, 0, 0); \
        if (k2nd) __builtin_amdgcn_global_load_lds((const unsigned*)(p.K2 + kr0_ * p.k2ld + ksrc1), (LAS unsigned*)(lds + KB + (slot_) * 12288 + (8 + wv) * 1024), 16, 0, 0); } while (0)
#define AT_DMAV(it_, slot_) do { if constexpr (VAR == 8) break; const size_t kr0_ = (size_t)AT_ROW0(it_); \
        __builtin_amdgcn_global_load_lds((const unsigned*)(p.V + kr0_ * p.vld + vsrc), (LAS unsigned*)(lds + VB + (slot_) * 8192 + wv * 1024), 16, 0, 0); } while (0)
#define AT_CLAMP(x_) ((x_) < ntiles ? (x_) : ntiles - 1)
#define AT_WAITBAR() do { if (k2nd) asm volatile("s_waitcnt vmcnt(6) lgkmcnt(0)" ::: "memory"); else asm volatile("s_waitcnt vmcnt(4) lgkmcnt(0)" ::: "memory"); if constexpr (VAR != 7) __builtin_amdgcn_s_barrier(); asm volatile("" ::: "memory"); } while (0)
#define AT_QK(C0, C1, slot_) do { const LAS char* ldsK_ = lds + KB + (slot_) * 12288 + hi * 1024 + r32 * 16; C0 = negm; C1 = negm; bf16x8 kf_[2 * NS]; \
        _Pragma("unroll") for (int s = 0; s < NS; ++s) { kf_[2 * s] = *(const LAS bf16x8*)(ldsK_ + s * 2048); kf_[2 * s + 1] = *(const LAS bf16x8*)(ldsK_ + s * 2048 + 512); } \
        __builtin_amdgcn_sched_group_barrier(0x100, 2 * NS, 0); \
        _Pragma("unroll") for (int s = 0; s < NS; ++s) { C0 = MFMA32(kf_[2 * s], qr[s], C0); C1 = MFMA32(kf_[2 * s + 1], qr[s], C1); } } while (0)
#define AT_REF(C0, C1, T_, first) do { const int tr_ = (T_); \
        if (p.window && tr_ >= 4) { const int kpos0 = lat_k0 + 64 * (tr_ - 4); \
            _Pragma("unroll") for (int r = 0; r < 16; ++r) { const int kp = kpos0 + crow(r, hi); int d0 = qpos - kp; if (d0 < 0) d0 = -d0; int d1 = qpos - (kp + 32); if (d1 < 0) d1 = -d1; \
                if (d0 > p.window) C0[r] = -1e30f; if (d1 > p.window) C1[r] = -1e30f; } } \
        if ((first) || (tr_ & 7) == 0) { \
        float mx = fmaxf(fmaxf(C0[0], C0[1]), C1[0]); \
        _Pragma("unroll") for (int r = 2; r < 16; r += 2) mx = fmaxf(fmaxf(mx, C0[r]), C0[r + 1]); \
        _Pragma("unroll") for (int r = 1; r < 15; r += 2) mx = fmaxf(fmaxf(mx, C1[r]), C1[r + 1]); \
        mx = fmaxf(mx, C1[15]); mx = fmaxf(mx, shxl(mx, 32, lane)); \
        if ((first) || __any(mx > THR)) { const float dl = (first) ? mx : fmaxf(mx, 0.f); \
            m += dl; const float alpha = __builtin_amdgcn_exp2f(-dl); l *= alpha; \
            _Pragma("unroll") for (int r = 0; r < 16; ++r) { C0[r] -= dl; C1[r] -= dl; negm[r] = -m; } \
            if (hi == 0) wsf[r32] = alpha; \
            _Pragma("unroll") for (int r = 0; r < 16; ++r) { const float f = wsf[crow(r, hi)]; o0[r] *= f; o1[r] *= f; } } } } while (0)
    f32x16 o0, o1, negm, cA0, cA1, cB0, cB1;
#pragma unroll
    for (int r = 0; r < 16; ++r) { o0[r] = 0.f; o1[r] = 0.f; negm[r] = 0.f; }
    float m = 0.f, l = 0.f;
    const int vlane = ((lane >> 4) & 1) * 32 + (lane & 3) * 8 + (4 * hi + ((lane & 15) >> 2)) * 64;
    asm volatile("s_waitcnt vmcnt(0) lgkmcnt(0)" ::: "memory"); __builtin_amdgcn_s_barrier(); asm volatile("" ::: "memory");
    AT_DMAK(0, 0); AT_DMAV(0, 0); AT_DMAK(AT_CLAMP(1), 1); AT_DMAV(AT_CLAMP(1), 1); AT_DMAK(AT_CLAMP(2), 2); AT_DMAV(AT_CLAMP(2), 2); AT_DMAK(AT_CLAMP(3), 3);
    asm volatile("s_waitcnt vmcnt(0)" ::: "memory"); __builtin_amdgcn_s_barrier(); asm volatile("" ::: "memory");
    AT_QK(cA0, cA1, 0);
    AT_REF(cA0, cA1, 0, true);
    asm volatile("s_waitcnt lgkmcnt(0)" ::: "memory"); __builtin_amdgcn_s_barrier(); asm volatile("" ::: "memory");
#define AT_SB() __builtin_amdgcn_sched_barrier(0)
#define AT_PIN2(x, y) asm volatile("" : "+v"(x), "+v"(y))
#define AT_PIN1(x) asm volatile("" : "+v"(x))
#define AT_PINRS() asm volatile("" : "+v"(ra_), "+v"(rb_))
#define AT_LDK(dst, addr_, off) asm volatile("ds_read_b128 %0, %1 offset:" #off : "=v"(dst) : "v"(addr_))
#define AT_WAITK(n, a, b) asm volatile("s_waitcnt lgkmcnt(" #n ")" : "+v"(a), "+v"(b))
#define AT_WAITV8(n, a, b, c, d, e, f, g, h) asm volatile("s_waitcnt lgkmcnt(" #n ")" : "+v"(a), "+v"(b), "+v"(c), "+v"(d), "+v"(e), "+v"(f), "+v"(g), "+v"(h))
#define AT_WAITV4(n, a, b, c, d) asm volatile("s_waitcnt lgkmcnt(" #n ")" : "+v"(a), "+v"(b), "+v"(c), "+v"(d))
#define AT_EXP(X) do { if constexpr (VAR != 6) X = __builtin_amdgcn_exp2f(X); } while (0)
#define AT_STEP(C0, C1, N0, N1, T_) do { const int t_ = (T_); const int t1_ = t_ + 1 < ntiles ? t_ + 1 : ntiles - 1; \
        AT_DMAK(AT_CLAMP(t_ + 4), t_ & 3); AT_DMAV(AT_CLAMP(t_ + 3), (t_ + 3) & 3); \
        const unsigned kaddr_ = (unsigned)(size_t)(lds + KB + ((t_ + 1) & 3) * 12288 + hi * 1024 + r32 * 16); const unsigned vaddr_ = (unsigned)(size_t)(lds + VB + (t_ & 3) * 8192 + vlane); \
        bf16x8 kfa0, kfa1, kfb0, kfb1, kfc0, kfc1; bf16x8 vf_[8]; s16x4 ta_[16]; f32x2v ra_ = {0.f, 0.f}, rb_ = {0.f, 0.f}; u32x4 pw[4]; \
        AT_LDK(kfa0, kaddr_, 0); AT_LDK(kfa1, kaddr_, 512); AT_LDK(kfb0, kaddr_, 2048); AT_LDK(kfb1, kaddr_, 2560); AT_SB(); \
        if constexpr (NS == 6) { \
          AT_LDK(kfc0, kaddr_, 4096); AT_LDK(kfc1, kaddr_, 4608); AT_WAITK(4, kfa0, kfa1); N0 = MFMA32(kfa0, qr[0], negm); AT_PIN1(N0); AT_EXP(C0[0]); AT_EXP(C0[1]); AT_EXP(C0[2]);  VTR_ASM(ta_[0], vaddr_, 0); AT_SB(); \
          N1 = MFMA32(kfa1, qr[0], negm); AT_PIN1(N1); AT_EXP(C0[3]); AT_EXP(C0[4]); AT_EXP(C0[5]);  VTR_ASM(ta_[1], vaddr_, 512); VTR_ASM(ta_[2], vaddr_, 4096); AT_SB(); \
          AT_LDK(kfa0, kaddr_, 6144); AT_LDK(kfa1, kaddr_, 6656); AT_WAITK(7, kfb0, kfb1); N0 = MFMA32(kfb0, qr[1], N0); AT_PIN1(N0); AT_EXP(C0[6]); AT_EXP(C0[7]); AT_EXP(C0[8]); VTR_ASM(ta_[3], vaddr_, 4608); AT_SB(); \
          N1 = MFMA32(kfb1, qr[1], N1); AT_PIN1(N1); AT_EXP(C0[9]); AT_EXP(C0[10]); AT_EXP(C0[11]); VTR_ASM(ta_[4], vaddr_, 1024); VTR_ASM(ta_[5], vaddr_, 1536); AT_SB(); \
          AT_LDK(kfb0, kaddr_, 8192); AT_LDK(kfb1, kaddr_, 8704); AT_WAITK(10, kfc0, kfc1); N0 = MFMA32(kfc0, qr[2], N0); AT_PIN1(N0); AT_EXP(C0[12]); AT_EXP(C0[13]); AT_EXP(C0[14]); VTR_ASM(ta_[6], vaddr_, 5120); AT_SB(); \
          N1 = MFMA32(kfc1, qr[2], N1); AT_PIN1(N1); AT_EXP(C0[15]); AT_EXP(C1[0]); AT_EXP(C1[1]); VTR_ASM(ta_[7], vaddr_, 5632); VTR_ASM(ta_[8], vaddr_, 2048); AT_SB(); \
          AT_LDK(kfc0, kaddr_, 10240); AT_LDK(kfc1, kaddr_, 10752); AT_WAITK(10, kfa0, kfa1); N0 = MFMA32(kfa0, qr[3], N0); AT_PIN1(N0); AT_EXP(C1[2]); AT_EXP(C1[3]); AT_EXP(C1[4]); VTR_ASM(ta_[9], vaddr_, 2560); AT_SB(); \
          N1 = MFMA32(kfa1, qr[3], N1); AT_PIN1(N1); AT_EXP(C1[5]); AT_EXP(C1[6]); AT_EXP(C1[7]); VTR_ASM(ta_[10], vaddr_, 6144); VTR_ASM(ta_[11], vaddr_, 6656); AT_SB(); \
           AT_WAITK(8, kfb0, kfb1); N0 = MFMA32(kfb0, qr[4], N0); AT_PIN1(N0); AT_EXP(C1[8]); AT_EXP(C1[9]); VTR_ASM(ta_[12], vaddr_, 3072); AT_SB(); \
          N1 = MFMA32(kfb1, qr[4], N1); AT_PIN1(N1); AT_EXP(C1[10]); AT_EXP(C1[11]); VTR_ASM(ta_[13], vaddr_, 3584); AT_SB(); \
           AT_WAITK(5, kfc0, kfc1); N0 = MFMA32(kfc0, qr[5], N0); AT_PIN1(N0); AT_EXP(C1[12]); AT_EXP(C1[13]); VTR_ASM(ta_[14], vaddr_, 7168); AT_SB(); \
          N1 = MFMA32(kfc1, qr[5], N1); AT_PIN1(N1); AT_EXP(C1[14]); AT_EXP(C1[15]); VTR_ASM(ta_[15], vaddr_, 7680); AT_SB(); \
          \
        } \
        if constexpr (NS == 4) { \
          AT_LDK(kfc0, kaddr_, 4096); AT_LDK(kfc1, kaddr_, 4608); AT_WAITK(4, kfa0, kfa1); N0 = MFMA32(kfa0, qr[0], negm); AT_PIN1(N0); AT_EXP(C0[0]); AT_EXP(C0[1]); AT_EXP(C0[2]); AT_EXP(C0[3]);  VTR_ASM(ta_[0], vaddr_, 0); AT_SB(); \
          N1 = MFMA32(kfa1, qr[0], negm); AT_PIN1(N1); AT_EXP(C0[4]); AT_EXP(C0[5]); AT_EXP(C0[6]); AT_EXP(C0[7]);  VTR_ASM(ta_[1], vaddr_, 512); VTR_ASM(ta_[2], vaddr_, 4096); VTR_ASM(ta_[3], vaddr_, 4608); AT_SB(); \
          AT_LDK(kfa0, kaddr_, 6144); AT_LDK(kfa1, kaddr_, 6656); AT_WAITK(8, kfb0, kfb1); N0 = MFMA32(kfb0, qr[1], N0); AT_PIN1(N0); AT_EXP(C0[8]); AT_EXP(C0[9]); AT_EXP(C0[10]); AT_EXP(C0[11]); VTR_ASM(ta_[4], vaddr_, 1024); AT_SB(); \
          N1 = MFMA32(kfb1, qr[1], N1); AT_PIN1(N1); AT_EXP(C0[12]); AT_EXP(C0[13]); AT_EXP(C0[14]); AT_EXP(C0[15]); VTR_ASM(ta_[5], vaddr_, 1536); VTR_ASM(ta_[6], vaddr_, 5120); VTR_ASM(ta_[7], vaddr_, 5632); AT_SB(); \
           AT_WAITK(10, kfc0, kfc1); N0 = MFMA32(kfc0, qr[2], N0); AT_PIN1(N0); AT_EXP(C1[0]); AT_EXP(C1[1]); AT_EXP(C1[2]); AT_EXP(C1[3]); VTR_ASM(ta_[8], vaddr_, 2048); AT_SB(); \
          N1 = MFMA32(kfc1, qr[2], N1); AT_PIN1(N1); AT_EXP(C1[4]); AT_EXP(C1[5]); AT_EXP(C1[6]); AT_EXP(C1[7]); VTR_ASM(ta_[9], vaddr_, 2560); VTR_ASM(ta_[10], vaddr_, 6144); VTR_ASM(ta_[11], vaddr_, 6656); AT_SB(); \
           AT_WAITK(8, kfa0, kfa1); N0 = MFMA32(kfa0, qr[3], N0); AT_PIN1(N0); AT_EXP(C1[8]); AT_EXP(C1[9]); AT_EXP(C1[10]); AT_EXP(C1[11]); VTR_ASM(ta_[12], vaddr_, 3072); AT_SB(); \
          N1 = MFMA32(kfa1, qr[3], N1); AT_PIN1(N1); AT_EXP(C1[12]); AT_EXP(C1[13]); AT_EXP(C1[14]); AT_EXP(C1[15]); VTR_ASM(ta_[13], vaddr_, 3584); VTR_ASM(ta_[14], vaddr_, 7168); VTR_ASM(ta_[15], vaddr_, 7680); AT_SB(); \
          \
        } \
        if constexpr (NS == 6) AT_WAITV8(9, ta_[0], ta_[1], ta_[2], ta_[3], ta_[4], ta_[5], ta_[6], ta_[7]); else AT_WAITV8(8, ta_[0], ta_[1], ta_[2], ta_[3], ta_[4], ta_[5], ta_[6], ta_[7]); AT_SB(); \
        vf_[0] = (bf16x8){ta_[0][0], ta_[0][1], ta_[0][2], ta_[0][3], ta_[1][0], ta_[1][1], ta_[1][2], ta_[1][3]}; vf_[1] = (bf16x8){ta_[2][0], ta_[2][1], ta_[2][2], ta_[2][3], ta_[3][0], ta_[3][1], ta_[3][2], ta_[3][3]}; vf_[2] = (bf16x8){ta_[4][0], ta_[4][1], ta_[4][2], ta_[4][3], ta_[5][0], ta_[5][1], ta_[5][2], ta_[5][3]}; vf_[3] = (bf16x8){ta_[6][0], ta_[6][1], ta_[6][2], ta_[6][3], ta_[7][0], ta_[7][1], ta_[7][2], ta_[7][3]}; \
        pw[0] = (u32x4){cvtpk(C0[0], C0[1]), cvtpk(C0[2], C0[3]), cvtpk(C0[4], C0[5]), cvtpk(C0[6], C0[7])}; AT_SB(); \
        if (!(PROBE_VARIANT == 2 && p.pad)) { \
        o0 = MFMA32(__builtin_bit_cast(bf16x8, pw[0]), vf_[0], o0); AT_PIN1(o0); pw[1].x = cvtpk(C0[8], C0[9]); pw[1].y = cvtpk(C0[10], C0[11]); ra_ += (f32x2v){C0[0], C0[1]}; rb_ += (f32x2v){C0[2], C0[3]}; AT_PINRS(); AT_SB(); \
        o1 = MFMA32(__builtin_bit_cast(bf16x8, pw[0]), vf_[1], o1); AT_PIN1(o1); pw[1].z = cvtpk(C0[12], C0[13]); pw[1].w = cvtpk(C0[14], C0[15]); ra_ += (f32x2v){C0[4], C0[5]}; rb_ += (f32x2v){C0[6], C0[7]}; AT_PINRS(); AT_SB(); \
        o0 = MFMA32(__builtin_bit_cast(bf16x8, pw[1]), vf_[2], o0); AT_PIN1(o0); pw[2].x = cvtpk(C1[0], C1[1]); pw[2].y = cvtpk(C1[2], C1[3]); ra_ += (f32x2v){C0[8], C0[9]}; rb_ += (f32x2v){C0[10], C0[11]}; AT_PINRS(); AT_SB(); \
        o1 = MFMA32(__builtin_bit_cast(bf16x8, pw[1]), vf_[3], o1); AT_PIN1(o1); pw[2].z = cvtpk(C1[4], C1[5]); pw[2].w = cvtpk(C1[6], C1[7]); ra_ += (f32x2v){C0[12], C0[13]}; rb_ += (f32x2v){C0[14], C0[15]}; AT_PINRS(); AT_SB(); \
        AT_WAITV4(4, ta_[8], ta_[9], ta_[10], ta_[11]); vf_[4] = (bf16x8){ta_[8][0], ta_[8][1], ta_[8][2], ta_[8][3], ta_[9][0], ta_[9][1], ta_[9][2], ta_[9][3]}; vf_[5] = (bf16x8){ta_[10][0], ta_[10][1], ta_[10][2], ta_[10][3], ta_[11][0], ta_[11][1], ta_[11][2], ta_[11][3]}; \
        o0 = MFMA32(__builtin_bit_cast(bf16x8, pw[2]), vf_[4], o0); AT_PIN1(o0); pw[3].x = cvtpk(C1[8], C1[9]); pw[3].y = cvtpk(C1[10], C1[11]); ra_ += (f32x2v){C1[0], C1[1]}; rb_ += (f32x2v){C1[2], C1[3]}; AT_PINRS(); AT_SB(); \
        o1 = MFMA32(__builtin_bit_cast(bf16x8, pw[2]), vf_[5], o1); AT_PIN1(o1); pw[3].z = cvtpk(C1[12], C1[13]); pw[3].w = cvtpk(C1[14], C1[15]); ra_ += (f32x2v){C1[4], C1[5]}; rb_ += (f32x2v){C1[6], C1[7]}; AT_PINRS(); AT_SB(); \
        AT_WAITV4(0, ta_[12], ta_[13], ta_[14], ta_[15]); vf_[6] = (bf16x8){ta_[12][0], ta_[12][1], ta_[12][2], ta_[12][3], ta_[13][0], ta_[13][1], ta_[13][2], ta_[13][3]}; vf_[7] = (bf16x8){ta_[14][0], ta_[14][1], ta_[14][2], ta_[14][3], ta_[15][0], ta_[15][1], ta_[15][2], ta_[15][3]}; \
        o0 = MFMA32(__builtin_bit_cast(bf16x8, pw[3]), vf_[6], o0); AT_PIN1(o0); ra_ += (f32x2v){C1[8], C1[9]}; rb_ += (f32x2v){C1[10], C1[11]}; AT_PINRS(); AT_SB(); \
        o1 = MFMA32(__builtin_bit_cast(bf16x8, pw[3]), vf_[7], o1); AT_PIN1(o1); ra_ += (f32x2v){C1[12], C1[13]}; rb_ += (f32x2v){C1[14], C1[15]}; AT_PINRS(); AT_SB(); } \
        l += (ra_[0] + ra_[1]) + (rb_[0] + rb_[1]); \
        AT_WAITBAR(); \
        if (t_ + 1 < ntiles) AT_REF(N0, N1, t1_, false); } while (0)
    for (int it = 0; it < ntiles; it += 2) {
        AT_STEP(cA0, cA1, cB0, cB1, it);
        AT_STEP(cB0, cB1, cA0, cA1, it + 1);
    }
#undef AT_ROW0
#undef AT_DMAK
#undef AT_DMAV
#undef AT_CLAMP
#undef AT_WAITBAR
#undef AT_REF
#undef AT_SB
#undef AT_PIN2
#undef AT_PIN1
#undef AT_PINRS
#undef AT_LDK
#undef AT_WAITK
#undef AT_WAITV8
#undef AT_WAITV4
#undef AT_EXP
#undef AT_QK
#undef AT_STEP
    float lt = l + shxl(l, 32, lane);
    float fin = 1.f;
    if (p.sink) { const float sk = p.sink[h] * LOG2E; const float m2 = fmaxf(m, sk); fin = __builtin_amdgcn_exp2f(m - m2); lt = lt * fin + __builtin_amdgcn_exp2f(sk - m2); }
    const float sc = fin / lt;
    if (hi == 0) wsf[r32] = sc;
    bf16_t* Ob = p.O + (size_t)(q0 + wid * 32) * p.old + h * p.ohs + r32;
#pragma unroll
    for (int r = 0; r < 16; ++r) { const int qr_ = crow(r, hi); const float f = wsf[qr_];
        if (!nostore) { Ob[(size_t)qr_ * p.old] = f2bf(o0[r] * f); Ob[(size_t)qr_ * p.old + 32] = f2bf(o1[r] * f); } }
}

namespace gp {
constexpr int BM = 256, BK = 64, HALF = 128, HTB = HALF * BK * 2, STAGE_BYTES = 8 * HTB, NXCD = 8, WGM = 8;
__host__ __device__ __forceinline__ int lds_byte(int r, int c) { const int st = (r >> 4) * 2 + (c >> 5), rr = r & 15, cc = c & 31, ob = rr * 64 + cc * 2; return st * 1024 + (ob ^ (((ob >> 9) & 1) << 5)); }
__host__ __device__ __forceinline__ void stage_rc(int b, int& R, int& C) { const int st = b / 1024, sb = b % 1024, swz = sb ^ (((sb >> 9) & 1) << 5); R = (st >> 1) * 16 + swz / 64; C = (st & 1) * 32 + (swz % 64) / 2; }
__host__ __device__ __forceinline__ int perm32(int rho) { const int n = rho >> 4, i = rho & 15; return 8 * (i >> 2) + 4 * n + (i & 3); }

struct GUnit { const char* A; const char* B; int nt, pm, pn, tag; const unsigned* goff; int lda2, ldb2; };

__device__ __forceinline__ bool tile_order(int i, int G_, int c, int nM, int nN, int& pm, int& pn) {
    const int nwg = nM * nN; const long L = (long)i * G_ + c; if (L >= nwg) return false;
    int wgid = (int)L; { const int q = nwg / NXCD, r = nwg % NXCD, xcd = wgid % NXCD, off = wgid / NXCD; wgid = (xcd < r ? xcd * (q + 1) : r * (q + 1) + (xcd - r) * q) + off; }
    const int nig = WGM * nN, gid = wgid / nig, fm = gid * WGM, gsz = (nM - fm) < WGM ? (nM - fm) : WGM;
    pm = fm + ((wgid % nig) % gsz); pn = (wgid % nig) / gsz; return true;
}
__device__ __forceinline__ unsigned cvt_pk_bf16(float lo, float hi) { return pkbf(lo, hi); }

template <class Epi, class Sched>
__device__ __forceinline__ void gemm_phase(LAS unsigned char* lds, const Sched& S, const Epi& E, int wv0) {
    constexpr bool GATHER = Sched::GATHER; constexpr bool VS = Sched::VARSTRIDE;
    const int tid = opaque_tid(wv0), wid = __builtin_amdgcn_readfirstlane(tid >> 6), lane = tid & 63, wr = wid >> 2, wc = wid & 3, fr = lane & 15, fq = lane >> 4;
    const int lda2 = S.lda2, ldb2 = S.ldb2;
    unsigned voffA[2], voffB[2], rowA[2], rowB[2], colb[2];
#pragma unroll
    for (int i = 0; i < 2; ++i) { int R, C; stage_rc(tid * 16 + i * 8192, R, C); const int Rb = Epi::PERM ? ((R & ~31) + perm32(R & 31)) : R;
        voffA[i] = GATHER ? (unsigned)C * 2u : (unsigned)R * (unsigned)lda2 + (unsigned)C * 2u; rowA[i] = (unsigned)R; voffB[i] = (unsigned)Rb * (unsigned)ldb2 + (unsigned)C * 2u; rowB[i] = (unsigned)Rb; colb[i] = (unsigned)C * 2u; }
    size_t hA = GATHER ? 0 : (size_t)HALF * lda2, hB = (size_t)HALF * ldb2;
    const unsigned ldsw = (unsigned)wid * 1024u;
    const int aoff = lds_byte(wr * 64 + fr, fq * 8), boff = lds_byte(wc * 32 + fr, fq * 8);
    constexpr size_t kstep = (size_t)(BK * 2);
#define GP_SA(b, h) (((b) * 2 + (h)) * HTB)
#define GP_SB(b, h) ((4 + (b) * 2 + (h)) * HTB)
#define GP_STAGE(bufoff, gbase, v0, v1) do { \
        __builtin_amdgcn_global_load_lds((const unsigned*)((const char*)(gbase) + (v0)), (LAS unsigned*)(lds + (bufoff) + ldsw), 16, 0, 0); \
        __builtin_amdgcn_global_load_lds((const unsigned*)((const char*)(gbase) + (v1)), (LAS unsigned*)(lds + (bufoff) + ldsw + 8192), 16, 0, 0); } while (0)
#define GP_LDA(dst, b, h) do { _Pragma("unroll") for (int m = 0; m < 4; ++m) _Pragma("unroll") for (int k = 0; k < 2; ++k) dst[m][k] = *(const LAS bf16x8*)(lds + GP_SA(b, h) + aoff + m * 2048 + k * 1024); } while (0)
#define GP_LDB(dst, b, h) do { _Pragma("unroll") for (int n = 0; n < 2; ++n) _Pragma("unroll") for (int k = 0; k < 2; ++k) dst[n][k] = *(const LAS bf16x8*)(lds + GP_SB(b, h) + boff + n * 2048 + k * 1024); } while (0)
#define GP_MMA(ai, bj, At, Bt) do { __builtin_amdgcn_s_setprio(1); _Pragma("unroll") for (int m = 0; m < 4; ++m) _Pragma("unroll") for (int n = 0; n < 2; ++n) _Pragma("unroll") for (int k = 0; k < 2; ++k) \
        acc[ai][bj][m][n] = __builtin_amdgcn_mfma_f32_16x16x32_bf16(Bt[n][k], At[m][k], acc[ai][bj][m][n], 0, 0, 0); __builtin_amdgcn_s_setprio(0); } while (0)
#define GP_WAIT_V(n) asm volatile("s_waitcnt vmcnt(" #n ")" ::: "memory")
#define GP_WAIT_L(n) asm volatile("s_waitcnt lgkmcnt(" #n ")" ::: "memory")
#define GP_BAR __builtin_amdgcn_s_barrier()
#define GP_SCHED __builtin_amdgcn_sched_barrier(0)
#define GP_GOFF(U, o0, o1, p0, p1) do { if (GATHER) { o0 = (U).goff[rowA[0]] + voffA[0]; o1 = (U).goff[rowA[1]] + voffA[1]; p0 = (U).goff[128 + rowA[0]] + voffA[0]; p1 = (U).goff[128 + rowA[1]] + voffA[1]; } \
        else { o0 = voffA[0]; o1 = voffA[1]; p0 = voffA[0]; p1 = voffA[1]; } } while (0)
    GUnit cur, nxt; int ui = 0;
    if (!S.next(0, cur)) return;
    f32x4 acc[2][2][4][2];
#pragma unroll
    for (int a = 0; a < 2; ++a)
#pragma unroll
        for (int b = 0; b < 2; ++b)
#pragma unroll
            for (int m = 0; m < 4; ++m)
#pragma unroll
                for (int n = 0; n < 2; ++n) acc[a][b][m][n] = (f32x4){0.f, 0.f, 0.f, 0.f};
    bf16x8 At[4][2], B0[2][2], B1[2][2];
    unsigned g00, g01, g10, g11;
    if (VS) { voffA[0] = rowA[0] * (unsigned)cur.lda2 + colb[0]; voffA[1] = rowA[1] * (unsigned)cur.lda2 + colb[1]; voffB[0] = rowB[0] * (unsigned)cur.ldb2 + colb[0]; voffB[1] = rowB[1] * (unsigned)cur.ldb2 + colb[1];
              hA = (size_t)HALF * cur.lda2; hB = (size_t)HALF * cur.ldb2; }
    GP_GOFF(cur, g00, g01, g10, g11);
    const char* cA = cur.A; const char* cB = cur.B;
    GP_STAGE(GP_SB(0, 0), cB, voffB[0], voffB[1]); GP_STAGE(GP_SA(0, 0), cA, g00, g01); GP_STAGE(GP_SB(0, 1), cB + hB, voffB[0], voffB[1]); GP_STAGE(GP_SA(0, 1), cA + hA, g10, g11);
    if (wr == 1) GP_BAR;
    GP_WAIT_V(4); GP_BAR;
    GP_STAGE(GP_SB(1, 0), cB + kstep, voffB[0], voffB[1]); GP_STAGE(GP_SA(1, 0), cA + kstep, g00, g01); GP_STAGE(GP_SB(1, 1), cB + hB + kstep, voffB[0], voffB[1]);
    GP_WAIT_V(6); GP_BAR;
    for (;;) {
        const bool has_next = S.next(ui + 1, nxt);
        const char* nA = has_next ? nxt.A : cA; const char* nB = has_next ? nxt.B : cB;
        const int nt = cur.nt;
        for (int t = 0; t < nt; t += 2) {
            const bool last = (t == nt - 2);
            const char* a1 = cA + (size_t)(t + 1) * kstep;
            const char* a2 = last ? nA : cA + (size_t)(t + 2) * kstep; const char* b2 = last ? nB : cB + (size_t)(t + 2) * kstep;
            const char* a3 = a2 + kstep; const char* b3 = b2 + kstep;
            unsigned w00 = g00, w01 = g01, w10 = g10, w11 = g11, wB0 = voffB[0], wB1 = voffB[1]; size_t whA = hA, whB = hB;
            if (GATHER && last && has_next) { GP_GOFF(nxt, w00, w01, w10, w11); }
            if (VS && last && has_next) { w00 = w10 = rowA[0] * (unsigned)nxt.lda2 + colb[0]; w01 = w11 = rowA[1] * (unsigned)nxt.lda2 + colb[1]; wB0 = rowB[0] * (unsigned)nxt.ldb2 + colb[0]; wB1 = rowB[1] * (unsigned)nxt.ldb2 + colb[1];
                whA = (size_t)HALF * nxt.lda2; whB = (size_t)HALF * nxt.ldb2; }
            GP_LDB(B0, 0, 0); GP_SCHED; GP_LDA(At, 0, 0); GP_STAGE(GP_SA(1, 1), a1 + hA, g10, g11);
            GP_WAIT_L(8); GP_BAR; GP_WAIT_L(0); GP_MMA(0, 0, At, B0); GP_BAR; GP_SCHED;
            GP_LDB(B1, 0, 1); GP_STAGE(GP_SB(0, 0), b2, wB0, wB1);
            GP_BAR; GP_WAIT_L(0); GP_MMA(0, 1, At, B1); GP_BAR;
            GP_LDA(At, 0, 1); GP_STAGE(GP_SA(0, 0), a2, w00, w01);
            GP_BAR; GP_WAIT_L(0); GP_MMA(1, 0, At, B0); GP_BAR; GP_SCHED;
            GP_STAGE(GP_SB(0, 1), b2 + whB, wB0, wB1);
            GP_WAIT_V(6); GP_BAR; GP_MMA(1, 1, At, B1); GP_BAR;
            GP_LDB(B0, 1, 0); GP_SCHED; GP_LDA(At, 1, 0); GP_STAGE(GP_SA(0, 1), a2 + whA, w10, w11);
            GP_WAIT_L(8); GP_BAR; GP_WAIT_L(0); GP_MMA(0, 0, At, B0); GP_BAR; GP_SCHED;
            GP_LDB(B1, 1, 1); GP_STAGE(GP_SB(1, 0), b3, wB0, wB1);
            GP_BAR; GP_WAIT_L(0); GP_MMA(0, 1, At, B1); GP_BAR;
            GP_LDA(At, 1, 1); GP_STAGE(GP_SA(1, 0), a3, w00, w01);
            GP_BAR; GP_WAIT_L(0); GP_MMA(1, 0, At, B0); GP_BAR; GP_SCHED;
            GP_STAGE(GP_SB(1, 1), b3 + whB, wB0, wB1);
            GP_WAIT_V(6); GP_BAR; GP_MMA(1, 1, At, B1); GP_BAR;
            if ((GATHER || VS) && last) { g00 = w00; g01 = w01; g10 = w10; g11 = w11; }
            if (VS && last) { voffB[0] = wB0; voffB[1] = wB1; hA = whA; hB = whB; }
        }
        { int fr_e = fr, fq_e = fq; asm volatile("" : "+v"(fr_e), "+v"(fq_e));
          E(acc, cur, wr, wc, fr_e, fq_e); }
        if (!has_next) break;
#pragma unroll
        for (int a = 0; a < 2; ++a)
#pragma unroll
            for (int b = 0; b < 2; ++b)
#pragma unroll
                for (int m = 0; m < 4; ++m)
#pragma unroll
                    for (int n = 0; n < 2; ++n) acc[a][b][m][n] = (f32x4){0.f, 0.f, 0.f, 0.f};
        cur = nxt; cA = nA; cB = nB; ++ui;
    }
    GP_WAIT_V(0);
    if (wr == 0) GP_BAR;
    GP_BAR;
#undef GP_SA
#undef GP_SB
#undef GP_STAGE
#undef GP_LDA
#undef GP_LDB
#undef GP_MMA
#undef GP_WAIT_V
#undef GP_WAIT_L
#undef GP_BAR
#undef GP_SCHED
#undef GP_GOFF
}
}

struct SchedStd {
    static constexpr bool GATHER = false; static constexpr bool VARSTRIDE = false;
    const bf16_t* A; const bf16_t* Bt; int K, nM, nN, G_, c, skipctx, lda2, ldb2;
    __device__ __forceinline__ bool next(int i, gp::GUnit& u) const {
        int pmv, pn; if (!gp::tile_order(i, G_, c, nM, nN, pmv, pn)) return false;
        const int pm = skipctx ? pmv + pmv / 32 : pmv;
        u.A = (const char*)(A + (size_t)pm * 256 * K); u.B = (const char*)(Bt + (size_t)pn * 256 * K); u.nt = K / 64; u.pm = pm; u.pn = pn; u.tag = 0; u.goff = nullptr; return true;
    }
};

__device__ __forceinline__ float fexp(float x) { return __builtin_amdgcn_exp2f(x * LOG2E); }
__device__ __forceinline__ float flog(float x) { return __builtin_amdgcn_logf(x) * 0.6931471805599453f; }
__device__ __forceinline__ float fsigmoid(float x) { return __builtin_amdgcn_rcpf(1.f + fexp(-x)); }
__device__ __forceinline__ float logf_gate_fast(float z, float lb) {
    if (lb <= 0.f) return fminf(z, 0.f) - flog(1.f + fexp(-fabsf(z)));
    return flog(lb + (1.f - lb) * fsigmoid(z));
}
__device__ __forceinline__ unsigned pkh2(float lo, float hi) { const f16_t a = (f16_t)lo, b = (f16_t)hi; return (unsigned)__builtin_bit_cast(unsigned short, a) | ((unsigned)__builtin_bit_cast(unsigned short, b) << 16); }

template <class T> __device__ __forceinline__ T* opq(T* p) { asm volatile("" : "+s"(p)); return p; }
struct EpiG1 {
    static constexpr bool PERM = true;
    bf16_t *AQ, *AK, *AV, *BQ, *BV, *BG; f16_t *BLF, *BLB; bf16_t *CQKV, *CKR; float* RS; const float *ropa_c, *ropa_s, *ropc_c, *ropc_s; const float* LBl; int rowoff;
    __device__ __forceinline__ void operator()(const f32x4 (&acc)[2][2][4][2], const gp::GUnit& u, int wr, int wc, int fr, int fq) const {
        const int pn = u.pn; const int pr = u.pm % 33; const bool lat = pr < 32;
        const int grow0 = u.pm * 256 + wr * 64 + fr; const int t0 = pr * 256 + wr * 64 + fr;
        if (pn < 3) {
            const int hh = pn * 4 + wc; bf16_t* dst; int ld, coff; bf16_t* const aq_ = opq(AQ); bf16_t* const ak_ = opq(AK); bf16_t* const av_ = opq(AV);
            if (hh < 8) { dst = aq_; ld = 512; coff = hh * 64; } else if (hh < 10) { dst = ak_; ld = 128; coff = (hh - 8) * 64; } else { dst = av_; ld = 128; coff = (hh - 10) * 64; }
            const bool rope = lat && hh < 10;
#pragma unroll
            for (int ai = 0; ai < 2; ++ai)
#pragma unroll
                for (int m = 0; m < 4; ++m) { const int grow = grow0 + ai * 128 + m * 16, t = t0 + ai * 128 + m * 16; const size_t row = (size_t)(grow - rowoff);
                    f32x4 x1a = acc[ai][0][m][0], x1b = acc[ai][0][m][1], x2a = acc[ai][1][m][0], x2b = acc[ai][1][m][1];
                    if (rope) { const f32x4 ca = *(const f32x4*)(ropa_c + t * 32 + 8 * fq), cb = *(const f32x4*)(ropa_c + t * 32 + 8 * fq + 4), sa = *(const f32x4*)(ropa_s + t * 32 + 8 * fq), sb = *(const f32x4*)(ropa_s + t * 32 + 8 * fq + 4);
                        const f32x4 o1a = x1a * ca - x2a * sa, o2a = x1a * sa + x2a * ca, o1b = x1b * cb - x2b * sb, o2b = x1b * sb + x2b * cb; x1a = o1a; x2a = o2a; x1b = o1b; x2b = o2b; }
                    if (hh < 8) { const float qs = 0.125f * LOG2E; x1a *= qs; x1b *= qs; x2a *= qs; x2b *= qs; }
                    bf16_t* p = dst + row * ld + coff + 8 * fq;
                    u32x4 w1, w2; w1.x = gp::cvt_pk_bf16(x1a[0], x1a[1]); w1.y = gp::cvt_pk_bf16(x1a[2], x1a[3]); w1.z = gp::cvt_pk_bf16(x1b[0], x1b[1]); w1.w = gp::cvt_pk_bf16(x1b[2], x1b[3]);
                    w2.x = gp::cvt_pk_bf16(x2a[0], x2a[1]); w2.y = gp::cvt_pk_bf16(x2a[2], x2a[3]); w2.z = gp::cvt_pk_bf16(x2b[0], x2b[1]); w2.w = gp::cvt_pk_bf16(x2b[2], x2b[3]);
                    *(u32x4*)p = w1; *(u32x4*)(p + 32) = w2; if (m == 3) asm volatile("" ::: "memory"); }
        } else if (pn < 13) {
            const int q = pn - 3, which = q >> 1; const int cb0 = (q & 1) * 256 + wc * 32 + 8 * fq;
            if (which == 2 || which == 3) {
                f16_t* const blf_ = opq(BLF); f16_t* const blb_ = opq(BLB); f16_t* dst = which == 2 ? blf_ : blb_; const float* lbp = LBl + (which == 2 ? 0 : 512);
#pragma unroll
                for (int bj = 0; bj < 2; ++bj) { const int c0 = cb0 + bj * 128; const f32x4 la = *(const f32x4*)(lbp + c0), lb4 = *(const f32x4*)(lbp + c0 + 4);
#pragma unroll
                    for (int ai = 0; ai < 2; ++ai)
#pragma unroll
                        for (int m = 0; m < 4; ++m) { const size_t row = (size_t)(grow0 + ai * 128 + m * 16 - rowoff); const f32x4 v0 = acc[ai][bj][m][0], v1 = acc[ai][bj][m][1];
                            u32x4 w; w.x = pkh2(logf_gate_fast(v0[0], la[0]), logf_gate_fast(v0[1], la[1])); w.y = pkh2(logf_gate_fast(v0[2], la[2]), logf_gate_fast(v0[3], la[3]));
                            w.z = pkh2(logf_gate_fast(v1[0], lb4[0]), logf_gate_fast(v1[1], lb4[1])); w.w = pkh2(logf_gate_fast(v1[2], lb4[2]), logf_gate_fast(v1[3], lb4[3]));
                            *(u32x4*)(dst + row * 512 + c0) = w; } }
            } else {
                bf16_t* const bq_ = opq(BQ); bf16_t* const bv_ = opq(BV); bf16_t* const bg_ = opq(BG); bf16_t* dst = which == 0 ? bq_ : (which == 1 ? bv_ : bg_);
#pragma unroll
                for (int ai = 0; ai < 2; ++ai)
#pragma unroll
                    for (int m = 0; m < 4; ++m) { const size_t row = (size_t)(grow0 + ai * 128 + m * 16 - rowoff);
#pragma unroll
                        for (int bj = 0; bj < 2; ++bj) { const f32x4 v0 = acc[ai][bj][m][0], v1 = acc[ai][bj][m][1];
                            u32x4 w; w.x = gp::cvt_pk_bf16(v0[0], v0[1]); w.y = gp::cvt_pk_bf16(v0[2], v0[3]); w.z = gp::cvt_pk_bf16(v1[0], v1[1]); w.w = gp::cvt_pk_bf16(v1[2], v1[3]);
                            *(u32x4*)(dst + row * 512 + cb0 + bj * 128) = w; } }
            }
        } else if (pn == 13) {
#pragma unroll
            for (int ai = 0; ai < 2; ++ai)
#pragma unroll
                for (int m = 0; m < 4; ++m) { const int grow = grow0 + ai * 128 + m * 16; const size_t row = (size_t)(grow - rowoff); float ss = 0.f;
#pragma unroll
                    for (int bj = 0; bj < 2; ++bj) { const f32x4 v0 = acc[ai][bj][m][0], v1 = acc[ai][bj][m][1];
                        ss += v0[0] * v0[0] + v0[1] * v0[1] + v0[2] * v0[2] + v0[3] * v0[3] + v1[0] * v1[0] + v1[1] * v1[1] + v1[2] * v1[2] + v1[3] * v1[3];
                        u32x4 w; w.x = gp::cvt_pk_bf16(v0[0], v0[1]); w.y = gp::cvt_pk_bf16(v0[2], v0[3]); w.z = gp::cvt_pk_bf16(v1[0], v1[1]); w.w = gp::cvt_pk_bf16(v1[2], v1[3]);
                        *(u32x4*)(CQKV + row * 384 + bj * 128 + wc * 32 + 8 * fq) = w; }
                    ss += shxl(ss, 16, fr | (fq << 4)); ss += shxl(ss, 32, fr | (fq << 4));
                    if (fq == 0) RS[(size_t)grow * 8 + wc] = ss; }
        } else {
#pragma unroll
            for (int ai = 0; ai < 2; ++ai)
#pragma unroll
                for (int m = 0; m < 4; ++m) { const int grow = grow0 + ai * 128 + m * 16, t = t0 + ai * 128 + m * 16; const size_t row = (size_t)(grow - rowoff);
                    const f32x4 v0 = acc[ai][0][m][0], v1 = acc[ai][0][m][1];
                    float ss = v0[0] * v0[0] + v0[1] * v0[1] + v0[2] * v0[2] + v0[3] * v0[3] + v1[0] * v1[0] + v1[1] * v1[1] + v1[2] * v1[2] + v1[3] * v1[3];
                    u32x4 w; w.x = gp::cvt_pk_bf16(v0[0], v0[1]); w.y = gp::cvt_pk_bf16(v0[2], v0[3]); w.z = gp::cvt_pk_bf16(v1[0], v1[1]); w.w = gp::cvt_pk_bf16(v1[2], v1[3]);
                    *(u32x4*)(CQKV + row * 384 + 256 + wc * 32 + 8 * fq) = w;
                    ss += shxl(ss, 16, fr | (fq << 4)); ss += shxl(ss, 32, fr | (fq << 4));
                    if (fq == 0) RS[(size_t)grow * 8 + 4 + wc] = ss;
                    if (wc == 0) { f32x4 x1 = acc[ai][1][m][0], x2 = acc[ai][1][m][1];
                        if (lat) { const f32x4 cc = *(const f32x4*)(ropc_c + t * 16 + 4 * fq), sn = *(const f32x4*)(ropc_s + t * 16 + 4 * fq); const f32x4 o1 = x1 * cc - x2 * sn, o2 = x1 * sn + x2 * cc; x1 = o1; x2 = o2; }
                        *(uint2*)(CKR + row * 32 + 4 * fq) = make_uint2(gp::cvt_pk_bf16(x1[0], x1[1]), gp::cvt_pk_bf16(x1[2], x1[3]));
                        *(uint2*)(CKR + row * 32 + 16 + 4 * fq) = make_uint2(gp::cvt_pk_bf16(x2[0], x2[1]), gp::cvt_pk_bf16(x2[2], x2[3])); } }
        }
    }
};

struct EpiC {
    static constexpr bool PERM = true;
    bf16_t *CQ, *CKV; const float* RS; const float *ropc_c, *ropc_s; int pmoff;
    __device__ __forceinline__ void operator()(const f32x4 (&acc)[2][2][4][2], const gp::GUnit& u, int wr, int wc, int fr, int fq) const {
        const int pn = u.pn; const int pr = (u.pm + pmoff) % 33; const bool lat = pr < 32;
        const int grow0 = u.pm * 256 + wr * 64 + fr; const int t0 = pr * 256 + wr * 64 + fr;
        f32x4 rs4[2][4];
#pragma unroll
        for (int ai = 0; ai < 2; ++ai)
#pragma unroll
            for (int m = 0; m < 4; ++m) rs4[ai][m] = *(const f32x4*)(RS + (size_t)(grow0 + ai * 128 + m * 16) * 8 + (pn < 3 ? 0 : 4));
#pragma unroll
        for (int ai = 0; ai < 2; ++ai)
#pragma unroll
            for (int m = 0; m < 4; ++m) { const size_t row = (size_t)(grow0 + ai * 128 + m * 16); const int t = t0 + ai * 128 + m * 16;
                if (pn < 3) { const f32x4 p4 = rs4[ai][m]; const float rq = rsqrtf(((p4[0] + p4[1]) + (p4[2] + p4[3])) * (1.f / 256.f) + EPS) * (0.10206207261596577f * LOG2E);
#pragma unroll
                    for (int bj = 0; bj < 2; ++bj) { const int gi = pn * 8 + bj * 4 + wc, head = gi / 3, part = gi - head * 3;
                        f32x4 v0 = acc[ai][bj][m][0] * rq, v1 = acc[ai][bj][m][1] * rq;
                        bf16_t* p = CQ + row * 768 + head * 96;
                        if (part < 2) { u32x4 w; w.x = gp::cvt_pk_bf16(v0[0], v0[1]); w.y = gp::cvt_pk_bf16(v0[2], v0[3]); w.z = gp::cvt_pk_bf16(v1[0], v1[1]); w.w = gp::cvt_pk_bf16(v1[2], v1[3]);
                            *(u32x4*)(p + part * 32 + 8 * fq) = w; }
                        else { if (lat) { const f32x4 cc = *(const f32x4*)(ropc_c + t * 16 + 4 * fq), sn = *(const f32x4*)(ropc_s + t * 16 + 4 * fq); const f32x4 o1 = v0 * cc - v1 * sn, o2 = v0 * sn + v1 * cc; v0 = o1; v1 = o2; }
                            *(uint2*)(p + 64 + 4 * fq) = make_uint2(gp::cvt_pk_bf16(v0[0], v0[1]), gp::cvt_pk_bf16(v0[2], v0[3]));
                            *(uint2*)(p + 80 + 4 * fq) = make_uint2(gp::cvt_pk_bf16(v1[0], v1[1]), gp::cvt_pk_bf16(v1[2], v1[3])); } }
                } else { const f32x4 p4 = rs4[ai][m]; const float rkv = rsqrtf(((p4[0] + p4[1]) + (p4[2] + p4[3])) * (1.f / 128.f) + EPS);
#pragma unroll
                    for (int bj = 0; bj < 2; ++bj) { const f32x4 v0 = acc[ai][bj][m][0] * rkv, v1 = acc[ai][bj][m][1] * rkv;
                        u32x4 w; w.x = gp::cvt_pk_bf16(v0[0], v0[1]); w.y = gp::cvt_pk_bf16(v0[2], v0[3]); w.z = gp::cvt_pk_bf16(v1[0], v1[1]); w.w = gp::cvt_pk_bf16(v1[2], v1[3]);
                        *(u32x4*)(CKV + row * 1024 + (pn - 3) * 256 + bj * 128 + wc * 32 + 8 * fq) = w; } } }
    }
};
struct EpiGate {
    static constexpr bool PERM = true;
    bf16_t* GATE; long nstride; int ld;
    __device__ __forceinline__ void operator()(const f32x4 (&acc)[2][2][4][2], const gp::GUnit& u, int wr, int wc, int fr, int fq) const {
        const int n3 = u.pn >> 2; bf16_t* base = GATE + (size_t)n3 * nstride + (u.pn & 3) * 256 + wc * 32 + 8 * fq; const int row0 = u.pm * 256 + wr * 64 + fr;
#pragma unroll
        for (int ai = 0; ai < 2; ++ai)
#pragma unroll
            for (int m = 0; m < 4; ++m) { bf16_t* rp = base + (size_t)(row0 + ai * 128 + m * 16) * ld;
#pragma unroll
                for (int bj = 0; bj < 2; ++bj) { const f32x4 v0 = acc[ai][bj][m][0], v1 = acc[ai][bj][m][1];
                    u32x4 w; w.x = gp::cvt_pk_bf16(fsigmoid(v0[0]), fsigmoid(v0[1])); w.y = gp::cvt_pk_bf16(fsigmoid(v0[2]), fsigmoid(v0[3])); w.z = gp::cvt_pk_bf16(fsigmoid(v1[0]), fsigmoid(v1[1])); w.w = gp::cvt_pk_bf16(fsigmoid(v1[2]), fsigmoid(v1[3]));
                    *(u32x4*)(rp + bj * 128) = w; } }
    }
};
struct SchedMerge {
    static constexpr bool GATHER = false; static constexpr bool VARSTRIDE = false;
    const bf16_t *A0, *A1, *A2; const bf16_t* Bt; int nM, G_, c, skipctx, lda2, ldb2;
    __device__ __forceinline__ bool next(int i, gp::GUnit& u) const {
        int pmv, pn12; if (!gp::tile_order(i, G_, c, nM, 12, pmv, pn12)) return false;
        const int n = pn12 >> 2, pn = pn12 & 3;
        const int pm = skipctx ? pmv + pmv / 32 : pmv;
        const bf16_t* a0 = opq(A0); const bf16_t* a1 = opq(A1); const bf16_t* a2 = opq(A2);
        const bf16_t* a = n == 0 ? a0 : (n == 1 ? a1 : a2);
        u.A = (const char*)(a + (size_t)pm * 256 * 512); u.B = (const char*)(Bt + (size_t)n * 1024 * 512 + (size_t)pn * 256 * 512); u.nt = 8; u.pm = pm; u.pn = pn; u.tag = n; u.goff = nullptr; return true;
    }
};
__device__ __forceinline__ float bflo(unsigned w) { return __uint_as_float(w << 16); }
__device__ __forceinline__ float bfhi(unsigned w) { return __uint_as_float(w & 0xffff0000u); }
struct EpiMerge {
    static constexpr bool PERM = true;
    bf16_t* GATE; long nstride; int ld;
    __device__ __forceinline__ void operator()(const f32x4 (&acc)[2][2][4][2], const gp::GUnit& u, int wr, int wc, int fr, int fq) const {
        if (PROBE_VARIANT == 3 && ld < 0) return;
        const int n3 = u.tag; const int col = u.pn * 256 + wc * 32 + 8 * fq; bf16_t* gb = GATE + (size_t)n3 * nstride + col; const int row0 = u.pm * 256 + wr * 64 + fr;
#pragma unroll
        for (int ai = 0; ai < 2; ++ai) { u32x4 g[4][2];
#pragma unroll
            for (int m = 0; m < 4; ++m)
#pragma unroll
                for (int bj = 0; bj < 2; ++bj) g[m][bj] = *(const u32x4*)(gb + (size_t)(row0 + ai * 128 + m * 16) * ld + bj * 128);
#pragma unroll
            for (int m = 0; m < 4; ++m)
#pragma unroll
                for (int bj = 0; bj < 2; ++bj) { const u32x4 gg = g[m][bj]; const f32x4 v0 = acc[ai][bj][m][0], v1 = acc[ai][bj][m][1];
                    u32x4 w; w.x = gp::cvt_pk_bf16(v0[0] * bflo(gg.x), v0[1] * bfhi(gg.x)); w.y = gp::cvt_pk_bf16(v0[2] * bflo(gg.y), v0[3] * bfhi(gg.y));
                    w.z = gp::cvt_pk_bf16(v1[0] * bflo(gg.z), v1[1] * bfhi(gg.z)); w.w = gp::cvt_pk_bf16(v1[2] * bflo(gg.w), v1[3] * bfhi(gg.w));
                    *(u32x4*)(gb + (size_t)(row0 + ai * 128 + m * 16) * ld + bj * 128) = w; }
            asm volatile("" ::: "memory"); }
    }
};
struct SchedGM {
    static constexpr bool GATHER = false; static constexpr bool VARSTRIDE = true;
    const bf16_t *A0, *A1, *A2, *Ag; const bf16_t *Bbr, *Bg; int nM, G_, c, skipctx, lda2, ldb2;
    __device__ __forceinline__ bool next(int i, gp::GUnit& u) const {
        int pmv, pn12; if (!gp::tile_order(i >> 1, G_, c, nM, 12, pmv, pn12)) return false;
        const int kind = i & 1, n = pn12 >> 2, pn = pn12 & 3;
        const int pm = skipctx ? pmv + pmv / 32 : pmv;
        const bf16_t* a0 = opq(A0); const bf16_t* a1 = opq(A1); const bf16_t* a2 = opq(A2); const bf16_t* ag = opq(Ag);
        const bf16_t* a = n == 0 ? a0 : (n == 1 ? a1 : a2);
        if (kind == 0) { u.A = (const char*)(a + (size_t)pm * 256 * 512); u.B = (const char*)(Bbr + (size_t)n * 1024 * 512 + (size_t)pn * 256 * 512); u.nt = 8; u.lda2 = 1024; u.ldb2 = 1024; }
        else { u.A = (const char*)(ag + (size_t)pm * 256 * 1024); u.B = (const char*)(Bg + (size_t)pn12 * 256 * 1024); u.nt = 16; u.lda2 = 2048; u.ldb2 = 2048; }
        u.pm = pm; u.pn = pn; u.tag = n + 4 * kind; u.goff = nullptr; return true;
    }
};
struct EpiGM {
    static constexpr bool PERM = true;
    bf16_t* U; long nstride; int ld;
    __device__ __forceinline__ void operator()(const f32x4 (&acc)[2][2][4][2], const gp::GUnit& u, int wr, int wc, int fr, int fq) const {
        const int n3 = u.tag & 3; const int col = u.pn * 256 + wc * 32 + 8 * fq; bf16_t* gb = U + (size_t)n3 * nstride + col; const int row0 = u.pm * 256 + wr * 64 + fr;
        if (u.tag < 4) {
#pragma unroll
            for (int ai = 0; ai < 2; ++ai)
#pragma unroll
                for (int m = 0; m < 4; ++m)
#pragma unroll
                    for (int bj = 0; bj < 2; ++bj) { const f32x4 v0 = acc[ai][bj][m][0], v1 = acc[ai][bj][m][1];
                        u32x4 w; w.x = gp::cvt_pk_bf16(v0[0], v0[1]); w.y = gp::cvt_pk_bf16(v0[2], v0[3]); w.z = gp::cvt_pk_bf16(v1[0], v1[1]); w.w = gp::cvt_pk_bf16(v1[2], v1[3]);
                        *(u32x4*)(gb + (size_t)(row0 + ai * 128 + m * 16) * ld + bj * 128) = w; }
        } else {
#pragma unroll
            for (int ai = 0; ai < 2; ++ai) { u32x4 z[4][2];
#pragma unroll
                for (int m = 0; m < 4; ++m)
#pragma unroll
                    for (int bj = 0; bj < 2; ++bj) z[m][bj] = *(const u32x4*)(gb + (size_t)(row0 + ai * 128 + m * 16) * ld + bj * 128);
#pragma unroll
                for (int m = 0; m < 4; ++m)
#pragma unroll
                    for (int bj = 0; bj < 2; ++bj) { const u32x4 zz = z[m][bj]; const f32x4 v0 = acc[ai][bj][m][0], v1 = acc[ai][bj][m][1];
                        u32x4 w; w.x = gp::cvt_pk_bf16(fsigmoid(v0[0]) * bflo(zz.x), fsigmoid(v0[1]) * bfhi(zz.x)); w.y = gp::cvt_pk_bf16(fsigmoid(v0[2]) * bflo(zz.y), fsigmoid(v0[3]) * bfhi(zz.y));
                        w.z = gp::cvt_pk_bf16(fsigmoid(v1[0]) * bflo(zz.z), fsigmoid(v1[1]) * bfhi(zz.z)); w.w = gp::cvt_pk_bf16(fsigmoid(v1[2]) * bflo(zz.w), fsigmoid(v1[3]) * bfhi(zz.w));
                        *(u32x4*)(gb + (size_t)(row0 + ai * 128 + m * 16) * ld + bj * 128) = w; }
                asm volatile("" ::: "memory"); }
        }
    }
};
struct EpiOut {
    static constexpr bool PERM = false;
    const float *xl_src, *xc_src; float *xl_dst, *xc_dst; const float* mod; int pmoff;
    __device__ __forceinline__ void operator()(const f32x4 (&acc)[2][2][4][2], const gp::GUnit& u, int wr, int wc, int fr, int fq) const {
        const int gpm = u.pm + pmoff, b = gpm / 33, pr = gpm - b * 33; const bool lat = pr < 32;
        const float* xs = opq(lat ? xl_src : xc_src); float* xd = opq(lat ? xl_dst : xc_dst);
        const size_t rbase = lat ? ((size_t)b * SEQ + pr * 256) : ((size_t)b * CTXL);
        const float* gt = mod + (size_t)(lat ? b : 4) * 6144 + 2048; const int col0 = u.pn * 256 + wc * 32 + 4 * fq;
        f32x4 g4[2][2];
#pragma unroll
        for (int bj = 0; bj < 2; ++bj)
#pragma unroll
            for (int n = 0; n < 2; ++n) g4[bj][n] = *(const f32x4*)(gt + col0 + bj * 128 + n * 16);
#pragma unroll
        for (int ai = 0; ai < 2; ++ai) { f32x4 xv[4][2][2];
#pragma unroll
            for (int m = 0; m < 4; ++m) { const size_t off = (rbase + ai * 128 + wr * 64 + m * 16 + fr) * D + col0;
#pragma unroll
                for (int bj = 0; bj < 2; ++bj)
#pragma unroll
                    for (int n = 0; n < 2; ++n) xv[m][bj][n] = *(const f32x4*)(xs + off + bj * 128 + n * 16); }
#pragma unroll
            for (int m = 0; m < 4; ++m) { const size_t off = (rbase + ai * 128 + wr * 64 + m * 16 + fr) * D + col0;
#pragma unroll
                for (int bj = 0; bj < 2; ++bj)
#pragma unroll
                    for (int n = 0; n < 2; ++n) *(f32x4*)(xd + off + bj * 128 + n * 16) = xv[m][bj][n] + g4[bj][n] * acc[ai][bj][m][n]; }
            asm volatile("" ::: "memory"); }
    }
};
template <bool GATHER_> struct SchedMoE {
    static constexpr bool GATHER = GATHER_; static constexpr bool VARSTRIDE = false;
    const bf16_t* A; const bf16_t* Bt; const int* tile_e; const unsigned* goff; int K, nM, nN, G_, c, lda2, ldb2; long strideB;
    __device__ __forceinline__ bool next(int i, gp::GUnit& u) const {
        int pm, pn; if (!gp::tile_order(i, G_, c, nM, nN, pm, pn)) return false;
        const int e = tile_e[pm];
        u.A = GATHER ? (const char*)A : (const char*)(A + (size_t)pm * 256 * K); u.B = (const char*)(Bt + (size_t)e * strideB + (size_t)pn * 256 * K); u.nt = K / 64; u.pm = pm; u.pn = pn; u.tag = e;
        u.goff = GATHER ? goff + (size_t)pm * 256 : nullptr; return true;
    }
};
struct EpiUp {
    static constexpr bool PERM = true;
    bf16_t* AUP;
    __device__ __forceinline__ void operator()(const f32x4 (&acc)[2][2][4][2], const gp::GUnit& u, int wr, int wc, int fr, int fq) const {
        const int row0 = u.pm * 256 + wr * 64 + fr; bf16_t* base = AUP + u.pn * 128 + wc * 32 + 8 * fq;
#pragma unroll
        for (int ai = 0; ai < 2; ++ai)
#pragma unroll
            for (int m = 0; m < 4; ++m) { const f32x4 a0 = acc[ai][0][m][0], a1 = acc[ai][0][m][1], b0 = acc[ai][1][m][0], b1 = acc[ai][1][m][1];
                float r[8];
#pragma unroll
                for (int e = 0; e < 4; ++e) { r[e] = a0[e] * fsigmoid(a0[e]) * b0[e]; r[4 + e] = a1[e] * fsigmoid(a1[e]) * b1[e]; }
                u32x4 w; w.x = gp::cvt_pk_bf16(r[0], r[1]); w.y = gp::cvt_pk_bf16(r[2], r[3]); w.z = gp::cvt_pk_bf16(r[4], r[5]); w.w = gp::cvt_pk_bf16(r[6], r[7]);
                *(u32x4*)(base + (size_t)(row0 + ai * 128 + m * 16) * 256) = w; }
    }
};
struct EpiDown {
    static constexpr bool PERM = true;
    bf16_t* YM2; const int* perm; const float* posw;
    __device__ __forceinline__ void operator()(const f32x4 (&acc)[2][2][4][2], const gp::GUnit& u, int wr, int wc, int fr, int fq) const {
        const int row0 = u.pm * 256 + wr * 64 + fr; const int col = u.pn * 256 + wc * 32 + 8 * fq;
        int pe8[2][4]; float w88[2][4];
#pragma unroll
        for (int ai = 0; ai < 2; ++ai)
#pragma unroll
            for (int m = 0; m < 4; ++m) { const int pos = row0 + ai * 128 + m * 16; pe8[ai][m] = perm[pos]; w88[ai][m] = posw[pos]; }
#pragma unroll
        for (int ai = 0; ai < 2; ++ai)
#pragma unroll
            for (int m = 0; m < 4; ++m) { const int pe = pe8[ai][m]; const float w8 = w88[ai][m];
                if (pe >= 0) {
#pragma unroll
                    for (int bj = 0; bj < 2; ++bj) { const f32x4 v0 = acc[ai][bj][m][0] * w8, v1 = acc[ai][bj][m][1] * w8;
                        u32x4 w; w.x = gp::cvt_pk_bf16(v0[0], v0[1]); w.y = gp::cvt_pk_bf16(v0[2], v0[3]); w.z = gp::cvt_pk_bf16(v1[0], v1[1]); w.w = gp::cvt_pk_bf16(v1[2], v1[3]);
                        *(u32x4*)(YM2 + (size_t)pe * 1024 + col + bj * 128) = w; } } }
    }
};
enum { MAP_WIN = 1, MAP_WC = 2, MAP_WUP = 3 };
__device__ __forceinline__ int colmap(int kind, int p) {
    if (kind == MAP_WIN) {
        if (p >= 3840) return MIXW + (p - 3840);
        const int pn = p >> 8, q = p & 255, bj = q >> 7, wc = (q >> 5) & 3, j = q & 31;
        if (pn < 3) return (pn * 4 + wc) * 64 + bj * 32 + j;
        if (pn < 14) return p;
        if (bj == 0) return p;
        if (wc != 0) return -1;
        return 3712 + 16 * ((j >> 2) & 1) + 4 * (j >> 3) + (j & 3);
    }
    return p;
}
constexpr int NCHK = RPB / 64;
struct ScanArgs { const bf16_t* BQ; const bf16_t* BV; const bf16_t* BG; const f16_t* BLF; const f16_t* BLB; bf16_t* ST; float* DS; bf16_t* OB; const float* gn; int in_off; int out_off; int skipctx_out; int pad; };
#define MFMA16(a, b, c) __builtin_amdgcn_mfma_f32_16x16x32_bf16(a, b, c, 0, 0, 0)
constexpr int BCS = 68;
constexpr int SC_RAW = 0, SC_VT = 2 * 64 * BCS * 4, SC_A = SC_VT + 9216;
typedef _Float16 sc_h8 __attribute__((ext_vector_type(8)));
struct StageRegs { sc_h8 lf, lb; bf16x8 v; };
__device__ __forceinline__ void scan_stage_load(const ScanArgs& a, size_t row0, int h, int tid, StageRegs& R) {
    const int row = tid >> 3, c8 = (tid & 7) * 8; const size_t off = (row0 + row) * 512 + h * 64 + c8;
    R.lf = *(const sc_h8*)(a.BLF + off); R.lb = *(const sc_h8*)(a.BLB + off);
    const int vrow = tid & 63, vc8 = (tid >> 6) * 8; R.v = *(const bf16x8*)(a.BV + (row0 + vrow) * 512 + h * 64 + vc8);
}
__device__ __forceinline__ void scan_stage_store(LAS char* lds, int tid, const StageRegs& R) {
    LAS float* RAW = (LAS float*)(lds + SC_RAW); LAS bf16_t* VT = (LAS bf16_t*)(lds + SC_VT);
    const int row = tid >> 3, c8 = (tid & 7) * 8; const int vrow = tid & 63, vc8 = (tid >> 6) * 8; const sc_h8 lf = R.lf, lb = R.lb; const bf16x8 v = R.v;
    *(LAS f32x4*)(RAW + row * BCS + c8) = (f32x4){(float)lf[0], (float)lf[1], (float)lf[2], (float)lf[3]}; *(LAS f32x4*)(RAW + row * BCS + c8 + 4) = (f32x4){(float)lf[4], (float)lf[5], (float)lf[6], (float)lf[7]};
    *(LAS f32x4*)(RAW + 64 * BCS + row * BCS + c8) = (f32x4){(float)lb[0], (float)lb[1], (float)lb[2], (float)lb[3]}; *(LAS f32x4*)(RAW + 64 * BCS + row * BCS + c8 + 4) = (f32x4){(float)lb[4], (float)lb[5], (float)lb[6], (float)lb[7]};
#pragma unroll
    for (int j = 0; j < 8; ++j) VT[(vc8 + j) * 72 + vrow] = (bf16_t)v[j];
}
__device__ __forceinline__ void scan_stage(LAS char* lds, const ScanArgs& a, size_t row0, int h, int tid) { StageRegs R; scan_stage_load(a, row0, h, tid, R); scan_stage_store(lds, tid, R); }
__device__ __forceinline__ void scan_cumsum(LAS char* lds, LAS float* XCH, int tid, float (&lf)[16], float (&bc)[16], float& total) {
    LAS float* RAW = (LAS float*)(lds + SC_RAW);
    const int col = tid & 127, dir = col >> 6, d = col & 63, seg = tid >> 7;
#pragma unroll
    for (int j = 0; j < 16; ++j) lf[j] = RAW[dir * 64 * BCS + (16 * seg + j) * BCS + d];
    if (dir == 0) { float c = 0.f;
#pragma unroll
        for (int j = 0; j < 16; ++j) { c += lf[j]; bc[j] = c; } }
    else { float c = 0.f;
#pragma unroll
        for (int j = 15; j >= 0; --j) { c += lf[j]; bc[j] = c; } }
    XCH[seg * 128 + col] = dir == 0 ? bc[15] : bc[0];
    __syncthreads();
    const float t0 = XCH[col], t1 = XCH[128 + col], t2 = XCH[256 + col], t3 = XCH[384 + col];
    total = (t0 + t1) + (t2 + t3);
    float off;
    if (dir == 0) off = seg == 0 ? 0.f : (seg == 1 ? t0 : (seg == 2 ? t0 + t1 : t0 + t1 + t2));
    else off = seg == 3 ? 0.f : (seg == 2 ? t3 : (seg == 1 ? t3 + t2 : t3 + t2 + t1));
#pragma unroll
    for (int j = 0; j < 16; ++j) bc[j] += off;
}
__device__ __forceinline__ void scan_s1_unit(LAS char* lds, const ScanArgs& a, int wv0, int b, int h, int k, bool hasnext, int nb, int nh, int nk) {
    const int tid = opaque_tid(wv0), lane = tid & 63, wid = tid >> 6;
    LAS bf16_t* VT = (LAS bf16_t*)(lds + SC_VT); LAS bf16_t* KKT = (LAS bf16_t*)(lds + SC_A); LAS float* XCH = (LAS float*)(lds + SC_A + 18432);
    const size_t row0 = (size_t)b * RPB + 64 * k - a.in_off;
    __syncthreads();
    float lf[16], bc[16], total; scan_cumsum(lds, XCH, tid, lf, bc, total);
    const int col = tid & 127, dir = col >> 6, d = col & 63, seg = tid >> 7;
    const size_t sidx = ((size_t)((b * 8 + h) * 2 + dir)) * NCHK + k;
    { unsigned w[8];
#pragma unroll
      for (int j = 0; j < 16; j += 2) { const float k0 = (1.f - fexp(lf[j])) * fexp(total - bc[j]), k1 = (1.f - fexp(lf[j + 1])) * fexp(total - bc[j + 1]); w[j >> 1] = pkbf(k0, k1); }
      LAS u32x4* kp = (LAS u32x4*)(KKT + (dir * 64 + d) * 72 + 16 * seg); kp[0] = (u32x4){w[0], w[1], w[2], w[3]}; kp[1] = (u32x4){w[4], w[5], w[6], w[7]};
      if (seg == 0) a.DS[sidx * 64 + d] = fexp(total); }
    __syncthreads();
    StageRegs R; if (hasnext) scan_stage_load(a, (size_t)nb * RPB + 64 * nk - a.in_off, nh, tid, R);
    { const int wdir = wid >> 2, et = wid & 3, fr = lane & 15, fq = lane >> 4;
      f32x4 acc[4];
#pragma unroll
      for (int dt = 0; dt < 4; ++dt) acc[dt] = (f32x4){0.f, 0.f, 0.f, 0.f};
#pragma unroll
      for (int ks = 0; ks < 2; ++ks) { const bf16x8 af = *(const LAS bf16x8*)(VT + (16 * et + fr) * 72 + 32 * ks + 8 * fq);
#pragma unroll
          for (int dt = 0; dt < 4; ++dt) { const bf16x8 bfv = *(const LAS bf16x8*)(KKT + (wdir * 64 + 16 * dt + fr) * 72 + 32 * ks + 8 * fq); acc[dt] = MFMA16(af, bfv, acc[dt]); } }
      bf16_t* sp = a.ST + (((size_t)((b * 8 + h) * 2 + wdir)) * NCHK + k) * 4096;
#pragma unroll
      for (int dt = 0; dt < 4; ++dt)
#pragma unroll
          for (int r = 0; r < 4; ++r) sp[(16 * et + 4 * fq + r) * 64 + 16 * dt + fr] = f2bf(acc[dt][r]); }
    __syncthreads();
    if (hasnext) scan_stage_store(lds, tid, R);
}
__device__ __forceinline__ void scan_s2_task(const ScanArgs& a, int wv0, int task) {
    const int chain = task >> 2, quarter = task & 3, dir = chain & 1, tid = opaque_tid(wv0);
    const int e = 16 * quarter + (tid >> 5), d = 2 * (tid & 31);
    float s0 = 0.f, s1 = 0.f;
    for (int g = 0; g < NCHK; g += 12) {
        unsigned L[12]; float2 Dv[12]; unsigned* pp[12];
#pragma unroll
        for (int j = 0; j < 12; ++j) { const int step = g + j; const int k = dir == 0 ? (step < 4 ? 128 + step : step - 4) : (step < 4 ? 131 - step : 131 - step);
            const size_t idx = (size_t)chain * NCHK + k; pp[j] = (unsigned*)(a.ST + idx * 4096 + e * 64 + d); L[j] = *pp[j]; Dv[j] = *(const float2*)(a.DS + idx * 64 + d); }
#pragma unroll
        for (int j = 0; j < 12; ++j) { *pp[j] = pkbf(s0, s1); s0 = Dv[j].x * s0 + bflo(L[j]); s1 = Dv[j].y * s1 + bfhi(L[j]); }
    }
}
__device__ __forceinline__ void s3_state_load(const ScanArgs& a, int b, int h, int k, int tid, u32x4& s0, u32x4& s1) {
    const int sd = tid >> 8, e = (tid & 255) >> 2, c16 = (tid & 3) * 16; const bf16_t* sp = a.ST + (((size_t)((b * 8 + h) * 2 + sd)) * NCHK + k) * 4096 + e * 64 + c16; s0 = *(const u32x4*)sp; s1 = *(const u32x4*)(sp + 8); }
__device__ __forceinline__ void s3_state_store(LAS bf16_t* STL, int tid, const u32x4& s0, const u32x4& s1) {
    const int sd = tid >> 8, e = (tid & 255) >> 2, c16 = (tid & 3) * 16; LAS u32x4* dp = (LAS u32x4*)(STL + (sd * 64 + e) * 72 + c16); dp[0] = s0; dp[1] = s1; }
__device__ __forceinline__ void scan_s3_unit(LAS char* lds, const ScanArgs& a, int wv0, int b, int h, int k, bool hasnext, int nb, int nh, int nk) {
    const int tid = opaque_tid(wv0), lane = tid & 63, wid = tid >> 6;
    LAS float* BC = (LAS float*)(lds + SC_RAW); LAS bf16_t* VT = (LAS bf16_t*)(lds + SC_VT);
    LAS bf16_t* STL = (LAS bf16_t*)(lds + SC_A);
    LAS float* XCH = (LAS float*)(lds + SC_A + 18432);
    LAS float* OSUM = (LAS float*)(lds + SC_A + 18432 + 2048);
    LAS bf16_t* PW = (LAS bf16_t*)(lds + SC_A + 18432 + 2048 + 17408) + wid * 3456;
    const size_t row0 = (size_t)b * RPB + 64 * k - a.in_off;
    bf16x8 q0_, q1_; bf16_t gpre[16];
    { const int dir_ = wid >> 2, si_ = wid & 3, erow_ = lane >> 2, dg_ = (lane & 3) * 16, fr_ = lane & 15, fq_ = lane >> 4;
      const bf16_t* qp = a.BQ + (row0 + 16 * si_ + erow_) * 512 + h * 64 + dg_; q0_ = *(const bf16x8*)qp; q1_ = *(const bf16x8*)(qp + 8);
      if (dir_ == 1) {
#pragma unroll
          for (int n = 0; n < 4; ++n)
#pragma unroll
              for (int r = 0; r < 4; ++r) gpre[n * 4 + r] = a.BG[(row0 + 16 * si_ + 4 * fq_ + r) * 512 + h * 64 + 16 * n + fr_]; }
      else {
#pragma unroll
          for (int i = 0; i < 16; ++i) gpre[i] = 0; } }
    __syncthreads();
    { float lf[16], bc[16], total; scan_cumsum(lds, XCH, tid, lf, bc, total);
      const int col = tid & 127, dir = col >> 6, d = col & 63, seg = tid >> 7;
      __syncthreads();
#pragma unroll
      for (int j = 0; j < 16; ++j) BC[dir * 64 * BCS + (16 * seg + j) * BCS + d] = bc[j]; }
    __syncthreads();
    StageRegs Rn; u32x4 ns0, ns1;
    if (hasnext) { scan_stage_load(a, (size_t)nb * RPB + 64 * nk - a.in_off, nh, tid, Rn); s3_state_load(a, nb, nh, nk, tid, ns0, ns1); }
    const int dir = wid >> 2, si = wid & 3;
    LAS bf16_t* QP = PW; LAS bf16_t* KP = PW + 1152; LAS bf16_t* ATT = PW + 2304;
    const int erow = lane >> 2, dg = (lane & 3) * 16;
    const int fr = lane & 15, fq = lane >> 4;
    LAS const float* bcd = BC + dir * 64 * BCS;
    float refv[16];
    { const int rr = dir == 0 ? 16 * si - 1 : 16 * (si + 1);
#pragma unroll
      for (int j = 0; j < 16; j += 4) { f32x4 t4 = (f32x4){0.f, 0.f, 0.f, 0.f}; if (rr >= 0 && rr < 64) t4 = *(const LAS f32x4*)(bcd + rr * BCS + dg + j); refv[j] = t4[0]; refv[j + 1] = t4[1]; refv[j + 2] = t4[2]; refv[j + 3] = t4[3]; } }
    float qv[16], bq[16];
    {
#pragma unroll
      for (int j = 0; j < 8; ++j) { qv[j] = bf2f((bf16_t)q0_[j]); qv[8 + j] = bf2f((bf16_t)q1_[j]); }
#pragma unroll
      for (int j = 0; j < 16; j += 4) { const f32x4 t4 = *(const LAS f32x4*)(bcd + (16 * si + erow) * BCS + dg + j); bq[j] = t4[0]; bq[j + 1] = t4[1]; bq[j + 2] = t4[2]; bq[j + 3] = t4[3]; } }
    { unsigned w[8];
#pragma unroll
      for (int j = 0; j < 16; j += 2) w[j >> 1] = pkbf(qv[j] * fexp(bq[j] - refv[j]), qv[j + 1] * fexp(bq[j + 1] - refv[j + 1]));
      LAS u32x4* p = (LAS u32x4*)(QP + erow * 72 + dg); p[0] = (u32x4){w[0], w[1], w[2], w[3]}; p[1] = (u32x4){w[4], w[5], w[6], w[7]};
      LAS u32x4* z = (LAS u32x4*)(ATT + erow * 72 + dg); z[0] = (u32x4){0u, 0u, 0u, 0u}; z[1] = (u32x4){0u, 0u, 0u, 0u}; }
    const int j_lo = dir == 0 ? 0 : si, j_hi = dir == 0 ? si : 3;
    for (int jb = j_lo; jb <= j_hi; ++jb) {
        { const int sg = 16 * jb + erow; const int sn = dir == 0 ? sg - 1 : sg + 1; unsigned w[8];
#pragma unroll
          for (int j = 0; j < 16; j += 4) { const f32x4 bs4 = *(const LAS f32x4*)(bcd + sg * BCS + dg + j); f32x4 bn4 = (f32x4){0.f, 0.f, 0.f, 0.f}; if (sn >= 0 && sn < 64) bn4 = *(const LAS f32x4*)(bcd + sn * BCS + dg + j);
              float kk[4];
#pragma unroll
              for (int t = 0; t < 4; ++t) kk[t] = (1.f - fexp(bs4[t] - bn4[t])) * fexp(fminf(refv[j + t] - bs4[t], 60.f));
              w[j >> 1] = pkbf(kk[0], kk[1]); w[(j >> 1) + 1] = pkbf(kk[2], kk[3]); }
          LAS u32x4* p = (LAS u32x4*)(KP + erow * 72 + dg); p[0] = (u32x4){w[0], w[1], w[2], w[3]}; p[1] = (u32x4){w[4], w[5], w[6], w[7]}; }
        __builtin_amdgcn_wave_barrier(); asm volatile("s_waitcnt lgkmcnt(0)" ::: "memory");
        f32x4 c = (f32x4){0.f, 0.f, 0.f, 0.f};
#pragma unroll
        for (int ks = 0; ks < 2; ++ks) { const bf16x8 af = *(const LAS bf16x8*)(QP + fr * 72 + 32 * ks + 8 * fq), bfv = *(const LAS bf16x8*)(KP + fr * 72 + 32 * ks + 8 * fq); c = MFMA16(af, bfv, c); }
#pragma unroll
        for (int r = 0; r < 4; ++r) { const int tq = 4 * fq + r; float v = c[r];
            if (jb == si) { if (dir == 0 ? (fr > tq) : (fr < tq)) v = 0.f; }
            ATT[tq * 72 + 16 * jb + fr] = f2bf(v); }
        __builtin_amdgcn_wave_barrier(); asm volatile("s_waitcnt lgkmcnt(0)" ::: "memory");
    }
    { unsigned w[8];
#pragma unroll
      for (int j = 0; j < 16; j += 2) w[j >> 1] = pkbf(qv[j] * fexp(bq[j]), qv[j + 1] * fexp(bq[j + 1]));
      LAS u32x4* p = (LAS u32x4*)(QP + erow * 72 + dg); p[0] = (u32x4){w[0], w[1], w[2], w[3]}; p[1] = (u32x4){w[4], w[5], w[6], w[7]}; }
    __builtin_amdgcn_wave_barrier(); asm volatile("s_waitcnt lgkmcnt(0)" ::: "memory");
    f32x4 o[4];
#pragma unroll
    for (int n = 0; n < 4; ++n) o[n] = (f32x4){0.f, 0.f, 0.f, 0.f};
#pragma unroll
    for (int ks = 0; ks < 2; ++ks) { const bf16x8 aq = *(const LAS bf16x8*)(QP + fr * 72 + 32 * ks + 8 * fq), aa = *(const LAS bf16x8*)(ATT + fr * 72 + 32 * ks + 8 * fq);
#pragma unroll
        for (int n = 0; n < 4; ++n) { const bf16x8 bs = *(const LAS bf16x8*)(STL + (dir * 64 + 16 * n + fr) * 72 + 32 * ks + 8 * fq), bv = *(const LAS bf16x8*)(VT + (16 * n + fr) * 72 + 32 * ks + 8 * fq);
            o[n] = MFMA16(aq, bs, o[n]); o[n] = MFMA16(aa, bv, o[n]); } }
    if (dir == 0) {
#pragma unroll
        for (int n = 0; n < 4; ++n)
#pragma unroll
            for (int r = 0; r < 4; ++r) OSUM[(16 * si + 4 * fq + r) * 68 + 16 * n + fr] = o[n][r]; }
    __syncthreads();
    if (hasnext) { scan_stage_store(lds, tid, Rn); s3_state_store(STL, tid, ns0, ns1); }
    if (dir == 1) {
        const bool wr_out = !(a.skipctx_out && k >= 128) && !a.pad;
        float ss[4] = {0.f, 0.f, 0.f, 0.f};
#pragma unroll
        for (int n = 0; n < 4; ++n)
#pragma unroll
            for (int r = 0; r < 4; ++r) { o[n][r] += OSUM[(16 * si + 4 * fq + r) * 68 + 16 * n + fr]; ss[r] += o[n][r] * o[n][r]; }
#pragma unroll
        for (int r = 0; r < 4; ++r) { ss[r] += shxl(ss[r], 1, lane); ss[r] += shxl(ss[r], 2, lane); ss[r] += shxl(ss[r], 4, lane); ss[r] += shxl(ss[r], 8, lane); ss[r] = rsqrtf(ss[r] * (1.f / 64.f) + EPS); }
        if (wr_out) {
            const size_t orow0 = (size_t)b * RPB + 64 * k - a.out_off;
#pragma unroll
            for (int n = 0; n < 4; ++n)
#pragma unroll
                for (int r = 0; r < 4; ++r) { const int tq = 16 * si + 4 * fq + r, e = 16 * n + fr; const float gv = bf2f(gpre[n * 4 + r]);
                    a.OB[(orow0 + tq) * 512 + h * 64 + e] = f2bf(o[n][r] * ss[r] * a.gn[h * 64 + e] * gv * fsigmoid(gv)); }
        }
    }
    __syncthreads();
}
constexpr int SCAN_LDS = SC_A + 18432 + 2048 + 17408 + 8 * 6912;

#define XB_TMO      128
#define XB_XCNT(j)  (256  + 64 * (j))
#define XB_XSUB(j)  (1280 + 64 * (j))
#define XB_XGEN(j)  (2304 + 64 * (j))
#define XB_TOP      3328
#define XB_TOPGEN   3392
#define XCD_BAR_WORDS 3456
#define XB_SPIN_CAP (1u << 18)

__device__ __forceinline__ unsigned xb_ld(unsigned* p)              { return __hip_atomic_load(p, __ATOMIC_RELAXED, __HIP_MEMORY_SCOPE_AGENT); }
__device__ __forceinline__ unsigned xb_add(unsigned* p, unsigned v) { return __hip_atomic_fetch_add(p, v, __ATOMIC_RELAXED, __HIP_MEMORY_SCOPE_AGENT); }
__device__ __forceinline__ unsigned xb_xcc_id() { return (unsigned)__builtin_amdgcn_s_getreg((3 << 11) | 20) & 0xFu; }
#define XB_SPIN(cond, bar) do { unsigned _sp = 0; while (cond) { __builtin_amdgcn_s_sleep(1); \
    if ((++_sp & 255u) == 0u) { if (xb_ld(&(bar)[XB_TMO])) break; if (_sp > XB_SPIN_CAP) { atomicAdd(&(bar)[XB_TMO], 1u); break; } } } } while (0)

struct XcdBarrier {
    unsigned* bar; unsigned x;
    volatile LAS unsigned* st;
};

__device__ __forceinline__ XcdBarrier xcd_barrier_post(unsigned* bar, volatile LAS unsigned* st) {
    XcdBarrier b; b.bar = bar; b.x = xb_xcc_id(); b.st = st;
    if (threadIdx.x == 0) (void)xb_add(&bar[XB_XCNT(b.x)], 1u);
    return b;
}
__device__ __forceinline__ void xcd_barrier_complete(unsigned* bar, unsigned x, unsigned& nloc, unsigned& nx) {
    const unsigned G = gridDim.x * gridDim.y * gridDim.z;
    unsigned sum, cnt, mine, sp = 0u;
    for (;;) {
        sum = 0u; cnt = 0u; mine = 0u;
#pragma unroll
        for (unsigned j = 0; j < 16; ++j) { const unsigned c = xb_ld(&bar[XB_XCNT(j)]); sum += c; cnt += (c > 0u) ? 1u : 0u; mine = (j == x) ? c : mine; }
        if (sum == G) break;
        __builtin_amdgcn_s_sleep(1);
        if ((++sp & 255u) == 0u) { if (xb_ld(&bar[XB_TMO])) break; if (sp > XB_SPIN_CAP) { atomicAdd(&bar[XB_TMO], 1u); break; } }
    }
    nloc = mine > 0u ? mine : 1u; nx = cnt > 0u ? cnt : 1u;
}

__device__ __forceinline__ void xcd_barrier(const XcdBarrier& b) {
    asm volatile("s_waitcnt vmcnt(0)" ::: "memory");
    __syncthreads();
    if (threadIdx.x == 0) {
        unsigned* bar = b.bar;
        __builtin_amdgcn_s_waitcnt(0);
        unsigned nloc = b.st[0], nx = b.st[1];
        if (nloc == 0u) { xcd_barrier_complete(bar, b.x, nloc, nx); b.st[0] = nloc; b.st[1] = nx; }
        const unsigned old = xb_add(&bar[XB_XSUB(b.x)], 1u);
        const unsigned gen = old / nloc;
        if (old + 1u == (gen + 1u) * nloc) {
            __builtin_amdgcn_fence(__ATOMIC_RELEASE, "agent");
            asm volatile("s_waitcnt vmcnt(0)" ::: "memory");
            const unsigned og = xb_add(&bar[XB_TOP], 1u);
            const unsigned tg = og / nx;
            if (og + 1u == (tg + 1u) * nx) xb_add(&bar[XB_TOPGEN], 1u);
            else XB_SPIN(xb_ld(&bar[XB_TOPGEN]) == tg, bar);
            __builtin_amdgcn_fence(__ATOMIC_ACQUIRE, "agent");
            xb_add(&bar[XB_XGEN(b.x)], 1u);
            asm volatile("s_waitcnt vmcnt(0)" ::: "memory");
        } else {
            XB_SPIN(xb_ld(&bar[XB_XGEN(b.x)]) == gen, bar);
            __builtin_amdgcn_fence(__ATOMIC_ACQUIRE, "agent");
            asm volatile("s_waitcnt vmcnt(0)" ::: "memory");
        }
    }
    __syncthreads();
}


constexpr size_t MiB = 1u << 20;
constexpr size_t CTL_ZERO_BYTES = 64 * 1024;
constexpr int CW_COUNTS = 8192, CW_CURSOR = 8192 + 128;
constexpr size_t O_MOD = 1 * MiB, O_LB = 1 * MiB + 512 * 1024, O_ROPA_C = 2 * MiB, O_ROPA_S = 3 * MiB, O_ROPC_C = 4 * MiB, O_ROPC_S = 4 * MiB + 512 * 1024, O_XC = 5 * MiB;
constexpr size_t O_ROUTE_E = 9 * MiB, O_ROUTE_W = 9 * MiB + 512 * 1024, O_PERM = 10 * MiB, O_POSW = 10 * MiB + 512 * 1024, O_GOFF = 11 * MiB, O_TILEE = 11 * MiB + 512 * 1024;
constexpr size_t O_WRT = 11 * MiB + 640 * 1024;
constexpr size_t O_RS = 12 * MiB, O_DS = 13 * MiB + 512 * 1024, O_WGH = 15 * MiB + 768 * 1024;
constexpr size_t O_WINP = 16 * MiB, O_WC = 30 * MiB, O_WBR = 32 * MiB, O_WOUT = 35 * MiB;
constexpr size_t O_H = 38 * MiB;
constexpr size_t O_AQ = 104 * MiB, O_AK = 137 * MiB, O_AV = 145 * MiB + 512 * 1024;
constexpr size_t O_BQ = 154 * MiB, O_BV = 187 * MiB, O_BG = 220 * MiB, O_BLF = 253 * MiB, O_BLB = 286 * MiB;
constexpr size_t O_CQKV = 319 * MiB, O_CKR = 344 * MiB, O_CQ = 347 * MiB, O_CKV = 397 * MiB, O_OC = 463 * MiB, O_WRB = 496 * MiB, WS_END = 497 * MiB;
constexpr size_t O_GATE = 187 * MiB;
constexpr size_t O_YM2 = 154 * MiB, O_AUP = 104 * MiB, O_WUP = 397 * MiB, O_WDN = 429 * MiB;
constexpr int LDS_BYTES = 163840, LDS_BAR_OFF = LDS_BYTES - 64, LDS_PTR_OFF = LDS_BYTES - 512;

struct KP { const float* in[24]; float* out; char* ws; int ph_lo, ph_hi; unsigned long long mask; };
struct Frame {
    LAS char* lds; char* ws; float* out; int wv0;
};
#define WSP(T, off) ((T*)(F.ws + (off)))
__device__ __forceinline__ const float* in_ptr(const Frame& F, int k) { const volatile LAS unsigned* q = (const volatile LAS unsigned*)(F.lds + LDS_PTR_OFF + 8 * k);
    unsigned lo = q[0], hi = q[1]; lo = __builtin_amdgcn_readfirstlane(lo); hi = __builtin_amdgcn_readfirstlane(hi); return (const float*)(((unsigned long long)hi << 32) | lo); }
#define INP(k) in_ptr(F, k)
__device__ __forceinline__ float wave_sum_dpp(float v) {
    int x = __builtin_bit_cast(int, v);
#define DPP_ADD(ctrl, rmask) x = __builtin_bit_cast(int, __builtin_bit_cast(float, x) + __builtin_bit_cast(float, __builtin_amdgcn_update_dpp(0, x, ctrl, rmask, 0xF, false)))
    DPP_ADD(0xB1, 0xF);
    DPP_ADD(0x4E, 0xF);
    DPP_ADD(0x141, 0xF);
    DPP_ADD(0x140, 0xF);
    DPP_ADD(0x142, 0xA);
    DPP_ADD(0x143, 0xC);
#undef DPP_ADD
    return __builtin_bit_cast(float, __builtin_amdgcn_readlane(x, 63));
}
__device__ __forceinline__ float wave_sum(float v) {
#pragma unroll
    for (int o = 32; o >= 1; o >>= 1) v += __shfl_xor(v, o);
    return v;
}

__device__ __forceinline__ void p0_mod(const Frame& F) {
    const int tid = opaque_tid(F.wv0), lane = tid & 63, wave = __builtin_amdgcn_readfirstlane(tid >> 6); (void)lane; (void)wave;
    LAS float* sc = (LAS float*)F.lds;
    LAS float* red = (LAS float*)(F.lds + 20480);
    for (int i = tid; i < 5 * 1024; i += 512) { const int r = i >> 10, k = i & 1023; const float v = r < 4 ? INP(1)[r * 1024 + k] : INP(3)[k]; sc[i] = v / (1.f + expf(-v)); }
    __syncthreads();
    float* MOD = WSP(float, O_MOD);
    for (int u = blockIdx.x; u < 2 * 96; u += gridDim.x) { const int l = u / 96, j = (u % 96) * 64 + lane;
        const float* w = INP(4) + (size_t)l * 1024 * 6144 + j; float a0 = 0.f, a1 = 0.f, a2 = 0.f, a3 = 0.f, a4 = 0.f;
#pragma unroll 8
        for (int kk = 0; kk < 128; ++kk) { const int k = wave * 128 + kk; const float wv = w[(size_t)k * 6144]; a0 += sc[k] * wv; a1 += sc[1024 + k] * wv; a2 += sc[2048 + k] * wv; a3 += sc[3072 + k] * wv; a4 += sc[4096 + k] * wv; }
        red[(wave * 5 + 0) * 64 + lane] = a0; red[(wave * 5 + 1) * 64 + lane] = a1; red[(wave * 5 + 2) * 64 + lane] = a2; red[(wave * 5 + 3) * 64 + lane] = a3; red[(wave * 5 + 4) * 64 + lane] = a4;
        __syncthreads();
        if (tid < 320) { const int r = tid >> 6, ln = tid & 63; float s = 0.f;
#pragma unroll
            for (int w8 = 0; w8 < 8; ++w8) s += red[(w8 * 5 + r) * 64 + ln];
            const int jj = (u % 96) * 64 + ln; MOD[(size_t)(l * 5 + r) * 6144 + jj] = s + INP(5)[l * 6144 + jj]; }
        __syncthreads();
    }
}
__device__ __forceinline__ void p0_tables(const Frame& F) {
    const int tid = opaque_tid(F.wv0), lane = tid & 63, wave = __builtin_amdgcn_readfirstlane(tid >> 6); (void)lane; (void)wave;
    float* ropa_c = WSP(float, O_ROPA_C); float* ropa_s = WSP(float, O_ROPA_S); float* ropc_c = WSP(float, O_ROPC_C); float* ropc_s = WSP(float, O_ROPC_S); float* LB = WSP(float, O_LB);
    for (int i = blockIdx.x * 512 + tid; i < 8192 * 32; i += gridDim.x * 512) {
        { const int t = i >> 5, j = i & 31, row = t >> 6, col = t & 63, f = j & 15; const float inv = powf(10000.f, -(float)f / 16.f); const float ang = (j < 16 ? (float)row : (float)col) * inv;
          ropa_c[i] = (float)cos((double)ang); ropa_s[i] = (float)sin((double)ang); }
        if (i < 8192 * 16) { const int t = i >> 4, j = i & 15, row = t >> 6, col = t & 63, f = j & 7; const float inv = powf(10000.f, -(float)f / 8.f); const float ang = (j < 8 ? (float)row : (float)col) * inv;
          ropc_c[i] = (float)cos((double)ang); ropc_s[i] = (float)sin((double)ang); }
        for (int i2 = i; i2 < 2 * 256 * 1024; i2 += 8192 * 32) { const int l = i2 >> 18, pp = (i2 >> 10) & 255, k = i2 & 1023;
          const int bj = pp >> 7, wc = (pp >> 5) & 3, n = (pp >> 4) & 1, fq = (pp >> 2) & 3, e = pp & 3; float v = 0.f;
          if (wc == 0) { if (bj == 0) v = INP(19)[(size_t)l * 1024 * 32 + k * 32 + fq * 8 + 4 * n + e]; else if (n == 0 && e == 0) v = INP(18)[(size_t)l * 1024 * 4 + k * 4 + fq]; }
          WSP(bf16_t, O_WRB)[i2] = f2bf(v); }
        if (i < 2048) { const int l = i >> 10, rest = i & 1023; if (l == 0) LB[i] = 0.f; else { const float a0 = INP(10)[rest], a1 = INP(10)[1024 + rest]; LB[i] = 1.f / (1.f + expf(a0 - a1)); } }
    }
}
template <class CM> __device__ __forceinline__ void wt_tile(const float* W, int ldw, const CM& cm, bf16_t* Bt, int K, int p0, int k0, LAS float* scr, int lane) {
    const int p4 = (lane & 7) * 4; const int c = cm(p0 + p4);
#pragma unroll
    for (int i = 0; i < 8; ++i) { const int kk = i * 8 + (lane >> 3); f32x4 v = (f32x4){0.f, 0.f, 0.f, 0.f};
        if (c >= 0) v = *(const f32x4*)(W + (size_t)(k0 + kk) * ldw + c);
        scr[kk * 33 + p4] = v[0]; scr[kk * 33 + p4 + 1] = v[1]; scr[kk * 33 + p4 + 2] = v[2]; scr[kk * 33 + p4 + 3] = v[3]; }
    asm volatile("s_waitcnt lgkmcnt(0)" ::: "memory"); __builtin_amdgcn_wave_barrier();
#pragma unroll 8
    for (int pi = 0; pi < 32; ++pi) Bt[(size_t)(p0 + pi) * K + k0 + lane] = f2bf(scr[lane * 33 + pi]);
    asm volatile("s_waitcnt lgkmcnt(0)" ::: "memory"); __builtin_amdgcn_wave_barrier();
}
struct WtDesc { const float* src; size_t ldw8; bf16_t* dst; int K; };
template <class CM> __device__ __forceinline__ WtDesc wt_desc(const float* W, int ldw, const CM& cm, bf16_t* Bt, int K, int p0, int k0, int lane) {
    const int p4 = (lane & 7) * 4; const int c = cm(p0 + p4); WtDesc d; d.src = c >= 0 ? W + (size_t)(k0 + (lane >> 3)) * ldw + c : nullptr; d.ldw8 = (size_t)ldw * 8; d.dst = Bt + (size_t)p0 * K + k0; d.K = K; return d; }
__device__ __forceinline__ void wt_load(const WtDesc& d, f32x4 (&v)[8]) {
#pragma unroll
    for (int i = 0; i < 8; ++i) { v[i] = (f32x4){0.f, 0.f, 0.f, 0.f}; if (d.src) v[i] = *(const f32x4*)(d.src + (size_t)i * d.ldw8); } }
__device__ __forceinline__ void wt_store(const WtDesc& d, const f32x4 (&v)[8], LAS float* scr, int lane) {
    const int p4 = (lane & 7) * 4;
#pragma unroll
    for (int i = 0; i < 8; ++i) { const int kk = i * 8 + (lane >> 3); scr[kk * 33 + p4] = v[i][0]; scr[kk * 33 + p4 + 1] = v[i][1]; scr[kk * 33 + p4 + 2] = v[i][2]; scr[kk * 33 + p4 + 3] = v[i][3]; }
    asm volatile("s_waitcnt lgkmcnt(0)" ::: "memory"); __builtin_amdgcn_wave_barrier();
    const int p = lane >> 1, kh = (lane & 1) * 32; bf16_t* o = d.dst + (size_t)p * d.K + kh;
#pragma unroll
    for (int s4 = 0; s4 < 4; ++s4) { const LAS float* r = scr + (kh + s4 * 8) * 33 + p;
        u32x4 w; w.x = pkbf(r[0], r[33]); w.y = pkbf(r[66], r[99]); w.z = pkbf(r[132], r[165]); w.w = pkbf(r[198], r[231]); *(u32x4*)(o + s4 * 8) = w; }
    asm volatile("s_waitcnt lgkmcnt(0)" ::: "memory"); __builtin_amdgcn_wave_barrier();
}
template <class Dec> __device__ __forceinline__ void wt_run(const Dec& dec, int first, int total, int stride, LAS float* scr, int lane) {
    if (first >= total) return;
    WtDesc cur = dec(first); f32x4 va[8]; wt_load(cur, va);
    for (int it = first; it < total; it += stride) { const int nx = it + stride; const bool hn = nx < total; WtDesc nxt = cur; f32x4 vb[8];
        if (hn) { nxt = dec(nx); wt_load(nxt, vb); }
        wt_store(cur, va, scr, lane);
        if (hn) { cur = nxt;
#pragma unroll
            for (int i = 0; i < 8; ++i) va[i] = vb[i]; } }
}
struct CmWin { __device__ __forceinline__ int operator()(int p) const { return colmap(MAP_WIN, p); } };
struct CmId { __device__ __forceinline__ int operator()(int p) const { return p; } };
__device__ __forceinline__ void conv_weights_nonmoe(const Frame& F, int l) {
    const int tid = opaque_tid(F.wv0), lane = tid & 63, wave = __builtin_amdgcn_readfirstlane(tid >> 6); (void)lane; (void)wave;
    LAS float* scr = (LAS float*)F.lds + wave * (64 * 33);
    const int gw = blockIdx.x * 8 + wave, NGW = gridDim.x * 8;
    constexpr int I_WIN = 216 * 16, I_BR = 3 * 32 * 8, I_OUT = 32 * 16;
    { const float* w_in = INP(8) + (size_t)l * 1024 * INW; const float* w_br = INP(16) + (size_t)l * 3 * 512 * 1024; const float* w_out = INP(17) + (size_t)l * 1024 * 1024; const Frame* Fp = &F;
      auto dec = [=](int it) -> WtDesc { const Frame& F = *Fp; int r = it;
          if (r < I_WIN) return wt_desc(w_in, INW, CmWin(), WSP(bf16_t, O_WINP), 1024, (r / 16) * 32, (r % 16) * 64, lane); r -= I_WIN;
          if (r < I_BR) { const int n = r / 256, q = r % 256; return wt_desc(w_br + (size_t)n * 512 * 1024, 1024, CmId(), WSP(bf16_t, O_WBR) + (size_t)n * 1024 * 512, 512, (q / 8) * 32, (q % 8) * 64, lane); } r -= I_BR;
          return wt_desc(w_out, 1024, CmId(), WSP(bf16_t, O_WOUT), 1024, (r / 16) * 32, (r % 16) * 64, lane); };
      wt_run(dec, gw, I_WIN + I_BR + I_OUT, NGW, scr, lane); }
    const float* wuq = INP(14) + (size_t)l * 256 * 768; const float* wukv = INP(15) + (size_t)l * 128 * 1024; const float* gq = INP(12) + l * 256; const float* gkv = INP(13) + l * 128; bf16_t* WC = WSP(bf16_t, O_WC);
    for (int i = blockIdx.x * 512 + tid; i < 1792 * 384; i += gridDim.x * 512) {
        const int pp = i / 384, k = i % 384; float v = 0.f;
        if (pp < 768) { const int pn = pp >> 8, q = pp & 255, bj = q >> 7, wc = (q >> 5) & 3, j = q & 31; const int gi = pn * 8 + bj * 4 + wc, head = gi / 3, part = gi - head * 3;
            const int p = part < 2 ? head * 96 + part * 32 + j : head * 96 + 64 + 16 * ((j >> 2) & 1) + 4 * (j >> 3) + (j & 3);
            if (k < 256) v = wuq[k * 768 + p] * gq[k]; }
        else { if (k >= 256) v = wukv[(k - 256) * 1024 + (pp - 768)] * gkv[k - 256]; }
        WC[i] = f2bf(v); }
}
struct CmUp { __device__ __forceinline__ int operator()(int p) const { return ((p >> 8) << 7) + (p & 127); } };
__device__ __forceinline__ void conv_weights_moe(const Frame& F, int l) {
    const int tid = opaque_tid(F.wv0), lane = tid & 63, wave = __builtin_amdgcn_readfirstlane(tid >> 6); (void)lane; (void)wave;
    LAS float* scr = (LAS float*)F.lds + wave * (64 * 33);
    const int gw = blockIdx.x * 8 + wave, NGW = gridDim.x * 8;
    constexpr int I_UP = 32 * 16 * 16, I_DN = 32 * 32 * 4;
    { const float* w1 = INP(20) + (size_t)l * 32 * 1024 * 256; const float* w3 = INP(21) + (size_t)l * 32 * 1024 * 256; const float* w2 = INP(22) + (size_t)l * 32 * 256 * 1024; const Frame* Fp = &F;
      auto dec = [=](int it) -> WtDesc { const Frame& F = *Fp; int r = it;
          if (r < I_UP) { const int e = r / 256, q = r % 256, p0 = (q / 16) * 32, k0 = (q % 16) * 64; const bool isw3 = (p0 >> 7) & 1;
              return wt_desc((isw3 ? w3 : w1) + (size_t)e * 1024 * 256, 256, CmUp(), WSP(bf16_t, O_WUP) + (size_t)e * 512 * 1024, 1024, p0, k0, lane); } r -= I_UP;
          const int e = r / 128, q = r % 128; return wt_desc(w2 + (size_t)e * 256 * 1024, 1024, CmId(), WSP(bf16_t, O_WDN) + (size_t)e * 1024 * 256, 256, (q / 4) * 32, (q % 4) * 64, lane); };
      wt_run(dec, gw, I_UP + I_DN, NGW, scr, lane); }
}

__device__ __forceinline__ void rp_load(const float* xs, float* xd, bool wx, const bf16_t* ym, const float* gt, int lane, f32x4 (&v)[4], float& rinv) {
    float ss = 0.f;
#pragma unroll
    for (int j = 0; j < 4; ++j) { const int c = 4 * lane + 256 * j; v[j] = *(const f32x4*)(xs + c);
        if (ym) { const uint2 y0 = *(const uint2*)(ym + c), y1 = *(const uint2*)(ym + 1024 + c); const f32x4 g4 = *(const f32x4*)(gt + c);
            v[j][0] += g4[0] * (bflo(y0.x) + bflo(y1.x)); v[j][1] += g4[1] * (bfhi(y0.x) + bfhi(y1.x)); v[j][2] += g4[2] * (bflo(y0.y) + bflo(y1.y)); v[j][3] += g4[3] * (bfhi(y0.y) + bfhi(y1.y)); }
        if (wx) *(f32x4*)(xd + c) = v[j];
        ss += v[j][0] * v[j][0] + v[j][1] * v[j][1] + v[j][2] * v[j][2] + v[j][3] * v[j][3]; }
    rinv = rsqrtf(wave_sum_dpp(ss) * (1.f / D) + EPS);
}
__device__ __forceinline__ void rp_mod(const f32x4 (&v)[4], float rinv, const float* gn, const float* mo, int sh_off, int sc_off, bf16_t* hp, int lane, f32x4 (&hv)[4]) {
#pragma unroll
    for (int j = 0; j < 4; ++j) { const int c = 4 * lane + 256 * j; const f32x4 g4 = *(const f32x4*)(gn + c), s4 = *(const f32x4*)(mo + sc_off + c), h4 = *(const f32x4*)(mo + sh_off + c);
        hv[j] = v[j] * rinv * g4 * (s4 + 1.f) + h4;
        *(uint2*)(hp + c) = make_uint2(pkbf(hv[j][0], hv[j][1]), pkbf(hv[j][2], hv[j][3])); }
}
__device__ __forceinline__ void phase_rowpass1(const Frame& F, int l, bool combine, size_t h_off) {
    const int tid = opaque_tid(F.wv0), lane = tid & 63, wave = __builtin_amdgcn_readfirstlane(tid >> 6); (void)lane; (void)wave;
    const int gw = blockIdx.x * 8 + wave, NGW = gridDim.x * 8;
    const float* xl = (l == 0) ? INP(0) : F.out; const float* xc = (l == 0) ? INP(2) : WSP(float, O_XC);
    const float* MODl = WSP(float, O_MOD) + (size_t)l * 5 * 6144; const float* MODp = WSP(float, O_MOD);
    for (int g = gw; g < G; g += NGW) { const RowInfo ri = rowinfo(g); const int mrow = ri.lat ? ri.b : 4; const size_t xo = xoff(ri);
        const float* xs = (ri.lat ? xl : xc) + xo; float* xd = (ri.lat ? F.out : WSP(float, O_XC)) + xo;
        f32x4 v[4], hv[4]; float rinv;
        rp_load(xs, xd, combine, combine ? WSP(bf16_t, O_YM2) + (size_t)g * 2048 : nullptr, MODp + (size_t)mrow * 6144 + 5120, lane, v, rinv);
        rp_mod(v, rinv, INP(6) + l * 1024, MODl + (size_t)mrow * 6144, 0, 1024, WSP(bf16_t, h_off) + (size_t)g * D, lane, hv); }
}
__device__ __forceinline__ void phase_rowpass2(const Frame& F, int l, bool last) {
    const int tid = opaque_tid(F.wv0), lane = tid & 63, wave = __builtin_amdgcn_readfirstlane(tid >> 6);
    { int* perm = WSP(int, O_PERM); unsigned* goff = WSP(unsigned, O_GOFF);
      for (int i = blockIdx.x * 512 + tid; i < PMAX; i += gridDim.x * 512) { perm[i] = -1; goff[i] = 0u; } }
    const int gw = blockIdx.x * 8 + wave, NGW = gridDim.x * 8;
    const float* MODl = WSP(float, O_MOD) + (size_t)l * 5 * 6144;
    for (int g = gw; g < G; g += NGW) { const RowInfo ri = rowinfo(g); if (last && !ri.lat) continue;
        const int mrow = ri.lat ? ri.b : 4; const size_t xo = xoff(ri);
        const float* xs = (ri.lat ? F.out : WSP(float, O_XC)) + xo;
        f32x4 v[4], hv[4]; float rinv;
        rp_load(xs, nullptr, false, nullptr, nullptr, lane, v, rinv);
        rp_mod(v, rinv, INP(7) + l * 1024, MODl + (size_t)mrow * 6144, 3072, 4096, WSP(bf16_t, O_H) + (size_t)g * D, lane, hv); }
}
struct EpiRoute {
    static constexpr bool PERM = false;
    int* route_e; float* route_w; LAS int* hist;
    __device__ __forceinline__ void operator()(const f32x4 (&acc)[2][2][4][2], const gp::GUnit& u, int wr, int wc, int fr, int fq) const {
        if (wc != 0) return;
#pragma unroll
        for (int ai = 0; ai < 2; ++ai)
#pragma unroll
            for (int m = 0; m < 4; ++m) { const int row = u.pm * 256 + ai * 128 + wr * 64 + m * 16 + fr;
                float el[8];
#pragma unroll
                for (int e = 0; e < 4; ++e) { el[e] = acc[ai][0][m][0][e]; el[4 + e] = acc[ai][0][m][1][e]; }
                const float gl = acc[ai][1][m][0][0];
                int i0 = 0; float m0 = el[0];
#pragma unroll
                for (int j = 1; j < 8; ++j) if (el[j] > m0) { m0 = el[j]; i0 = j; }
                int i1 = -1; float m1 = -3.4e38f;
#pragma unroll
                for (int j = 0; j < 8; ++j) if (j != i0 && el[j] > m1) { m1 = el[j]; i1 = j; }
                float gmax = gl; int gidx = fq;
#pragma unroll
                for (int off = 16; off <= 32; off <<= 1) { const float og = shxl(gmax, off, fr | (fq << 4)); const int oi = shxli(gidx, off, fr | (fq << 4)); if (og > gmax || (og == gmax && oi < gidx)) { gmax = og; gidx = oi; } }
                float gs = expf(gl - gmax); gs += shxl(gs, 16, fr | (fq << 4)); gs += shxl(gs, 32, fr | (fq << 4));
                if (fq == gidx) { const float gwt = 1.f / gs, p1 = expf(m1 - m0); const int e0 = fq * 8 + i0, e1 = fq * 8 + i1;
                    route_e[row * 2] = e0; route_e[row * 2 + 1] = e1; route_w[row * 2] = gwt / (1.f + p1); route_w[row * 2 + 1] = gwt * p1 / (1.f + p1);
                    __hip_atomic_fetch_add(hist + e0, 1, __ATOMIC_RELAXED, __HIP_MEMORY_SCOPE_WORKGROUP); __hip_atomic_fetch_add(hist + e1, 1, __ATOMIC_RELAXED, __HIP_MEMORY_SCOPE_WORKGROUP); } }
    }
};
__device__ __forceinline__ void phase_final(const Frame& F) {
    const int tid = opaque_tid(F.wv0), lane = tid & 63, wave = __builtin_amdgcn_readfirstlane(tid >> 6); (void)lane; (void)wave;
    const int gw = blockIdx.x * 8 + wave, NGW = gridDim.x * 8; const float* MOD1 = WSP(float, O_MOD) + (size_t)5 * 6144;
    for (int lr = gw; lr < NB * SEQ; lr += NGW) { const int b = lr / SEQ, t = lr - b * SEQ; const int g = b * RPB + t; float* xp = F.out + (size_t)lr * D;
        f32x4 v[4]; float rinv; rp_load(xp, nullptr, false, WSP(bf16_t, O_YM2) + (size_t)g * 2048, MOD1 + (size_t)b * 6144 + 5120, lane, v, rinv);
#pragma unroll
        for (int j = 0; j < 4; ++j) { const int c = 4 * lane + 256 * j; const f32x4 g4 = *(const f32x4*)(INP(23) + c); *(f32x4*)(xp + c) = v[j] * rinv * g4; } }
}
__device__ __forceinline__ void phase_moe_scatter(const Frame& F, int l, bool last) {
    const int tid = opaque_tid(F.wv0), lane = tid & 63, wave = __builtin_amdgcn_readfirstlane(tid >> 6);
    LAS int* tot = (LAS int*)F.lds; LAS int* bef = tot + 512; LAS int* base = tot + 1024; LAS int* lcur = tot + 1056;
    const int* WGH = WSP(int, O_WGH) + (size_t)l * 256 * 32; const int nwg = gridDim.x, me = blockIdx.x;
    { const int e = tid & 31, part = tid >> 5; int sa = 0, sb = 0;
      for (int w = part * 16; w < part * 16 + 16 && w < nwg; ++w) { const int c = WGH[w * 32 + e]; sa += c; if (w < me) sb += c; }
      tot[part * 32 + e] = sa; bef[part * 32 + e] = sb; }
    __syncthreads();
    int sa2 = 0, sb2 = 0;
    if (tid < 32) {
#pragma unroll
        for (int part = 0; part < 16; ++part) { sa2 += tot[part * 32 + tid]; sb2 += bef[part * 32 + tid]; } }
    __syncthreads();
    if (tid < 32) { tot[tid] = sa2; bef[tid] = sb2; lcur[tid] = 0; }
    __syncthreads();
    if (tid == 0) { int o = 0; int* tile_e = WSP(int, O_TILEE);
#pragma clang loop unroll(disable) vectorize(disable)
        for (int e = 0; e < 32; ++e) { base[e] = o + bef[e]; const int n = (tot[e] + 255) & ~255;
            if (me == 0) {
#pragma clang loop unroll(disable) vectorize(disable)
                for (int t = o >> 8; t < (o + n) >> 8; ++t) tile_e[t] = e; }
            o += n; }
        if (me == 0) tile_e[NTILE] = o >> 8; }
    __syncthreads();
    const int* route_e = WSP(int, O_ROUTE_E); const float* route_w = WSP(float, O_ROUTE_W); int* perm = WSP(int, O_PERM); float* posw = WSP(float, O_POSW); unsigned* goff = WSP(unsigned, O_GOFF);
    { int pmv, pn;
      if (gp::tile_order(0, (int)gridDim.x, (int)blockIdx.x, last ? 128 : 132, 1, pmv, pn)) { const int pm = last ? pmv + pmv / 32 : pmv; const int g = pm * 256 + (tid >> 1); const int i = g * 2 + (tid & 1);
          const int e = route_e[i]; const int pos = base[e] + __hip_atomic_fetch_add(lcur + e, 1, __ATOMIC_RELAXED, __HIP_MEMORY_SCOPE_WORKGROUP);
          perm[pos] = i; posw[pos] = route_w[i]; goff[pos] = (unsigned)g * 2048u; } }
    (void)lane; (void)wave;
}

#ifndef PROBE_DUP
#define PROBE_DUP 0
#endif
#ifndef PROBE_EXTRA_MASK
#define PROBE_EXTRA_MASK 0ull
#endif
#define DUP(bit) for (int rep_ = 0; rep_ < (((PROBE_DUP) >> (bit)) & 1) + 1; ++rep_)
__global__ void __launch_bounds__(512, 2) hybrid_trunk_fwd(KP p) {
    extern __shared__ __attribute__((aligned(16))) unsigned char dynlds[];
    Frame F; F.lds = (LAS char*)dynlds; F.ws = p.ws; F.out = p.out; F.wv0 = __builtin_amdgcn_readfirstlane((int)(threadIdx.x >> 6));
    if (threadIdx.x == 0) { LAS unsigned long long* pp = (LAS unsigned long long*)(F.lds + LDS_PTR_OFF);
        pp[0] = (unsigned long long)p.in[0];
        pp[1] = (unsigned long long)p.in[1];
        pp[2] = (unsigned long long)p.in[2];
        pp[3] = (unsigned long long)p.in[3];
        pp[4] = (unsigned long long)p.in[4];
        pp[5] = (unsigned long long)p.in[5];
        pp[6] = (unsigned long long)p.in[6];
        pp[7] = (unsigned long long)p.in[7];
        pp[8] = (unsigned long long)p.in[8];
        pp[9] = (unsigned long long)p.in[9];
        pp[10] = (unsigned long long)p.in[10];
        pp[11] = (unsigned long long)p.in[11];
        pp[12] = (unsigned long long)p.in[12];
        pp[13] = (unsigned long long)p.in[13];
        pp[14] = (unsigned long long)p.in[14];
        pp[15] = (unsigned long long)p.in[15];
        pp[16] = (unsigned long long)p.in[16];
        pp[17] = (unsigned long long)p.in[17];
        pp[18] = (unsigned long long)p.in[18];
        pp[19] = (unsigned long long)p.in[19];
        pp[20] = (unsigned long long)p.in[20];
        pp[21] = (unsigned long long)p.in[21];
        pp[22] = (unsigned long long)p.in[22];
        pp[23] = (unsigned long long)p.in[23];
    }
    LAS unsigned char* glds = (LAS unsigned char*)dynlds;
    volatile LAS unsigned* barst = (volatile LAS unsigned*)(F.lds + LDS_BAR_OFF);
    if (threadIdx.x < 16) ((LAS unsigned*)(F.lds + LDS_BAR_OFF))[threadIdx.x] = 0u;
    __syncthreads();
    const bool multi = (p.ph_hi - p.ph_lo) > 1;
    XcdBarrier bar; bar.bar = (unsigned*)F.ws; bar.x = 0; bar.st = nullptr;
    if (multi) bar = xcd_barrier_post((unsigned*)F.ws, barst);
    int ph = 0;
#define PH_BEGIN if (ph >= p.ph_lo && ph < p.ph_hi && (p.mask == 0ull || ((p.mask >> ph) & 1ull))) {
#define PH_END   if (ph + 1 < p.ph_hi) xcd_barrier(bar); else __syncthreads(); } ++ph;
    const int Gd = gridDim.x, cb = blockIdx.x;

    PH_BEGIN p0_mod(F); p0_tables(F); __syncthreads(); conv_weights_nonmoe(F, 0); PH_END

    for (int l = 0; l < 2; ++l) {
        const bool last = (l == 1);
        const float* MODl = WSP(float, O_MOD) + (size_t)l * 5 * 6144;
        PH_BEGIN phase_rowpass1(F, l, l > 0, O_H); PH_END
        PH_BEGIN
        { SchedStd S{}; S.A = WSP(bf16_t, O_H); S.Bt = WSP(bf16_t, O_WINP); S.K = 1024; S.nM = 132; S.nN = 15; S.G_ = Gd; S.c = cb; S.skipctx = 0; S.lda2 = 2048; S.ldb2 = 2048;
          EpiG1 E{}; E.AQ = WSP(bf16_t, O_AQ); E.AK = WSP(bf16_t, O_AK); E.AV = WSP(bf16_t, O_AV); E.BQ = WSP(bf16_t, O_BQ); E.BV = WSP(bf16_t, O_BV); E.BG = WSP(bf16_t, O_BG); E.BLF = WSP(f16_t, O_BLF); E.BLB = WSP(f16_t, O_BLB);
          E.CQKV = WSP(bf16_t, O_CQKV); E.CKR = WSP(bf16_t, O_CKR); E.RS = WSP(float, O_RS); E.ropa_c = WSP(float, O_ROPA_C); E.ropa_s = WSP(float, O_ROPA_S); E.ropc_c = WSP(float, O_ROPC_C); E.ropc_s = WSP(float, O_ROPC_S);
          E.LBl = WSP(float, O_LB) + l * 1024; E.rowoff = 0;
          DUP(0) gp::gemm_phase<EpiG1, SchedStd>(glds, S, E, F.wv0); }
        PH_END
        PH_BEGIN
        { SchedStd S{}; S.A = WSP(bf16_t, O_CQKV); S.Bt = WSP(bf16_t, O_WC); S.K = 384; S.nM = 132; S.nN = 7; S.G_ = Gd; S.c = cb; S.skipctx = 0; S.lda2 = 768; S.ldb2 = 768;
          EpiC E{}; E.CQ = WSP(bf16_t, O_CQ); E.CKV = WSP(bf16_t, O_CKV); E.RS = WSP(float, O_RS); E.ropc_c = WSP(float, O_ROPC_C); E.ropc_s = WSP(float, O_ROPC_S); E.pmoff = 0;
          DUP(1) gp::gemm_phase<EpiC, SchedStd>(glds, S, E, F.wv0); }
        __syncthreads();
        { AttnArgs a{}; a.Q = WSP(bf16_t, O_AQ); a.qld = 512; a.qhs = 64; a.K1 = WSP(bf16_t, O_AK); a.k1ld = 128; a.k1hs = 64; a.kvgroup = 4; a.K2 = nullptr; a.k2ld = 0; a.V = WSP(bf16_t, O_AV); a.vld = 128; a.vhs = 64;
          a.O = WSP(bf16_t, O_AQ); a.old = 512; a.ohs = 64; a.scale_l2 = 0.125f * LOG2E; a.sink = INP(9) + l * 8; a.window = 128;
          const int nqb = last ? 32 : 33;
          DUP(10) for (int u = cb; u < NB * 8 * nqb; u += Gd) { int b, h, qb; if (u < NB * 8 * 32) { b = u >> 8; h = u & 7; qb = (u >> 3) & 31; }     else { const int r_ = u - NB * 8 * 32; b = r_ >> 3; h = r_ & 7; qb = 32; }
              attn_unit<64>(F.lds, a, F.wv0, b, qb, h, ((PROBE_DUP >> 10) & 1) && rep_ == 0); } }
        __syncthreads();
        { ScanArgs a{}; a.BQ = WSP(bf16_t, O_BQ); a.BV = WSP(bf16_t, O_BV); a.BG = WSP(bf16_t, O_BG); a.BLF = WSP(f16_t, O_BLF); a.BLB = WSP(f16_t, O_BLB); a.ST = WSP(bf16_t, O_H); a.DS = WSP(float, O_DS); a.OB = WSP(bf16_t, O_BQ); a.gn = INP(11) + l * 512;
          DUP(2) { const int tid_ = opaque_tid(F.wv0);
            if (cb < NB * 8 * NCHK) { const int b = cb / (8 * NCHK), rem = cb - b * 8 * NCHK, h = rem / NCHK, k = rem - h * NCHK; __syncthreads(); scan_stage(F.lds, a, (size_t)b * RPB + 64 * k - a.in_off, h, tid_); }
            for (int u = cb; u < NB * 8 * NCHK; u += Gd) { const int b = u / (8 * NCHK), rem = u - b * 8 * NCHK, h = rem / NCHK, k = rem - h * NCHK;
                const int un = u + Gd; const bool hn = un < NB * 8 * NCHK; const int nb_ = un / (8 * NCHK), nrem = un - nb_ * 8 * NCHK, nh_ = nrem / NCHK, nk_ = nrem - nh_ * NCHK;
                scan_s1_unit(F.lds, a, F.wv0, b, h, k, hn, nb_, nh_, nk_); } } }
        PH_END
        PH_BEGIN
        { ScanArgs a{}; a.ST = WSP(bf16_t, O_H); a.DS = WSP(float, O_DS);
          for (int t = cb; t < NB * 8 * 2 * 4; t += Gd) scan_s2_task(a, F.wv0, t); }
        { AttnArgs a{}; a.Q = WSP(bf16_t, O_CQ); a.qld = 768; a.qhs = 96; a.K1 = WSP(bf16_t, O_CKV); a.k1ld = 1024; a.k1hs = 128; a.kvgroup = 1; a.K2 = WSP(bf16_t, O_CKR); a.k2ld = 32; a.V = WSP(bf16_t, O_CKV) + 64; a.vld = 1024; a.vhs = 128;
          a.O = WSP(bf16_t, O_OC); a.old = 512; a.ohs = 64; a.scale_l2 = 0.10206207261596577f * LOG2E; a.sink = nullptr; a.window = 0; a.pad = (PROBE_VARIANT && p.mask != 0ull) ? 1 : 0;
          const int nqb = last ? 32 : 33;
          DUP(3) for (int u = cb; u < NB * 8 * nqb; u += Gd) { int b, h, qb; if (u < NB * 8 * 32) { b = u >> 8; h = u & 7; qb = (u >> 3) & 31; }     else { const int r_ = u - NB * 8 * 32; b = r_ >> 3; h = r_ & 7; qb = 32; }
              if (PROBE_VARIANT >= 6 && p.mask != 0ull) attn_unit<96, PROBE_VARIANT>(F.lds, a, F.wv0, b, qb, h); else attn_unit<96>(F.lds, a, F.wv0, b, qb, h); } }
        PH_END
        PH_BEGIN
        { ScanArgs a{}; a.BQ = WSP(bf16_t, O_BQ); a.BV = WSP(bf16_t, O_BV); a.BG = WSP(bf16_t, O_BG); a.BLF = WSP(f16_t, O_BLF); a.BLB = WSP(f16_t, O_BLB); a.ST = WSP(bf16_t, O_H); a.DS = WSP(float, O_DS); a.OB = WSP(bf16_t, O_BQ); a.gn = INP(11) + l * 512; a.skipctx_out = last ? 1 : 0;
          DUP(9) { a.pad = (((PROBE_DUP >> 9) & 1) && rep_ == 0) ? 1 : 0; const int tid_ = opaque_tid(F.wv0);
            if (cb < NB * 8 * NCHK) { const int b = cb / (8 * NCHK), rem = cb - b * 8 * NCHK, h = rem / NCHK, k = rem - h * NCHK; u32x4 t0, t1; __syncthreads(); scan_stage(F.lds, a, (size_t)b * RPB + 64 * k - a.in_off, h, tid_); s3_state_load(a, b, h, k, tid_, t0, t1); s3_state_store((LAS bf16_t*)(F.lds + SC_A), tid_, t0, t1); }
            for (int u = cb; u < NB * 8 * NCHK; u += Gd) { const int b = u / (8 * NCHK), rem = u - b * 8 * NCHK, h = rem / NCHK, k = rem - h * NCHK;
                const int un = u + Gd; const bool hn = un < NB * 8 * NCHK; const int nb_ = un / (8 * NCHK), nrem = un - nb_ * 8 * NCHK, nh_ = nrem / NCHK, nk_ = nrem - nh_ * NCHK;
                scan_s3_unit(F.lds, a, F.wv0, b, h, k, hn, nb_, nh_, nk_); } } }
        phase_rowpass1(F, l, false, O_CKV);
        PH_END
        PH_BEGIN
        { SchedGM S{}; S.A0 = WSP(bf16_t, O_AQ); S.A1 = WSP(bf16_t, O_BQ); S.A2 = WSP(bf16_t, O_OC); S.Ag = WSP(bf16_t, O_CKV); S.Bbr = WSP(bf16_t, O_WBR); S.Bg = WSP(bf16_t, O_WINP) + (size_t)3840 * 1024;
          S.nM = last ? 128 : 132; S.G_ = Gd; S.c = cb; S.skipctx = last ? 1 : 0; S.lda2 = 1024; S.ldb2 = 1024;
          EpiGM E{}; E.U = WSP(bf16_t, O_GATE); E.nstride = (long)G * 1024; E.ld = 1024;
          gp::gemm_phase<EpiGM, SchedGM>(glds, S, E, F.wv0); }
        PH_END
        PH_BEGIN
        { const int tid_ = opaque_tid(F.wv0), lane_ = tid_ & 63, wave_ = __builtin_amdgcn_readfirstlane(tid_ >> 6); const bf16_t* U = WSP(bf16_t, O_GATE); bf16_t* Y = WSP(bf16_t, O_H);
          for (int g = cb * 8 + wave_; g < G; g += Gd * 8) { if (last && (g % RPB) >= SEQ) continue;
#pragma unroll
              for (int j = 0; j < 2; ++j) { const size_t o = (size_t)g * 1024 + 8 * lane_ + 512 * j;
                  const u32x4 a = *(const u32x4*)(U + o), b2 = *(const u32x4*)(U + (size_t)G * 1024 + o), c2 = *(const u32x4*)(U + (size_t)2 * G * 1024 + o);
                  u32x4 w; w.x = pkbf(bflo(a.x) + bflo(b2.x) + bflo(c2.x), bfhi(a.x) + bfhi(b2.x) + bfhi(c2.x)); w.y = pkbf(bflo(a.y) + bflo(b2.y) + bflo(c2.y), bfhi(a.y) + bfhi(b2.y) + bfhi(c2.y));
                  w.z = pkbf(bflo(a.z) + bflo(b2.z) + bflo(c2.z), bfhi(a.z) + bfhi(b2.z) + bfhi(c2.z)); w.w = pkbf(bflo(a.w) + bflo(b2.w) + bflo(c2.w), bfhi(a.w) + bfhi(b2.w) + bfhi(c2.w));
                  *(u32x4*)(Y + o) = w; } } }
        PH_END
        PH_BEGIN
        { SchedStd S{}; S.A = WSP(bf16_t, O_H); S.Bt = WSP(bf16_t, O_WOUT); S.K = 1024; S.nM = last ? 128 : 132; S.nN = 4; S.G_ = Gd; S.c = cb; S.skipctx = last ? 1 : 0; S.lda2 = 2048; S.ldb2 = 2048;
          EpiOut E{}; E.xl_src = l == 0 ? INP(0) : F.out; E.xc_src = l == 0 ? INP(2) : WSP(float, O_XC); E.xl_dst = F.out; E.xc_dst = WSP(float, O_XC); E.mod = MODl; E.pmoff = 0;
          gp::gemm_phase<EpiOut, SchedStd>(glds, S, E, F.wv0); }
        PH_END
        PH_BEGIN phase_rowpass2(F, l, last); PH_END
        PH_BEGIN
        { LAS int* hist = (LAS int*)(F.lds + 131072); const int t_ = opaque_tid(F.wv0);
          if (t_ < 32) hist[t_] = 0;
          __syncthreads();
          SchedStd S{}; S.A = WSP(bf16_t, O_H); S.Bt = WSP(bf16_t, O_WRB) + (size_t)l * 256 * 1024; S.K = 1024; S.nM = last ? 128 : 132; S.nN = 1; S.G_ = Gd; S.c = cb; S.skipctx = last ? 1 : 0; S.lda2 = 2048; S.ldb2 = 2048;
          EpiRoute E{}; E.route_e = WSP(int, O_ROUTE_E); E.route_w = WSP(float, O_ROUTE_W); E.hist = hist;
          gp::gemm_phase<EpiRoute, SchedStd>(glds, S, E, F.wv0);
          __syncthreads();
          { const int t2_ = opaque_tid(F.wv0); if (t2_ < 32) WSP(int, O_WGH)[((size_t)l * 256 + cb) * 32 + t2_] = hist[t2_]; }
          __syncthreads(); }
        conv_weights_moe(F, l); if (!last) conv_weights_nonmoe(F, l + 1);
        PH_END
        PH_BEGIN phase_moe_scatter(F, l, last); PH_END
        PH_BEGIN
        { SchedMoE<true> S{}; S.A = WSP(bf16_t, O_H); S.Bt = WSP(bf16_t, O_WUP); S.tile_e = WSP(int, O_TILEE); S.goff = WSP(unsigned, O_GOFF); S.K = 1024; S.nM = WSP(int, O_TILEE)[NTILE]; S.nN = 2; S.G_ = Gd; S.c = cb; S.lda2 = 2048; S.ldb2 = 2048; S.strideB = 512 * 1024;
          EpiUp E{}; E.AUP = WSP(bf16_t, O_AUP);
          DUP(7) gp::gemm_phase<EpiUp, SchedMoE<true>>(glds, S, E, F.wv0); }
        PH_END
        PH_BEGIN
        { SchedMoE<false> S{}; S.A = WSP(bf16_t, O_AUP); S.Bt = WSP(bf16_t, O_WDN); S.tile_e = WSP(int, O_TILEE); S.goff = nullptr; S.K = 256; S.nM = WSP(int, O_TILEE)[NTILE]; S.nN = 4; S.G_ = Gd; S.c = cb; S.lda2 = 512; S.ldb2 = 512; S.strideB = 1024 * 256;
          EpiDown E{}; E.YM2 = WSP(bf16_t, O_YM2); E.perm = WSP(int, O_PERM); E.posw = WSP(float, O_POSW);
          DUP(8) gp::gemm_phase<EpiDown, SchedMoE<false>>(glds, S, E, F.wv0); }
        PH_END
    }
    PH_BEGIN phase_final(F); PH_END
#undef PH_BEGIN
#undef PH_END
}
constexpr int N_PHASES = 1 + 2 * 13 + 1;
}

#ifndef MK_N_LAUNCHES
#define MK_N_LAUNCHES 1
#endif
extern "C" void kernel_launch(void* const* d_in, const int* in_sizes, int n_in, void* d_out, int out_size, void* d_ws, size_t ws_size, hipStream_t stream) {
    static int grid = 0;
    if (grid == 0) {
        if (ws_size < WS_END) { grid = -1; return; }
        int dev = 0, cus = 0;
        if (hipGetDevice(&dev) != hipSuccess || hipDeviceGetAttribute(&cus, hipDeviceAttributeMultiprocessorCount, dev) != hipSuccess) { grid = -1; return; }
        if (hipFuncSetAttribute((const void*)hybrid_trunk_fwd, hipFuncAttributeMaxDynamicSharedMemorySize, LDS_BYTES) != hipSuccess) { grid = -1; return; }
        int per_cu = 0; (void)hipOccupancyMaxActiveBlocksPerMultiprocessor(&per_cu, (const void*)hybrid_trunk_fwd, 512, LDS_BYTES); (void)hipGetLastError();
        grid = cus;
    }
    if (grid < 0) return;
    (void)hipMemsetAsync(d_ws, 0, CTL_ZERO_BYTES, stream);
    KP p{}; for (int i = 0; i < 24; ++i) p.in[i] = (const float*)d_in[i]; p.out = (float*)d_out; p.ws = (char*)d_ws;
    (void)in_sizes; (void)n_in; (void)out_size;
    if (MK_N_LAUNCHES == 1) { p.ph_lo = 0; p.ph_hi = N_PHASES; hipLaunchKernelGGL(hybrid_trunk_fwd, dim3(grid), dim3(512), LDS_BYTES, stream, p);
        if (PROBE_EXTRA_MASK) { (void)hipMemsetAsync(d_ws, 0, CTL_ZERO_BYTES, stream); p.mask = PROBE_EXTRA_MASK; hipLaunchKernelGGL(hybrid_trunk_fwd, dim3(grid), dim3(512), LDS_BYTES, stream, p); } }
    else { for (int k = 0; k < N_PHASES; ++k) { p.ph_lo = k; p.ph_hi = k + 1; hipLaunchKernelGGL(hybrid_trunk_fwd, dim3(grid), dim3(512), LDS_BYTES, stream, p); } }
}
```

```cpp
#include <hip/hip_runtime.h>
#include <stdint.h>
#include <math.h>

namespace {
typedef unsigned short bf16_t;
typedef _Float16 f16_t;
typedef short bf16x8 __attribute__((ext_vector_type(8)));
typedef short s16x4 __attribute__((ext_vector_type(4)));
typedef float f32x4 __attribute__((ext_vector_type(4)));
typedef float f32x16 __attribute__((ext_vector_type(16)));
typedef unsigned u32x4 __attribute__((ext_vector_type(4)));
#define LAS __attribute__((address_space(3)))

constexpr int D = 1024, NB = 4, SEQ = 8192, CTXL = 256, RPB = SEQ + CTXL, G = NB * RPB;
constexpr int INW = 6816, MIXW = 3744, GATEW = 3072;
constexpr float EPS = 1e-6f;
constexpr float LOG2E = 1.4426950408889634f;
constexpr int PMAX = 75776;
constexpr int NTILE = PMAX / 256;

__device__ __forceinline__ float bf2f(bf16_t v) { return __uint_as_float(((unsigned)v) << 16); }
__device__ __forceinline__ bf16_t f2bf(float f) { unsigned u = __float_as_uint(f); u += 0x7fffu + ((u >> 16) & 1u); return (bf16_t)(u >> 16); }
typedef float f32x2v __attribute__((ext_vector_type(2)));
typedef __bf16 bf16x2v __attribute__((ext_vector_type(2)));
__device__ __forceinline__ unsigned pkbf(float lo, float hi) { const f32x2v v = {lo, hi}; const bf16x2v b = __builtin_convertvector(v, bf16x2v); return __builtin_bit_cast(unsigned, b); }
__device__ __forceinline__ unsigned pk2(float lo, float hi) { return (unsigned)f2bf(lo) | ((unsigned)f2bf(hi) << 16); }
__device__ __forceinline__ float silu_f(float v) { return v / (1.f + expf(-v)); }
__device__ __forceinline__ float sigmoid_f(float v) { return 1.f / (1.f + expf(-v)); }
__device__ __forceinline__ int opaque_tid(int wv) { unsigned z; asm volatile("s_mov_b32 %0, 0" : "=s"(z));
    int t = (wv << 6) | (int)__builtin_amdgcn_mbcnt_hi(~0u, __builtin_amdgcn_mbcnt_lo(~0u, z)); asm volatile("" : "+v"(t)); return t; }
__device__ __forceinline__ float shxl(float v, int k, int lane) { return __builtin_bit_cast(float, __builtin_amdgcn_ds_bpermute((lane ^ k) << 2, __builtin_bit_cast(int, v))); }
__device__ __forceinline__ int shxli(int v, int k, int lane) { return __builtin_amdgcn_ds_bpermute((lane ^ k) << 2, v); }
struct RowInfo { int b, r; bool lat; };
__device__ __forceinline__ RowInfo rowinfo(int g) { RowInfo ri; ri.b = g / RPB; ri.r = g - ri.b * RPB; ri.lat = ri.r < SEQ; return ri; }
__device__ __forceinline__ size_t xoff(const RowInfo& ri) { return ri.lat ? ((size_t)ri.b * SEQ + ri.r) * D : ((size_t)ri.b * CTXL + (ri.r - SEQ)) * D; }
__device__ __forceinline__ int crow(int r, int hi) { return (r & 3) + 8 * (r >> 2) + 4 * hi; }
__device__ __forceinline__ unsigned cvtpk(float lo, float hi) { return pkbf(lo, hi); }
typedef short v4i16_t __attribute__((ext_vector_type(4)));
__device__ __forceinline__ s16x4 vtr(const LAS char* p) { return __builtin_bit_cast(s16x4, __builtin_amdgcn_ds_read_tr16_b64_v4i16((LAS v4i16_t*)p)); }
#define MFMA32(a, b, c) __builtin_amdgcn_mfma_f32_32x32x16_bf16(a, b, c, 0, 0, 0)
#ifndef PROBE_VARIANT
#define PROBE_VARIANT 0
#endif
#if PROBE_VARIANT == 4
#define VTR_ASM(dst, addr, off) do { if (!p.pad) asm volatile("ds_read_b64_tr_b16 %0, %1 offset:" #off : "=v"(dst) : "v"(addr)); else asm volatile("" : "=v"(dst)); } while (0)
#else
#define VTR_ASM(dst, addr, off) asm volatile("ds_read_b64_tr_b16 %0, %1 offset:" #off : "=v"(dst) : "v"(addr))
#endif
struct AttnArgs { const bf16_t* Q; int qld, qhs; const bf16_t* K1; int k1ld, k1hs, kvgroup; const bf16_t* K2; int k2ld; const bf16_t* V; int vld, vhs;
                  bf16_t* O; int old, ohs; float scale_l2; const float* sink; int window; int pad; };
template <int DQK, int VAR = 0>
__device__ __forceinline__ void attn_unit(LAS char* lds, const AttnArgs& p, int wv0, int b, int qb, int h, bool nostore = false) {
    constexpr int NS = DQK / 16, NCH = DQK / 8; constexpr float THR = 8.f;
    constexpr int KB = 0, VB = 49152, WSF = 81920;
    const int tid = opaque_tid(wv0), lane = tid & 63, r32 = lane & 31, hi = lane >> 5, wid = tid >> 6;
    const int rb = b * RPB;
    const bool ctxq = (qb == 32);
    const int q0 = rb + (ctxq ? SEQ : qb * 256);
    int lat_k0 = 0, lat_k1 = 0;
    if (!ctxq) { if (p.window) { lat_k0 = qb * 256 - 128; if (lat_k0 < 0) lat_k0 = 0; lat_k1 = qb * 256 + 384; if (lat_k1 > SEQ) lat_k1 = SEQ; } else { lat_k0 = 0; lat_k1 = SEQ; } }
    const int ntiles = 4 + (lat_k1 - lat_k0) / 64;
    const int qrow = q0 + wid * 32 + r32;
    const int qpos = qb * 256 + wid * 32 + r32;
    const int wq0 = qb * 256 + wid * 32;
    LAS float* wsf = (LAS float*)(lds + WSF) + wid * 64;
    bf16x8 qr[NS];
#pragma unroll
    for (int s = 0; s < NS; ++s) qr[s] = *(const bf16x8*)(p.Q + (size_t)qrow * p.qld + h * p.qhs + 16 * s + 8 * hi);
    const int k1off = (h / p.kvgroup) * p.k1hs, voff = (h / p.kvgroup) * p.vhs;
    const int wv = __builtin_amdgcn_readfirstlane(wid);
    const bool k2nd = (NCH > 8) && (wv < NCH - 8);
    const size_t ksrc0 = (size_t)lane * p.k1ld + k1off + wv * 8, ksrc1 = (size_t)lane * p.k2ld + wv * 8;
    const size_t vsrc = (size_t)(16 * (wv & 3) + (lane >> 2)) * p.vld + voff + (wv >> 2) * 32 + (lane & 3) * 8;
#define AT_ROW0(it_) (rb + ((it_) >= 4 ? lat_k0 + 64 * ((it_) - 4) : SEQ + 64 * (it_)))
#define AT_DMAK(it_, slot_) do { if constexpr (VAR == 8) break; const size_t kr0_ = (size_t)AT_ROW0(it_); \
        __builtin_amdgcn_global_load_lds((const unsigned*)(p.K1 + kr0_ * p.k1ld + ksrc0), (LAS unsigned*)(lds + KB + (slot_) * 12288 + wv * 1024), 16, 0, 0); \
        if (k2nd) __builtin_amdgcn_global_load_lds((const unsigned*)(p.K2 + kr0_ * p.k2ld + ksrc1), (LAS unsigned*)(lds + KB + (slot_) * 12288 + (8 + wv) * 1024), 16, 0, 0); } while (0)
#define AT_DMAV(it_, slot_) do { if constexpr (VAR == 8) break; const size_t kr0_ = (size_t)AT_ROW0(it_); \
        __builtin_amdgcn_global_load_lds((const unsigned*)(p.V + kr0_ * p.vld + vsrc), (LAS unsigned*)(lds + VB + (slot_) * 8192 + wv * 1024), 16, 0, 0); } while (0)
#define AT_CLAMP(x_) ((x_) < ntiles ? (x_) : ntiles - 1)
#define AT_WAITBAR() do { if (k2nd) asm volatile("s_waitcnt vmcnt(6) lgkmcnt(0)" ::: "memory"); else asm volatile("s_waitcnt vmcnt(4) lgkmcnt(0)" ::: "memory"); if constexpr (VAR != 7) __builtin_amdgcn_s_barrier(); asm volatile("" ::: "memory"); } while (0)
#define AT_QK(C0, C1, slot_) do { const LAS char* ldsK_ = lds + KB + (slot_) * 12288 + hi * 1024 + r32 * 16; C0 = negm; C1 = negm; bf16x8 kf_[2 * NS]; \
        _Pragma("unroll") for (int s = 0; s < NS; ++s) { kf_[2 * s] = *(const LAS bf16x8*)(ldsK_ + s * 2048); kf_[2 * s + 1] = *(const LAS bf16x8*)(ldsK_ + s * 2048 + 512); } \
        __builtin_amdgcn_sched_group_barrier(0x100, 2 * NS, 0); \
        _Pragma("unroll") for (int s = 0; s < NS; ++s) { C0 = MFMA32(kf_[2 * s], qr[s], C0); C1 = MFMA32(kf_[2 * s + 1], qr[s], C1); } } while (0)
#define AT_REF(C0, C1, T_, first) do { const int tr_ = (T_); \
        if (p.window && tr_ >= 4) { const int kpos0 = lat_k0 + 64 * (tr_ - 4); \
            _Pragma("unroll") for (int r = 0; r < 16; ++r) { const int kp = kpos0 + crow(r, hi); int d0 = qpos - kp; if (d0 < 0) d0 = -d0; int d1 = qpos - (kp + 32); if (d1 < 0) d1 = -d1; \
                if (d0 > p.window) C0[r] = -1e30f; if (d1 > p.window) C1[r] = -1e30f; } } \
        if ((first) || (tr_ & 7) == 0) { \
        float mx = fmaxf(fmaxf(C0[0], C0[1]), C1[0]); \
        _Pragma("unroll") for (int r = 2; r < 16; r += 2) mx = fmaxf(fmaxf(mx, C0[r]), C0[r + 1]); \
        _Pragma("unroll") for (int r = 1; r < 15; r += 2) mx = fmaxf(fmaxf(mx, C1[r]), C1[r + 1]); \
        mx = fmaxf(mx, C1[15]); mx = fmaxf(mx, shxl(mx, 32, lane)); \
        if ((first) || __any(mx > THR)) { const float dl = (first) ? mx : fmaxf(mx, 0.f); \
            m += dl; const float alpha = __builtin_amdgcn_exp2f(-dl); l *= alpha; \
            _Pragma("unroll") for (int r = 0; r < 16; ++r) { C0[r] -= dl; C1[r] -= dl; negm[r] = -m; } \
            if (hi == 0) wsf[r32] = alpha; \
            _Pragma("unroll") for (int r = 0; r < 16; ++r) { const float f = wsf[crow(r, hi)]; o0[r] *= f; o1[r] *= f; } } } } while (0)
    f32x16 o0, o1, negm, cA0, cA1, cB0, cB1;
#pragma unroll
    for (int r = 0; r < 16; ++r) { o0[r] = 0.f; o1[r] = 0.f; negm[r] = 0.f; }
    float m = 0.f, l = 0.f;
    const int vlane = ((lane >> 4) & 1) * 32 + (lane & 3) * 8 + (4 * hi + ((lane & 15) >> 2)) * 64;
    asm volatile("s_waitcnt vmcnt(0) lgkmcnt(0)" ::: "memory"); __builtin_amdgcn_s_barrier(); asm volatile("" ::: "memory");
    AT_DMAK(0, 0); AT_DMAV(0, 0); AT_DMAK(AT_CLAMP(1), 1); AT_DMAV(AT_CLAMP(1), 1); AT_DMAK(AT_CLAMP(2), 2); AT_DMAV(AT_CLAMP(2), 2); AT_DMAK(AT_CLAMP(3), 3);
    asm volatile("s_waitcnt vmcnt(0)" ::: "memory"); __builtin_amdgcn_s_barrier(); asm volatile("" ::: "memory");
    AT_QK(cA0, cA1, 0);
    AT_REF(cA0, cA1, 0, true);
    asm volatile("s_waitcnt lgkmcnt(0)" ::: "memory"); __builtin_amdgcn_s_barrier(); asm volatile("" ::: "memory");
#define AT_SB() __builtin_amdgcn_sched_barrier(0)
#define AT_PIN2(x, y) asm volatile("" : "+v"(x), "+v"(y))
#define AT_PIN1(x) asm volatile("" : "+v"(x))
#define AT_PINRS() asm volatile("" : "+v"(ra_), "+v"(rb_))
#define AT_LDK(dst, addr_, off) asm volatile("ds_read_b128 %0, %1 offset:" #off : "=v"(dst) : "v"(addr_))
#define AT_WAITK(n, a, b) asm volatile("s_waitcnt lgkmcnt(" #n ")" : "+v"(a), "+v"(b))
#define AT_WAITV8(n, a, b, c, d, e, f, g, h) asm volatile("s_waitcnt lgkmcnt(" #n ")" : "+v"(a), "+v"(b), "+v"(c), "+v"(d), "+v"(e), "+v"(f), "+v"(g), "+v"(h))
#define AT_WAITV4(n, a, b, c, d) asm volatile("s_waitcnt lgkmcnt(" #n ")" : "+v"(a), "+v"(b), "+v"(c), "+v"(d))
#define AT_EXP(X) do { if constexpr (VAR != 6) X = __builtin_amdgcn_exp2f(X); } while (0)
#define AT_STEP(C0, C1, N0, N1, T_) do { const int t_ = (T_); const int t1_ = t_ + 1 < ntiles ? t_ + 1 : ntiles - 1; \
        AT_DMAK(AT_CLAMP(t_ + 4), t_ & 3); AT_DMAV(AT_CLAMP(t_ + 3), (t_ + 3) & 3); \
        const unsigned kaddr_ = (unsigned)(size_t)(lds + KB + ((t_ + 1) & 3) * 12288 + hi * 1024 + r32 * 16); const unsigned vaddr_ = (unsigned)(size_t)(lds + VB + (t_ & 3) * 8192 + vlane); \
        bf16x8 kfa0, kfa1, kfb0, kfb1, kfc0, kfc1; bf16x8 vf_[8]; s16x4 ta_[16]; f32x2v ra_ = {0.f, 0.f}, rb_ = {0.f, 0.f}; u32x4 pw[4]; \
        AT_LDK(kfa0, kaddr_, 0); AT_LDK(kfa1, kaddr_, 512); AT_LDK(kfb0, kaddr_, 2048); AT_LDK(kfb1, kaddr_, 2560); AT_SB(); \
        if constexpr (NS == 6) { \
          AT_LDK(kfc0, kaddr_, 4096); AT_LDK(kfc1, kaddr_, 4608); AT_WAITK(4, kfa0, kfa1); N0 = MFMA32(kfa0, qr[0], negm); AT_PIN1(N0); AT_EXP(C0[0]); AT_EXP(C0[1]); AT_EXP(C0[2]);  VTR_ASM(ta_[0], vaddr_, 0); AT_SB(); \
          N1 = MFMA32(kfa1, qr[0], negm); AT_PIN1(N1); AT_EXP(C0[3]); AT_EXP(C0[4]); AT_EXP(C0[5]);  VTR_ASM(ta_[1], vaddr_, 512); VTR_ASM(ta_[2], vaddr_, 4096); AT_SB(); \
          AT_LDK(kfa0, kaddr_, 6144); AT_LDK(kfa1, kaddr_, 6656); AT_WAITK(7, kfb0, kfb1); N0 = MFMA32(kfb0, qr[1], N0); AT_PIN1(N0); AT_EXP(C0[6]); AT_EXP(C0[7]); AT_EXP(C0[8]); VTR_ASM(ta_[3], vaddr_, 4608); AT_SB(); \
          N1 = MFMA32(kfb1, qr[1], N1); AT_PIN1(N1); AT_EXP(C0[9]); AT_EXP(C0[10]); AT_EXP(C0[11]); VTR_ASM(ta_[4], vaddr_, 1024); VTR_ASM(ta_[5], vaddr_, 1536); AT_SB(); \
          AT_LDK(kfb0, kaddr_, 8192); AT_LDK(kfb1, kaddr_, 8704); AT_WAITK(10, kfc0, kfc1); N0 = MFMA32(kfc0, qr[2], N0); AT_PIN1(N0); AT_EXP(C0[12]); AT_EXP(C0[13]); AT_EXP(C0[14]); VTR_ASM(ta_[6], vaddr_, 5120); AT_SB(); \
          N1 = MFMA32(kfc1, qr[2], N1); AT_PIN1(N1); AT_EXP(C0[15]); AT_EXP(C1[0]); AT_EXP(C1[1]); VTR_ASM(ta_[7], vaddr_, 5632); VTR_ASM(ta_[8], vaddr_, 2048); AT_SB(); \
          AT_LDK(kfc0, kaddr_, 10240); AT_LDK(kfc1, kaddr_, 10752); AT_WAITK(10, kfa0, kfa1); N0 = MFMA32(kfa0, qr[3], N0); AT_PIN1(N0); AT_EXP(C1[2]); AT_EXP(C1[3]); AT_EXP(C1[4]); VTR_ASM(ta_[9], vaddr_, 2560); AT_SB(); \
          N1 = MFMA32(kfa1, qr[3], N1); AT_PIN1(N1); AT_EXP(C1[5]); AT_EXP(C1[6]); AT_EXP(C1[7]); VTR_ASM(ta_[10], vaddr_, 6144); VTR_ASM(ta_[11], vaddr_, 6656); AT_SB(); \
           AT_WAITK(8, kfb0, kfb1); N0 = MFMA32(kfb0, qr[4], N0); AT_PIN1(N0); AT_EXP(C1[8]); AT_EXP(C1[9]); VTR_ASM(ta_[12], vaddr_, 3072); AT_SB(); \
          N1 = MFMA32(kfb1, qr[4], N1); AT_PIN1(N1); AT_EXP(C1[10]); AT_EXP(C1[11]); VTR_ASM(ta_[13], vaddr_, 3584); AT_SB(); \
           AT_WAITK(5, kfc0, kfc1); N0 = MFMA32(kfc0, qr[5], N0); AT_PIN1(N0); AT_EXP(C1[12]); AT_EXP(C1[13]); VTR_ASM(ta_[14], vaddr_, 7168); AT_SB(); \
          N1 = MFMA32(kfc1, qr[5], N1); AT_PIN1(N1); AT_EXP(C1[14]); AT_EXP(C1[15]); VTR_ASM(ta_[15], vaddr_, 7680); AT_SB(); \
          \
        } \
        if constexpr (NS == 4) { \
          AT_LDK(kfc0, kaddr_, 4096); AT_LDK(kfc1, kaddr_, 4608); AT_WAITK(4, kfa0, kfa1); N0 = MFMA32(kfa0, qr[0], negm); AT_PIN1(N0); AT_EXP(C0[0]); AT_EXP(C0[1]); AT_EXP(C0[2]); AT_EXP(C0[3]);  VTR_ASM(ta_[0], vaddr_, 0); AT_SB(); \
          N1 = MFMA32(kfa1, qr[0], negm); AT_PIN1(N1); AT_EXP(C0[4]); AT_EXP(C0[5]); AT_EXP(C0[6]); AT_EXP(C0[7]);  VTR_ASM(ta_[1], vaddr_, 512); VTR_ASM(ta_[2], vaddr_, 4096); VTR_ASM(ta_[3], vaddr_, 4608); AT_SB(); \
          AT_LDK(kfa0, kaddr_, 6144); AT_LDK(kfa1, kaddr_, 6656); AT_WAITK(8, kfb0, kfb1); N0 = MFMA32(kfb0, qr[1], N0); AT_PIN1(N0); AT_EXP(C0[8]); AT_EXP(C0[9]); AT_EXP(C0[10]); AT_EXP(C0[11]); VTR_ASM(ta_[4], vaddr_, 1024); AT_SB(); \
          N1 = MFMA32(kfb1, qr[1], N1); AT_PIN1(N1); AT_EXP(C0[12]); AT_EXP(C0[13]); AT_EXP(C0[14]); AT_EXP(C0[15]); VTR_ASM(ta_[5], vaddr_, 1536); VTR_ASM(ta_[6], vaddr_, 5120); VTR_ASM(ta_[7], vaddr_, 5632); AT_SB(); \
           AT_WAITK(10, kfc0, kfc1); N0 = MFMA32(kfc0, qr[2], N0); AT_PIN1(N0); AT_EXP(C1[0]); AT_EXP(C1[1]); AT_EXP(C1[2]); AT_EXP(C1[3]); VTR_ASM(ta_[8], vaddr_, 2048); AT_SB(); \
          N1 = MFMA32(kfc1, qr[2], N1); AT_PIN1(N1); AT_EXP(C1[4]); AT_EXP(C1[5]); AT_EXP(C1[6]); AT_EXP(C1[7]); VTR_ASM(ta_[9], vaddr_, 2560); VTR_ASM(ta_[10], vaddr_, 6144); VTR_ASM(ta_[11], vaddr_, 6656); AT_SB(); \
           AT_WAITK(8, kfa0, kfa1); N0 = MFMA32(kfa0, qr[3], N0); AT_PIN1(N0); AT_EXP(C1[8]); AT_EXP(C1[9]); AT_EXP(C1[10]); AT_EXP(C1[11]); VTR_ASM(ta_[12], vaddr_, 3072); AT_SB(); \
          N1 = MFMA32(kfa1, qr[3], N1); AT_PIN1(N1); AT_EXP(C1[12]); AT_EXP(C1[13]); AT_EXP(C1[14]); AT_EXP(C1[15]); VTR_ASM(ta_[13], vaddr_, 3584); VTR_ASM(ta_[14], vaddr_, 7168); VTR_ASM(ta_[15], vaddr_, 7680); AT_SB(); \
          \
        } \
        if constexpr (NS == 6) AT_WAITV8(9, ta_[0], ta_[1], ta_[2], ta_[3], ta_[4], ta_[5], ta_[6], ta_[7]); else AT_WAITV8(8, ta_[0], ta_[1], ta_[2], ta_[3], ta_[4], ta_[5], ta_[6], ta_[7]); AT_SB(); \
        vf_[0] = (bf16x8){ta_[0][0], ta_[0][1], ta_[0][2], ta_[0][3], ta_[1][0], ta_[1][1], ta_[1][2], ta_[1][3]}; vf_[1] = (bf16x8){ta_[2][0], ta_[2][1], ta_[2][2], ta_[2][3], ta_[3][0], ta_[3][1], ta_[3][2], ta_[3][3]}; vf_[2] = (bf16x8){ta_[4][0], ta_[4][1], ta_[4][2], ta_[4][3], ta_[5][0], ta_[5][1], ta_[5][2], ta_[5][3]}; vf_[3] = (bf16x8){ta_[6][0], ta_[6][1], ta_[6][2], ta_[6][3], ta_[7][0], ta_[7][1], ta_[7][2], ta_[7][3]}; \
        pw[0] = (u32x4){cvtpk(C0[0], C0[1]), cvtpk(C0[2], C0[3]), cvtpk(C0[4], C0[5]), cvtpk(C0[6], C0[7])}; AT_SB(); \
        if (!(PROBE_VARIANT == 2 && p.pad)) { \
        o0 = MFMA32(__builtin_bit_cast(bf16x8, pw[0]), vf_[0], o0); AT_PIN1(o0); pw[1].x = cvtpk(C0[8], C0[9]); pw[1].y = cvtpk(C0[10], C0[11]); ra_ += (f32x2v){C0[0], C0[1]}; rb_ += (f32x2v){C0[2], C0[3]}; AT_PINRS(); AT_SB(); \
        o1 = MFMA32(__builtin_bit_cast(bf16x8, pw[0]), vf_[1], o1); AT_PIN1(o1); pw[1].z = cvtpk(C0[12], C0[13]); pw[1].w = cvtpk(C0[14], C0[15]); ra_ += (f32x2v){C0[4], C0[5]}; rb_ += (f32x2v){C0[6], C0[7]}; AT_PINRS(); AT_SB(); \
        o0 = MFMA32(__builtin_bit_cast(bf16x8, pw[1]), vf_[2], o0); AT_PIN1(o0); pw[2].x = cvtpk(C1[0], C1[1]); pw[2].y = cvtpk(C1[2], C1[3]); ra_ += (f32x2v){C0[8], C0[9]}; rb_ += (f32x2v){C0[10], C0[11]}; AT_PINRS(); AT_SB(); \
        o1 = MFMA32(__builtin_bit_cast(bf16x8, pw[1]), vf_[3], o1); AT_PIN1(o1); pw[2].z = cvtpk(C1[4], C1[5]); pw[2].w = cvtpk(C1[6], C1[7]); ra_ += (f32x2v){C0[12], C0[13]}; rb_ += (f32x2v){C0[14], C0[15]}; AT_PINRS(); AT_SB(); \
        AT_WAITV4(4, ta_[8], ta_[9], ta_[10], ta_[11]); vf_[4] = (bf16x8){ta_[8][0], ta_[8][1], ta_[8][2], ta_[8][3], ta_[9][0], ta_[9][1], ta_[9][2], ta_[9][3]}; vf_[5] = (bf16x8){ta_[10][0], ta_[10][1], ta_[10][2], ta_[10][3], ta_[11][0], ta_[11][1], ta_[11][2], ta_[11][3]}; \
        o0 = MFMA32(__builtin_bit_cast(bf16x8, pw[2]), vf_[4], o0); AT_PIN1(o0); pw[3].x = cvtpk(C1[8], C1[9]); pw[3].y = cvtpk(C1[10], C1[11]); ra_ += (f32x2v){C1[0], C1[1]}; rb_ += (f32x2v){C1[2], C1[3]}; AT_PINRS(); AT_SB(); \
        o1 = MFMA32(__builtin_bit_cast(bf16x8, pw[2]), vf_[5], o1); AT_PIN1(o1); pw[3].z = cvtpk(C1[12], C1[13]); pw[3].w = cvtpk(C1[14], C1[15]); ra_ += (f32x2v){C1[4], C1[5]}; rb_ += (f32x2v){C1[6], C1[7]}; AT_PINRS(); AT_SB(); \
        AT_WAITV4(0, ta_[12], ta_[13], ta_[14], ta_[15]); vf_[6] = (bf16x8){ta_[12][0], ta_[12][1], ta_[12][2], ta_[12][3], ta_[13][0], ta_[13][1], ta_[13][2], ta_[13][3]}; vf_[7] = (bf16x8){ta_[14][0], ta_[14][1], ta_[14][2], ta_[14][3], ta_[15][0], ta_[15][1], ta_[15][2], ta_[15][3]}; \
        o0 = MFMA32(__builtin_bit_cast(bf16x8, pw[3]), vf_[6], o0); AT_PIN1(o0); ra_ += (f32x2v){C1[8], C1[9]}; rb_ += (f32x2v){C1[10], C1[11]}; AT_PINRS(); AT_SB(); \
        o1 = MFMA32(__builtin_bit_cast(bf16x8, pw[3]), vf_[7], o1); AT_PIN1(o1); ra_ += (f32x2v){C1[12], C1[13]}; rb_ += (f32x2v){C1[14], C1[15]}; AT_PINRS(); AT_SB(); } \
        l += (ra_[0] + ra_[1]) + (rb_[0] + rb_[1]); \
        AT_WAITBAR(); \
        if (t_ + 1 < ntiles) AT_REF(N0, N1, t1_, false); } while (0)
    for (int it = 0; it < ntiles; it += 2) {
        AT_STEP(cA0, cA1, cB0, cB1, it);
        AT_STEP(cB0, cB1, cA0, cA1, it + 1);
    }
#undef AT_ROW0
#undef AT_DMAK
#undef AT_DMAV
#undef AT_CLAMP
#undef AT_WAITBAR
#undef AT_REF
#undef AT_SB
#undef AT_PIN2
#undef AT_PIN1
#undef AT_PINRS
#undef AT_LDK
#undef AT_WAITK
#undef AT_WAITV8
#undef AT_WAITV4
#undef AT_EXP
#undef AT_QK
#undef AT_STEP
    float lt = l + shxl(l, 32, lane);
    float fin = 1.f;
    if (p.sink) { const float sk = p.sink[h] * LOG2E; const float m2 = fmaxf(m, sk); fin = __builtin_amdgcn_exp2f(m - m2); lt = lt * fin + __builtin_amdgcn_exp2f(sk - m2); }
    const float sc = fin / lt;
    if (hi == 0) wsf[r32] = sc;
    bf16_t* Ob = p.O + (size_t)(q0 + wid * 32) * p.old + h * p.ohs + r32;
#pragma unroll
    for (int r = 0; r < 16; ++r) { const int qr_ = crow(r, hi); const float f = wsf[qr_];
        if (!nostore) { Ob[(size_t)qr_ * p.old] = f2bf(o0[r] * f); Ob[(size_t)qr_ * p.old + 32] = f2bf(o1[r] * f); } }
}

namespace gp {
constexpr int BM = 256, BK = 64, HALF = 128, HTB = HALF * BK * 2, STAGE_BYTES = 8 * HTB, NXCD = 8, WGM = 8;
__host__ __device__ __forceinline__ int lds_byte(int r, int c) { const int st = (r >> 4) * 2 + (c >> 5), rr = r & 15, cc = c & 31, ob = rr * 64 + cc * 2; return st * 1024 + (ob ^ (((ob >> 9) & 1) << 5)); }
__host__ __device__ __forceinline__ void stage_rc(int b, int& R, int& C) { const int st = b / 1024, sb = b % 1024, swz = sb ^ (((sb >> 9) & 1) << 5); R = (st >> 1) * 16 + swz / 64; C = (st & 1) * 32 + (swz % 64) / 2; }
__host__ __device__ __forceinline__ int perm32(int rho) { const int n = rho >> 4, i = rho & 15; return 8 * (i >> 2) + 4 * n + (i & 3); }

struct GUnit { const char* A; const char* B; int nt, pm, pn, tag; const unsigned* goff; int lda2, ldb2; };

__device__ __forceinline__ bool tile_order(int i, int G_, int c, int nM, int nN, int& pm, int& pn) {
    const int nwg = nM * nN; const long L = (long)i * G_ + c; if (L >= nwg) return false;
    int wgid = (int)L; { const int q = nwg / NXCD, r = nwg % NXCD, xcd = wgid % NXCD, off = wgid / NXCD; wgid = (xcd < r ? xcd * (q + 1) : r * (q + 1) + (xcd - r) * q) + off; }
    const int nig = WGM * nN, gid = wgid / nig, fm = gid * WGM, gsz = (nM - fm) < WGM ? (nM - fm) : WGM;
    pm = fm + ((wgid % nig) % gsz); pn = (wgid % nig) / gsz; return true;
}
__device__ __forceinline__ unsigned cvt_pk_bf16(float lo, float hi) { return pkbf(lo, hi); }

template <class Epi, class Sched>
__device__ __forceinline__ void gemm_phase(LAS unsigned char* lds, const Sched& S, const Epi& E, int wv0) {
    constexpr bool GATHER = Sched::GATHER; constexpr bool VS = Sched::VARSTRIDE;
    const int tid = opaque_tid(wv0), wid = __builtin_amdgcn_readfirstlane(tid >> 6), lane = tid & 63, wr = wid >> 2, wc = wid & 3, fr = lane & 15, fq = lane >> 4;
    const int lda2 = S.lda2, ldb2 = S.ldb2;
    unsigned voffA[2], voffB[2], rowA[2], rowB[2], colb[2];
#pragma unroll
    for (int i = 0; i < 2; ++i) { int R, C; stage_rc(tid * 16 + i * 8192, R, C); const int Rb = Epi::PERM ? ((R & ~31) + perm32(R & 31)) : R;
        voffA[i] = GATHER ? (unsigned)C * 2u : (unsigned)R * (unsigned)lda2 + (unsigned)C * 2u; rowA[i] = (unsigned)R; voffB[i] = (unsigned)Rb * (unsigned)ldb2 + (unsigned)C * 2u; rowB[i] = (unsigned)Rb; colb[i] = (unsigned)C * 2u; }
    size_t hA = GATHER ? 0 : (size_t)HALF * lda2, hB = (size_t)HALF * ldb2;
    const unsigned ldsw = (unsigned)wid * 1024u;
    const int aoff = lds_byte(wr * 64 + fr, fq * 8), boff = lds_byte(wc * 32 + fr, fq * 8);
    constexpr size_t kstep = (size_t)(BK * 2);
#define GP_SA(b, h) (((b) * 2 + (h)) * HTB)
#define GP_SB(b, h) ((4 + (b) * 2 + (h)) * HTB)
#define GP_STAGE(bufoff, gbase, v0, v1) do { \
        __builtin_amdgcn_global_load_lds((const unsigned*)((const char*)(gbase) + (v0)), (LAS unsigned*)(lds + (bufoff) + ldsw), 16, 0, 0); \
        __builtin_amdgcn_global_load_lds((const unsigned*)((const char*)(gbase) + (v1)), (LAS unsigned*)(lds + (bufoff) + ldsw + 8192), 16, 0, 0); } while (0)
#define GP_LDA(dst, b, h) do { _Pragma("unroll") for (int m = 0; m < 4; ++m) _Pragma("unroll") for (int k = 0; k < 2; ++k) dst[m][k] = *(const LAS bf16x8*)(lds + GP_SA(b, h) + aoff + m * 2048 + k * 1024); } while (0)
#define GP_LDB(dst, b, h) do { _Pragma("unroll") for (int n = 0; n < 2; ++n) _Pragma("unroll") for (int k = 0; k < 2; ++k) dst[n][k] = *(const LAS bf16x8*)(lds + GP_SB(b, h) + boff + n * 2048 + k * 1024); } while (0)
#define GP_MMA(ai, bj, At, Bt) do { __builtin_amdgcn_s_setprio(1); _Pragma("unroll") for (int m = 0; m < 4; ++m) _Pragma("unroll") for (int n = 0; n < 2; ++n) _Pragma("unroll") for (int k = 0; k < 2; ++k) \
        acc[ai][bj][m][n] = __builtin_amdgcn_mfma_f32_16x16x32_bf16(Bt[n][k], At[m][k], acc[ai][bj][m][n], 0, 0, 0); __builtin_amdgcn_s_setprio(0); } while (0)
#define GP_WAIT_V(n) asm volatile("s_waitcnt vmcnt(" #n ")" ::: "memory")
#define GP_WAIT_L(n) asm volatile("s_waitcnt lgkmcnt(" #n ")" ::: "memory")
#define GP_BAR __builtin_amdgcn_s_barrier()
#define GP_SCHED __builtin_amdgcn_sched_barrier(0)
#define GP_GOFF(U, o0, o1, p0, p1) do { if (GATHER) { o0 = (U).goff[rowA[0]] + voffA[0]; o1 = (U).goff[rowA[1]] + voffA[1]; p0 = (U).goff[128 + rowA[0]] + voffA[0]; p1 = (U).goff[128 + rowA[1]] + voffA[1]; } \
        else { o0 = voffA[0]; o1 = voffA[1]; p0 = voffA[0]; p1 = voffA[1]; } } while (0)
    GUnit cur, nxt; int ui = 0;
    if (!S.next(0, cur)) return;
    f32x4 acc[2][2][4][2];
#pragma unroll
    for (int a = 0; a < 2; ++a)
#pragma unroll
        for (int b = 0; b < 2; ++b)
#pragma unroll
            for (int m = 0; m < 4; ++m)
#pragma unroll
                for (int n = 0; n < 2; ++n) acc[a][b][m][n] = (f32x4){0.f, 0.f, 0.f, 0.f};
    bf16x8 At[4][2], B0[2][2], B1[2][2];
    unsigned g00, g01, g10, g11;
    if (VS) { voffA[0] = rowA[0] * (unsigned)cur.lda2 + colb[0]; voffA[1] = rowA[1] * (unsigned)cur.lda2 + colb[1]; voffB[0] = rowB[0] * (unsigned)cur.ldb2 + colb[0]; voffB[1] = rowB[1] * (unsigned)cur.ldb2 + colb[1];
              hA = (size_t)HALF * cur.lda2; hB = (size_t)HALF * cur.ldb2; }
    GP_GOFF(cur, g00, g01, g10, g11);
    const char* cA = cur.A; const char* cB = cur.B;
    GP_STAGE(GP_SB(0, 0), cB, voffB[0], voffB[1]); GP_STAGE(GP_SA(0, 0), cA, g00, g01); GP_STAGE(GP_SB(0, 1), cB + hB, voffB[0], voffB[1]); GP_STAGE(GP_SA(0, 1), cA + hA, g10, g11);
    if (wr == 1) GP_BAR;
    GP_WAIT_V(4); GP_BAR;
    GP_STAGE(GP_SB(1, 0), cB + kstep, voffB[0], voffB[1]); GP_STAGE(GP_SA(1, 0), cA + kstep, g00, g01); GP_STAGE(GP_SB(1, 1), cB + hB + kstep, voffB[0], voffB[1]);
    GP_WAIT_V(6); GP_BAR;
    for (;;) {
        const bool has_next = S.next(ui + 1, nxt);
        const char* nA = has_next ? nxt.A : cA; const char* nB = has_next ? nxt.B : cB;
        const int nt = cur.nt;
        for (int t = 0; t < nt; t += 2) {
            const bool last = (t == nt - 2);
            const char* a1 = cA + (size_t)(t + 1) * kstep;
            const char* a2 = last ? nA : cA + (size_t)(t + 2) * kstep; const char* b2 = last ? nB : cB + (size_t)(t + 2) * kstep;
            const char* a3 = a2 + kstep; const char* b3 = b2 + kstep;
            unsigned w00 = g00, w01 = g01, w10 = g10, w11 = g11, wB0 = voffB[0], wB1 = voffB[1]; size_t whA = hA, whB = hB;
            if (GATHER && last && has_next) { GP_GOFF(nxt, w00, w01, w10, w11); }
            if (VS && last && has_next) { w00 = w10 = rowA[0] * (unsigned)nxt.lda2 + colb[0]; w01 = w11 = rowA[1] * (unsigned)nxt.lda2 + colb[1]; wB0 = rowB[0] * (unsigned)nxt.ldb2 + colb[0]; wB1 = rowB[1] * (unsigned)nxt.ldb2 + colb[1];
                whA = (size_t)HALF * nxt.lda2; whB = (size_t)HALF * nxt.ldb2; }
            GP_LDB(B0, 0, 0); GP_SCHED; GP_LDA(At, 0, 0); GP_STAGE(GP_SA(1, 1), a1 + hA, g10, g11);
            GP_WAIT_L(8); GP_BAR; GP_WAIT_L(0); GP_MMA(0, 0, At, B0); GP_BAR; GP_SCHED;
            GP_LDB(B1, 0, 1); GP_STAGE(GP_SB(0, 0), b2, wB0, wB1);
            GP_BAR; GP_WAIT_L(0); GP_MMA(0, 1, At, B1); GP_BAR;
            GP_LDA(At, 0, 1); GP_STAGE(GP_SA(0, 0), a2, w00, w01);
            GP_BAR; GP_WAIT_L(0); GP_MMA(1, 0, At, B0); GP_BAR; GP_SCHED;
            GP_STAGE(GP_SB(0, 1), b2 + whB, wB0, wB1);
            GP_WAIT_V(6); GP_BAR; GP_MMA(1, 1, At, B1); GP_BAR;
            GP_LDB(B0, 1, 0); GP_SCHED; GP_LDA(At, 1, 0); GP_STAGE(GP_SA(0, 1), a2 + whA, w10, w11);
            GP_WAIT_L(8); GP_BAR; GP_WAIT_L(0); GP_MMA(0, 0, At, B0); GP_BAR; GP_SCHED;
            GP_LDB(B1, 1, 1); GP_STAGE(GP_SB(1, 0), b3, wB0, wB1);
            GP_BAR; GP_WAIT_L(0); GP_MMA(0, 1, At, B1); GP_BAR;
            GP_LDA(At, 1, 1); GP_STAGE(GP_SA(1, 0), a3, w00, w01);
            GP_BAR; GP_WAIT_L(0); GP_MMA(1, 0, At, B0); GP_BAR; GP_SCHED;
            GP_STAGE(GP_SB(1, 1), b3 + whB, wB0, wB1);
            GP_WAIT_V(6); GP_BAR; GP_MMA(1, 1, At, B1); GP_BAR;
            if ((GATHER || VS) && last) { g00 = w00; g01 = w01; g10 = w10; g11 = w11; }
            if (VS && last) { voffB[0] = wB0; voffB[1] = wB1; hA = whA; hB = whB; }
        }
        { int fr_e = fr, fq_e = fq; asm volatile("" : "+v"(fr_e), "+v"(fq_e));
          E(acc, cur, wr, wc, fr_e, fq_e); }
        if (!has_next) break;
#pragma unroll
        for (int a = 0; a < 2; ++a)
#pragma unroll
            for (int b = 0; b < 2; ++b)
#pragma unroll
                for (int m = 0; m < 4; ++m)
#pragma unroll
                    for (int n = 0; n < 2; ++n) acc[a][b][m][n] = (f32x4){0.f, 0.f, 0.f, 0.f};
        cur = nxt; cA = nA; cB = nB; ++ui;
    }
    GP_WAIT_V(0);
    if (wr == 0) GP_BAR;
    GP_BAR;
#undef GP_SA
#undef GP_SB
#undef GP_STAGE
#undef GP_LDA
#undef GP_LDB
#undef GP_MMA
#undef GP_WAIT_V
#undef GP_WAIT_L
#undef GP_BAR
#undef GP_SCHED
#undef GP_GOFF
}
}

struct SchedStd {
    static constexpr bool GATHER = false; static constexpr bool VARSTRIDE = false;
    const bf16_t* A; const bf16_t* Bt; int K, nM, nN, G_, c, skipctx, lda2, ldb2;
    __device__ __forceinline__ bool next(int i, gp::GUnit& u) const {
        int pmv, pn; if (!gp::tile_order(i, G_, c, nM, nN, pmv, pn)) return false;
        const int pm = skipctx ? pmv + pmv / 32 : pmv;
        u.A = (const char*)(A + (size_t)pm * 256 * K); u.B = (const char*)(Bt + (size_t)pn * 256 * K); u.nt = K / 64; u.pm = pm; u.pn = pn; u.tag = 0; u.goff = nullptr; return true;
    }
};

__device__ __forceinline__ float fexp(float x) { return __builtin_amdgcn_exp2f(x * LOG2E); }
__device__ __forceinline__ float flog(float x) { return __builtin_amdgcn_logf(x) * 0.6931471805599453f; }
__device__ __forceinline__ float fsigmoid(float x) { return __builtin_amdgcn_rcpf(1.f + fexp(-x)); }
template <bool ZERO> __device__ __forceinline__ float logf_gate_fast(float z, float lb) {
    if constexpr (ZERO) return fminf(z, 0.f) - flog(1.f + fexp(-fabsf(z)));
    else return flog(lb + (1.f - lb) * fsigmoid(z));
}
__device__ __forceinline__ unsigned pkh2(float lo, float hi) { const f16_t a = (f16_t)lo, b = (f16_t)hi; return (unsigned)__builtin_bit_cast(unsigned short, a) | ((unsigned)__builtin_bit_cast(unsigned short, b) << 16); }

template <class T> __device__ __forceinline__ T* opq(T* p) { asm volatile("" : "+s"(p)); return p; }
struct EpiG1 {
    static constexpr bool PERM = true;
    bf16_t *AQ, *AK, *AV, *BQ, *BV, *BG; f16_t *BLF, *BLB; bf16_t *CQKV, *CKR; float* RS; const float *ropa_c, *ropa_s, *ropc_c, *ropc_s; const float* LBl; int rowoff; int lbzero;
    __device__ __forceinline__ void operator()(const f32x4 (&acc)[2][2][4][2], const gp::GUnit& u, int wr, int wc, int fr, int fq) const {
        const int pn = u.pn; const int pr = u.pm % 33; const bool lat = pr < 32;
        const int grow0 = u.pm * 256 + wr * 64 + fr; const int t0 = pr * 256 + wr * 64 + fr;
        if (pn < 3) {
            const int hh = pn * 4 + wc; bf16_t* dst; int ld, coff; bf16_t* const aq_ = opq(AQ); bf16_t* const ak_ = opq(AK); bf16_t* const av_ = opq(AV);
            if (hh < 8) { dst = aq_; ld = 512; coff = hh * 64; } else if (hh < 10) { dst = ak_; ld = 128; coff = (hh - 8) * 64; } else { dst = av_; ld = 128; coff = (hh - 10) * 64; }
            const bool rope = lat && hh < 10;
#pragma unroll
            for (int ai = 0; ai < 2; ++ai)
#pragma unroll
                for (int m = 0; m < 4; ++m) { const int grow = grow0 + ai * 128 + m * 16, t = t0 + ai * 128 + m * 16; const size_t row = (size_t)(grow - rowoff);
                    f32x4 x1a = acc[ai][0][m][0], x1b = acc[ai][0][m][1], x2a = acc[ai][1][m][0], x2b = acc[ai][1][m][1];
                    if (rope) { const f32x4 ca = *(const f32x4*)(ropa_c + t * 32 + 8 * fq), cb = *(const f32x4*)(ropa_c + t * 32 + 8 * fq + 4), sa = *(const f32x4*)(ropa_s + t * 32 + 8 * fq), sb = *(const f32x4*)(ropa_s + t * 32 + 8 * fq + 4);
                        const f32x4 o1a = x1a * ca - x2a * sa, o2a = x1a * sa + x2a * ca, o1b = x1b * cb - x2b * sb, o2b = x1b * sb + x2b * cb; x1a = o1a; x2a = o2a; x1b = o1b; x2b = o2b; }
                    if (hh < 8) { const float qs = 0.125f * LOG2E; x1a *= qs; x1b *= qs; x2a *= qs; x2b *= qs; }
                    bf16_t* p = dst + row * ld + coff + 8 * fq;
                    u32x4 w1, w2; w1.x = gp::cvt_pk_bf16(x1a[0], x1a[1]); w1.y = gp::cvt_pk_bf16(x1a[2], x1a[3]); w1.z = gp::cvt_pk_bf16(x1b[0], x1b[1]); w1.w = gp::cvt_pk_bf16(x1b[2], x1b[3]);
                    w2.x = gp::cvt_pk_bf16(x2a[0], x2a[1]); w2.y = gp::cvt_pk_bf16(x2a[2], x2a[3]); w2.z = gp::cvt_pk_bf16(x2b[0], x2b[1]); w2.w = gp::cvt_pk_bf16(x2b[2], x2b[3]);
                    *(u32x4*)p = w1; *(u32x4*)(p + 32) = w2; if (m == 3) asm volatile("" ::: "memory"); }
        } else if (pn < 13) {
            const int q = pn - 3, which = q >> 1; const int cb0 = (q & 1) * 256 + wc * 32 + 8 * fq;
            if (which == 2 || which == 3) {
                f16_t* const blf_ = opq(BLF); f16_t* const blb_ = opq(BLB); f16_t* dst = which == 2 ? blf_ : blb_; const float* lbp = LBl + (which == 2 ? 0 : 512);
                if (lbzero) {
#pragma unroll
                for (int bj = 0; bj < 2; ++bj) { const int c0 = cb0 + bj * 128; const f32x4 la = *(const f32x4*)(lbp + c0), lb4 = *(const f32x4*)(lbp + c0 + 4);
#pragma unroll
                    for (int ai = 0; ai < 2; ++ai)
#pragma unroll
                        for (int m = 0; m < 4; ++m) { const size_t row = (size_t)(grow0 + ai * 128 + m * 16 - rowoff); const f32x4 v0 = acc[ai][bj][m][0], v1 = acc[ai][bj][m][1];
                            u32x4 w; w.x = pkh2(logf_gate_fast<true>(v0[0], la[0]), logf_gate_fast<true>(v0[1], la[1])); w.y = pkh2(logf_gate_fast<true>(v0[2], la[2]), logf_gate_fast<true>(v0[3], la[3]));
                            w.z = pkh2(logf_gate_fast<true>(v1[0], lb4[0]), logf_gate_fast<true>(v1[1], lb4[1])); w.w = pkh2(logf_gate_fast<true>(v1[2], lb4[2]), logf_gate_fast<true>(v1[3], lb4[3]));
                            *(u32x4*)(dst + row * 512 + c0) = w; } }
                } else {
#pragma unroll
                for (int bj = 0; bj < 2; ++bj) { const int c0 = cb0 + bj * 128; const f32x4 la = *(const f32x4*)(lbp + c0), lb4 = *(const f32x4*)(lbp + c0 + 4);
#pragma unroll
                    for (int ai = 0; ai < 2; ++ai)
#pragma unroll
                        for (int m = 0; m < 4; ++m) { const size_t row = (size_t)(grow0 + ai * 128 + m * 16 - rowoff); const f32x4 v0 = acc[ai][bj][m][0], v1 = acc[ai][bj][m][1];
                            u32x4 w; w.x = pkh2(logf_gate_fast<false>(v0[0], la[0]), logf_gate_fast<false>(v0[1], la[1])); w.y = pkh2(logf_gate_fast<false>(v0[2], la[2]), logf_gate_fast<false>(v0[3], la[3]));
                            w.z = pkh2(logf_gate_fast<false>(v1[0], lb4[0]), logf_gate_fast<false>(v1[1], lb4[1])); w.w = pkh2(logf_gate_fast<false>(v1[2], lb4[2]), logf_gate_fast<false>(v1[3], lb4[3]));
                            *(u32x4*)(dst + row * 512 + c0) = w; } }
                }
            } else {
                bf16_t* const bq_ = opq(BQ); bf16_t* const bv_ = opq(BV); bf16_t* const bg_ = opq(BG); bf16_t* dst = which == 0 ? bq_ : (which == 1 ? bv_ : bg_);
#pragma unroll
                for (int ai = 0; ai < 2; ++ai)
#pragma unroll
                    for (int m = 0; m < 4; ++m) { const size_t row = (size_t)(grow0 + ai * 128 + m * 16 - rowoff);
#pragma unroll
                        for (int bj = 0; bj < 2; ++bj) { const f32x4 v0 = acc[ai][bj][m][0], v1 = acc[ai][bj][m][1];
                            u32x4 w; w.x = gp::cvt_pk_bf16(v0[0], v0[1]); w.y = gp::cvt_pk_bf16(v0[2], v0[3]); w.z = gp::cvt_pk_bf16(v1[0], v1[1]); w.w = gp::cvt_pk_bf16(v1[2], v1[3]);
                            *(u32x4*)(dst + row * 512 + cb0 + bj * 128) = w; } }
            }
        } else if (pn == 13) {
#pragma unroll
            for (int ai = 0; ai < 2; ++ai)
#pragma unroll
                for (int m = 0; m < 4; ++m) { const int grow = grow0 + ai * 128 + m * 16; const size_t row = (size_t)(grow - rowoff); float ss = 0.f;
#pragma unroll
                    for (int bj = 0; bj < 2; ++bj) { const f32x4 v0 = acc[ai][bj][m][0], v1 = acc[ai][bj][m][1];
                        ss += v0[0] * v0[0] + v0[1] * v0[1] + v0[2] * v0[2] + v0[3] * v0[3] + v1[0] * v1[0] + v1[1] * v1[1] + v1[2] * v1[2] + v1[3] * v1[3];
                        u32x4 w; w.x = gp::cvt_pk_bf16(v0[0], v0[1]); w.y = gp::cvt_pk_bf16(v0[2], v0[3]); w.z = gp::cvt_pk_bf16(v1[0], v1[1]); w.w = gp::cvt_pk_bf16(v1[2], v1[3]);
                        *(u32x4*)(CQKV + row * 384 + bj * 128 + wc * 32 + 8 * fq) = w; }
                    ss += shxl(ss, 16, fr | (fq << 4)); ss += shxl(ss, 32, fr | (fq << 4));
                    if (fq == 0) RS[(size_t)grow * 8 + wc] = ss; }
        } else {
#pragma unroll
            for (int ai = 0; ai < 2; ++ai)
#pragma unroll
                for (int m = 0; m < 4; ++m) { const int grow = grow0 + ai * 128 + m * 16, t = t0 + ai * 128 + m * 16; const size_t row = (size_t)(grow - rowoff);
                    const f32x4 v0 = acc[ai][0][m][0], v1 = acc[ai][0][m][1];
                    float ss = v0[0] * v0[0] + v0[1] * v0[1] + v0[2] * v0[2] + v0[3] * v0[3] + v1[0] * v1[0] + v1[1] * v1[1] + v1[2] * v1[2] + v1[3] * v1[3];
                    u32x4 w; w.x = gp::cvt_pk_bf16(v0[0], v0[1]); w.y = gp::cvt_pk_bf16(v0[2], v0[3]); w.z = gp::cvt_pk_bf16(v1[0], v1[1]); w.w = gp::cvt_pk_bf16(v1[2], v1[3]);
                    *(u32x4*)(CQKV + row * 384 + 256 + wc * 32 + 8 * fq) = w;
                    ss += shxl(ss, 16, fr | (fq << 4)); ss += shxl(ss, 32, fr | (fq << 4));
                    if (fq == 0) RS[(size_t)grow * 8 + 4 + wc] = ss;
                    if (wc == 0) { f32x4 x1 = acc[ai][1][m][0], x2 = acc[ai][1][m][1];
                        if (lat) { const f32x4 cc = *(const f32x4*)(ropc_c + t * 16 + 4 * fq), sn = *(const f32x4*)(ropc_s + t * 16 + 4 * fq); const f32x4 o1 = x1 * cc - x2 * sn, o2 = x1 * sn + x2 * cc; x1 = o1; x2 = o2; }
                        *(uint2*)(CKR + row * 32 + 4 * fq) = make_uint2(gp::cvt_pk_bf16(x1[0], x1[1]), gp::cvt_pk_bf16(x1[2], x1[3]));
                        *(uint2*)(CKR + row * 32 + 16 + 4 * fq) = make_uint2(gp::cvt_pk_bf16(x2[0], x2[1]), gp::cvt_pk_bf16(x2[2], x2[3])); } }
        }
    }
};

struct EpiC {
    static constexpr bool PERM = true;
    bf16_t *CQ, *CKV; const float* RS; const float *ropc_c, *ropc_s; int pmoff;
    __device__ __forceinline__ void operator()(const f32x4 (&acc)[2][2][4][2], const gp::GUnit& u, int wr, int wc, int fr, int fq) const {
        const int pn = u.pn; const int pr = (u.pm + pmoff) % 33; const bool lat = pr < 32;
        const int grow0 = u.pm * 256 + wr * 64 + fr; const int t0 = pr * 256 + wr * 64 + fr;
        f32x4 rs4[2][4];
#pragma unroll
        for (int ai = 0; ai < 2; ++ai)
#pragma unroll
            for (int m = 0; m < 4; ++m) rs4[ai][m] = *(const f32x4*)(RS + (size_t)(grow0 + ai * 128 + m * 16) * 8 + (pn < 3 ? 0 : 4));
#pragma unroll
        for (int ai = 0; ai < 2; ++ai)
#pragma unroll
            for (int m = 0; m < 4; ++m) { const size_t row = (size_t)(grow0 + ai * 128 + m * 16); const int t = t0 + ai * 128 + m * 16;
                if (pn < 3) { const f32x4 p4 = rs4[ai][m]; const float rq = rsqrtf(((p4[0] + p4[1]) + (p4[2] + p4[3])) * (1.f / 256.f) + EPS) * (0.10206207261596577f * LOG2E);
#pragma unroll
                    for (int bj = 0; bj < 2; ++bj) { const int gi = pn * 8 + bj * 4 + wc, head = gi / 3, part = gi - head * 3;
                        f32x4 v0 = acc[ai][bj][m][0] * rq, v1 = acc[ai][bj][m][1] * rq;
                        bf16_t* p = CQ + row * 768 + head * 96;
                        if (part < 2) { u32x4 w; w.x = gp::cvt_pk_bf16(v0[0], v0[1]); w.y = gp::cvt_pk_bf16(v0[2], v0[3]); w.z = gp::cvt_pk_bf16(v1[0], v1[1]); w.w = gp::cvt_pk_bf16(v1[2], v1[3]);
                            *(u32x4*)(p + part * 32 + 8 * fq) = w; }
                        else { if (lat) { const f32x4 cc = *(const f32x4*)(ropc_c + t * 16 + 4 * fq), sn = *(const f32x4*)(ropc_s + t * 16 + 4 * fq); const f32x4 o1 = v0 * cc - v1 * sn, o2 = v0 * sn + v1 * cc; v0 = o1; v1 = o2; }
                            *(uint2*)(p + 64 + 4 * fq) = make_uint2(gp::cvt_pk_bf16(v0[0], v0[1]), gp::cvt_pk_bf16(v0[2], v0[3]));
                            *(uint2*)(p + 80 + 4 * fq) = make_uint2(gp::cvt_pk_bf16(v1[0], v1[1]), gp::cvt_pk_bf16(v1[2], v1[3])); } }
                } else { const f32x4 p4 = rs4[ai][m]; const float rkv = rsqrtf(((p4[0] + p4[1]) + (p4[2] + p4[3])) * (1.f / 128.f) + EPS);
#pragma unroll
                    for (int bj = 0; bj < 2; ++bj) { const f32x4 v0 = acc[ai][bj][m][0] * rkv, v1 = acc[ai][bj][m][1] * rkv;
                        u32x4 w; w.x = gp::cvt_pk_bf16(v0[0], v0[1]); w.y = gp::cvt_pk_bf16(v0[2], v0[3]); w.z = gp::cvt_pk_bf16(v1[0], v1[1]); w.w = gp::cvt_pk_bf16(v1[2], v1[3]);
                        *(u32x4*)(CKV + row * 1024 + (pn - 3) * 256 + bj * 128 + wc * 32 + 8 * fq) = w; } } }
    }
};
struct EpiGate {
    static constexpr bool PERM = true;
    bf16_t* GATE; long nstride; int ld;
    __device__ __forceinline__ void operator()(const f32x4 (&acc)[2][2][4][2], const gp::GUnit& u, int wr, int wc, int fr, int fq) const {
        const int n3 = u.pn >> 2; bf16_t* base = GATE + (size_t)n3 * nstride + (u.pn & 3) * 256 + wc * 32 + 8 * fq; const int row0 = u.pm * 256 + wr * 64 + fr;
#pragma unroll
        for (int ai = 0; ai < 2; ++ai)
#pragma unroll
            for (int m = 0; m < 4; ++m) { bf16_t* rp = base + (size_t)(row0 + ai * 128 + m * 16) * ld;
#pragma unroll
                for (int bj = 0; bj < 2; ++bj) { const f32x4 v0 = acc[ai][bj][m][0], v1 = acc[ai][bj][m][1];
                    u32x4 w; w.x = gp::cvt_pk_bf16(fsigmoid(v0[0]), fsigmoid(v0[1])); w.y = gp::cvt_pk_bf16(fsigmoid(v0[2]), fsigmoid(v0[3])); w.z = gp::cvt_pk_bf16(fsigmoid(v1[0]), fsigmoid(v1[1])); w.w = gp::cvt_pk_bf16(fsigmoid(v1[2]), fsigmoid(v1[3]));
                    *(u32x4*)(rp + bj * 128) = w; } }
    }
};
struct SchedMerge {
    static constexpr bool GATHER = false; static constexpr bool VARSTRIDE = false;
    const bf16_t *A0, *A1, *A2; const bf16_t* Bt; int nM, G_, c, skipctx, lda2, ldb2;
    __device__ __forceinline__ bool next(int i, gp::GUnit& u) const {
        int pmv, pn12; if (!gp::tile_order(i, G_, c, nM, 12, pmv, pn12)) return false;
        const int n = pn12 >> 2, pn = pn12 & 3;
        const int pm = skipctx ? pmv + pmv / 32 : pmv;
        const bf16_t* a0 = opq(A0); const bf16_t* a1 = opq(A1); const bf16_t* a2 = opq(A2);
        const bf16_t* a = n == 0 ? a0 : (n == 1 ? a1 : a2);
        u.A = (const char*)(a + (size_t)pm * 256 * 512); u.B = (const char*)(Bt + (size_t)n * 1024 * 512 + (size_t)pn * 256 * 512); u.nt = 8; u.pm = pm; u.pn = pn; u.tag = n; u.goff = nullptr; return true;
    }
};
__device__ __forceinline__ float bflo(unsigned w) { return __uint_as_float(w << 16); }
__device__ __forceinline__ float bfhi(unsigned w) { return __uint_as_float(w & 0xffff0000u); }
struct EpiMerge {
    static constexpr bool PERM = true;
    bf16_t* GATE; long nstride; int ld;
    __device__ __forceinline__ void operator()(const f32x4 (&acc)[2][2][4][2], const gp::GUnit& u, int wr, int wc, int fr, int fq) const {
        if (PROBE_VARIANT == 3 && ld < 0) return;
        const int n3 = u.tag; const int col = u.pn * 256 + wc * 32 + 8 * fq; bf16_t* gb = GATE + (size_t)n3 * nstride + col; const int row0 = u.pm * 256 + wr * 64 + fr;
#pragma unroll
        for (int ai = 0; ai < 2; ++ai) { u32x4 g[4][2];
#pragma unroll
            for (int m = 0; m < 4; ++m)
#pragma unroll
                for (int bj = 0; bj < 2; ++bj) g[m][bj] = *(const u32x4*)(gb + (size_t)(row0 + ai * 128 + m * 16) * ld + bj * 128);
#pragma unroll
            for (int m = 0; m < 4; ++m)
#pragma unroll
                for (int bj = 0; bj < 2; ++bj) { const u32x4 gg = g[m][bj]; const f32x4 v0 = acc[ai][bj][m][0], v1 = acc[ai][bj][m][1];
                    u32x4 w; w.x = gp::cvt_pk_bf16(v0[0] * bflo(gg.x), v0[1] * bfhi(gg.x)); w.y = gp::cvt_pk_bf16(v0[2] * bflo(gg.y), v0[3] * bfhi(gg.y));
                    w.z = gp::cvt_pk_bf16(v1[0] * bflo(gg.z), v1[1] * bfhi(gg.z)); w.w = gp::cvt_pk_bf16(v1[2] * bflo(gg.w), v1[3] * bfhi(gg.w));
                    *(u32x4*)(gb + (size_t)(row0 + ai * 128 + m * 16) * ld + bj * 128) = w; }
            asm volatile("" ::: "memory"); }
    }
};
struct SchedGM {
    static constexpr bool GATHER = false; static constexpr bool VARSTRIDE = true;
    const bf16_t *A0, *A1, *A2, *Ag; const bf16_t *Bbr, *Bg; int nM, G_, c, skipctx, lda2, ldb2;
    __device__ __forceinline__ bool next(int i, gp::GUnit& u) const {
        int pmv, pn12; if (!gp::tile_order(i >> 1, G_, c, nM, 12, pmv, pn12)) return false;
        const int kind = i & 1, n = pn12 >> 2, pn = pn12 & 3;
        const int pm = skipctx ? pmv + pmv / 32 : pmv;
        const bf16_t* a0 = opq(A0); const bf16_t* a1 = opq(A1); const bf16_t* a2 = opq(A2); const bf16_t* ag = opq(Ag);
        const bf16_t* a = n == 0 ? a0 : (n == 1 ? a1 : a2);
        if (kind == 0) { u.A = (const char*)(a + (size_t)pm * 256 * 512); u.B = (const char*)(Bbr + (size_t)n * 1024 * 512 + (size_t)pn * 256 * 512); u.nt = 8; u.lda2 = 1024; u.ldb2 = 1024; }
        else { u.A = (const char*)(ag + (size_t)pm * 256 * 1024); u.B = (const char*)(Bg + (size_t)pn12 * 256 * 1024); u.nt = 16; u.lda2 = 2048; u.ldb2 = 2048; }
        u.pm = pm; u.pn = pn; u.tag = n + 4 * kind; u.goff = nullptr; return true;
    }
};
struct EpiGM {
    static constexpr bool PERM = true;
    bf16_t* U; long nstride; int ld;
    __device__ __forceinline__ void operator()(const f32x4 (&acc)[2][2][4][2], const gp::GUnit& u, int wr, int wc, int fr, int fq) const {
        const int n3 = u.tag & 3; const int col = u.pn * 256 + wc * 32 + 8 * fq; bf16_t* gb = U + (size_t)n3 * nstride + col; const int row0 = u.pm * 256 + wr * 64 + fr;
        if (u.tag < 4) {
#pragma unroll
            for (int ai = 0; ai < 2; ++ai)
#pragma unroll
                for (int m = 0; m < 4; ++m)
#pragma unroll
                    for (int bj = 0; bj < 2; ++bj) { const f32x4 v0 = acc[ai][bj][m][0], v1 = acc[ai][bj][m][1];
                        u32x4 w; w.x = gp::cvt_pk_bf16(v0[0], v0[1]); w.y = gp::cvt_pk_bf16(v0[2], v0[3]); w.z = gp::cvt_pk_bf16(v1[0], v1[1]); w.w = gp::cvt_pk_bf16(v1[2], v1[3]);
                        *(u32x4*)(gb + (size_t)(row0 + ai * 128 + m * 16) * ld + bj * 128) = w; }
        } else {
#pragma unroll
            for (int ai = 0; ai < 2; ++ai) { u32x4 z[4][2];
#pragma unroll
                for (int m = 0; m < 4; ++m)
#pragma unroll
                    for (int bj = 0; bj < 2; ++bj) z[m][bj] = *(const u32x4*)(gb + (size_t)(row0 + ai * 128 + m * 16) * ld + bj * 128);
#pragma unroll
                for (int m = 0; m < 4; ++m)
#pragma unroll
                    for (int bj = 0; bj < 2; ++bj) { const u32x4 zz = z[m][bj]; const f32x4 v0 = acc[ai][bj][m][0], v1 = acc[ai][bj][m][1];
                        u32x4 w; w.x = gp::cvt_pk_bf16(fsigmoid(v0[0]) * bflo(zz.x), fsigmoid(v0[1]) * bfhi(zz.x)); w.y = gp::cvt_pk_bf16(fsigmoid(v0[2]) * bflo(zz.y), fsigmoid(v0[3]) * bfhi(zz.y));
                        w.z = gp::cvt_pk_bf16(fsigmoid(v1[0]) * bflo(zz.z), fsigmoid(v1[1]) * bfhi(zz.z)); w.w = gp::cvt_pk_bf16(fsigmoid(v1[2]) * bflo(zz.w), fsigmoid(v1[3]) * bfhi(zz.w));
                        *(u32x4*)(gb + (size_t)(row0 + ai * 128 + m * 16) * ld + bj * 128) = w; }
                asm volatile("" ::: "memory"); }
        }
    }
};
struct EpiOut {
    static constexpr bool PERM = false;
    const float *xl_src, *xc_src; float *xl_dst, *xc_dst; const float* mod; int pmoff;
    __device__ __forceinline__ void operator()(const f32x4 (&acc)[2][2][4][2], const gp::GUnit& u, int wr, int wc, int fr, int fq) const {
        const int gpm = u.pm + pmoff, b = gpm / 33, pr = gpm - b * 33; const bool lat = pr < 32;
        const float* xs = opq(lat ? xl_src : xc_src); float* xd = opq(lat ? xl_dst : xc_dst);
        const size_t rbase = lat ? ((size_t)b * SEQ + pr * 256) : ((size_t)b * CTXL);
        const float* gt = mod + (size_t)(lat ? b : 4) * 6144 + 2048; const int col0 = u.pn * 256 + wc * 32 + 4 * fq;
        f32x4 g4[2][2];
#pragma unroll
        for (int bj = 0; bj < 2; ++bj)
#pragma unroll
            for (int n = 0; n < 2; ++n) g4[bj][n] = *(const f32x4*)(gt + col0 + bj * 128 + n * 16);
#pragma unroll
        for (int ai = 0; ai < 2; ++ai) { f32x4 xv[4][2][2];
#pragma unroll
            for (int m = 0; m < 4; ++m) { const size_t off = (rbase + ai * 128 + wr * 64 + m * 16 + fr) * D + col0;
#pragma unroll
                for (int bj = 0; bj < 2; ++bj)
#pragma unroll
                    for (int n = 0; n < 2; ++n) xv[m][bj][n] = *(const f32x4*)(xs + off + bj * 128 + n * 16); }
#pragma unroll
            for (int m = 0; m < 4; ++m) { const size_t off = (rbase + ai * 128 + wr * 64 + m * 16 + fr) * D + col0;
#pragma unroll
                for (int bj = 0; bj < 2; ++bj)
#pragma unroll
                    for (int n = 0; n < 2; ++n) *(f32x4*)(xd + off + bj * 128 + n * 16) = xv[m][bj][n] + g4[bj][n] * acc[ai][bj][m][n]; }
            asm volatile("" ::: "memory"); }
    }
};
template <bool GATHER_> struct SchedMoE {
    static constexpr bool GATHER = GATHER_; static constexpr bool VARSTRIDE = false;
    const bf16_t* A; const bf16_t* Bt; const int* tile_e; const unsigned* goff; int K, nM, nN, G_, c, lda2, ldb2; long strideB;
    __device__ __forceinline__ bool next(int i, gp::GUnit& u) const {
        int pm, pn; if (!gp::tile_order(i, G_, c, nM, nN, pm, pn)) return false;
        const int e = tile_e[pm];
        u.A = GATHER ? (const char*)A : (const char*)(A + (size_t)pm * 256 * K); u.B = (const char*)(Bt + (size_t)e * strideB + (size_t)pn * 256 * K); u.nt = K / 64; u.pm = pm; u.pn = pn; u.tag = e;
        u.goff = GATHER ? goff + (size_t)pm * 256 : nullptr; return true;
    }
};
struct EpiUp {
    static constexpr bool PERM = true;
    bf16_t* AUP;
    __device__ __forceinline__ void operator()(const f32x4 (&acc)[2][2][4][2], const gp::GUnit& u, int wr, int wc, int fr, int fq) const {
        const int row0 = u.pm * 256 + wr * 64 + fr; bf16_t* base = AUP + u.pn * 128 + wc * 32 + 8 * fq;
#pragma unroll
        for (int ai = 0; ai < 2; ++ai)
#pragma unroll
            for (int m = 0; m < 4; ++m) { const f32x4 a0 = acc[ai][0][m][0], a1 = acc[ai][0][m][1], b0 = acc[ai][1][m][0], b1 = acc[ai][1][m][1];
                float r[8];
#pragma unroll
                for (int e = 0; e < 4; ++e) { r[e] = a0[e] * fsigmoid(a0[e]) * b0[e]; r[4 + e] = a1[e] * fsigmoid(a1[e]) * b1[e]; }
                u32x4 w; w.x = gp::cvt_pk_bf16(r[0], r[1]); w.y = gp::cvt_pk_bf16(r[2], r[3]); w.z = gp::cvt_pk_bf16(r[4], r[5]); w.w = gp::cvt_pk_bf16(r[6], r[7]);
                *(u32x4*)(base + (size_t)(row0 + ai * 128 + m * 16) * 256) = w; }
    }
};
struct EpiDown {
    static constexpr bool PERM = true;
    bf16_t* YM2; const int* perm; const float* posw;
    __device__ __forceinline__ void operator()(const f32x4 (&acc)[2][2][4][2], const gp::GUnit& u, int wr, int wc, int fr, int fq) const {
        const int row0 = u.pm * 256 + wr * 64 + fr; const int col = u.pn * 256 + wc * 32 + 8 * fq;
        int pe8[2][4]; float w88[2][4];
#pragma unroll
        for (int ai = 0; ai < 2; ++ai)
#pragma unroll
            for (int m = 0; m < 4; ++m) { const int pos = row0 + ai * 128 + m * 16; pe8[ai][m] = perm[pos]; w88[ai][m] = posw[pos]; }
#pragma unroll
        for (int ai = 0; ai < 2; ++ai)
#pragma unroll
            for (int m = 0; m < 4; ++m) { const int pe = pe8[ai][m]; const float w8 = w88[ai][m];
                if (pe >= 0) {
#pragma unroll
                    for (int bj = 0; bj < 2; ++bj) { const f32x4 v0 = acc[ai][bj][m][0] * w8, v1 = acc[ai][bj][m][1] * w8;
                        u32x4 w; w.x = gp::cvt_pk_bf16(v0[0], v0[1]); w.y = gp::cvt_pk_bf16(v0[2], v0[3]); w.z = gp::cvt_pk_bf16(v1[0], v1[1]); w.w = gp::cvt_pk_bf16(v1[2], v1[3]);
                        *(u32x4*)(YM2 + (size_t)pe * 1024 + col + bj * 128) = w; } } }
    }
};
enum { MAP_WIN = 1, MAP_WC = 2, MAP_WUP = 3 };
__device__ __forceinline__ int colmap(int kind, int p) {
    if (kind == MAP_WIN) {
        if (p >= 3840) return MIXW + (p - 3840);
        const int pn = p >> 8, q = p & 255, bj = q >> 7, wc = (q >> 5) & 3, j = q & 31;
        if (pn < 3) return (pn * 4 + wc) * 64 + bj * 32 + j;
        if (pn < 14) return p;
        if (bj == 0) return p;
        if (wc != 0) return -1;
        return 3712 + 16 * ((j >> 2) & 1) + 4 * (j >> 3) + (j & 3);
    }
    return p;
}
constexpr int NCHK = RPB / 64;
struct ScanArgs { const bf16_t* BQ; const bf16_t* BV; const bf16_t* BG; const f16_t* BLF; const f16_t* BLB; bf16_t* ST; float* DS; bf16_t* OB; const float* gn; int in_off; int out_off; int skipctx_out; int pad; };
#define MFMA16(a, b, c) __builtin_amdgcn_mfma_f32_16x16x32_bf16(a, b, c, 0, 0, 0)
constexpr int BCS = 68;
constexpr int SC_RAW = 0, SC_VT = 2 * 64 * BCS * 4, SC_A = SC_VT + 9216;
typedef _Float16 sc_h8 __attribute__((ext_vector_type(8)));
struct StageRegs { sc_h8 lf, lb; bf16x8 v; };
__device__ __forceinline__ void scan_stage_load(const ScanArgs& a, size_t row0, int h, int tid, StageRegs& R) {
    const int row = tid >> 3, c8 = (tid & 7) * 8; const size_t off = (row0 + row) * 512 + h * 64 + c8;
    R.lf = *(const sc_h8*)(a.BLF + off); R.lb = *(const sc_h8*)(a.BLB + off);
    const int vrow = tid & 63, vc8 = (tid >> 6) * 8; R.v = *(const bf16x8*)(a.BV + (row0 + vrow) * 512 + h * 64 + vc8);
}
__device__ __forceinline__ void scan_stage_store(LAS char* lds, int tid, const StageRegs& R) {
    LAS float* RAW = (LAS float*)(lds + SC_RAW); LAS bf16_t* VT = (LAS bf16_t*)(lds + SC_VT);
    const int row = tid >> 3, c8 = (tid & 7) * 8; const int vrow = tid & 63, vc8 = (tid >> 6) * 8; const sc_h8 lf = R.lf, lb = R.lb; const bf16x8 v = R.v;
    *(LAS f32x4*)(RAW + row * BCS + c8) = (f32x4){(float)lf[0], (float)lf[1], (float)lf[2], (float)lf[3]}; *(LAS f32x4*)(RAW + row * BCS + c8 + 4) = (f32x4){(float)lf[4], (float)lf[5], (float)lf[6], (float)lf[7]};
    *(LAS f32x4*)(RAW + 64 * BCS + row * BCS + c8) = (f32x4){(float)lb[0], (float)lb[1], (float)lb[2], (float)lb[3]}; *(LAS f32x4*)(RAW + 64 * BCS + row * BCS + c8 + 4) = (f32x4){(float)lb[4], (float)lb[5], (float)lb[6], (float)lb[7]};
#pragma unroll
    for (int j = 0; j < 8; ++j) VT[(vc8 + j) * 72 + vrow] = (bf16_t)v[j];
}
__device__ __forceinline__ void scan_stage(LAS char* lds, const ScanArgs& a, size_t row0, int h, int tid) { StageRegs R; scan_stage_load(a, row0, h, tid, R); scan_stage_store(lds, tid, R); }
__device__ __forceinline__ void scan_cumsum(LAS char* lds, LAS float* XCH, int tid, float (&lf)[16], float (&bc)[16], float& total) {
    LAS float* RAW = (LAS float*)(lds + SC_RAW);
    const int col = tid & 127, dir = col >> 6, d = col & 63, seg = tid >> 7;
#pragma unroll
    for (int j = 0; j < 16; ++j) lf[j] = RAW[dir * 64 * BCS + (16 * seg + j) * BCS + d];
    if (dir == 0) { float c = 0.f;
#pragma unroll
        for (int j = 0; j < 16; ++j) { c += lf[j]; bc[j] = c; } }
    else { float c = 0.f;
#pragma unroll
        for (int j = 15; j >= 0; --j) { c += lf[j]; bc[j] = c; } }
    XCH[seg * 128 + col] = dir == 0 ? bc[15] : bc[0];
    __syncthreads();
    const float t0 = XCH[col], t1 = XCH[128 + col], t2 = XCH[256 + col], t3 = XCH[384 + col];
    total = (t0 + t1) + (t2 + t3);
    float off;
    if (dir == 0) off = seg == 0 ? 0.f : (seg == 1 ? t0 : (seg == 2 ? t0 + t1 : t0 + t1 + t2));
    else off = seg == 3 ? 0.f : (seg == 2 ? t3 : (seg == 1 ? t3 + t2 : t3 + t2 + t1));
#pragma unroll
    for (int j = 0; j < 16; ++j) bc[j] += off;
}
__device__ __forceinline__ void scan_s1_unit(LAS char* lds, const ScanArgs& a, int wv0, int b, int h, int k, bool hasnext, int nb, int nh, int nk) {
    const int tid = opaque_tid(wv0), lane = tid & 63, wid = tid >> 6;
    LAS bf16_t* VT = (LAS bf16_t*)(lds + SC_VT); LAS bf16_t* KKT = (LAS bf16_t*)(lds + SC_A); LAS float* XCH = (LAS float*)(lds + SC_A + 18432);
    const size_t row0 = (size_t)b * RPB + 64 * k - a.in_off;
    __syncthreads();
    float lf[16], bc[16], total; scan_cumsum(lds, XCH, tid, lf, bc, total);
    const int col = tid & 127, dir = col >> 6, d = col & 63, seg = tid >> 7;
    const size_t sidx = ((size_t)((b * 8 + h) * 2 + dir)) * NCHK + k;
    { unsigned w[8];
#pragma unroll
      for (int j = 0; j < 16; j += 2) { const float k0 = (1.f - fexp(lf[j])) * fexp(total - bc[j]), k1 = (1.f - fexp(lf[j + 1])) * fexp(total - bc[j + 1]); w[j >> 1] = pkbf(k0, k1); }
      LAS u32x4* kp = (LAS u32x4*)(KKT + (dir * 64 + d) * 72 + 16 * seg); kp[0] = (u32x4){w[0], w[1], w[2], w[3]}; kp[1] = (u32x4){w[4], w[5], w[6], w[7]};
      if (seg == 0) a.DS[sidx * 64 + d] = fexp(total); }
    __syncthreads();
    StageRegs R; if (hasnext) scan_stage_load(a, (size_t)nb * RPB + 64 * nk - a.in_off, nh, tid, R);
    { const int wdir = wid >> 2, et = wid & 3, fr = lane & 15, fq = lane >> 4;
      f32x4 acc[4];
#pragma unroll
      for (int dt = 0; dt < 4; ++dt) acc[dt] = (f32x4){0.f, 0.f, 0.f, 0.f};
#pragma unroll
      for (int ks = 0; ks < 2; ++ks) { const bf16x8 af = *(const LAS bf16x8*)(VT + (16 * et + fr) * 72 + 32 * ks + 8 * fq);
#pragma unroll
          for (int dt = 0; dt < 4; ++dt) { const bf16x8 bfv = *(const LAS bf16x8*)(KKT + (wdir * 64 + 16 * dt + fr) * 72 + 32 * ks + 8 * fq); acc[dt] = MFMA16(bfv, af, acc[dt]); } }
      bf16_t* sp = a.ST + (((size_t)((b * 8 + h) * 2 + wdir)) * NCHK + k) * 4096;
#pragma unroll
      for (int dt = 0; dt < 4; ++dt) *(uint2*)(sp + (16 * et + fr) * 64 + 16 * dt + 4 * fq) = make_uint2(pkbf(acc[dt][0], acc[dt][1]), pkbf(acc[dt][2], acc[dt][3])); }
    __syncthreads();
    if (hasnext) scan_stage_store(lds, tid, R);
}
__device__ __forceinline__ void scan_s2_task(const ScanArgs& a, int wv0, int task) {
    const int chain = task >> 2, quarter = task & 3, dir = chain & 1, tid = opaque_tid(wv0);
    const int e = 16 * quarter + (tid >> 5), d = 2 * (tid & 31);
    float s0 = 0.f, s1 = 0.f;
    for (int g = 0; g < NCHK; g += 12) {
        unsigned L[12]; float2 Dv[12]; unsigned* pp[12];
#pragma unroll
        for (int j = 0; j < 12; ++j) { const int step = g + j; const int k = dir == 0 ? (step < 4 ? 128 + step : step - 4) : (step < 4 ? 131 - step : 131 - step);
            const size_t idx = (size_t)chain * NCHK + k; pp[j] = (unsigned*)(a.ST + idx * 4096 + e * 64 + d); L[j] = *pp[j]; Dv[j] = *(const float2*)(a.DS + idx * 64 + d); }
#pragma unroll
        for (int j = 0; j < 12; ++j) { *pp[j] = pkbf(s0, s1); s0 = Dv[j].x * s0 + bflo(L[j]); s1 = Dv[j].y * s1 + bfhi(L[j]); }
    }
}
__device__ __forceinline__ void s3_state_load(const ScanArgs& a, int b, int h, int k, int tid, u32x4& s0, u32x4& s1) {
    const int sd = tid >> 8, e = (tid & 255) >> 2, c16 = (tid & 3) * 16; const bf16_t* sp = a.ST + (((size_t)((b * 8 + h) * 2 + sd)) * NCHK + k) * 4096 + e * 64 + c16; s0 = *(const u32x4*)sp; s1 = *(const u32x4*)(sp + 8); }
__device__ __forceinline__ void s3_state_store(LAS bf16_t* STL, int tid, const u32x4& s0, const u32x4& s1) {
    const int sd = tid >> 8, e = (tid & 255) >> 2, c16 = (tid & 3) * 16; LAS u32x4* dp = (LAS u32x4*)(STL + (sd * 64 + e) * 72 + c16); dp[0] = s0; dp[1] = s1; }
__device__ __forceinline__ void scan_s3_unit(LAS char* lds, const ScanArgs& a, int wv0, int b, int h, int k, bool hasnext, int nb, int nh, int nk) {
    const int tid = opaque_tid(wv0), lane = tid & 63, wid = tid >> 6;
    LAS float* BC = (LAS float*)(lds + SC_RAW); LAS bf16_t* VT = (LAS bf16_t*)(lds + SC_VT);
    LAS bf16_t* STL = (LAS bf16_t*)(lds + SC_A);
    LAS float* XCH = (LAS float*)(lds + SC_A + 18432);
    LAS float* OSUM = (LAS float*)(lds + SC_A + 18432 + 2048);
    LAS bf16_t* PW = (LAS bf16_t*)(lds + SC_A + 18432 + 2048 + 17408) + wid * 3456;
    const size_t row0 = (size_t)b * RPB + 64 * k - a.in_off;
    bf16x8 q0_, q1_; uint2 gp[4];
    { const int dir_ = wid >> 2, si_ = wid & 3, erow_ = lane >> 2, dg_ = (lane & 3) * 16, fr_ = lane & 15, fq_ = lane >> 4;
      const bf16_t* qp = a.BQ + (row0 + 16 * si_ + erow_) * 512 + h * 64 + dg_; q0_ = *(const bf16x8*)qp; q1_ = *(const bf16x8*)(qp + 8);
#pragma unroll
      for (int n = 0; n < 4; ++n) { gp[n] = make_uint2(0u, 0u); if (dir_ == 1) gp[n] = *(const uint2*)(a.BG + (row0 + 16 * si_ + fr_) * 512 + h * 64 + 16 * n + 4 * fq_); } }
    __syncthreads();
    { float lf[16], bc[16], total; scan_cumsum(lds, XCH, tid, lf, bc, total);
      const int col = tid & 127, dir = col >> 6, d = col & 63, seg = tid >> 7;
      __syncthreads();
#pragma unroll
      for (int j = 0; j < 16; ++j) BC[dir * 64 * BCS + (16 * seg + j) * BCS + d] = bc[j]; }
    __syncthreads();
    StageRegs Rn; u32x4 ns0, ns1;
    if (hasnext) { scan_stage_load(a, (size_t)nb * RPB + 64 * nk - a.in_off, nh, tid, Rn); s3_state_load(a, nb, nh, nk, tid, ns0, ns1); }
    const int dir = wid >> 2, si = wid & 3;
    LAS bf16_t* QP = PW; LAS bf16_t* KP = PW + 1152; LAS bf16_t* ATT = PW + 2304;
    const int erow = lane >> 2, dg = (lane & 3) * 16;
    const int fr = lane & 15, fq = lane >> 4;
    LAS const float* bcd = BC + dir * 64 * BCS;
    float refv[16];
    { const int rr = dir == 0 ? 16 * si - 1 : 16 * (si + 1);
#pragma unroll
      for (int j = 0; j < 16; j += 4) { f32x4 t4 = (f32x4){0.f, 0.f, 0.f, 0.f}; if (rr >= 0 && rr < 64) t4 = *(const LAS f32x4*)(bcd + rr * BCS + dg + j); refv[j] = t4[0]; refv[j + 1] = t4[1]; refv[j + 2] = t4[2]; refv[j + 3] = t4[3]; } }
    float qv[16], bq[16];
    {
#pragma unroll
      for (int j = 0; j < 8; ++j) { qv[j] = bf2f((bf16_t)q0_[j]); qv[8 + j] = bf2f((bf16_t)q1_[j]); }
#pragma unroll
      for (int j = 0; j < 16; j += 4) { const f32x4 t4 = *(const LAS f32x4*)(bcd + (16 * si + erow) * BCS + dg + j); bq[j] = t4[0]; bq[j + 1] = t4[1]; bq[j + 2] = t4[2]; bq[j + 3] = t4[3]; } }
    { unsigned w[8];
#pragma unroll
      for (int j = 0; j < 16; j += 2) w[j >> 1] = pkbf(qv[j] * fexp(bq[j] - refv[j]), qv[j + 1] * fexp(bq[j + 1] - refv[j + 1]));
      LAS u32x4* p = (LAS u32x4*)(QP + erow * 72 + dg); p[0] = (u32x4){w[0], w[1], w[2], w[3]}; p[1] = (u32x4){w[4], w[5], w[6], w[7]};
      LAS u32x4* z = (LAS u32x4*)(ATT + erow * 72 + dg); z[0] = (u32x4){0u, 0u, 0u, 0u}; z[1] = (u32x4){0u, 0u, 0u, 0u}; }
    const int j_lo = dir == 0 ? 0 : si, j_hi = dir == 0 ? si : 3;
    for (int jb = j_lo; jb <= j_hi; ++jb) {
        { const int sg = 16 * jb + erow; const int sn = dir == 0 ? sg - 1 : sg + 1; unsigned w[8];
#pragma unroll
          for (int j = 0; j < 16; j += 4) { const f32x4 bs4 = *(const LAS f32x4*)(bcd + sg * BCS + dg + j); f32x4 bn4 = (f32x4){0.f, 0.f, 0.f, 0.f}; if (sn >= 0 && sn < 64) bn4 = *(const LAS f32x4*)(bcd + sn * BCS + dg + j);
              float kk[4];
#pragma unroll
              for (int t = 0; t < 4; ++t) kk[t] = (1.f - fexp(bs4[t] - bn4[t])) * fexp(fminf(refv[j + t] - bs4[t], 60.f));
              w[j >> 1] = pkbf(kk[0], kk[1]); w[(j >> 1) + 1] = pkbf(kk[2], kk[3]); }
          LAS u32x4* p = (LAS u32x4*)(KP + erow * 72 + dg); p[0] = (u32x4){w[0], w[1], w[2], w[3]}; p[1] = (u32x4){w[4], w[5], w[6], w[7]}; }
        __builtin_amdgcn_wave_barrier(); asm volatile("s_waitcnt lgkmcnt(0)" ::: "memory");
        f32x4 c = (f32x4){0.f, 0.f, 0.f, 0.f};
#pragma unroll
        for (int ks = 0; ks < 2; ++ks) { const bf16x8 af = *(const LAS bf16x8*)(QP + fr * 72 + 32 * ks + 8 * fq), bfv = *(const LAS bf16x8*)(KP + fr * 72 + 32 * ks + 8 * fq); c = MFMA16(af, bfv, c); }
#pragma unroll
        for (int r = 0; r < 4; ++r) { const int tq = 4 * fq + r; float v = c[r];
            if (jb == si) { if (dir == 0 ? (fr > tq) : (fr < tq)) v = 0.f; }
            ATT[tq * 72 + 16 * jb + fr] = f2bf(v); }
        __builtin_amdgcn_wave_barrier(); asm volatile("s_waitcnt lgkmcnt(0)" ::: "memory");
    }
    { unsigned w[8];
#pragma unroll
      for (int j = 0; j < 16; j += 2) w[j >> 1] = pkbf(qv[j] * fexp(bq[j]), qv[j + 1] * fexp(bq[j + 1]));
      LAS u32x4* p = (LAS u32x4*)(QP + erow * 72 + dg); p[0] = (u32x4){w[0], w[1], w[2], w[3]}; p[1] = (u32x4){w[4], w[5], w[6], w[7]}; }
    __builtin_amdgcn_wave_barrier(); asm volatile("s_waitcnt lgkmcnt(0)" ::: "memory");
    f32x4 o[4];
#pragma unroll
    for (int n = 0; n < 4; ++n) o[n] = (f32x4){0.f, 0.f, 0.f, 0.f};
#pragma unroll
    for (int ks = 0; ks < 2; ++ks) { const bf16x8 aq = *(const LAS bf16x8*)(QP + fr * 72 + 32 * ks + 8 * fq), aa = *(const LAS bf16x8*)(ATT + fr * 72 + 32 * ks + 8 * fq);
#pragma unroll
        for (int n = 0; n < 4; ++n) { const bf16x8 bs = *(const LAS bf16x8*)(STL + (dir * 64 + 16 * n + fr) * 72 + 32 * ks + 8 * fq), bv = *(const LAS bf16x8*)(VT + (16 * n + fr) * 72 + 32 * ks + 8 * fq);
            o[n] = MFMA16(bs, aq, o[n]); o[n] = MFMA16(bv, aa, o[n]); } }
    if (dir == 0) {
#pragma unroll
        for (int n = 0; n < 4; ++n) *(LAS f32x4*)(OSUM + (16 * si + fr) * 68 + 16 * n + 4 * fq) = o[n]; }
    __syncthreads();
    if (hasnext) { scan_stage_store(lds, tid, Rn); s3_state_store(STL, tid, ns0, ns1); }
    if (dir == 1) {
        const bool wr_out = !(a.skipctx_out && k >= 128) && !a.pad;
        float ss = 0.f;
#pragma unroll
        for (int n = 0; n < 4; ++n) { o[n] += *(const LAS f32x4*)(OSUM + (16 * si + fr) * 68 + 16 * n + 4 * fq); ss += o[n][0] * o[n][0] + o[n][1] * o[n][1] + o[n][2] * o[n][2] + o[n][3] * o[n][3]; }
        ss += shxl(ss, 16, lane); ss += shxl(ss, 32, lane); const float rn = rsqrtf(ss * (1.f / 64.f) + EPS);
        if (wr_out) {
            const size_t orow0 = (size_t)b * RPB + 64 * k - a.out_off;
#pragma unroll
            for (int n = 0; n < 4; ++n) { const f32x4 g4 = *(const f32x4*)(a.gn + h * 64 + 16 * n + 4 * fq);
                const float gv0 = bflo(gp[n].x), gv1 = bfhi(gp[n].x), gv2 = bflo(gp[n].y), gv3 = bfhi(gp[n].y);
                const float y0 = o[n][0] * rn * g4[0] * gv0 * fsigmoid(gv0), y1 = o[n][1] * rn * g4[1] * gv1 * fsigmoid(gv1), y2 = o[n][2] * rn * g4[2] * gv2 * fsigmoid(gv2), y3 = o[n][3] * rn * g4[3] * gv3 * fsigmoid(gv3);
                *(uint2*)(a.OB + (orow0 + 16 * si + fr) * 512 + h * 64 + 16 * n + 4 * fq) = make_uint2(pkbf(y0, y1), pkbf(y2, y3)); }
        }
    }
    __syncthreads();
}
constexpr int SCAN_LDS = SC_A + 18432 + 2048 + 17408 + 8 * 6912;

#define XB_TMO      128
#define XB_XCNT(j)  (256  + 64 * (j))
#define XB_XSUB(j)  (1280 + 64 * (j))
#define XB_XGEN(j)  (2304 + 64 * (j))
#define XB_TOP      3328
#define XB_TOPGEN   3392
#define XCD_BAR_WORDS 3456
#define XB_SPIN_CAP (1u << 18)

__device__ __forceinline__ unsigned xb_ld(unsigned* p)              { return __hip_atomic_load(p, __ATOMIC_RELAXED, __HIP_MEMORY_SCOPE_AGENT); }
__device__ __forceinline__ unsigned xb_add(unsigned* p, unsigned v) { return __hip_atomic_fetch_add(p, v, __ATOMIC_RELAXED, __HIP_MEMORY_SCOPE_AGENT); }
__device__ __forceinline__ unsigned xb_xcc_id() { return (unsigned)__builtin_amdgcn_s_getreg((3 << 11) | 20) & 0xFu; }
#define XB_SPIN(cond, bar) do { unsigned _sp = 0; while (cond) { __builtin_amdgcn_s_sleep(1); \
    if ((++_sp & 255u) == 0u) { if (xb_ld(&(bar)[XB_TMO])) break; if (_sp > XB_SPIN_CAP) { atomicAdd(&(bar)[XB_TMO], 1u); break; } } } } while (0)

struct XcdBarrier {
    unsigned* bar; unsigned x;
    volatile LAS unsigned* st;
};

__device__ __forceinline__ XcdBarrier xcd_barrier_post(unsigned* bar, volatile LAS unsigned* st) {
    XcdBarrier b; b.bar = bar; b.x = xb_xcc_id(); b.st = st;
    if (threadIdx.x == 0) (void)xb_add(&bar[XB_XCNT(b.x)], 1u);
    return b;
}
__device__ __forceinline__ void xcd_barrier_complete(unsigned* bar, unsigned x, unsigned& nloc, unsigned& nx) {
    const unsigned G = gridDim.x * gridDim.y * gridDim.z;
    unsigned sum, cnt, mine, sp = 0u;
    for (;;) {
        sum = 0u; cnt = 0u; mine = 0u;
#pragma unroll
        for (unsigned j = 0; j < 16; ++j) { const unsigned c = xb_ld(&bar[XB_XCNT(j)]); sum += c; cnt += (c > 0u) ? 1u : 0u; mine = (j == x) ? c : mine; }
        if (sum == G) break;
        __builtin_amdgcn_s_sleep(1);
        if ((++sp & 255u) == 0u) { if (xb_ld(&bar[XB_TMO])) break; if (sp > XB_SPIN_CAP) { atomicAdd(&bar[XB_TMO], 1u); break; } }
    }
    nloc = mine > 0u ? mine : 1u; nx = cnt > 0u ? cnt : 1u;
}

__device__ __forceinline__ void xcd_barrier(const XcdBarrier& b) {
    asm volatile("s_waitcnt vmcnt(0)" ::: "memory");
    __syncthreads();
    if (threadIdx.x == 0) {
        unsigned* bar = b.bar;
        __builtin_amdgcn_s_waitcnt(0);
        unsigned nloc = b.st[0], nx = b.st[1];
        if (nloc == 0u) { xcd_barrier_complete(bar, b.x, nloc, nx); b.st[0] = nloc; b.st[1] = nx; }
        const unsigned old = xb_add(&bar[XB_XSUB(b.x)], 1u);
        const unsigned gen = old / nloc;
        if (old + 1u == (gen + 1u) * nloc) {
            __builtin_amdgcn_fence(__ATOMIC_RELEASE, "agent");
            asm volatile("s_waitcnt vmcnt(0)" ::: "memory");
            const unsigned og = xb_add(&bar[XB_TOP], 1u);
            const unsigned tg = og / nx;
            if (og + 1u == (tg + 1u) * nx) xb_add(&bar[XB_TOPGEN], 1u);
            else XB_SPIN(xb_ld(&bar[XB_TOPGEN]) == tg, bar);
            __builtin_amdgcn_fence(__ATOMIC_ACQUIRE, "agent");
            xb_add(&bar[XB_XGEN(b.x)], 1u);
            asm volatile("s_waitcnt vmcnt(0)" ::: "memory");
        } else {
            XB_SPIN(xb_ld(&bar[XB_XGEN(b.x)]) == gen, bar);
            __builtin_amdgcn_fence(__ATOMIC_ACQUIRE, "agent");
            asm volatile("s_waitcnt vmcnt(0)" ::: "memory");
        }
    }
    __syncthreads();
}


constexpr size_t MiB = 1u << 20;
constexpr size_t CTL_ZERO_BYTES = 64 * 1024;
constexpr int CW_COUNTS = 8192, CW_CURSOR = 8192 + 128;
constexpr size_t O_MOD = 1 * MiB, O_LB = 1 * MiB + 512 * 1024, O_ROPA_C = 2 * MiB, O_ROPA_S = 3 * MiB, O_ROPC_C = 4 * MiB, O_ROPC_S = 4 * MiB + 512 * 1024, O_XC = 5 * MiB;
constexpr size_t O_ROUTE_E = 9 * MiB, O_ROUTE_W = 9 * MiB + 512 * 1024, O_PERM = 10 * MiB, O_POSW = 10 * MiB + 512 * 1024, O_GOFF = 11 * MiB, O_TILEE = 11 * MiB + 512 * 1024;
constexpr size_t O_WRT = 11 * MiB + 640 * 1024;
constexpr size_t O_RS = 12 * MiB, O_DS = 13 * MiB + 512 * 1024, O_WGH = 15 * MiB + 768 * 1024;
constexpr size_t O_WINP = 16 * MiB, O_WC = 30 * MiB, O_WBR = 32 * MiB, O_WOUT = 35 * MiB;
constexpr size_t O_H = 38 * MiB;
constexpr size_t O_AQ = 104 * MiB, O_AK = 137 * MiB, O_AV = 145 * MiB + 512 * 1024;
constexpr size_t O_BQ = 154 * MiB, O_BV = 187 * MiB, O_BG = 220 * MiB, O_BLF = 253 * MiB, O_BLB = 286 * MiB;
constexpr size_t O_CQKV = 319 * MiB, O_CKR = 344 * MiB, O_CQ = 347 * MiB, O_CKV = 397 * MiB, O_OC = 463 * MiB, O_WRB = 496 * MiB, WS_END = 497 * MiB;
constexpr size_t O_GATE = 187 * MiB;
constexpr size_t O_YM2 = 154 * MiB, O_AUP = 104 * MiB, O_WUP = 397 * MiB, O_WDN = 429 * MiB;
constexpr int LDS_BYTES = 163840, LDS_BAR_OFF = LDS_BYTES - 64, LDS_PTR_OFF = LDS_BYTES - 512;

struct KP { const float* in[24]; float* out; char* ws; int ph_lo, ph_hi; unsigned long long mask; };
struct Frame {
    LAS char* lds; char* ws; float* out; int wv0;
};
#define WSP(T, off) ((T*)(F.ws + (off)))
__device__ __forceinline__ const float* in_ptr(const Frame& F, int k) { const volatile LAS unsigned* q = (const volatile LAS unsigned*)(F.lds + LDS_PTR_OFF + 8 * k);
    unsigned lo = q[0], hi = q[1]; lo = __builtin_amdgcn_readfirstlane(lo); hi = __builtin_amdgcn_readfirstlane(hi); return (const float*)(((unsigned long long)hi << 32) | lo); }
#define INP(k) in_ptr(F, k)
__device__ __forceinline__ float wave_sum_dpp(float v) {
    int x = __builtin_bit_cast(int, v);
#define DPP_ADD(ctrl, rmask) x = __builtin_bit_cast(int, __builtin_bit_cast(float, x) + __builtin_bit_cast(float, __builtin_amdgcn_update_dpp(0, x, ctrl, rmask, 0xF, false)))
    DPP_ADD(0xB1, 0xF);
    DPP_ADD(0x4E, 0xF);
    DPP_ADD(0x141, 0xF);
    DPP_ADD(0x140, 0xF);
    DPP_ADD(0x142, 0xA);
    DPP_ADD(0x143, 0xC);
#undef DPP_ADD
    return __builtin_bit_cast(float, __builtin_amdgcn_readlane(x, 63));
}
__device__ __forceinline__ float wave_sum(float v) {
#pragma unroll
    for (int o = 32; o >= 1; o >>= 1) v += __shfl_xor(v, o);
    return v;
}

__device__ __forceinline__ void p0_mod(const Frame& F) {
    const int tid = opaque_tid(F.wv0), lane = tid & 63, wave = __builtin_amdgcn_readfirstlane(tid >> 6); (void)lane; (void)wave;
    LAS float* sc = (LAS float*)F.lds;
    LAS float* red = (LAS float*)(F.lds + 20480);
    for (int i = tid; i < 5 * 1024; i += 512) { const int r = i >> 10, k = i & 1023; const float v = r < 4 ? INP(1)[r * 1024 + k] : INP(3)[k]; sc[i] = v / (1.f + expf(-v)); }
    __syncthreads();
    float* MOD = WSP(float, O_MOD);
    for (int u = blockIdx.x; u < 2 * 96; u += gridDim.x) { const int l = u / 96, j = (u % 96) * 64 + lane;
        const float* w = INP(4) + (size_t)l * 1024 * 6144 + j; float a0 = 0.f, a1 = 0.f, a2 = 0.f, a3 = 0.f, a4 = 0.f;
#pragma unroll 8
        for (int kk = 0; kk < 128; ++kk) { const int k = wave * 128 + kk; const float wv = w[(size_t)k * 6144]; a0 += sc[k] * wv; a1 += sc[1024 + k] * wv; a2 += sc[2048 + k] * wv; a3 += sc[3072 + k] * wv; a4 += sc[4096 + k] * wv; }
        red[(wave * 5 + 0) * 64 + lane] = a0; red[(wave * 5 + 1) * 64 + lane] = a1; red[(wave * 5 + 2) * 64 + lane] = a2; red[(wave * 5 + 3) * 64 + lane] = a3; red[(wave * 5 + 4) * 64 + lane] = a4;
        __syncthreads();
        if (tid < 320) { const int r = tid >> 6, ln = tid & 63; float s = 0.f;
#pragma unroll
            for (int w8 = 0; w8 < 8; ++w8) s += red[(w8 * 5 + r) * 64 + ln];
            const int jj = (u % 96) * 64 + ln; MOD[(size_t)(l * 5 + r) * 6144 + jj] = s + INP(5)[l * 6144 + jj]; }
        __syncthreads();
    }
}
__device__ __forceinline__ void p0_tables(const Frame& F) {
    const int tid = opaque_tid(F.wv0), lane = tid & 63, wave = __builtin_amdgcn_readfirstlane(tid >> 6); (void)lane; (void)wave;
    float* ropa_c = WSP(float, O_ROPA_C); float* ropa_s = WSP(float, O_ROPA_S); float* ropc_c = WSP(float, O_ROPC_C); float* ropc_s = WSP(float, O_ROPC_S); float* LB = WSP(float, O_LB);
    for (int i = blockIdx.x * 512 + tid; i < 8192 * 32; i += gridDim.x * 512) {
        { const int t = i >> 5, j = i & 31, row = t >> 6, col = t & 63, f = j & 15; const float inv = powf(10000.f, -(float)f / 16.f); const float ang = (j < 16 ? (float)row : (float)col) * inv;
          ropa_c[i] = (float)cos((double)ang); ropa_s[i] = (float)sin((double)ang); }
        if (i < 8192 * 16) { const int t = i >> 4, j = i & 15, row = t >> 6, col = t & 63, f = j & 7; const float inv = powf(10000.f, -(float)f / 8.f); const float ang = (j < 8 ? (float)row : (float)col) * inv;
          ropc_c[i] = (float)cos((double)ang); ropc_s[i] = (float)sin((double)ang); }
        for (int i2 = i; i2 < 2 * 256 * 1024; i2 += 8192 * 32) { const int l = i2 >> 18, pp = (i2 >> 10) & 255, k = i2 & 1023;
          const int bj = pp >> 7, wc = (pp >> 5) & 3, n = (pp >> 4) & 1, fq = (pp >> 2) & 3, e = pp & 3; float v = 0.f;
          if (wc == 0) { if (bj == 0) v = INP(19)[(size_t)l * 1024 * 32 + k * 32 + fq * 8 + 4 * n + e]; else if (n == 0 && e == 0) v = INP(18)[(size_t)l * 1024 * 4 + k * 4 + fq]; }
          WSP(bf16_t, O_WRB)[i2] = f2bf(v); }
        if (i < 2048) { const int l = i >> 10, rest = i & 1023; if (l == 0) LB[i] = 0.f; else { const float a0 = INP(10)[rest], a1 = INP(10)[1024 + rest]; LB[i] = 1.f / (1.f + expf(a0 - a1)); } }
    }
}
template <class CM> __device__ __forceinline__ void wt_tile(const float* W, int ldw, const CM& cm, bf16_t* Bt, int K, int p0, int k0, LAS float* scr, int lane) {
    const int p4 = (lane & 7) * 4; const int c = cm(p0 + p4);
#pragma unroll
    for (int i = 0; i < 8; ++i) { const int kk = i * 8 + (lane >> 3); f32x4 v = (f32x4){0.f, 0.f, 0.f, 0.f};
        if (c >= 0) v = *(const f32x4*)(W + (size_t)(k0 + kk) * ldw + c);
        scr[kk * 33 + p4] = v[0]; scr[kk * 33 + p4 + 1] = v[1]; scr[kk * 33 + p4 + 2] = v[2]; scr[kk * 33 + p4 + 3] = v[3]; }
    asm volatile("s_waitcnt lgkmcnt(0)" ::: "memory"); __builtin_amdgcn_wave_barrier();
#pragma unroll 8
    for (int pi = 0; pi < 32; ++pi) Bt[(size_t)(p0 + pi) * K + k0 + lane] = f2bf(scr[lane * 33 + pi]);
    asm volatile("s_waitcnt lgkmcnt(0)" ::: "memory"); __builtin_amdgcn_wave_barrier();
}
struct WtDesc { const float* src; size_t ldw8; bf16_t* dst; int K; };
template <class CM> __device__ __forceinline__ WtDesc wt_desc(const float* W, int ldw, const CM& cm, bf16_t* Bt, int K, int p0, int k0, int lane) {
    const int p4 = (lane & 7) * 4; const int c = cm(p0 + p4); WtDesc d; d.src = c >= 0 ? W + (size_t)(k0 + (lane >> 3)) * ldw + c : nullptr; d.ldw8 = (size_t)ldw * 8; d.dst = Bt + (size_t)p0 * K + k0; d.K = K; return d; }
__device__ __forceinline__ void wt_load(const WtDesc& d, f32x4 (&v)[8]) {
#pragma unroll
    for (int i = 0; i < 8; ++i) { v[i] = (f32x4){0.f, 0.f, 0.f, 0.f}; if (d.src) v[i] = *(const f32x4*)(d.src + (size_t)i * d.ldw8); } }
__device__ __forceinline__ void wt_store(const WtDesc& d, const f32x4 (&v)[8], LAS float* scr, int lane) {
    const int p4 = (lane & 7) * 4;
#pragma unroll
    for (int i = 0; i < 8; ++i) { const int kk = i * 8 + (lane >> 3); scr[kk * 33 + p4] = v[i][0]; scr[kk * 33 + p4 + 1] = v[i][1]; scr[kk * 33 + p4 + 2] = v[i][2]; scr[kk * 33 + p4 + 3] = v[i][3]; }
    asm volatile("s_waitcnt lgkmcnt(0)" ::: "memory"); __builtin_amdgcn_wave_barrier();
    const int p = lane >> 1, kh = (lane & 1) * 32; bf16_t* o = d.dst + (size_t)p * d.K + kh;
#pragma unroll
    for (int s4 = 0; s4 < 4; ++s4) { const LAS float* r = scr + (kh + s4 * 8) * 33 + p;
        u32x4 w; w.x = pkbf(r[0], r[33]); w.y = pkbf(r[66], r[99]); w.z = pkbf(r[132], r[165]); w.w = pkbf(r[198], r[231]); *(u32x4*)(o + s4 * 8) = w; }
    asm volatile("s_waitcnt lgkmcnt(0)" ::: "memory"); __builtin_amdgcn_wave_barrier();
}
template <class Dec> __device__ __forceinline__ void wt_run(const Dec& dec, int first, int total, int stride, LAS float* scr, int lane) {
    if (first >= total) return;
    WtDesc cur = dec(first); f32x4 va[8]; wt_load(cur, va);
    for (int it = first; it < total; it += stride) { const int nx = it + stride; const bool hn = nx < total; WtDesc nxt = cur; f32x4 vb[8];
        if (hn) { nxt = dec(nx); wt_load(nxt, vb); }
        wt_store(cur, va, scr, lane);
        if (hn) { cur = nxt;
#pragma unroll
            for (int i = 0; i < 8; ++i) va[i] = vb[i]; } }
}
struct CmWin { __device__ __forceinline__ int operator()(int p) const { return colmap(MAP_WIN, p); } };
struct CmId { __device__ __forceinline__ int operator()(int p) const { return p; } };
__device__ __forceinline__ void conv_weights_nonmoe(const Frame& F, int l) {
    const int tid = opaque_tid(F.wv0), lane = tid & 63, wave = __builtin_amdgcn_readfirstlane(tid >> 6); (void)lane; (void)wave;
    LAS float* scr = (LAS float*)F.lds + wave * (64 * 33);
    const int gw = blockIdx.x * 8 + wave, NGW = gridDim.x * 8;
    constexpr int I_WIN = 216 * 16, I_BR = 3 * 32 * 8, I_OUT = 32 * 16;
    { const float* w_in = INP(8) + (size_t)l * 1024 * INW; const float* w_br = INP(16) + (size_t)l * 3 * 512 * 1024; const float* w_out = INP(17) + (size_t)l * 1024 * 1024; const Frame* Fp = &F;
      auto dec = [=](int it) -> WtDesc { const Frame& F = *Fp; int r = it;
          if (r < I_WIN) return wt_desc(w_in, INW, CmWin(), WSP(bf16_t, O_WINP), 1024, (r / 16) * 32, (r % 16) * 64, lane); r -= I_WIN;
          if (r < I_BR) { const int n = r / 256, q = r % 256; return wt_desc(w_br + (size_t)n * 512 * 1024, 1024, CmId(), WSP(bf16_t, O_WBR) + (size_t)n * 1024 * 512, 512, (q / 8) * 32, (q % 8) * 64, lane); } r -= I_BR;
          return wt_desc(w_out, 1024, CmId(), WSP(bf16_t, O_WOUT), 1024, (r / 16) * 32, (r % 16) * 64, lane); };
      wt_run(dec, gw, I_WIN + I_BR + I_OUT, NGW, scr, lane); }
    const float* wuq = INP(14) + (size_t)l * 256 * 768; const float* wukv = INP(15) + (size_t)l * 128 * 1024; const float* gq = INP(12) + l * 256; const float* gkv = INP(13) + l * 128; bf16_t* WC = WSP(bf16_t, O_WC);
    for (int i = blockIdx.x * 512 + tid; i < 1792 * 384; i += gridDim.x * 512) {
        const int pp = i / 384, k = i % 384; float v = 0.f;
        if (pp < 768) { const int pn = pp >> 8, q = pp & 255, bj = q >> 7, wc = (q >> 5) & 3, j = q & 31; const int gi = pn * 8 + bj * 4 + wc, head = gi / 3, part = gi - head * 3;
            const int p = part < 2 ? head * 96 + part * 32 + j : head * 96 + 64 + 16 * ((j >> 2) & 1) + 4 * (j >> 3) + (j & 3);
            if (k < 256) v = wuq[k * 768 + p] * gq[k]; }
        else { if (k >= 256) v = wukv[(k - 256) * 1024 + (pp - 768)] * gkv[k - 256]; }
        WC[i] = f2bf(v); }
}
struct CmUp { __device__ __forceinline__ int operator()(int p) const { return ((p >> 8) << 7) + (p & 127); } };
__device__ __forceinline__ void conv_weights_moe(const Frame& F, int l) {
    const int tid = opaque_tid(F.wv0), lane = tid & 63, wave = __builtin_amdgcn_readfirstlane(tid >> 6); (void)lane; (void)wave;
    LAS float* scr = (LAS float*)F.lds + wave * (64 * 33);
    const int gw = blockIdx.x * 8 + wave, NGW = gridDim.x * 8;
    constexpr int I_UP = 32 * 16 * 16, I_DN = 32 * 32 * 4;
    { const float* w1 = INP(20) + (size_t)l * 32 * 1024 * 256; const float* w3 = INP(21) + (size_t)l * 32 * 1024 * 256; const float* w2 = INP(22) + (size_t)l * 32 * 256 * 1024; const Frame* Fp = &F;
      auto dec = [=](int it) -> WtDesc { const Frame& F = *Fp; int r = it;
          if (r < I_UP) { const int e = r / 256, q = r % 256, p0 = (q / 16) * 32, k0 = (q % 16) * 64; const bool isw3 = (p0 >> 7) & 1;
              return wt_desc((isw3 ? w3 : w1) + (size_t)e * 1024 * 256, 256, CmUp(), WSP(bf16_t, O_WUP) + (size_t)e * 512 * 1024, 1024, p0, k0, lane); } r -= I_UP;
          const int e = r / 128, q = r % 128; return wt_desc(w2 + (size_t)e * 256 * 1024, 1024, CmId(), WSP(bf16_t, O_WDN) + (size_t)e * 1024 * 256, 256, (q / 4) * 32, (q % 4) * 64, lane); };
      wt_run(dec, gw, I_UP + I_DN, NGW, scr, lane); }
}

__device__ __forceinline__ void rp_load(const float* xs, float* xd, bool wx, const bf16_t* ym, const float* gt, int lane, f32x4 (&v)[4], float& rinv) {
    float ss = 0.f;
#pragma unroll
    for (int j = 0; j < 4; ++j) { const int c = 4 * lane + 256 * j; v[j] = *(const f32x4*)(xs + c);
        if (ym) { const uint2 y0 = *(const uint2*)(ym + c), y1 = *(const uint2*)(ym + 1024 + c); const f32x4 g4 = *(const f32x4*)(gt + c);
            v[j][0] += g4[0] * (bflo(y0.x) + bflo(y1.x)); v[j][1] += g4[1] * (bfhi(y0.x) + bfhi(y1.x)); v[j][2] += g4[2] * (bflo(y0.y) + bflo(y1.y)); v[j][3] += g4[3] * (bfhi(y0.y) + bfhi(y1.y)); }
        if (wx) *(f32x4*)(xd + c) = v[j];
        ss += v[j][0] * v[j][0] + v[j][1] * v[j][1] + v[j][2] * v[j][2] + v[j][3] * v[j][3]; }
    rinv = rsqrtf(wave_sum_dpp(ss) * (1.f / D) + EPS);
}
__device__ __forceinline__ void rp_mod(const f32x4 (&v)[4], float rinv, const float* gn, const float* mo, int sh_off, int sc_off, bf16_t* hp, int lane, f32x4 (&hv)[4]) {
#pragma unroll
    for (int j = 0; j < 4; ++j) { const int c = 4 * lane + 256 * j; const f32x4 g4 = *(const f32x4*)(gn + c), s4 = *(const f32x4*)(mo + sc_off + c), h4 = *(const f32x4*)(mo + sh_off + c);
        hv[j] = v[j] * rinv * g4 * (s4 + 1.f) + h4;
        *(uint2*)(hp + c) = make_uint2(pkbf(hv[j][0], hv[j][1]), pkbf(hv[j][2], hv[j][3])); }
}
__device__ __forceinline__ void phase_rowpass1(const Frame& F, int l, bool combine, size_t h_off) {
    const int tid = opaque_tid(F.wv0), lane = tid & 63, wave = __builtin_amdgcn_readfirstlane(tid >> 6); (void)lane; (void)wave;
    const int gw = blockIdx.x * 8 + wave, NGW = gridDim.x * 8;
    const float* xl = (l == 0) ? INP(0) : F.out; const float* xc = (l == 0) ? INP(2) : WSP(float, O_XC);
    const float* MODl = WSP(float, O_MOD) + (size_t)l * 5 * 6144; const float* MODp = WSP(float, O_MOD);
    for (int g = gw; g < G; g += NGW) { const RowInfo ri = rowinfo(g); const int mrow = ri.lat ? ri.b : 4; const size_t xo = xoff(ri);
        const float* xs = (ri.lat ? xl : xc) + xo; float* xd = (ri.lat ? F.out : WSP(float, O_XC)) + xo;
        f32x4 v[4], hv[4]; float rinv;
        rp_load(xs, xd, combine, combine ? WSP(bf16_t, O_YM2) + (size_t)g * 2048 : nullptr, MODp + (size_t)mrow * 6144 + 5120, lane, v, rinv);
        rp_mod(v, rinv, INP(6) + l * 1024, MODl + (size_t)mrow * 6144, 0, 1024, WSP(bf16_t, h_off) + (size_t)g * D, lane, hv); }
}
__device__ __forceinline__ void phase_rowpass2(const Frame& F, int l, bool last) {
    const int tid = opaque_tid(F.wv0), lane = tid & 63, wave = __builtin_amdgcn_readfirstlane(tid >> 6);
    { int* perm = WSP(int, O_PERM); unsigned* goff = WSP(unsigned, O_GOFF);
      for (int i = blockIdx.x * 512 + tid; i < PMAX; i += gridDim.x * 512) { perm[i] = -1; goff[i] = 0u; } }
    const int gw = blockIdx.x * 8 + wave, NGW = gridDim.x * 8;
    const float* MODl = WSP(float, O_MOD) + (size_t)l * 5 * 6144;
    for (int g = gw; g < G; g += NGW) { const RowInfo ri = rowinfo(g); if (last && !ri.lat) continue;
        const int mrow = ri.lat ? ri.b : 4; const size_t xo = xoff(ri);
        const float* xs = (ri.lat ? F.out : WSP(float, O_XC)) + xo;
        f32x4 v[4], hv[4]; float rinv;
        rp_load(xs, nullptr, false, nullptr, nullptr, lane, v, rinv);
        rp_mod(v, rinv, INP(7) + l * 1024, MODl + (size_t)mrow * 6144, 3072, 4096, WSP(bf16_t, O_H) + (size_t)g * D, lane, hv); }
}
struct EpiRoute {
    static constexpr bool PERM = false;
    int* route_e; float* route_w; LAS int* hist;
    __device__ __forceinline__ void operator()(const f32x4 (&acc)[2][2][4][2], const gp::GUnit& u, int wr, int wc, int fr, int fq) const {
        if (wc != 0) return;
#pragma unroll
        for (int ai = 0; ai < 2; ++ai)
#pragma unroll
            for (int m = 0; m < 4; ++m) { const int row = u.pm * 256 + ai * 128 + wr * 64 + m * 16 + fr;
                float el[8];
#pragma unroll
                for (int e = 0; e < 4; ++e) { el[e] = acc[ai][0][m][0][e]; el[4 + e] = acc[ai][0][m][1][e]; }
                const float gl = acc[ai][1][m][0][0];
                int i0 = 0; float m0 = el[0];
#pragma unroll
                for (int j = 1; j < 8; ++j) if (el[j] > m0) { m0 = el[j]; i0 = j; }
                int i1 = -1; float m1 = -3.4e38f;
#pragma unroll
                for (int j = 0; j < 8; ++j) if (j != i0 && el[j] > m1) { m1 = el[j]; i1 = j; }
                float gmax = gl; int gidx = fq;
#pragma unroll
                for (int off = 16; off <= 32; off <<= 1) { const float og = shxl(gmax, off, fr | (fq << 4)); const int oi = shxli(gidx, off, fr | (fq << 4)); if (og > gmax || (og == gmax && oi < gidx)) { gmax = og; gidx = oi; } }
                float gs = expf(gl - gmax); gs += shxl(gs, 16, fr | (fq << 4)); gs += shxl(gs, 32, fr | (fq << 4));
                if (fq == gidx) { const float gwt = 1.f / gs, p1 = expf(m1 - m0); const int e0 = fq * 8 + i0, e1 = fq * 8 + i1;
                    route_e[row * 2] = e0; route_e[row * 2 + 1] = e1; route_w[row * 2] = gwt / (1.f + p1); route_w[row * 2 + 1] = gwt * p1 / (1.f + p1);
                    __hip_atomic_fetch_add(hist + e0, 1, __ATOMIC_RELAXED, __HIP_MEMORY_SCOPE_WORKGROUP); __hip_atomic_fetch_add(hist + e1, 1, __ATOMIC_RELAXED, __HIP_MEMORY_SCOPE_WORKGROUP); } }
    }
};
__device__ __forceinline__ void phase_final(const Frame& F) {
    const int tid = opaque_tid(F.wv0), lane = tid & 63, wave = __builtin_amdgcn_readfirstlane(tid >> 6); (void)lane; (void)wave;
    const int gw = blockIdx.x * 8 + wave, NGW = gridDim.x * 8; const float* MOD1 = WSP(float, O_MOD) + (size_t)5 * 6144;
    for (int lr = gw; lr < NB * SEQ; lr += NGW) { const int b = lr / SEQ, t = lr - b * SEQ; const int g = b * RPB + t; float* xp = F.out + (size_t)lr * D;
        f32x4 v[4]; float rinv; rp_load(xp, nullptr, false, WSP(bf16_t, O_YM2) + (size_t)g * 2048, MOD1 + (size_t)b * 6144 + 5120, lane, v, rinv);
#pragma unroll
        for (int j = 0; j < 4; ++j) { const int c = 4 * lane + 256 * j; const f32x4 g4 = *(const f32x4*)(INP(23) + c); *(f32x4*)(xp + c) = v[j] * rinv * g4; } }
}
__device__ __forceinline__ void phase_moe_scatter(const Frame& F, int l, bool last) {
    const int tid = opaque_tid(F.wv0), lane = tid & 63, wave = __builtin_amdgcn_readfirstlane(tid >> 6);
    LAS int* tot = (LAS int*)F.lds; LAS int* bef = tot + 512; LAS int* base = tot + 1024; LAS int* lcur = tot + 1056;
    const int* WGH = WSP(int, O_WGH) + (size_t)l * 256 * 32; const int nwg = gridDim.x, me = blockIdx.x;
    { const int e = tid & 31, part = tid >> 5; int sa = 0, sb = 0;
      for (int w = part * 16; w < part * 16 + 16 && w < nwg; ++w) { const int c = WGH[w * 32 + e]; sa += c; if (w < me) sb += c; }
      tot[part * 32 + e] = sa; bef[part * 32 + e] = sb; }
    __syncthreads();
    int sa2 = 0, sb2 = 0;
    if (tid < 32) {
#pragma unroll
        for (int part = 0; part < 16; ++part) { sa2 += tot[part * 32 + tid]; sb2 += bef[part * 32 + tid]; } }
    __syncthreads();
    if (tid < 32) { tot[tid] = sa2; bef[tid] = sb2; lcur[tid] = 0; }
    __syncthreads();
    if (tid == 0) { int o = 0; int* tile_e = WSP(int, O_TILEE);
#pragma clang loop unroll(disable) vectorize(disable)
        for (int e = 0; e < 32; ++e) { base[e] = o + bef[e]; const int n = (tot[e] + 255) & ~255;
            if (me == 0) {
#pragma clang loop unroll(disable) vectorize(disable)
                for (int t = o >> 8; t < (o + n) >> 8; ++t) tile_e[t] = e; }
            o += n; }
        if (me == 0) tile_e[NTILE] = o >> 8; }
    __syncthreads();
    const int* route_e = WSP(int, O_ROUTE_E); const float* route_w = WSP(float, O_ROUTE_W); int* perm = WSP(int, O_PERM); float* posw = WSP(float, O_POSW); unsigned* goff = WSP(unsigned, O_GOFF);
    { int pmv, pn;
      if (gp::tile_order(0, (int)gridDim.x, (int)blockIdx.x, last ? 128 : 132, 1, pmv, pn)) { const int pm = last ? pmv + pmv / 32 : pmv; const int g = pm * 256 + (tid >> 1); const int i = g * 2 + (tid & 1);
          const int e = route_e[i]; const int pos = base[e] + __hip_atomic_fetch_add(lcur + e, 1, __ATOMIC_RELAXED, __HIP_MEMORY_SCOPE_WORKGROUP);
          perm[pos] = i; posw[pos] = route_w[i]; goff[pos] = (unsigned)g * 2048u; } }
    (void)lane; (void)wave;
}

#ifndef PROBE_DUP
#define PROBE_DUP 0
#endif
#ifndef PROBE_EXTRA_MASK
#define PROBE_EXTRA_MASK 0ull
#endif
#define DUP(bit) for (int rep_ = 0; rep_ < (((PROBE_DUP) >> (bit)) & 1) + 1; ++rep_)
__global__ void __launch_bounds__(512, 2) hybrid_trunk_fwd(KP p) {
    extern __shared__ __attribute__((aligned(16))) unsigned char dynlds[];
    Frame F; F.lds = (LAS char*)dynlds; F.ws = p.ws; F.out = p.out; F.wv0 = __builtin_amdgcn_readfirstlane((int)(threadIdx.x >> 6));
    if (threadIdx.x == 0) { LAS unsigned long long* pp = (LAS unsigned long long*)(F.lds + LDS_PTR_OFF);
        pp[0] = (unsigned long long)p.in[0];
        pp[1] = (unsigned long long)p.in[1];
        pp[2] = (unsigned long long)p.in[2];
        pp[3] = (unsigned long long)p.in[3];
        pp[4] = (unsigned long long)p.in[4];
        pp[5] = (unsigned long long)p.in[5];
        pp[6] = (unsigned long long)p.in[6];
        pp[7] = (unsigned long long)p.in[7];
        pp[8] = (unsigned long long)p.in[8];
        pp[9] = (unsigned long long)p.in[9];
        pp[10] = (unsigned long long)p.in[10];
        pp[11] = (unsigned long long)p.in[11];
        pp[12] = (unsigned long long)p.in[12];
        pp[13] = (unsigned long long)p.in[13];
        pp[14] = (unsigned long long)p.in[14];
        pp[15] = (unsigned long long)p.in[15];
        pp[16] = (unsigned long long)p.in[16];
        pp[17] = (unsigned long long)p.in[17];
        pp[18] = (unsigned long long)p.in[18];
        pp[19] = (unsigned long long)p.in[19];
        pp[20] = (unsigned long long)p.in[20];
        pp[21] = (unsigned long long)p.in[21];
        pp[22] = (unsigned long long)p.in[22];
        pp[23] = (unsigned long long)p.in[23];
    }
    LAS unsigned char* glds = (LAS unsigned char*)dynlds;
    volatile LAS unsigned* barst = (volatile LAS unsigned*)(F.lds + LDS_BAR_OFF);
    if (threadIdx.x < 16) ((LAS unsigned*)(F.lds + LDS_BAR_OFF))[threadIdx.x] = 0u;
    __syncthreads();
    const bool multi = (p.ph_hi - p.ph_lo) > 1;
    XcdBarrier bar; bar.bar = (unsigned*)F.ws; bar.x = 0; bar.st = nullptr;
    if (multi) bar = xcd_barrier_post((unsigned*)F.ws, barst);
    int ph = 0;
#define PH_BEGIN if (ph >= p.ph_lo && ph < p.ph_hi && (p.mask == 0ull || ((p.mask >> ph) & 1ull))) {
#define PH_END   if (ph + 1 < p.ph_hi) xcd_barrier(bar); else __syncthreads(); } ++ph;
    const int Gd = gridDim.x, cb = blockIdx.x;

    PH_BEGIN p0_mod(F); p0_tables(F); PH_END

    for (int l = 0; l < 2; ++l) {
        const bool last = (l == 1);
        const float* MODl = WSP(float, O_MOD) + (size_t)l * 5 * 6144;
        PH_BEGIN phase_rowpass1(F, l, l > 0, O_H); if (l == 0) { __syncthreads(); conv_weights_nonmoe(F, 0); } PH_END
        PH_BEGIN
        { SchedStd S{}; S.A = WSP(bf16_t, O_H); S.Bt = WSP(bf16_t, O_WINP); S.K = 1024; S.nM = 132; S.nN = 15; S.G_ = Gd; S.c = cb; S.skipctx = 0; S.lda2 = 2048; S.ldb2 = 2048;
          EpiG1 E{}; E.AQ = WSP(bf16_t, O_AQ); E.AK = WSP(bf16_t, O_AK); E.AV = WSP(bf16_t, O_AV); E.BQ = WSP(bf16_t, O_BQ); E.BV = WSP(bf16_t, O_BV); E.BG = WSP(bf16_t, O_BG); E.BLF = WSP(f16_t, O_BLF); E.BLB = WSP(f16_t, O_BLB);
          E.CQKV = WSP(bf16_t, O_CQKV); E.CKR = WSP(bf16_t, O_CKR); E.RS = WSP(float, O_RS); E.ropa_c = WSP(float, O_ROPA_C); E.ropa_s = WSP(float, O_ROPA_S); E.ropc_c = WSP(float, O_ROPC_C); E.ropc_s = WSP(float, O_ROPC_S);
          E.LBl = WSP(float, O_LB) + l * 1024; E.rowoff = 0; E.lbzero = (l == 0) ? 1 : 0;
          DUP(0) gp::gemm_phase<EpiG1, SchedStd>(glds, S, E, F.wv0); }
        PH_END
        PH_BEGIN
        { SchedStd S{}; S.A = WSP(bf16_t, O_CQKV); S.Bt = WSP(bf16_t, O_WC); S.K = 384; S.nM = 132; S.nN = 7; S.G_ = Gd; S.c = cb; S.skipctx = 0; S.lda2 = 768; S.ldb2 = 768;
          EpiC E{}; E.CQ = WSP(bf16_t, O_CQ); E.CKV = WSP(bf16_t, O_CKV); E.RS = WSP(float, O_RS); E.ropc_c = WSP(float, O_ROPC_C); E.ropc_s = WSP(float, O_ROPC_S); E.pmoff = 0;
          DUP(1) gp::gemm_phase<EpiC, SchedStd>(glds, S, E, F.wv0); }
        __syncthreads();
        { AttnArgs a{}; a.Q = WSP(bf16_t, O_AQ); a.qld = 512; a.qhs = 64; a.K1 = WSP(bf16_t, O_AK); a.k1ld = 128; a.k1hs = 64; a.kvgroup = 4; a.K2 = nullptr; a.k2ld = 0; a.V = WSP(bf16_t, O_AV); a.vld = 128; a.vhs = 64;
          a.O = WSP(bf16_t, O_AQ); a.old = 512; a.ohs = 64; a.scale_l2 = 0.125f * LOG2E; a.sink = INP(9) + l * 8; a.window = 128;
          const int nqb = last ? 32 : 33;
          DUP(10) for (int u = cb; u < NB * 8 * nqb; u += Gd) { int b, h, qb; if (u < NB * 8 * 32) { b = u >> 8; h = u & 7; qb = (u >> 3) & 31; }     else { const int r_ = u - NB * 8 * 32; b = r_ >> 3; h = r_ & 7; qb = 32; }
              attn_unit<64>(F.lds, a, F.wv0, b, qb, h, ((PROBE_DUP >> 10) & 1) && rep_ == 0); } }
        __syncthreads();
        { ScanArgs a{}; a.BQ = WSP(bf16_t, O_BQ); a.BV = WSP(bf16_t, O_BV); a.BG = WSP(bf16_t, O_BG); a.BLF = WSP(f16_t, O_BLF); a.BLB = WSP(f16_t, O_BLB); a.ST = WSP(bf16_t, O_H); a.DS = WSP(float, O_DS); a.OB = WSP(bf16_t, O_BQ); a.gn = INP(11) + l * 512;
          DUP(2) { const int tid_ = opaque_tid(F.wv0);
            if (cb < NB * 8 * NCHK) { const int b = cb / (8 * NCHK), rem = cb - b * 8 * NCHK, h = rem / NCHK, k = rem - h * NCHK; __syncthreads(); scan_stage(F.lds, a, (size_t)b * RPB + 64 * k - a.in_off, h, tid_); }
            for (int u = cb; u < NB * 8 * NCHK; u += Gd) { const int b = u / (8 * NCHK), rem = u - b * 8 * NCHK, h = rem / NCHK, k = rem - h * NCHK;
                const int un = u + Gd; const bool hn = un < NB * 8 * NCHK; const int nb_ = un / (8 * NCHK), nrem = un - nb_ * 8 * NCHK, nh_ = nrem / NCHK, nk_ = nrem - nh_ * NCHK;
                scan_s1_unit(F.lds, a, F.wv0, b, h, k, hn, nb_, nh_, nk_); } } }
        PH_END
        PH_BEGIN
        { ScanArgs a{}; a.ST = WSP(bf16_t, O_H); a.DS = WSP(float, O_DS);
          for (int t = cb; t < NB * 8 * 2 * 4; t += Gd) scan_s2_task(a, F.wv0, t); }
        { AttnArgs a{}; a.Q = WSP(bf16_t, O_CQ); a.qld = 768; a.qhs = 96; a.K1 = WSP(bf16_t, O_CKV); a.k1ld = 1024; a.k1hs = 128; a.kvgroup = 1; a.K2 = WSP(bf16_t, O_CKR); a.k2ld = 32; a.V = WSP(bf16_t, O_CKV) + 64; a.vld = 1024; a.vhs = 128;
          a.O = WSP(bf16_t, O_OC); a.old = 512; a.ohs = 64; a.scale_l2 = 0.10206207261596577f * LOG2E; a.sink = nullptr; a.window = 0; a.pad = (PROBE_VARIANT && p.mask != 0ull) ? 1 : 0;
          const int nqb = last ? 32 : 33;
          DUP(3) for (int u = cb; u < NB * 8 * nqb; u += Gd) { int b, h, qb; if (u < NB * 8 * 32) { b = u >> 8; h = u & 7; qb = (u >> 3) & 31; }     else { const int r_ = u - NB * 8 * 32; b = r_ >> 3; h = r_ & 7; qb = 32; }
              if (PROBE_VARIANT >= 6 && p.mask != 0ull) attn_unit<96, PROBE_VARIANT>(F.lds, a, F.wv0, b, qb, h); else attn_unit<96>(F.lds, a, F.wv0, b, qb, h); } }
        PH_END
        PH_BEGIN
        { ScanArgs a{}; a.BQ = WSP(bf16_t, O_BQ); a.BV = WSP(bf16_t, O_BV); a.BG = WSP(bf16_t, O_BG); a.BLF = WSP(f16_t, O_BLF); a.BLB = WSP(f16_t, O_BLB); a.ST = WSP(bf16_t, O_H); a.DS = WSP(float, O_DS); a.OB = WSP(bf16_t, O_BQ); a.gn = INP(11) + l * 512; a.skipctx_out = last ? 1 : 0;
          DUP(9) { a.pad = (((PROBE_DUP >> 9) & 1) && rep_ == 0) ? 1 : 0; const int tid_ = opaque_tid(F.wv0);
            if (cb < NB * 8 * NCHK) { const int b = cb / (8 * NCHK), rem = cb - b * 8 * NCHK, h = rem / NCHK, k = rem - h * NCHK; u32x4 t0, t1; __syncthreads(); scan_stage(F.lds, a, (size_t)b * RPB + 64 * k - a.in_off, h, tid_); s3_state_load(a, b, h, k, tid_, t0, t1); s3_state_store((LAS bf16_t*)(F.lds + SC_A), tid_, t0, t1); }
            for (int u = cb; u < NB * 8 * NCHK; u += Gd) { const int b = u / (8 * NCHK), rem = u - b * 8 * NCHK, h = rem / NCHK, k = rem - h * NCHK;
                const int un = u + Gd; const bool hn = un < NB * 8 * NCHK; const int nb_ = un / (8 * NCHK), nrem = un - nb_ * 8 * NCHK, nh_ = nrem / NCHK, nk_ = nrem - nh_ * NCHK;
                scan_s3_unit(F.lds, a, F.wv0, b, h, k, hn, nb_, nh_, nk_); } } }
        phase_rowpass1(F, l, false, O_CKV);
        PH_END
        PH_BEGIN
        { SchedGM S{}; S.A0 = WSP(bf16_t, O_AQ); S.A1 = WSP(bf16_t, O_BQ); S.A2 = WSP(bf16_t, O_OC); S.Ag = WSP(bf16_t, O_CKV); S.Bbr = WSP(bf16_t, O_WBR); S.Bg = WSP(bf16_t, O_WINP) + (size_t)3840 * 1024;
          S.nM = last ? 128 : 132; S.G_ = Gd; S.c = cb; S.skipctx = last ? 1 : 0; S.lda2 = 1024; S.ldb2 = 1024;
          EpiGM E{}; E.U = WSP(bf16_t, O_GATE); E.nstride = (long)G * 1024; E.ld = 1024;
          gp::gemm_phase<EpiGM, SchedGM>(glds, S, E, F.wv0); }
        PH_END
        PH_BEGIN
        { const int tid_ = opaque_tid(F.wv0), lane_ = tid_ & 63, wave_ = __builtin_amdgcn_readfirstlane(tid_ >> 6); const bf16_t* U = WSP(bf16_t, O_GATE); bf16_t* Y = WSP(bf16_t, O_H);
          for (int g = cb * 8 + wave_; g < G; g += Gd * 8) { if (last && (g % RPB) >= SEQ) continue;
#pragma unroll
              for (int j = 0; j < 2; ++j) { const size_t o = (size_t)g * 1024 + 8 * lane_ + 512 * j;
                  const u32x4 a = *(const u32x4*)(U + o), b2 = *(const u32x4*)(U + (size_t)G * 1024 + o), c2 = *(const u32x4*)(U + (size_t)2 * G * 1024 + o);
                  u32x4 w; w.x = pkbf(bflo(a.x) + bflo(b2.x) + bflo(c2.x), bfhi(a.x) + bfhi(b2.x) + bfhi(c2.x)); w.y = pkbf(bflo(a.y) + bflo(b2.y) + bflo(c2.y), bfhi(a.y) + bfhi(b2.y) + bfhi(c2.y));
                  w.z = pkbf(bflo(a.z) + bflo(b2.z) + bflo(c2.z), bfhi(a.z) + bfhi(b2.z) + bfhi(c2.z)); w.w = pkbf(bflo(a.w) + bflo(b2.w) + bflo(c2.w), bfhi(a.w) + bfhi(b2.w) + bfhi(c2.w));
                  *(u32x4*)(Y + o) = w; } } }
        PH_END
        PH_BEGIN
        { SchedStd S{}; S.A = WSP(bf16_t, O_H); S.Bt = WSP(bf16_t, O_WOUT); S.K = 1024; S.nM = last ? 128 : 132; S.nN = 4; S.G_ = Gd; S.c = cb; S.skipctx = last ? 1 : 0; S.lda2 = 2048; S.ldb2 = 2048;
          EpiOut E{}; E.xl_src = l == 0 ? INP(0) : F.out; E.xc_src = l == 0 ? INP(2) : WSP(float, O_XC); E.xl_dst = F.out; E.xc_dst = WSP(float, O_XC); E.mod = MODl; E.pmoff = 0;
          gp::gemm_phase<EpiOut, SchedStd>(glds, S, E, F.wv0); }
        PH_END
        PH_BEGIN phase_rowpass2(F, l, last); PH_END
        PH_BEGIN
        { LAS int* hist = (LAS int*)(F.lds + 131072); const int t_ = opaque_tid(F.wv0);
          if (t_ < 32) hist[t_] = 0;
          __syncthreads();
          SchedStd S{}; S.A = WSP(bf16_t, O_H); S.Bt = WSP(bf16_t, O_WRB) + (size_t)l * 256 * 1024; S.K = 1024; S.nM = last ? 128 : 132; S.nN = 1; S.G_ = Gd; S.c = cb; S.skipctx = last ? 1 : 0; S.lda2 = 2048; S.ldb2 = 2048;
          EpiRoute E{}; E.route_e = WSP(int, O_ROUTE_E); E.route_w = WSP(float, O_ROUTE_W); E.hist = hist;
          gp::gemm_phase<EpiRoute, SchedStd>(glds, S, E, F.wv0);
          __syncthreads();
          { const int t2_ = opaque_tid(F.wv0); if (t2_ < 32) WSP(int, O_WGH)[((size_t)l * 256 + cb) * 32 + t2_] = hist[t2_]; }
          __syncthreads(); }
        conv_weights_moe(F, l); if (!last) conv_weights_nonmoe(F, l + 1);
        PH_END
        PH_BEGIN phase_moe_scatter(F, l, last); PH_END
        PH_BEGIN
        { SchedMoE<true> S{}; S.A = WSP(bf16_t, O_H); S.Bt = WSP(bf16_t, O_WUP); S.tile_e = WSP(int, O_TILEE); S.goff = WSP(unsigned, O_GOFF); S.K = 1024; S.nM = WSP(int, O_TILEE)[NTILE]; S.nN = 2; S.G_ = Gd; S.c = cb; S.lda2 = 2048; S.ldb2 = 2048; S.strideB = 512 * 1024;
          EpiUp E{}; E.AUP = WSP(bf16_t, O_AUP);
          DUP(7) gp::gemm_phase<EpiUp, SchedMoE<true>>(glds, S, E, F.wv0); }
        PH_END
        PH_BEGIN
        { SchedMoE<false> S{}; S.A = WSP(bf16_t, O_AUP); S.Bt = WSP(bf16_t, O_WDN); S.tile_e = WSP(int, O_TILEE); S.goff = nullptr; S.K = 256; S.nM = WSP(int, O_TILEE)[NTILE]; S.nN = 4; S.G_ = Gd; S.c = cb; S.lda2 = 512; S.ldb2 = 512; S.strideB = 1024 * 256;
          EpiDown E{}; E.YM2 = WSP(bf16_t, O_YM2); E.perm = WSP(int, O_PERM); E.posw = WSP(float, O_POSW);
          DUP(8) gp::gemm_phase<EpiDown, SchedMoE<false>>(glds, S, E, F.wv0); }
        PH_END
    }
    PH_BEGIN phase_final(F); PH_END
#undef PH_BEGIN
#undef PH_END
}
constexpr int N_PHASES = 1 + 2 * 13 + 1;
}

#ifndef MK_N_LAUNCHES
#define MK_N_LAUNCHES 1
#endif
extern "C" void kernel_launch(void* const* d_in, const int* in_sizes, int n_in, void* d_out, int out_size, void* d_ws, size_t ws_size, hipStream_t stream) {
    static int grid = 0;
    if (grid == 0) {
        if (ws_size < WS_END) { grid = -1; return; }
        int dev = 0, cus = 0;
        if (hipGetDevice(&dev) != hipSuccess || hipDeviceGetAttribute(&cus, hipDeviceAttributeMultiprocessorCount, dev) != hipSuccess) { grid = -1; return; }
        if (hipFuncSetAttribute((const void*)hybrid_trunk_fwd, hipFuncAttributeMaxDynamicSharedMemorySize, LDS_BYTES) != hipSuccess) { grid = -1; return; }
        int per_cu = 0; (void)hipOccupancyMaxActiveBlocksPerMultiprocessor(&per_cu, (const void*)hybrid_trunk_fwd, 512, LDS_BYTES); (void)hipGetLastError();
        grid = cus;
    }
    if (grid < 0) return;
    (void)hipMemsetAsync(d_ws, 0, CTL_ZERO_BYTES, stream);
    KP p{}; for (int i = 0; i < 24; ++i) p.in[i] = (const float*)d_in[i]; p.out = (float*)d_out; p.ws = (char*)d_ws;
    (void)in_sizes; (void)n_in; (void)out_size;
    if (MK_N_LAUNCHES == 1) { p.ph_lo = 0; p.ph_hi = N_PHASES; hipLaunchKernelGGL(hybrid_trunk_fwd, dim3(grid), dim3(512), LDS_BYTES, stream, p);
        if (PROBE_EXTRA_MASK) { (void)hipMemsetAsync(d_ws, 0, CTL_ZERO_BYTES, stream); p.mask = PROBE_EXTRA_MASK; hipLaunchKernelGGL(hybrid_trunk_fwd, dim3(grid), dim3(512), LDS_BYTES, stream, p); } }
    else { for (int k = 0; k < N_PHASES; ++k) { p.ph_lo = k; p.ph_hi = k + 1; hipLaunchKernelGGL(hybrid_trunk_fwd, dim3(grid), dim3(512), LDS_BYTES, stream, p); } }
}
```

```cpp
#include <hip/hip_runtime.h>
#include <stdint.h>
#include <math.h>

namespace {
typedef unsigned short bf16_t;
typedef _Float16 f16_t;
typedef short bf16x8 __attribute__((ext_vector_type(8)));
typedef short s16x4 __attribute__((ext_vector_type(4)));
typedef float f32x4 __attribute__((ext_vector_type(4)));
typedef float f32x16 __attribute__((ext_vector_type(16)));
typedef unsigned u32x4 __attribute__((ext_vector_type(4)));
#define LAS __attribute__((address_space(3)))

constexpr int D = 1024, NB = 4, SEQ = 8192, CTXL = 256, RPB = SEQ + CTXL, G = NB * RPB;
constexpr int INW = 6816, MIXW = 3744, GATEW = 3072;
constexpr float EPS = 1e-6f;
constexpr float LOG2E = 1.4426950408889634f;
constexpr int PMAX = 75776;
constexpr int NTILE = PMAX / 256;

__device__ __forceinline__ float bf2f(bf16_t v) { return __uint_as_float(((unsigned)v) << 16); }
__device__ __forceinline__ bf16_t f2bf(float f) { unsigned u = __float_as_uint(f); u += 0x7fffu + ((u >> 16) & 1u); return (bf16_t)(u >> 16); }
typedef float f32x2v __attribute__((ext_vector_type(2)));
typedef __bf16 bf16x2v __attribute__((ext_vector_type(2)));
__device__ __forceinline__ unsigned pkbf(float lo, float hi) { const f32x2v v = {lo, hi}; const bf16x2v b = __builtin_convertvector(v, bf16x2v); return __builtin_bit_cast(unsigned, b); }
__device__ __forceinline__ unsigned pk2(float lo, float hi) { return (unsigned)f2bf(lo) | ((unsigned)f2bf(hi) << 16); }
__device__ __forceinline__ float silu_f(float v) { return v / (1.f + expf(-v)); }
__device__ __forceinline__ float sigmoid_f(float v) { return 1.f / (1.f + expf(-v)); }
__device__ __forceinline__ int opaque_tid(int wv) { unsigned z; asm volatile("s_mov_b32 %0, 0" : "=s"(z));
    int t = (wv << 6) | (int)__builtin_amdgcn_mbcnt_hi(~0u, __builtin_amdgcn_mbcnt_lo(~0u, z)); asm volatile("" : "+v"(t)); return t; }
__device__ __forceinline__ float shxl(float v, int k, int lane) { return __builtin_bit_cast(float, __builtin_amdgcn_ds_bpermute((lane ^ k) << 2, __builtin_bit_cast(int, v))); }
__device__ __forceinline__ int shxli(int v, int k, int lane) { return __builtin_amdgcn_ds_bpermute((lane ^ k) << 2, v); }
struct RowInfo { int b, r; bool lat; };
__device__ __forceinline__ RowInfo rowinfo(int g) { RowInfo ri; ri.b = g / RPB; ri.r = g - ri.b * RPB; ri.lat = ri.r < SEQ; return ri; }
__device__ __forceinline__ size_t xoff(const RowInfo& ri) { return ri.lat ? ((size_t)ri.b * SEQ + ri.r) * D : ((size_t)ri.b * CTXL + (ri.r - SEQ)) * D; }
__device__ __forceinline__ int crow(int r, int hi) { return (r & 3) + 8 * (r >> 2) + 4 * hi; }
__device__ __forceinline__ unsigned cvtpk(float lo, float hi) { return pkbf(lo, hi); }
typedef short v4i16_t __attribute__((ext_vector_type(4)));
__device__ __forceinline__ s16x4 vtr(const LAS char* p) { return __builtin_bit_cast(s16x4, __builtin_amdgcn_ds_read_tr16_b64_v4i16((LAS v4i16_t*)p)); }
#define MFMA32(a, b, c) __builtin_amdgcn_mfma_f32_32x32x16_bf16(a, b, c, 0, 0, 0)
#ifndef PROBE_VARIANT
#define PROBE_VARIANT 0
#endif
#if PROBE_VARIANT == 4
#define VTR_ASM(dst, addr, off) do { if (!p.pad) asm volatile("ds_read_b64_tr_b16 %0, %1 offset:" #off : "=v"(dst) : "v"(addr)); else asm volatile("" : "=v"(dst)); } while (0)
#else
#define VTR_ASM(dst, addr, off) asm volatile("ds_read_b64_tr_b16 %0, %1 offset:" #off : "=v"(dst) : "v"(addr))
#endif
struct AttnArgs { const bf16_t* Q; int qld, qhs; const bf16_t* K1; int k1ld, k1hs, kvgroup; const bf16_t* K2; int k2ld; const bf16_t* V; int vld, vhs;
                  bf16_t* O; int old, ohs; float scale_l2; const float* sink; int window; int pad; };
template <int DQK, int VAR = 0>
__device__ __forceinline__ void attn_unit(LAS char* lds, const AttnArgs& p, int wv0, int b, int qb, int h, bool nostore = false) {
    constexpr int NS = DQK / 16, NCH = DQK / 8; constexpr float THR = 8.f;
    constexpr int KB = 0, VB = 49152, WSF = 81920;
    const int tid = opaque_tid(wv0), lane = tid & 63, r32 = lane & 31, hi = lane >> 5, wid = tid >> 6;
    const int rb = b * RPB;
    const bool ctxq = (qb == 32);
    const int q0 = rb + (ctxq ? SEQ : qb * 256);
    int lat_k0 = 0, lat_k1 = 0;
    if (!ctxq) { if (p.window) { lat_k0 = qb * 256 - 128; if (lat_k0 < 0) lat_k0 = 0; lat_k1 = qb * 256 + 384; if (lat_k1 > SEQ) lat_k1 = SEQ; } else { lat_k0 = 0; lat_k1 = SEQ; } }
    const int ntiles = 4 + (lat_k1 - lat_k0) / 64;
    const int qrow = q0 + wid * 32 + r32;
    const int qpos = qb * 256 + wid * 32 + r32;
    const int wq0 = qb * 256 + wid * 32;
    LAS float* wsf = (LAS float*)(lds + WSF) + wid * 64;
    bf16x8 qr[NS];
#pragma unroll
    for (int s = 0; s < NS; ++s) qr[s] = *(const bf16x8*)(p.Q + (size_t)qrow * p.qld + h * p.qhs + 16 * s + 8 * hi);
    const int k1off = (h / p.kvgroup) * p.k1hs, voff = (h / p.kvgroup) * p.vhs;
    const int wv = __builtin_amdgcn_readfirstlane(wid);
    const bool k2nd = (NCH > 8) && (wv < NCH - 8);
    const size_t ksrc0 = (size_t)lane * p.k1ld + k1off + wv * 8, ksrc1 = (size_t)lane * p.k2ld + wv * 8;
    const size_t vsrc = (size_t)(16 * (wv & 3) + (lane >> 2)) * p.vld + voff + (wv >> 2) * 32 + (lane & 3) * 8;
#define AT_ROW0(it_) (rb + ((it_) >= 4 ? lat_k0 + 64 * ((it_) - 4) : SEQ + 64 * (it_)))
#define AT_DMAK(it_, slot_) do { if constexpr (VAR == 8) break; const size_t kr0_ = (size_t)AT_ROW0(it_); \
        __builtin_amdgcn_global_load_lds((const unsigned*)(p.K1 + kr0_ * p.k1ld + ksrc0), (LAS unsigned*)(lds + KB + (slot_) * 12288 + wv * 1024), 16, 0, 0); \
        if (k2nd) __builtin_amdgcn_global_load_lds((const unsigned*)(p.K2 + kr0_ * p.k2ld + ksrc1), (LAS unsigned*)(lds + KB + (slot_) * 12288 + (8 + wv) * 1024), 16, 0, 0); } while (0)
#define AT_DMAV(it_, slot_) do { if constexpr (VAR == 8) break; const size_t kr0_ = (size_t)AT_ROW0(it_); \
        __builtin_amdgcn_global_load_lds((const unsigned*)(p.V + kr0_ * p.vld + vsrc), (LAS unsigned*)(lds + VB + (slot_) * 8192 + wv * 1024), 16, 0, 0); } while (0)
#define AT_CLAMP(x_) ((x_) < ntiles ? (x_) : ntiles - 1)
#define AT_WAITBAR() do { if (k2nd) asm volatile("s_waitcnt vmcnt(6) lgkmcnt(0)" ::: "memory"); else asm volatile("s_waitcnt vmcnt(4) lgkmcnt(0)" ::: "memory"); if constexpr (VAR != 7) __builtin_amdgcn_s_barrier(); asm volatile("" ::: "memory"); } while (0)
#define AT_QK(C0, C1, slot_) do { const LAS char* ldsK_ = lds + KB + (slot_) * 12288 + hi * 1024 + r32 * 16; C0 = negm; C1 = negm; bf16x8 kf_[2 * NS]; \
        _Pragma("unroll") for (int s = 0; s < NS; ++s) { kf_[2 * s] = *(const LAS bf16x8*)(ldsK_ + s * 2048); kf_[2 * s + 1] = *(const LAS bf16x8*)(ldsK_ + s * 2048 + 512); } \
        __builtin_amdgcn_sched_group_barrier(0x100, 2 * NS, 0); \
        _Pragma("unroll") for (int s = 0; s < NS; ++s) { C0 = MFMA32(kf_[2 * s], qr[s], C0); C1 = MFMA32(kf_[2 * s + 1], qr[s], C1); } } while (0)
#define AT_REF(C0, C1, T_, first) do { const int tr_ = (T_); \
        if (p.window && tr_ >= 4) { const int kpos0 = lat_k0 + 64 * (tr_ - 4), wq0s_ = qb * 256 + wv * 32;        \
            const bool full_ = (kpos0 >= wq0s_ + 31 - p.window) && (kpos0 + 63 <= wq0s_ + p.window), dead_ = (kpos0 + 63 < wq0s_ - p.window) || (kpos0 > wq0s_ + 31 + p.window); \
            if (dead_) { _Pragma("unroll") for (int r = 0; r < 16; ++r) { C0[r] = -1e30f; C1[r] = -1e30f; } } \
            else if (!full_) { const unsigned tb_ = (unsigned)(kpos0 + 4 * hi - qpos + p.window), w2_ = 2u * (unsigned)p.window;         \
                _Pragma("unroll") for (int r = 0; r < 16; ++r) { const unsigned t0_ = tb_ + (unsigned)((r & 3) + 8 * (r >> 2)); if (t0_ > w2_) C0[r] = -1e30f; if (t0_ + 32u > w2_) C1[r] = -1e30f; } } } \
        if ((first) || (tr_ & 7) == 0) { \
        float mx = fmaxf(fmaxf(C0[0], C0[1]), C1[0]); \
        _Pragma("unroll") for (int r = 2; r < 16; r += 2) mx = fmaxf(fmaxf(mx, C0[r]), C0[r + 1]); \
        _Pragma("unroll") for (int r = 1; r < 15; r += 2) mx = fmaxf(fmaxf(mx, C1[r]), C1[r + 1]); \
        mx = fmaxf(mx, C1[15]); mx = fmaxf(mx, shxl(mx, 32, lane)); \
        if ((first) || __any(mx > THR)) { const float dl = (first) ? mx : fmaxf(mx, 0.f); \
            m += dl; const float alpha = __builtin_amdgcn_exp2f(-dl); l *= alpha; \
            _Pragma("unroll") for (int r = 0; r < 16; ++r) { C0[r] -= dl; C1[r] -= dl; negm[r] = -m; } \
            if (hi == 0) wsf[r32] = alpha; \
            _Pragma("unroll") for (int r = 0; r < 16; ++r) { const float f = wsf[crow(r, hi)]; o0[r] *= f; o1[r] *= f; } } } } while (0)
    f32x16 o0, o1, negm, cA0, cA1, cB0, cB1;
#pragma unroll
    for (int r = 0; r < 16; ++r) { o0[r] = 0.f; o1[r] = 0.f; negm[r] = 0.f; }
    float m = 0.f, l = 0.f;
    const int vlane = ((lane >> 4) & 1) * 32 + (lane & 3) * 8 + (4 * hi + ((lane & 15) >> 2)) * 64;
    asm volatile("s_waitcnt vmcnt(0) lgkmcnt(0)" ::: "memory"); __builtin_amdgcn_s_barrier(); asm volatile("" ::: "memory");
    AT_DMAK(0, 0); AT_DMAV(0, 0); AT_DMAK(AT_CLAMP(1), 1); AT_DMAV(AT_CLAMP(1), 1); AT_DMAK(AT_CLAMP(2), 2); AT_DMAV(AT_CLAMP(2), 2); AT_DMAK(AT_CLAMP(3), 3);
    asm volatile("s_waitcnt vmcnt(0)" ::: "memory"); __builtin_amdgcn_s_barrier(); asm volatile("" ::: "memory");
    AT_QK(cA0, cA1, 0);
    AT_REF(cA0, cA1, 0, true);
    asm volatile("s_waitcnt lgkmcnt(0)" ::: "memory"); __builtin_amdgcn_s_barrier(); asm volatile("" ::: "memory");
#define AT_SB() __builtin_amdgcn_sched_barrier(0)
#define AT_PIN2(x, y) asm volatile("" : "+v"(x), "+v"(y))
#define AT_PIN1(x) asm volatile("" : "+v"(x))
#define AT_PINRS() asm volatile("" : "+v"(ra_), "+v"(rb_))
#define AT_LDK(dst, addr_, off) asm volatile("ds_read_b128 %0, %1 offset:" #off : "=v"(dst) : "v"(addr_))
#define AT_WAITK(n, a, b) asm volatile("s_waitcnt lgkmcnt(" #n ")" : "+v"(a), "+v"(b))
#define AT_WAITV8(n, a, b, c, d, e, f, g, h) asm volatile("s_waitcnt lgkmcnt(" #n ")" : "+v"(a), "+v"(b), "+v"(c), "+v"(d), "+v"(e), "+v"(f), "+v"(g), "+v"(h))
#define AT_WAITV4(n, a, b, c, d) asm volatile("s_waitcnt lgkmcnt(" #n ")" : "+v"(a), "+v"(b), "+v"(c), "+v"(d))
#define AT_EXP(X) do { if constexpr (VAR != 6) X = __builtin_amdgcn_exp2f(X); } while (0)
#define AT_STEP(C0, C1, N0, N1, T_) do { const int t_ = (T_); const int t1_ = t_ + 1 < ntiles ? t_ + 1 : ntiles - 1; \
        AT_DMAK(AT_CLAMP(t_ + 4), t_ & 3); AT_DMAV(AT_CLAMP(t_ + 3), (t_ + 3) & 3); \
        const unsigned kaddr_ = (unsigned)(size_t)(lds + KB + ((t_ + 1) & 3) * 12288 + hi * 1024 + r32 * 16); const unsigned vaddr_ = (unsigned)(size_t)(lds + VB + (t_ & 3) * 8192 + vlane); \
        bf16x8 kfa0, kfa1, kfb0, kfb1, kfc0, kfc1; bf16x8 vf_[8]; s16x4 ta_[16]; f32x2v ra_ = {0.f, 0.f}, rb_ = {0.f, 0.f}; u32x4 pw[4]; \
        AT_LDK(kfa0, kaddr_, 0); AT_LDK(kfa1, kaddr_, 512); AT_LDK(kfb0, kaddr_, 2048); AT_LDK(kfb1, kaddr_, 2560); AT_SB(); \
        if constexpr (NS == 6) { \
          AT_LDK(kfc0, kaddr_, 4096); AT_LDK(kfc1, kaddr_, 4608); AT_WAITK(4, kfa0, kfa1); N0 = MFMA32(kfa0, qr[0], negm); AT_PIN1(N0); AT_EXP(C0[0]); AT_EXP(C0[1]); AT_EXP(C0[2]);  VTR_ASM(ta_[0], vaddr_, 0); AT_SB(); \
          N1 = MFMA32(kfa1, qr[0], negm); AT_PIN1(N1); AT_EXP(C0[3]); AT_EXP(C0[4]); AT_EXP(C0[5]);  VTR_ASM(ta_[1], vaddr_, 512); VTR_ASM(ta_[2], vaddr_, 4096); AT_SB(); \
          AT_LDK(kfa0, kaddr_, 6144); AT_LDK(kfa1, kaddr_, 6656); AT_WAITK(7, kfb0, kfb1); N0 = MFMA32(kfb0, qr[1], N0); AT_PIN1(N0); AT_EXP(C0[6]); AT_EXP(C0[7]); AT_EXP(C0[8]); VTR_ASM(ta_[3], vaddr_, 4608); AT_SB(); \
          N1 = MFMA32(kfb1, qr[1], N1); AT_PIN1(N1); AT_EXP(C0[9]); AT_EXP(C0[10]); AT_EXP(C0[11]); VTR_ASM(ta_[4], vaddr_, 1024); VTR_ASM(ta_[5], vaddr_, 1536); AT_SB(); \
          AT_LDK(kfb0, kaddr_, 8192); AT_LDK(kfb1, kaddr_, 8704); AT_WAITK(10, kfc0, kfc1); N0 = MFMA32(kfc0, qr[2], N0); AT_PIN1(N0); AT_EXP(C0[12]); AT_EXP(C0[13]); AT_EXP(C0[14]); VTR_ASM(ta_[6], vaddr_, 5120); AT_SB(); \
          N1 = MFMA32(kfc1, qr[2], N1); AT_PIN1(N1); AT_EXP(C0[15]); AT_EXP(C1[0]); AT_EXP(C1[1]); VTR_ASM(ta_[7], vaddr_, 5632); VTR_ASM(ta_[8], vaddr_, 2048); AT_SB(); \
          AT_LDK(kfc0, kaddr_, 10240); AT_LDK(kfc1, kaddr_, 10752); AT_WAITK(10, kfa0, kfa1); N0 = MFMA32(kfa0, qr[3], N0); AT_PIN1(N0); AT_EXP(C1[2]); AT_EXP(C1[3]); AT_EXP(C1[4]); VTR_ASM(ta_[9], vaddr_, 2560); AT_SB(); \
          N1 = MFMA32(kfa1, qr[3], N1); AT_PIN1(N1); AT_EXP(C1[5]); AT_EXP(C1[6]); AT_EXP(C1[7]); VTR_ASM(ta_[10], vaddr_, 6144); VTR_ASM(ta_[11], vaddr_, 6656); AT_SB(); \
           AT_WAITK(8, kfb0, kfb1); N0 = MFMA32(kfb0, qr[4], N0); AT_PIN1(N0); AT_EXP(C1[8]); AT_EXP(C1[9]); VTR_ASM(ta_[12], vaddr_, 3072); AT_SB(); \
          N1 = MFMA32(kfb1, qr[4], N1); AT_PIN1(N1); AT_EXP(C1[10]); AT_EXP(C1[11]); VTR_ASM(ta_[13], vaddr_, 3584); AT_SB(); \
           AT_WAITK(5, kfc0, kfc1); N0 = MFMA32(kfc0, qr[5], N0); AT_PIN1(N0); AT_EXP(C1[12]); AT_EXP(C1[13]); VTR_ASM(ta_[14], vaddr_, 7168); AT_SB(); \
          N1 = MFMA32(kfc1, qr[5], N1); AT_PIN1(N1); AT_EXP(C1[14]); AT_EXP(C1[15]); VTR_ASM(ta_[15], vaddr_, 7680); AT_SB(); \
          \
        } \
        if constexpr (NS == 4) { \
          AT_LDK(kfc0, kaddr_, 4096); AT_LDK(kfc1, kaddr_, 4608); AT_WAITK(4, kfa0, kfa1); N0 = MFMA32(kfa0, qr[0], negm); AT_PIN1(N0); AT_EXP(C0[0]); AT_EXP(C0[1]); AT_EXP(C0[2]); AT_EXP(C0[3]);  VTR_ASM(ta_[0], vaddr_, 0); AT_SB(); \
          N1 = MFMA32(kfa1, qr[0], negm); AT_PIN1(N1); AT_EXP(C0[4]); AT_EXP(C0[5]); AT_EXP(C0[6]); AT_EXP(C0[7]);  VTR_ASM(ta_[1], vaddr_, 512); VTR_ASM(ta_[2], vaddr_, 4096); VTR_ASM(ta_[3], vaddr_, 4608); AT_SB(); \
          AT_LDK(kfa0, kaddr_, 6144); AT_LDK(kfa1, kaddr_, 6656); AT_WAITK(8, kfb0, kfb1); N0 = MFMA32(kfb0, qr[1], N0); AT_PIN1(N0); AT_EXP(C0[8]); AT_EXP(C0[9]); AT_EXP(C0[10]); AT_EXP(C0[11]); VTR_ASM(ta_[4], vaddr_, 1024); AT_SB(); \
          N1 = MFMA32(kfb1, qr[1], N1); AT_PIN1(N1); AT_EXP(C0[12]); AT_EXP(C0[13]); AT_EXP(C0[14]); AT_EXP(C0[15]); VTR_ASM(ta_[5], vaddr_, 1536); VTR_ASM(ta_[6], vaddr_, 5120); VTR_ASM(ta_[7], vaddr_, 5632); AT_SB(); \
           AT_WAITK(10, kfc0, kfc1); N0 = MFMA32(kfc0, qr[2], N0); AT_PIN1(N0); AT_EXP(C1[0]); AT_EXP(C1[1]); AT_EXP(C1[2]); AT_EXP(C1[3]); VTR_ASM(ta_[8], vaddr_, 2048); AT_SB(); \
          N1 = MFMA32(kfc1, qr[2], N1); AT_PIN1(N1); AT_EXP(C1[4]); AT_EXP(C1[5]); AT_EXP(C1[6]); AT_EXP(C1[7]); VTR_ASM(ta_[9], vaddr_, 2560); VTR_ASM(ta_[10], vaddr_, 6144); VTR_ASM(ta_[11], vaddr_, 6656); AT_SB(); \
           AT_WAITK(8, kfa0, kfa1); N0 = MFMA32(kfa0, qr[3], N0); AT_PIN1(N0); AT_EXP(C1[8]); AT_EXP(C1[9]); AT_EXP(C1[10]); AT_EXP(C1[11]); VTR_ASM(ta_[12], vaddr_, 3072); AT_SB(); \
          N1 = MFMA32(kfa1, qr[3], N1); AT_PIN1(N1); AT_EXP(C1[12]); AT_EXP(C1[13]); AT_EXP(C1[14]); AT_EXP(C1[15]); VTR_ASM(ta_[13], vaddr_, 3584); VTR_ASM(ta_[14], vaddr_, 7168); VTR_ASM(ta_[15], vaddr_, 7680); AT_SB(); \
          \
        } \
        if constexpr (NS == 6) AT_WAITV8(9, ta_[0], ta_[1], ta_[2], ta_[3], ta_[4], ta_[5], ta_[6], ta_[7]); else AT_WAITV8(8, ta_[0], ta_[1], ta_[2], ta_[3], ta_[4], ta_[5], ta_[6], ta_[7]); AT_SB(); \
        vf_[0] = (bf16x8){ta_[0][0], ta_[0][1], ta_[0][2], ta_[0][3], ta_[1][0], ta_[1][1], ta_[1][2], ta_[1][3]}; vf_[1] = (bf16x8){ta_[2][0], ta_[2][1], ta_[2][2], ta_[2][3], ta_[3][0], ta_[3][1], ta_[3][2], ta_[3][3]}; vf_[2] = (bf16x8){ta_[4][0], ta_[4][1], ta_[4][2], ta_[4][3], ta_[5][0], ta_[5][1], ta_[5][2], ta_[5][3]}; vf_[3] = (bf16x8){ta_[6][0], ta_[6][1], ta_[6][2], ta_[6][3], ta_[7][0], ta_[7][1], ta_[7][2], ta_[7][3]}; \
        pw[0] = (u32x4){cvtpk(C0[0], C0[1]), cvtpk(C0[2], C0[3]), cvtpk(C0[4], C0[5]), cvtpk(C0[6], C0[7])}; AT_SB(); \
        if (!(PROBE_VARIANT == 2 && p.pad)) { \
        o0 = MFMA32(__builtin_bit_cast(bf16x8, pw[0]), vf_[0], o0); AT_PIN1(o0); pw[1].x = cvtpk(C0[8], C0[9]); pw[1].y = cvtpk(C0[10], C0[11]); ra_ += (f32x2v){C0[0], C0[1]}; rb_ += (f32x2v){C0[2], C0[3]}; AT_PINRS(); AT_SB(); \
        o1 = MFMA32(__builtin_bit_cast(bf16x8, pw[0]), vf_[1], o1); AT_PIN1(o1); pw[1].z = cvtpk(C0[12], C0[13]); pw[1].w = cvtpk(C0[14], C0[15]); ra_ += (f32x2v){C0[4], C0[5]}; rb_ += (f32x2v){C0[6], C0[7]}; AT_PINRS(); AT_SB(); \
        o0 = MFMA32(__builtin_bit_cast(bf16x8, pw[1]), vf_[2], o0); AT_PIN1(o0); pw[2].x = cvtpk(C1[0], C1[1]); pw[2].y = cvtpk(C1[2], C1[3]); ra_ += (f32x2v){C0[8], C0[9]}; rb_ += (f32x2v){C0[10], C0[11]}; AT_PINRS(); AT_SB(); \
        o1 = MFMA32(__builtin_bit_cast(bf16x8, pw[1]), vf_[3], o1); AT_PIN1(o1); pw[2].z = cvtpk(C1[4], C1[5]); pw[2].w = cvtpk(C1[6], C1[7]); ra_ += (f32x2v){C0[12], C0[13]}; rb_ += (f32x2v){C0[14], C0[15]}; AT_PINRS(); AT_SB(); \
        AT_WAITV4(4, ta_[8], ta_[9], ta_[10], ta_[11]); vf_[4] = (bf16x8){ta_[8][0], ta_[8][1], ta_[8][2], ta_[8][3], ta_[9][0], ta_[9][1], ta_[9][2], ta_[9][3]}; vf_[5] = (bf16x8){ta_[10][0], ta_[10][1], ta_[10][2], ta_[10][3], ta_[11][0], ta_[11][1], ta_[11][2], ta_[11][3]}; \
        o0 = MFMA32(__builtin_bit_cast(bf16x8, pw[2]), vf_[4], o0); AT_PIN1(o0); pw[3].x = cvtpk(C1[8], C1[9]); pw[3].y = cvtpk(C1[10], C1[11]); ra_ += (f32x2v){C1[0], C1[1]}; rb_ += (f32x2v){C1[2], C1[3]}; AT_PINRS(); AT_SB(); \
        o1 = MFMA32(__builtin_bit_cast(bf16x8, pw[2]), vf_[5], o1); AT_PIN1(o1); pw[3].z = cvtpk(C1[12], C1[13]); pw[3].w = cvtpk(C1[14], C1[15]); ra_ += (f32x2v){C1[4], C1[5]}; rb_ += (f32x2v){C1[6], C1[7]}; AT_PINRS(); AT_SB(); \
        AT_WAITV4(0, ta_[12], ta_[13], ta_[14], ta_[15]); vf_[6] = (bf16x8){ta_[12][0], ta_[12][1], ta_[12][2], ta_[12][3], ta_[13][0], ta_[13][1], ta_[13][2], ta_[13][3]}; vf_[7] = (bf16x8){ta_[14][0], ta_[14][1], ta_[14][2], ta_[14][3], ta_[15][0], ta_[15][1], ta_[15][2], ta_[15][3]}; \
        o0 = MFMA32(__builtin_bit_cast(bf16x8, pw[3]), vf_[6], o0); AT_PIN1(o0); ra_ += (f32x2v){C1[8], C1[9]}; rb_ += (f32x2v){C1[10], C1[11]}; AT_PINRS(); AT_SB(); \
        o1 = MFMA32(__builtin_bit_cast(bf16x8, pw[3]), vf_[7], o1); AT_PIN1(o1); ra_ += (f32x2v){C1[12], C1[13]}; rb_ += (f32x2v){C1[14], C1[15]}; AT_PINRS(); AT_SB(); } \
        l += (ra_[0] + ra_[1]) + (rb_[0] + rb_[1]); \
        AT_WAITBAR(); \
        if (t_ + 1 < ntiles) AT_REF(N0, N1, t1_, false); } while (0)
    for (int it = 0; it < ntiles; it += 2) {
        AT_STEP(cA0, cA1, cB0, cB1, it);
        AT_STEP(cB0, cB1, cA0, cA1, it + 1);
    }
#undef AT_ROW0
#undef AT_DMAK
#undef AT_DMAV
#undef AT_CLAMP
#undef AT_WAITBAR
#undef AT_REF
#undef AT_SB
#undef AT_PIN2
#undef AT_PIN1
#undef AT_PINRS
#undef AT_LDK
#undef AT_WAITK
#undef AT_WAITV8
#undef AT_WAITV4
#undef AT_EXP
#undef AT_QK
#undef AT_STEP
    float lt = l + shxl(l, 32, lane);
    float fin = 1.f;
    if (p.sink) { const float sk = p.sink[h] * LOG2E; const float m2 = fmaxf(m, sk); fin = __builtin_amdgcn_exp2f(m - m2); lt = lt * fin + __builtin_amdgcn_exp2f(sk - m2); }
    const float sc = fin / lt;
    if (hi == 0) wsf[r32] = sc;
    bf16_t* Ob = p.O + (size_t)(q0 + wid * 32) * p.old + h * p.ohs + r32;
#pragma unroll
    for (int r = 0; r < 16; ++r) { const int qr_ = crow(r, hi); const float f = wsf[qr_];
        if (!nostore) { Ob[(size_t)qr_ * p.old] = f2bf(o0[r] * f); Ob[(size_t)qr_ * p.old + 32] = f2bf(o1[r] * f); } }
}

namespace gp {
constexpr int BM = 256, BK = 64, HALF = 128, HTB = HALF * BK * 2, STAGE_BYTES = 8 * HTB, NXCD = 8, WGM = 8;
__host__ __device__ __forceinline__ int lds_byte(int r, int c) { const int st = (r >> 4) * 2 + (c >> 5), rr = r & 15, cc = c & 31, ob = rr * 64 + cc * 2; return st * 1024 + (ob ^ (((ob >> 9) & 1) << 5)); }
__host__ __device__ __forceinline__ void stage_rc(int b, int& R, int& C) { const int st = b / 1024, sb = b % 1024, swz = sb ^ (((sb >> 9) & 1) << 5); R = (st >> 1) * 16 + swz / 64; C = (st & 1) * 32 + (swz % 64) / 2; }
__host__ __device__ __forceinline__ int perm32(int rho) { const int n = rho >> 4, i = rho & 15; return 8 * (i >> 2) + 4 * n + (i & 3); }

struct GUnit { const char* A; const char* B; int nt, pm, pn, tag; const unsigned* goff; int lda2, ldb2; };

__device__ __forceinline__ bool tile_order(int i, int G_, int c, int nM, int nN, int& pm, int& pn) {
    const int nwg = nM * nN; const long L = (long)i * G_ + c; if (L >= nwg) return false;
    int wgid = (int)L; { const int q = nwg / NXCD, r = nwg % NXCD, xcd = wgid % NXCD, off = wgid / NXCD; wgid = (xcd < r ? xcd * (q + 1) : r * (q + 1) + (xcd - r) * q) + off; }
    const int nig = WGM * nN, gid = wgid / nig, fm = gid * WGM, gsz = (nM - fm) < WGM ? (nM - fm) : WGM;
    pm = fm + ((wgid % nig) % gsz); pn = (wgid % nig) / gsz; return true;
}
__device__ __forceinline__ unsigned cvt_pk_bf16(float lo, float hi) { return pkbf(lo, hi); }

template <class Epi, class Sched>
__device__ __forceinline__ void gemm_phase(LAS unsigned char* lds, const Sched& S, const Epi& E, int wv0) {
    constexpr bool GATHER = Sched::GATHER; constexpr bool VS = Sched::VARSTRIDE;
    const int tid = opaque_tid(wv0), wid = __builtin_amdgcn_readfirstlane(tid >> 6), lane = tid & 63, wr = wid >> 2, wc = wid & 3, fr = lane & 15, fq = lane >> 4;
    const int lda2 = S.lda2, ldb2 = S.ldb2;
    unsigned voffA[2], voffB[2], rowA[2], rowB[2], colb[2];
#pragma unroll
    for (int i = 0; i < 2; ++i) { int R, C; stage_rc(tid * 16 + i * 8192, R, C); const int Rb = Epi::PERM ? ((R & ~31) + perm32(R & 31)) : R;
        voffA[i] = GATHER ? (unsigned)C * 2u : (unsigned)R * (unsigned)lda2 + (unsigned)C * 2u; rowA[i] = (unsigned)R; voffB[i] = (unsigned)Rb * (unsigned)ldb2 + (unsigned)C * 2u; rowB[i] = (unsigned)Rb; colb[i] = (unsigned)C * 2u; }
    size_t hA = GATHER ? 0 : (size_t)HALF * lda2, hB = (size_t)HALF * ldb2;
    const unsigned ldsw = (unsigned)wid * 1024u;
    const int aoff = lds_byte(wr * 64 + fr, fq * 8), boff = lds_byte(wc * 32 + fr, fq * 8);
    constexpr size_t kstep = (size_t)(BK * 2);
#define GP_SA(b, h) (((b) * 2 + (h)) * HTB)
#define GP_SB(b, h) ((4 + (b) * 2 + (h)) * HTB)
#define GP_STAGE(bufoff, gbase, v0, v1) do { \
        __builtin_amdgcn_global_load_lds((const unsigned*)((const char*)(gbase) + (v0)), (LAS unsigned*)(lds + (bufoff) + ldsw), 16, 0, 0); \
        __builtin_amdgcn_global_load_lds((const unsigned*)((const char*)(gbase) + (v1)), (LAS unsigned*)(lds + (bufoff) + ldsw + 8192), 16, 0, 0); } while (0)
#define GP_LDA(dst, b, h) do { _Pragma("unroll") for (int m = 0; m < 4; ++m) _Pragma("unroll") for (int k = 0; k < 2; ++k) dst[m][k] = *(const LAS bf16x8*)(lds + GP_SA(b, h) + aoff + m * 2048 + k * 1024); } while (0)
#define GP_LDB(dst, b, h) do { _Pragma("unroll") for (int n = 0; n < 2; ++n) _Pragma("unroll") for (int k = 0; k < 2; ++k) dst[n][k] = *(const LAS bf16x8*)(lds + GP_SB(b, h) + boff + n * 2048 + k * 1024); } while (0)
#define GP_MMA(ai, bj, At, Bt) do { __builtin_amdgcn_s_setprio(1); _Pragma("unroll") for (int m = 0; m < 4; ++m) _Pragma("unroll") for (int n = 0; n < 2; ++n) _Pragma("unroll") for (int k = 0; k < 2; ++k) \
        acc[ai][bj][m][n] = __builtin_amdgcn_mfma_f32_16x16x32_bf16(Bt[n][k], At[m][k], acc[ai][bj][m][n], 0, 0, 0); __builtin_amdgcn_s_setprio(0); } while (0)
#define GP_WAIT_V(n) asm volatile("s_waitcnt vmcnt(" #n ")" ::: "memory")
#define GP_WAIT_L(n) asm volatile("s_waitcnt lgkmcnt(" #n ")" ::: "memory")
#define GP_BAR __builtin_amdgcn_s_barrier()
#define GP_SCHED __builtin_amdgcn_sched_barrier(0)
#define GP_GOFF(U, o0, o1, p0, p1) do { if (GATHER) { o0 = (U).goff[rowA[0]] + voffA[0]; o1 = (U).goff[rowA[1]] + voffA[1]; p0 = (U).goff[128 + rowA[0]] + voffA[0]; p1 = (U).goff[128 + rowA[1]] + voffA[1]; } \
        else { o0 = voffA[0]; o1 = voffA[1]; p0 = voffA[0]; p1 = voffA[1]; } } while (0)
    GUnit cur, nxt; int ui = 0;
    if (!S.next(0, cur)) return;
    f32x4 acc[2][2][4][2];
#pragma unroll
    for (int a = 0; a < 2; ++a)
#pragma unroll
        for (int b = 0; b < 2; ++b)
#pragma unroll
            for (int m = 0; m < 4; ++m)
#pragma unroll
                for (int n = 0; n < 2; ++n) acc[a][b][m][n] = (f32x4){0.f, 0.f, 0.f, 0.f};
    bf16x8 At[4][2], B0[2][2], B1[2][2];
    unsigned g00, g01, g10, g11;
    if (VS) { voffA[0] = rowA[0] * (unsigned)cur.lda2 + colb[0]; voffA[1] = rowA[1] * (unsigned)cur.lda2 + colb[1]; voffB[0] = rowB[0] * (unsigned)cur.ldb2 + colb[0]; voffB[1] = rowB[1] * (unsigned)cur.ldb2 + colb[1];
              hA = (size_t)HALF * cur.lda2; hB = (size_t)HALF * cur.ldb2; }
    GP_GOFF(cur, g00, g01, g10, g11);
    const char* cA = cur.A; const char* cB = cur.B;
    GP_STAGE(GP_SB(0, 0), cB, voffB[0], voffB[1]); GP_STAGE(GP_SA(0, 0), cA, g00, g01); GP_STAGE(GP_SB(0, 1), cB + hB, voffB[0], voffB[1]); GP_STAGE(GP_SA(0, 1), cA + hA, g10, g11);
    if (wr == 1) GP_BAR;
    GP_WAIT_V(4); GP_BAR;
    GP_STAGE(GP_SB(1, 0), cB + kstep, voffB[0], voffB[1]); GP_STAGE(GP_SA(1, 0), cA + kstep, g00, g01); GP_STAGE(GP_SB(1, 1), cB + hB + kstep, voffB[0], voffB[1]);
    GP_WAIT_V(6); GP_BAR;
    for (;;) {
        const bool has_next = S.next(ui + 1, nxt);
        const char* nA = has_next ? nxt.A : cA; const char* nB = has_next ? nxt.B : cB;
        const int nt = cur.nt;
        for (int t = 0; t < nt; t += 2) {
            const bool last = (t == nt - 2);
            const char* a1 = cA + (size_t)(t + 1) * kstep;
            const char* a2 = last ? nA : cA + (size_t)(t + 2) * kstep; const char* b2 = last ? nB : cB + (size_t)(t + 2) * kstep;
            const char* a3 = a2 + kstep; const char* b3 = b2 + kstep;
            unsigned w00 = g00, w01 = g01, w10 = g10, w11 = g11, wB0 = voffB[0], wB1 = voffB[1]; size_t whA = hA, whB = hB;
            if (GATHER && last && has_next) { GP_GOFF(nxt, w00, w01, w10, w11); }
            if (VS && last && has_next) { w00 = w10 = rowA[0] * (unsigned)nxt.lda2 + colb[0]; w01 = w11 = rowA[1] * (unsigned)nxt.lda2 + colb[1]; wB0 = rowB[0] * (unsigned)nxt.ldb2 + colb[0]; wB1 = rowB[1] * (unsigned)nxt.ldb2 + colb[1];
                whA = (size_t)HALF * nxt.lda2; whB = (size_t)HALF * nxt.ldb2; }
            GP_LDB(B0, 0, 0); GP_SCHED; GP_LDA(At, 0, 0); GP_STAGE(GP_SA(1, 1), a1 + hA, g10, g11);
            GP_WAIT_L(8); GP_BAR; GP_WAIT_L(0); GP_MMA(0, 0, At, B0); GP_BAR; GP_SCHED;
            GP_LDB(B1, 0, 1); GP_STAGE(GP_SB(0, 0), b2, wB0, wB1);
            GP_BAR; GP_WAIT_L(0); GP_MMA(0, 1, At, B1); GP_BAR;
            GP_LDA(At, 0, 1); GP_STAGE(GP_SA(0, 0), a2, w00, w01);
            GP_BAR; GP_WAIT_L(0); GP_MMA(1, 0, At, B0); GP_BAR; GP_SCHED;
            GP_STAGE(GP_SB(0, 1), b2 + whB, wB0, wB1);
            GP_WAIT_V(6); GP_BAR; GP_MMA(1, 1, At, B1); GP_BAR;
            GP_LDB(B0, 1, 0); GP_SCHED; GP_LDA(At, 1, 0); GP_STAGE(GP_SA(0, 1), a2 + whA, w10, w11);
            GP_WAIT_L(8); GP_BAR; GP_WAIT_L(0); GP_MMA(0, 0, At, B0); GP_BAR; GP_SCHED;
            GP_LDB(B1, 1, 1); GP_STAGE(GP_SB(1, 0), b3, wB0, wB1);
            GP_BAR; GP_WAIT_L(0); GP_MMA(0, 1, At, B1); GP_BAR;
            GP_LDA(At, 1, 1); GP_STAGE(GP_SA(1, 0), a3, w00, w01);
            GP_BAR; GP_WAIT_L(0); GP_MMA(1, 0, At, B0); GP_BAR; GP_SCHED;
            GP_STAGE(GP_SB(1, 1), b3 + whB, wB0, wB1);
            GP_WAIT_V(6); GP_BAR; GP_MMA(1, 1, At, B1); GP_BAR;
            if ((GATHER || VS) && last) { g00 = w00; g01 = w01; g10 = w10; g11 = w11; }
            if (VS && last) { voffB[0] = wB0; voffB[1] = wB1; hA = whA; hB = whB; }
        }
        { int fr_e = fr, fq_e = fq; asm volatile("" : "+v"(fr_e), "+v"(fq_e));
          E(acc, cur, wr, wc, fr_e, fq_e); }
        if (!has_next) break;
#pragma unroll
        for (int a = 0; a < 2; ++a)
#pragma unroll
            for (int b = 0; b < 2; ++b)
#pragma unroll
                for (int m = 0; m < 4; ++m)
#pragma unroll
                    for (int n = 0; n < 2; ++n) acc[a][b][m][n] = (f32x4){0.f, 0.f, 0.f, 0.f};
        cur = nxt; cA = nA; cB = nB; ++ui;
    }
    GP_WAIT_V(0);
    if (wr == 0) GP_BAR;
    GP_BAR;
#undef GP_SA
#undef GP_SB
#undef GP_STAGE
#undef GP_LDA
#undef GP_LDB
#undef GP_MMA
#undef GP_WAIT_V
#undef GP_WAIT_L
#undef GP_BAR
#undef GP_SCHED
#undef GP_GOFF
}
}

struct SchedStd {
    static constexpr bool GATHER = false; static constexpr bool VARSTRIDE = false;
    const bf16_t* A; const bf16_t* Bt; int K, nM, nN, G_, c, skipctx, lda2, ldb2;
    __device__ __forceinline__ bool next(int i, gp::GUnit& u) const {
        int pmv, pn; if (!gp::tile_order(i, G_, c, nM, nN, pmv, pn)) return false;
        const int pm = skipctx ? pmv + pmv / 32 : pmv;
        u.A = (const char*)(A + (size_t)pm * 256 * K); u.B = (const char*)(Bt + (size_t)pn * 256 * K); u.nt = K / 64; u.pm = pm; u.pn = pn; u.tag = 0; u.goff = nullptr; return true;
    }
};

__device__ __forceinline__ float fexp(float x) { return __builtin_amdgcn_exp2f(x * LOG2E); }
__device__ __forceinline__ float flog(float x) { return __builtin_amdgcn_logf(x) * 0.6931471805599453f; }
__device__ __forceinline__ float fsigmoid(float x) { return __builtin_amdgcn_rcpf(1.f + fexp(-x)); }
template <bool ZERO> __device__ __forceinline__ float logf_gate_fast(float z, float lb) {
    if constexpr (ZERO) return fminf(z, 0.f) - flog(1.f + fexp(-fabsf(z)));
    else return flog(lb + (1.f - lb) * fsigmoid(z));
}
__device__ __forceinline__ unsigned pkh2(float lo, float hi) { const f16_t a = (f16_t)lo, b = (f16_t)hi; return (unsigned)__builtin_bit_cast(unsigned short, a) | ((unsigned)__builtin_bit_cast(unsigned short, b) << 16); }

template <class T> __device__ __forceinline__ T* opq(T* p) { asm volatile("" : "+s"(p)); return p; }
struct EpiG1 {
    static constexpr bool PERM = true;
    bf16_t *AQ, *AK, *AV, *BQ, *BV, *BG; f16_t *BLF, *BLB; bf16_t *CQKV, *CKR; float* RS; const float *ropa_c, *ropa_s, *ropc_c, *ropc_s; const float* LBl; int rowoff; int lbzero;
    __device__ __forceinline__ void operator()(const f32x4 (&acc)[2][2][4][2], const gp::GUnit& u, int wr, int wc, int fr, int fq) const {
        const int pn = u.pn; const int pr = u.pm % 33; const bool lat = pr < 32;
        const int grow0 = u.pm * 256 + wr * 64 + fr; const int t0 = pr * 256 + wr * 64 + fr;
        if (pn < 3) {
            const int hh = pn * 4 + wc; bf16_t* dst; int ld, coff; bf16_t* const aq_ = opq(AQ); bf16_t* const ak_ = opq(AK); bf16_t* const av_ = opq(AV);
            if (hh < 8) { dst = aq_; ld = 512; coff = hh * 64; } else if (hh < 10) { dst = ak_; ld = 128; coff = (hh - 8) * 64; } else { dst = av_; ld = 128; coff = (hh - 10) * 64; }
            const bool rope = lat && hh < 10;
#pragma unroll
            for (int ai = 0; ai < 2; ++ai)
#pragma unroll
                for (int m = 0; m < 4; ++m) { const int grow = grow0 + ai * 128 + m * 16, t = t0 + ai * 128 + m * 16; const size_t row = (size_t)(grow - rowoff);
                    f32x4 x1a = acc[ai][0][m][0], x1b = acc[ai][0][m][1], x2a = acc[ai][1][m][0], x2b = acc[ai][1][m][1];
                    if (rope) { const f32x4 ca = *(const f32x4*)(ropa_c + t * 32 + 8 * fq), cb = *(const f32x4*)(ropa_c + t * 32 + 8 * fq + 4), sa = *(const f32x4*)(ropa_s + t * 32 + 8 * fq), sb = *(const f32x4*)(ropa_s + t * 32 + 8 * fq + 4);
                        const f32x4 o1a = x1a * ca - x2a * sa, o2a = x1a * sa + x2a * ca, o1b = x1b * cb - x2b * sb, o2b = x1b * sb + x2b * cb; x1a = o1a; x2a = o2a; x1b = o1b; x2b = o2b; }
                    if (hh < 8) { const float qs = 0.125f * LOG2E; x1a *= qs; x1b *= qs; x2a *= qs; x2b *= qs; }
                    bf16_t* p = dst + row * ld + coff + 8 * fq;
                    u32x4 w1, w2; w1.x = gp::cvt_pk_bf16(x1a[0], x1a[1]); w1.y = gp::cvt_pk_bf16(x1a[2], x1a[3]); w1.z = gp::cvt_pk_bf16(x1b[0], x1b[1]); w1.w = gp::cvt_pk_bf16(x1b[2], x1b[3]);
                    w2.x = gp::cvt_pk_bf16(x2a[0], x2a[1]); w2.y = gp::cvt_pk_bf16(x2a[2], x2a[3]); w2.z = gp::cvt_pk_bf16(x2b[0], x2b[1]); w2.w = gp::cvt_pk_bf16(x2b[2], x2b[3]);
                    *(u32x4*)p = w1; *(u32x4*)(p + 32) = w2; if (m == 3) asm volatile("" ::: "memory"); }
        } else if (pn < 13) {
            const int q = pn - 3, which = q >> 1; const int cb0 = (q & 1) * 256 + wc * 32 + 8 * fq;
            if (which == 2 || which == 3) {
                f16_t* const blf_ = opq(BLF); f16_t* const blb_ = opq(BLB); f16_t* dst = which == 2 ? blf_ : blb_; const float* lbp = LBl + (which == 2 ? 0 : 512);
                if (lbzero) {
#pragma unroll
                for (int bj = 0; bj < 2; ++bj) { const int c0 = cb0 + bj * 128; const f32x4 la = *(const f32x4*)(lbp + c0), lb4 = *(const f32x4*)(lbp + c0 + 4);
#pragma unroll
                    for (int ai = 0; ai < 2; ++ai)
#pragma unroll
                        for (int m = 0; m < 4; ++m) { const size_t row = (size_t)(grow0 + ai * 128 + m * 16 - rowoff); const f32x4 v0 = acc[ai][bj][m][0], v1 = acc[ai][bj][m][1];
                            u32x4 w; w.x = pkh2(logf_gate_fast<true>(v0[0], la[0]), logf_gate_fast<true>(v0[1], la[1])); w.y = pkh2(logf_gate_fast<true>(v0[2], la[2]), logf_gate_fast<true>(v0[3], la[3]));
                            w.z = pkh2(logf_gate_fast<true>(v1[0], lb4[0]), logf_gate_fast<true>(v1[1], lb4[1])); w.w = pkh2(logf_gate_fast<true>(v1[2], lb4[2]), logf_gate_fast<true>(v1[3], lb4[3]));
                            *(u32x4*)(dst + row * 512 + c0) = w; } }
                } else {
#pragma unroll
                for (int bj = 0; bj < 2; ++bj) { const int c0 = cb0 + bj * 128; const f32x4 la = *(const f32x4*)(lbp + c0), lb4 = *(const f32x4*)(lbp + c0 + 4);
#pragma unroll
                    for (int ai = 0; ai < 2; ++ai)
#pragma unroll
                        for (int m = 0; m < 4; ++m) { const size_t row = (size_t)(grow0 + ai * 128 + m * 16 - rowoff); const f32x4 v0 = acc[ai][bj][m][0], v1 = acc[ai][bj][m][1];
                            u32x4 w; w.x = pkh2(logf_gate_fast<false>(v0[0], la[0]), logf_gate_fast<false>(v0[1], la[1])); w.y = pkh2(logf_gate_fast<false>(v0[2], la[2]), logf_gate_fast<false>(v0[3], la[3]));
                            w.z = pkh2(logf_gate_fast<false>(v1[0], lb4[0]), logf_gate_fast<false>(v1[1], lb4[1])); w.w = pkh2(logf_gate_fast<false>(v1[2], lb4[2]), logf_gate_fast<false>(v1[3], lb4[3]));
                            *(u32x4*)(dst + row * 512 + c0) = w; } }
                }
            } else {
                bf16_t* const bq_ = opq(BQ); bf16_t* const bv_ = opq(BV); bf16_t* const bg_ = opq(BG); bf16_t* dst = which == 0 ? bq_ : (which == 1 ? bv_ : bg_);
#pragma unroll
                for (int ai = 0; ai < 2; ++ai)
#pragma unroll
                    for (int m = 0; m < 4; ++m) { const size_t row = (size_t)(grow0 + ai * 128 + m * 16 - rowoff);
#pragma unroll
                        for (int bj = 0; bj < 2; ++bj) { const f32x4 v0 = acc[ai][bj][m][0], v1 = acc[ai][bj][m][1];
                            u32x4 w; w.x = gp::cvt_pk_bf16(v0[0], v0[1]); w.y = gp::cvt_pk_bf16(v0[2], v0[3]); w.z = gp::cvt_pk_bf16(v1[0], v1[1]); w.w = gp::cvt_pk_bf16(v1[2], v1[3]);
                            *(u32x4*)(dst + row * 512 + cb0 + bj * 128) = w; } }
            }
        } else if (pn == 13) {
#pragma unroll
            for (int ai = 0; ai < 2; ++ai)
#pragma unroll
                for (int m = 0; m < 4; ++m) { const int grow = grow0 + ai * 128 + m * 16; const size_t row = (size_t)(grow - rowoff); float ss = 0.f;
#pragma unroll
                    for (int bj = 0; bj < 2; ++bj) { const f32x4 v0 = acc[ai][bj][m][0], v1 = acc[ai][bj][m][1];
                        ss += v0[0] * v0[0] + v0[1] * v0[1] + v0[2] * v0[2] + v0[3] * v0[3] + v1[0] * v1[0] + v1[1] * v1[1] + v1[2] * v1[2] + v1[3] * v1[3];
                        u32x4 w; w.x = gp::cvt_pk_bf16(v0[0], v0[1]); w.y = gp::cvt_pk_bf16(v0[2], v0[3]); w.z = gp::cvt_pk_bf16(v1[0], v1[1]); w.w = gp::cvt_pk_bf16(v1[2], v1[3]);
                        *(u32x4*)(CQKV + row * 384 + bj * 128 + wc * 32 + 8 * fq) = w; }
                    ss += shxl(ss, 16, fr | (fq << 4)); ss += shxl(ss, 32, fr | (fq << 4));
                    if (fq == 0) RS[(size_t)grow * 8 + wc] = ss; }
        } else {
#pragma unroll
            for (int ai = 0; ai < 2; ++ai)
#pragma unroll
                for (int m = 0; m < 4; ++m) { const int grow = grow0 + ai * 128 + m * 16, t = t0 + ai * 128 + m * 16; const size_t row = (size_t)(grow - rowoff);
                    const f32x4 v0 = acc[ai][0][m][0], v1 = acc[ai][0][m][1];
                    float ss = v0[0] * v0[0] + v0[1] * v0[1] + v0[2] * v0[2] + v0[3] * v0[3] + v1[0] * v1[0] + v1[1] * v1[1] + v1[2] * v1[2] + v1[3] * v1[3];
                    u32x4 w; w.x = gp::cvt_pk_bf16(v0[0], v0[1]); w.y = gp::cvt_pk_bf16(v0[2], v0[3]); w.z = gp::cvt_pk_bf16(v1[0], v1[1]); w.w = gp::cvt_pk_bf16(v1[2], v1[3]);
                    *(u32x4*)(CQKV + row * 384 + 256 + wc * 32 + 8 * fq) = w;
                    ss += shxl(ss, 16, fr | (fq << 4)); ss += shxl(ss, 32, fr | (fq << 4));
                    if (fq == 0) RS[(size_t)grow * 8 + 4 + wc] = ss;
                    if (wc == 0) { f32x4 x1 = acc[ai][1][m][0], x2 = acc[ai][1][m][1];
                        if (lat) { const f32x4 cc = *(const f32x4*)(ropc_c + t * 16 + 4 * fq), sn = *(const f32x4*)(ropc_s + t * 16 + 4 * fq); const f32x4 o1 = x1 * cc - x2 * sn, o2 = x1 * sn + x2 * cc; x1 = o1; x2 = o2; }
                        *(uint2*)(CKR + row * 32 + 4 * fq) = make_uint2(gp::cvt_pk_bf16(x1[0], x1[1]), gp::cvt_pk_bf16(x1[2], x1[3]));
                        *(uint2*)(CKR + row * 32 + 16 + 4 * fq) = make_uint2(gp::cvt_pk_bf16(x2[0], x2[1]), gp::cvt_pk_bf16(x2[2], x2[3])); } }
        }
    }
};

struct EpiC {
    static constexpr bool PERM = true;
    bf16_t *CQ, *CKV; const float* RS; const float *ropc_c, *ropc_s; int pmoff;
    __device__ __forceinline__ void operator()(const f32x4 (&acc)[2][2][4][2], const gp::GUnit& u, int wr, int wc, int fr, int fq) const {
        const int pn = u.pn; const int pr = (u.pm + pmoff) % 33; const bool lat = pr < 32;
        const int grow0 = u.pm * 256 + wr * 64 + fr; const int t0 = pr * 256 + wr * 64 + fr;
        f32x4 rs4[2][4];
#pragma unroll
        for (int ai = 0; ai < 2; ++ai)
#pragma unroll
            for (int m = 0; m < 4; ++m) rs4[ai][m] = *(const f32x4*)(RS + (size_t)(grow0 + ai * 128 + m * 16) * 8 + (pn < 3 ? 0 : 4));
#pragma unroll
        for (int ai = 0; ai < 2; ++ai)
#pragma unroll
            for (int m = 0; m < 4; ++m) { const size_t row = (size_t)(grow0 + ai * 128 + m * 16); const int t = t0 + ai * 128 + m * 16;
                if (pn < 3) { const f32x4 p4 = rs4[ai][m]; const float rq = rsqrtf(((p4[0] + p4[1]) + (p4[2] + p4[3])) * (1.f / 256.f) + EPS) * (0.10206207261596577f * LOG2E);
#pragma unroll
                    for (int bj = 0; bj < 2; ++bj) { const int gi = pn * 8 + bj * 4 + wc, head = gi / 3, part = gi - head * 3;
                        f32x4 v0 = acc[ai][bj][m][0] * rq, v1 = acc[ai][bj][m][1] * rq;
                        bf16_t* p = CQ + row * 768 + head * 96;
                        if (part < 2) { u32x4 w; w.x = gp::cvt_pk_bf16(v0[0], v0[1]); w.y = gp::cvt_pk_bf16(v0[2], v0[3]); w.z = gp::cvt_pk_bf16(v1[0], v1[1]); w.w = gp::cvt_pk_bf16(v1[2], v1[3]);
                            *(u32x4*)(p + part * 32 + 8 * fq) = w; }
                        else { if (lat) { const f32x4 cc = *(const f32x4*)(ropc_c + t * 16 + 4 * fq), sn = *(const f32x4*)(ropc_s + t * 16 + 4 * fq); const f32x4 o1 = v0 * cc - v1 * sn, o2 = v0 * sn + v1 * cc; v0 = o1; v1 = o2; }
                            *(uint2*)(p + 64 + 4 * fq) = make_uint2(gp::cvt_pk_bf16(v0[0], v0[1]), gp::cvt_pk_bf16(v0[2], v0[3]));
                            *(uint2*)(p + 80 + 4 * fq) = make_uint2(gp::cvt_pk_bf16(v1[0], v1[1]), gp::cvt_pk_bf16(v1[2], v1[3])); } }
                } else { const f32x4 p4 = rs4[ai][m]; const float rkv = rsqrtf(((p4[0] + p4[1]) + (p4[2] + p4[3])) * (1.f / 128.f) + EPS);
#pragma unroll
                    for (int bj = 0; bj < 2; ++bj) { const f32x4 v0 = acc[ai][bj][m][0] * rkv, v1 = acc[ai][bj][m][1] * rkv;
                        u32x4 w; w.x = gp::cvt_pk_bf16(v0[0], v0[1]); w.y = gp::cvt_pk_bf16(v0[2], v0[3]); w.z = gp::cvt_pk_bf16(v1[0], v1[1]); w.w = gp::cvt_pk_bf16(v1[2], v1[3]);
                        *(u32x4*)(CKV + row * 1024 + (pn - 3) * 256 + bj * 128 + wc * 32 + 8 * fq) = w; } } }
    }
};
struct EpiGate {
    static constexpr bool PERM = true;
    bf16_t* GATE; long nstride; int ld;
    __device__ __forceinline__ void operator()(const f32x4 (&acc)[2][2][4][2], const gp::GUnit& u, int wr, int wc, int fr, int fq) const {
        const int n3 = u.pn >> 2; bf16_t* base = GATE + (size_t)n3 * nstride + (u.pn & 3) * 256 + wc * 32 + 8 * fq; const int row0 = u.pm * 256 + wr * 64 + fr;
#pragma unroll
        for (int ai = 0; ai < 2; ++ai)
#pragma unroll
            for (int m = 0; m < 4; ++m) { bf16_t* rp = base + (size_t)(row0 + ai * 128 + m * 16) * ld;
#pragma unroll
                for (int bj = 0; bj < 2; ++bj) { const f32x4 v0 = acc[ai][bj][m][0], v1 = acc[ai][bj][m][1];
                    u32x4 w; w.x = gp::cvt_pk_bf16(fsigmoid(v0[0]), fsigmoid(v0[1])); w.y = gp::cvt_pk_bf16(fsigmoid(v0[2]), fsigmoid(v0[3])); w.z = gp::cvt_pk_bf16(fsigmoid(v1[0]), fsigmoid(v1[1])); w.w = gp::cvt_pk_bf16(fsigmoid(v1[2]), fsigmoid(v1[3]));
                    *(u32x4*)(rp + bj * 128) = w; } }
    }
};
struct SchedMerge {
    static constexpr bool GATHER = false; static constexpr bool VARSTRIDE = false;
    const bf16_t *A0, *A1, *A2; const bf16_t* Bt; int nM, G_, c, skipctx, lda2, ldb2;
    __device__ __forceinline__ bool next(int i, gp::GUnit& u) const {
        int pmv, pn12; if (!gp::tile_order(i, G_, c, nM, 12, pmv, pn12)) return false;
        const int n = pn12 >> 2, pn = pn12 & 3;
        const int pm = skipctx ? pmv + pmv / 32 : pmv;
        const bf16_t* a0 = opq(A0); const bf16_t* a1 = opq(A1); const bf16_t* a2 = opq(A2);
        const bf16_t* a = n == 0 ? a0 : (n == 1 ? a1 : a2);
        u.A = (const char*)(a + (size_t)pm * 256 * 512); u.B = (const char*)(Bt + (size_t)n * 1024 * 512 + (size_t)pn * 256 * 512); u.nt = 8; u.pm = pm; u.pn = pn; u.tag = n; u.goff = nullptr; return true;
    }
};
__device__ __forceinline__ float bflo(unsigned w) { return __uint_as_float(w << 16); }
__device__ __forceinline__ float bfhi(unsigned w) { return __uint_as_float(w & 0xffff0000u); }
struct EpiMerge {
    static constexpr bool PERM = true;
    bf16_t* GATE; long nstride; int ld;
    __device__ __forceinline__ void operator()(const f32x4 (&acc)[2][2][4][2], const gp::GUnit& u, int wr, int wc, int fr, int fq) const {
        if (PROBE_VARIANT == 3 && ld < 0) return;
        const int n3 = u.tag; const int col = u.pn * 256 + wc * 32 + 8 * fq; bf16_t* gb = GATE + (size_t)n3 * nstride + col; const int row0 = u.pm * 256 + wr * 64 + fr;
#pragma unroll
        for (int ai = 0; ai < 2; ++ai) { u32x4 g[4][2];
#pragma unroll
            for (int m = 0; m < 4; ++m)
#pragma unroll
                for (int bj = 0; bj < 2; ++bj) g[m][bj] = *(const u32x4*)(gb + (size_t)(row0 + ai * 128 + m * 16) * ld + bj * 128);
#pragma unroll
            for (int m = 0; m < 4; ++m)
#pragma unroll
                for (int bj = 0; bj < 2; ++bj) { const u32x4 gg = g[m][bj]; const f32x4 v0 = acc[ai][bj][m][0], v1 = acc[ai][bj][m][1];
                    u32x4 w; w.x = gp::cvt_pk_bf16(v0[0] * bflo(gg.x), v0[1] * bfhi(gg.x)); w.y = gp::cvt_pk_bf16(v0[2] * bflo(gg.y), v0[3] * bfhi(gg.y));
                    w.z = gp::cvt_pk_bf16(v1[0] * bflo(gg.z), v1[1] * bfhi(gg.z)); w.w = gp::cvt_pk_bf16(v1[2] * bflo(gg.w), v1[3] * bfhi(gg.w));
                    *(u32x4*)(gb + (size_t)(row0 + ai * 128 + m * 16) * ld + bj * 128) = w; }
            asm volatile("" ::: "memory"); }
    }
};
struct SchedGM {
    static constexpr bool GATHER = false; static constexpr bool VARSTRIDE = true;
    const bf16_t *A0, *A1, *A2, *Ag; const bf16_t *Bbr, *Bg; int nM, G_, c, skipctx, lda2, ldb2;
    __device__ __forceinline__ bool next(int i, gp::GUnit& u) const {
        int pmv, pn12; if (!gp::tile_order(i >> 1, G_, c, nM, 12, pmv, pn12)) return false;
        const int kind = i & 1, n = pn12 >> 2, pn = pn12 & 3;
        const int pm = skipctx ? pmv + pmv / 32 : pmv;
        const bf16_t* a0 = opq(A0); const bf16_t* a1 = opq(A1); const bf16_t* a2 = opq(A2); const bf16_t* ag = opq(Ag);
        const bf16_t* a = n == 0 ? a0 : (n == 1 ? a1 : a2);
        if (kind == 0) { u.A = (const char*)(a + (size_t)pm * 256 * 512); u.B = (const char*)(Bbr + (size_t)n * 1024 * 512 + (size_t)pn * 256 * 512); u.nt = 8; u.lda2 = 1024; u.ldb2 = 1024; }
        else { u.A = (const char*)(ag + (size_t)pm * 256 * 1024); u.B = (const char*)(Bg + (size_t)pn12 * 256 * 1024); u.nt = 16; u.lda2 = 2048; u.ldb2 = 2048; }
        u.pm = pm; u.pn = pn; u.tag = n + 4 * kind; u.goff = nullptr; return true;
    }
};
struct EpiGM {
    static constexpr bool PERM = true;
    bf16_t* U; long nstride; int ld;
    __device__ __forceinline__ void operator()(const f32x4 (&acc)[2][2][4][2], const gp::GUnit& u, int wr, int wc, int fr, int fq) const {
        const int n3 = u.tag & 3; const int col = u.pn * 256 + wc * 32 + 8 * fq; bf16_t* gb = U + (size_t)n3 * nstride + col; const int row0 = u.pm * 256 + wr * 64 + fr;
        if (u.tag < 4) {
#pragma unroll
            for (int ai = 0; ai < 2; ++ai)
#pragma unroll
                for (int m = 0; m < 4; ++m)
#pragma unroll
                    for (int bj = 0; bj < 2; ++bj) { const f32x4 v0 = acc[ai][bj][m][0], v1 = acc[ai][bj][m][1];
                        u32x4 w; w.x = gp::cvt_pk_bf16(v0[0], v0[1]); w.y = gp::cvt_pk_bf16(v0[2], v0[3]); w.z = gp::cvt_pk_bf16(v1[0], v1[1]); w.w = gp::cvt_pk_bf16(v1[2], v1[3]);
                        *(u32x4*)(gb + (size_t)(row0 + ai * 128 + m * 16) * ld + bj * 128) = w; }
        } else {
#pragma unroll
            for (int ai = 0; ai < 2; ++ai) { u32x4 z[4][2];
#pragma unroll
                for (int m = 0; m < 4; ++m)
#pragma unroll
                    for (int bj = 0; bj < 2; ++bj) z[m][bj] = *(const u32x4*)(gb + (size_t)(row0 + ai * 128 + m * 16) * ld + bj * 128);
#pragma unroll
                for (int m = 0; m < 4; ++m)
#pragma unroll
                    for (int bj = 0; bj < 2; ++bj) { const u32x4 zz = z[m][bj]; const f32x4 v0 = acc[ai][bj][m][0], v1 = acc[ai][bj][m][1];
                        u32x4 w; w.x = gp::cvt_pk_bf16(fsigmoid(v0[0]) * bflo(zz.x), fsigmoid(v0[1]) * bfhi(zz.x)); w.y = gp::cvt_pk_bf16(fsigmoid(v0[2]) * bflo(zz.y), fsigmoid(v0[3]) * bfhi(zz.y));
                        w.z = gp::cvt_pk_bf16(fsigmoid(v1[0]) * bflo(zz.z), fsigmoid(v1[1]) * bfhi(zz.z)); w.w = gp::cvt_pk_bf16(fsigmoid(v1[2]) * bflo(zz.w), fsigmoid(v1[3]) * bfhi(zz.w));
                        *(u32x4*)(gb + (size_t)(row0 + ai * 128 + m * 16) * ld + bj * 128) = w; }
                asm volatile("" ::: "memory"); }
        }
    }
};
struct EpiOut {
    static constexpr bool PERM = false;
    const float *xl_src, *xc_src; float *xl_dst, *xc_dst; const float* mod; int pmoff;
    __device__ __forceinline__ void operator()(const f32x4 (&acc)[2][2][4][2], const gp::GUnit& u, int wr, int wc, int fr, int fq) const {
        const int gpm = u.pm + pmoff, b = gpm / 33, pr = gpm - b * 33; const bool lat = pr < 32;
        const float* xs = opq(lat ? xl_src : xc_src); float* xd = opq(lat ? xl_dst : xc_dst);
        const size_t rbase = lat ? ((size_t)b * SEQ + pr * 256) : ((size_t)b * CTXL);
        const float* gt = mod + (size_t)(lat ? b : 4) * 6144 + 2048; const int col0 = u.pn * 256 + wc * 32 + 4 * fq;
        f32x4 g4[2][2];
#pragma unroll
        for (int bj = 0; bj < 2; ++bj)
#pragma unroll
            for (int n = 0; n < 2; ++n) g4[bj][n] = *(const f32x4*)(gt + col0 + bj * 128 + n * 16);
#pragma unroll
        for (int ai = 0; ai < 2; ++ai) { f32x4 xv[4][2][2];
#pragma unroll
            for (int m = 0; m < 4; ++m) { const size_t off = (rbase + ai * 128 + wr * 64 + m * 16 + fr) * D + col0;
#pragma unroll
                for (int bj = 0; bj < 2; ++bj)
#pragma unroll
                    for (int n = 0; n < 2; ++n) xv[m][bj][n] = *(const f32x4*)(xs + off + bj * 128 + n * 16); }
#pragma unroll
            for (int m = 0; m < 4; ++m) { const size_t off = (rbase + ai * 128 + wr * 64 + m * 16 + fr) * D + col0;
#pragma unroll
                for (int bj = 0; bj < 2; ++bj)
#pragma unroll
                    for (int n = 0; n < 2; ++n) *(f32x4*)(xd + off + bj * 128 + n * 16) = xv[m][bj][n] + g4[bj][n] * acc[ai][bj][m][n]; }
            asm volatile("" ::: "memory"); }
    }
};
template <bool GATHER_> struct SchedMoE {
    static constexpr bool GATHER = GATHER_; static constexpr bool VARSTRIDE = false;
    const bf16_t* A; const bf16_t* Bt; const int* tile_e; const unsigned* goff; int K, nM, nN, G_, c, lda2, ldb2; long strideB;
    __device__ __forceinline__ bool next(int i, gp::GUnit& u) const {
        int pm, pn; if (!gp::tile_order(i, G_, c, nM, nN, pm, pn)) return false;
        const int e = tile_e[pm];
        u.A = GATHER ? (const char*)A : (const char*)(A + (size_t)pm * 256 * K); u.B = (const char*)(Bt + (size_t)e * strideB + (size_t)pn * 256 * K); u.nt = K / 64; u.pm = pm; u.pn = pn; u.tag = e;
        u.goff = GATHER ? goff + (size_t)pm * 256 : nullptr; return true;
    }
};
struct EpiUp {
    static constexpr bool PERM = true;
    bf16_t* AUP;
    __device__ __forceinline__ void operator()(const f32x4 (&acc)[2][2][4][2], const gp::GUnit& u, int wr, int wc, int fr, int fq) const {
        const int row0 = u.pm * 256 + wr * 64 + fr; bf16_t* base = AUP + u.pn * 128 + wc * 32 + 8 * fq;
#pragma unroll
        for (int ai = 0; ai < 2; ++ai)
#pragma unroll
            for (int m = 0; m < 4; ++m) { const f32x4 a0 = acc[ai][0][m][0], a1 = acc[ai][0][m][1], b0 = acc[ai][1][m][0], b1 = acc[ai][1][m][1];
                float r[8];
#pragma unroll
                for (int e = 0; e < 4; ++e) { r[e] = a0[e] * fsigmoid(a0[e]) * b0[e]; r[4 + e] = a1[e] * fsigmoid(a1[e]) * b1[e]; }
                u32x4 w; w.x = gp::cvt_pk_bf16(r[0], r[1]); w.y = gp::cvt_pk_bf16(r[2], r[3]); w.z = gp::cvt_pk_bf16(r[4], r[5]); w.w = gp::cvt_pk_bf16(r[6], r[7]);
                *(u32x4*)(base + (size_t)(row0 + ai * 128 + m * 16) * 256) = w; }
    }
};
struct EpiDown {
    static constexpr bool PERM = true;
    bf16_t* YM2; const int* perm; const float* posw;
    __device__ __forceinline__ void operator()(const f32x4 (&acc)[2][2][4][2], const gp::GUnit& u, int wr, int wc, int fr, int fq) const {
        const int row0 = u.pm * 256 + wr * 64 + fr; const int col = u.pn * 256 + wc * 32 + 8 * fq;
        int pe8[2][4]; float w88[2][4];
#pragma unroll
        for (int ai = 0; ai < 2; ++ai)
#pragma unroll
            for (int m = 0; m < 4; ++m) { const int pos = row0 + ai * 128 + m * 16; pe8[ai][m] = perm[pos]; w88[ai][m] = posw[pos]; }
#pragma unroll
        for (int ai = 0; ai < 2; ++ai)
#pragma unroll
            for (int m = 0; m < 4; ++m) { const int pe = pe8[ai][m]; const float w8 = w88[ai][m];
                if (pe >= 0) {
#pragma unroll
                    for (int bj = 0; bj < 2; ++bj) { const f32x4 v0 = acc[ai][bj][m][0] * w8, v1 = acc[ai][bj][m][1] * w8;
                        u32x4 w; w.x = gp::cvt_pk_bf16(v0[0], v0[1]); w.y = gp::cvt_pk_bf16(v0[2], v0[3]); w.z = gp::cvt_pk_bf16(v1[0], v1[1]); w.w = gp::cvt_pk_bf16(v1[2], v1[3]);
                        *(u32x4*)(YM2 + (size_t)pe * 1024 + col + bj * 128) = w; } } }
    }
};
enum { MAP_WIN = 1, MAP_WC = 2, MAP_WUP = 3 };
__device__ __forceinline__ int colmap(int kind, int p) {
    if (kind == MAP_WIN) {
        if (p >= 3840) return MIXW + (p - 3840);
        const int pn = p >> 8, q = p & 255, bj = q >> 7, wc = (q >> 5) & 3, j = q & 31;
        if (pn < 3) return (pn * 4 + wc) * 64 + bj * 32 + j;
        if (pn < 14) return p;
        if (bj == 0) return p;
        if (wc != 0) return -1;
        return 3712 + 16 * ((j >> 2) & 1) + 4 * (j >> 3) + (j & 3);
    }
    return p;
}
constexpr int NCHK = RPB / 64;
struct ScanArgs { const bf16_t* BQ; const bf16_t* BV; const bf16_t* BG; const f16_t* BLF; const f16_t* BLB; bf16_t* ST; float* DS; bf16_t* OB; const float* gn; int in_off; int out_off; int skipctx_out; int pad; };
#define MFMA16(a, b, c) __builtin_amdgcn_mfma_f32_16x16x32_bf16(a, b, c, 0, 0, 0)
constexpr int BCS = 68;
constexpr int SC_RAW = 0, SC_VT = 2 * 64 * BCS * 4, SC_A = SC_VT + 9216;
typedef _Float16 sc_h8 __attribute__((ext_vector_type(8)));
struct StageRegs { sc_h8 lf, lb; bf16x8 v; };
__device__ __forceinline__ void scan_stage_load(const ScanArgs& a, size_t row0, int h, int tid, StageRegs& R) {
    const int row = tid >> 3, c8 = (tid & 7) * 8; const size_t off = (row0 + row) * 512 + h * 64 + c8;
    R.lf = *(const sc_h8*)(a.BLF + off); R.lb = *(const sc_h8*)(a.BLB + off);
    const int vrow = tid & 63, vc8 = (tid >> 6) * 8; R.v = *(const bf16x8*)(a.BV + (row0 + vrow) * 512 + h * 64 + vc8);
}
__device__ __forceinline__ void scan_stage_store(LAS char* lds, int tid, const StageRegs& R) {
    LAS float* RAW = (LAS float*)(lds + SC_RAW); LAS bf16_t* VT = (LAS bf16_t*)(lds + SC_VT);
    const int row = tid >> 3, c8 = (tid & 7) * 8; const int vrow = tid & 63, vc8 = (tid >> 6) * 8; const sc_h8 lf = R.lf, lb = R.lb; const bf16x8 v = R.v;
    *(LAS f32x4*)(RAW + row * BCS + c8) = (f32x4){(float)lf[0], (float)lf[1], (float)lf[2], (float)lf[3]}; *(LAS f32x4*)(RAW + row * BCS + c8 + 4) = (f32x4){(float)lf[4], (float)lf[5], (float)lf[6], (float)lf[7]};
    *(LAS f32x4*)(RAW + 64 * BCS + row * BCS + c8) = (f32x4){(float)lb[0], (float)lb[1], (float)lb[2], (float)lb[3]}; *(LAS f32x4*)(RAW + 64 * BCS + row * BCS + c8 + 4) = (f32x4){(float)lb[4], (float)lb[5], (float)lb[6], (float)lb[7]};
#pragma unroll
    for (int j = 0; j < 8; ++j) VT[(vc8 + j) * 72 + vrow] = (bf16_t)v[j];
}
__device__ __forceinline__ void scan_stage(LAS char* lds, const ScanArgs& a, size_t row0, int h, int tid) { StageRegs R; scan_stage_load(a, row0, h, tid, R); scan_stage_store(lds, tid, R); }
__device__ __forceinline__ void scan_cumsum(LAS char* lds, LAS float* XCH, int tid, float (&lf)[16], float (&bc)[16], float& total) {
    LAS float* RAW = (LAS float*)(lds + SC_RAW);
    const int col = tid & 127, dir = col >> 6, d = col & 63, seg = tid >> 7;
#pragma unroll
    for (int j = 0; j < 16; ++j) lf[j] = RAW[dir * 64 * BCS + (16 * seg + j) * BCS + d];
    if (dir == 0) { float c = 0.f;
#pragma unroll
        for (int j = 0; j < 16; ++j) { c += lf[j]; bc[j] = c; } }
    else { float c = 0.f;
#pragma unroll
        for (int j = 15; j >= 0; --j) { c += lf[j]; bc[j] = c; } }
    XCH[seg * 128 + col] = dir == 0 ? bc[15] : bc[0];
    __syncthreads();
    const float t0 = XCH[col], t1 = XCH[128 + col], t2 = XCH[256 + col], t3 = XCH[384 + col];
    total = (t0 + t1) + (t2 + t3);
    float off;
    if (dir == 0) off = seg == 0 ? 0.f : (seg == 1 ? t0 : (seg == 2 ? t0 + t1 : t0 + t1 + t2));
    else off = seg == 3 ? 0.f : (seg == 2 ? t3 : (seg == 1 ? t3 + t2 : t3 + t2 + t1));
#pragma unroll
    for (int j = 0; j < 16; ++j) bc[j] += off;
}
__device__ __forceinline__ void scan_s1_unit(LAS char* lds, const ScanArgs& a, int wv0, int b, int h, int k, bool hasnext, int nb, int nh, int nk) {
    const int tid = opaque_tid(wv0), lane = tid & 63, wid = tid >> 6;
    LAS bf16_t* VT = (LAS bf16_t*)(lds + SC_VT); LAS bf16_t* KKT = (LAS bf16_t*)(lds + SC_A); LAS float* XCH = (LAS float*)(lds + SC_A + 18432);
    const size_t row0 = (size_t)b * RPB + 64 * k - a.in_off;
    __syncthreads();
    float lf[16], bc[16], total; scan_cumsum(lds, XCH, tid, lf, bc, total);
    const int col = tid & 127, dir = col >> 6, d = col & 63, seg = tid >> 7;
    const size_t sidx = ((size_t)((b * 8 + h) * 2 + dir)) * NCHK + k;
    { unsigned w[8];
#pragma unroll
      for (int j = 0; j < 16; j += 2) { const float k0 = (1.f - fexp(lf[j])) * fexp(total - bc[j]), k1 = (1.f - fexp(lf[j + 1])) * fexp(total - bc[j + 1]); w[j >> 1] = pkbf(k0, k1); }
      LAS u32x4* kp = (LAS u32x4*)(KKT + (dir * 64 + d) * 72 + 16 * seg); kp[0] = (u32x4){w[0], w[1], w[2], w[3]}; kp[1] = (u32x4){w[4], w[5], w[6], w[7]};
      if (seg == 0) a.DS[sidx * 64 + d] = fexp(total); }
    __syncthreads();
    StageRegs R; if (hasnext) scan_stage_load(a, (size_t)nb * RPB + 64 * nk - a.in_off, nh, tid, R);
    { const int wdir = wid >> 2, et = wid & 3, fr = lane & 15, fq = lane >> 4;
      f32x4 acc[4];
#pragma unroll
      for (int dt = 0; dt < 4; ++dt) acc[dt] = (f32x4){0.f, 0.f, 0.f, 0.f};
#pragma unroll
      for (int ks = 0; ks < 2; ++ks) { const bf16x8 af = *(const LAS bf16x8*)(VT + (16 * et + fr) * 72 + 32 * ks + 8 * fq);
#pragma unroll
          for (int dt = 0; dt < 4; ++dt) { const bf16x8 bfv = *(const LAS bf16x8*)(KKT + (wdir * 64 + 16 * dt + fr) * 72 + 32 * ks + 8 * fq); acc[dt] = MFMA16(bfv, af, acc[dt]); } }
      bf16_t* sp = a.ST + (((size_t)((b * 8 + h) * 2 + wdir)) * NCHK + k) * 4096;
#pragma unroll
      for (int dt = 0; dt < 4; ++dt) *(uint2*)(sp + (16 * et + fr) * 64 + 16 * dt + 4 * fq) = make_uint2(pkbf(acc[dt][0], acc[dt][1]), pkbf(acc[dt][2], acc[dt][3])); }
    __syncthreads();
    if (hasnext) scan_stage_store(lds, tid, R);
}
__device__ __forceinline__ void scan_s2_task(const ScanArgs& a, int wv0, int task) {
    const int chain = task >> 2, quarter = task & 3, dir = chain & 1, tid = opaque_tid(wv0);
    const int e = 16 * quarter + (tid >> 5), d = 2 * (tid & 31);
    float s0 = 0.f, s1 = 0.f;
    for (int g = 0; g < NCHK; g += 12) {
        unsigned L[12]; float2 Dv[12]; unsigned* pp[12];
#pragma unroll
        for (int j = 0; j < 12; ++j) { const int step = g + j; const int k = dir == 0 ? (step < 4 ? 128 + step : step - 4) : (step < 4 ? 131 - step : 131 - step);
            const size_t idx = (size_t)chain * NCHK + k; pp[j] = (unsigned*)(a.ST + idx * 4096 + e * 64 + d); L[j] = *pp[j]; Dv[j] = *(const float2*)(a.DS + idx * 64 + d); }
#pragma unroll
        for (int j = 0; j < 12; ++j) { *pp[j] = pkbf(s0, s1); s0 = Dv[j].x * s0 + bflo(L[j]); s1 = Dv[j].y * s1 + bfhi(L[j]); }
    }
}
__device__ __forceinline__ void s3_state_load(const ScanArgs& a, int b, int h, int k, int tid, u32x4& s0, u32x4& s1) {
    const int sd = tid >> 8, e = (tid & 255) >> 2, c16 = (tid & 3) * 16; const bf16_t* sp = a.ST + (((size_t)((b * 8 + h) * 2 + sd)) * NCHK + k) * 4096 + e * 64 + c16; s0 = *(const u32x4*)sp; s1 = *(const u32x4*)(sp + 8); }
__device__ __forceinline__ void s3_state_store(LAS bf16_t* STL, int tid, const u32x4& s0, const u32x4& s1) {
    const int sd = tid >> 8, e = (tid & 255) >> 2, c16 = (tid & 3) * 16; LAS u32x4* dp = (LAS u32x4*)(STL + (sd * 64 + e) * 72 + c16); dp[0] = s0; dp[1] = s1; }
__device__ __forceinline__ void scan_s3_unit(LAS char* lds, const ScanArgs& a, int wv0, int b, int h, int k, bool hasnext, int nb, int nh, int nk) {
    const int tid = opaque_tid(wv0), lane = tid & 63, wid = tid >> 6;
    LAS float* BC = (LAS float*)(lds + SC_RAW); LAS bf16_t* VT = (LAS bf16_t*)(lds + SC_VT);
    LAS bf16_t* STL = (LAS bf16_t*)(lds + SC_A);
    LAS float* XCH = (LAS float*)(lds + SC_A + 18432);
    LAS float* OSUM = (LAS float*)(lds + SC_A + 18432 + 2048);
    LAS bf16_t* PW = (LAS bf16_t*)(lds + SC_A + 18432 + 2048 + 17408) + wid * 3456;
    const size_t row0 = (size_t)b * RPB + 64 * k - a.in_off;
    bf16x8 q0_, q1_; uint2 gp[4];
    { const int dir_ = wid >> 2, si_ = wid & 3, erow_ = lane >> 2, dg_ = (lane & 3) * 16, fr_ = lane & 15, fq_ = lane >> 4;
      const bf16_t* qp = a.BQ + (row0 + 16 * si_ + erow_) * 512 + h * 64 + dg_; q0_ = *(const bf16x8*)qp; q1_ = *(const bf16x8*)(qp + 8);
#pragma unroll
      for (int n = 0; n < 4; ++n) { gp[n] = make_uint2(0u, 0u); if (dir_ == 1) gp[n] = *(const uint2*)(a.BG + (row0 + 16 * si_ + fr_) * 512 + h * 64 + 16 * n + 4 * fq_); } }
    __syncthreads();
    { float lf[16], bc[16], total; scan_cumsum(lds, XCH, tid, lf, bc, total);
      const int col = tid & 127, dir = col >> 6, d = col & 63, seg = tid >> 7;
      __syncthreads();
#pragma unroll
      for (int j = 0; j < 16; ++j) BC[dir * 64 * BCS + (16 * seg + j) * BCS + d] = bc[j]; }
    __syncthreads();
    StageRegs Rn; u32x4 ns0, ns1;
    if (hasnext) { scan_stage_load(a, (size_t)nb * RPB + 64 * nk - a.in_off, nh, tid, Rn); s3_state_load(a, nb, nh, nk, tid, ns0, ns1); }
    const int dir = wid >> 2, si = wid & 3;
    LAS bf16_t* QP = PW; LAS bf16_t* KP = PW + 1152; LAS bf16_t* ATT = PW + 2304;
    const int erow = lane >> 2, dg = (lane & 3) * 16;
    const int fr = lane & 15, fq = lane >> 4;
    LAS const float* bcd = BC + dir * 64 * BCS;
    float refv[16];
    { const int rr = dir == 0 ? 16 * si - 1 : 16 * (si + 1);
#pragma unroll
      for (int j = 0; j < 16; j += 4) { f32x4 t4 = (f32x4){0.f, 0.f, 0.f, 0.f}; if (rr >= 0 && rr < 64) t4 = *(const LAS f32x4*)(bcd + rr * BCS + dg + j); refv[j] = t4[0]; refv[j + 1] = t4[1]; refv[j + 2] = t4[2]; refv[j + 3] = t4[3]; } }
    float qv[16], bq[16];
    {
#pragma unroll
      for (int j = 0; j < 8; ++j) { qv[j] = bf2f((bf16_t)q0_[j]); qv[8 + j] = bf2f((bf16_t)q1_[j]); }
#pragma unroll
      for (int j = 0; j < 16; j += 4) { const f32x4 t4 = *(const LAS f32x4*)(bcd + (16 * si + erow) * BCS + dg + j); bq[j] = t4[0]; bq[j + 1] = t4[1]; bq[j + 2] = t4[2]; bq[j + 3] = t4[3]; } }
    { unsigned w[8];
#pragma unroll
      for (int j = 0; j < 16; j += 2) w[j >> 1] = pkbf(qv[j] * fexp(bq[j] - refv[j]), qv[j + 1] * fexp(bq[j + 1] - refv[j + 1]));
      LAS u32x4* p = (LAS u32x4*)(QP + erow * 72 + dg); p[0] = (u32x4){w[0], w[1], w[2], w[3]}; p[1] = (u32x4){w[4], w[5], w[6], w[7]};
      LAS u32x4* z = (LAS u32x4*)(ATT + erow * 72 + dg); z[0] = (u32x4){0u, 0u, 0u, 0u}; z[1] = (u32x4){0u, 0u, 0u, 0u}; }
    const int j_lo = dir == 0 ? 0 : si, j_hi = dir == 0 ? si : 3;
    for (int jb = j_lo; jb <= j_hi; ++jb) {
        { const int sg = 16 * jb + erow; const int sn = dir == 0 ? sg - 1 : sg + 1; unsigned w[8];
#pragma unroll
          for (int j = 0; j < 16; j += 4) { const f32x4 bs4 = *(const LAS f32x4*)(bcd + sg * BCS + dg + j); f32x4 bn4 = (f32x4){0.f, 0.f, 0.f, 0.f}; if (sn >= 0 && sn < 64) bn4 = *(const LAS f32x4*)(bcd + sn * BCS + dg + j);
              float kk[4];
#pragma unroll
              for (int t = 0; t < 4; ++t) kk[t] = (1.f - fexp(bs4[t] - bn4[t])) * fexp(fminf(refv[j + t] - bs4[t], 60.f));
              w[j >> 1] = pkbf(kk[0], kk[1]); w[(j >> 1) + 1] = pkbf(kk[2], kk[3]); }
          LAS u32x4* p = (LAS u32x4*)(KP + erow * 72 + dg); p[0] = (u32x4){w[0], w[1], w[2], w[3]}; p[1] = (u32x4){w[4], w[5], w[6], w[7]}; }
        __builtin_amdgcn_wave_barrier(); asm volatile("s_waitcnt lgkmcnt(0)" ::: "memory");
        f32x4 c = (f32x4){0.f, 0.f, 0.f, 0.f};
#pragma unroll
        for (int ks = 0; ks < 2; ++ks) { const bf16x8 af = *(const LAS bf16x8*)(QP + fr * 72 + 32 * ks + 8 * fq), bfv = *(const LAS bf16x8*)(KP + fr * 72 + 32 * ks + 8 * fq); c = MFMA16(af, bfv, c); }
#pragma unroll
        for (int r = 0; r < 4; ++r) { const int tq = 4 * fq + r; float v = c[r];
            if (jb == si) { if (dir == 0 ? (fr > tq) : (fr < tq)) v = 0.f; }
            ATT[tq * 72 + 16 * jb + fr] = f2bf(v); }
        __builtin_amdgcn_wave_barrier(); asm volatile("s_waitcnt lgkmcnt(0)" ::: "memory");
    }
    { unsigned w[8];
#pragma unroll
      for (int j = 0; j < 16; j += 2) w[j >> 1] = pkbf(qv[j] * fexp(bq[j]), qv[j + 1] * fexp(bq[j + 1]));
      LAS u32x4* p = (LAS u32x4*)(QP + erow * 72 + dg); p[0] = (u32x4){w[0], w[1], w[2], w[3]}; p[1] = (u32x4){w[4], w[5], w[6], w[7]}; }
    __builtin_amdgcn_wave_barrier(); asm volatile("s_waitcnt lgkmcnt(0)" ::: "memory");
    f32x4 o[4];
#pragma unroll
    for (int n = 0; n < 4; ++n) o[n] = (f32x4){0.f, 0.f, 0.f, 0.f};
#pragma unroll
    for (int ks = 0; ks < 2; ++ks) { const bf16x8 aq = *(const LAS bf16x8*)(QP + fr * 72 + 32 * ks + 8 * fq), aa = *(const LAS bf16x8*)(ATT + fr * 72 + 32 * ks + 8 * fq);
#pragma unroll
        for (int n = 0; n < 4; ++n) { const bf16x8 bs = *(const LAS bf16x8*)(STL + (dir * 64 + 16 * n + fr) * 72 + 32 * ks + 8 * fq), bv = *(const LAS bf16x8*)(VT + (16 * n + fr) * 72 + 32 * ks + 8 * fq);
            o[n] = MFMA16(bs, aq, o[n]); o[n] = MFMA16(bv, aa, o[n]); } }
    if (dir == 0) {
#pragma unroll
        for (int n = 0; n < 4; ++n) *(LAS f32x4*)(OSUM + (16 * si + fr) * 68 + 16 * n + 4 * fq) = o[n]; }
    __syncthreads();
    if (hasnext) { scan_stage_store(lds, tid, Rn); s3_state_store(STL, tid, ns0, ns1); }
    if (dir == 1) {
        const bool wr_out = !(a.skipctx_out && k >= 128) && !a.pad;
        float ss = 0.f;
#pragma unroll
        for (int n = 0; n < 4; ++n) { o[n] += *(const LAS f32x4*)(OSUM + (16 * si + fr) * 68 + 16 * n + 4 * fq); ss += o[n][0] * o[n][0] + o[n][1] * o[n][1] + o[n][2] * o[n][2] + o[n][3] * o[n][3]; }
        ss += shxl(ss, 16, lane); ss += shxl(ss, 32, lane); const float rn = rsqrtf(ss * (1.f / 64.f) + EPS);
        if (wr_out) {
            const size_t orow0 = (size_t)b * RPB + 64 * k - a.out_off;
#pragma unroll
            for (int n = 0; n < 4; ++n) { const f32x4 g4 = *(const f32x4*)(a.gn + h * 64 + 16 * n + 4 * fq);
                const float gv0 = bflo(gp[n].x), gv1 = bfhi(gp[n].x), gv2 = bflo(gp[n].y), gv3 = bfhi(gp[n].y);
                const float y0 = o[n][0] * rn * g4[0] * gv0 * fsigmoid(gv0), y1 = o[n][1] * rn * g4[1] * gv1 * fsigmoid(gv1), y2 = o[n][2] * rn * g4[2] * gv2 * fsigmoid(gv2), y3 = o[n][3] * rn * g4[3] * gv3 * fsigmoid(gv3);
                *(uint2*)(a.OB + (orow0 + 16 * si + fr) * 512 + h * 64 + 16 * n + 4 * fq) = make_uint2(pkbf(y0, y1), pkbf(y2, y3)); }
        }
    }
    __syncthreads();
}
constexpr int SCAN_LDS = SC_A + 18432 + 2048 + 17408 + 8 * 6912;

#define XB_TMO      128
#define XB_XCNT(j)  (256  + 64 * (j))
#define XB_XSUB(j)  (1280 + 64 * (j))
#define XB_XGEN(j)  (2304 + 64 * (j))
#define XB_TOP      3328
#define XB_TOPGEN   3392
#define XCD_BAR_WORDS 3456
#define XB_SPIN_CAP (1u << 18)

__device__ __forceinline__ unsigned xb_ld(unsigned* p)              { return __hip_atomic_load(p, __ATOMIC_RELAXED, __HIP_MEMORY_SCOPE_AGENT); }
__device__ __forceinline__ unsigned xb_add(unsigned* p, unsigned v) { return __hip_atomic_fetch_add(p, v, __ATOMIC_RELAXED, __HIP_MEMORY_SCOPE_AGENT); }
__device__ __forceinline__ unsigned xb_xcc_id() { return (unsigned)__builtin_amdgcn_s_getreg((3 << 11) | 20) & 0xFu; }
#define XB_SPIN(cond, bar) do { unsigned _sp = 0; while (cond) { __builtin_amdgcn_s_sleep(1); \
    if ((++_sp & 255u) == 0u) { if (xb_ld(&(bar)[XB_TMO])) break; if (_sp > XB_SPIN_CAP) { atomicAdd(&(bar)[XB_TMO], 1u); break; } } } } while (0)

struct XcdBarrier {
    unsigned* bar; unsigned x;
    volatile LAS unsigned* st;
};

__device__ __forceinline__ XcdBarrier xcd_barrier_post(unsigned* bar, volatile LAS unsigned* st) {
    XcdBarrier b; b.bar = bar; b.x = xb_xcc_id(); b.st = st;
    if (threadIdx.x == 0) (void)xb_add(&bar[XB_XCNT(b.x)], 1u);
    return b;
}
__device__ __forceinline__ void xcd_barrier_complete(unsigned* bar, unsigned x, unsigned& nloc, unsigned& nx) {
    const unsigned G = gridDim.x * gridDim.y * gridDim.z;
    unsigned sum, cnt, mine, sp = 0u;
    for (;;) {
        sum = 0u; cnt = 0u; mine = 0u;
#pragma unroll
        for (unsigned j = 0; j < 16; ++j) { const unsigned c = xb_ld(&bar[XB_XCNT(j)]); sum += c; cnt += (c > 0u) ? 1u : 0u; mine = (j == x) ? c : mine; }
        if (sum == G) break;
        __builtin_amdgcn_s_sleep(1);
        if ((++sp & 255u) == 0u) { if (xb_ld(&bar[XB_TMO])) break; if (sp > XB_SPIN_CAP) { atomicAdd(&bar[XB_TMO], 1u); break; } }
    }
    nloc = mine > 0u ? mine : 1u; nx = cnt > 0u ? cnt : 1u;
}

__device__ __forceinline__ void xcd_barrier(const XcdBarrier& b) {
    asm volatile("s_waitcnt vmcnt(0)" ::: "memory");
    __syncthreads();
    if (threadIdx.x == 0) {
        unsigned* bar = b.bar;
        __builtin_amdgcn_s_waitcnt(0);
        unsigned nloc = b.st[0], nx = b.st[1];
        if (nloc == 0u) { xcd_barrier_complete(bar, b.x, nloc, nx); b.st[0] = nloc; b.st[1] = nx; }
        const unsigned old = xb_add(&bar[XB_XSUB(b.x)], 1u);
        const unsigned gen = old / nloc;
        if (old + 1u == (gen + 1u) * nloc) {
            __builtin_amdgcn_fence(__ATOMIC_RELEASE, "agent");
            asm volatile("s_waitcnt vmcnt(0)" ::: "memory");
            const unsigned og = xb_add(&bar[XB_TOP], 1u);
            const unsigned tg = og / nx;
            if (og + 1u == (tg + 1u) * nx) xb_add(&bar[XB_TOPGEN], 1u);
            else XB_SPIN(xb_ld(&bar[XB_TOPGEN]) == tg, bar);
            __builtin_amdgcn_fence(__ATOMIC_ACQUIRE, "agent");
            xb_add(&bar[XB_XGEN(b.x)], 1u);
            asm volatile("s_waitcnt vmcnt(0)" ::: "memory");
        } else {
            XB_SPIN(xb_ld(&bar[XB_XGEN(b.x)]) == gen, bar);
            __builtin_amdgcn_fence(__ATOMIC_ACQUIRE, "agent");
            asm volatile("s_waitcnt vmcnt(0)" ::: "memory");
        }
    }
    __syncthreads();
}


constexpr size_t MiB = 1u << 20;
constexpr size_t CTL_ZERO_BYTES = 64 * 1024;
constexpr int CW_COUNTS = 8192, CW_CURSOR = 8192 + 128;
constexpr size_t O_MOD = 1 * MiB, O_LB = 1 * MiB + 512 * 1024, O_ROPA_C = 2 * MiB, O_ROPA_S = 3 * MiB, O_ROPC_C = 4 * MiB, O_ROPC_S = 4 * MiB + 512 * 1024, O_XC = 5 * MiB;
constexpr size_t O_ROUTE_E = 9 * MiB, O_ROUTE_W = 9 * MiB + 512 * 1024, O_PERM = 10 * MiB, O_POSW = 10 * MiB + 512 * 1024, O_GOFF = 11 * MiB, O_TILEE = 11 * MiB + 512 * 1024;
constexpr size_t O_WRT = 11 * MiB + 640 * 1024;
constexpr size_t O_RS = 12 * MiB, O_DS = 13 * MiB + 512 * 1024, O_WGH = 15 * MiB + 768 * 1024;
constexpr size_t O_WINP = 16 * MiB, O_WC = 30 * MiB, O_WBR = 32 * MiB, O_WOUT = 35 * MiB;
constexpr size_t O_H = 38 * MiB;
constexpr size_t O_AQ = 104 * MiB, O_AK = 137 * MiB, O_AV = 145 * MiB + 512 * 1024;
constexpr size_t O_BQ = 154 * MiB, O_BV = 187 * MiB, O_BG = 220 * MiB, O_BLF = 253 * MiB, O_BLB = 286 * MiB;
constexpr size_t O_CQKV = 319 * MiB, O_CKR = 344 * MiB, O_CQ = 347 * MiB, O_CKV = 397 * MiB, O_OC = 463 * MiB, O_WRB = 496 * MiB, WS_END = 497 * MiB;
constexpr size_t O_GATE = 187 * MiB;
constexpr size_t O_YM2 = 154 * MiB, O_AUP = 104 * MiB, O_WUP = 397 * MiB, O_WDN = 429 * MiB;
constexpr int LDS_BYTES = 163840, LDS_BAR_OFF = LDS_BYTES - 64, LDS_PTR_OFF = LDS_BYTES - 512;

struct KP { const float* in[24]; float* out; char* ws; int ph_lo, ph_hi; unsigned long long mask; };
struct Frame {
    LAS char* lds; char* ws; float* out; int wv0;
};
#define WSP(T, off) ((T*)(F.ws + (off)))
__device__ __forceinline__ const float* in_ptr(const Frame& F, int k) { const volatile LAS unsigned* q = (const volatile LAS unsigned*)(F.lds + LDS_PTR_OFF + 8 * k);
    unsigned lo = q[0], hi = q[1]; lo = __builtin_amdgcn_readfirstlane(lo); hi = __builtin_amdgcn_readfirstlane(hi); return (const float*)(((unsigned long long)hi << 32) | lo); }
#define INP(k) in_ptr(F, k)
__device__ __forceinline__ float wave_sum_dpp(float v) {
    int x = __builtin_bit_cast(int, v);
#define DPP_ADD(ctrl, rmask) x = __builtin_bit_cast(int, __builtin_bit_cast(float, x) + __builtin_bit_cast(float, __builtin_amdgcn_update_dpp(0, x, ctrl, rmask, 0xF, false)))
    DPP_ADD(0xB1, 0xF);
    DPP_ADD(0x4E, 0xF);
    DPP_ADD(0x141, 0xF);
    DPP_ADD(0x140, 0xF);
    DPP_ADD(0x142, 0xA);
    DPP_ADD(0x143, 0xC);
#undef DPP_ADD
    return __builtin_bit_cast(float, __builtin_amdgcn_readlane(x, 63));
}
__device__ __forceinline__ float wave_sum(float v) {
#pragma unroll
    for (int o = 32; o >= 1; o >>= 1) v += __shfl_xor(v, o);
    return v;
}

__device__ __forceinline__ void p0_mod(const Frame& F) {
    const int tid = opaque_tid(F.wv0), lane = tid & 63, wave = __builtin_amdgcn_readfirstlane(tid >> 6); (void)lane; (void)wave;
    LAS float* sc = (LAS float*)F.lds;
    LAS float* red = (LAS float*)(F.lds + 20480);
    for (int i = tid; i < 5 * 1024; i += 512) { const int r = i >> 10, k = i & 1023; const float v = r < 4 ? INP(1)[r * 1024 + k] : INP(3)[k]; sc[i] = v / (1.f + expf(-v)); }
    __syncthreads();
    float* MOD = WSP(float, O_MOD);
    for (int u = blockIdx.x; u < 2 * 96; u += gridDim.x) { const int l = u / 96, j = (u % 96) * 64 + lane;
        const float* w = INP(4) + (size_t)l * 1024 * 6144 + j; float a0 = 0.f, a1 = 0.f, a2 = 0.f, a3 = 0.f, a4 = 0.f;
#pragma unroll 8
        for (int kk = 0; kk < 128; ++kk) { const int k = wave * 128 + kk; const float wv = w[(size_t)k * 6144]; a0 += sc[k] * wv; a1 += sc[1024 + k] * wv; a2 += sc[2048 + k] * wv; a3 += sc[3072 + k] * wv; a4 += sc[4096 + k] * wv; }
        red[(wave * 5 + 0) * 64 + lane] = a0; red[(wave * 5 + 1) * 64 + lane] = a1; red[(wave * 5 + 2) * 64 + lane] = a2; red[(wave * 5 + 3) * 64 + lane] = a3; red[(wave * 5 + 4) * 64 + lane] = a4;
        __syncthreads();
        if (tid < 320) { const int r = tid >> 6, ln = tid & 63; float s = 0.f;
#pragma unroll
            for (int w8 = 0; w8 < 8; ++w8) s += red[(w8 * 5 + r) * 64 + ln];
            const int jj = (u % 96) * 64 + ln; MOD[(size_t)(l * 5 + r) * 6144 + jj] = s + INP(5)[l * 6144 + jj]; }
        __syncthreads();
    }
}
__device__ __forceinline__ void p0_tables(const Frame& F) {
    const int tid = opaque_tid(F.wv0), lane = tid & 63, wave = __builtin_amdgcn_readfirstlane(tid >> 6); (void)lane; (void)wave;
    float* ropa_c = WSP(float, O_ROPA_C); float* ropa_s = WSP(float, O_ROPA_S); float* ropc_c = WSP(float, O_ROPC_C); float* ropc_s = WSP(float, O_ROPC_S); float* LB = WSP(float, O_LB);
    for (int i = blockIdx.x * 512 + tid; i < 8192 * 32; i += gridDim.x * 512) {
        { const int t = i >> 5, j = i & 31, row = t >> 6, col = t & 63, f = j & 15; const float inv = powf(10000.f, -(float)f / 16.f); const float ang = (j < 16 ? (float)row : (float)col) * inv;
          ropa_c[i] = (float)cos((double)ang); ropa_s[i] = (float)sin((double)ang); }
        if (i < 8192 * 16) { const int t = i >> 4, j = i & 15, row = t >> 6, col = t & 63, f = j & 7; const float inv = powf(10000.f, -(float)f / 8.f); const float ang = (j < 8 ? (float)row : (float)col) * inv;
          ropc_c[i] = (float)cos((double)ang); ropc_s[i] = (float)sin((double)ang); }
        for (int i2 = i; i2 < 2 * 256 * 1024; i2 += 8192 * 32) { const int l = i2 >> 18, pp = (i2 >> 10) & 255, k = i2 & 1023;
          const int bj = pp >> 7, wc = (pp >> 5) & 3, n = (pp >> 4) & 1, fq = (pp >> 2) & 3, e = pp & 3; float v = 0.f;
          if (wc == 0) { if (bj == 0) v = INP(19)[(size_t)l * 1024 * 32 + k * 32 + fq * 8 + 4 * n + e]; else if (n == 0 && e == 0) v = INP(18)[(size_t)l * 1024 * 4 + k * 4 + fq]; }
          WSP(bf16_t, O_WRB)[i2] = f2bf(v); }
        if (i < 2048) { const int l = i >> 10, rest = i & 1023; if (l == 0) LB[i] = 0.f; else { const float a0 = INP(10)[rest], a1 = INP(10)[1024 + rest]; LB[i] = 1.f / (1.f + expf(a0 - a1)); } }
    }
}
template <class CM> __device__ __forceinline__ void wt_tile(const float* W, int ldw, const CM& cm, bf16_t* Bt, int K, int p0, int k0, LAS float* scr, int lane) {
    const int p4 = (lane & 7) * 4; const int c = cm(p0 + p4);
#pragma unroll
    for (int i = 0; i < 8; ++i) { const int kk = i * 8 + (lane >> 3); f32x4 v = (f32x4){0.f, 0.f, 0.f, 0.f};
        if (c >= 0) v = *(const f32x4*)(W + (size_t)(k0 + kk) * ldw + c);
        scr[kk * 33 + p4] = v[0]; scr[kk * 33 + p4 + 1] = v[1]; scr[kk * 33 + p4 + 2] = v[2]; scr[kk * 33 + p4 + 3] = v[3]; }
    asm volatile("s_waitcnt lgkmcnt(0)" ::: "memory"); __builtin_amdgcn_wave_barrier();
#pragma unroll 8
    for (int pi = 0; pi < 32; ++pi) Bt[(size_t)(p0 + pi) * K + k0 + lane] = f2bf(scr[lane * 33 + pi]);
    asm volatile("s_waitcnt lgkmcnt(0)" ::: "memory"); __builtin_amdgcn_wave_barrier();
}
struct WtDesc { const float* src; size_t ldw8; bf16_t* dst; int K; };
template <class CM> __device__ __forceinline__ WtDesc wt_desc(const float* W, int ldw, const CM& cm, bf16_t* Bt, int K, int p0, int k0, int lane) {
    const int p4 = (lane & 7) * 4; const int c = cm(p0 + p4); WtDesc d; d.src = c >= 0 ? W + (size_t)(k0 + (lane >> 3)) * ldw + c : nullptr; d.ldw8 = (size_t)ldw * 8; d.dst = Bt + (size_t)p0 * K + k0; d.K = K; return d; }
__device__ __forceinline__ void wt_load(const WtDesc& d, f32x4 (&v)[8]) {
#pragma unroll
    for (int i = 0; i < 8; ++i) { v[i] = (f32x4){0.f, 0.f, 0.f, 0.f}; if (d.src) v[i] = *(const f32x4*)(d.src + (size_t)i * d.ldw8); } }
__device__ __forceinline__ void wt_store(const WtDesc& d, const f32x4 (&v)[8], LAS float* scr, int lane) {
    const int p4 = (lane & 7) * 4;
#pragma unroll
    for (int i = 0; i < 8; ++i) { const int kk = i * 8 + (lane >> 3); scr[kk * 33 + p4] = v[i][0]; scr[kk * 33 + p4 + 1] = v[i][1]; scr[kk * 33 + p4 + 2] = v[i][2]; scr[kk * 33 + p4 + 3] = v[i][3]; }
    asm volatile("s_waitcnt lgkmcnt(0)" ::: "memory"); __builtin_amdgcn_wave_barrier();
    const int p = lane >> 1, kh = (lane & 1) * 32; bf16_t* o = d.dst + (size_t)p * d.K + kh;
#pragma unroll
    for (int s4 = 0; s4 < 4; ++s4) { const LAS float* r = scr + (kh + s4 * 8) * 33 + p;
        u32x4 w; w.x = pkbf(r[0], r[33]); w.y = pkbf(r[66], r[99]); w.z = pkbf(r[132], r[165]); w.w = pkbf(r[198], r[231]); *(u32x4*)(o + s4 * 8) = w; }
    asm volatile("s_waitcnt lgkmcnt(0)" ::: "memory"); __builtin_amdgcn_wave_barrier();
}
template <class Dec> __device__ __forceinline__ void wt_run(const Dec& dec, int first, int total, int stride, LAS float* scr, int lane) {
    if (first >= total) return;
    WtDesc cur = dec(first); f32x4 va[8]; wt_load(cur, va);
    for (int it = first; it < total; it += stride) { const int nx = it + stride; const bool hn = nx < total; WtDesc nxt = cur; f32x4 vb[8];
        if (hn) { nxt = dec(nx); wt_load(nxt, vb); }
        wt_store(cur, va, scr, lane);
        if (hn) { cur = nxt;
#pragma unroll
            for (int i = 0; i < 8; ++i) va[i] = vb[i]; } }
}
struct CmWin { __device__ __forceinline__ int operator()(int p) const { return colmap(MAP_WIN, p); } };
struct CmId { __device__ __forceinline__ int operator()(int p) const { return p; } };
__device__ __forceinline__ void conv_weights_nonmoe(const Frame& F, int l) {
    const int tid = opaque_tid(F.wv0), lane = tid & 63, wave = __builtin_amdgcn_readfirstlane(tid >> 6); (void)lane; (void)wave;
    LAS float* scr = (LAS float*)F.lds + wave * (64 * 33);
    const int gw = blockIdx.x * 8 + wave, NGW = gridDim.x * 8;
    constexpr int I_WIN = 216 * 16, I_BR = 3 * 32 * 8, I_OUT = 32 * 16;
    { const float* w_in = INP(8) + (size_t)l * 1024 * INW; const float* w_br = INP(16) + (size_t)l * 3 * 512 * 1024; const float* w_out = INP(17) + (size_t)l * 1024 * 1024; const Frame* Fp = &F;
      auto dec = [=](int it) -> WtDesc { const Frame& F = *Fp; int r = it;
          if (r < I_WIN) return wt_desc(w_in, INW, CmWin(), WSP(bf16_t, O_WINP), 1024, (r / 16) * 32, (r % 16) * 64, lane); r -= I_WIN;
          if (r < I_BR) { const int n = r / 256, q = r % 256; return wt_desc(w_br + (size_t)n * 512 * 1024, 1024, CmId(), WSP(bf16_t, O_WBR) + (size_t)n * 1024 * 512, 512, (q / 8) * 32, (q % 8) * 64, lane); } r -= I_BR;
          return wt_desc(w_out, 1024, CmId(), WSP(bf16_t, O_WOUT), 1024, (r / 16) * 32, (r % 16) * 64, lane); };
      wt_run(dec, gw, I_WIN + I_BR + I_OUT, NGW, scr, lane); }
    const float* wuq = INP(14) + (size_t)l * 256 * 768; const float* wukv = INP(15) + (size_t)l * 128 * 1024; const float* gq = INP(12) + l * 256; const float* gkv = INP(13) + l * 128; bf16_t* WC = WSP(bf16_t, O_WC);
    for (int i = blockIdx.x * 512 + tid; i < 1792 * 384; i += gridDim.x * 512) {
        const int pp = i / 384, k = i % 384; float v = 0.f;
        if (pp < 768) { const int pn = pp >> 8, q = pp & 255, bj = q >> 7, wc = (q >> 5) & 3, j = q & 31; const int gi = pn * 8 + bj * 4 + wc, head = gi / 3, part = gi - head * 3;
            const int p = part < 2 ? head * 96 + part * 32 + j : head * 96 + 64 + 16 * ((j >> 2) & 1) + 4 * (j >> 3) + (j & 3);
            if (k < 256) v = wuq[k * 768 + p] * gq[k]; }
        else { if (k >= 256) v = wukv[(k - 256) * 1024 + (pp - 768)] * gkv[k - 256]; }
        WC[i] = f2bf(v); }
}
struct CmUp { __device__ __forceinline__ int operator()(int p) const { return ((p >> 8) << 7) + (p & 127); } };
__device__ __forceinline__ void conv_weights_moe(const Frame& F, int l) {
    const int tid = opaque_tid(F.wv0), lane = tid & 63, wave = __builtin_amdgcn_readfirstlane(tid >> 6); (void)lane; (void)wave;
    LAS float* scr = (LAS float*)F.lds + wave * (64 * 33);
    const int gw = blockIdx.x * 8 + wave, NGW = gridDim.x * 8;
    constexpr int I_UP = 32 * 16 * 16, I_DN = 32 * 32 * 4;
    { const float* w1 = INP(20) + (size_t)l * 32 * 1024 * 256; const float* w3 = INP(21) + (size_t)l * 32 * 1024 * 256; const float* w2 = INP(22) + (size_t)l * 32 * 256 * 1024; const Frame* Fp = &F;
      auto dec = [=](int it) -> WtDesc { const Frame& F = *Fp; int r = it;
          if (r < I_UP) { const int e = r / 256, q = r % 256, p0 = (q / 16) * 32, k0 = (q % 16) * 64; const bool isw3 = (p0 >> 7) & 1;
              return wt_desc((isw3 ? w3 : w1) + (size_t)e * 1024 * 256, 256, CmUp(), WSP(bf16_t, O_WUP) + (size_t)e * 512 * 1024, 1024, p0, k0, lane); } r -= I_UP;
          const int e = r / 128, q = r % 128; return wt_desc(w2 + (size_t)e * 256 * 1024, 1024, CmId(), WSP(bf16_t, O_WDN) + (size_t)e * 1024 * 256, 256, (q / 4) * 32, (q % 4) * 64, lane); };
      wt_run(dec, gw, I_UP + I_DN, NGW, scr, lane); }
}

__device__ __forceinline__ void rp_load(const float* xs, float* xd, bool wx, const bf16_t* ym, const float* gt, int lane, f32x4 (&v)[4], float& rinv) {
    float ss = 0.f;
#pragma unroll
    for (int j = 0; j < 4; ++j) { const int c = 4 * lane + 256 * j; v[j] = *(const f32x4*)(xs + c);
        if (ym) { const uint2 y0 = *(const uint2*)(ym + c), y1 = *(const uint2*)(ym + 1024 + c); const f32x4 g4 = *(const f32x4*)(gt + c);
            v[j][0] += g4[0] * (bflo(y0.x) + bflo(y1.x)); v[j][1] += g4[1] * (bfhi(y0.x) + bfhi(y1.x)); v[j][2] += g4[2] * (bflo(y0.y) + bflo(y1.y)); v[j][3] += g4[3] * (bfhi(y0.y) + bfhi(y1.y)); }
        if (wx) *(f32x4*)(xd + c) = v[j];
        ss += v[j][0] * v[j][0] + v[j][1] * v[j][1] + v[j][2] * v[j][2] + v[j][3] * v[j][3]; }
    rinv = rsqrtf(wave_sum_dpp(ss) * (1.f / D) + EPS);
}
__device__ __forceinline__ void rp_mod(const f32x4 (&v)[4], float rinv, const float* gn, const float* mo, int sh_off, int sc_off, bf16_t* hp, int lane, f32x4 (&hv)[4]) {
#pragma unroll
    for (int j = 0; j < 4; ++j) { const int c = 4 * lane + 256 * j; const f32x4 g4 = *(const f32x4*)(gn + c), s4 = *(const f32x4*)(mo + sc_off + c), h4 = *(const f32x4*)(mo + sh_off + c);
        hv[j] = v[j] * rinv * g4 * (s4 + 1.f) + h4;
        *(uint2*)(hp + c) = make_uint2(pkbf(hv[j][0], hv[j][1]), pkbf(hv[j][2], hv[j][3])); }
}
__device__ __forceinline__ void phase_rowpass1(const Frame& F, int l, bool combine, size_t h_off) {
    const int tid = opaque_tid(F.wv0), lane = tid & 63, wave = __builtin_amdgcn_readfirstlane(tid >> 6); (void)lane; (void)wave;
    const int gw = blockIdx.x * 8 + wave, NGW = gridDim.x * 8;
    const float* xl = (l == 0) ? INP(0) : F.out; const float* xc = (l == 0) ? INP(2) : WSP(float, O_XC);
    const float* MODl = WSP(float, O_MOD) + (size_t)l * 5 * 6144; const float* MODp = WSP(float, O_MOD);
    for (int g = gw; g < G; g += NGW) { const RowInfo ri = rowinfo(g); const int mrow = ri.lat ? ri.b : 4; const size_t xo = xoff(ri);
        const float* xs = (ri.lat ? xl : xc) + xo; float* xd = (ri.lat ? F.out : WSP(float, O_XC)) + xo;
        f32x4 v[4], hv[4]; float rinv;
        rp_load(xs, xd, combine, combine ? WSP(bf16_t, O_YM2) + (size_t)g * 2048 : nullptr, MODp + (size_t)mrow * 6144 + 5120, lane, v, rinv);
        rp_mod(v, rinv, INP(6) + l * 1024, MODl + (size_t)mrow * 6144, 0, 1024, WSP(bf16_t, h_off) + (size_t)g * D, lane, hv); }
}
__device__ __forceinline__ void phase_rowpass2(const Frame& F, int l, bool last) {
    const int tid = opaque_tid(F.wv0), lane = tid & 63, wave = __builtin_amdgcn_readfirstlane(tid >> 6);
    { int* perm = WSP(int, O_PERM); unsigned* goff = WSP(unsigned, O_GOFF);
      for (int i = blockIdx.x * 512 + tid; i < PMAX; i += gridDim.x * 512) { perm[i] = -1; goff[i] = 0u; } }
    const int gw = blockIdx.x * 8 + wave, NGW = gridDim.x * 8;
    const float* MODl = WSP(float, O_MOD) + (size_t)l * 5 * 6144;
    for (int g = gw; g < G; g += NGW) { const RowInfo ri = rowinfo(g); if (last && !ri.lat) continue;
        const int mrow = ri.lat ? ri.b : 4; const size_t xo = xoff(ri);
        const float* xs = (ri.lat ? F.out : WSP(float, O_XC)) + xo;
        f32x4 v[4], hv[4]; float rinv;
        rp_load(xs, nullptr, false, nullptr, nullptr, lane, v, rinv);
        rp_mod(v, rinv, INP(7) + l * 1024, MODl + (size_t)mrow * 6144, 3072, 4096, WSP(bf16_t, O_H) + (size_t)g * D, lane, hv); }
}
struct EpiRoute {
    static constexpr bool PERM = false;
    int* route_e; float* route_w; LAS int* hist;
    __device__ __forceinline__ void operator()(const f32x4 (&acc)[2][2][4][2], const gp::GUnit& u, int wr, int wc, int fr, int fq) const {
        if (wc != 0) return;
#pragma unroll
        for (int ai = 0; ai < 2; ++ai)
#pragma unroll
            for (int m = 0; m < 4; ++m) { const int row = u.pm * 256 + ai * 128 + wr * 64 + m * 16 + fr;
                float el[8];
#pragma unroll
                for (int e = 0; e < 4; ++e) { el[e] = acc[ai][0][m][0][e]; el[4 + e] = acc[ai][0][m][1][e]; }
                const float gl = acc[ai][1][m][0][0];
                int i0 = 0; float m0 = el[0];
#pragma unroll
                for (int j = 1; j < 8; ++j) if (el[j] > m0) { m0 = el[j]; i0 = j; }
                int i1 = -1; float m1 = -3.4e38f;
#pragma unroll
                for (int j = 0; j < 8; ++j) if (j != i0 && el[j] > m1) { m1 = el[j]; i1 = j; }
                float gmax = gl; int gidx = fq;
#pragma unroll
                for (int off = 16; off <= 32; off <<= 1) { const float og = shxl(gmax, off, fr | (fq << 4)); const int oi = shxli(gidx, off, fr | (fq << 4)); if (og > gmax || (og == gmax && oi < gidx)) { gmax = og; gidx = oi; } }
                float gs = expf(gl - gmax); gs += shxl(gs, 16, fr | (fq << 4)); gs += shxl(gs, 32, fr | (fq << 4));
                if (fq == gidx) { const float gwt = 1.f / gs, p1 = expf(m1 - m0); const int e0 = fq * 8 + i0, e1 = fq * 8 + i1;
                    route_e[row * 2] = e0; route_e[row * 2 + 1] = e1; route_w[row * 2] = gwt / (1.f + p1); route_w[row * 2 + 1] = gwt * p1 / (1.f + p1);
                    __hip_atomic_fetch_add(hist + e0, 1, __ATOMIC_RELAXED, __HIP_MEMORY_SCOPE_WORKGROUP); __hip_atomic_fetch_add(hist + e1, 1, __ATOMIC_RELAXED, __HIP_MEMORY_SCOPE_WORKGROUP); } }
    }
};
__device__ __forceinline__ void phase_final(const Frame& F) {
    const int tid = opaque_tid(F.wv0), lane = tid & 63, wave = __builtin_amdgcn_readfirstlane(tid >> 6); (void)lane; (void)wave;
    const int gw = blockIdx.x * 8 + wave, NGW = gridDim.x * 8; const float* MOD1 = WSP(float, O_MOD) + (size_t)5 * 6144;
    for (int lr = gw; lr < NB * SEQ; lr += NGW) { const int b = lr / SEQ, t = lr - b * SEQ; const int g = b * RPB + t; float* xp = F.out + (size_t)lr * D;
        f32x4 v[4]; float rinv; rp_load(xp, nullptr, false, WSP(bf16_t, O_YM2) + (size_t)g * 2048, MOD1 + (size_t)b * 6144 + 5120, lane, v, rinv);
#pragma unroll
        for (int j = 0; j < 4; ++j) { const int c = 4 * lane + 256 * j; const f32x4 g4 = *(const f32x4*)(INP(23) + c); *(f32x4*)(xp + c) = v[j] * rinv * g4; } }
}
__device__ __forceinline__ void phase_moe_scatter(const Frame& F, int l, bool last) {
    const int tid = opaque_tid(F.wv0), lane = tid & 63, wave = __builtin_amdgcn_readfirstlane(tid >> 6);
    LAS int* tot = (LAS int*)F.lds; LAS int* bef = tot + 512; LAS int* base = tot + 1024; LAS int* lcur = tot + 1056;
    const int* WGH = WSP(int, O_WGH) + (size_t)l * 256 * 32; const int nwg = gridDim.x, me = blockIdx.x;
    { const int e = tid & 31, part = tid >> 5; int sa = 0, sb = 0;
      for (int w = part * 16; w < part * 16 + 16 && w < nwg; ++w) { const int c = WGH[w * 32 + e]; sa += c; if (w < me) sb += c; }
      tot[part * 32 + e] = sa; bef[part * 32 + e] = sb; }
    __syncthreads();
    int sa2 = 0, sb2 = 0;
    if (tid < 32) {
#pragma unroll
        for (int part = 0; part < 16; ++part) { sa2 += tot[part * 32 + tid]; sb2 += bef[part * 32 + tid]; } }
    __syncthreads();
    if (tid < 32) { tot[tid] = sa2; bef[tid] = sb2; lcur[tid] = 0; }
    __syncthreads();
    if (tid == 0) { int o = 0; int* tile_e = WSP(int, O_TILEE);
#pragma clang loop unroll(disable) vectorize(disable)
        for (int e = 0; e < 32; ++e) { base[e] = o + bef[e]; const int n = (tot[e] + 255) & ~255;
            if (me == 0) {
#pragma clang loop unroll(disable) vectorize(disable)
                for (int t = o >> 8; t < (o + n) >> 8; ++t) tile_e[t] = e; }
            o += n; }
        if (me == 0) tile_e[NTILE] = o >> 8; }
    __syncthreads();
    const int* route_e = WSP(int, O_ROUTE_E); const float* route_w = WSP(float, O_ROUTE_W); int* perm = WSP(int, O_PERM); float* posw = WSP(float, O_POSW); unsigned* goff = WSP(unsigned, O_GOFF);
    { int pmv, pn;
      if (gp::tile_order(0, (int)gridDim.x, (int)blockIdx.x, last ? 128 : 132, 1, pmv, pn)) { const int pm = last ? pmv + pmv / 32 : pmv; const int g = pm * 256 + (tid >> 1); const int i = g * 2 + (tid & 1);
          const int e = route_e[i]; const int pos = base[e] + __hip_atomic_fetch_add(lcur + e, 1, __ATOMIC_RELAXED, __HIP_MEMORY_SCOPE_WORKGROUP);
          perm[pos] = i; posw[pos] = route_w[i]; goff[pos] = (unsigned)g * 2048u; } }
    (void)lane; (void)wave;
}

#ifndef PROBE_DUP
#define PROBE_DUP 0
#endif
#ifndef PROBE_EXTRA_MASK
#define PROBE_EXTRA_MASK 0ull
#endif
#define DUP(bit) for (int rep_ = 0; rep_ < (((PROBE_DUP) >> (bit)) & 1) + 1; ++rep_)
__global__ void __launch_bounds__(512, 2) hybrid_trunk_fwd(KP p) {
    extern __shared__ __attribute__((aligned(16))) unsigned char dynlds[];
    Frame F; F.lds = (LAS char*)dynlds; F.ws = p.ws; F.out = p.out; F.wv0 = __builtin_amdgcn_readfirstlane((int)(threadIdx.x >> 6));
    if (threadIdx.x == 0) { LAS unsigned long long* pp = (LAS unsigned long long*)(F.lds + LDS_PTR_OFF);
        pp[0] = (unsigned long long)p.in[0];
        pp[1] = (unsigned long long)p.in[1];
        pp[2] = (unsigned long long)p.in[2];
        pp[3] = (unsigned long long)p.in[3];
        pp[4] = (unsigned long long)p.in[4];
        pp[5] = (unsigned long long)p.in[5];
        pp[6] = (unsigned long long)p.in[6];
        pp[7] = (unsigned long long)p.in[7];
        pp[8] = (unsigned long long)p.in[8];
        pp[9] = (unsigned long long)p.in[9];
        pp[10] = (unsigned long long)p.in[10];
        pp[11] = (unsigned long long)p.in[11];
        pp[12] = (unsigned long long)p.in[12];
        pp[13] = (unsigned long long)p.in[13];
        pp[14] = (unsigned long long)p.in[14];
        pp[15] = (unsigned long long)p.in[15];
        pp[16] = (unsigned long long)p.in[16];
        pp[17] = (unsigned long long)p.in[17];
        pp[18] = (unsigned long long)p.in[18];
        pp[19] = (unsigned long long)p.in[19];
        pp[20] = (unsigned long long)p.in[20];
        pp[21] = (unsigned long long)p.in[21];
        pp[22] = (unsigned long long)p.in[22];
        pp[23] = (unsigned long long)p.in[23];
    }
    LAS unsigned char* glds = (LAS unsigned char*)dynlds;
    volatile LAS unsigned* barst = (volatile LAS unsigned*)(F.lds + LDS_BAR_OFF);
    if (threadIdx.x < 16) ((LAS unsigned*)(F.lds + LDS_BAR_OFF))[threadIdx.x] = 0u;
    __syncthreads();
    const bool multi = (p.ph_hi - p.ph_lo) > 1;
    XcdBarrier bar; bar.bar = (unsigned*)F.ws; bar.x = 0; bar.st = nullptr;
    if (multi) bar = xcd_barrier_post((unsigned*)F.ws, barst);
    int ph = 0;
#define PH_BEGIN if (ph >= p.ph_lo && ph < p.ph_hi && (p.mask == 0ull || ((p.mask >> ph) & 1ull))) {
#define PH_END   if (ph + 1 < p.ph_hi) xcd_barrier(bar); else __syncthreads(); } ++ph;
    const int Gd = gridDim.x, cb = blockIdx.x;

    PH_BEGIN p0_mod(F); p0_tables(F); __syncthreads(); conv_weights_nonmoe(F, 0); PH_END

    for (int l = 0; l < 2; ++l) {
        const bool last = (l == 1);
        const float* MODl = WSP(float, O_MOD) + (size_t)l * 5 * 6144;
        PH_BEGIN phase_rowpass1(F, l, l > 0, O_H); PH_END
        PH_BEGIN
        { SchedStd S{}; S.A = WSP(bf16_t, O_H); S.Bt = WSP(bf16_t, O_WINP); S.K = 1024; S.nM = 132; S.nN = 15; S.G_ = Gd; S.c = cb; S.skipctx = 0; S.lda2 = 2048; S.ldb2 = 2048;
          EpiG1 E{}; E.AQ = WSP(bf16_t, O_AQ); E.AK = WSP(bf16_t, O_AK); E.AV = WSP(bf16_t, O_AV); E.BQ = WSP(bf16_t, O_BQ); E.BV = WSP(bf16_t, O_BV); E.BG = WSP(bf16_t, O_BG); E.BLF = WSP(f16_t, O_BLF); E.BLB = WSP(f16_t, O_BLB);
          E.CQKV = WSP(bf16_t, O_CQKV); E.CKR = WSP(bf16_t, O_CKR); E.RS = WSP(float, O_RS); E.ropa_c = WSP(float, O_ROPA_C); E.ropa_s = WSP(float, O_ROPA_S); E.ropc_c = WSP(float, O_ROPC_C); E.ropc_s = WSP(float, O_ROPC_S);
          E.LBl = WSP(float, O_LB) + l * 1024; E.rowoff = 0; E.lbzero = (l == 0) ? 1 : 0;
          DUP(0) gp::gemm_phase<EpiG1, SchedStd>(glds, S, E, F.wv0); }
        PH_END
        PH_BEGIN
        { SchedStd S{}; S.A = WSP(bf16_t, O_CQKV); S.Bt = WSP(bf16_t, O_WC); S.K = 384; S.nM = 132; S.nN = 7; S.G_ = Gd; S.c = cb; S.skipctx = 0; S.lda2 = 768; S.ldb2 = 768;
          EpiC E{}; E.CQ = WSP(bf16_t, O_CQ); E.CKV = WSP(bf16_t, O_CKV); E.RS = WSP(float, O_RS); E.ropc_c = WSP(float, O_ROPC_C); E.ropc_s = WSP(float, O_ROPC_S); E.pmoff = 0;
          DUP(1) gp::gemm_phase<EpiC, SchedStd>(glds, S, E, F.wv0); }
        __syncthreads();
        { AttnArgs a{}; a.Q = WSP(bf16_t, O_AQ); a.qld = 512; a.qhs = 64; a.K1 = WSP(bf16_t, O_AK); a.k1ld = 128; a.k1hs = 64; a.kvgroup = 4; a.K2 = nullptr; a.k2ld = 0; a.V = WSP(bf16_t, O_AV); a.vld = 128; a.vhs = 64;
          a.O = WSP(bf16_t, O_AQ); a.old = 512; a.ohs = 64; a.scale_l2 = 0.125f * LOG2E; a.sink = INP(9) + l * 8; a.window = 128;
          const int nqb = last ? 32 : 33;
          DUP(10) for (int u = cb; u < NB * 8 * nqb; u += Gd) { int b, h, qb; if (u < NB * 8 * 32) { b = u >> 8; h = u & 7; qb = (u >> 3) & 31; }     else { const int r_ = u - NB * 8 * 32; b = r_ >> 3; h = r_ & 7; qb = 32; }
              attn_unit<64>(F.lds, a, F.wv0, b, qb, h, ((PROBE_DUP >> 10) & 1) && rep_ == 0); } }
        __syncthreads();
        { ScanArgs a{}; a.BQ = WSP(bf16_t, O_BQ); a.BV = WSP(bf16_t, O_BV); a.BG = WSP(bf16_t, O_BG); a.BLF = WSP(f16_t, O_BLF); a.BLB = WSP(f16_t, O_BLB); a.ST = WSP(bf16_t, O_H); a.DS = WSP(float, O_DS); a.OB = WSP(bf16_t, O_BQ); a.gn = INP(11) + l * 512;
          DUP(2) { const int tid_ = opaque_tid(F.wv0);
            if (cb < NB * 8 * NCHK) { const int b = cb / (8 * NCHK), rem = cb - b * 8 * NCHK, h = rem / NCHK, k = rem - h * NCHK; __syncthreads(); scan_stage(F.lds, a, (size_t)b * RPB + 64 * k - a.in_off, h, tid_); }
            for (int u = cb; u < NB * 8 * NCHK; u += Gd) { const int b = u / (8 * NCHK), rem = u - b * 8 * NCHK, h = rem / NCHK, k = rem - h * NCHK;
                const int un = u + Gd; const bool hn = un < NB * 8 * NCHK; const int nb_ = un / (8 * NCHK), nrem = un - nb_ * 8 * NCHK, nh_ = nrem / NCHK, nk_ = nrem - nh_ * NCHK;
                scan_s1_unit(F.lds, a, F.wv0, b, h, k, hn, nb_, nh_, nk_); } } }
        PH_END
        PH_BEGIN
        { ScanArgs a{}; a.ST = WSP(bf16_t, O_H); a.DS = WSP(float, O_DS);
          for (int t = cb; t < NB * 8 * 2 * 4; t += Gd) scan_s2_task(a, F.wv0, t); }
        { AttnArgs a{}; a.Q = WSP(bf16_t, O_CQ); a.qld = 768; a.qhs = 96; a.K1 = WSP(bf16_t, O_CKV); a.k1ld = 1024; a.k1hs = 128; a.kvgroup = 1; a.K2 = WSP(bf16_t, O_CKR); a.k2ld = 32; a.V = WSP(bf16_t, O_CKV) + 64; a.vld = 1024; a.vhs = 128;
          a.O = WSP(bf16_t, O_OC); a.old = 512; a.ohs = 64; a.scale_l2 = 0.10206207261596577f * LOG2E; a.sink = nullptr; a.window = 0; a.pad = (PROBE_VARIANT && p.mask != 0ull) ? 1 : 0;
          const int nqb = last ? 32 : 33;
          DUP(3) for (int u = cb; u < NB * 8 * nqb; u += Gd) { int b, h, qb; if (u < NB * 8 * 32) { b = u >> 8; h = u & 7; qb = (u >> 3) & 31; }     else { const int r_ = u - NB * 8 * 32; b = r_ >> 3; h = r_ & 7; qb = 32; }
              if (PROBE_VARIANT >= 6 && p.mask != 0ull) attn_unit<96, PROBE_VARIANT>(F.lds, a, F.wv0, b, qb, h); else attn_unit<96>(F.lds, a, F.wv0, b, qb, h); } }
        PH_END
        PH_BEGIN
        { ScanArgs a{}; a.BQ = WSP(bf16_t, O_BQ); a.BV = WSP(bf16_t, O_BV); a.BG = WSP(bf16_t, O_BG); a.BLF = WSP(f16_t, O_BLF); a.BLB = WSP(f16_t, O_BLB); a.ST = WSP(bf16_t, O_H); a.DS = WSP(float, O_DS); a.OB = WSP(bf16_t, O_BQ); a.gn = INP(11) + l * 512; a.skipctx_out = last ? 1 : 0;
          DUP(9) { a.pad = (((PROBE_DUP >> 9) & 1) && rep_ == 0) ? 1 : 0; const int tid_ = opaque_tid(F.wv0);
            if (cb < NB * 8 * NCHK) { const int b = cb / (8 * NCHK), rem = cb - b * 8 * NCHK, h = rem / NCHK, k = rem - h * NCHK; u32x4 t0, t1; __syncthreads(); scan_stage(F.lds, a, (size_t)b * RPB + 64 * k - a.in_off, h, tid_); s3_state_load(a, b, h, k, tid_, t0, t1); s3_state_store((LAS bf16_t*)(F.lds + SC_A), tid_, t0, t1); }
            for (int u = cb; u < NB * 8 * NCHK; u += Gd) { const int b = u / (8 * NCHK), rem = u - b * 8 * NCHK, h = rem / NCHK, k = rem - h * NCHK;
                const int un = u + Gd; const bool hn = un < NB * 8 * NCHK; const int nb_ = un / (8 * NCHK), nrem = un - nb_ * 8 * NCHK, nh_ = nrem / NCHK, nk_ = nrem - nh_ * NCHK;
                scan_s3_unit(F.lds, a, F.wv0, b, h, k, hn, nb_, nh_, nk_); } } }
        phase_rowpass1(F, l, false, O_CKV);
        PH_END
        PH_BEGIN
        { SchedGM S{}; S.A0 = WSP(bf16_t, O_AQ); S.A1 = WSP(bf16_t, O_BQ); S.A2 = WSP(bf16_t, O_OC); S.Ag = WSP(bf16_t, O_CKV); S.Bbr = WSP(bf16_t, O_WBR); S.Bg = WSP(bf16_t, O_WINP) + (size_t)3840 * 1024;
          S.nM = last ? 128 : 132; S.G_ = Gd; S.c = cb; S.skipctx = last ? 1 : 0; S.lda2 = 1024; S.ldb2 = 1024;
          EpiGM E{}; E.U = WSP(bf16_t, O_GATE); E.nstride = (long)G * 1024; E.ld = 1024;
          gp::gemm_phase<EpiGM, SchedGM>(glds, S, E, F.wv0); }
        PH_END
        PH_BEGIN
        { const int tid_ = opaque_tid(F.wv0), lane_ = tid_ & 63, wave_ = __builtin_amdgcn_readfirstlane(tid_ >> 6); const bf16_t* U = WSP(bf16_t, O_GATE); bf16_t* Y = WSP(bf16_t, O_H);
          for (int g = cb * 8 + wave_; g < G; g += Gd * 8) { if (last && (g % RPB) >= SEQ) continue;
#pragma unroll
              for (int j = 0; j < 2; ++j) { const size_t o = (size_t)g * 1024 + 8 * lane_ + 512 * j;
                  const u32x4 a = *(const u32x4*)(U + o), b2 = *(const u32x4*)(U + (size_t)G * 1024 + o), c2 = *(const u32x4*)(U + (size_t)2 * G * 1024 + o);
                  u32x4 w; w.x = pkbf(bflo(a.x) + bflo(b2.x) + bflo(c2.x), bfhi(a.x) + bfhi(b2.x) + bfhi(c2.x)); w.y = pkbf(bflo(a.y) + bflo(b2.y) + bflo(c2.y), bfhi(a.y) + bfhi(b2.y) + bfhi(c2.y));
                  w.z = pkbf(bflo(a.z) + bflo(b2.z) + bflo(c2.z), bfhi(a.z) + bfhi(b2.z) + bfhi(c2.z)); w.w = pkbf(bflo(a.w) + bflo(b2.w) + bflo(c2.w), bfhi(a.w) + bfhi(b2.w) + bfhi(c2.w));
                  *(u32x4*)(Y + o) = w; } } }
        PH_END
        PH_BEGIN
        { SchedStd S{}; S.A = WSP(bf16_t, O_H); S.Bt = WSP(bf16_t, O_WOUT); S.K = 1024; S.nM = last ? 128 : 132; S.nN = 4; S.G_ = Gd; S.c = cb; S.skipctx = last ? 1 : 0; S.lda2 = 2048; S.ldb2 = 2048;
          EpiOut E{}; E.xl_src = l == 0 ? INP(0) : F.out; E.xc_src = l == 0 ? INP(2) : WSP(float, O_XC); E.xl_dst = F.out; E.xc_dst = WSP(float, O_XC); E.mod = MODl; E.pmoff = 0;
          gp::gemm_phase<EpiOut, SchedStd>(glds, S, E, F.wv0); }
        PH_END
        PH_BEGIN phase_rowpass2(F, l, last); PH_END
        PH_BEGIN
        { LAS int* hist = (LAS int*)(F.lds + 131072); const int t_ = opaque_tid(F.wv0);
          if (t_ < 32) hist[t_] = 0;
          __syncthreads();
          SchedStd S{}; S.A = WSP(bf16_t, O_H); S.Bt = WSP(bf16_t, O_WRB) + (size_t)l * 256 * 1024; S.K = 1024; S.nM = last ? 128 : 132; S.nN = 1; S.G_ = Gd; S.c = cb; S.skipctx = last ? 1 : 0; S.lda2 = 2048; S.ldb2 = 2048;
          EpiRoute E{}; E.route_e = WSP(int, O_ROUTE_E); E.route_w = WSP(float, O_ROUTE_W); E.hist = hist;
          gp::gemm_phase<EpiRoute, SchedStd>(glds, S, E, F.wv0);
          __syncthreads();
          { const int t2_ = opaque_tid(F.wv0); if (t2_ < 32) WSP(int, O_WGH)[((size_t)l * 256 + cb) * 32 + t2_] = hist[t2_]; }
          __syncthreads(); }
        conv_weights_moe(F, l); if (!last) conv_weights_nonmoe(F, l + 1);
        PH_END
        PH_BEGIN phase_moe_scatter(F, l, last); PH_END
        PH_BEGIN
        { SchedMoE<true> S{}; S.A = WSP(bf16_t, O_H); S.Bt = WSP(bf16_t, O_WUP); S.tile_e = WSP(int, O_TILEE); S.goff = WSP(unsigned, O_GOFF); S.K = 1024; S.nM = WSP(int, O_TILEE)[NTILE]; S.nN = 2; S.G_ = Gd; S.c = cb; S.lda2 = 2048; S.ldb2 = 2048; S.strideB = 512 * 1024;
          EpiUp E{}; E.AUP = WSP(bf16_t, O_AUP);
          DUP(7) gp::gemm_phase<EpiUp, SchedMoE<true>>(glds, S, E, F.wv0); }
        PH_END
        PH_BEGIN
        { SchedMoE<false> S{}; S.A = WSP(bf16_t, O_AUP); S.Bt = WSP(bf16_t, O_WDN); S.tile_e = WSP(int, O_TILEE); S.goff = nullptr; S.K = 256; S.nM = WSP(int, O_TILEE)[NTILE]; S.nN = 4; S.G_ = Gd; S.c = cb; S.lda2 = 512; S.ldb2 = 512; S.strideB = 1024 * 256;
          EpiDown E{}; E.YM2 = WSP(bf16_t, O_YM2); E.perm = WSP(int, O_PERM); E.posw = WSP(float, O_POSW);
          DUP(8) gp::gemm_phase<EpiDown, SchedMoE<false>>(glds, S, E, F.wv0); }
        PH_END
    }
    PH_BEGIN phase_final(F); PH_END
#undef PH_BEGIN
#undef PH_END
}
constexpr int N_PHASES = 1 + 2 * 13 + 1;
}

#ifndef MK_N_LAUNCHES
#define MK_N_LAUNCHES 1
#endif
extern "C" void kernel_launch(void* const* d_in, const int* in_sizes, int n_in, void* d_out, int out_size, void* d_ws, size_t ws_size, hipStream_t stream) {
    static int grid = 0;
    if (grid == 0) {
        if (ws_size < WS_END) { grid = -1; return; }
        int dev = 0, cus = 0;
        if (hipGetDevice(&dev) != hipSuccess || hipDeviceGetAttribute(&cus, hipDeviceAttributeMultiprocessorCount, dev) != hipSuccess) { grid = -1; return; }
        if (hipFuncSetAttribute((const void*)hybrid_trunk_fwd, hipFuncAttributeMaxDynamicSharedMemorySize, LDS_BYTES) != hipSuccess) { grid = -1; return; }
        int per_cu = 0; (void)hipOccupancyMaxActiveBlocksPerMultiprocessor(&per_cu, (const void*)hybrid_trunk_fwd, 512, LDS_BYTES); (void)hipGetLastError();
        grid = cus;
    }
    if (grid < 0) return;
    (void)hipMemsetAsync(d_ws, 0, CTL_ZERO_BYTES, stream);
    KP p{}; for (int i = 0; i < 24; ++i) p.in[i] = (const float*)d_in[i]; p.out = (float*)d_out; p.ws = (char*)d_ws;
    (void)in_sizes; (void)n_in; (void)out_size;
    if (MK_N_LAUNCHES == 1) { p.ph_lo = 0; p.ph_hi = N_PHASES; hipLaunchKernelGGL(hybrid_trunk_fwd, dim3(grid), dim3(512), LDS_BYTES, stream, p);
        if (PROBE_EXTRA_MASK) { (void)hipMemsetAsync(d_ws, 0, CTL_ZERO_BYTES, stream); p.mask = PROBE_EXTRA_MASK; hipLaunchKernelGGL(hybrid_trunk_fwd, dim3(grid), dim3(512), LDS_BYTES, stream, p); } }
    else { for (int k = 0; k < N_PHASES; ++k) { p.ph_lo = k; p.ph_hi = k + 1; hipLaunchKernelGGL(hybrid_trunk_fwd, dim3(grid), dim3(512), LDS_BYTES, stream, p); } }
}
```

```cpp
#include <hip/hip_runtime.h>
#include <stdint.h>
#include <math.h>

namespace {
typedef unsigned short bf16_t;
typedef _Float16 f16_t;
typedef short bf16x8 __attribute__((ext_vector_type(8)));
typedef short s16x4 __attribute__((ext_vector_type(4)));
typedef float f32x4 __attribute__((ext_vector_type(4)));
typedef float f32x16 __attribute__((ext_vector_type(16)));
typedef unsigned u32x4 __attribute__((ext_vector_type(4)));
#define LAS __attribute__((address_space(3)))

constexpr int D = 1024, NB = 4, SEQ = 8192, CTXL = 256, RPB = SEQ + CTXL, G = NB * RPB;
constexpr int INW = 6816, MIXW = 3744, GATEW = 3072;
constexpr float EPS = 1e-6f;
constexpr float LOG2E = 1.4426950408889634f;
constexpr int PMAX = 75776;
constexpr int NTILE = PMAX / 256;

__device__ __forceinline__ float bf2f(bf16_t v) { return __uint_as_float(((unsigned)v) << 16); }
__device__ __forceinline__ bf16_t f2bf(float f) { unsigned u = __float_as_uint(f); u += 0x7fffu + ((u >> 16) & 1u); return (bf16_t)(u >> 16); }
typedef float f32x2v __attribute__((ext_vector_type(2)));
typedef __bf16 bf16x2v __attribute__((ext_vector_type(2)));
__device__ __forceinline__ unsigned pkbf(float lo, float hi) { const f32x2v v = {lo, hi}; const bf16x2v b = __builtin_convertvector(v, bf16x2v); return __builtin_bit_cast(unsigned, b); }
__device__ __forceinline__ unsigned pk2(float lo, float hi) { return (unsigned)f2bf(lo) | ((unsigned)f2bf(hi) << 16); }
__device__ __forceinline__ float silu_f(float v) { return v / (1.f + expf(-v)); }
__device__ __forceinline__ float sigmoid_f(float v) { return 1.f / (1.f + expf(-v)); }
__device__ __forceinline__ int opaque_tid(int wv) { unsigned z; asm volatile("s_mov_b32 %0, 0" : "=s"(z));
    int t = (wv << 6) | (int)__builtin_amdgcn_mbcnt_hi(~0u, __builtin_amdgcn_mbcnt_lo(~0u, z)); asm volatile("" : "+v"(t)); return t; }
__device__ __forceinline__ float shxl(float v, int k, int lane) { return __builtin_bit_cast(float, __builtin_amdgcn_ds_bpermute((lane ^ k) << 2, __builtin_bit_cast(int, v))); }
__device__ __forceinline__ int shxli(int v, int k, int lane) { return __builtin_amdgcn_ds_bpermute((lane ^ k) << 2, v); }
struct RowInfo { int b, r; bool lat; };
__device__ __forceinline__ RowInfo rowinfo(int g) { RowInfo ri; ri.b = g / RPB; ri.r = g - ri.b * RPB; ri.lat = ri.r < SEQ; return ri; }
__device__ __forceinline__ size_t xoff(const RowInfo& ri) { return ri.lat ? ((size_t)ri.b * SEQ + ri.r) * D : ((size_t)ri.b * CTXL + (ri.r - SEQ)) * D; }
__device__ __forceinline__ int crow(int r, int hi) { return (r & 3) + 8 * (r >> 2) + 4 * hi; }
__device__ __forceinline__ unsigned cvtpk(float lo, float hi) { return pkbf(lo, hi); }
typedef short v4i16_t __attribute__((ext_vector_type(4)));
__device__ __forceinline__ s16x4 vtr(const LAS char* p) { return __builtin_bit_cast(s16x4, __builtin_amdgcn_ds_read_tr16_b64_v4i16((LAS v4i16_t*)p)); }
#define MFMA32(a, b, c) __builtin_amdgcn_mfma_f32_32x32x16_bf16(a, b, c, 0, 0, 0)
#ifndef PROBE_VARIANT
#define PROBE_VARIANT 0
#endif
#if PROBE_VARIANT == 4
#define VTR_ASM(dst, addr, off) do { if (!p.pad) asm volatile("ds_read_b64_tr_b16 %0, %1 offset:" #off : "=v"(dst) : "v"(addr)); else asm volatile("" : "=v"(dst)); } while (0)
#else
#define VTR_ASM(dst, addr, off) asm volatile("ds_read_b64_tr_b16 %0, %1 offset:" #off : "=v"(dst) : "v"(addr))
#endif
struct AttnArgs { const bf16_t* Q; int qld, qhs; const bf16_t* K1; int k1ld, k1hs, kvgroup; const bf16_t* K2; int k2ld; const bf16_t* V; int vld, vhs;
                  bf16_t* O; int old, ohs; float scale_l2; const float* sink; int window; int pad; };
template <int DQK, int VAR = 0>
__device__ __forceinline__ void attn_unit(LAS char* lds, const AttnArgs& p, int wv0, int b, int qb, int h, bool nostore = false) {
    constexpr int NS = DQK / 16, NCH = DQK / 8; constexpr float THR = 8.f;
    constexpr int KB = 0, VB = 49152, WSF = 81920;
    const int tid = opaque_tid(wv0), lane = tid & 63, r32 = lane & 31, hi = lane >> 5, wid = tid >> 6;
    const int rb = b * RPB;
    const bool ctxq = (qb == 32);
    const int q0 = rb + (ctxq ? SEQ : qb * 256);
    int lat_k0 = 0, lat_k1 = 0;
    if (!ctxq) { if (p.window) { lat_k0 = qb * 256 - 128; if (lat_k0 < 0) lat_k0 = 0; lat_k1 = qb * 256 + 384; if (lat_k1 > SEQ) lat_k1 = SEQ; } else { lat_k0 = 0; lat_k1 = SEQ; } }
    const int ntiles = 4 + (lat_k1 - lat_k0) / 64;
    const int qrow = q0 + wid * 32 + r32;
    const int qpos = qb * 256 + wid * 32 + r32;
    const int wq0 = qb * 256 + wid * 32;
    LAS float* wsf = (LAS float*)(lds + WSF) + wid * 64;
    bf16x8 qr[NS];
#pragma unroll
    for (int s = 0; s < NS; ++s) qr[s] = *(const bf16x8*)(p.Q + (size_t)qrow * p.qld + h * p.qhs + 16 * s + 8 * hi);
    const int k1off = (h / p.kvgroup) * p.k1hs, voff = (h / p.kvgroup) * p.vhs;
    const int wv = __builtin_amdgcn_readfirstlane(wid);
    const bool k2nd = (NCH > 8) && (wv < NCH - 8);
    const size_t ksrc0 = (size_t)lane * p.k1ld + k1off + wv * 8, ksrc1 = (size_t)lane * p.k2ld + wv * 8;
    const size_t vsrc = (size_t)(16 * (wv & 3) + (lane >> 2)) * p.vld + voff + (wv >> 2) * 32 + (lane & 3) * 8;
#define AT_ROW0(it_) (rb + ((it_) >= 4 ? lat_k0 + 64 * ((it_) - 4) : SEQ + 64 * (it_)))
#define AT_DMAK(it_, slot_) do { if constexpr (VAR == 8) break; const size_t kr0_ = (size_t)AT_ROW0(it_); \
        __builtin_amdgcn_global_load_lds((const unsigned*)(p.K1 + kr0_ * p.k1ld + ksrc0), (LAS unsigned*)(lds + KB + (slot_) * 12288 + wv * 1024), 16, 0, 0); \
        if (k2nd) __builtin_amdgcn_global_load_lds((const unsigned*)(p.K2 + kr0_ * p.k2ld + ksrc1), (LAS unsigned*)(lds + KB + (slot_) * 12288 + (8 + wv) * 1024), 16, 0, 0); } while (0)
#define AT_DMAV(it_, slot_) do { if constexpr (VAR == 8) break; const size_t kr0_ = (size_t)AT_ROW0(it_); \
        __builtin_amdgcn_global_load_lds((const unsigned*)(p.V + kr0_ * p.vld + vsrc), (LAS unsigned*)(lds + VB + (slot_) * 8192 + wv * 1024), 16, 0, 0); } while (0)
#define AT_CLAMP(x_) ((x_) < ntiles ? (x_) : ntiles - 1)
#define AT_WAITBAR() do { if (k2nd) asm volatile("s_waitcnt vmcnt(6) lgkmcnt(0)" ::: "memory"); else asm volatile("s_waitcnt vmcnt(4) lgkmcnt(0)" ::: "memory"); if constexpr (VAR != 7) __builtin_amdgcn_s_barrier(); asm volatile("" ::: "memory"); } while (0)
#define AT_QK(C0, C1, slot_) do { const LAS char* ldsK_ = lds + KB + (slot_) * 12288 + hi * 1024 + r32 * 16; C0 = negm; C1 = negm; bf16x8 kf_[2 * NS]; \
        _Pragma("unroll") for (int s = 0; s < NS; ++s) { kf_[2 * s] = *(const LAS bf16x8*)(ldsK_ + s * 2048); kf_[2 * s + 1] = *(const LAS bf16x8*)(ldsK_ + s * 2048 + 512); } \
        __builtin_amdgcn_sched_group_barrier(0x100, 2 * NS, 0); \
        _Pragma("unroll") for (int s = 0; s < NS; ++s) { C0 = MFMA32(kf_[2 * s], qr[s], C0); C1 = MFMA32(kf_[2 * s + 1], qr[s], C1); } } while (0)
#define AT_REF(C0, C1, T_, first) do { const int tr_ = (T_); \
        if (p.window && tr_ >= 4) { const int kpos0 = lat_k0 + 64 * (tr_ - 4), wq0s_ = qb * 256 + wv * 32;        \
            const bool full_ = (kpos0 >= wq0s_ + 31 - p.window) && (kpos0 + 63 <= wq0s_ + p.window), dead_ = (kpos0 + 63 < wq0s_ - p.window) || (kpos0 > wq0s_ + 31 + p.window); \
            if (dead_) { _Pragma("unroll") for (int r = 0; r < 16; ++r) { C0[r] = -1e30f; C1[r] = -1e30f; } } \
            else if (!full_) { const unsigned tb_ = (unsigned)(kpos0 + 4 * hi - qpos + p.window), w2_ = 2u * (unsigned)p.window;         \
                _Pragma("unroll") for (int r = 0; r < 16; ++r) { const unsigned t0_ = tb_ + (unsigned)((r & 3) + 8 * (r >> 2)); if (t0_ > w2_) C0[r] = -1e30f; if (t0_ + 32u > w2_) C1[r] = -1e30f; } } } \
        if ((first) || (tr_ & 7) == 0) { \
        float mx = fmaxf(fmaxf(C0[0], C0[1]), C1[0]); \
        _Pragma("unroll") for (int r = 2; r < 16; r += 2) mx = fmaxf(fmaxf(mx, C0[r]), C0[r + 1]); \
        _Pragma("unroll") for (int r = 1; r < 15; r += 2) mx = fmaxf(fmaxf(mx, C1[r]), C1[r + 1]); \
        mx = fmaxf(mx, C1[15]); mx = fmaxf(mx, shxl(mx, 32, lane)); \
        if ((first) || __any(mx > THR)) { const float dl = (first) ? mx : fmaxf(mx, 0.f); \
            m += dl; const float alpha = __builtin_amdgcn_exp2f(-dl); l *= alpha; \
            _Pragma("unroll") for (int r = 0; r < 16; ++r) { C0[r] -= dl; C1[r] -= dl; negm[r] = -m; } \
            if (hi == 0) wsf[r32] = alpha; \
            _Pragma("unroll") for (int r = 0; r < 16; ++r) { const float f = wsf[crow(r, hi)]; o0[r] *= f; o1[r] *= f; } } } } while (0)
    f32x16 o0, o1, negm, cA0, cA1, cB0, cB1;
#pragma unroll
    for (int r = 0; r < 16; ++r) { o0[r] = 0.f; o1[r] = 0.f; negm[r] = 0.f; }
    float m = 0.f, l = 0.f;
    const int vlane = ((lane >> 4) & 1) * 32 + (lane & 3) * 8 + (4 * hi + ((lane & 15) >> 2)) * 64;
    asm volatile("s_waitcnt vmcnt(0) lgkmcnt(0)" ::: "memory"); __builtin_amdgcn_s_barrier(); asm volatile("" ::: "memory");
    AT_DMAK(0, 0); AT_DMAV(0, 0); AT_DMAK(AT_CLAMP(1), 1); AT_DMAV(AT_CLAMP(1), 1); AT_DMAK(AT_CLAMP(2), 2); AT_DMAV(AT_CLAMP(2), 2); AT_DMAK(AT_CLAMP(3), 3);
    asm volatile("s_waitcnt vmcnt(0)" ::: "memory"); __builtin_amdgcn_s_barrier(); asm volatile("" ::: "memory");
    AT_QK(cA0, cA1, 0);
    AT_REF(cA0, cA1, 0, true);
    asm volatile("s_waitcnt lgkmcnt(0)" ::: "memory"); __builtin_amdgcn_s_barrier(); asm volatile("" ::: "memory");
#define AT_SB() __builtin_amdgcn_sched_barrier(0)
#define AT_PIN2(x, y) asm volatile("" : "+v"(x), "+v"(y))
#define AT_PIN1(x) asm volatile("" : "+v"(x))
#define AT_ADD4(a, b, c, d) asm volatile("v_add_f32 %0, %0, %4\n\tv_add_f32 %1, %1, %5\n\tv_add_f32 %2, %2, %6\n\tv_add_f32 %3, %3, %7" : "+v"(r0_), "+v"(r1_), "+v"(r2_), "+v"(r3_) : "v"(a), "v"(b), "v"(c), "v"(d))
#define AT_PINRS() asm volatile("" : "+v"(ra_), "+v"(rb_))
#define AT_LDK(dst, addr_, off) asm volatile("ds_read_b128 %0, %1 offset:" #off : "=v"(dst) : "v"(addr_))
#define AT_WAITK(n, a, b) asm volatile("s_waitcnt lgkmcnt(" #n ")" : "+v"(a), "+v"(b))
#define AT_WAITV8(n, a, b, c, d, e, f, g, h) asm volatile("s_waitcnt lgkmcnt(" #n ")" : "+v"(a), "+v"(b), "+v"(c), "+v"(d), "+v"(e), "+v"(f), "+v"(g), "+v"(h))
#define AT_WAITV4(n, a, b, c, d) asm volatile("s_waitcnt lgkmcnt(" #n ")" : "+v"(a), "+v"(b), "+v"(c), "+v"(d))
#define AT_EXP(X) do { if constexpr (VAR != 6) X = __builtin_amdgcn_exp2f(X); } while (0)
#define AT_STEP(C0, C1, N0, N1, T_) do { const int t_ = (T_); const int t1_ = t_ + 1 < ntiles ? t_ + 1 : ntiles - 1; \
        AT_DMAK(AT_CLAMP(t_ + 4), t_ & 3); AT_DMAV(AT_CLAMP(t_ + 3), (t_ + 3) & 3); \
        const unsigned kaddr_ = (unsigned)(size_t)(lds + KB + ((t_ + 1) & 3) * 12288 + hi * 1024 + r32 * 16); const unsigned vaddr_ = (unsigned)(size_t)(lds + VB + (t_ & 3) * 8192 + vlane); \
        bf16x8 kfa0, kfa1, kfb0, kfb1, kfc0, kfc1; bf16x8 vf_[8]; s16x4 ta_[16]; float r0_ = 0.f, r1_ = 0.f, r2_ = 0.f, r3_ = 0.f; u32x4 pw[4]; \
        bool skipc_ = false; if constexpr (NS == 4) { if (p.window && t_ >= 4) {        \
            const int wq0s_ = qb * 256 + wv * 32, ka_ = lat_k0 + 64 * (t_ - 4), kb_ = ka_ + 64; \
            const bool da_ = (ka_ + 63 < wq0s_ - p.window) || (ka_ > wq0s_ + 31 + p.window), db_ = (t_ + 1 >= ntiles) || (kb_ + 63 < wq0s_ - p.window) || (kb_ > wq0s_ + 31 + p.window); skipc_ = da_ && db_; } } \
        if (!skipc_) { \
        AT_LDK(kfa0, kaddr_, 0); AT_LDK(kfa1, kaddr_, 512); AT_LDK(kfb0, kaddr_, 2048); AT_LDK(kfb1, kaddr_, 2560); AT_SB(); \
        if constexpr (NS == 6) { \
          AT_LDK(kfc0, kaddr_, 4096); AT_LDK(kfc1, kaddr_, 4608); AT_WAITK(4, kfa0, kfa1); N0 = MFMA32(kfa0, qr[0], negm); AT_PIN1(N0); AT_EXP(C0[0]); AT_EXP(C0[1]); AT_EXP(C0[2]);  VTR_ASM(ta_[0], vaddr_, 0); AT_SB(); \
          N1 = MFMA32(kfa1, qr[0], negm); AT_PIN1(N1); AT_EXP(C0[3]); AT_EXP(C0[4]); AT_EXP(C0[5]);  VTR_ASM(ta_[1], vaddr_, 512); VTR_ASM(ta_[2], vaddr_, 4096); AT_SB(); \
          AT_LDK(kfa0, kaddr_, 6144); AT_LDK(kfa1, kaddr_, 6656); AT_WAITK(7, kfb0, kfb1); N0 = MFMA32(kfb0, qr[1], N0); AT_PIN1(N0); AT_EXP(C0[6]); AT_EXP(C0[7]); AT_EXP(C0[8]); VTR_ASM(ta_[3], vaddr_, 4608); AT_SB(); \
          N1 = MFMA32(kfb1, qr[1], N1); AT_PIN1(N1); AT_EXP(C0[9]); AT_EXP(C0[10]); AT_EXP(C0[11]); VTR_ASM(ta_[4], vaddr_, 1024); VTR_ASM(ta_[5], vaddr_, 1536); AT_SB(); \
          AT_LDK(kfb0, kaddr_, 8192); AT_LDK(kfb1, kaddr_, 8704); AT_WAITK(10, kfc0, kfc1); N0 = MFMA32(kfc0, qr[2], N0); AT_PIN1(N0); AT_EXP(C0[12]); AT_EXP(C0[13]); AT_EXP(C0[14]); VTR_ASM(ta_[6], vaddr_, 5120); AT_SB(); \
          N1 = MFMA32(kfc1, qr[2], N1); AT_PIN1(N1); AT_EXP(C0[15]); AT_EXP(C1[0]); AT_EXP(C1[1]); VTR_ASM(ta_[7], vaddr_, 5632); VTR_ASM(ta_[8], vaddr_, 2048); AT_SB(); \
          AT_LDK(kfc0, kaddr_, 10240); AT_LDK(kfc1, kaddr_, 10752); AT_WAITK(10, kfa0, kfa1); N0 = MFMA32(kfa0, qr[3], N0); AT_PIN1(N0); AT_EXP(C1[2]); AT_EXP(C1[3]); AT_EXP(C1[4]); VTR_ASM(ta_[9], vaddr_, 2560); AT_SB(); \
          N1 = MFMA32(kfa1, qr[3], N1); AT_PIN1(N1); AT_EXP(C1[5]); AT_EXP(C1[6]); AT_EXP(C1[7]); VTR_ASM(ta_[10], vaddr_, 6144); VTR_ASM(ta_[11], vaddr_, 6656); AT_SB(); \
           AT_WAITK(8, kfb0, kfb1); N0 = MFMA32(kfb0, qr[4], N0); AT_PIN1(N0); AT_EXP(C1[8]); AT_EXP(C1[9]); VTR_ASM(ta_[12], vaddr_, 3072); AT_SB(); \
          N1 = MFMA32(kfb1, qr[4], N1); AT_PIN1(N1); AT_EXP(C1[10]); AT_EXP(C1[11]); VTR_ASM(ta_[13], vaddr_, 3584); AT_SB(); \
           AT_WAITK(5, kfc0, kfc1); N0 = MFMA32(kfc0, qr[5], N0); AT_PIN1(N0); AT_EXP(C1[12]); AT_EXP(C1[13]); VTR_ASM(ta_[14], vaddr_, 7168); AT_SB(); \
          N1 = MFMA32(kfc1, qr[5], N1); AT_PIN1(N1); AT_EXP(C1[14]); AT_EXP(C1[15]); VTR_ASM(ta_[15], vaddr_, 7680); AT_SB(); \
          \
        } \
        if constexpr (NS == 4) { \
          AT_LDK(kfc0, kaddr_, 4096); AT_LDK(kfc1, kaddr_, 4608); AT_WAITK(4, kfa0, kfa1); N0 = MFMA32(kfa0, qr[0], negm); AT_PIN1(N0); AT_EXP(C0[0]); AT_EXP(C0[1]); AT_EXP(C0[2]); AT_EXP(C0[3]);  VTR_ASM(ta_[0], vaddr_, 0); AT_SB(); \
          N1 = MFMA32(kfa1, qr[0], negm); AT_PIN1(N1); AT_EXP(C0[4]); AT_EXP(C0[5]); AT_EXP(C0[6]); AT_EXP(C0[7]);  VTR_ASM(ta_[1], vaddr_, 512); VTR_ASM(ta_[2], vaddr_, 4096); VTR_ASM(ta_[3], vaddr_, 4608); AT_SB(); \
          AT_LDK(kfa0, kaddr_, 6144); AT_LDK(kfa1, kaddr_, 6656); AT_WAITK(8, kfb0, kfb1); N0 = MFMA32(kfb0, qr[1], N0); AT_PIN1(N0); AT_EXP(C0[8]); AT_EXP(C0[9]); AT_EXP(C0[10]); AT_EXP(C0[11]); VTR_ASM(ta_[4], vaddr_, 1024); AT_SB(); \
          N1 = MFMA32(kfb1, qr[1], N1); AT_PIN1(N1); AT_EXP(C0[12]); AT_EXP(C0[13]); AT_EXP(C0[14]); AT_EXP(C0[15]); VTR_ASM(ta_[5], vaddr_, 1536); VTR_ASM(ta_[6], vaddr_, 5120); VTR_ASM(ta_[7], vaddr_, 5632); AT_SB(); \
           AT_WAITK(10, kfc0, kfc1); N0 = MFMA32(kfc0, qr[2], N0); AT_PIN1(N0); AT_EXP(C1[0]); AT_EXP(C1[1]); AT_EXP(C1[2]); AT_EXP(C1[3]); VTR_ASM(ta_[8], vaddr_, 2048); AT_SB(); \
          N1 = MFMA32(kfc1, qr[2], N1); AT_PIN1(N1); AT_EXP(C1[4]); AT_EXP(C1[5]); AT_EXP(C1[6]); AT_EXP(C1[7]); VTR_ASM(ta_[9], vaddr_, 2560); VTR_ASM(ta_[10], vaddr_, 6144); VTR_ASM(ta_[11], vaddr_, 6656); AT_SB(); \
           AT_WAITK(8, kfa0, kfa1); N0 = MFMA32(kfa0, qr[3], N0); AT_PIN1(N0); AT_EXP(C1[8]); AT_EXP(C1[9]); AT_EXP(C1[10]); AT_EXP(C1[11]); VTR_ASM(ta_[12], vaddr_, 3072); AT_SB(); \
          N1 = MFMA32(kfa1, qr[3], N1); AT_PIN1(N1); AT_EXP(C1[12]); AT_EXP(C1[13]); AT_EXP(C1[14]); AT_EXP(C1[15]); VTR_ASM(ta_[13], vaddr_, 3584); VTR_ASM(ta_[14], vaddr_, 7168); VTR_ASM(ta_[15], vaddr_, 7680); AT_SB(); \
          \
        } \
        if constexpr (NS == 6) AT_WAITV8(9, ta_[0], ta_[1], ta_[2], ta_[3], ta_[4], ta_[5], ta_[6], ta_[7]); else AT_WAITV8(8, ta_[0], ta_[1], ta_[2], ta_[3], ta_[4], ta_[5], ta_[6], ta_[7]); AT_SB(); \
        vf_[0] = (bf16x8){ta_[0][0], ta_[0][1], ta_[0][2], ta_[0][3], ta_[1][0], ta_[1][1], ta_[1][2], ta_[1][3]}; vf_[1] = (bf16x8){ta_[2][0], ta_[2][1], ta_[2][2], ta_[2][3], ta_[3][0], ta_[3][1], ta_[3][2], ta_[3][3]}; vf_[2] = (bf16x8){ta_[4][0], ta_[4][1], ta_[4][2], ta_[4][3], ta_[5][0], ta_[5][1], ta_[5][2], ta_[5][3]}; vf_[3] = (bf16x8){ta_[6][0], ta_[6][1], ta_[6][2], ta_[6][3], ta_[7][0], ta_[7][1], ta_[7][2], ta_[7][3]}; \
        pw[0] = (u32x4){cvtpk(C0[0], C0[1]), cvtpk(C0[2], C0[3]), cvtpk(C0[4], C0[5]), cvtpk(C0[6], C0[7])}; AT_SB(); \
        if (!(PROBE_VARIANT == 2 && p.pad)) { \
        o0 = MFMA32(__builtin_bit_cast(bf16x8, pw[0]), vf_[0], o0); AT_PIN1(o0); pw[1].x = cvtpk(C0[8], C0[9]); pw[1].y = cvtpk(C0[10], C0[11]); AT_ADD4(C0[0], C0[1], C0[2], C0[3]); AT_SB(); \
        o1 = MFMA32(__builtin_bit_cast(bf16x8, pw[0]), vf_[1], o1); AT_PIN1(o1); pw[1].z = cvtpk(C0[12], C0[13]); pw[1].w = cvtpk(C0[14], C0[15]); AT_ADD4(C0[4], C0[5], C0[6], C0[7]); AT_SB(); \
        o0 = MFMA32(__builtin_bit_cast(bf16x8, pw[1]), vf_[2], o0); AT_PIN1(o0); pw[2].x = cvtpk(C1[0], C1[1]); pw[2].y = cvtpk(C1[2], C1[3]); AT_ADD4(C0[8], C0[9], C0[10], C0[11]); AT_SB(); \
        o1 = MFMA32(__builtin_bit_cast(bf16x8, pw[1]), vf_[3], o1); AT_PIN1(o1); pw[2].z = cvtpk(C1[4], C1[5]); pw[2].w = cvtpk(C1[6], C1[7]); AT_ADD4(C0[12], C0[13], C0[14], C0[15]); AT_SB(); \
        AT_WAITV4(4, ta_[8], ta_[9], ta_[10], ta_[11]); vf_[4] = (bf16x8){ta_[8][0], ta_[8][1], ta_[8][2], ta_[8][3], ta_[9][0], ta_[9][1], ta_[9][2], ta_[9][3]}; vf_[5] = (bf16x8){ta_[10][0], ta_[10][1], ta_[10][2], ta_[10][3], ta_[11][0], ta_[11][1], ta_[11][2], ta_[11][3]}; \
        o0 = MFMA32(__builtin_bit_cast(bf16x8, pw[2]), vf_[4], o0); AT_PIN1(o0); pw[3].x = cvtpk(C1[8], C1[9]); pw[3].y = cvtpk(C1[10], C1[11]); AT_ADD4(C1[0], C1[1], C1[2], C1[3]); AT_SB(); \
        o1 = MFMA32(__builtin_bit_cast(bf16x8, pw[2]), vf_[5], o1); AT_PIN1(o1); pw[3].z = cvtpk(C1[12], C1[13]); pw[3].w = cvtpk(C1[14], C1[15]); AT_ADD4(C1[4], C1[5], C1[6], C1[7]); AT_SB(); \
        AT_WAITV4(0, ta_[12], ta_[13], ta_[14], ta_[15]); vf_[6] = (bf16x8){ta_[12][0], ta_[12][1], ta_[12][2], ta_[12][3], ta_[13][0], ta_[13][1], ta_[13][2], ta_[13][3]}; vf_[7] = (bf16x8){ta_[14][0], ta_[14][1], ta_[14][2], ta_[14][3], ta_[15][0], ta_[15][1], ta_[15][2], ta_[15][3]}; \
        o0 = MFMA32(__builtin_bit_cast(bf16x8, pw[3]), vf_[6], o0); AT_PIN1(o0); AT_ADD4(C1[8], C1[9], C1[10], C1[11]); AT_SB(); \
        o1 = MFMA32(__builtin_bit_cast(bf16x8, pw[3]), vf_[7], o1); AT_PIN1(o1); AT_ADD4(C1[12], C1[13], C1[14], C1[15]); AT_SB(); } \
        l += (r0_ + r1_) + (r2_ + r3_); } \
        AT_WAITBAR(); \
        if (t_ + 1 < ntiles) AT_REF(N0, N1, t1_, false); } while (0)
    for (int it = 0; it < ntiles; it += 2) {
        AT_STEP(cA0, cA1, cB0, cB1, it);
        AT_STEP(cB0, cB1, cA0, cA1, it + 1);
    }
#undef AT_ROW0
#undef AT_DMAK
#undef AT_DMAV
#undef AT_CLAMP
#undef AT_WAITBAR
#undef AT_REF
#undef AT_SB
#undef AT_PIN2
#undef AT_PIN1
#undef AT_ADD4
#undef AT_PINRS
#undef AT_LDK
#undef AT_WAITK
#undef AT_WAITV8
#undef AT_WAITV4
#undef AT_EXP
#undef AT_QK
#undef AT_STEP
    float lt = l + shxl(l, 32, lane);
    float fin = 1.f;
    if (p.sink) { const float sk = p.sink[h] * LOG2E; const float m2 = fmaxf(m, sk); fin = __builtin_amdgcn_exp2f(m - m2); lt = lt * fin + __builtin_amdgcn_exp2f(sk - m2); }
    const float sc = fin / lt;
    if (hi == 0) wsf[r32] = sc;
    bf16_t* Ob = p.O + (size_t)(q0 + wid * 32) * p.old + h * p.ohs + r32;
#pragma unroll
    for (int r = 0; r < 16; ++r) { const int qr_ = crow(r, hi); const float f = wsf[qr_];
        if (!nostore) { Ob[(size_t)qr_ * p.old] = f2bf(o0[r] * f); Ob[(size_t)qr_ * p.old + 32] = f2bf(o1[r] * f); } }
}

namespace gp {
constexpr int BM = 256, BK = 64, HALF = 128, HTB = HALF * BK * 2, STAGE_BYTES = 8 * HTB, NXCD = 8, WGM = 8;
__host__ __device__ __forceinline__ int lds_byte(int r, int c) { const int st = (r >> 4) * 2 + (c >> 5), rr = r & 15, cc = c & 31, ob = rr * 64 + cc * 2; return st * 1024 + (ob ^ (((ob >> 9) & 1) << 5)); }
__host__ __device__ __forceinline__ void stage_rc(int b, int& R, int& C) { const int st = b / 1024, sb = b % 1024, swz = sb ^ (((sb >> 9) & 1) << 5); R = (st >> 1) * 16 + swz / 64; C = (st & 1) * 32 + (swz % 64) / 2; }
__host__ __device__ __forceinline__ int perm32(int rho) { const int n = rho >> 4, i = rho & 15; return 8 * (i >> 2) + 4 * n + (i & 3); }

struct GUnit { const char* A; const char* B; int nt, pm, pn, tag; const unsigned* goff; int lda2, ldb2; };

__device__ __forceinline__ bool tile_order(int i, int G_, int c, int nM, int nN, int& pm, int& pn) {
    const int nwg = nM * nN; const long L = (long)i * G_ + c; if (L >= nwg) return false;
    int wgid = (int)L; { const int q = nwg / NXCD, r = nwg % NXCD, xcd = wgid % NXCD, off = wgid / NXCD; wgid = (xcd < r ? xcd * (q + 1) : r * (q + 1) + (xcd - r) * q) + off; }
    const int nig = WGM * nN, gid = wgid / nig, fm = gid * WGM, gsz = (nM - fm) < WGM ? (nM - fm) : WGM;
    pm = fm + ((wgid % nig) % gsz); pn = (wgid % nig) / gsz; return true;
}
__device__ __forceinline__ unsigned cvt_pk_bf16(float lo, float hi) { return pkbf(lo, hi); }

template <class Epi, class Sched>
__device__ __forceinline__ void gemm_phase(LAS unsigned char* lds, const Sched& S, const Epi& E, int wv0) {
    constexpr bool GATHER = Sched::GATHER; constexpr bool VS = Sched::VARSTRIDE;
    const int tid = opaque_tid(wv0), wid = __builtin_amdgcn_readfirstlane(tid >> 6), lane = tid & 63, wr = wid >> 2, wc = wid & 3, fr = lane & 15, fq = lane >> 4;
    const int lda2 = S.lda2, ldb2 = S.ldb2;
    unsigned voffA[2], voffB[2], rowA[2], rowB[2], colb[2];
#pragma unroll
    for (int i = 0; i < 2; ++i) { int R, C; stage_rc(tid * 16 + i * 8192, R, C); const int Rb = Epi::PERM ? ((R & ~31) + perm32(R & 31)) : R;
        voffA[i] = GATHER ? (unsigned)C * 2u : (unsigned)R * (unsigned)lda2 + (unsigned)C * 2u; rowA[i] = (unsigned)R; voffB[i] = (unsigned)Rb * (unsigned)ldb2 + (unsigned)C * 2u; rowB[i] = (unsigned)Rb; colb[i] = (unsigned)C * 2u; }
    size_t hA = GATHER ? 0 : (size_t)HALF * lda2, hB = (size_t)HALF * ldb2;
    const unsigned ldsw = (unsigned)wid * 1024u;
    const int aoff = lds_byte(wr * 64 + fr, fq * 8), boff = lds_byte(wc * 32 + fr, fq * 8);
    constexpr size_t kstep = (size_t)(BK * 2);
#define GP_SA(b, h) (((b) * 2 + (h)) * HTB)
#define GP_SB(b, h) ((4 + (b) * 2 + (h)) * HTB)
#define GP_STAGE(bufoff, gbase, v0, v1) do { \
        __builtin_amdgcn_global_load_lds((const unsigned*)((const char*)(gbase) + (v0)), (LAS unsigned*)(lds + (bufoff) + ldsw), 16, 0, 0); \
        __builtin_amdgcn_global_load_lds((const unsigned*)((const char*)(gbase) + (v1)), (LAS unsigned*)(lds + (bufoff) + ldsw + 8192), 16, 0, 0); } while (0)
#define GP_LDA(dst, b, h) do { _Pragma("unroll") for (int m = 0; m < 4; ++m) _Pragma("unroll") for (int k = 0; k < 2; ++k) dst[m][k] = *(const LAS bf16x8*)(lds + GP_SA(b, h) + aoff + m * 2048 + k * 1024); } while (0)
#define GP_LDB(dst, b, h) do { _Pragma("unroll") for (int n = 0; n < 2; ++n) _Pragma("unroll") for (int k = 0; k < 2; ++k) dst[n][k] = *(const LAS bf16x8*)(lds + GP_SB(b, h) + boff + n * 2048 + k * 1024); } while (0)
#define GP_MMA(ai, bj, At, Bt) do { __builtin_amdgcn_s_setprio(1); _Pragma("unroll") for (int m = 0; m < 4; ++m) _Pragma("unroll") for (int n = 0; n < 2; ++n) _Pragma("unroll") for (int k = 0; k < 2; ++k) \
        acc[ai][bj][m][n] = __builtin_amdgcn_mfma_f32_16x16x32_bf16(Bt[n][k], At[m][k], acc[ai][bj][m][n], 0, 0, 0); __builtin_amdgcn_s_setprio(0); } while (0)
#define GP_WAIT_V(n) asm volatile("s_waitcnt vmcnt(" #n ")" ::: "memory")
#define GP_WAIT_L(n) asm volatile("s_waitcnt lgkmcnt(" #n ")" ::: "memory")
#define GP_BAR __builtin_amdgcn_s_barrier()
#define GP_SCHED __builtin_amdgcn_sched_barrier(0)
#define GP_GOFF(U, o0, o1, p0, p1) do { if (GATHER) { o0 = (U).goff[rowA[0]] + voffA[0]; o1 = (U).goff[rowA[1]] + voffA[1]; p0 = (U).goff[128 + rowA[0]] + voffA[0]; p1 = (U).goff[128 + rowA[1]] + voffA[1]; } \
        else { o0 = voffA[0]; o1 = voffA[1]; p0 = voffA[0]; p1 = voffA[1]; } } while (0)
    GUnit cur, nxt; int ui = 0;
    if (!S.next(0, cur)) return;
    f32x4 acc[2][2][4][2];
#pragma unroll
    for (int a = 0; a < 2; ++a)
#pragma unroll
        for (int b = 0; b < 2; ++b)
#pragma unroll
            for (int m = 0; m < 4; ++m)
#pragma unroll
                for (int n = 0; n < 2; ++n) acc[a][b][m][n] = (f32x4){0.f, 0.f, 0.f, 0.f};
    bf16x8 At[4][2], B0[2][2], B1[2][2];
    unsigned g00, g01, g10, g11;
    if (VS) { voffA[0] = rowA[0] * (unsigned)cur.lda2 + colb[0]; voffA[1] = rowA[1] * (unsigned)cur.lda2 + colb[1]; voffB[0] = rowB[0] * (unsigned)cur.ldb2 + colb[0]; voffB[1] = rowB[1] * (unsigned)cur.ldb2 + colb[1];
              hA = (size_t)HALF * cur.lda2; hB = (size_t)HALF * cur.ldb2; }
    GP_GOFF(cur, g00, g01, g10, g11);
    const char* cA = cur.A; const char* cB = cur.B;
    GP_STAGE(GP_SB(0, 0), cB, voffB[0], voffB[1]); GP_STAGE(GP_SA(0, 0), cA, g00, g01); GP_STAGE(GP_SB(0, 1), cB + hB, voffB[0], voffB[1]); GP_STAGE(GP_SA(0, 1), cA + hA, g10, g11);
    if (wr == 1) GP_BAR;
    GP_WAIT_V(4); GP_BAR;
    GP_STAGE(GP_SB(1, 0), cB + kstep, voffB[0], voffB[1]); GP_STAGE(GP_SA(1, 0), cA + kstep, g00, g01); GP_STAGE(GP_SB(1, 1), cB + hB + kstep, voffB[0], voffB[1]);
    GP_WAIT_V(6); GP_BAR;
    for (;;) {
        const bool has_next = S.next(ui + 1, nxt);
        const char* nA = has_next ? nxt.A : cA; const char* nB = has_next ? nxt.B : cB;
        const int nt = cur.nt;
        for (int t = 0; t < nt; t += 2) {
            const bool last = (t == nt - 2);
            const char* a1 = cA + (size_t)(t + 1) * kstep;
            const char* a2 = last ? nA : cA + (size_t)(t + 2) * kstep; const char* b2 = last ? nB : cB + (size_t)(t + 2) * kstep;
            const char* a3 = a2 + kstep; const char* b3 = b2 + kstep;
            unsigned w00 = g00, w01 = g01, w10 = g10, w11 = g11, wB0 = voffB[0], wB1 = voffB[1]; size_t whA = hA, whB = hB;
            if (GATHER && last && has_next) { GP_GOFF(nxt, w00, w01, w10, w11); }
            if (VS && last && has_next) { w00 = w10 = rowA[0] * (unsigned)nxt.lda2 + colb[0]; w01 = w11 = rowA[1] * (unsigned)nxt.lda2 + colb[1]; wB0 = rowB[0] * (unsigned)nxt.ldb2 + colb[0]; wB1 = rowB[1] * (unsigned)nxt.ldb2 + colb[1];
                whA = (size_t)HALF * nxt.lda2; whB = (size_t)HALF * nxt.ldb2; }
            GP_LDB(B0, 0, 0); GP_SCHED; GP_LDA(At, 0, 0); GP_STAGE(GP_SA(1, 1), a1 + hA, g10, g11);
            GP_WAIT_L(8); GP_BAR; GP_WAIT_L(0); GP_MMA(0, 0, At, B0); GP_BAR; GP_SCHED;
            GP_LDB(B1, 0, 1); GP_STAGE(GP_SB(0, 0), b2, wB0, wB1);
            GP_BAR; GP_WAIT_L(0); GP_MMA(0, 1, At, B1); GP_BAR;
            GP_LDA(At, 0, 1); GP_STAGE(GP_SA(0, 0), a2, w00, w01);
            GP_BAR; GP_WAIT_L(0); GP_MMA(1, 0, At, B0); GP_BAR; GP_SCHED;
            GP_STAGE(GP_SB(0, 1), b2 + whB, wB0, wB1);
            GP_WAIT_V(6); GP_BAR; GP_MMA(1, 1, At, B1); GP_BAR;
            GP_LDB(B0, 1, 0); GP_SCHED; GP_LDA(At, 1, 0); GP_STAGE(GP_SA(0, 1), a2 + whA, w10, w11);
            GP_WAIT_L(8); GP_BAR; GP_WAIT_L(0); GP_MMA(0, 0, At, B0); GP_BAR; GP_SCHED;
            GP_LDB(B1, 1, 1); GP_STAGE(GP_SB(1, 0), b3, wB0, wB1);
            GP_BAR; GP_WAIT_L(0); GP_MMA(0, 1, At, B1); GP_BAR;
            GP_LDA(At, 1, 1); GP_STAGE(GP_SA(1, 0), a3, w00, w01);
            GP_BAR; GP_WAIT_L(0); GP_MMA(1, 0, At, B0); GP_BAR; GP_SCHED;
            GP_STAGE(GP_SB(1, 1), b3 + whB, wB0, wB1);
            GP_WAIT_V(6); GP_BAR; GP_MMA(1, 1, At, B1); GP_BAR;
            if ((GATHER || VS) && last) { g00 = w00; g01 = w01; g10 = w10; g11 = w11; }
            if (VS && last) { voffB[0] = wB0; voffB[1] = wB1; hA = whA; hB = whB; }
        }
        { int fr_e = fr, fq_e = fq; asm volatile("" : "+v"(fr_e), "+v"(fq_e));
          E(acc, cur, wr, wc, fr_e, fq_e); }
        if (!has_next) break;
#pragma unroll
        for (int a = 0; a < 2; ++a)
#pragma unroll
            for (int b = 0; b < 2; ++b)
#pragma unroll
                for (int m = 0; m < 4; ++m)
#pragma unroll
                    for (int n = 0; n < 2; ++n) acc[a][b][m][n] = (f32x4){0.f, 0.f, 0.f, 0.f};
        cur = nxt; cA = nA; cB = nB; ++ui;
    }
    GP_WAIT_V(0);
    if (wr == 0) GP_BAR;
    GP_BAR;
#undef GP_SA
#undef GP_SB
#undef GP_STAGE
#undef GP_LDA
#undef GP_LDB
#undef GP_MMA
#undef GP_WAIT_V
#undef GP_WAIT_L
#undef GP_BAR
#undef GP_SCHED
#undef GP_GOFF
}
}

struct SchedStd {
    static constexpr bool GATHER = false; static constexpr bool VARSTRIDE = false;
    const bf16_t* A; const bf16_t* Bt; int K, nM, nN, G_, c, skipctx, lda2, ldb2;
    __device__ __forceinline__ bool next(int i, gp::GUnit& u) const {
        int pmv, pn; if (!gp::tile_order(i, G_, c, nM, nN, pmv, pn)) return false;
        const int pm = skipctx == 2 ? pmv * 33 + 32 : (skipctx ? pmv + pmv / 32 : pmv);
        u.A = (const char*)(A + (size_t)pm * 256 * K); u.B = (const char*)(Bt + (size_t)pn * 256 * K); u.nt = K / 64; u.pm = pm; u.pn = pn; u.tag = 0; u.goff = nullptr; return true;
    }
};

__device__ __forceinline__ float fexp(float x) { return __builtin_amdgcn_exp2f(x * LOG2E); }
__device__ __forceinline__ float flog(float x) { return __builtin_amdgcn_logf(x) * 0.6931471805599453f; }
__device__ __forceinline__ float fsigmoid(float x) { return __builtin_amdgcn_rcpf(1.f + fexp(-x)); }
template <bool ZERO> __device__ __forceinline__ float logf_gate_fast(float z, float lb) {
    if constexpr (ZERO) return fminf(z, 0.f) - flog(1.f + fexp(-fabsf(z)));
    else return flog(lb + (1.f - lb) * fsigmoid(z));
}
__device__ __forceinline__ unsigned pkh2(float lo, float hi) { const f16_t a = (f16_t)lo, b = (f16_t)hi; return (unsigned)__builtin_bit_cast(unsigned short, a) | ((unsigned)__builtin_bit_cast(unsigned short, b) << 16); }

template <class T> __device__ __forceinline__ T* opq(T* p) { asm volatile("" : "+s"(p)); return p; }
struct EpiG1 {
    static constexpr bool PERM = true;
    bf16_t *AQ, *AK, *AV, *BQ, *BV, *BG; f16_t *BLF, *BLB; bf16_t *CQKV, *CKR; float* RS; const float *ropa_c, *ropa_s, *ropc_c, *ropc_s; const float* LBl; int rowoff; int lbzero;
    __device__ __forceinline__ void operator()(const f32x4 (&acc)[2][2][4][2], const gp::GUnit& u, int wr, int wc, int fr, int fq) const {
        const int pn = u.pn; const int pr = u.pm % 33; const bool lat = pr < 32;
        const int grow0 = u.pm * 256 + wr * 64 + fr; const int t0 = pr * 256 + wr * 64 + fr;
        if (pn < 3) {
            const int hh = pn * 4 + wc; bf16_t* dst; int ld, coff; bf16_t* const aq_ = opq(AQ); bf16_t* const ak_ = opq(AK); bf16_t* const av_ = opq(AV);
            if (hh < 8) { dst = aq_; ld = 512; coff = hh * 64; } else if (hh < 10) { dst = ak_; ld = 128; coff = (hh - 8) * 64; } else { dst = av_; ld = 128; coff = (hh - 10) * 64; }
            const bool rope = lat && hh < 10;
#pragma unroll
            for (int ai = 0; ai < 2; ++ai)
#pragma unroll
                for (int m = 0; m < 4; ++m) { const int grow = grow0 + ai * 128 + m * 16, t = t0 + ai * 128 + m * 16; const size_t row = (size_t)(grow - rowoff);
                    f32x4 x1a = acc[ai][0][m][0], x1b = acc[ai][0][m][1], x2a = acc[ai][1][m][0], x2b = acc[ai][1][m][1];
                    if (rope) { const f32x4 ca = *(const f32x4*)(ropa_c + t * 32 + 8 * fq), cb = *(const f32x4*)(ropa_c + t * 32 + 8 * fq + 4), sa = *(const f32x4*)(ropa_s + t * 32 + 8 * fq), sb = *(const f32x4*)(ropa_s + t * 32 + 8 * fq + 4);
                        const f32x4 o1a = x1a * ca - x2a * sa, o2a = x1a * sa + x2a * ca, o1b = x1b * cb - x2b * sb, o2b = x1b * sb + x2b * cb; x1a = o1a; x2a = o2a; x1b = o1b; x2b = o2b; }
                    if (hh < 8) { const float qs = 0.125f * LOG2E; x1a *= qs; x1b *= qs; x2a *= qs; x2b *= qs; }
                    bf16_t* p = dst + row * ld + coff + 8 * fq;
                    u32x4 w1, w2; w1.x = gp::cvt_pk_bf16(x1a[0], x1a[1]); w1.y = gp::cvt_pk_bf16(x1a[2], x1a[3]); w1.z = gp::cvt_pk_bf16(x1b[0], x1b[1]); w1.w = gp::cvt_pk_bf16(x1b[2], x1b[3]);
                    w2.x = gp::cvt_pk_bf16(x2a[0], x2a[1]); w2.y = gp::cvt_pk_bf16(x2a[2], x2a[3]); w2.z = gp::cvt_pk_bf16(x2b[0], x2b[1]); w2.w = gp::cvt_pk_bf16(x2b[2], x2b[3]);
                    *(u32x4 __attribute__((address_space(1)))*)p = w1; *(u32x4 __attribute__((address_space(1)))*)(p + 32) = w2; if (m == 3) asm volatile("" ::: "memory"); }
        } else if (pn < 13) {
            const int q = pn - 3, which = q >> 1; const int cb0 = (q & 1) * 256 + wc * 32 + 8 * fq;
            if (which == 2 || which == 3) {
                f16_t* const blf_ = opq(BLF); f16_t* const blb_ = opq(BLB); f16_t* dst = which == 2 ? blf_ : blb_; const float* lbp = LBl + (which == 2 ? 0 : 512);
                if (lbzero) {
#pragma unroll
                for (int bj = 0; bj < 2; ++bj) { const int c0 = cb0 + bj * 128; const f32x4 la = *(const f32x4*)(lbp + c0), lb4 = *(const f32x4*)(lbp + c0 + 4);
#pragma unroll
                    for (int ai = 0; ai < 2; ++ai)
#pragma unroll
                        for (int m = 0; m < 4; ++m) { const size_t row = (size_t)(grow0 + ai * 128 + m * 16 - rowoff); const f32x4 v0 = acc[ai][bj][m][0], v1 = acc[ai][bj][m][1];
                            u32x4 w; w.x = pkh2(logf_gate_fast<true>(v0[0], la[0]), logf_gate_fast<true>(v0[1], la[1])); w.y = pkh2(logf_gate_fast<true>(v0[2], la[2]), logf_gate_fast<true>(v0[3], la[3]));
                            w.z = pkh2(logf_gate_fast<true>(v1[0], lb4[0]), logf_gate_fast<true>(v1[1], lb4[1])); w.w = pkh2(logf_gate_fast<true>(v1[2], lb4[2]), logf_gate_fast<true>(v1[3], lb4[3]));
                            *(u32x4 __attribute__((address_space(1)))*)(dst + row * 512 + c0) = w; } }
                } else {
#pragma unroll
                for (int bj = 0; bj < 2; ++bj) { const int c0 = cb0 + bj * 128; const f32x4 la = *(const f32x4*)(lbp + c0), lb4 = *(const f32x4*)(lbp + c0 + 4);
#pragma unroll
                    for (int ai = 0; ai < 2; ++ai)
#pragma unroll
                        for (int m = 0; m < 4; ++m) { const size_t row = (size_t)(grow0 + ai * 128 + m * 16 - rowoff); const f32x4 v0 = acc[ai][bj][m][0], v1 = acc[ai][bj][m][1];
                            u32x4 w; w.x = pkh2(logf_gate_fast<false>(v0[0], la[0]), logf_gate_fast<false>(v0[1], la[1])); w.y = pkh2(logf_gate_fast<false>(v0[2], la[2]), logf_gate_fast<false>(v0[3], la[3]));
                            w.z = pkh2(logf_gate_fast<false>(v1[0], lb4[0]), logf_gate_fast<false>(v1[1], lb4[1])); w.w = pkh2(logf_gate_fast<false>(v1[2], lb4[2]), logf_gate_fast<false>(v1[3], lb4[3]));
                            *(u32x4 __attribute__((address_space(1)))*)(dst + row * 512 + c0) = w; } }
                }
            } else {
                bf16_t* const bq_ = opq(BQ); bf16_t* const bv_ = opq(BV); bf16_t* const bg_ = opq(BG); bf16_t* dst = which == 0 ? bq_ : (which == 1 ? bv_ : bg_);
#pragma unroll
                for (int ai = 0; ai < 2; ++ai)
#pragma unroll
                    for (int m = 0; m < 4; ++m) { const size_t row = (size_t)(grow0 + ai * 128 + m * 16 - rowoff);
#pragma unroll
                        for (int bj = 0; bj < 2; ++bj) { const f32x4 v0 = acc[ai][bj][m][0], v1 = acc[ai][bj][m][1];
                            u32x4 w; w.x = gp::cvt_pk_bf16(v0[0], v0[1]); w.y = gp::cvt_pk_bf16(v0[2], v0[3]); w.z = gp::cvt_pk_bf16(v1[0], v1[1]); w.w = gp::cvt_pk_bf16(v1[2], v1[3]);
                            *(u32x4 __attribute__((address_space(1)))*)(dst + row * 512 + cb0 + bj * 128) = w; } }
            }
        } else if (pn == 13) {
#pragma unroll
            for (int ai = 0; ai < 2; ++ai)
#pragma unroll
                for (int m = 0; m < 4; ++m) { const int grow = grow0 + ai * 128 + m * 16; const size_t row = (size_t)(grow - rowoff); float ss = 0.f;
#pragma unroll
                    for (int bj = 0; bj < 2; ++bj) { const f32x4 v0 = acc[ai][bj][m][0], v1 = acc[ai][bj][m][1];
                        ss += v0[0] * v0[0] + v0[1] * v0[1] + v0[2] * v0[2] + v0[3] * v0[3] + v1[0] * v1[0] + v1[1] * v1[1] + v1[2] * v1[2] + v1[3] * v1[3];
                        u32x4 w; w.x = gp::cvt_pk_bf16(v0[0], v0[1]); w.y = gp::cvt_pk_bf16(v0[2], v0[3]); w.z = gp::cvt_pk_bf16(v1[0], v1[1]); w.w = gp::cvt_pk_bf16(v1[2], v1[3]);
                        *(u32x4 __attribute__((address_space(1)))*)(CQKV + row * 384 + bj * 128 + wc * 32 + 8 * fq) = w; }
                    ss += shxl(ss, 16, fr | (fq << 4)); ss += shxl(ss, 32, fr | (fq << 4));
                    if (fq == 0) RS[(size_t)grow * 8 + wc] = ss; }
        } else {
#pragma unroll
            for (int ai = 0; ai < 2; ++ai)
#pragma unroll
                for (int m = 0; m < 4; ++m) { const int grow = grow0 + ai * 128 + m * 16, t = t0 + ai * 128 + m * 16; const size_t row = (size_t)(grow - rowoff);
                    const f32x4 v0 = acc[ai][0][m][0], v1 = acc[ai][0][m][1];
                    float ss = v0[0] * v0[0] + v0[1] * v0[1] + v0[2] * v0[2] + v0[3] * v0[3] + v1[0] * v1[0] + v1[1] * v1[1] + v1[2] * v1[2] + v1[3] * v1[3];
                    u32x4 w; w.x = gp::cvt_pk_bf16(v0[0], v0[1]); w.y = gp::cvt_pk_bf16(v0[2], v0[3]); w.z = gp::cvt_pk_bf16(v1[0], v1[1]); w.w = gp::cvt_pk_bf16(v1[2], v1[3]);
                    *(u32x4 __attribute__((address_space(1)))*)(CQKV + row * 384 + 256 + wc * 32 + 8 * fq) = w;
                    ss += shxl(ss, 16, fr | (fq << 4)); ss += shxl(ss, 32, fr | (fq << 4));
                    if (fq == 0) RS[(size_t)grow * 8 + 4 + wc] = ss;
                    if (wc == 0) { f32x4 x1 = acc[ai][1][m][0], x2 = acc[ai][1][m][1];
                        if (lat) { const f32x4 cc = *(const f32x4*)(ropc_c + t * 16 + 4 * fq), sn = *(const f32x4*)(ropc_s + t * 16 + 4 * fq); const f32x4 o1 = x1 * cc - x2 * sn, o2 = x1 * sn + x2 * cc; x1 = o1; x2 = o2; }
                        *(uint2*)(CKR + row * 32 + 4 * fq) = make_uint2(gp::cvt_pk_bf16(x1[0], x1[1]), gp::cvt_pk_bf16(x1[2], x1[3]));
                        *(uint2*)(CKR + row * 32 + 16 + 4 * fq) = make_uint2(gp::cvt_pk_bf16(x2[0], x2[1]), gp::cvt_pk_bf16(x2[2], x2[3])); } }
        }
    }
};

struct EpiC {
    static constexpr bool PERM = true;
    bf16_t *CQ, *CKV; const float* RS; const float *ropc_c, *ropc_s; int pmoff;
    __device__ __forceinline__ void operator()(const f32x4 (&acc)[2][2][4][2], const gp::GUnit& u, int wr, int wc, int fr, int fq) const {
        const int pn = u.pn; const int pr = (u.pm + pmoff) % 33; const bool lat = pr < 32;
        const int grow0 = u.pm * 256 + wr * 64 + fr; const int t0 = pr * 256 + wr * 64 + fr;
        f32x4 rs4[2][4];
#pragma unroll
        for (int ai = 0; ai < 2; ++ai)
#pragma unroll
            for (int m = 0; m < 4; ++m) rs4[ai][m] = *(const f32x4*)(RS + (size_t)(grow0 + ai * 128 + m * 16) * 8 + (pn < 3 ? 0 : 4));
#pragma unroll
        for (int ai = 0; ai < 2; ++ai)
#pragma unroll
            for (int m = 0; m < 4; ++m) { const size_t row = (size_t)(grow0 + ai * 128 + m * 16); const int t = t0 + ai * 128 + m * 16;
                if (pn < 3) { const f32x4 p4 = rs4[ai][m]; const float rq = rsqrtf(((p4[0] + p4[1]) + (p4[2] + p4[3])) * (1.f / 256.f) + EPS) * (0.10206207261596577f * LOG2E);
#pragma unroll
                    for (int bj = 0; bj < 2; ++bj) { const int gi = pn * 8 + bj * 4 + wc, head = gi / 3, part = gi - head * 3;
                        f32x4 v0 = acc[ai][bj][m][0] * rq, v1 = acc[ai][bj][m][1] * rq;
                        bf16_t* p = CQ + row * 768 + head * 96;
                        if (part < 2) { u32x4 w; w.x = gp::cvt_pk_bf16(v0[0], v0[1]); w.y = gp::cvt_pk_bf16(v0[2], v0[3]); w.z = gp::cvt_pk_bf16(v1[0], v1[1]); w.w = gp::cvt_pk_bf16(v1[2], v1[3]);
                            *(u32x4*)(p + part * 32 + 8 * fq) = w; }
                        else { if (lat) { const f32x4 cc = *(const f32x4*)(ropc_c + t * 16 + 4 * fq), sn = *(const f32x4*)(ropc_s + t * 16 + 4 * fq); const f32x4 o1 = v0 * cc - v1 * sn, o2 = v0 * sn + v1 * cc; v0 = o1; v1 = o2; }
                            *(uint2*)(p + 64 + 4 * fq) = make_uint2(gp::cvt_pk_bf16(v0[0], v0[1]), gp::cvt_pk_bf16(v0[2], v0[3]));
                            *(uint2*)(p + 80 + 4 * fq) = make_uint2(gp::cvt_pk_bf16(v1[0], v1[1]), gp::cvt_pk_bf16(v1[2], v1[3])); } }
                } else { const f32x4 p4 = rs4[ai][m]; const float rkv = rsqrtf(((p4[0] + p4[1]) + (p4[2] + p4[3])) * (1.f / 128.f) + EPS);
#pragma unroll
                    for (int bj = 0; bj < 2; ++bj) { const f32x4 v0 = acc[ai][bj][m][0] * rkv, v1 = acc[ai][bj][m][1] * rkv;
                        u32x4 w; w.x = gp::cvt_pk_bf16(v0[0], v0[1]); w.y = gp::cvt_pk_bf16(v0[2], v0[3]); w.z = gp::cvt_pk_bf16(v1[0], v1[1]); w.w = gp::cvt_pk_bf16(v1[2], v1[3]);
                        *(u32x4*)(CKV + row * 1024 + (pn - 3) * 256 + bj * 128 + wc * 32 + 8 * fq) = w; } } }
    }
};
struct EpiGate {
    static constexpr bool PERM = true;
    bf16_t* GATE; long nstride; int ld;
    __device__ __forceinline__ void operator()(const f32x4 (&acc)[2][2][4][2], const gp::GUnit& u, int wr, int wc, int fr, int fq) const {
        const int n3 = u.pn >> 2; bf16_t* base = GATE + (size_t)n3 * nstride + (u.pn & 3) * 256 + wc * 32 + 8 * fq; const int row0 = u.pm * 256 + wr * 64 + fr;
#pragma unroll
        for (int ai = 0; ai < 2; ++ai)
#pragma unroll
            for (int m = 0; m < 4; ++m) { bf16_t* rp = base + (size_t)(row0 + ai * 128 + m * 16) * ld;
#pragma unroll
                for (int bj = 0; bj < 2; ++bj) { const f32x4 v0 = acc[ai][bj][m][0], v1 = acc[ai][bj][m][1];
                    u32x4 w; w.x = gp::cvt_pk_bf16(fsigmoid(v0[0]), fsigmoid(v0[1])); w.y = gp::cvt_pk_bf16(fsigmoid(v0[2]), fsigmoid(v0[3])); w.z = gp::cvt_pk_bf16(fsigmoid(v1[0]), fsigmoid(v1[1])); w.w = gp::cvt_pk_bf16(fsigmoid(v1[2]), fsigmoid(v1[3]));
                    *(u32x4*)(rp + bj * 128) = w; } }
    }
};
struct SchedMerge {
    static constexpr bool GATHER = false; static constexpr bool VARSTRIDE = false;
    const bf16_t *A0, *A1, *A2; const bf16_t* Bt; int nM, G_, c, skipctx, lda2, ldb2;
    __device__ __forceinline__ bool next(int i, gp::GUnit& u) const {
        int pmv, pn12; if (!gp::tile_order(i, G_, c, nM, 12, pmv, pn12)) return false;
        const int n = pn12 >> 2, pn = pn12 & 3;
        const int pm = skipctx == 2 ? pmv * 33 + 32 : (skipctx ? pmv + pmv / 32 : pmv);
        const bf16_t* a0 = opq(A0); const bf16_t* a1 = opq(A1); const bf16_t* a2 = opq(A2);
        const bf16_t* a = n == 0 ? a0 : (n == 1 ? a1 : a2);
        u.A = (const char*)(a + (size_t)pm * 256 * 512); u.B = (const char*)(Bt + (size_t)n * 1024 * 512 + (size_t)pn * 256 * 512); u.nt = 8; u.pm = pm; u.pn = pn; u.tag = n; u.goff = nullptr; return true;
    }
};
__device__ __forceinline__ float bflo(unsigned w) { return __uint_as_float(w << 16); }
__device__ __forceinline__ float bfhi(unsigned w) { return __uint_as_float(w & 0xffff0000u); }
struct EpiMerge {
    static constexpr bool PERM = true;
    bf16_t* GATE; long nstride; int ld;
    __device__ __forceinline__ void operator()(const f32x4 (&acc)[2][2][4][2], const gp::GUnit& u, int wr, int wc, int fr, int fq) const {
        if (PROBE_VARIANT == 3 && ld < 0) return;
        const int n3 = u.tag; const int col = u.pn * 256 + wc * 32 + 8 * fq; bf16_t* gb = GATE + (size_t)n3 * nstride + col; const int row0 = u.pm * 256 + wr * 64 + fr;
#pragma unroll
        for (int ai = 0; ai < 2; ++ai) { u32x4 g[4][2];
#pragma unroll
            for (int m = 0; m < 4; ++m)
#pragma unroll
                for (int bj = 0; bj < 2; ++bj) g[m][bj] = *(const u32x4*)(gb + (size_t)(row0 + ai * 128 + m * 16) * ld + bj * 128);
#pragma unroll
            for (int m = 0; m < 4; ++m)
#pragma unroll
                for (int bj = 0; bj < 2; ++bj) { const u32x4 gg = g[m][bj]; const f32x4 v0 = acc[ai][bj][m][0], v1 = acc[ai][bj][m][1];
                    u32x4 w; w.x = gp::cvt_pk_bf16(v0[0] * bflo(gg.x), v0[1] * bfhi(gg.x)); w.y = gp::cvt_pk_bf16(v0[2] * bflo(gg.y), v0[3] * bfhi(gg.y));
                    w.z = gp::cvt_pk_bf16(v1[0] * bflo(gg.z), v1[1] * bfhi(gg.z)); w.w = gp::cvt_pk_bf16(v1[2] * bflo(gg.w), v1[3] * bfhi(gg.w));
                    *(u32x4*)(gb + (size_t)(row0 + ai * 128 + m * 16) * ld + bj * 128) = w; }
            asm volatile("" ::: "memory"); }
    }
};
struct SchedGM {
    static constexpr bool GATHER = false; static constexpr bool VARSTRIDE = true;
    const bf16_t *A0, *A1, *A2, *Ag; const bf16_t *Bbr, *Bg; int nM, G_, c, skipctx, lda2, ldb2, su;
    __device__ __forceinline__ bool next(int i, gp::GUnit& u) const {
        int pmv, pn12, kind;
        if (su) { const int t6 = i / 6, sub = i - 6 * t6; int pn4; if (!gp::tile_order(t6, G_, c, nM, 4, pmv, pn4)) return false; kind = sub & 1; pn12 = (sub >> 1) * 4 + pn4; }
        else { if (!gp::tile_order(i >> 1, G_, c, nM, 12, pmv, pn12)) return false; kind = i & 1; }
        const int n = pn12 >> 2, pn = pn12 & 3;
        const int pm = skipctx == 2 ? pmv * 33 + 32 : (skipctx ? pmv + pmv / 32 : pmv);
        const bf16_t* a0 = opq(A0); const bf16_t* a1 = opq(A1); const bf16_t* a2 = opq(A2); const bf16_t* ag = opq(Ag);
        const bf16_t* a = n == 0 ? a0 : (n == 1 ? a1 : a2);
        if (kind == 0) { u.A = (const char*)(a + (size_t)pm * 256 * 512); u.B = (const char*)(Bbr + (size_t)n * 1024 * 512 + (size_t)pn * 256 * 512); u.nt = 8; u.lda2 = 1024; u.ldb2 = 1024; }
        else { u.A = (const char*)(ag + (size_t)pm * 256 * 1024); u.B = (const char*)(Bg + (size_t)pn12 * 256 * 1024); u.nt = 16; u.lda2 = 2048; u.ldb2 = 2048; }
        u.pm = pm; u.pn = pn; u.tag = n + 4 * kind; u.goff = nullptr; return true;
    }
};
struct EpiGM {
    static constexpr bool PERM = true;
    bf16_t* U; long nstride; int ld; bf16_t* Y; int fuse;
    __device__ __forceinline__ void operator()(const f32x4 (&acc)[2][2][4][2], const gp::GUnit& u, int wr, int wc, int fr, int fq) const {
        const int n3 = u.tag & 3; const int col = u.pn * 256 + wc * 32 + 8 * fq; bf16_t* gb = U + (size_t)n3 * nstride + col; const int row0 = u.pm * 256 + wr * 64 + fr;
        if (fuse && u.tag == 6) {
            const bf16_t* u0 = U + col; const bf16_t* u1 = U + (size_t)nstride + col; bf16_t* yb = Y + col;
#pragma unroll
            for (int ai = 0; ai < 2; ++ai)
#pragma unroll
                for (int mh = 0; mh < 2; ++mh) { u32x4 z[2][2], a[2][2], b[2][2];
#pragma unroll
                    for (int m2 = 0; m2 < 2; ++m2)
#pragma unroll
                        for (int bj = 0; bj < 2; ++bj) { const size_t o = (size_t)(row0 + ai * 128 + (mh * 2 + m2) * 16) * ld + bj * 128; z[m2][bj] = *(const u32x4*)(gb + o); a[m2][bj] = *(const u32x4*)(u0 + o); b[m2][bj] = *(const u32x4*)(u1 + o); }
#pragma unroll
                    for (int m2 = 0; m2 < 2; ++m2)
#pragma unroll
                        for (int bj = 0; bj < 2; ++bj) { const int m = mh * 2 + m2; const u32x4 zz = z[m2][bj], aa = a[m2][bj], bb = b[m2][bj]; const f32x4 v0 = acc[ai][bj][m][0], v1 = acc[ai][bj][m][1];
                            u32x4 w; w.x = gp::cvt_pk_bf16(fsigmoid(v0[0]) * bflo(zz.x) + bflo(aa.x) + bflo(bb.x), fsigmoid(v0[1]) * bfhi(zz.x) + bfhi(aa.x) + bfhi(bb.x));
                            w.y = gp::cvt_pk_bf16(fsigmoid(v0[2]) * bflo(zz.y) + bflo(aa.y) + bflo(bb.y), fsigmoid(v0[3]) * bfhi(zz.y) + bfhi(aa.y) + bfhi(bb.y));
                            w.z = gp::cvt_pk_bf16(fsigmoid(v1[0]) * bflo(zz.z) + bflo(aa.z) + bflo(bb.z), fsigmoid(v1[1]) * bfhi(zz.z) + bfhi(aa.z) + bfhi(bb.z));
                            w.w = gp::cvt_pk_bf16(fsigmoid(v1[2]) * bflo(zz.w) + bflo(aa.w) + bflo(bb.w), fsigmoid(v1[3]) * bfhi(zz.w) + bfhi(aa.w) + bfhi(bb.w));
                            *(u32x4*)(yb + (size_t)(row0 + ai * 128 + m * 16) * ld + bj * 128) = w; }
                    asm volatile("" ::: "memory"); }
        } else if (u.tag < 4) {
#pragma unroll
            for (int ai = 0; ai < 2; ++ai)
#pragma unroll
                for (int m = 0; m < 4; ++m)
#pragma unroll
                    for (int bj = 0; bj < 2; ++bj) { const f32x4 v0 = acc[ai][bj][m][0], v1 = acc[ai][bj][m][1];
                        u32x4 w; w.x = gp::cvt_pk_bf16(v0[0], v0[1]); w.y = gp::cvt_pk_bf16(v0[2], v0[3]); w.z = gp::cvt_pk_bf16(v1[0], v1[1]); w.w = gp::cvt_pk_bf16(v1[2], v1[3]);
                        *(u32x4*)(gb + (size_t)(row0 + ai * 128 + m * 16) * ld + bj * 128) = w; }
        } else {
#pragma unroll
            for (int ai = 0; ai < 2; ++ai) { u32x4 z[4][2];
#pragma unroll
                for (int m = 0; m < 4; ++m)
#pragma unroll
                    for (int bj = 0; bj < 2; ++bj) z[m][bj] = *(const u32x4*)(gb + (size_t)(row0 + ai * 128 + m * 16) * ld + bj * 128);
#pragma unroll
                for (int m = 0; m < 4; ++m)
#pragma unroll
                    for (int bj = 0; bj < 2; ++bj) { const u32x4 zz = z[m][bj]; const f32x4 v0 = acc[ai][bj][m][0], v1 = acc[ai][bj][m][1];
                        u32x4 w; w.x = gp::cvt_pk_bf16(fsigmoid(v0[0]) * bflo(zz.x), fsigmoid(v0[1]) * bfhi(zz.x)); w.y = gp::cvt_pk_bf16(fsigmoid(v0[2]) * bflo(zz.y), fsigmoid(v0[3]) * bfhi(zz.y));
                        w.z = gp::cvt_pk_bf16(fsigmoid(v1[0]) * bflo(zz.z), fsigmoid(v1[1]) * bfhi(zz.z)); w.w = gp::cvt_pk_bf16(fsigmoid(v1[2]) * bflo(zz.w), fsigmoid(v1[3]) * bfhi(zz.w));
                        *(u32x4*)(gb + (size_t)(row0 + ai * 128 + m * 16) * ld + bj * 128) = w; }
                asm volatile("" ::: "memory"); }
        }
    }
};
struct EpiOut {
    static constexpr bool PERM = false;
    const float *xl_src, *xc_src; float *xl_dst, *xc_dst; const float* mod; int pmoff;
    __device__ __forceinline__ void operator()(const f32x4 (&acc)[2][2][4][2], const gp::GUnit& u, int wr, int wc, int fr, int fq) const {
        const int gpm = u.pm + pmoff, b = gpm / 33, pr = gpm - b * 33; const bool lat = pr < 32;
        const float* xs = opq(lat ? xl_src : xc_src); float* xd = opq(lat ? xl_dst : xc_dst);
        const size_t rbase = lat ? ((size_t)b * SEQ + pr * 256) : ((size_t)b * CTXL);
        const float* gt = mod + (size_t)(lat ? b : 4) * 6144 + 2048; const int col0 = u.pn * 256 + wc * 32 + 4 * fq;
        f32x4 g4[2][2];
#pragma unroll
        for (int bj = 0; bj < 2; ++bj)
#pragma unroll
            for (int n = 0; n < 2; ++n) g4[bj][n] = *(const f32x4*)(gt + col0 + bj * 128 + n * 16);
#pragma unroll
        for (int ai = 0; ai < 2; ++ai) { f32x4 xv[4][2][2];
#pragma unroll
            for (int m = 0; m < 4; ++m) { const size_t off = (rbase + ai * 128 + wr * 64 + m * 16 + fr) * D + col0;
#pragma unroll
                for (int bj = 0; bj < 2; ++bj)
#pragma unroll
                    for (int n = 0; n < 2; ++n) xv[m][bj][n] = *(const f32x4 __attribute__((address_space(1)))*)(xs + off + bj * 128 + n * 16); }
#pragma unroll
            for (int m = 0; m < 4; ++m) { const size_t off = (rbase + ai * 128 + wr * 64 + m * 16 + fr) * D + col0;
#pragma unroll
                for (int bj = 0; bj < 2; ++bj)
#pragma unroll
                    for (int n = 0; n < 2; ++n) *(f32x4 __attribute__((address_space(1)))*)(xd + off + bj * 128 + n * 16) = xv[m][bj][n] + g4[bj][n] * acc[ai][bj][m][n]; }
            asm volatile("" ::: "memory"); }
    }
};
template <bool GATHER_> struct SchedMoE {
    static constexpr bool GATHER = GATHER_; static constexpr bool VARSTRIDE = false;
    const bf16_t* A; const bf16_t* Bt; const int* tile_e; const unsigned* goff; int K, nM, nN, G_, c, lda2, ldb2; long strideB;
    __device__ __forceinline__ bool next(int i, gp::GUnit& u) const {
        int pm, pn; if (!gp::tile_order(i, G_, c, nM, nN, pm, pn)) return false;
        const int e = tile_e[pm];
        u.A = GATHER ? (const char*)A : (const char*)(A + (size_t)pm * 256 * K); u.B = (const char*)(Bt + (size_t)e * strideB + (size_t)pn * 256 * K); u.nt = K / 64; u.pm = pm; u.pn = pn; u.tag = e;
        u.goff = GATHER ? goff + (size_t)pm * 256 : nullptr; return true;
    }
};
struct EpiUp {
    static constexpr bool PERM = true;
    bf16_t* AUP;
    __device__ __forceinline__ void operator()(const f32x4 (&acc)[2][2][4][2], const gp::GUnit& u, int wr, int wc, int fr, int fq) const {
        const int row0 = u.pm * 256 + wr * 64 + fr; bf16_t* base = AUP + u.pn * 128 + wc * 32 + 8 * fq;
#pragma unroll
        for (int ai = 0; ai < 2; ++ai)
#pragma unroll
            for (int m = 0; m < 4; ++m) { const f32x4 a0 = acc[ai][0][m][0], a1 = acc[ai][0][m][1], b0 = acc[ai][1][m][0], b1 = acc[ai][1][m][1];
                float r[8];
#pragma unroll
                for (int e = 0; e < 4; ++e) { r[e] = a0[e] * fsigmoid(a0[e]) * b0[e]; r[4 + e] = a1[e] * fsigmoid(a1[e]) * b1[e]; }
                u32x4 w; w.x = gp::cvt_pk_bf16(r[0], r[1]); w.y = gp::cvt_pk_bf16(r[2], r[3]); w.z = gp::cvt_pk_bf16(r[4], r[5]); w.w = gp::cvt_pk_bf16(r[6], r[7]);
                *(u32x4*)(base + (size_t)(row0 + ai * 128 + m * 16) * 256) = w; }
    }
};
struct EpiDown {
    static constexpr bool PERM = true;
    bf16_t* YM2; const int* perm; const float* posw;
    __device__ __forceinline__ void operator()(const f32x4 (&acc)[2][2][4][2], const gp::GUnit& u, int wr, int wc, int fr, int fq) const {
        const int row0 = u.pm * 256 + wr * 64 + fr; const int col = u.pn * 256 + wc * 32 + 8 * fq;
        int pe8[2][4]; float w88[2][4];
#pragma unroll
        for (int ai = 0; ai < 2; ++ai)
#pragma unroll
            for (int m = 0; m < 4; ++m) { const int pos = row0 + ai * 128 + m * 16; pe8[ai][m] = perm[pos]; w88[ai][m] = posw[pos]; }
#pragma unroll
        for (int ai = 0; ai < 2; ++ai)
#pragma unroll
            for (int m = 0; m < 4; ++m) { const int pe = pe8[ai][m]; const float w8 = w88[ai][m];
                if (pe >= 0) {
#pragma unroll
                    for (int bj = 0; bj < 2; ++bj) { const f32x4 v0 = acc[ai][bj][m][0] * w8, v1 = acc[ai][bj][m][1] * w8;
                        u32x4 w; w.x = gp::cvt_pk_bf16(v0[0], v0[1]); w.y = gp::cvt_pk_bf16(v0[2], v0[3]); w.z = gp::cvt_pk_bf16(v1[0], v1[1]); w.w = gp::cvt_pk_bf16(v1[2], v1[3]);
                        *(u32x4*)(YM2 + (size_t)pe * 1024 + col + bj * 128) = w; } } }
    }
};
enum { MAP_WIN = 1, MAP_WC = 2, MAP_WUP = 3 };
__device__ __forceinline__ int colmap(int kind, int p) {
    if (kind == MAP_WIN) {
        if (p >= 3840) return MIXW + (p - 3840);
        const int pn = p >> 8, q = p & 255, bj = q >> 7, wc = (q >> 5) & 3, j = q & 31;
        if (pn < 3) return (pn * 4 + wc) * 64 + bj * 32 + j;
        if (pn < 14) return p;
        if (bj == 0) return p;
        if (wc != 0) return -1;
        return 3712 + 16 * ((j >> 2) & 1) + 4 * (j >> 3) + (j & 3);
    }
    return p;
}
constexpr int NCHK = RPB / 64;
struct ScanArgs { const bf16_t* BQ; const bf16_t* BV; const bf16_t* BG; const f16_t* BLF; const f16_t* BLB; bf16_t* ST; float* DS; bf16_t* OB; const float* gn; int in_off; int out_off; int skipctx_out; int pad; };
#define MFMA16(a, b, c) __builtin_amdgcn_mfma_f32_16x16x32_bf16(a, b, c, 0, 0, 0)
constexpr int BCS = 68;
constexpr int SC_RAW = 0, SC_VT = 2 * 64 * BCS * 4, SC_A = SC_VT + 9216;
typedef _Float16 sc_h8 __attribute__((ext_vector_type(8)));
struct StageRegs { sc_h8 lf, lb; bf16x8 v; };
__device__ __forceinline__ void scan_stage_load(const ScanArgs& a, size_t row0, int h, int tid, StageRegs& R) {
    const int row = tid >> 3, c8 = (tid & 7) * 8; const size_t off = (row0 + row) * 512 + h * 64 + c8;
    R.lf = *(const sc_h8*)(a.BLF + off); R.lb = *(const sc_h8*)(a.BLB + off);
    const int vrow = tid & 63, vc8 = (tid >> 6) * 8; R.v = *(const bf16x8*)(a.BV + (row0 + vrow) * 512 + h * 64 + vc8);
}
__device__ __forceinline__ void scan_stage_store(LAS char* lds, int tid, const StageRegs& R) {
    LAS float* RAW = (LAS float*)(lds + SC_RAW); LAS bf16_t* VT = (LAS bf16_t*)(lds + SC_VT);
    const int row = tid >> 3, c8 = (tid & 7) * 8; const int vrow = tid & 63, vc8 = (tid >> 6) * 8; const sc_h8 lf = R.lf, lb = R.lb; const bf16x8 v = R.v;
    *(LAS f32x4*)(RAW + row * BCS + c8) = (f32x4){(float)lf[0], (float)lf[1], (float)lf[2], (float)lf[3]}; *(LAS f32x4*)(RAW + row * BCS + c8 + 4) = (f32x4){(float)lf[4], (float)lf[5], (float)lf[6], (float)lf[7]};
    *(LAS f32x4*)(RAW + 64 * BCS + row * BCS + c8) = (f32x4){(float)lb[0], (float)lb[1], (float)lb[2], (float)lb[3]}; *(LAS f32x4*)(RAW + 64 * BCS + row * BCS + c8 + 4) = (f32x4){(float)lb[4], (float)lb[5], (float)lb[6], (float)lb[7]};
#pragma unroll
    for (int j = 0; j < 8; ++j) VT[(vc8 + j) * 72 + vrow] = (bf16_t)v[j];
}
__device__ __forceinline__ void scan_stage(LAS char* lds, const ScanArgs& a, size_t row0, int h, int tid) { StageRegs R; scan_stage_load(a, row0, h, tid, R); scan_stage_store(lds, tid, R); }
__device__ __forceinline__ void scan_cumsum(LAS char* lds, LAS float* XCH, int tid, float (&lf)[16], float (&bc)[16], float& total) {
    LAS float* RAW = (LAS float*)(lds + SC_RAW);
    const int col = tid & 127, dir = __builtin_amdgcn_readfirstlane(col >> 6), d = col & 63, seg = __builtin_amdgcn_readfirstlane(tid >> 7);
#pragma unroll
    for (int j = 0; j < 16; ++j) lf[j] = RAW[dir * 64 * BCS + (16 * seg + j) * BCS + d];
    if (dir == 0) { float c = 0.f;
#pragma unroll
        for (int j = 0; j < 16; ++j) { c += lf[j]; bc[j] = c; } }
    else { float c = 0.f;
#pragma unroll
        for (int j = 15; j >= 0; --j) { c += lf[j]; bc[j] = c; } }
    XCH[seg * 128 + col] = dir == 0 ? bc[15] : bc[0];
    __syncthreads();
    const float t0 = XCH[col], t1 = XCH[128 + col], t2 = XCH[256 + col], t3 = XCH[384 + col];
    total = (t0 + t1) + (t2 + t3);
    float off;
    if (dir == 0) off = seg == 0 ? 0.f : (seg == 1 ? t0 : (seg == 2 ? t0 + t1 : t0 + t1 + t2));
    else off = seg == 3 ? 0.f : (seg == 2 ? t3 : (seg == 1 ? t3 + t2 : t3 + t2 + t1));
#pragma unroll
    for (int j = 0; j < 16; ++j) bc[j] += off;
}
__device__ __forceinline__ void scan_s1_unit(LAS char* lds, const ScanArgs& a, int wv0, int b, int h, int k, bool hasnext, int nb, int nh, int nk) {
    const int tid = opaque_tid(wv0), lane = tid & 63, wid = __builtin_amdgcn_readfirstlane(tid >> 6);
    LAS bf16_t* VT = (LAS bf16_t*)(lds + SC_VT); LAS bf16_t* KKT = (LAS bf16_t*)(lds + SC_A); LAS float* XCH = (LAS float*)(lds + SC_A + 18432);
    const size_t row0 = (size_t)b * RPB + 64 * k - a.in_off;
    __syncthreads();
    float lf[16], bc[16], total; scan_cumsum(lds, XCH, tid, lf, bc, total);
    const int col = tid & 127, dir = __builtin_amdgcn_readfirstlane(col >> 6), d = col & 63, seg = __builtin_amdgcn_readfirstlane(tid >> 7);
    const size_t sidx = ((size_t)((b * 8 + h) * 2 + dir)) * NCHK + k;
    { unsigned w[8];
#pragma unroll
      for (int j = 0; j < 16; j += 2) { const float k0 = (1.f - fexp(lf[j])) * fexp(total - bc[j]), k1 = (1.f - fexp(lf[j + 1])) * fexp(total - bc[j + 1]); w[j >> 1] = pkbf(k0, k1); }
      LAS u32x4* kp = (LAS u32x4*)(KKT + (dir * 64 + d) * 72 + 16 * seg); kp[0] = (u32x4){w[0], w[1], w[2], w[3]}; kp[1] = (u32x4){w[4], w[5], w[6], w[7]};
      if (seg == 0) a.DS[sidx * 64 + d] = fexp(total); }
    __syncthreads();
    StageRegs R; if (hasnext) scan_stage_load(a, (size_t)nb * RPB + 64 * nk - a.in_off, nh, tid, R);
    { const int wdir = wid >> 2, et = wid & 3, fr = lane & 15, fq = lane >> 4;
      f32x4 acc[4];
#pragma unroll
      for (int dt = 0; dt < 4; ++dt) acc[dt] = (f32x4){0.f, 0.f, 0.f, 0.f};
#pragma unroll
      for (int ks = 0; ks < 2; ++ks) { const bf16x8 af = *(const LAS bf16x8*)(VT + (16 * et + fr) * 72 + 32 * ks + 8 * fq);
#pragma unroll
          for (int dt = 0; dt < 4; ++dt) { const bf16x8 bfv = *(const LAS bf16x8*)(KKT + (wdir * 64 + 16 * dt + fr) * 72 + 32 * ks + 8 * fq); acc[dt] = MFMA16(bfv, af, acc[dt]); } }
      bf16_t* sp = a.ST + (((size_t)((b * 8 + h) * 2 + wdir)) * NCHK + k) * 4096;
#pragma unroll
      for (int dt = 0; dt < 4; ++dt) *(uint2*)(sp + (16 * et + fr) * 64 + 16 * dt + 4 * fq) = make_uint2(pkbf(acc[dt][0], acc[dt][1]), pkbf(acc[dt][2], acc[dt][3])); }
    __syncthreads();
    if (hasnext) scan_stage_store(lds, tid, R);
}
__device__ __forceinline__ void scan_s2_task(const ScanArgs& a, int wv0, int task) {
    const int chain = task >> 2, quarter = task & 3, dir = chain & 1, tid = opaque_tid(wv0);
    const int e = 16 * quarter + (tid >> 5), d = 2 * (tid & 31);
    float s0 = 0.f, s1 = 0.f;
    for (int g = 0; g < NCHK; g += 12) {
        unsigned L[12]; float2 Dv[12]; unsigned* pp[12];
#pragma unroll
        for (int j = 0; j < 12; ++j) { const int step = g + j; const int k = dir == 0 ? (step < 4 ? 128 + step : step - 4) : (step < 4 ? 131 - step : 131 - step);
            const size_t idx = (size_t)chain * NCHK + k; pp[j] = (unsigned*)(a.ST + idx * 4096 + e * 64 + d); L[j] = *pp[j]; Dv[j] = *(const float2*)(a.DS + idx * 64 + d); }
#pragma unroll
        for (int j = 0; j < 12; ++j) { *pp[j] = pkbf(s0, s1); s0 = Dv[j].x * s0 + bflo(L[j]); s1 = Dv[j].y * s1 + bfhi(L[j]); }
    }
}
__device__ __forceinline__ void s3_state_load(const ScanArgs& a, int b, int h, int k, int tid, u32x4& s0, u32x4& s1) {
    const int sd = tid >> 8, e = (tid & 255) >> 2, c16 = (tid & 3) * 16; const bf16_t* sp = a.ST + (((size_t)((b * 8 + h) * 2 + sd)) * NCHK + k) * 4096 + e * 64 + c16; s0 = *(const u32x4*)sp; s1 = *(const u32x4*)(sp + 8); }
__device__ __forceinline__ void s3_state_store(LAS bf16_t* STL, int tid, const u32x4& s0, const u32x4& s1) {
    const int sd = tid >> 8, e = (tid & 255) >> 2, c16 = (tid & 3) * 16; LAS u32x4* dp = (LAS u32x4*)(STL + (sd * 64 + e) * 72 + c16); dp[0] = s0; dp[1] = s1; }
__device__ __forceinline__ void scan_s3_unit(LAS char* lds, const ScanArgs& a, int wv0, int b, int h, int k, bool hasnext, int nb, int nh, int nk) {
    const int tid = opaque_tid(wv0), lane = tid & 63, wid = __builtin_amdgcn_readfirstlane(tid >> 6);
    LAS float* BC = (LAS float*)(lds + SC_RAW); LAS bf16_t* VT = (LAS bf16_t*)(lds + SC_VT);
    LAS bf16_t* STL = (LAS bf16_t*)(lds + SC_A);
    LAS float* XCH = (LAS float*)(lds + SC_A + 18432);
    LAS float* OSUM = (LAS float*)(lds + SC_A + 18432 + 2048);
    LAS bf16_t* PW = (LAS bf16_t*)(lds + SC_A + 18432 + 2048 + 17408) + wid * 3456;
    const size_t row0 = (size_t)b * RPB + 64 * k - a.in_off;
    bf16x8 q0_, q1_; uint2 gp[4];
    { const int dir_ = wid >> 2, si_ = wid & 3, erow_ = lane >> 2, dg_ = (lane & 3) * 16, fr_ = lane & 15, fq_ = lane >> 4;
      const bf16_t* qp = a.BQ + (row0 + 16 * si_ + erow_) * 512 + h * 64 + dg_; q0_ = *(const bf16x8*)qp; q1_ = *(const bf16x8*)(qp + 8);
#pragma unroll
      for (int n = 0; n < 4; ++n) { gp[n] = make_uint2(0u, 0u); if (dir_ == 1) gp[n] = *(const uint2*)(a.BG + (row0 + 16 * si_ + fr_) * 512 + h * 64 + 16 * n + 4 * fq_); } }
    __syncthreads();
    { float lf[16], bc[16], total; scan_cumsum(lds, XCH, tid, lf, bc, total);
      const int col = tid & 127, dir = __builtin_amdgcn_readfirstlane(col >> 6), d = col & 63, seg = __builtin_amdgcn_readfirstlane(tid >> 7);
      __syncthreads();
#pragma unroll
      for (int j = 0; j < 16; ++j) BC[dir * 64 * BCS + (16 * seg + j) * BCS + d] = bc[j]; }
    __syncthreads();
    StageRegs Rn; u32x4 ns0, ns1;
    if (hasnext) { scan_stage_load(a, (size_t)nb * RPB + 64 * nk - a.in_off, nh, tid, Rn); s3_state_load(a, nb, nh, nk, tid, ns0, ns1); }
    const int dir = wid >> 2, si = wid & 3;
    LAS bf16_t* QP = PW; LAS bf16_t* KP = PW + 1152; LAS bf16_t* ATT = PW + 2304;
    const int erow = lane >> 2, dg = (lane & 3) * 16;
    const int fr = lane & 15, fq = lane >> 4;
    LAS const float* bcd = BC + dir * 64 * BCS;
    float refv[16];
    { const int rr = dir == 0 ? 16 * si - 1 : 16 * (si + 1);
#pragma unroll
      for (int j = 0; j < 16; j += 4) { f32x4 t4 = (f32x4){0.f, 0.f, 0.f, 0.f}; if (rr >= 0 && rr < 64) t4 = *(const LAS f32x4*)(bcd + rr * BCS + dg + j); refv[j] = t4[0]; refv[j + 1] = t4[1]; refv[j + 2] = t4[2]; refv[j + 3] = t4[3]; } }
    float qv[16], bq[16];
    {
#pragma unroll
      for (int j = 0; j < 8; ++j) { qv[j] = bf2f((bf16_t)q0_[j]); qv[8 + j] = bf2f((bf16_t)q1_[j]); }
#pragma unroll
      for (int j = 0; j < 16; j += 4) { const f32x4 t4 = *(const LAS f32x4*)(bcd + (16 * si + erow) * BCS + dg + j); bq[j] = t4[0]; bq[j + 1] = t4[1]; bq[j + 2] = t4[2]; bq[j + 3] = t4[3]; } }
    { unsigned w[8];
#pragma unroll
      for (int j = 0; j < 16; j += 2) w[j >> 1] = pkbf(qv[j] * fexp(bq[j] - refv[j]), qv[j + 1] * fexp(bq[j + 1] - refv[j + 1]));
      LAS u32x4* p = (LAS u32x4*)(QP + erow * 72 + dg); p[0] = (u32x4){w[0], w[1], w[2], w[3]}; p[1] = (u32x4){w[4], w[5], w[6], w[7]};
      LAS u32x4* z = (LAS u32x4*)(ATT + erow * 72 + dg); z[0] = (u32x4){0u, 0u, 0u, 0u}; z[1] = (u32x4){0u, 0u, 0u, 0u}; }
    const int j_lo = dir == 0 ? 0 : si, j_hi = dir == 0 ? si : 3;
    for (int jb = j_lo; jb <= j_hi; ++jb) {
        { const int sg = 16 * jb + erow; const int sn = dir == 0 ? sg - 1 : sg + 1; unsigned w[8];
#pragma unroll
          for (int j = 0; j < 16; j += 4) { const f32x4 bs4 = *(const LAS f32x4*)(bcd + sg * BCS + dg + j); f32x4 bn4 = (f32x4){0.f, 0.f, 0.f, 0.f}; if (sn >= 0 && sn < 64) bn4 = *(const LAS f32x4*)(bcd + sn * BCS + dg + j);
              float kk[4];
#pragma unroll
              for (int t = 0; t < 4; ++t) kk[t] = (1.f - fexp(bs4[t] - bn4[t])) * fexp(fminf(refv[j + t] - bs4[t], 60.f));
              w[j >> 1] = pkbf(kk[0], kk[1]); w[(j >> 1) + 1] = pkbf(kk[2], kk[3]); }
          LAS u32x4* p = (LAS u32x4*)(KP + erow * 72 + dg); p[0] = (u32x4){w[0], w[1], w[2], w[3]}; p[1] = (u32x4){w[4], w[5], w[6], w[7]}; }
        __builtin_amdgcn_wave_barrier(); asm volatile("s_waitcnt lgkmcnt(0)" ::: "memory");
        f32x4 c = (f32x4){0.f, 0.f, 0.f, 0.f};
#pragma unroll
        for (int ks = 0; ks < 2; ++ks) { const bf16x8 af = *(const LAS bf16x8*)(QP + fr * 72 + 32 * ks + 8 * fq), bfv = *(const LAS bf16x8*)(KP + fr * 72 + 32 * ks + 8 * fq); c = MFMA16(bfv, af, c); }
        { const bool diag = (jb == si);
          float v4[4];
#pragma unroll
          for (int r = 0; r < 4; ++r) { const int kq = 4 * fq + r; const bool mk = diag & (dir == 0 ? (kq > fr) : (kq < fr)); v4[r] = mk ? 0.f : c[r]; }
          typedef unsigned u32x2v_ __attribute__((ext_vector_type(2))); *(LAS u32x2v_*)(ATT + fr * 72 + 16 * jb + 4 * fq) = (u32x2v_){pkbf(v4[0], v4[1]), pkbf(v4[2], v4[3])}; }
        __builtin_amdgcn_wave_barrier(); asm volatile("s_waitcnt lgkmcnt(0)" ::: "memory");
    }
    { unsigned w[8];
#pragma unroll
      for (int j = 0; j < 16; j += 2) w[j >> 1] = pkbf(qv[j] * fexp(bq[j]), qv[j + 1] * fexp(bq[j + 1]));
      LAS u32x4* p = (LAS u32x4*)(QP + erow * 72 + dg); p[0] = (u32x4){w[0], w[1], w[2], w[3]}; p[1] = (u32x4){w[4], w[5], w[6], w[7]}; }
    __builtin_amdgcn_wave_barrier(); asm volatile("s_waitcnt lgkmcnt(0)" ::: "memory");
    f32x4 o[4];
#pragma unroll
    for (int n = 0; n < 4; ++n) o[n] = (f32x4){0.f, 0.f, 0.f, 0.f};
#pragma unroll
    for (int ks = 0; ks < 2; ++ks) { const bf16x8 aq = *(const LAS bf16x8*)(QP + fr * 72 + 32 * ks + 8 * fq), aa = *(const LAS bf16x8*)(ATT + fr * 72 + 32 * ks + 8 * fq);
#pragma unroll
        for (int n = 0; n < 4; ++n) { const bf16x8 bs = *(const LAS bf16x8*)(STL + (dir * 64 + 16 * n + fr) * 72 + 32 * ks + 8 * fq), bv = *(const LAS bf16x8*)(VT + (16 * n + fr) * 72 + 32 * ks + 8 * fq);
            o[n] = MFMA16(bs, aq, o[n]); o[n] = MFMA16(bv, aa, o[n]); } }
    if (dir == 0) {
#pragma unroll
        for (int n = 0; n < 4; ++n) *(LAS f32x4*)(OSUM + (16 * si + fr) * 68 + 16 * n + 4 * fq) = o[n]; }
    __syncthreads();
    if (hasnext) { scan_stage_store(lds, tid, Rn); s3_state_store(STL, tid, ns0, ns1); }
    if (dir == 1) {
        const bool wr_out = !(a.skipctx_out && k >= 128) && !a.pad;
        float ss = 0.f;
#pragma unroll
        for (int n = 0; n < 4; ++n) { o[n] += *(const LAS f32x4*)(OSUM + (16 * si + fr) * 68 + 16 * n + 4 * fq); ss += o[n][0] * o[n][0] + o[n][1] * o[n][1] + o[n][2] * o[n][2] + o[n][3] * o[n][3]; }
        ss += shxl(ss, 16, lane); ss += shxl(ss, 32, lane); const float rn = rsqrtf(ss * (1.f / 64.f) + EPS);
        if (wr_out) {
            const size_t orow0 = (size_t)b * RPB + 64 * k - a.out_off;
#pragma unroll
            for (int n = 0; n < 4; ++n) { const f32x4 g4 = *(const f32x4*)(a.gn + h * 64 + 16 * n + 4 * fq);
                const float gv0 = bflo(gp[n].x), gv1 = bfhi(gp[n].x), gv2 = bflo(gp[n].y), gv3 = bfhi(gp[n].y);
                const float y0 = o[n][0] * rn * g4[0] * gv0 * fsigmoid(gv0), y1 = o[n][1] * rn * g4[1] * gv1 * fsigmoid(gv1), y2 = o[n][2] * rn * g4[2] * gv2 * fsigmoid(gv2), y3 = o[n][3] * rn * g4[3] * gv3 * fsigmoid(gv3);
                *(uint2*)(a.OB + (orow0 + 16 * si + fr) * 512 + h * 64 + 16 * n + 4 * fq) = make_uint2(pkbf(y0, y1), pkbf(y2, y3)); }
        }
    }
    __syncthreads();
}
constexpr int SCAN_LDS = SC_A + 18432 + 2048 + 17408 + 8 * 6912;

#define XB_TMO      128
#define XB_XCNT(j)  (256  + 64 * (j))
#define XB_XSUB(j)  (1280 + 64 * (j))
#define XB_XGEN(j)  (2304 + 64 * (j))
#define XB_TOP      3328
#define XB_TOPGEN   3392
#define XCD_BAR_WORDS 3456
#define XB_SPIN_CAP (1u << 18)

__device__ __forceinline__ unsigned xb_ld(unsigned* p)              { return __hip_atomic_load(p, __ATOMIC_RELAXED, __HIP_MEMORY_SCOPE_AGENT); }
__device__ __forceinline__ unsigned xb_add(unsigned* p, unsigned v) { return __hip_atomic_fetch_add(p, v, __ATOMIC_RELAXED, __HIP_MEMORY_SCOPE_AGENT); }
__device__ __forceinline__ unsigned xb_xcc_id() { return (unsigned)__builtin_amdgcn_s_getreg((3 << 11) | 20) & 0xFu; }
#define XB_SPIN(cond, bar) do { unsigned _sp = 0; while (cond) { __builtin_amdgcn_s_sleep(1); \
    if ((++_sp & 255u) == 0u) { if (xb_ld(&(bar)[XB_TMO])) break; if (_sp > XB_SPIN_CAP) { atomicAdd(&(bar)[XB_TMO], 1u); break; } } } } while (0)

struct XcdBarrier {
    unsigned* bar; unsigned x;
    volatile LAS unsigned* st;
};

__device__ __forceinline__ XcdBarrier xcd_barrier_post(unsigned* bar, volatile LAS unsigned* st) {
    XcdBarrier b; b.bar = bar; b.x = xb_xcc_id(); b.st = st;
    if (threadIdx.x == 0) (void)xb_add(&bar[XB_XCNT(b.x)], 1u);
    return b;
}
__device__ __forceinline__ void xcd_barrier_complete(unsigned* bar, unsigned x, unsigned& nloc, unsigned& nx) {
    const unsigned G = gridDim.x * gridDim.y * gridDim.z;
    unsigned sum, cnt, mine, sp = 0u;
    for (;;) {
        sum = 0u; cnt = 0u; mine = 0u;
#pragma unroll
        for (unsigned j = 0; j < 16; ++j) { const unsigned c = xb_ld(&bar[XB_XCNT(j)]); sum += c; cnt += (c > 0u) ? 1u : 0u; mine = (j == x) ? c : mine; }
        if (sum == G) break;
        __builtin_amdgcn_s_sleep(1);
        if ((++sp & 255u) == 0u) { if (xb_ld(&bar[XB_TMO])) break; if (sp > XB_SPIN_CAP) { atomicAdd(&bar[XB_TMO], 1u); break; } }
    }
    nloc = mine > 0u ? mine : 1u; nx = cnt > 0u ? cnt : 1u;
}

__device__ __forceinline__ void xcd_barrier(const XcdBarrier& b) {
    asm volatile("s_waitcnt vmcnt(0)" ::: "memory");
    __syncthreads();
    if (threadIdx.x == 0) {
        unsigned* bar = b.bar;
        __builtin_amdgcn_s_waitcnt(0);
        unsigned nloc = b.st[0], nx = b.st[1];
        if (nloc == 0u) { xcd_barrier_complete(bar, b.x, nloc, nx); b.st[0] = nloc; b.st[1] = nx; }
        const unsigned old = xb_add(&bar[XB_XSUB(b.x)], 1u);
        const unsigned gen = old / nloc;
        if (old + 1u == (gen + 1u) * nloc) {
            __builtin_amdgcn_fence(__ATOMIC_RELEASE, "agent");
            asm volatile("s_waitcnt vmcnt(0)" ::: "memory");
            const unsigned og = xb_add(&bar[XB_TOP], 1u);
            const unsigned tg = og / nx;
            if (og + 1u == (tg + 1u) * nx) xb_add(&bar[XB_TOPGEN], 1u);
            else XB_SPIN(xb_ld(&bar[XB_TOPGEN]) == tg, bar);
            __builtin_amdgcn_fence(__ATOMIC_ACQUIRE, "agent");
            xb_add(&bar[XB_XGEN(b.x)], 1u);
            asm volatile("s_waitcnt vmcnt(0)" ::: "memory");
        } else {
            XB_SPIN(xb_ld(&bar[XB_XGEN(b.x)]) == gen, bar);
            __builtin_amdgcn_fence(__ATOMIC_ACQUIRE, "agent");
            asm volatile("s_waitcnt vmcnt(0)" ::: "memory");
        }
    }
    __syncthreads();
}


constexpr size_t MiB = 1u << 20;
constexpr size_t CTL_ZERO_BYTES = 64 * 1024;
constexpr int CW_COUNTS = 8192, CW_CURSOR = 8192 + 128;
constexpr size_t O_MOD = 1 * MiB, O_LB = 1 * MiB + 512 * 1024, O_ROPA_C = 2 * MiB, O_ROPA_S = 3 * MiB, O_ROPC_C = 4 * MiB, O_ROPC_S = 4 * MiB + 512 * 1024, O_XC = 5 * MiB;
constexpr size_t O_ROUTE_E = 9 * MiB, O_ROUTE_W = 9 * MiB + 512 * 1024, O_PERM = 10 * MiB, O_POSW = 10 * MiB + 512 * 1024, O_GOFF = 11 * MiB, O_TILEE = 11 * MiB + 512 * 1024;
constexpr size_t O_WRT = 11 * MiB + 640 * 1024;
constexpr size_t O_RS = 12 * MiB, O_DS = 13 * MiB + 512 * 1024, O_WGH = 15 * MiB + 768 * 1024;
constexpr size_t O_WINP = 16 * MiB, O_WC = 30 * MiB, O_WBR = 32 * MiB, O_WOUT = 35 * MiB;
constexpr size_t O_H = 38 * MiB;
constexpr size_t O_AQ = 104 * MiB, O_AK = 137 * MiB, O_AV = 145 * MiB + 512 * 1024;
constexpr size_t O_BQ = 154 * MiB, O_BV = 187 * MiB, O_BG = 220 * MiB, O_BLF = 253 * MiB, O_BLB = 286 * MiB;
constexpr size_t O_CQKV = 319 * MiB, O_CKR = 344 * MiB, O_CQ = 347 * MiB, O_CKV = 397 * MiB, O_OC = 463 * MiB, O_WRB = 496 * MiB, WS_END = 497 * MiB;
constexpr size_t O_GATE = 187 * MiB;
constexpr size_t O_YM2 = 154 * MiB, O_AUP = 104 * MiB, O_WUP = 397 * MiB, O_WDN = 429 * MiB;
constexpr int LDS_BYTES = 163840, LDS_BAR_OFF = LDS_BYTES - 64, LDS_PTR_OFF = LDS_BYTES - 512;

struct KP { const float* in[24]; float* out; char* ws; int ph_lo, ph_hi; unsigned long long mask; };
struct Frame {
    LAS char* lds; char* ws; float* out; int wv0;
};
#define WSP(T, off) ((T*)(F.ws + (off)))
__device__ __forceinline__ const float* in_ptr(const Frame& F, int k) { const volatile LAS unsigned* q = (const volatile LAS unsigned*)(F.lds + LDS_PTR_OFF + 8 * k);
    unsigned lo = q[0], hi = q[1]; lo = __builtin_amdgcn_readfirstlane(lo); hi = __builtin_amdgcn_readfirstlane(hi); return (const float*)(((unsigned long long)hi << 32) | lo); }
#define INP(k) in_ptr(F, k)
__device__ __forceinline__ float wave_sum_dpp(float v) {
    int x = __builtin_bit_cast(int, v);
#define DPP_ADD(ctrl, rmask) x = __builtin_bit_cast(int, __builtin_bit_cast(float, x) + __builtin_bit_cast(float, __builtin_amdgcn_update_dpp(0, x, ctrl, rmask, 0xF, false)))
    DPP_ADD(0xB1, 0xF);
    DPP_ADD(0x4E, 0xF);
    DPP_ADD(0x141, 0xF);
    DPP_ADD(0x140, 0xF);
    DPP_ADD(0x142, 0xA);
    DPP_ADD(0x143, 0xC);
#undef DPP_ADD
    return __builtin_bit_cast(float, __builtin_amdgcn_readlane(x, 63));
}
__device__ __forceinline__ float wave_sum(float v) {
#pragma unroll
    for (int o = 32; o >= 1; o >>= 1) v += __shfl_xor(v, o);
    return v;
}

__device__ __forceinline__ void p0_mod(const Frame& F) {
    const int tid = opaque_tid(F.wv0), lane = tid & 63, wave = __builtin_amdgcn_readfirstlane(tid >> 6); (void)lane; (void)wave;
    LAS float* sc = (LAS float*)F.lds;
    LAS float* red = (LAS float*)(F.lds + 20480);
    for (int i = tid; i < 5 * 1024; i += 512) { const int r = i >> 10, k = i & 1023; const float v = r < 4 ? INP(1)[r * 1024 + k] : INP(3)[k]; sc[i] = v / (1.f + expf(-v)); }
    __syncthreads();
    float* MOD = WSP(float, O_MOD);
    for (int u = blockIdx.x; u < 2 * 96; u += gridDim.x) { const int l = u / 96, j = (u % 96) * 64 + lane;
        const float* w = INP(4) + (size_t)l * 1024 * 6144 + j; float a0 = 0.f, a1 = 0.f, a2 = 0.f, a3 = 0.f, a4 = 0.f;
#pragma unroll 32
        for (int kk = 0; kk < 128; ++kk) { const int k = wave * 128 + kk; const float wv = w[(size_t)k * 6144]; a0 += sc[k] * wv; a1 += sc[1024 + k] * wv; a2 += sc[2048 + k] * wv; a3 += sc[3072 + k] * wv; a4 += sc[4096 + k] * wv; }
        red[(wave * 5 + 0) * 64 + lane] = a0; red[(wave * 5 + 1) * 64 + lane] = a1; red[(wave * 5 + 2) * 64 + lane] = a2; red[(wave * 5 + 3) * 64 + lane] = a3; red[(wave * 5 + 4) * 64 + lane] = a4;
        __syncthreads();
        if (tid < 320) { const int r = tid >> 6, ln = tid & 63; float s = 0.f;
#pragma unroll
            for (int w8 = 0; w8 < 8; ++w8) s += red[(w8 * 5 + r) * 64 + ln];
            const int jj = (u % 96) * 64 + ln; MOD[(size_t)(l * 5 + r) * 6144 + jj] = s + INP(5)[l * 6144 + jj]; }
        __syncthreads();
    }
}
__device__ __forceinline__ void p0_tables(const Frame& F) {
    const int tid = opaque_tid(F.wv0), lane = tid & 63, wave = __builtin_amdgcn_readfirstlane(tid >> 6); (void)lane; (void)wave;
    float* ropa_c = WSP(float, O_ROPA_C); float* ropa_s = WSP(float, O_ROPA_S); float* ropc_c = WSP(float, O_ROPC_C); float* ropc_s = WSP(float, O_ROPC_S); float* LB = WSP(float, O_LB);
    for (int i = blockIdx.x * 512 + tid; i < 8192 * 32; i += gridDim.x * 512) {
        { const int t = i >> 5, j = i & 31, row = t >> 6, col = t & 63, f = j & 15; const float inv = powf(10000.f, -(float)f / 16.f); const float ang = (j < 16 ? (float)row : (float)col) * inv;
          ropa_c[i] = cosf(ang); ropa_s[i] = sinf(ang); }
        if (i < 8192 * 16) { const int t = i >> 4, j = i & 15, row = t >> 6, col = t & 63, f = j & 7; const float inv = powf(10000.f, -(float)f / 8.f); const float ang = (j < 8 ? (float)row : (float)col) * inv;
          ropc_c[i] = cosf(ang); ropc_s[i] = sinf(ang); }
        for (int i2 = i; i2 < 2 * 256 * 1024; i2 += 8192 * 32) { const int l = i2 >> 18, pp = (i2 >> 10) & 255, k = i2 & 1023;
          const int bj = pp >> 7, wc = (pp >> 5) & 3, n = (pp >> 4) & 1, fq = (pp >> 2) & 3, e = pp & 3; float v = 0.f;
          if (wc == 0) { if (bj == 0) v = INP(19)[(size_t)l * 1024 * 32 + k * 32 + fq * 8 + 4 * n + e]; else if (n == 0 && e == 0) v = INP(18)[(size_t)l * 1024 * 4 + k * 4 + fq]; }
          WSP(bf16_t, O_WRB)[i2] = f2bf(v); }
        if (i < 2048) { const int l = i >> 10, rest = i & 1023; if (l == 0) LB[i] = 0.f; else { const float a0 = INP(10)[rest], a1 = INP(10)[1024 + rest]; LB[i] = 1.f / (1.f + expf(a0 - a1)); } }
    }
}
template <class CM> __device__ __forceinline__ void wt_tile(const float* W, int ldw, const CM& cm, bf16_t* Bt, int K, int p0, int k0, LAS float* scr, int lane) {
    const int p4 = (lane & 7) * 4; const int c = cm(p0 + p4);
#pragma unroll
    for (int i = 0; i < 8; ++i) { const int kk = i * 8 + (lane >> 3); f32x4 v = (f32x4){0.f, 0.f, 0.f, 0.f};
        if (c >= 0) v = *(const f32x4*)(W + (size_t)(k0 + kk) * ldw + c);
        scr[kk * 33 + p4] = v[0]; scr[kk * 33 + p4 + 1] = v[1]; scr[kk * 33 + p4 + 2] = v[2]; scr[kk * 33 + p4 + 3] = v[3]; }
    asm volatile("s_waitcnt lgkmcnt(0)" ::: "memory"); __builtin_amdgcn_wave_barrier();
#pragma unroll 8
    for (int pi = 0; pi < 32; ++pi) Bt[(size_t)(p0 + pi) * K + k0 + lane] = f2bf(scr[lane * 33 + pi]);
    asm volatile("s_waitcnt lgkmcnt(0)" ::: "memory"); __builtin_amdgcn_wave_barrier();
}
struct WtDesc { const float* src; size_t ldw8; bf16_t* dst; int K; float keep; };
template <class CM> __device__ __forceinline__ WtDesc wt_desc(const float* W, int ldw, const CM& cm, bf16_t* Bt, int K, int p0, int k0, int lane) {
    const int p4 = (lane & 7) * 4; const int c = cm(p0 + p4); WtDesc d; d.src = W + (size_t)(k0 + (lane >> 3)) * ldw + (c >= 0 ? c : 0); d.keep = c >= 0 ? 1.f : 0.f;        d.ldw8 = (size_t)ldw * 8; d.dst = Bt + (size_t)p0 * K + k0; d.K = K; return d; }
__device__ __forceinline__ void wt_load(const WtDesc& d, f32x4 (&v)[8]) {
#pragma unroll
    for (int i = 0; i < 8; ++i) { typedef const f32x4 __attribute__((address_space(1))) gf32x4_; v[i] = *(gf32x4_*)(d.src + (size_t)i * d.ldw8) * d.keep; } }
__device__ __forceinline__ void wt_store(const WtDesc& d, const f32x4 (&v)[8], LAS float* scr, int lane) {
    const int p4 = (lane & 7) * 4;
#pragma unroll
    for (int i = 0; i < 8; ++i) { const int kk = i * 8 + (lane >> 3); scr[kk * 33 + p4] = v[i][0]; scr[kk * 33 + p4 + 1] = v[i][1]; scr[kk * 33 + p4 + 2] = v[i][2]; scr[kk * 33 + p4 + 3] = v[i][3]; }
    asm volatile("s_waitcnt lgkmcnt(0)" ::: "memory"); __builtin_amdgcn_wave_barrier();
    const int p = lane >> 1, kh = (lane & 1) * 32; bf16_t* o = d.dst + (size_t)p * d.K + kh;
#pragma unroll
    for (int s4 = 0; s4 < 4; ++s4) { const LAS float* r = scr + (kh + s4 * 8) * 33 + p;
        u32x4 w; w.x = pkbf(r[0], r[33]); w.y = pkbf(r[66], r[99]); w.z = pkbf(r[132], r[165]); w.w = pkbf(r[198], r[231]); *(u32x4*)(o + s4 * 8) = w; }
    asm volatile("s_waitcnt lgkmcnt(0)" ::: "memory"); __builtin_amdgcn_wave_barrier();
}
template <class Dec> __device__ __forceinline__ void wt_run(const Dec& dec, int first, int total, int stride, LAS float* scr, int lane) {
    if (first >= total) return;
    WtDesc cur = dec(first); f32x4 va[8]; wt_load(cur, va);
    for (int it = first; it < total; it += stride) { const int nx = it + stride; const bool hn = nx < total; WtDesc nxt = cur; f32x4 vb[8];
        if (hn) { nxt = dec(nx); wt_load(nxt, vb); }
        wt_store(cur, va, scr, lane);
        if (hn) { cur = nxt;
#pragma unroll
            for (int i = 0; i < 8; ++i) va[i] = vb[i]; } }
}
struct CmWin { __device__ __forceinline__ int operator()(int p) const { return colmap(MAP_WIN, p); } };
struct CmId { __device__ __forceinline__ int operator()(int p) const { return p; } };
__device__ __forceinline__ void conv_weights_nonmoe(const Frame& F, int l) {
    const int tid = opaque_tid(F.wv0), lane = tid & 63, wave = __builtin_amdgcn_readfirstlane(tid >> 6); (void)lane; (void)wave;
    LAS float* scr = (LAS float*)F.lds + wave * (64 * 33);
    const int gw = blockIdx.x * 8 + wave, NGW = gridDim.x * 8;
    constexpr int I_WIN = 216 * 16, I_BR = 3 * 32 * 8, I_OUT = 32 * 16;
    { const float* w_in = INP(8) + (size_t)l * 1024 * INW; const float* w_br = INP(16) + (size_t)l * 3 * 512 * 1024; const float* w_out = INP(17) + (size_t)l * 1024 * 1024; const Frame* Fp = &F;
      auto dec = [=](int it) -> WtDesc { const Frame& F = *Fp; int r = it;
          if (r < I_WIN) return wt_desc(w_in, INW, CmWin(), WSP(bf16_t, O_WINP), 1024, (r / 16) * 32, (r % 16) * 64, lane); r -= I_WIN;
          if (r < I_BR) { const int n = r / 256, q = r % 256; return wt_desc(w_br + (size_t)n * 512 * 1024, 1024, CmId(), WSP(bf16_t, O_WBR) + (size_t)n * 1024 * 512, 512, (q / 8) * 32, (q % 8) * 64, lane); } r -= I_BR;
          return wt_desc(w_out, 1024, CmId(), WSP(bf16_t, O_WOUT), 1024, (r / 16) * 32, (r % 16) * 64, lane); };
      wt_run(dec, gw, I_WIN + I_BR + I_OUT, NGW, scr, lane); }
    const float* wuq = INP(14) + (size_t)l * 256 * 768; const float* wukv = INP(15) + (size_t)l * 128 * 1024; const float* gq = INP(12) + l * 256; const float* gkv = INP(13) + l * 128; bf16_t* WC = WSP(bf16_t, O_WC);
    for (int i = blockIdx.x * 512 + tid; i < 1792 * 384; i += gridDim.x * 512) {
        const int pp = i / 384, k = i % 384; float v = 0.f;
        if (pp < 768) { const int pn = pp >> 8, q = pp & 255, bj = q >> 7, wc = (q >> 5) & 3, j = q & 31; const int gi = pn * 8 + bj * 4 + wc, head = gi / 3, part = gi - head * 3;
            const int p = part < 2 ? head * 96 + part * 32 + j : head * 96 + 64 + 16 * ((j >> 2) & 1) + 4 * (j >> 3) + (j & 3);
            if (k < 256) v = wuq[k * 768 + p] * gq[k]; }
        else { if (k >= 256) v = wukv[(k - 256) * 1024 + (pp - 768)] * gkv[k - 256]; }
        WC[i] = f2bf(v); }
}
struct CmUp { __device__ __forceinline__ int operator()(int p) const { return ((p >> 8) << 7) + (p & 127); } };
__device__ __forceinline__ void conv_weights_moe(const Frame& F, int l, int nbusy, int bextra, bool skipA, int rankA, int nskipA) {
    const int tid = opaque_tid(F.wv0), lane = tid & 63, wave = __builtin_amdgcn_readfirstlane(tid >> 6); (void)lane; (void)wave;
    LAS float* scr = (LAS float*)F.lds + wave * (64 * 33);
    const int gw = blockIdx.x * 8 + wave, NGW = gridDim.x * 8;
    constexpr int I_UP = 32 * 16 * 16, I_DN = 32 * 32 * 4;
    { const float* w1 = INP(20) + (size_t)l * 32 * 1024 * 256; const float* w3 = INP(21) + (size_t)l * 32 * 1024 * 256; const float* w2 = INP(22) + (size_t)l * 32 * 256 * 1024; const Frame* Fp = &F;
      auto dec = [=](int it) -> WtDesc { const Frame& F = *Fp; int r = it;
          if (r < I_UP) { const int e = r / 256, q = r % 256, p0 = (q / 16) * 32, k0 = (q % 16) * 64; const bool isw3 = (p0 >> 7) & 1;
              return wt_desc((isw3 ? w3 : w1) + (size_t)e * 1024 * 256, 256, CmUp(), WSP(bf16_t, O_WUP) + (size_t)e * 512 * 1024, 1024, p0, k0, lane); } r -= I_UP;
          const int e = r / 128, q = r % 128; return wt_desc(w2 + (size_t)e * 256 * 1024, 1024, CmId(), WSP(bf16_t, O_WDN) + (size_t)e * 1024 * 256, 256, (q / 4) * 32, (q % 4) * 64, lane); };
      const int nfree = (int)gridDim.x - nbusy; const int B_ = (nbusy > 0 && nfree > 0) ? bextra : 0, A_ = I_UP + I_DN - B_;
      if (!skipA) wt_run(dec, ((int)blockIdx.x - rankA) * 8 + wave, A_, ((int)gridDim.x - nskipA) * 8, scr, lane);
      if (B_ > 0 && (int)blockIdx.x >= nbusy) wt_run(dec, A_ + ((int)blockIdx.x - nbusy) * 8 + wave, I_UP + I_DN, nfree * 8, scr, lane); }
}

__device__ __forceinline__ void rp_load(const float* xs, float* xd, bool wx, const bf16_t* ym, const float* gt, int lane, f32x4 (&v)[4], float& rinv) {
    float ss = 0.f;
#pragma unroll
    for (int j = 0; j < 4; ++j) { const int c = 4 * lane + 256 * j; v[j] = *(const f32x4*)(xs + c);
        if (ym) { const uint2 y0 = *(const uint2*)(ym + c), y1 = *(const uint2*)(ym + 1024 + c); const f32x4 g4 = *(const f32x4*)(gt + c);
            v[j][0] += g4[0] * (bflo(y0.x) + bflo(y1.x)); v[j][1] += g4[1] * (bfhi(y0.x) + bfhi(y1.x)); v[j][2] += g4[2] * (bflo(y0.y) + bflo(y1.y)); v[j][3] += g4[3] * (bfhi(y0.y) + bfhi(y1.y)); }
        if (wx) *(f32x4*)(xd + c) = v[j];
        ss += v[j][0] * v[j][0] + v[j][1] * v[j][1] + v[j][2] * v[j][2] + v[j][3] * v[j][3]; }
    rinv = rsqrtf(wave_sum_dpp(ss) * (1.f / D) + EPS);
}
__device__ __forceinline__ void rp_mod(const f32x4 (&v)[4], float rinv, const float* gn, const float* mo, int sh_off, int sc_off, bf16_t* hp, int lane, f32x4 (&hv)[4], bf16_t* hp2 = nullptr) {
#pragma unroll
    for (int j = 0; j < 4; ++j) { const int c = 4 * lane + 256 * j; const f32x4 g4 = *(const f32x4*)(gn + c), s4 = *(const f32x4*)(mo + sc_off + c), h4 = *(const f32x4*)(mo + sh_off + c);
        hv[j] = v[j] * rinv * g4 * (s4 + 1.f) + h4;
        const uint2 w = make_uint2(pkbf(hv[j][0], hv[j][1]), pkbf(hv[j][2], hv[j][3])); *(uint2*)(hp + c) = w; if (hp2) *(uint2*)(hp2 + c) = w; }
}
__device__ __forceinline__ void phase_rowpass1(const Frame& F, int l, bool combine, size_t h_off, bf16_t* copy = nullptr) {
    const int tid = opaque_tid(F.wv0), lane = tid & 63, wave = __builtin_amdgcn_readfirstlane(tid >> 6); (void)lane; (void)wave;
    const int gw = blockIdx.x * 8 + wave, NGW = gridDim.x * 8;
    const float* xl = (l == 0) ? INP(0) : F.out; const float* xc = (l == 0) ? INP(2) : WSP(float, O_XC);
    const float* MODl = WSP(float, O_MOD) + (size_t)l * 5 * 6144; const float* MODp = WSP(float, O_MOD);
    for (int g = gw; g < G; g += NGW) { const RowInfo ri = rowinfo(g); const int mrow = ri.lat ? ri.b : 4; const size_t xo = xoff(ri);
        const float* xs = (ri.lat ? xl : xc) + xo; float* xd = (ri.lat ? F.out : WSP(float, O_XC)) + xo;
        f32x4 v[4], hv[4]; float rinv;
        rp_load(xs, xd, combine, combine ? WSP(bf16_t, O_YM2) + (size_t)g * 2048 : nullptr, MODp + (size_t)mrow * 6144 + 5120, lane, v, rinv);
        rp_mod(v, rinv, INP(6) + l * 1024, MODl + (size_t)mrow * 6144, 0, 1024, WSP(bf16_t, h_off) + (size_t)g * D, lane, hv, copy ? copy + (size_t)g * D : nullptr); }
}
__device__ __forceinline__ void phase_rowpass2(const Frame& F, int l, int nbusy) {
    const int tid = opaque_tid(F.wv0), lane = tid & 63, wave = __builtin_amdgcn_readfirstlane(tid >> 6);
    { int* perm = WSP(int, O_PERM); unsigned* goff = WSP(unsigned, O_GOFF);
      for (int i = blockIdx.x * 512 + tid; i < PMAX; i += gridDim.x * 512) { perm[i] = -1; goff[i] = 0u; } }
    if ((int)blockIdx.x < nbusy) return;
    const int gw = ((int)blockIdx.x - nbusy) * 8 + wave, NGW = ((int)gridDim.x - nbusy) * 8;
    const float* MODl = WSP(float, O_MOD) + (size_t)l * 5 * 6144;
    for (int lr = gw; lr < NB * SEQ; lr += NGW) { const int b = lr / SEQ, t = lr - b * SEQ, g = b * RPB + t;
        const float* xs = F.out + (size_t)lr * D;
        f32x4 v[4], hv[4]; float rinv;
        rp_load(xs, nullptr, false, nullptr, nullptr, lane, v, rinv);
        rp_mod(v, rinv, INP(7) + l * 1024, MODl + (size_t)b * 6144, 3072, 4096, WSP(bf16_t, O_H) + (size_t)g * D, lane, hv); }
}
__device__ __forceinline__ void rowpass2_ctx_panel(const Frame& F, int l, int b) {
    const int tid = opaque_tid(F.wv0), lane = tid & 63, wave = __builtin_amdgcn_readfirstlane(tid >> 6);
    const float* MODc = WSP(float, O_MOD) + (size_t)l * 5 * 6144 + (size_t)4 * 6144; const float* xc = WSP(float, O_XC) + (size_t)b * CTXL * D;
    for (int r0 = wave * 4; r0 < CTXL; r0 += 32) { f32x4 v[4][4]; f32x4 hv[4]; float rinv;
#pragma unroll
        for (int q = 0; q < 4; ++q)
#pragma unroll
            for (int j = 0; j < 4; ++j) v[q][j] = *(const f32x4*)(xc + (size_t)(r0 + q) * D + 4 * lane + 256 * j);
#pragma unroll
        for (int q = 0; q < 4; ++q) { float ss = 0.f;
#pragma unroll
            for (int j = 0; j < 4; ++j) ss += v[q][j][0] * v[q][j][0] + v[q][j][1] * v[q][j][1] + v[q][j][2] * v[q][j][2] + v[q][j][3] * v[q][j][3];
            rinv = rsqrtf(wave_sum_dpp(ss) * (1.f / D) + EPS);
            rp_mod(v[q], rinv, INP(7) + l * 1024, MODc, 3072, 4096, WSP(bf16_t, O_H) + (size_t)(b * RPB + SEQ + r0 + q) * D, lane, hv); } }
}
struct EpiRoute {
    static constexpr bool PERM = false;
    int* route_e; float* route_w; LAS int* hist;
    __device__ __forceinline__ void operator()(const f32x4 (&acc)[2][2][4][2], const gp::GUnit& u, int wr, int wc, int fr, int fq) const {
        if (wc != 0) return;
#pragma unroll
        for (int ai = 0; ai < 2; ++ai)
#pragma unroll
            for (int m = 0; m < 4; ++m) { const int row = u.pm * 256 + ai * 128 + wr * 64 + m * 16 + fr;
                float el[8];
#pragma unroll
                for (int e = 0; e < 4; ++e) { el[e] = acc[ai][0][m][0][e]; el[4 + e] = acc[ai][0][m][1][e]; }
                const float gl = acc[ai][1][m][0][0];
                int i0 = 0; float m0 = el[0];
#pragma unroll
                for (int j = 1; j < 8; ++j) if (el[j] > m0) { m0 = el[j]; i0 = j; }
                int i1 = -1; float m1 = -3.4e38f;
#pragma unroll
                for (int j = 0; j < 8; ++j) if (j != i0 && el[j] > m1) { m1 = el[j]; i1 = j; }
                float gmax = gl; int gidx = fq;
#pragma unroll
                for (int off = 16; off <= 32; off <<= 1) { const float og = shxl(gmax, off, fr | (fq << 4)); const int oi = shxli(gidx, off, fr | (fq << 4)); if (og > gmax || (og == gmax && oi < gidx)) { gmax = og; gidx = oi; } }
                float gs = expf(gl - gmax); gs += shxl(gs, 16, fr | (fq << 4)); gs += shxl(gs, 32, fr | (fq << 4));
                if (fq == gidx) { const float gwt = 1.f / gs, p1 = expf(m1 - m0); const int e0 = fq * 8 + i0, e1 = fq * 8 + i1;
                    route_e[row * 2] = e0; route_e[row * 2 + 1] = e1; route_w[row * 2] = gwt / (1.f + p1); route_w[row * 2 + 1] = gwt * p1 / (1.f + p1);
                    __hip_atomic_fetch_add(hist + e0, 1, __ATOMIC_RELAXED, __HIP_MEMORY_SCOPE_WORKGROUP); __hip_atomic_fetch_add(hist + e1, 1, __ATOMIC_RELAXED, __HIP_MEMORY_SCOPE_WORKGROUP); } }
    }
};
__device__ __forceinline__ void phase_final(const Frame& F) {
    const int tid = opaque_tid(F.wv0), lane = tid & 63, wave = __builtin_amdgcn_readfirstlane(tid >> 6); (void)lane; (void)wave;
    const int gw = blockIdx.x * 8 + wave, NGW = gridDim.x * 8; const float* MOD1 = WSP(float, O_MOD) + (size_t)5 * 6144;
    for (int lr = gw; lr < NB * SEQ; lr += NGW) { const int b = lr / SEQ, t = lr - b * SEQ; const int g = b * RPB + t; float* xp = F.out + (size_t)lr * D;
        f32x4 v[4]; float rinv; rp_load(xp, nullptr, false, WSP(bf16_t, O_YM2) + (size_t)g * 2048, MOD1 + (size_t)b * 6144 + 5120, lane, v, rinv);
#pragma unroll
        for (int j = 0; j < 4; ++j) { const int c = 4 * lane + 256 * j; const f32x4 g4 = *(const f32x4*)(INP(23) + c); *(f32x4*)(xp + c) = v[j] * rinv * g4; } }
}
__device__ __forceinline__ void phase_moe_scatter(const Frame& F, int l, bool last) {
    const int tid = opaque_tid(F.wv0), lane = tid & 63, wave = __builtin_amdgcn_readfirstlane(tid >> 6);
    LAS int* tot = (LAS int*)F.lds; LAS int* bef = tot + 512; LAS int* base = tot + 1024; LAS int* lcur = tot + 1056;
    const int* WGH = WSP(int, O_WGH) + (size_t)l * 256 * 32; const int nwg = gridDim.x, me = blockIdx.x;
    { const int e = tid & 31, part = tid >> 5; int sa = 0, sb = 0;
      for (int w = part * 16; w < part * 16 + 16 && w < nwg; ++w) { const int c = WGH[w * 32 + e]; sa += c; if (w < me) sb += c; }
      tot[part * 32 + e] = sa; bef[part * 32 + e] = sb; }
    __syncthreads();
    int sa2 = 0, sb2 = 0;
    if (tid < 32) {
#pragma unroll
        for (int part = 0; part < 16; ++part) { sa2 += tot[part * 32 + tid]; sb2 += bef[part * 32 + tid]; } }
    __syncthreads();
    if (tid < 32) { tot[tid] = sa2; bef[tid] = sb2; lcur[tid] = 0; }
    __syncthreads();
    if (tid == 0) { int o = 0; int* tile_e = WSP(int, O_TILEE);
#pragma clang loop unroll(disable) vectorize(disable)
        for (int e = 0; e < 32; ++e) { base[e] = o + bef[e]; const int n = (tot[e] + 255) & ~255;
            if (me == 0) {
#pragma clang loop unroll(disable) vectorize(disable)
                for (int t = o >> 8; t < (o + n) >> 8; ++t) tile_e[t] = e; }
            o += n; }
        if (me == 0) tile_e[NTILE] = o >> 8; }
    __syncthreads();
    const int* route_e = WSP(int, O_ROUTE_E); const float* route_w = WSP(float, O_ROUTE_W); int* perm = WSP(int, O_PERM); float* posw = WSP(float, O_POSW); unsigned* goff = WSP(unsigned, O_GOFF);
    { int pmv, pn;
      if (gp::tile_order(0, (int)gridDim.x, (int)blockIdx.x, last ? 128 : 132, 1, pmv, pn)) { const int pm = last ? pmv + pmv / 32 : pmv; const int g = pm * 256 + (tid >> 1); const int i = g * 2 + (tid & 1);
          const int e = route_e[i]; const int pos = base[e] + __hip_atomic_fetch_add(lcur + e, 1, __ATOMIC_RELAXED, __HIP_MEMORY_SCOPE_WORKGROUP);
          perm[pos] = i; posw[pos] = route_w[i]; goff[pos] = (unsigned)g * 2048u; } }
    (void)lane; (void)wave;
}

#ifndef PROBE_DUP
#define PROBE_DUP 0
#endif
#ifndef PROBE_EXTRA_MASK
#define PROBE_EXTRA_MASK 0ull
#endif
#define DUP(bit) for (int rep_ = 0; rep_ < (((PROBE_DUP) >> (bit)) & 1) + 1; ++rep_)
__global__ void __launch_bounds__(512, 2) hybrid_trunk_fwd(KP p) {
    extern __shared__ __attribute__((aligned(16))) unsigned char dynlds[];
    Frame F; F.lds = (LAS char*)dynlds; F.ws = p.ws; F.out = p.out; F.wv0 = __builtin_amdgcn_readfirstlane((int)(threadIdx.x >> 6));
    if (threadIdx.x == 0) { LAS unsigned long long* pp = (LAS unsigned long long*)(F.lds + LDS_PTR_OFF);
        pp[0] = (unsigned long long)p.in[0];
        pp[1] = (unsigned long long)p.in[1];
        pp[2] = (unsigned long long)p.in[2];
        pp[3] = (unsigned long long)p.in[3];
        pp[4] = (unsigned long long)p.in[4];
        pp[5] = (unsigned long long)p.in[5];
        pp[6] = (unsigned long long)p.in[6];
        pp[7] = (unsigned long long)p.in[7];
        pp[8] = (unsigned long long)p.in[8];
        pp[9] = (unsigned long long)p.in[9];
        pp[10] = (unsigned long long)p.in[10];
        pp[11] = (unsigned long long)p.in[11];
        pp[12] = (unsigned long long)p.in[12];
        pp[13] = (unsigned long long)p.in[13];
        pp[14] = (unsigned long long)p.in[14];
        pp[15] = (unsigned long long)p.in[15];
        pp[16] = (unsigned long long)p.in[16];
        pp[17] = (unsigned long long)p.in[17];
        pp[18] = (unsigned long long)p.in[18];
        pp[19] = (unsigned long long)p.in[19];
        pp[20] = (unsigned long long)p.in[20];
        pp[21] = (unsigned long long)p.in[21];
        pp[22] = (unsigned long long)p.in[22];
        pp[23] = (unsigned long long)p.in[23];
    }
    LAS unsigned char* glds = (LAS unsigned char*)dynlds;
    volatile LAS unsigned* barst = (volatile LAS unsigned*)(F.lds + LDS_BAR_OFF);
    if (threadIdx.x < 16) ((LAS unsigned*)(F.lds + LDS_BAR_OFF))[threadIdx.x] = 0u;
    __syncthreads();
    const bool multi = (p.ph_hi - p.ph_lo) > 1;
    XcdBarrier bar; bar.bar = (unsigned*)F.ws; bar.x = 0; bar.st = nullptr;
    if (multi) bar = xcd_barrier_post((unsigned*)F.ws, barst);
    int ph = 0;
#define PH_BEGIN if (ph >= p.ph_lo && ph < p.ph_hi && (PROBE_EXTRA_MASK == 0ull || p.mask == 0ull || ((p.mask >> ph) & 1ull))) {
#define PH_END   if (ph + 1 < p.ph_hi) xcd_barrier(bar); else __syncthreads(); } ++ph;
    const int Gd = gridDim.x, cb = blockIdx.x;

    PH_BEGIN p0_mod(F); p0_tables(F); __syncthreads(); conv_weights_nonmoe(F, 0); PH_END

    for (int l = 0; l < 2; ++l) {
        const bool last = (l == 1);
        const float* MODl = WSP(float, O_MOD) + (size_t)l * 5 * 6144;
        PH_BEGIN phase_rowpass1(F, l, l > 0, O_H, l == 0 ? (bf16_t*)F.out : nullptr); PH_END
        PH_BEGIN
        { SchedStd S{}; S.A = WSP(bf16_t, O_H); S.Bt = WSP(bf16_t, O_WINP); S.K = 1024; S.nM = 132; S.nN = 15; S.G_ = Gd; S.c = cb; S.skipctx = 0; S.lda2 = 2048; S.ldb2 = 2048;
          EpiG1 E{}; E.AQ = WSP(bf16_t, O_AQ); E.AK = WSP(bf16_t, O_AK); E.AV = WSP(bf16_t, O_AV); E.BQ = WSP(bf16_t, O_BQ); E.BV = WSP(bf16_t, O_BV); E.BG = WSP(bf16_t, O_BG); E.BLF = WSP(f16_t, O_BLF); E.BLB = WSP(f16_t, O_BLB);
          E.CQKV = WSP(bf16_t, O_CQKV); E.CKR = WSP(bf16_t, O_CKR); E.RS = WSP(float, O_RS); E.ropa_c = WSP(float, O_ROPA_C); E.ropa_s = WSP(float, O_ROPA_S); E.ropc_c = WSP(float, O_ROPC_C); E.ropc_s = WSP(float, O_ROPC_S);
          E.LBl = WSP(float, O_LB) + l * 1024; E.rowoff = 0; E.lbzero = (l == 0) ? 1 : 0;
          DUP(0) gp::gemm_phase<EpiG1, SchedStd>(glds, S, E, F.wv0); }
        PH_END
        PH_BEGIN
        { SchedStd S{}; S.A = WSP(bf16_t, O_CQKV); S.Bt = WSP(bf16_t, O_WC); S.K = 384; S.nM = 132; S.nN = 7; S.G_ = Gd; S.c = cb; S.skipctx = 0; S.lda2 = 768; S.ldb2 = 768;
          EpiC E{}; E.CQ = WSP(bf16_t, O_CQ); E.CKV = WSP(bf16_t, O_CKV); E.RS = WSP(float, O_RS); E.ropc_c = WSP(float, O_ROPC_C); E.ropc_s = WSP(float, O_ROPC_S); E.pmoff = 0;
          DUP(1) gp::gemm_phase<EpiC, SchedStd>(glds, S, E, F.wv0); }
        __syncthreads();
        { AttnArgs a{}; a.Q = WSP(bf16_t, O_AQ); a.qld = 512; a.qhs = 64; a.K1 = WSP(bf16_t, O_AK); a.k1ld = 128; a.k1hs = 64; a.kvgroup = 4; a.K2 = nullptr; a.k2ld = 0; a.V = WSP(bf16_t, O_AV); a.vld = 128; a.vhs = 64;
          a.O = WSP(bf16_t, O_AQ); a.old = 512; a.ohs = 64; a.scale_l2 = 0.125f * LOG2E; a.sink = INP(9) + l * 8; a.window = 128;
          const int nqb = last ? 32 : 33;
          DUP(10) for (int u = cb; u < NB * 8 * nqb; u += Gd) { int b, h, qb; if (u < NB * 8 * 32) { b = u >> 8; h = u & 7; qb = (u >> 3) & 31; }     else { const int r_ = u - NB * 8 * 32; b = r_ >> 3; h = r_ & 7; qb = 32; }
              attn_unit<64>(F.lds, a, F.wv0, b, qb, h, ((PROBE_DUP >> 10) & 1) && rep_ == 0); } }
        __syncthreads();
        { ScanArgs a{}; a.BQ = WSP(bf16_t, O_BQ); a.BV = WSP(bf16_t, O_BV); a.BG = WSP(bf16_t, O_BG); a.BLF = WSP(f16_t, O_BLF); a.BLB = WSP(f16_t, O_BLB); a.ST = WSP(bf16_t, O_H); a.DS = WSP(float, O_DS); a.OB = WSP(bf16_t, O_BQ); a.gn = INP(11) + l * 512;
          DUP(2) { const int tid_ = opaque_tid(F.wv0);
            if (cb < NB * 8 * NCHK) { const int b = cb / (8 * NCHK), rem = cb - b * 8 * NCHK, h = rem / NCHK, k = rem - h * NCHK; __syncthreads(); scan_stage(F.lds, a, (size_t)b * RPB + 64 * k - a.in_off, h, tid_); }
            for (int u = cb; u < NB * 8 * NCHK; u += Gd) { const int b = u / (8 * NCHK), rem = u - b * 8 * NCHK, h = rem / NCHK, k = rem - h * NCHK;
                const int un = u + Gd; const bool hn = un < NB * 8 * NCHK; const int nb_ = un / (8 * NCHK), nrem = un - nb_ * 8 * NCHK, nh_ = nrem / NCHK, nk_ = nrem - nh_ * NCHK;
                scan_s1_unit(F.lds, a, F.wv0, b, h, k, hn, nb_, nh_, nk_); } } }
        PH_END
        PH_BEGIN
        { ScanArgs a{}; a.ST = WSP(bf16_t, O_H); a.DS = WSP(float, O_DS);
          for (int t = cb; t < NB * 8 * 2 * 4; t += Gd) scan_s2_task(a, F.wv0, t); }
        { AttnArgs a{}; a.Q = WSP(bf16_t, O_CQ); a.qld = 768; a.qhs = 96; a.K1 = WSP(bf16_t, O_CKV); a.k1ld = 1024; a.k1hs = 128; a.kvgroup = 1; a.K2 = WSP(bf16_t, O_CKR); a.k2ld = 32; a.V = WSP(bf16_t, O_CKV) + 64; a.vld = 1024; a.vhs = 128;
          a.O = WSP(bf16_t, O_OC); a.old = 512; a.ohs = 64; a.scale_l2 = 0.10206207261596577f * LOG2E; a.sink = nullptr; a.window = 0; a.pad = (PROBE_VARIANT && p.mask != 0ull) ? 1 : 0;
          const int nqb = last ? 32 : 33;
          DUP(3) for (int u = cb; u < NB * 8 * nqb; u += Gd) { int b, h, qb; if (u < NB * 8 * 32) { b = u >> 8; h = u & 7; qb = (u >> 3) & 31; }     else { const int r_ = u - NB * 8 * 32; b = r_ >> 3; h = r_ & 7; qb = 32; }
              if (PROBE_VARIANT >= 6 && p.mask != 0ull) attn_unit<96, PROBE_VARIANT>(F.lds, a, F.wv0, b, qb, h); else attn_unit<96>(F.lds, a, F.wv0, b, qb, h); } }
        PH_END
        PH_BEGIN
        { ScanArgs a{}; a.BQ = WSP(bf16_t, O_BQ); a.BV = WSP(bf16_t, O_BV); a.BG = WSP(bf16_t, O_BG); a.BLF = WSP(f16_t, O_BLF); a.BLB = WSP(f16_t, O_BLB); a.ST = WSP(bf16_t, O_H); a.DS = WSP(float, O_DS); a.OB = WSP(bf16_t, O_BQ); a.gn = INP(11) + l * 512; a.skipctx_out = last ? 1 : 0;
          DUP(9) { a.pad = (((PROBE_DUP >> 9) & 1) && rep_ == 0) ? 1 : 0; const int tid_ = opaque_tid(F.wv0);
            if (cb < NB * 8 * NCHK) { const int b = cb / (8 * NCHK), rem = cb - b * 8 * NCHK, h = rem / NCHK, k = rem - h * NCHK; u32x4 t0, t1; __syncthreads(); scan_stage(F.lds, a, (size_t)b * RPB + 64 * k - a.in_off, h, tid_); s3_state_load(a, b, h, k, tid_, t0, t1); s3_state_store((LAS bf16_t*)(F.lds + SC_A), tid_, t0, t1); }
            for (int u = cb; u < NB * 8 * NCHK; u += Gd) { const int b = u / (8 * NCHK), rem = u - b * 8 * NCHK, h = rem / NCHK, k = rem - h * NCHK;
                const int un = u + Gd; const bool hn = un < NB * 8 * NCHK; const int nb_ = un / (8 * NCHK), nrem = un - nb_ * 8 * NCHK, nh_ = nrem / NCHK, nk_ = nrem - nh_ * NCHK;
                scan_s3_unit(F.lds, a, F.wv0, b, h, k, hn, nb_, nh_, nk_); } } }
        if (last) phase_rowpass1(F, l, false, O_CKV);
        PH_END
        PH_BEGIN
        { SchedGM S{}; S.A0 = WSP(bf16_t, O_AQ); S.A1 = WSP(bf16_t, O_BQ); S.A2 = WSP(bf16_t, O_OC); S.Ag = last ? WSP(bf16_t, O_CKV) : (const bf16_t*)F.out; S.Bbr = WSP(bf16_t, O_WBR); S.Bg = WSP(bf16_t, O_WINP) + (size_t)3840 * 1024;
          S.nM = 128; S.G_ = Gd; S.c = cb; S.skipctx = 1; S.lda2 = 1024; S.ldb2 = 1024; S.su = 1;
          EpiGM E{}; E.U = WSP(bf16_t, O_GATE); E.nstride = (long)G * 1024; E.ld = 1024; E.Y = WSP(bf16_t, O_H); E.fuse = 1;
          gp::gemm_phase<EpiGM, SchedGM>(glds, S, E, F.wv0); }
        PH_END
        if (!last) {
        PH_BEGIN
        constexpr int NCTXW = 48;
        { SchedGM S{}; S.A0 = WSP(bf16_t, O_AQ); S.A1 = WSP(bf16_t, O_BQ); S.A2 = WSP(bf16_t, O_OC); S.Ag = (const bf16_t*)F.out; S.Bbr = WSP(bf16_t, O_WBR); S.Bg = WSP(bf16_t, O_WINP) + (size_t)3840 * 1024;
          S.nM = 4; S.G_ = Gd; S.c = cb; S.skipctx = 2; S.lda2 = 1024; S.ldb2 = 1024; S.su = 0;
          EpiGM E{}; E.U = WSP(bf16_t, O_GATE); E.nstride = (long)G * 1024; E.ld = 1024; E.Y = nullptr; E.fuse = 0;
          gp::gemm_phase<EpiGM, SchedGM>(glds, S, E, F.wv0); }
        conv_weights_moe(F, l, NCTXW, 32 * 16 * 16 + 32 * 32 * 4, false, 0, 0);
        PH_END
        }
        PH_BEGIN
        if (!last) { const int tid_ = opaque_tid(F.wv0), lane_ = tid_ & 63, wave_ = __builtin_amdgcn_readfirstlane(tid_ >> 6); const bf16_t* U = WSP(bf16_t, O_GATE); bf16_t* Y = WSP(bf16_t, O_H);
          const int r_ = cb * 8 + wave_;
          if (r_ < NB * CTXL) { const int g = (r_ / CTXL) * RPB + SEQ + (r_ % CTXL);
#pragma unroll
              for (int j = 0; j < 2; ++j) { const size_t o = (size_t)g * 1024 + 8 * lane_ + 512 * j;
                  const u32x4 a = *(const u32x4*)(U + o), b2 = *(const u32x4*)(U + (size_t)G * 1024 + o), c2 = *(const u32x4*)(U + (size_t)2 * G * 1024 + o);
                  u32x4 w; w.x = pkbf(bflo(a.x) + bflo(b2.x) + bflo(c2.x), bfhi(a.x) + bfhi(b2.x) + bfhi(c2.x)); w.y = pkbf(bflo(a.y) + bflo(b2.y) + bflo(c2.y), bfhi(a.y) + bfhi(b2.y) + bfhi(c2.y));
                  w.z = pkbf(bflo(a.z) + bflo(b2.z) + bflo(c2.z), bfhi(a.z) + bfhi(b2.z) + bfhi(c2.z)); w.w = pkbf(bflo(a.w) + bflo(b2.w) + bflo(c2.w), bfhi(a.w) + bfhi(b2.w) + bfhi(c2.w));
                  *(u32x4*)(Y + o) = w; } }
          asm volatile("s_waitcnt vmcnt(0)" ::: "memory"); __syncthreads(); }
        { SchedStd S{}; S.A = WSP(bf16_t, O_H); S.Bt = WSP(bf16_t, O_WOUT); S.K = 1024; S.nM = 128; S.nN = 4; S.G_ = Gd; S.c = cb; S.skipctx = 1; S.lda2 = 2048; S.ldb2 = 2048;
          EpiOut E{}; E.xl_src = l == 0 ? INP(0) : F.out; E.xc_src = l == 0 ? INP(2) : WSP(float, O_XC); E.xl_dst = F.out; E.xc_dst = WSP(float, O_XC); E.mod = MODl; E.pmoff = 0;
          gp::gemm_phase<EpiOut, SchedStd>(glds, S, E, F.wv0); }
        PH_END
        PH_BEGIN
        constexpr int NCTXO = 16;
        if (!last) { SchedStd S{}; S.A = WSP(bf16_t, O_H); S.Bt = WSP(bf16_t, O_WOUT); S.K = 1024; S.nM = 4; S.nN = 4; S.G_ = Gd; S.c = cb; S.skipctx = 2; S.lda2 = 2048; S.ldb2 = 2048;
          EpiOut E{}; E.xl_src = INP(0); E.xc_src = INP(2); E.xl_dst = F.out; E.xc_dst = WSP(float, O_XC); E.mod = MODl; E.pmoff = 0;
          gp::gemm_phase<EpiOut, SchedStd>(glds, S, E, F.wv0); }
        phase_rowpass2(F, l, last ? 0 : NCTXO);
        PH_END
        PH_BEGIN
        bool ctxown_ = false;
        { LAS int* hist = (LAS int*)(F.lds + 131072); const int t_ = opaque_tid(F.wv0);
          if (t_ < 32) hist[t_] = 0;
          __syncthreads();
          if (!last) { int pmv_, pn_; ctxown_ = gp::tile_order(0, Gd, cb, 132, 1, pmv_, pn_) && (pmv_ % 33) == 32;
              if (ctxown_) { rowpass2_ctx_panel(F, l, pmv_ / 33); asm volatile("s_waitcnt vmcnt(0)" ::: "memory"); } __syncthreads();
}          SchedStd S{}; S.A = WSP(bf16_t, O_H); S.Bt = WSP(bf16_t, O_WRB) + (size_t)l * 256 * 1024; S.K = 1024; S.nM = last ? 128 : 132; S.nN = 1; S.G_ = Gd; S.c = cb; S.skipctx = last ? 1 : 0; S.lda2 = 2048; S.ldb2 = 2048;
          EpiRoute E{}; E.route_e = WSP(int, O_ROUTE_E); E.route_w = WSP(float, O_ROUTE_W); E.hist = hist;
          gp::gemm_phase<EpiRoute, SchedStd>(glds, S, E, F.wv0);
          __syncthreads();
          { const int t2_ = opaque_tid(F.wv0); if (t2_ < 32) WSP(int, O_WGH)[((size_t)l * 256 + cb) * 32 + t2_] = hist[t2_]; }
          __syncthreads(); }
        if (last) conv_weights_moe(F, l, 128, 6000, false, 0, 0); else conv_weights_nonmoe(F, l + 1);
        PH_END
        PH_BEGIN phase_moe_scatter(F, l, last); PH_END
        PH_BEGIN
        { SchedMoE<true> S{}; S.A = WSP(bf16_t, O_H); S.Bt = WSP(bf16_t, O_WUP); S.tile_e = WSP(int, O_TILEE); S.goff = WSP(unsigned, O_GOFF); S.K = 1024; S.nM = WSP(int, O_TILEE)[NTILE]; S.nN = 2; S.G_ = Gd; S.c = cb; S.lda2 = 2048; S.ldb2 = 2048; S.strideB = 512 * 1024;
          EpiUp E{}; E.AUP = WSP(bf16_t, O_AUP);
          DUP(7) gp::gemm_phase<EpiUp, SchedMoE<true>>(glds, S, E, F.wv0); }
        PH_END
        PH_BEGIN
        { SchedMoE<false> S{}; S.A = WSP(bf16_t, O_AUP); S.Bt = WSP(bf16_t, O_WDN); S.tile_e = WSP(int, O_TILEE); S.goff = nullptr; S.K = 256; S.nM = WSP(int, O_TILEE)[NTILE]; S.nN = 4; S.G_ = Gd; S.c = cb; S.lda2 = 512; S.ldb2 = 512; S.strideB = 1024 * 256;
          EpiDown E{}; E.YM2 = WSP(bf16_t, O_YM2); E.perm = WSP(int, O_PERM); E.posw = WSP(float, O_POSW);
          DUP(8) gp::gemm_phase<EpiDown, SchedMoE<false>>(glds, S, E, F.wv0); }
        PH_END
    }
    PH_BEGIN phase_final(F); PH_END
#undef PH_BEGIN
#undef PH_END
}
constexpr int N_PHASES = 1 + 13 + 12 + 1;
}

#ifndef MK_N_LAUNCHES
#define MK_N_LAUNCHES 1
#endif
extern "C" void kernel_launch(void* const* d_in, const int* in_sizes, int n_in, void* d_out, int out_size, void* d_ws, size_t ws_size, hipStream_t stream) {
    static int grid = 0;
    if (grid == 0) {
        if (ws_size < WS_END) { grid = -1; return; }
        int dev = 0, cus = 0;
        if (hipGetDevice(&dev) != hipSuccess || hipDeviceGetAttribute(&cus, hipDeviceAttributeMultiprocessorCount, dev) != hipSuccess) { grid = -1; return; }
        if (hipFuncSetAttribute((const void*)hybrid_trunk_fwd, hipFuncAttributeMaxDynamicSharedMemorySize, LDS_BYTES) != hipSuccess) { grid = -1; return; }
        int per_cu = 0; (void)hipOccupancyMaxActiveBlocksPerMultiprocessor(&per_cu, (const void*)hybrid_trunk_fwd, 512, LDS_BYTES); (void)hipGetLastError();
        grid = cus;
    }
    if (grid < 0) return;
    (void)hipMemsetAsync(d_ws, 0, CTL_ZERO_BYTES, stream);
    KP p{}; for (int i = 0; i < 24; ++i) p.in[i] = (const float*)d_in[i]; p.out = (float*)d_out; p.ws = (char*)d_ws;
    (void)in_sizes; (void)n_in; (void)out_size;
    if (MK_N_LAUNCHES == 1) { p.ph_lo = 0; p.ph_hi = N_PHASES; hipLaunchKernelGGL(hybrid_trunk_fwd, dim3(grid), dim3(512), LDS_BYTES, stream, p);
        if (PROBE_EXTRA_MASK) { (void)hipMemsetAsync(d_ws, 0, CTL_ZERO_BYTES, stream); p.mask = PROBE_EXTRA_MASK; hipLaunchKernelGGL(hybrid_trunk_fwd, dim3(grid), dim3(512), LDS_BYTES, stream, p); } }
    else { for (int k = 0; k < N_PHASES; ++k) { p.ph_lo = k; p.ph_hi = k + 1; hipLaunchKernelGGL(hybrid_trunk_fwd, dim3(grid), dim3(512), LDS_BYTES, stream, p); } }
}
```
